# Optimizing an MI355X kernel written in HIP

```python
import math
import jax
import jax.numpy as jnp
from jax import lax
import numpy as np

D_MODEL = 1024
BATCH = 2
SEQ = 8192
DEPTH = 4
DEC_BATCH = 128
DEC_SEQ = 8
PAST_LEN = 8192
PAGE_SIZE = 128

N_MIXERS = 2
N_ATTN_LAYERS = (DEPTH + N_MIXERS - 1) // N_MIXERS
N_SSM_LAYERS = DEPTH // N_MIXERS
HEAD_DIM = 64
N_HEADS = D_MODEL // HEAD_DIM
N_KV_HEADS = 4
Q_PER_KV = N_HEADS // N_KV_HEADS
WINDOW = 128
QKV_DIM = (N_HEADS + 2 * N_KV_HEADS) * HEAD_DIM
GROUP_CH = 16
N_GROUPS = D_MODEL // GROUP_CH
STATE_DIM = 64
D_FF = 4 * D_MODEL
RMS_EPS = 1e-6
NEG_INF = -1e30

kernel_name = "hybrid_swa_sink_s5_decoder_step"


def rms_norm(x, g):
    xf = x.astype(jnp.float32)
    y = xf * lax.rsqrt(jnp.mean(xf * xf, axis=-1, keepdims=True) + RMS_EPS)
    return (y * g.astype(jnp.float32)).astype(x.dtype)


def alibi_slopes():
    h = jnp.arange(1, N_HEADS + 1, dtype=jnp.float32)
    return jnp.exp2(-8.0 * h / N_HEADS)


def qkv_split(x, w_qkv):
    b, t, _ = x.shape
    qkv = x @ w_qkv
    q_end = N_HEADS * HEAD_DIM
    k_end = q_end + N_KV_HEADS * HEAD_DIM
    q = qkv[..., :q_end].reshape(b, t, N_KV_HEADS, Q_PER_KV, HEAD_DIM)
    k = qkv[..., q_end:k_end].reshape(b, t, N_KV_HEADS, HEAD_DIM)
    v = qkv[..., k_end:].reshape(b, t, N_KV_HEADS, HEAD_DIM)
    return q, k, v


def sink_attention(q, k, v, dist, valid, sinks):
    f32 = jnp.float32
    slopes = alibi_slopes().reshape(1, N_KV_HEADS, Q_PER_KV, 1, 1)
    s = jnp.einsum("bqkgd,bskd->bkgqs", q.astype(f32), k.astype(f32)) * (HEAD_DIM ** -0.5)
    s = s - slopes * dist.astype(f32)[None, None, None]
    s = jnp.where(valid[:, None, None], s, NEG_INF)
    sink = sinks.astype(f32).reshape(1, N_KV_HEADS, Q_PER_KV, 1, 1)
    m = jnp.maximum(jnp.max(s, axis=-1, keepdims=True), sink)
    p = jnp.exp(s - m)
    denom = jnp.sum(p, axis=-1, keepdims=True) + jnp.exp(sink - m)
    o = jnp.einsum("bkgqs,bskd->bqkgd", p / denom, v.astype(f32))
    return o.astype(q.dtype)


def attn_prompt(x, w_qkv, w_o, sinks):
    b, t, _ = x.shape
    nb = t // WINDOW
    q, k, v = qkv_split(x, w_qkv)
    pad = jnp.zeros((b, WINDOW, N_KV_HEADS, HEAD_DIM), k.dtype)
    kp = jnp.concatenate([pad, k], axis=1).reshape(b, nb + 1, WINDOW, N_KV_HEADS, HEAD_DIM)
    vp = jnp.concatenate([pad, v], axis=1).reshape(b, nb + 1, WINDOW, N_KV_HEADS, HEAD_DIM)
    kb = jnp.concatenate([kp[:, :-1], kp[:, 1:]], axis=2).reshape(b * nb, 2 * WINDOW, N_KV_HEADS, HEAD_DIM)
    vb = jnp.concatenate([vp[:, :-1], vp[:, 1:]], axis=2).reshape(b * nb, 2 * WINDOW, N_KV_HEADS, HEAD_DIM)
    qb = q.reshape(b * nb, WINDOW, N_KV_HEADS, Q_PER_KV, HEAD_DIM)
    a = jnp.arange(WINDOW)[:, None]
    j = jnp.arange(2 * WINDOW)[None, :]
    dist = a + WINDOW - j
    blk = jnp.arange(nb)[:, None, None]
    valid = (dist >= 0) & (dist <= WINDOW) & ((blk > 0) | (j >= WINDOW))
    valid = jnp.tile(valid, (b, 1, 1))
    o = sink_attention(qb, kb, vb, dist, valid, sinks).reshape(b, t, N_HEADS * HEAD_DIM)
    return o @ w_o, k[:, -WINDOW:], v[:, -WINDOW:]


def attn_sample(x, ck, cv, w_qkv, w_o, sinks):
    b, t, _ = x.shape
    q, k, v = qkv_split(x, w_qkv)
    kk = jnp.concatenate([ck.astype(k.dtype), k], axis=1)
    vv = jnp.concatenate([cv.astype(v.dtype), v], axis=1)
    q_pos = PAST_LEN + jnp.arange(t)
    k_pos = jnp.concatenate([PAST_LEN - WINDOW + jnp.arange(WINDOW), PAST_LEN + jnp.arange(t)])
    dist = q_pos[:, None] - k_pos[None, :]
    valid = ((dist >= 0) & (dist <= WINDOW))[None]
    o = sink_attention(q, kk, vv, dist, valid, sinks).reshape(b, t, N_HEADS * HEAD_DIM)
    return o @ w_o, kk[:, -WINDOW:], vv[:, -WINDOW:]


def _complex_linear_combine(e1, e2):
    a1r, a1i, b1r, b1i = e1
    a2r, a2i, b2r, b2i = e2
    ar = a2r * a1r - a2i * a1i
    ai = a2r * a1i + a2i * a1r
    br = a2r * b1r - a2i * b1i + b2r
    bi = a2r * b1i + a2i * b1r + b2i
    return ar, ai, br, bi


def ssm_layer(u, h0_re, h0_im, a_re, a_im, log_dt, b_re, b_im, c_re, c_im, d_skip, w_glu):
    f32 = jnp.float32
    bsz, t, _ = u.shape
    uf = u.astype(f32).reshape(bsz, t, N_GROUPS, GROUP_CH)
    ar, ai = a_re.astype(f32), a_im.astype(f32)
    dt = jnp.exp(log_dt.astype(f32))[:, None]
    mag = jnp.exp(dt * ar)
    abar_r, abar_i = mag * jnp.cos(dt * ai), mag * jnp.sin(dt * ai)
    den = ar * ar + ai * ai
    nr = abar_r - 1.0
    coef_r = (nr * ar + abar_i * ai) / den
    coef_i = (abar_i * ar - nr * ai) / den
    bu_r = jnp.einsum("btgc,gnc->btgn", uf, b_re.astype(f32))
    bu_i = jnp.einsum("btgc,gnc->btgn", uf, b_im.astype(f32))
    in_r = coef_r * bu_r - coef_i * bu_i
    in_i = coef_r * bu_i + coef_i * bu_r
    if h0_re is not None:
        h0r, h0i = h0_re.astype(f32), h0_im.astype(f32)
        in_r = in_r.at[:, 0].add(abar_r * h0r - abar_i * h0i)
        in_i = in_i.at[:, 0].add(abar_r * h0i + abar_i * h0r)
    a_r = jnp.broadcast_to(abar_r, (1, t, N_GROUPS, STATE_DIM))
    a_i = jnp.broadcast_to(abar_i, (1, t, N_GROUPS, STATE_DIM))
    _, _, h_r, h_i = lax.associative_scan(_complex_linear_combine, (a_r, a_i, in_r, in_i), axis=1)
    y = (jnp.einsum("btgn,gcn->btgc", h_r, c_re.astype(f32))
         - jnp.einsum("btgn,gcn->btgc", h_i, c_im.astype(f32)))
    y = y.reshape(bsz, t, D_MODEL) + d_skip.astype(f32) * uf.reshape(bsz, t, D_MODEL)
    z = jax.nn.gelu(y).astype(u.dtype) @ w_glu
    val, gate = jnp.split(z, 2, axis=-1)
    out = val * jax.nn.sigmoid(gate)
    return out.astype(u.dtype), h_r[:, -1], h_i[:, -1]


def sq_relu_mlp(x, w_up, w_down):
    h = jax.nn.relu(x @ w_up)
    return (h * h) @ w_down


def run_trunk(x, cache_k, cache_v, h_re, h_im, norm_mix, norm_mlp, norm_final,
              w_qkv, w_o, attn_sinks, ssm_A_re, ssm_A_im, ssm_log_dt, ssm_B_re, ssm_B_im,
              ssm_C_re, ssm_C_im, ssm_D, w_glu, w_up, w_down):
    sample = cache_k is not None
    ks, vs, hrs, his = [], [], [], []
    for i in range(DEPTH):
        j = i // N_MIXERS
        h = rms_norm(x, norm_mix[i])
        if i % N_MIXERS == 0:
            if sample:
                y, k_buf, v_buf = attn_sample(h, cache_k[j], cache_v[j], w_qkv[j], w_o[j], attn_sinks[j])
            else:
                y, k_buf, v_buf = attn_prompt(h, w_qkv[j], w_o[j], attn_sinks[j])
            ks.append(k_buf)
            vs.append(v_buf)
        else:
            h0r = h_re[j] if sample else None
            h0i = h_im[j] if sample else None
            y, hr, hi = ssm_layer(h, h0r, h0i, ssm_A_re[j], ssm_A_im[j], ssm_log_dt[j],
                                  ssm_B_re[j], ssm_B_im[j], ssm_C_re[j], ssm_C_im[j],
                                  ssm_D[j], w_glu[j])
            hrs.append(hr)
            his.append(hi)
        x = x + y
        x = x + sq_relu_mlp(rms_norm(x, norm_mlp[i]), w_up[i], w_down[i])
    return rms_norm(x, norm_final), jnp.stack(ks), jnp.stack(vs), jnp.stack(hrs), jnp.stack(his)


def setup_inputs(seed: int = 0) -> dict:
    key = jax.random.key(seed)
    ks = jax.random.split(key, 24)
    f32 = jnp.float32

    def nrm(k, shape, scale):
        return scale * jax.random.normal(k, shape, f32)

    n = jnp.arange(STATE_DIM, dtype=f32)
    ssm_shape = (N_SSM_LAYERS, N_GROUPS, STATE_DIM)
    return {
        "x_prompt": nrm(ks[0], (BATCH, SEQ, D_MODEL), 1.0),
        "x_sample": nrm(ks[1], (DEC_BATCH, DEC_SEQ, D_MODEL), 1.0),
        "cache_k": nrm(ks[2], (N_ATTN_LAYERS, DEC_BATCH, WINDOW, N_KV_HEADS, HEAD_DIM), 1.0),
        "cache_v": nrm(ks[3], (N_ATTN_LAYERS, DEC_BATCH, WINDOW, N_KV_HEADS, HEAD_DIM), 1.0),
        "state_ssm_re": nrm(ks[4], (N_SSM_LAYERS, DEC_BATCH, N_GROUPS, STATE_DIM), 0.5),
        "state_ssm_im": nrm(ks[5], (N_SSM_LAYERS, DEC_BATCH, N_GROUPS, STATE_DIM), 0.5),
        "norm_mix": 1.0 + nrm(ks[6], (DEPTH, D_MODEL), 0.02),
        "norm_mlp": 1.0 + nrm(ks[7], (DEPTH, D_MODEL), 0.02),
        "norm_final": 1.0 + nrm(ks[8], (D_MODEL,), 0.02),
        "w_qkv": nrm(ks[9], (N_ATTN_LAYERS, D_MODEL, QKV_DIM), D_MODEL ** -0.5),
        "w_o": nrm(ks[10], (N_ATTN_LAYERS, N_HEADS * HEAD_DIM, D_MODEL), (N_HEADS * HEAD_DIM) ** -0.5),
        "attn_sinks": nrm(ks[11], (N_ATTN_LAYERS, N_HEADS), 0.5),
        "ssm_A_re": -0.5 + nrm(ks[12], ssm_shape, 0.01),
        "ssm_A_im": math.pi * n + nrm(ks[13], ssm_shape, 0.01),
        "ssm_log_dt": jax.random.uniform(ks[14], (N_SSM_LAYERS, N_GROUPS), f32,
                                         math.log(1e-3), math.log(1e-1)),
        "ssm_B_re": nrm(ks[15], (N_SSM_LAYERS, N_GROUPS, STATE_DIM, GROUP_CH), (2 * GROUP_CH) ** -0.5),
        "ssm_B_im": nrm(ks[16], (N_SSM_LAYERS, N_GROUPS, STATE_DIM, GROUP_CH), (2 * GROUP_CH) ** -0.5),
        "ssm_C_re": nrm(ks[17], (N_SSM_LAYERS, N_GROUPS, GROUP_CH, STATE_DIM), (2 * STATE_DIM) ** -0.5),
        "ssm_C_im": nrm(ks[18], (N_SSM_LAYERS, N_GROUPS, GROUP_CH, STATE_DIM), (2 * STATE_DIM) ** -0.5),
        "ssm_D": nrm(ks[19], (N_SSM_LAYERS, D_MODEL), 1.0),
        "w_glu": nrm(ks[20], (N_SSM_LAYERS, D_MODEL, 2 * D_MODEL), D_MODEL ** -0.5),
        "w_up": nrm(ks[21], (DEPTH, D_MODEL, D_FF), D_MODEL ** -0.5),
        "w_down": nrm(ks[22], (DEPTH, D_FF, D_MODEL), D_FF ** -0.5),
    }


def reference(x_prompt, x_sample, cache_k, cache_v, state_ssm_re, state_ssm_im,
              norm_mix, norm_mlp, norm_final, w_qkv, w_o, attn_sinks,
              ssm_A_re, ssm_A_im, ssm_log_dt, ssm_B_re, ssm_B_im, ssm_C_re, ssm_C_im,
              ssm_D, w_glu, w_up, w_down):
    y_prompt, k_prompt, v_prompt, h_re_prompt, h_im_prompt = run_trunk(
        x_prompt, None, None, None, None, norm_mix, norm_mlp, norm_final, w_qkv, w_o,
        attn_sinks, ssm_A_re, ssm_A_im, ssm_log_dt, ssm_B_re, ssm_B_im, ssm_C_re, ssm_C_im,
        ssm_D, w_glu, w_up, w_down)
    y_sample, k_sample, v_sample, h_re_sample, h_im_sample = run_trunk(
        x_sample, cache_k, cache_v, state_ssm_re, state_ssm_im, norm_mix, norm_mlp, norm_final,
        w_qkv, w_o, attn_sinks, ssm_A_re, ssm_A_im, ssm_log_dt, ssm_B_re, ssm_B_im, ssm_C_re,
        ssm_C_im, ssm_D, w_glu, w_up, w_down)
    return (y_prompt, y_sample, k_prompt, v_prompt, h_re_prompt, h_im_prompt,
            k_sample, v_sample, h_re_sample, h_im_sample)
```

```cpp
#include <hip/hip_runtime.h>
#include <cstdio>
#include <cstdint>
namespace pg8 {
#define PG8_LAS __attribute__((address_space(3)))
typedef unsigned short bf16_t;
typedef short bf16x8 __attribute__((ext_vector_type(8)));
typedef float f32x4 __attribute__((ext_vector_type(4)));
typedef unsigned u32x4 __attribute__((ext_vector_type(4)));
constexpr int BM = 256, BK = 64, HALF = 128, HTB = HALF * BK * 2  , STAGE_BYTES = 8 * HTB, NXCD = 8, WGM = 8;

__host__ __device__ __forceinline__ int lds_byte(int r, int c) { const int st = (r >> 4) * 2 + (c >> 5), rr = r & 15, cc = c & 31, ob = rr * 64 + cc * 2; return st * 1024 + (ob ^ (((ob >> 9) & 1) << 5)); }
__host__ __device__ __forceinline__ void stage_rc(int b, int& R, int& C) { const int st = b / 1024, sb = b % 1024, swz = sb ^ (((sb >> 9) & 1) << 5); R = (st >> 1) * 16 + swz / 64; C = (st & 1) * 32 + (swz % 64) / 2; }
__host__ __device__ __forceinline__ int perm32(int rho) { const int n = rho >> 4, i = rho & 15; return 8 * (i >> 2) + 4 * n + (i & 3); }

struct Unit { int pm, pn; };
struct Gemm { const bf16_t* A; const bf16_t* Bt; int M, N, K; };

struct StaticOrder {
    int nM, nN, nwg, G, c;
    __host__ __device__ void init(int M, int N, int G_, int c_) { nM = M / BM; nN = N / BM; nwg = nM * nN; G = G_; c = c_; }
    __host__ __device__ bool next(int i, Unit& u) const {
        const long L = (long)i * G + c; if (L >= nwg) return false;
        int wgid = (int)L; { const int q = nwg / NXCD, r = nwg % NXCD, xcd = wgid % NXCD, off = wgid / NXCD; wgid = (xcd < r ? xcd * (q + 1) : r * (q + 1) + (xcd - r) * q) + off; }
        const int nig = WGM * nN, gid = wgid / nig, fm = gid * WGM, gsz = (nM - fm) < WGM ? (nM - fm) : WGM;
        u.pm = fm + ((wgid % nig) % gsz); u.pn = (wgid % nig) / gsz; return true;
    }
    __device__ __forceinline__ void a_ready(const Unit&) const {}
    __device__ __forceinline__ void done(const Unit&) const {}
};
__device__ __forceinline__ unsigned cvt_pk_bf16(float lo, float hi) { unsigned r; asm volatile("v_cvt_pk_bf16_f32 %0, %1, %2" : "=v"(r) : "v"(lo), "v"(hi)); return r; }
typedef float f32x2 __attribute__((ext_vector_type(2)));
template <class Epi, class Sched, bool ALIGN_EPI = false, bool SP2 = false>
__device__ __forceinline__ void gemm_phase(PG8_LAS unsigned char* lds, const Gemm g, const Sched& S, const Epi& E) {
    const int tid = threadIdx.x, wid = __builtin_amdgcn_readfirstlane(tid >> 6), lane = tid & 63, wr = wid >> 2, wc = wid & 3, fr = lane & 15, fq = lane >> 4;
    const int K = g.K, nt = K / BK;
    unsigned voffA[2], voffB[2];
#pragma unroll
    for (int i = 0; i < 2; ++i) { int R, C; stage_rc(tid * 16 + i * 8192, R, C); const int Rb = Epi::PERM ? ((R & ~31) + perm32(R & 31)) : R;
        voffA[i] = (unsigned)(R * K + C) * 2u; voffB[i] = (unsigned)(Rb * K + C) * 2u; }
    const size_t kstep = (size_t)(BK * 2);
    const size_t hstep = (size_t)HALF * K * 2;
    const size_t tstep = 2 * hstep;
    const unsigned ldsw = (unsigned)wid * 1024u;
    const int aoff = lds_byte(wr * 64 + fr, fq * 8), boff = lds_byte(wc * 32 + fr, fq * 8);
#define PG8_SA(b, h) (((b) * 2 + (h)) * HTB)
#define PG8_SB(b, h) ((4 + (b) * 2 + (h)) * HTB)
#define PG8_STAGE(bufoff, gbase, voff) do { _Pragma("unroll") for (int _i = 0; _i < 2; ++_i) \
        __builtin_amdgcn_global_load_lds((const unsigned*)((const char*)(gbase) + (voff)[_i]), (PG8_LAS unsigned*)(lds + (bufoff) + ldsw + _i * 8192), 16, 0, 0); } while (0)
#define PG8_LDA(dst, b, h) do { _Pragma("unroll") for (int m = 0; m < 4; ++m) _Pragma("unroll") for (int k = 0; k < 2; ++k) dst[m][k] = *(const PG8_LAS bf16x8*)(lds + PG8_SA(b, h) + aoff + m * 2048 + k * 1024); } while (0)
#define PG8_LDB(dst, b, h) do { _Pragma("unroll") for (int n = 0; n < 2; ++n) _Pragma("unroll") for (int k = 0; k < 2; ++k) dst[n][k] = *(const PG8_LAS bf16x8*)(lds + PG8_SB(b, h) + boff + n * 2048 + k * 1024); } while (0)
#define PG8_MMA(ai, bj, At, Bt) do { __builtin_amdgcn_s_setprio(1); _Pragma("unroll") for (int m = 0; m < 4; ++m) _Pragma("unroll") for (int n = 0; n < 2; ++n) _Pragma("unroll") for (int k = 0; k < 2; ++k) \
        acc[ai][bj][m][n] = __builtin_amdgcn_mfma_f32_16x16x32_bf16(Bt[n][k], At[m][k], acc[ai][bj][m][n], 0, 0, 0); __builtin_amdgcn_s_setprio(0); } while (0)
#define PG8_WAIT_V(n) asm volatile("s_waitcnt vmcnt(" #n ")" ::: "memory")
#define PG8_WAIT_L(n) asm volatile("s_waitcnt lgkmcnt(" #n ")" ::: "memory")
#define PG8_BAR __builtin_amdgcn_s_barrier()
#define PG8_SCHED __builtin_amdgcn_sched_barrier(0)
    Unit cur, nxt; int ui = 0;
    if (!S.next(0, cur)) return;
    f32x4 acc[2][2][4][2];
#pragma unroll
    for (int a = 0; a < 2; ++a)
#pragma unroll
        for (int b = 0; b < 2; ++b)
#pragma unroll
            for (int m = 0; m < 4; ++m)
#pragma unroll
                for (int n = 0; n < 2; ++n) acc[a][b][m][n] = (f32x4){0.f, 0.f, 0.f, 0.f};
    bf16x8 At[4][2], B0[2][2], B1[2][2];
    const char* cA = (const char*)g.A + (size_t)cur.pm * tstep; const char* cB = (const char*)g.Bt + (size_t)cur.pn * tstep;
    S.a_ready(cur);
    if constexpr (SP2) {
        PG8_STAGE(PG8_SB(0, 0), cB, voffB); PG8_STAGE(PG8_SB(0, 1), cB + hstep, voffB); PG8_STAGE(PG8_SA(0, 0), cA, voffA); PG8_STAGE(PG8_SA(0, 1), cA + hstep, voffA);
        if (wr == 1) PG8_BAR;
        PG8_WAIT_V(2); PG8_BAR;
        PG8_STAGE(PG8_SB(1, 0), cB + kstep, voffB); PG8_STAGE(PG8_SA(1, 0), cA + kstep, voffA); PG8_STAGE(PG8_SB(1, 1), cB + hstep + kstep, voffB);
        PG8_WAIT_V(6); PG8_BAR;
    } else {
        PG8_STAGE(PG8_SB(0, 0), cB, voffB); PG8_STAGE(PG8_SA(0, 0), cA, voffA); PG8_STAGE(PG8_SB(0, 1), cB + hstep, voffB); PG8_STAGE(PG8_SA(0, 1), cA + hstep, voffA);
        if (wr == 1) PG8_BAR;
        PG8_WAIT_V(4); PG8_BAR;
        PG8_STAGE(PG8_SB(1, 0), cB + kstep, voffB); PG8_STAGE(PG8_SA(1, 0), cA + kstep, voffA); PG8_STAGE(PG8_SB(1, 1), cB + hstep + kstep, voffB);
        PG8_WAIT_V(6); PG8_BAR;
    }
    for (;;) {
        const bool has_next = S.next(ui + 1, nxt);
        const char* nA = has_next ? (const char*)g.A + (size_t)nxt.pm * tstep : cA; const char* nB = has_next ? (const char*)g.Bt + (size_t)nxt.pn * tstep : cB;
        for (int t = 0; t < nt; t += 2) {
            const bool last = (t == nt - 2);
            const char* a1 = cA + (size_t)(t + 1) * kstep;
            const char* a2 = last ? nA : cA + (size_t)(t + 2) * kstep; const char* b2 = last ? nB : cB + (size_t)(t + 2) * kstep;
            const char* a3 = a2 + kstep; const char* b3 = b2 + kstep;
            if (last && has_next) S.a_ready(nxt);
            if constexpr (SP2) {
            PG8_LDB(B0, 0, 0); PG8_LDB(B1, 0, 1); PG8_SCHED; PG8_LDA(At, 0, 0); PG8_STAGE(PG8_SA(1, 1), a1 + hstep, voffA);
            PG8_WAIT_V(8); PG8_WAIT_L(0); PG8_BAR; PG8_MMA(0, 0, At, B0); PG8_MMA(0, 1, At, B1); PG8_BAR; PG8_SCHED;
            PG8_LDA(At, 0, 1); PG8_STAGE(PG8_SB(0, 0), b2, voffB); PG8_STAGE(PG8_SB(0, 1), b2 + hstep, voffB); PG8_STAGE(PG8_SA(0, 0), a2, voffA);
            PG8_WAIT_V(8); PG8_WAIT_L(0); PG8_BAR; PG8_MMA(1, 0, At, B0); PG8_MMA(1, 1, At, B1); PG8_BAR; PG8_SCHED;
            PG8_LDB(B0, 1, 0); PG8_LDB(B1, 1, 1); PG8_SCHED; PG8_LDA(At, 1, 0); PG8_STAGE(PG8_SA(0, 1), a2 + hstep, voffA);
            PG8_WAIT_V(8); PG8_WAIT_L(0); PG8_BAR; PG8_MMA(0, 0, At, B0); PG8_MMA(0, 1, At, B1); PG8_BAR; PG8_SCHED;
            PG8_LDA(At, 1, 1); PG8_STAGE(PG8_SB(1, 0), b3, voffB); PG8_STAGE(PG8_SB(1, 1), b3 + hstep, voffB); PG8_STAGE(PG8_SA(1, 0), a3, voffA);
            PG8_WAIT_V(8); PG8_WAIT_L(0); PG8_BAR; PG8_MMA(1, 0, At, B0); PG8_MMA(1, 1, At, B1); PG8_BAR; PG8_SCHED;
            } else {
            PG8_LDB(B0, 0, 0); PG8_SCHED; PG8_LDA(At, 0, 0); PG8_STAGE(PG8_SA(1, 1), a1 + hstep, voffA);
            PG8_WAIT_L(8); PG8_BAR; PG8_WAIT_L(0); PG8_MMA(0, 0, At, B0); PG8_BAR; PG8_SCHED;
            PG8_LDB(B1, 0, 1); PG8_STAGE(PG8_SB(0, 0), b2, voffB);
            PG8_BAR; PG8_WAIT_L(0); PG8_MMA(0, 1, At, B1); PG8_BAR;
            PG8_LDA(At, 0, 1); PG8_STAGE(PG8_SA(0, 0), a2, voffA);
            PG8_BAR; PG8_WAIT_L(0); PG8_MMA(1, 0, At, B0); PG8_BAR; PG8_SCHED;
            PG8_STAGE(PG8_SB(0, 1), b2 + hstep, voffB);
            PG8_WAIT_V(6); PG8_BAR; PG8_MMA(1, 1, At, B1); PG8_BAR;
            PG8_LDB(B0, 1, 0); PG8_SCHED; PG8_LDA(At, 1, 0); PG8_STAGE(PG8_SA(0, 1), a2 + hstep, voffA);
            PG8_WAIT_L(8); PG8_BAR; PG8_WAIT_L(0); PG8_MMA(0, 0, At, B0); PG8_BAR; PG8_SCHED;
            PG8_LDB(B1, 1, 1); PG8_STAGE(PG8_SB(1, 0), b3, voffB);
            PG8_BAR; PG8_WAIT_L(0); PG8_MMA(0, 1, At, B1); PG8_BAR;
            PG8_LDA(At, 1, 1); PG8_STAGE(PG8_SA(1, 0), a3, voffA);
            PG8_BAR; PG8_WAIT_L(0); PG8_MMA(1, 0, At, B0); PG8_BAR; PG8_SCHED;
            PG8_STAGE(PG8_SB(1, 1), b3 + hstep, voffB);
            PG8_WAIT_V(6); PG8_BAR; PG8_MMA(1, 1, At, B1); PG8_BAR;
            }
        }
        if constexpr (ALIGN_EPI) { if (wr == 0) PG8_BAR; }
        if constexpr (!Epi::AFTER_DRAIN) { E(acc, cur, wr, wc, fr, fq); S.done(cur); }
        if (!has_next) break;
#pragma unroll
        for (int a = 0; a < 2; ++a)
#pragma unroll
            for (int b = 0; b < 2; ++b)
#pragma unroll
                for (int m = 0; m < 4; ++m)
#pragma unroll
                    for (int n = 0; n < 2; ++n) acc[a][b][m][n] = (f32x4){0.f, 0.f, 0.f, 0.f};
        cur = nxt; cA = nA; cB = nB; ++ui;
        if constexpr (ALIGN_EPI) { if (wr == 1) PG8_BAR; }
    }
    PG8_WAIT_V(0);
    if constexpr (!ALIGN_EPI) { if (wr == 0) PG8_BAR; }
    PG8_BAR;
    if constexpr (Epi::AFTER_DRAIN) { E.fused(acc, cur, wr, wc, fr, fq, lds, wid, lane); S.done(cur); }
#undef PG8_SA
#undef PG8_SB
#undef PG8_STAGE
#undef PG8_LDA
#undef PG8_LDB
#undef PG8_MMA
#undef PG8_WAIT_V
#undef PG8_WAIT_L
#undef PG8_BAR
#undef PG8_SCHED
}
}
#define GAS __attribute__((address_space(1)))
#define LAS __attribute__((address_space(3)))
typedef unsigned short bf16;
typedef unsigned v4u __attribute__((ext_vector_type(4)));
typedef float f32x4 __attribute__((ext_vector_type(4)));
typedef short bf16x8 __attribute__((ext_vector_type(8)));
typedef GAS unsigned gu32;
typedef GAS unsigned long long gu64;
#define RLX_AGENT __ATOMIC_RELAXED, __HIP_MEMORY_SCOPE_AGENT
#define LDS_WAIT() asm volatile("s_waitcnt lgkmcnt(0)" ::: "memory")
#define VM_WAIT() asm volatile("s_waitcnt vmcnt(0)" ::: "memory")
__device__ __forceinline__ unsigned long long rt() { return __builtin_amdgcn_s_memrealtime(); }
__device__ __forceinline__ unsigned f2bf(float f) { unsigned u = __builtin_bit_cast(unsigned, f); return (u + 0x7fffu + ((u >> 16) & 1u)) >> 16; }
__device__ __forceinline__ unsigned pk2(float lo, float hi) { return f2bf(lo) | (f2bf(hi) << 16); }
#define XB_TMO      128
#define XB_XCNT(j)  (256  + 64 * (j))
#define XB_XSUB(j)  (1280 + 64 * (j))
#define XB_XGEN(j)  (2304 + 64 * (j))
#define XB_TOP      3328
#define XB_TOPGEN   3392
#define XCD_BAR_WORDS 3456
#define XB_SPIN_CAP (1u << 18)

__device__ __forceinline__ unsigned xb_ld(unsigned* p)              { return __hip_atomic_load(p, __ATOMIC_RELAXED, __HIP_MEMORY_SCOPE_AGENT); }
__device__ __forceinline__ unsigned xb_add(unsigned* p, unsigned v) { return __hip_atomic_fetch_add(p, v, __ATOMIC_RELAXED, __HIP_MEMORY_SCOPE_AGENT); }
__device__ __forceinline__ unsigned xb_xcc_id() { return (unsigned)__builtin_amdgcn_s_getreg((3 << 11) | 20) & 0xFu; }
#define XB_SPIN(cond, bar) do { unsigned _sp = 0; while (cond) { __builtin_amdgcn_s_sleep(1); \
    if ((++_sp & 255u) == 0u) { if (xb_ld(&(bar)[XB_TMO])) break; if (_sp > XB_SPIN_CAP) { atomicAdd(&(bar)[XB_TMO], 1u); break; } } } } while (0)

struct XcdBarrier {
    unsigned* bar; unsigned x;
    volatile LAS unsigned* st;
};

__device__ __forceinline__ XcdBarrier xcd_barrier_post(unsigned* bar, volatile LAS unsigned* st) {
    XcdBarrier b; b.bar = bar; b.x = xb_xcc_id(); b.st = st;
    if (threadIdx.x == 0) (void)xb_add(&bar[XB_XCNT(b.x)], 1u);
    return b;
}
__device__ __forceinline__ void xcd_barrier_complete(unsigned* bar, unsigned x, unsigned& nloc, unsigned& nx) {
    const unsigned G = gridDim.x * gridDim.y * gridDim.z;
    unsigned sum, cnt, mine, sp = 0u;
    for (;;) {
        sum = 0u; cnt = 0u; mine = 0u;
#pragma unroll
        for (unsigned j = 0; j < 16; ++j) { const unsigned c = xb_ld(&bar[XB_XCNT(j)]); sum += c; cnt += (c > 0u) ? 1u : 0u; mine = (j == x) ? c : mine; }
        if (sum == G) break;
        __builtin_amdgcn_s_sleep(1);
        if ((++sp & 255u) == 0u) { if (xb_ld(&bar[XB_TMO])) break; if (sp > XB_SPIN_CAP) { atomicAdd(&bar[XB_TMO], 1u); break; } }
    }
    nloc = mine > 0u ? mine : 1u; nx = cnt > 0u ? cnt : 1u;
}

__device__ __forceinline__ void xcd_barrier(const XcdBarrier& b) {
    asm volatile("s_waitcnt vmcnt(0)" ::: "memory");
    __syncthreads();
    if (threadIdx.x == 0) {
        unsigned* bar = b.bar;
        __builtin_amdgcn_s_waitcnt(0);
        unsigned nloc = b.st[0], nx = b.st[1];
        if (nloc == 0u) { xcd_barrier_complete(bar, b.x, nloc, nx); b.st[0] = nloc; b.st[1] = nx; }
        const unsigned old = xb_add(&bar[XB_XSUB(b.x)], 1u);
        const unsigned gen = old / nloc;
        if (old + 1u == (gen + 1u) * nloc) {
            __builtin_amdgcn_fence(__ATOMIC_RELEASE, "agent");
            asm volatile("s_waitcnt vmcnt(0)" ::: "memory");
            const unsigned og = xb_add(&bar[XB_TOP], 1u);
            const unsigned tg = og / nx;
            if (og + 1u == (tg + 1u) * nx) xb_add(&bar[XB_TOPGEN], 1u);
            else XB_SPIN(xb_ld(&bar[XB_TOPGEN]) == tg, bar);
            __builtin_amdgcn_fence(__ATOMIC_ACQUIRE, "agent");
            xb_add(&bar[XB_XGEN(b.x)], 1u);
            asm volatile("s_waitcnt vmcnt(0)" ::: "memory");
        } else {
            XB_SPIN(xb_ld(&bar[XB_XGEN(b.x)]) == gen, bar);
            __builtin_amdgcn_fence(__ATOMIC_ACQUIRE, "agent");
            asm volatile("s_waitcnt vmcnt(0)" ::: "memory");
        }
    }
    __syncthreads();
}

constexpr int D = 1024, SEQ = 8192, NB = 2, MP = NB * SEQ, SB = 128, ST = 8, MS = SB * ST, M = MP + MS;
constexpr int NQKV = 1536, FF = 4096, NKV = 4, HD = 64, KVW = NKV * HD, NG = 64, GC = 16, NS = 64;
constexpr int CH = 256, NCH = SEQ / CH;
constexpr int NPHASE = 22;
constexpr size_t O_KP = 17825792, O_VP = 17956864, O_HRP = 18087936, O_HIP = 18104320, O_KS = 18120704, O_VS = 26509312, O_HRS = 34897920, O_HIS = 35946496, O_END = 36995072;
constexpr size_t MiB = 1u << 20;
constexpr size_t WS_CTL = 0, CTL_ZERO_BYTES = 64 * 1024;
constexpr size_t WS_SSP = 1 * MiB;
constexpr size_t WS_HS = 4 * MiB;
constexpr size_t WS_WQKV = 8 * MiB, WS_WO = 14 * MiB, WS_WGLU = 18 * MiB, WS_WUP = 26 * MiB, WS_WDN = 58 * MiB;
constexpr size_t WS_XB = 90 * MiB;
constexpr size_t WS_H = 124 * MiB;
constexpr size_t WS_Q = 124 * MiB, WS_K = 158 * MiB, WS_V = 167 * MiB, WS_O = 176 * MiB;
constexpr size_t WS_END = 260 * MiB;
constexpr int CW_BAR = 4096;
static_assert((CW_BAR + XCD_BAR_WORDS) * 4 <= (int)CTL_ZERO_BYTES, "barrier words inside the memset region");
constexpr int RING_BYTES = 131072, LDSCTL_OFF = RING_BYTES, MISC_OFF = LDSCTL_OFF + 320, LDS_BYTES = 147456;

__device__ __forceinline__ float wave_sum(float v) {
#pragma unroll
    for (int o = 1; o < 64; o <<= 1) v += __shfl_xor(v, o);
    return v;
}
__device__ __forceinline__ float wave_max(float v) {
#pragma unroll
    for (int o = 1; o < 64; o <<= 1) v = fmaxf(v, __shfl_xor(v, o));
    return v;
}
__device__ __forceinline__ float bf_lo(unsigned u) { return __uint_as_float(u << 16); }
__device__ __forceinline__ float bf_hi(unsigned u) { return __uint_as_float(u & 0xffff0000u); }

namespace pg8 {
__device__ __forceinline__ float row_rinv(const float* ssp, int row, int np, int fq) {
    const float* p = ssp + (size_t)row * 32;
    const f32x4 v = *(const f32x4*)(p + 4 * fq); float s = (v[0] + v[1]) + (v[2] + v[3]);
    if (np == 32) { const f32x4 w = *(const f32x4*)(p + 16 + 4 * fq); s += (w[0] + w[1]) + (w[2] + w[3]); }
    s += __shfl_xor(s, 16); s += __shfl_xor(s, 32);
    return rsqrtf(s * (1.0f / 1024.0f) + 1e-6f);
}
__device__ __forceinline__ u32x4 pack8(const f32x4 a, const f32x4 b) { u32x4 w; w.x = cvt_pk_bf16(a[0], a[1]); w.y = cvt_pk_bf16(a[2], a[3]); w.z = cvt_pk_bf16(b[0], b[1]); w.w = cvt_pk_bf16(b[2], b[3]); return w; }

struct EpiQKV {
    static constexpr bool PERM = true, AFTER_DRAIN = false;
    bf16_t *Q, *K, *V; const float* ssp; int np; float *kp, *vp, *ks, *vs;
    __device__ __forceinline__ void operator()(const f32x4 (&acc)[2][2][4][2], const Unit& u, int wr, int wc, int fr, int fq) const {
        const int rowb = u.pm * BM + wr * 64 + fr, pn = u.pn;
#pragma unroll
        for (int ai = 0; ai < 2; ++ai)
#pragma unroll
            for (int m = 0; m < 4; ++m) {
                const int row = rowb + ai * HALF + m * 16;
                const float r = row_rinv(ssp, row, np, fq);
#pragma unroll
                for (int bj = 0; bj < 2; ++bj) {
                    const f32x4 v0 = acc[ai][bj][m][0] * r, v1 = acc[ai][bj][m][1] * r;
                    const int cl = bj * HALF + wc * 32 + 8 * fq;
                    const u32x4 w = pack8(v0, v1);
                    if (pn < 4) { *(u32x4*)(Q + (size_t)row * 1024 + pn * 256 + cl) = w; }
                    else {
                        bf16_t* B = (pn == 4) ? K : V;
                        *(u32x4*)(B + (size_t)row * 256 + cl) = w;
                        float* o = nullptr;
                        if (row >= 16384) { const int rs = row - 16384; o = ((pn == 4) ? ks : vs) + ((size_t)(rs >> 3) * 128 + 120 + (rs & 7)) * 256 + cl; }
                        else { const int t = row & 8191; if (t >= 8064) o = ((pn == 4) ? kp : vp) + ((size_t)(row >> 13) * 128 + (t - 8064)) * 256 + cl; }
                        if (o) { *(f32x4*)o = v0; *(f32x4*)(o + 4) = v1; }
                    }
                }
            }
    }
};
struct EpiRes {
    static constexpr bool PERM = true, AFTER_DRAIN = false;
    const float* xp; const float* xs; float* XR; bf16_t* XB; float* ssp;
    __device__ __forceinline__ void operator()(const f32x4 (&acc)[2][2][4][2], const Unit& u, int wr, int wc, int fr, int fq) const {
        const int rowb = u.pm * BM + wr * 64 + fr, pn = u.pn;
#pragma unroll
        for (int ai = 0; ai < 2; ++ai)
#pragma unroll
            for (int m = 0; m < 4; ++m) {
                const int row = rowb + ai * HALF + m * 16;
                const float* old = (row < 16384) ? xp + (size_t)row * 1024 : xs + (size_t)(row - 16384) * 1024;
                float ss = 0.f;
#pragma unroll
                for (int bj = 0; bj < 2; ++bj) {
                    const int col = pn * 256 + bj * HALF + wc * 32 + 8 * fq;
                    const f32x4 o0 = *(const f32x4*)(old + col), o1 = *(const f32x4*)(old + col + 4);
                    const f32x4 v0 = acc[ai][bj][m][0] + o0, v1 = acc[ai][bj][m][1] + o1;
                    *(f32x4*)(XR + (size_t)row * 1024 + col) = v0; *(f32x4*)(XR + (size_t)row * 1024 + col + 4) = v1;
                    *(u32x4*)(XB + (size_t)row * 1024 + col) = pack8(v0, v1);
                    ss += (v0[0] * v0[0] + v0[1] * v0[1]) + (v0[2] * v0[2] + v0[3] * v0[3]) + (v1[0] * v1[0] + v1[1] * v1[1]) + (v1[2] * v1[2] + v1[3] * v1[3]);
                }
                ss += __shfl_xor(ss, 16); ss += __shfl_xor(ss, 32);
                if (fq == 0) ssp[(size_t)row * 32 + pn * 4 + wc] = ss;
            }
    }
};
struct EpiGlu {
    static constexpr bool PERM = true, AFTER_DRAIN = false;
    float* XR; bf16_t* XB; float* ssp;
    __device__ __forceinline__ void operator()(const f32x4 (&acc)[2][2][4][2], const Unit& u, int wr, int wc, int fr, int fq) const {
        const int rowb = u.pm * BM + wr * 64 + fr, pn = u.pn;
#pragma unroll
        for (int ai = 0; ai < 2; ++ai)
#pragma unroll
            for (int m = 0; m < 4; ++m) {
                const int row = rowb + ai * HALF + m * 16;
                const int col = pn * 128 + wc * 32 + 8 * fq;
                float* xr = XR + (size_t)row * 1024 + col;
                const f32x4 o0 = *(const f32x4*)xr, o1 = *(const f32x4*)(xr + 4);
                f32x4 v0, v1;
#pragma unroll
                for (int e = 0; e < 4; ++e) {
                    v0[e] = o0[e] + acc[ai][0][m][0][e] * (1.0f / (1.0f + __expf(-acc[ai][1][m][0][e])));
                    v1[e] = o1[e] + acc[ai][0][m][1][e] * (1.0f / (1.0f + __expf(-acc[ai][1][m][1][e])));
                }
                *(f32x4*)xr = v0; *(f32x4*)(xr + 4) = v1;
                *(u32x4*)(XB + (size_t)row * 1024 + col) = pack8(v0, v1);
                float ss = (v0[0] * v0[0] + v0[1] * v0[1]) + (v0[2] * v0[2] + v0[3] * v0[3]) + (v1[0] * v1[0] + v1[1] * v1[1]) + (v1[2] * v1[2] + v1[3] * v1[3]);
                ss += __shfl_xor(ss, 16); ss += __shfl_xor(ss, 32);
                if (fq == 0) ssp[(size_t)row * 32 + pn * 4 + wc] = ss;
            }
    }
};
struct EpiUp {
    static constexpr bool PERM = true, AFTER_DRAIN = false;
    bf16_t* H; const float* ssp; int np;
    __device__ __forceinline__ void operator()(const f32x4 (&acc)[2][2][4][2], const Unit& u, int wr, int wc, int fr, int fq) const {
        const int rowb = u.pm * BM + wr * 64 + fr, pn = u.pn;
#pragma unroll
        for (int ai = 0; ai < 2; ++ai)
#pragma unroll
            for (int m = 0; m < 4; ++m) {
                const int row = rowb + ai * HALF + m * 16;
                const float r = row_rinv(ssp, row, np, fq);
#pragma unroll
                for (int bj = 0; bj < 2; ++bj) {
                    f32x4 v0 = acc[ai][bj][m][0] * r, v1 = acc[ai][bj][m][1] * r;
#pragma unroll
                    for (int e = 0; e < 4; ++e) { const float a = fmaxf(v0[e], 0.f), b = fmaxf(v1[e], 0.f); v0[e] = a * a; v1[e] = b * b; }
                    *(u32x4*)(H + (size_t)row * 4096 + pn * 256 + bj * HALF + wc * 32 + 8 * fq) = pack8(v0, v1);
                }
            }
    }
};
}

__device__ __forceinline__ void p0_transpose_item(const float* W, int K, int N, const float* gain, bf16* WT, int glu, LAS float* scr, int item, int lane) {
    const int nblk = N / 32, kb = item / nblk, nb = item % nblk, k0 = 64 * kb, n0 = 32 * nb;
#pragma unroll 8
    for (int i = 0; i < 32; ++i) { const int kk = 2 * i + (lane >> 5); float w = W[(size_t)(k0 + kk) * N + n0 + (lane & 31)]; if (gain) w *= gain[k0 + kk]; scr[kk * 33 + (lane & 31)] = w; }
    LDS_WAIT(); asm volatile("" ::: "memory");
    int drow0 = n0; if (glu) { const int bj = n0 / 1024, rem = n0 % 1024; drow0 = (rem / 128) * 256 + bj * 128 + (rem % 128); }
    const int c = lane & 7;
#pragma unroll
    for (int j = 0; j < 4; ++j) { const int n = (lane >> 3) + 8 * j; const LAS float* s = scr + (8 * c) * 33 + n;
        v4u o; o.x = pk2(s[0 * 33], s[1 * 33]); o.y = pk2(s[2 * 33], s[3 * 33]); o.z = pk2(s[4 * 33], s[5 * 33]); o.w = pk2(s[6 * 33], s[7 * 33]);
        *(GAS v4u*)(WT + (size_t)(drow0 + n) * K + k0 + 8 * c) = o; }
    LDS_WAIT(); asm volatile("" ::: "memory");
}

__device__ __forceinline__ void sincos_rr(float x, float& s, float& c) {
    const float q = rintf(x * 0.63661977236758f);
    float r = fmaf(-q, 1.57079637050629f, x); r = fmaf(-q, -4.37113882867379e-8f, r);
    const float r2 = r * r;
    const float sp = r + r * r2 * (-1.6666667163e-1f + r2 * (8.3333337680e-3f + r2 * (-1.9841270114e-4f + r2 * 2.7557314297e-6f)));
    const float cp = 1.0f + r2 * (-0.5f + r2 * (4.1666667908e-2f + r2 * (-1.3888889225e-3f + r2 * (2.4801587642e-5f + r2 * -2.7557314297e-7f))));
    const int qi = (int)q & 3;
    s = (qi == 0) ? sp : (qi == 1) ? cp : (qi == 2) ? -sp : -cp;
    c = (qi == 0) ? cp : (qi == 1) ? -sp : (qi == 2) ? -cp : sp;
}

struct SsmC { const float *A_re, *A_im, *log_dt, *B_re, *B_im, *C_re, *C_im, *Dk, *gain; };
__device__ __forceinline__ void ssm_abar(const SsmC& c, int g, int n, float& abr, float& abi, float& cfr, float& cfi) {
    const float dt = expf(c.log_dt[g]);
    const float ar = c.A_re[g * 64 + n], ai = c.A_im[g * 64 + n];
    const float mag = expf(dt * ar); float sn, cs; sincos_rr(dt * ai, sn, cs);
    abr = mag * cs; abi = mag * sn;
    const float den = ar * ar + ai * ai, nr = abr - 1.0f;
    cfr = (nr * ar + abi * ai) / den; cfi = (abi * ar - nr * ai) / den;
}
__device__ __forceinline__ float gelu_tanh(float y) {
    const float z = 0.7978845608028654f * (y + 0.044715f * y * y * y);
    return y / (1.0f + __expf(-2.0f * z));
}
template <bool FULL>
__device__ __forceinline__ void ssm_unit(LAS float* xs, LAS float* hb, int lane, int g, const SsmC& c, const float* XR, const float* ssp, int row0, int L, float& hr, float& hi, bf16* Gout) {
    float abr, abi, cfr, cfi; ssm_abar(c, g, lane, abr, abi, cfr, cfi);
    float Br[16], Bi[16];
#pragma unroll
    for (int c4 = 0; c4 < 4; ++c4) {
        const f32x4 br = *(const f32x4*)(c.B_re + ((size_t)g * 64 + lane) * 16 + 4 * c4), bi = *(const f32x4*)(c.B_im + ((size_t)g * 64 + lane) * 16 + 4 * c4), gn = *(const f32x4*)(c.gain + g * 16 + 4 * c4);
#pragma unroll
        for (int e = 0; e < 4; ++e) { Br[4 * c4 + e] = (cfr * br[e] - cfi * bi[e]) * gn[e]; Bi[4 * c4 + e] = (cfr * bi[e] + cfi * br[e]) * gn[e]; }
    }
    const int cc = lane & 15, q = lane >> 4;
    float Cq[32]; float Dg = 0.f;
    if (FULL) {
        const float* src = ((q < 2) ? c.C_re : c.C_im) + ((size_t)g * 16 + cc) * 64 + 32 * (q & 1); const float sg = (q < 2) ? 1.0f : -1.0f;
#pragma unroll
        for (int i4 = 0; i4 < 8; ++i4) { const f32x4 v = *(const f32x4*)(src + 4 * i4);
#pragma unroll
            for (int e = 0; e < 4; ++e) Cq[4 * i4 + e] = sg * v[e]; }
        Dg = c.Dk[g * 16 + cc] * c.gain[g * 16 + cc];
    }
    for (int t0 = 0; t0 < L; t0 += 64) {
        const int cnt = (L - t0) < 64 ? (L - t0) : 64;
        if (lane < cnt) {
            const int row = row0 + t0 + lane;
            const float* sp = ssp + (size_t)row * 32;
            const f32x4 s0 = *(const f32x4*)sp, s1 = *(const f32x4*)(sp + 4), s2 = *(const f32x4*)(sp + 8), s3 = *(const f32x4*)(sp + 12);
            const float ss = ((s0[0] + s0[1]) + (s0[2] + s0[3])) + ((s1[0] + s1[1]) + (s1[2] + s1[3])) + ((s2[0] + s2[1]) + (s2[2] + s2[3])) + ((s3[0] + s3[1]) + (s3[2] + s3[3]));
            const float rinv = rsqrtf(ss * (1.0f / 1024.0f) + 1e-6f);
            const float* xr = XR + (size_t)row * 1024 + g * 16;
#pragma unroll
            for (int c4 = 0; c4 < 4; ++c4) { const f32x4 v = *(const f32x4*)(xr + 4 * c4); *(LAS f32x4*)(xs + lane * 16 + 4 * c4) = v * rinv; }
        }
        LDS_WAIT(); asm volatile("" ::: "memory");
        float ykeep = 0.f;
        for (int tt = 0; tt < cnt; ++tt) {
            float inr = 0.f, ini = 0.f;
#pragma unroll
            for (int c4 = 0; c4 < 4; ++c4) { const f32x4 xv = *(const LAS f32x4*)(xs + tt * 16 + 4 * c4);
#pragma unroll
                for (int e = 0; e < 4; ++e) { inr = fmaf(xv[e], Br[4 * c4 + e], inr); ini = fmaf(xv[e], Bi[4 * c4 + e], ini); } }
            const float nhr = abr * hr - abi * hi + inr, nhi = abr * hi + abi * hr + ini; hr = nhr; hi = nhi;
            if (FULL) {
                hb[lane] = hr; hb[64 + lane] = hi;
                LDS_WAIT(); asm volatile("" ::: "memory");
                float part = 0.f;
#pragma unroll
                for (int i4 = 0; i4 < 8; ++i4) { const f32x4 hv = *(const LAS f32x4*)(hb + 32 * q + 4 * i4);
#pragma unroll
                    for (int e = 0; e < 4; ++e) part = fmaf(hv[e], Cq[4 * i4 + e], part); }
                part += __shfl_xor(part, 16); part += __shfl_xor(part, 32);
                const float y = part + Dg * xs[tt * 16 + cc];
                if ((tt & 3) == q) ykeep = y;
                if ((tt & 3) == 3) Gout[(size_t)(row0 + t0 + (tt & ~3) + q) * 1024 + g * 16 + cc] = (bf16)f2bf(gelu_tanh(ykeep));
                asm volatile("" ::: "memory");
            }
        }
        LDS_WAIT(); asm volatile("" ::: "memory");
    }
}

#ifndef EN_P0
#define EN_P0 1
#endif
#ifndef EN_QKV
#define EN_QKV 1
#endif
#ifndef EN_ATT
#define EN_ATT 1
#endif
#ifndef EN_OPJ
#define EN_OPJ 1
#endif
#ifndef EN_S1
#define EN_S1 1
#endif
#ifndef EN_S3
#define EN_S3 1
#endif
#ifndef EN_GLU
#define EN_GLU 1
#endif
#ifndef EN_UP
#define EN_UP 1
#endif
#ifndef EN_DN
#define EN_DN 1
#endif
#ifndef EN_FIN
#define EN_FIN 1
#endif
struct Args { const float* in[23]; float* out; unsigned char* ws; int ph_lo, ph_hi; };

__global__ void __launch_bounds__(512, 2) fwd_kernel(Args args) {
    extern __shared__ __attribute__((aligned(16))) unsigned char lds[];
    LAS unsigned char* const L = (LAS unsigned char*)lds;
#define FRESH_IDS int tid = threadIdx.x; asm volatile("" : "+v"(tid)); const int lane = tid & 63, wave = __builtin_amdgcn_readfirstlane(tid >> 6); const int gw = vcu * 8 + wave; (void)lane; (void)gw
    const int G = gridDim.x, bx = blockIdx.x;
    const int vcu = (G % 8 == 0) ? (bx % 8) * (G / 8) + bx / 8 : bx;
    const int NGW = G * 8;
    for (int u = threadIdx.x; u < (LDS_BYTES - LDSCTL_OFF) / 4; u += 512) ((LAS unsigned*)(L + LDSCTL_OFF))[u] = 0u;
    __syncthreads();
    const int lo = args.ph_lo, hi = args.ph_hi;
    const bool multi = (hi - lo) > 1;
    unsigned char* const ws = args.ws;
    float* const out = args.out;
    XcdBarrier bar; bar.bar = (unsigned*)(ws + WS_CTL) + CW_BAR; bar.x = 0; bar.st = nullptr;
    if (multi) bar = xcd_barrier_post((unsigned*)(ws + WS_CTL) + CW_BAR, (volatile LAS unsigned*)(L + MISC_OFF) + 8);
#define IN(k) (lo <= (k) && (k) < hi)
#define SEAM(k) do { if (IN(k) && IN((k) + 1)) xcd_barrier(bar); } while (0)

    float* const ssp = (float*)(ws + WS_SSP);
    float* const HS = (float*)(ws + WS_HS);
    bf16* const XB = (bf16*)(ws + WS_XB);
    bf16* const Hb = (bf16*)(ws + WS_H);
    bf16* const Qb = (bf16*)(ws + WS_Q); bf16* const Kb = (bf16*)(ws + WS_K); bf16* const Vb = (bf16*)(ws + WS_V); bf16* const Ob = (bf16*)(ws + WS_O);
    const float* const x_p = args.in[0]; const float* const x_s = args.in[1];

    if (EN_P0 && IN(0)) {
        FRESH_IDS;
        LAS float* scr = (LAS float*)(L + wave * 16384);
        constexpr int I_QKV = 16 * 48, I_O = 16 * 32, I_GLU = 16 * 64, I_UP = 16 * 128, I_DN = 64 * 32;
        constexpr int NITEMS = 2 * I_QKV + 2 * I_O + 2 * I_GLU + 4 * I_UP + 4 * I_DN;
        for (int it = gw; it < NITEMS; it += NGW) {
            int r = it;
            if (r < 2 * I_QKV) { const int j = r / I_QKV; r -= j * I_QKV; p0_transpose_item(args.in[9] + (size_t)j * D * NQKV, D, NQKV, args.in[6] + (size_t)(2 * j) * D, (bf16*)(ws + WS_WQKV) + (size_t)j * NQKV * D, 0, scr, r, lane); continue; } r -= 2 * I_QKV;
            if (r < 2 * I_O) { const int j = r / I_O; r -= j * I_O; p0_transpose_item(args.in[10] + (size_t)j * D * D, D, D, nullptr, (bf16*)(ws + WS_WO) + (size_t)j * D * D, 0, scr, r, lane); continue; } r -= 2 * I_O;
            if (r < 2 * I_GLU) { const int j = r / I_GLU; r -= j * I_GLU; p0_transpose_item(args.in[20] + (size_t)j * D * 2 * D, D, 2 * D, nullptr, (bf16*)(ws + WS_WGLU) + (size_t)j * 2 * D * D, 1, scr, r, lane); continue; } r -= 2 * I_GLU;
            if (r < 4 * I_UP) { const int l = r / I_UP; r -= l * I_UP; p0_transpose_item(args.in[21] + (size_t)l * D * FF, D, FF, args.in[7] + (size_t)l * D, (bf16*)(ws + WS_WUP) + (size_t)l * FF * D, 0, scr, r, lane); continue; } r -= 4 * I_UP;
            { const int l = r / I_DN; r -= l * I_DN; p0_transpose_item(args.in[22] + (size_t)l * FF * D, FF, D, nullptr, (bf16*)(ws + WS_WDN) + (size_t)l * D * FF, 0, scr, r, lane); }
        }
        for (int m = gw; m < M; m += NGW) {
            const float* xrow = (m < MP) ? x_p + (size_t)m * D : x_s + (size_t)(m - MP) * D;
            const GAS f32x4* xr = (const GAS f32x4*)xrow + lane;
            f32x4 v[4]; float s = 0.f;
#pragma unroll
            for (int j = 0; j < 4; ++j) { v[j] = xr[64 * j]; s += (v[j][0] * v[j][0] + v[j][1] * v[j][1]) + (v[j][2] * v[j][2] + v[j][3] * v[j][3]); }
            s = wave_sum(s);
            GAS unsigned long long* o8 = (GAS unsigned long long*)(XB + (size_t)m * D) + lane;
#pragma unroll
            for (int j = 0; j < 4; ++j) o8[64 * j] = (unsigned long long)pk2(v[j][0], v[j][1]) | ((unsigned long long)pk2(v[j][2], v[j][3]) << 32);
            if (lane < 16) ssp[(size_t)m * 32 + lane] = (lane == 0) ? s : 0.f;
        }
        {
            constexpr int PER = 120 * 256 / 4;
            constexpr int TOT = 2 * 2 * SB * PER;
            for (int i = bx * 512 + tid; i < TOT; i += G * 512) {
                const int kv = i / (2 * SB * PER), rem = i % (2 * SB * PER), jb = rem / PER, e = rem % PER;
                const f32x4 v = *((const f32x4*)(args.in[2 + kv] + (size_t)jb * 128 * 256 + 8 * 256) + e);
                *((f32x4*)(out + (kv ? O_VS : O_KS) + (size_t)jb * 128 * 256) + e) = v;
            }
        }
    }
    SEAM(0);

    for (int l = 0; l < 4; ++l) {
        const int pb = 1 + 5 * l, j = l >> 1;
        if ((l & 1) == 0) {
            if (EN_QKV && IN(pb)) {
                pg8::Gemm g{XB, (const bf16*)(ws + WS_WQKV) + (size_t)j * NQKV * D, M, NQKV, D}; pg8::StaticOrder S; S.init(M, NQKV, G, bx);
                pg8::EpiQKV E{Qb, Kb, Vb, ssp, 16, out + O_KP + (size_t)j * 2 * 128 * 256, out + O_VP + (size_t)j * 2 * 128 * 256, out + O_KS + (size_t)j * SB * 128 * 256, out + O_VS + (size_t)j * SB * 128 * 256};
                pg8::gemm_phase<pg8::EpiQKV, pg8::StaticOrder, true, true>(L, g, S, E);
            }
            SEAM(pb);
            if (EN_ATT && IN(pb + 1)) {
                FRESH_IDS;
                LAS float* qs = (LAS float*)(L + wave * 4096);
                LAS float* ps = qs + 256;
                const float* ck = args.in[2] + (size_t)j * SB * 128 * 256; const float* cv = args.in[3] + (size_t)j * SB * 128 * 256;
                const float* sinks = args.in[11] + j * 16;
                constexpr int NITEMS = (M / 8) * NKV;
                for (int item = vcu; item < NITEMS; item += G) {
                    const int tg = item >> 2, kvh = item & 3, m = tg * 8 + wave;
                    const bool samp = m >= MP;
                    const int b = samp ? ((m - MP) >> 3) : (m >> 13), t = samp ? ((m - MP) & 7) : (m & 8191);
                    { const uint2 qv = *(const uint2*)(Qb + (size_t)m * 1024 + kvh * 256 + 4 * lane);
                      f32x4 qf; qf[0] = bf_lo(qv.x); qf[1] = bf_hi(qv.x); qf[2] = bf_lo(qv.y); qf[3] = bf_hi(qv.y);
                      *(LAS f32x4*)(qs + 4 * lane) = qf; }
                    LDS_WAIT(); asm volatile("" ::: "memory");
                    float sc[4][3];
#pragma unroll
                    for (int p = 0; p < 3; ++p) {
                        const int jj = lane + 64 * p; const int dist = 128 - jj;
                        bool valid = jj <= 128; const bf16* pb_ = nullptr; const float* pf_ = nullptr;
                        if (!samp) { const int s = t - dist; valid = valid && (s >= 0); pb_ = Kb + (size_t)((b << 13) + s) * 256 + kvh * 64; }
                        else { const int jk = t + jj; if (jk < 128) pf_ = ck + ((size_t)b * 128 + jk) * 256 + kvh * 64; else pb_ = Kb + (size_t)(MP + b * 8 + (jk - 128)) * 256 + kvh * 64; }
                        float a0 = 0.f, a1 = 0.f, a2 = 0.f, a3 = 0.f;
                        if (valid) {
#pragma unroll 2
                            for (int i = 0; i < 8; ++i) {
                                float k8[8];
                                if (pf_) { const f32x4 u0 = *(const f32x4*)(pf_ + 8 * i), u1 = *(const f32x4*)(pf_ + 8 * i + 4);
                                    k8[0] = u0[0]; k8[1] = u0[1]; k8[2] = u0[2]; k8[3] = u0[3]; k8[4] = u1[0]; k8[5] = u1[1]; k8[6] = u1[2]; k8[7] = u1[3]; }
                                else { const v4u v = *(const v4u*)(pb_ + 8 * i);
                                    k8[0] = bf_lo(v.x); k8[1] = bf_hi(v.x); k8[2] = bf_lo(v.y); k8[3] = bf_hi(v.y); k8[4] = bf_lo(v.z); k8[5] = bf_hi(v.z); k8[6] = bf_lo(v.w); k8[7] = bf_hi(v.w); }
#define QDOT(acc_, hq_) do { const f32x4 qa = *(const LAS f32x4*)(qs + (hq_) * 64 + 8 * i), qb = *(const LAS f32x4*)(qs + (hq_) * 64 + 8 * i + 4); \
    acc_ = fmaf(qa[0], k8[0], acc_); acc_ = fmaf(qa[1], k8[1], acc_); acc_ = fmaf(qa[2], k8[2], acc_); acc_ = fmaf(qa[3], k8[3], acc_); \
    acc_ = fmaf(qb[0], k8[4], acc_); acc_ = fmaf(qb[1], k8[5], acc_); acc_ = fmaf(qb[2], k8[6], acc_); acc_ = fmaf(qb[3], k8[7], acc_); } while (0)
                                QDOT(a0, 0); QDOT(a1, 1); QDOT(a2, 2); QDOT(a3, 3);
#undef QDOT
                            }
                        }
                        const float fd = (float)dist; const int h0 = kvh * 4;
                        sc[0][p] = valid ? (a0 * 0.125f - exp2f(-0.5f * (float)(h0 + 1)) * fd) : -1e30f;
                        sc[1][p] = valid ? (a1 * 0.125f - exp2f(-0.5f * (float)(h0 + 2)) * fd) : -1e30f;
                        sc[2][p] = valid ? (a2 * 0.125f - exp2f(-0.5f * (float)(h0 + 3)) * fd) : -1e30f;
                        sc[3][p] = valid ? (a3 * 0.125f - exp2f(-0.5f * (float)(h0 + 4)) * fd) : -1e30f;
                    }
#pragma unroll
                    for (int hq = 0; hq < 4; ++hq) {
                        const float sink = sinks[kvh * 4 + hq];
                        const float mx = fmaxf(wave_max(fmaxf(fmaxf(sc[hq][0], sc[hq][1]), sc[hq][2])), sink);
                        const float e0 = __expf(sc[hq][0] - mx), e1 = __expf(sc[hq][1] - mx), e2 = __expf(sc[hq][2] - mx);
                        const float den = wave_sum(e0 + e1 + e2) + __expf(sink - mx);
                        const float inv = 1.0f / den;
                        ps[(lane) * 4 + hq] = e0 * inv; ps[(lane + 64) * 4 + hq] = e1 * inv; if (lane == 0) ps[128 * 4 + hq] = e2 * inv;
                    }
                    LDS_WAIT(); asm volatile("" ::: "memory");
                    float o0 = 0.f, o1 = 0.f, o2 = 0.f, o3 = 0.f;
                    const int jj0 = samp ? 0 : ((t < 128) ? (128 - t) : 0);
                    for (int jj = jj0; jj <= 128; ++jj) {
                        const f32x4 pv = *(const LAS f32x4*)(ps + 4 * jj);
                        float v;
                        if (!samp) v = bf_lo((unsigned)Vb[(size_t)((b << 13) + t - 128 + jj) * 256 + kvh * 64 + lane]);
                        else { const int jk = t + jj; v = (jk < 128) ? cv[((size_t)b * 128 + jk) * 256 + kvh * 64 + lane] : bf_lo((unsigned)Vb[(size_t)(MP + b * 8 + (jk - 128)) * 256 + kvh * 64 + lane]); }
                        o0 = fmaf(pv[0], v, o0); o1 = fmaf(pv[1], v, o1); o2 = fmaf(pv[2], v, o2); o3 = fmaf(pv[3], v, o3);
                    }
                    bf16* orow = Ob + (size_t)m * 1024 + kvh * 256 + lane;
                    orow[0] = (bf16)f2bf(o0); orow[64] = (bf16)f2bf(o1); orow[128] = (bf16)f2bf(o2); orow[192] = (bf16)f2bf(o3);
                    LDS_WAIT(); asm volatile("" ::: "memory");
                }
                __syncthreads();
            }
            SEAM(pb + 1);
            if (EN_OPJ && IN(pb + 2)) {
                pg8::Gemm g{Ob, (const bf16*)(ws + WS_WO) + (size_t)j * D * D, M, D, D}; pg8::StaticOrder S; S.init(M, D, G, bx);
                pg8::EpiRes E{(l == 0) ? x_p : out, (l == 0) ? x_s : out + (size_t)MP * D, out, XB, ssp};
                pg8::gemm_phase<pg8::EpiRes, pg8::StaticOrder, true, true>(L, g, S, E);
            }
            SEAM(pb + 2);
        } else {
            const SsmC sc{args.in[12] + (size_t)j * NG * NS, args.in[13] + (size_t)j * NG * NS, args.in[14] + (size_t)j * NG, args.in[15] + (size_t)j * NG * NS * GC, args.in[16] + (size_t)j * NG * NS * GC,
                          args.in[17] + (size_t)j * NG * GC * NS, args.in[18] + (size_t)j * NG * GC * NS, args.in[19] + (size_t)j * D, args.in[6] + (size_t)l * D};
            if (EN_S1 && IN(pb)) {
                FRESH_IDS; LAS float* xs = (LAS float*)(L + wave * 8192); LAS float* hb = xs + 1024;
                for (int u = gw; u < NB * (NCH - 1) * NG; u += NGW) {
                    const int g = u & 63, ch = (u >> 6) % (NCH - 1), b = (u >> 6) / (NCH - 1);
                    float hr = 0.f, hi_ = 0.f;
                    ssm_unit<false>(xs, hb, lane, g, sc, out, ssp, b * SEQ + ch * CH, CH, hr, hi_, nullptr);
                    *(float2*)(HS + ((size_t)((b * NCH + ch) * NG + g) * NS + lane) * 2) = make_float2(hr, hi_);
                }
                __syncthreads();
            }
            SEAM(pb);
            if (EN_S3 && IN(pb + 1)) {
                FRESH_IDS; LAS float* xs = (LAS float*)(L + wave * 8192); LAS float* hb = xs + 1024;
                for (int u = gw; u < NB * NCH * NG + SB * NG; u += NGW) {
                    if (u < NB * NCH * NG) {
                        const int g = u & 63, ch = (u >> 6) & (NCH - 1), b = u >> 11;
                        float abr, abi, cfr, cfi; ssm_abar(sc, g, lane, abr, abi, cfr, cfi);
                        float aLr = abr, aLi = abi;
#pragma unroll
                        for (int s = 0; s < 8; ++s) { const float tr = aLr * aLr - aLi * aLi, ti = 2.0f * aLr * aLi; aLr = tr; aLi = ti; }
                        float hr = 0.f, hi_ = 0.f;
                        for (int i = 0; i < ch; ++i) { const float2 e = *(const float2*)(HS + ((size_t)((b * NCH + i) * NG + g) * NS + lane) * 2);
                            const float tr = aLr * hr - aLi * hi_ + e.x, ti = aLr * hi_ + aLi * hr + e.y; hr = tr; hi_ = ti; }
                        ssm_unit<true>(xs, hb, lane, g, sc, out, ssp, b * SEQ + ch * CH, CH, hr, hi_, Ob);
                        if (ch == NCH - 1) { out[O_HRP + ((size_t)(j * NB + b) * NG + g) * NS + lane] = hr; out[O_HIP + ((size_t)(j * NB + b) * NG + g) * NS + lane] = hi_; }
                    } else {
                        const int us = u - NB * NCH * NG, g = us & 63, bs = us >> 6;
                        const size_t si = ((size_t)(j * SB + bs) * NG + g) * NS + lane;
                        float hr = args.in[4][si], hi_ = args.in[5][si];
                        ssm_unit<true>(xs, hb, lane, g, sc, out, ssp, MP + bs * ST, ST, hr, hi_, Ob);
                        out[O_HRS + si] = hr; out[O_HIS + si] = hi_;
                    }
                }
                __syncthreads();
            }
            SEAM(pb + 1);
            if (EN_GLU && IN(pb + 2)) {
                pg8::Gemm g{Ob, (const bf16*)(ws + WS_WGLU) + (size_t)j * 2 * D * D, M, 2 * D, D}; pg8::StaticOrder S; S.init(M, 2 * D, G, bx);
                pg8::EpiGlu E{out, XB, ssp};
                pg8::gemm_phase<pg8::EpiGlu, pg8::StaticOrder, true, true>(L, g, S, E);
            }
            SEAM(pb + 2);
        }
        if (EN_UP && IN(pb + 3)) {
            pg8::Gemm g{XB, (const bf16*)(ws + WS_WUP) + (size_t)l * FF * D, M, FF, D}; pg8::StaticOrder S; S.init(M, FF, G, bx);
            pg8::EpiUp E{Hb, ssp, (l & 1) ? 32 : 16};
            pg8::gemm_phase<pg8::EpiUp, pg8::StaticOrder, true, true>(L, g, S, E);
        }
        SEAM(pb + 3);
        if (EN_DN && IN(pb + 4)) {
            pg8::Gemm g{Hb, (const bf16*)(ws + WS_WDN) + (size_t)l * D * FF, M, D, FF}; pg8::StaticOrder S; S.init(M, D, G, bx);
            pg8::EpiRes E{out, out + (size_t)MP * D, out, XB, ssp};
            pg8::gemm_phase<pg8::EpiRes, pg8::StaticOrder, true, true>(L, g, S, E);
        }
        SEAM(pb + 4);
    }
    if (EN_FIN && IN(21)) {
        FRESH_IDS;
        const float* gf = args.in[8];
        for (int m = gw; m < M; m += NGW) {
            const float pv = (lane < 16) ? ssp[(size_t)m * 32 + lane] : 0.f;
            const float rinv = rsqrtf(wave_sum(pv) * (1.0f / 1024.0f) + 1e-6f);
            GAS f32x4* xr = (GAS f32x4*)(out + (size_t)m * D) + lane;
#pragma unroll
            for (int jx = 0; jx < 4; ++jx) { const f32x4 gv = *((const f32x4*)gf + 64 * jx + lane); f32x4 v = xr[64 * jx]; v = v * rinv * gv; xr[64 * jx] = v; }
        }
    }
#undef IN
#undef SEAM
}

#ifndef MK_SPLIT
#define MK_SPLIT 1
#endif
extern "C" void kernel_launch(void* const* d_in, const int* in_sizes, int n_in, void* d_out, int out_size, void* d_ws, size_t ws_size, hipStream_t stream) {
    static int grid = 0;
    if (grid == 0) {
        if (n_in != 23 || in_sizes[0] != MP * D || (size_t)out_size != O_END || ws_size < WS_END) { fprintf(stderr, "kernel_launch: unexpected shapes (n_in %d, in0 %d, out %d, ws %zu); nothing launched\n", n_in, n_in > 0 ? in_sizes[0] : -1, out_size, ws_size); grid = -1; return; }
        int dev = 0, cus = 0, per_cu = 0;
        if (hipGetDevice(&dev) != hipSuccess || hipDeviceGetAttribute(&cus, hipDeviceAttributeMultiprocessorCount, dev) != hipSuccess) { fprintf(stderr, "kernel_launch: device query failed\n"); grid = -1; return; }
        if (hipFuncSetAttribute((const void*)fwd_kernel, hipFuncAttributeMaxDynamicSharedMemorySize, LDS_BYTES) != hipSuccess) { fprintf(stderr, "kernel_launch: hipFuncSetAttribute failed\n"); grid = -1; return; }
        if (hipOccupancyMaxActiveBlocksPerMultiprocessor(&per_cu, (const void*)fwd_kernel, 512, LDS_BYTES) != hipSuccess || per_cu < 1) fprintf(stderr, "kernel_launch: note: occupancy query reports %d blocks per CU\n", per_cu);
        (void)hipGetLastError();
        grid = cus;
    }
    if (grid < 0) return;
    (void)hipMemsetAsync((char*)d_ws + WS_CTL, 0, CTL_ZERO_BYTES, stream);
    Args a{};
    for (int i = 0; i < 23; ++i) a.in[i] = (const float*)d_in[i];
    a.out = (float*)d_out; a.ws = (unsigned char*)d_ws;
#if MK_SPLIT
    for (int p = 0; p < NPHASE; ++p) { a.ph_lo = p; a.ph_hi = p + 1; hipLaunchKernelGGL(fwd_kernel, dim3(grid), dim3(512), LDS_BYTES, stream, a); }
#else
    a.ph_lo = 0; a.ph_hi = NPHASE; hipLaunchKernelGGL(fwd_kernel, dim3(grid), dim3(512), LDS_BYTES, stream, a);
#endif
}
```

```cpp
#include <hip/hip_runtime.h>
#include <cstdio>
#include <cstdint>
namespace pg8 {
#define PG8_LAS __attribute__((address_space(3)))
typedef unsigned short bf16_t;
typedef short bf16x8 __attribute__((ext_vector_type(8)));
typedef float f32x4 __attribute__((ext_vector_type(4)));
typedef unsigned u32x4 __attribute__((ext_vector_type(4)));
constexpr int BM = 256, BK = 64, HALF = 128, HTB = HALF * BK * 2  , STAGE_BYTES = 8 * HTB, NXCD = 8, WGM = 8;

__host__ __device__ __forceinline__ int lds_byte(int r, int c) { const int st = (r >> 4) * 2 + (c >> 5), rr = r & 15, cc = c & 31, ob = rr * 64 + cc * 2; return st * 1024 + (ob ^ (((ob >> 9) & 1) << 5)); }
__host__ __device__ __forceinline__ void stage_rc(int b, int& R, int& C) { const int st = b / 1024, sb = b % 1024, swz = sb ^ (((sb >> 9) & 1) << 5); R = (st >> 1) * 16 + swz / 64; C = (st & 1) * 32 + (swz % 64) / 2; }
__host__ __device__ __forceinline__ int perm32(int rho) { const int n = rho >> 4, i = rho & 15; return 8 * (i >> 2) + 4 * n + (i & 3); }

struct Unit { int pm, pn; };
struct Gemm { const bf16_t* A; const bf16_t* Bt; int M, N, K; };

struct StaticOrder {
    int nM, nN, nwg, G, c;
    __host__ __device__ void init(int M, int N, int G_, int c_) { nM = M / BM; nN = N / BM; nwg = nM * nN; G = G_; c = c_; }
    __host__ __device__ bool next(int i, Unit& u) const {
        const long L = (long)i * G + c; if (L >= nwg) return false;
        int wgid = (int)L; { const int q = nwg / NXCD, r = nwg % NXCD, xcd = wgid % NXCD, off = wgid / NXCD; wgid = (xcd < r ? xcd * (q + 1) : r * (q + 1) + (xcd - r) * q) + off; }
        const int nig = WGM * nN, gid = wgid / nig, fm = gid * WGM, gsz = (nM - fm) < WGM ? (nM - fm) : WGM;
        u.pm = fm + ((wgid % nig) % gsz); u.pn = (wgid % nig) / gsz; return true;
    }
    __device__ __forceinline__ void a_ready(const Unit&) const {}
    __device__ __forceinline__ void done(const Unit&) const {}
};
__device__ __forceinline__ unsigned cvt_pk_bf16(float lo, float hi) { unsigned r; asm volatile("v_cvt_pk_bf16_f32 %0, %1, %2" : "=v"(r) : "v"(lo), "v"(hi)); return r; }
typedef float f32x2 __attribute__((ext_vector_type(2)));
template <class Epi, class Sched, bool ALIGN_EPI = false, bool SP2 = false>
__device__ __forceinline__ void gemm_phase(PG8_LAS unsigned char* lds, const Gemm g, const Sched& S, const Epi& E) {
    const int tid = threadIdx.x, wid = __builtin_amdgcn_readfirstlane(tid >> 6), lane = tid & 63, wr = wid >> 2, wc = wid & 3, fr = lane & 15, fq = lane >> 4;
    const int K = g.K, nt = K / BK;
    unsigned voffA[2], voffB[2];
#pragma unroll
    for (int i = 0; i < 2; ++i) { int R, C; stage_rc(tid * 16 + i * 8192, R, C); const int Rb = Epi::PERM ? ((R & ~31) + perm32(R & 31)) : R;
        voffA[i] = (unsigned)(R * K + C) * 2u; voffB[i] = (unsigned)(Rb * K + C) * 2u; }
    const size_t kstep = (size_t)(BK * 2);
    const size_t hstep = (size_t)HALF * K * 2;
    const size_t tstep = 2 * hstep;
    const unsigned ldsw = (unsigned)wid * 1024u;
    const int aoff = lds_byte(wr * 64 + fr, fq * 8), boff = lds_byte(wc * 32 + fr, fq * 8);
#define PG8_SA(b, h) (((b) * 2 + (h)) * HTB)
#define PG8_SB(b, h) ((4 + (b) * 2 + (h)) * HTB)
#define PG8_STAGE(bufoff, gbase, voff) do { _Pragma("unroll") for (int _i = 0; _i < 2; ++_i) \
        __builtin_amdgcn_global_load_lds((const unsigned*)((const char*)(gbase) + (voff)[_i]), (PG8_LAS unsigned*)(lds + (bufoff) + ldsw + _i * 8192), 16, 0, 0); } while (0)
#define PG8_LDA(dst, b, h) do { _Pragma("unroll") for (int m = 0; m < 4; ++m) _Pragma("unroll") for (int k = 0; k < 2; ++k) dst[m][k] = *(const PG8_LAS bf16x8*)(lds + PG8_SA(b, h) + aoff + m * 2048 + k * 1024); } while (0)
#define PG8_LDB(dst, b, h) do { _Pragma("unroll") for (int n = 0; n < 2; ++n) _Pragma("unroll") for (int k = 0; k < 2; ++k) dst[n][k] = *(const PG8_LAS bf16x8*)(lds + PG8_SB(b, h) + boff + n * 2048 + k * 1024); } while (0)
#define PG8_MMA(ai, bj, At, Bt) do { __builtin_amdgcn_s_setprio(1); _Pragma("unroll") for (int m = 0; m < 4; ++m) _Pragma("unroll") for (int n = 0; n < 2; ++n) _Pragma("unroll") for (int k = 0; k < 2; ++k) \
        acc[ai][bj][m][n] = __builtin_amdgcn_mfma_f32_16x16x32_bf16(Bt[n][k], At[m][k], acc[ai][bj][m][n], 0, 0, 0); __builtin_amdgcn_s_setprio(0); } while (0)
#define PG8_WAIT_V(n) asm volatile("s_waitcnt vmcnt(" #n ")" ::: "memory")
#define PG8_WAIT_L(n) asm volatile("s_waitcnt lgkmcnt(" #n ")" ::: "memory")
#define PG8_BAR __builtin_amdgcn_s_barrier()
#define PG8_SCHED __builtin_amdgcn_sched_barrier(0)
    Unit cur, nxt; int ui = 0;
    if (!S.next(0, cur)) return;
    f32x4 acc[2][2][4][2];
#pragma unroll
    for (int a = 0; a < 2; ++a)
#pragma unroll
        for (int b = 0; b < 2; ++b)
#pragma unroll
            for (int m = 0; m < 4; ++m)
#pragma unroll
                for (int n = 0; n < 2; ++n) acc[a][b][m][n] = (f32x4){0.f, 0.f, 0.f, 0.f};
    bf16x8 At[4][2], B0[2][2], B1[2][2];
    const char* cA = (const char*)g.A + (size_t)cur.pm * tstep; const char* cB = (const char*)g.Bt + (size_t)cur.pn * tstep;
    S.a_ready(cur);
    if constexpr (SP2) {
        PG8_STAGE(PG8_SB(0, 0), cB, voffB); PG8_STAGE(PG8_SB(0, 1), cB + hstep, voffB); PG8_STAGE(PG8_SA(0, 0), cA, voffA); PG8_STAGE(PG8_SA(0, 1), cA + hstep, voffA);
        if (wr == 1) PG8_BAR;
        PG8_WAIT_V(2); PG8_BAR;
        PG8_STAGE(PG8_SB(1, 0), cB + kstep, voffB); PG8_STAGE(PG8_SA(1, 0), cA + kstep, voffA); PG8_STAGE(PG8_SB(1, 1), cB + hstep + kstep, voffB);
        PG8_WAIT_V(6); PG8_BAR;
    } else {
        PG8_STAGE(PG8_SB(0, 0), cB, voffB); PG8_STAGE(PG8_SA(0, 0), cA, voffA); PG8_STAGE(PG8_SB(0, 1), cB + hstep, voffB); PG8_STAGE(PG8_SA(0, 1), cA + hstep, voffA);
        if (wr == 1) PG8_BAR;
        PG8_WAIT_V(4); PG8_BAR;
        PG8_STAGE(PG8_SB(1, 0), cB + kstep, voffB); PG8_STAGE(PG8_SA(1, 0), cA + kstep, voffA); PG8_STAGE(PG8_SB(1, 1), cB + hstep + kstep, voffB);
        PG8_WAIT_V(6); PG8_BAR;
    }
    for (;;) {
        const bool has_next = S.next(ui + 1, nxt);
        const char* nA = has_next ? (const char*)g.A + (size_t)nxt.pm * tstep : cA; const char* nB = has_next ? (const char*)g.Bt + (size_t)nxt.pn * tstep : cB;
        for (int t = 0; t < nt; t += 2) {
            const bool last = (t == nt - 2);
            const char* a1 = cA + (size_t)(t + 1) * kstep;
            const char* a2 = last ? nA : cA + (size_t)(t + 2) * kstep; const char* b2 = last ? nB : cB + (size_t)(t + 2) * kstep;
            const char* a3 = a2 + kstep; const char* b3 = b2 + kstep;
            if (last && has_next) S.a_ready(nxt);
            if constexpr (SP2) {
            PG8_LDB(B0, 0, 0); PG8_LDB(B1, 0, 1); PG8_SCHED; PG8_LDA(At, 0, 0); PG8_STAGE(PG8_SA(1, 1), a1 + hstep, voffA);
            PG8_WAIT_V(8); PG8_WAIT_L(0); PG8_BAR; PG8_MMA(0, 0, At, B0); PG8_MMA(0, 1, At, B1); PG8_BAR; PG8_SCHED;
            PG8_LDA(At, 0, 1); PG8_STAGE(PG8_SB(0, 0), b2, voffB); PG8_STAGE(PG8_SB(0, 1), b2 + hstep, voffB); PG8_STAGE(PG8_SA(0, 0), a2, voffA);
            PG8_WAIT_V(8); PG8_WAIT_L(0); PG8_BAR; PG8_MMA(1, 0, At, B0); PG8_MMA(1, 1, At, B1); PG8_BAR; PG8_SCHED;
            PG8_LDB(B0, 1, 0); PG8_LDB(B1, 1, 1); PG8_SCHED; PG8_LDA(At, 1, 0); PG8_STAGE(PG8_SA(0, 1), a2 + hstep, voffA);
            PG8_WAIT_V(8); PG8_WAIT_L(0); PG8_BAR; PG8_MMA(0, 0, At, B0); PG8_MMA(0, 1, At, B1); PG8_BAR; PG8_SCHED;
            PG8_LDA(At, 1, 1); PG8_STAGE(PG8_SB(1, 0), b3, voffB); PG8_STAGE(PG8_SB(1, 1), b3 + hstep, voffB); PG8_STAGE(PG8_SA(1, 0), a3, voffA);
            PG8_WAIT_V(8); PG8_WAIT_L(0); PG8_BAR; PG8_MMA(1, 0, At, B0); PG8_MMA(1, 1, At, B1); PG8_BAR; PG8_SCHED;
            } else {
            PG8_LDB(B0, 0, 0); PG8_SCHED; PG8_LDA(At, 0, 0); PG8_STAGE(PG8_SA(1, 1), a1 + hstep, voffA);
            PG8_WAIT_L(8); PG8_BAR; PG8_WAIT_L(0); PG8_MMA(0, 0, At, B0); PG8_BAR; PG8_SCHED;
            PG8_LDB(B1, 0, 1); PG8_STAGE(PG8_SB(0, 0), b2, voffB);
            PG8_BAR; PG8_WAIT_L(0); PG8_MMA(0, 1, At, B1); PG8_BAR;
            PG8_LDA(At, 0, 1); PG8_STAGE(PG8_SA(0, 0), a2, voffA);
            PG8_BAR; PG8_WAIT_L(0); PG8_MMA(1, 0, At, B0); PG8_BAR; PG8_SCHED;
            PG8_STAGE(PG8_SB(0, 1), b2 + hstep, voffB);
            PG8_WAIT_V(6); PG8_BAR; PG8_MMA(1, 1, At, B1); PG8_BAR;
            PG8_LDB(B0, 1, 0); PG8_SCHED; PG8_LDA(At, 1, 0); PG8_STAGE(PG8_SA(0, 1), a2 + hstep, voffA);
            PG8_WAIT_L(8); PG8_BAR; PG8_WAIT_L(0); PG8_MMA(0, 0, At, B0); PG8_BAR; PG8_SCHED;
            PG8_LDB(B1, 1, 1); PG8_STAGE(PG8_SB(1, 0), b3, voffB);
            PG8_BAR; PG8_WAIT_L(0); PG8_MMA(0, 1, At, B1); PG8_BAR;
            PG8_LDA(At, 1, 1); PG8_STAGE(PG8_SA(1, 0), a3, voffA);
            PG8_BAR; PG8_WAIT_L(0); PG8_MMA(1, 0, At, B0); PG8_BAR; PG8_SCHED;
            PG8_STAGE(PG8_SB(1, 1), b3 + hstep, voffB);
            PG8_WAIT_V(6); PG8_BAR; PG8_MMA(1, 1, At, B1); PG8_BAR;
            }
        }
        if constexpr (ALIGN_EPI) { if (wr == 0) PG8_BAR; }
        if constexpr (!Epi::AFTER_DRAIN) { E(acc, cur, wr, wc, fr, fq); S.done(cur); }
        if (!has_next) break;
#pragma unroll
        for (int a = 0; a < 2; ++a)
#pragma unroll
            for (int b = 0; b < 2; ++b)
#pragma unroll
                for (int m = 0; m < 4; ++m)
#pragma unroll
                    for (int n = 0; n < 2; ++n) acc[a][b][m][n] = (f32x4){0.f, 0.f, 0.f, 0.f};
        cur = nxt; cA = nA; cB = nB; ++ui;
        if constexpr (ALIGN_EPI) { if (wr == 1) PG8_BAR; }
    }
    PG8_WAIT_V(0);
    if constexpr (!ALIGN_EPI) { if (wr == 0) PG8_BAR; }
    PG8_BAR;
    if constexpr (Epi::AFTER_DRAIN) { E.fused(acc, cur, wr, wc, fr, fq, lds, wid, lane); S.done(cur); }
#undef PG8_SA
#undef PG8_SB
#undef PG8_STAGE
#undef PG8_LDA
#undef PG8_LDB
#undef PG8_MMA
#undef PG8_WAIT_V
#undef PG8_WAIT_L
#undef PG8_BAR
#undef PG8_SCHED
}
}
#define GAS __attribute__((address_space(1)))
#define LAS __attribute__((address_space(3)))
typedef unsigned short bf16;
typedef unsigned v4u __attribute__((ext_vector_type(4)));
typedef float f32x4 __attribute__((ext_vector_type(4)));
typedef short bf16x8 __attribute__((ext_vector_type(8)));
typedef GAS unsigned gu32;
typedef GAS unsigned long long gu64;
#define RLX_AGENT __ATOMIC_RELAXED, __HIP_MEMORY_SCOPE_AGENT
#define LDS_WAIT() asm volatile("s_waitcnt lgkmcnt(0)" ::: "memory")
#define VM_WAIT() asm volatile("s_waitcnt vmcnt(0)" ::: "memory")
__device__ __forceinline__ unsigned long long rt() { return __builtin_amdgcn_s_memrealtime(); }
__device__ __forceinline__ unsigned f2bf(float f) { unsigned u = __builtin_bit_cast(unsigned, f); return (u + 0x7fffu + ((u >> 16) & 1u)) >> 16; }
__device__ __forceinline__ unsigned pk2(float lo, float hi) { return f2bf(lo) | (f2bf(hi) << 16); }
#define XB_TMO      128
#define XB_XCNT(j)  (256  + 64 * (j))
#define XB_XSUB(j)  (1280 + 64 * (j))
#define XB_XGEN(j)  (2304 + 64 * (j))
#define XB_TOP      3328
#define XB_TOPGEN   3392
#define XCD_BAR_WORDS 3456
#define XB_SPIN_CAP (1u << 18)

__device__ __forceinline__ unsigned xb_ld(unsigned* p)              { return __hip_atomic_load(p, __ATOMIC_RELAXED, __HIP_MEMORY_SCOPE_AGENT); }
__device__ __forceinline__ unsigned xb_add(unsigned* p, unsigned v) { return __hip_atomic_fetch_add(p, v, __ATOMIC_RELAXED, __HIP_MEMORY_SCOPE_AGENT); }
__device__ __forceinline__ unsigned xb_xcc_id() { return (unsigned)__builtin_amdgcn_s_getreg((3 << 11) | 20) & 0xFu; }
#define XB_SPIN(cond, bar) do { unsigned _sp = 0; while (cond) { __builtin_amdgcn_s_sleep(1); \
    if ((++_sp & 255u) == 0u) { if (xb_ld(&(bar)[XB_TMO])) break; if (_sp > XB_SPIN_CAP) { atomicAdd(&(bar)[XB_TMO], 1u); break; } } } } while (0)

struct XcdBarrier {
    unsigned* bar; unsigned x;
    volatile LAS unsigned* st;
};

__device__ __forceinline__ XcdBarrier xcd_barrier_post(unsigned* bar, volatile LAS unsigned* st) {
    XcdBarrier b; b.bar = bar; b.x = xb_xcc_id(); b.st = st;
    if (threadIdx.x == 0) (void)xb_add(&bar[XB_XCNT(b.x)], 1u);
    return b;
}
__device__ __forceinline__ void xcd_barrier_complete(unsigned* bar, unsigned x, unsigned& nloc, unsigned& nx) {
    const unsigned G = gridDim.x * gridDim.y * gridDim.z;
    unsigned sum, cnt, mine, sp = 0u;
    for (;;) {
        sum = 0u; cnt = 0u; mine = 0u;
#pragma unroll
        for (unsigned j = 0; j < 16; ++j) { const unsigned c = xb_ld(&bar[XB_XCNT(j)]); sum += c; cnt += (c > 0u) ? 1u : 0u; mine = (j == x) ? c : mine; }
        if (sum == G) break;
        __builtin_amdgcn_s_sleep(1);
        if ((++sp & 255u) == 0u) { if (xb_ld(&bar[XB_TMO])) break; if (sp > XB_SPIN_CAP) { atomicAdd(&bar[XB_TMO], 1u); break; } }
    }
    nloc = mine > 0u ? mine : 1u; nx = cnt > 0u ? cnt : 1u;
}

__device__ __forceinline__ void xcd_barrier(const XcdBarrier& b) {
    asm volatile("s_waitcnt vmcnt(0)" ::: "memory");
    __syncthreads();
    if (threadIdx.x == 0) {
        unsigned* bar = b.bar;
        __builtin_amdgcn_s_waitcnt(0);
        unsigned nloc = b.st[0], nx = b.st[1];
        if (nloc == 0u) { xcd_barrier_complete(bar, b.x, nloc, nx); b.st[0] = nloc; b.st[1] = nx; }
        const unsigned old = xb_add(&bar[XB_XSUB(b.x)], 1u);
        const unsigned gen = old / nloc;
        if (old + 1u == (gen + 1u) * nloc) {
            __builtin_amdgcn_fence(__ATOMIC_RELEASE, "agent");
            asm volatile("s_waitcnt vmcnt(0)" ::: "memory");
            const unsigned og = xb_add(&bar[XB_TOP], 1u);
            const unsigned tg = og / nx;
            if (og + 1u == (tg + 1u) * nx) xb_add(&bar[XB_TOPGEN], 1u);
            else XB_SPIN(xb_ld(&bar[XB_TOPGEN]) == tg, bar);
            __builtin_amdgcn_fence(__ATOMIC_ACQUIRE, "agent");
            xb_add(&bar[XB_XGEN(b.x)], 1u);
            asm volatile("s_waitcnt vmcnt(0)" ::: "memory");
        } else {
            XB_SPIN(xb_ld(&bar[XB_XGEN(b.x)]) == gen, bar);
            __builtin_amdgcn_fence(__ATOMIC_ACQUIRE, "agent");
            asm volatile("s_waitcnt vmcnt(0)" ::: "memory");
        }
    }
    __syncthreads();
}

constexpr int D = 1024, SEQ = 8192, NB = 2, MP = NB * SEQ, SB = 128, ST = 8, MS = SB * ST, M = MP + MS;
constexpr int NQKV = 1536, FF = 4096, NKV = 4, HD = 64, KVW = NKV * HD, NG = 64, GC = 16, NS = 64;
constexpr int CH = 256, NCH = SEQ / CH;
constexpr int NPHASE = 22;
constexpr size_t O_KP = 17825792, O_VP = 17956864, O_HRP = 18087936, O_HIP = 18104320, O_KS = 18120704, O_VS = 26509312, O_HRS = 34897920, O_HIS = 35946496, O_END = 36995072;
constexpr size_t MiB = 1u << 20;
constexpr size_t WS_CTL = 0, CTL_ZERO_BYTES = 64 * 1024;
constexpr size_t WS_SSP = 1 * MiB;
constexpr size_t WS_HS = 4 * MiB;
constexpr size_t WS_WQKV = 8 * MiB, WS_WO = 14 * MiB, WS_WGLU = 18 * MiB, WS_WUP = 26 * MiB, WS_WDN = 58 * MiB;
constexpr size_t WS_XB = 90 * MiB;
constexpr size_t WS_H = 124 * MiB;
constexpr size_t WS_Q = 124 * MiB, WS_K = 158 * MiB, WS_V = 167 * MiB, WS_O = 176 * MiB;
constexpr size_t WS_END = 260 * MiB;
constexpr int CW_BAR = 4096;
static_assert((CW_BAR + XCD_BAR_WORDS) * 4 <= (int)CTL_ZERO_BYTES, "barrier words inside the memset region");
constexpr int RING_BYTES = 131072, LDSCTL_OFF = RING_BYTES, MISC_OFF = LDSCTL_OFF + 320, LDS_BYTES = 147456;

__device__ __forceinline__ float wave_sum(float v) {
#pragma unroll
    for (int o = 1; o < 64; o <<= 1) v += __shfl_xor(v, o);
    return v;
}
__device__ __forceinline__ float wave_max(float v) {
#pragma unroll
    for (int o = 1; o < 64; o <<= 1) v = fmaxf(v, __shfl_xor(v, o));
    return v;
}
__device__ __forceinline__ float bf_lo(unsigned u) { return __uint_as_float(u << 16); }
__device__ __forceinline__ float bf_hi(unsigned u) { return __uint_as_float(u & 0xffff0000u); }

namespace pg8 {
__device__ __forceinline__ float row_rinv(const float* ssp, int row, int np, int fq) {
    const float* p = ssp + (size_t)row * 32;
    const f32x4 v = *(const f32x4*)(p + 4 * fq); float s = (v[0] + v[1]) + (v[2] + v[3]);
    if (np == 32) { const f32x4 w = *(const f32x4*)(p + 16 + 4 * fq); s += (w[0] + w[1]) + (w[2] + w[3]); }
    s += __shfl_xor(s, 16); s += __shfl_xor(s, 32);
    return rsqrtf(s * (1.0f / 1024.0f) + 1e-6f);
}
__device__ __forceinline__ u32x4 pack8(const f32x4 a, const f32x4 b) { u32x4 w; w.x = cvt_pk_bf16(a[0], a[1]); w.y = cvt_pk_bf16(a[2], a[3]); w.z = cvt_pk_bf16(b[0], b[1]); w.w = cvt_pk_bf16(b[2], b[3]); return w; }

struct EpiQKV {
    static constexpr bool PERM = true, AFTER_DRAIN = false;
    bf16_t *Q, *K, *V; const float* ssp; int np; float *kp, *vp, *ks, *vs;
    __device__ __forceinline__ void operator()(const f32x4 (&acc)[2][2][4][2], const Unit& u, int wr, int wc, int fr, int fq) const {
        const int rowb = u.pm * BM + wr * 64 + fr, pn = u.pn;
#pragma unroll
        for (int ai = 0; ai < 2; ++ai)
#pragma unroll
            for (int m = 0; m < 4; ++m) {
                const int row = rowb + ai * HALF + m * 16;
                const float r = row_rinv(ssp, row, np, fq);
#pragma unroll
                for (int bj = 0; bj < 2; ++bj) {
                    const f32x4 v0 = acc[ai][bj][m][0] * r, v1 = acc[ai][bj][m][1] * r;
                    const int cl = bj * HALF + wc * 32 + 8 * fq;
                    const u32x4 w = pack8(v0, v1);
                    if (pn < 4) { *(u32x4*)(Q + (size_t)row * 1024 + pn * 256 + cl) = w; }
                    else {
                        bf16_t* B = (pn == 4) ? K : V;
                        *(u32x4*)(B + (size_t)row * 256 + cl) = w;
                        float* o = nullptr;
                        if (row >= 16384) { const int rs = row - 16384; o = ((pn == 4) ? ks : vs) + ((size_t)(rs >> 3) * 128 + 120 + (rs & 7)) * 256 + cl; }
                        else { const int t = row & 8191; if (t >= 8064) o = ((pn == 4) ? kp : vp) + ((size_t)(row >> 13) * 128 + (t - 8064)) * 256 + cl; }
                        if (o) { *(f32x4*)o = v0; *(f32x4*)(o + 4) = v1; }
                    }
                }
            }
    }
};
struct EpiRes {
    static constexpr bool PERM = true, AFTER_DRAIN = false;
    const float* xp; const float* xs; float* XR; bf16_t* XB; float* ssp;
    __device__ __forceinline__ void operator()(const f32x4 (&acc)[2][2][4][2], const Unit& u, int wr, int wc, int fr, int fq) const {
        const int rowb = u.pm * BM + wr * 64 + fr, pn = u.pn;
#pragma unroll
        for (int ai = 0; ai < 2; ++ai)
#pragma unroll
            for (int m = 0; m < 4; ++m) {
                const int row = rowb + ai * HALF + m * 16;
                const float* old = (row < 16384) ? xp + (size_t)row * 1024 : xs + (size_t)(row - 16384) * 1024;
                float ss = 0.f;
#pragma unroll
                for (int bj = 0; bj < 2; ++bj) {
                    const int col = pn * 256 + bj * HALF + wc * 32 + 8 * fq;
                    const f32x4 o0 = *(const f32x4*)(old + col), o1 = *(const f32x4*)(old + col + 4);
                    const f32x4 v0 = acc[ai][bj][m][0] + o0, v1 = acc[ai][bj][m][1] + o1;
                    *(f32x4*)(XR + (size_t)row * 1024 + col) = v0; *(f32x4*)(XR + (size_t)row * 1024 + col + 4) = v1;
                    *(u32x4*)(XB + (size_t)row * 1024 + col) = pack8(v0, v1);
                    ss += (v0[0] * v0[0] + v0[1] * v0[1]) + (v0[2] * v0[2] + v0[3] * v0[3]) + (v1[0] * v1[0] + v1[1] * v1[1]) + (v1[2] * v1[2] + v1[3] * v1[3]);
                }
                ss += __shfl_xor(ss, 16); ss += __shfl_xor(ss, 32);
                if (fq == 0) ssp[(size_t)row * 32 + pn * 4 + wc] = ss;
            }
    }
};
struct EpiGlu {
    static constexpr bool PERM = true, AFTER_DRAIN = false;
    float* XR; bf16_t* XB; float* ssp;
    __device__ __forceinline__ void operator()(const f32x4 (&acc)[2][2][4][2], const Unit& u, int wr, int wc, int fr, int fq) const {
        const int rowb = u.pm * BM + wr * 64 + fr, pn = u.pn;
#pragma unroll
        for (int ai = 0; ai < 2; ++ai)
#pragma unroll
            for (int m = 0; m < 4; ++m) {
                const int row = rowb + ai * HALF + m * 16;
                const int col = pn * 128 + wc * 32 + 8 * fq;
                float* xr = XR + (size_t)row * 1024 + col;
                const f32x4 o0 = *(const f32x4*)xr, o1 = *(const f32x4*)(xr + 4);
                f32x4 v0, v1;
#pragma unroll
                for (int e = 0; e < 4; ++e) {
                    v0[e] = o0[e] + acc[ai][0][m][0][e] * (1.0f / (1.0f + __expf(-acc[ai][1][m][0][e])));
                    v1[e] = o1[e] + acc[ai][0][m][1][e] * (1.0f / (1.0f + __expf(-acc[ai][1][m][1][e])));
                }
                *(f32x4*)xr = v0; *(f32x4*)(xr + 4) = v1;
                *(u32x4*)(XB + (size_t)row * 1024 + col) = pack8(v0, v1);
                float ss = (v0[0] * v0[0] + v0[1] * v0[1]) + (v0[2] * v0[2] + v0[3] * v0[3]) + (v1[0] * v1[0] + v1[1] * v1[1]) + (v1[2] * v1[2] + v1[3] * v1[3]);
                ss += __shfl_xor(ss, 16); ss += __shfl_xor(ss, 32);
                if (fq == 0) ssp[(size_t)row * 32 + pn * 4 + wc] = ss;
            }
    }
};
struct EpiUp {
    static constexpr bool PERM = true, AFTER_DRAIN = false;
    bf16_t* H; const float* ssp; int np;
    __device__ __forceinline__ void operator()(const f32x4 (&acc)[2][2][4][2], const Unit& u, int wr, int wc, int fr, int fq) const {
        const int rowb = u.pm * BM + wr * 64 + fr, pn = u.pn;
#pragma unroll
        for (int ai = 0; ai < 2; ++ai)
#pragma unroll
            for (int m = 0; m < 4; ++m) {
                const int row = rowb + ai * HALF + m * 16;
                const float r = row_rinv(ssp, row, np, fq);
#pragma unroll
                for (int bj = 0; bj < 2; ++bj) {
                    f32x4 v0 = acc[ai][bj][m][0] * r, v1 = acc[ai][bj][m][1] * r;
#pragma unroll
                    for (int e = 0; e < 4; ++e) { const float a = fmaxf(v0[e], 0.f), b = fmaxf(v1[e], 0.f); v0[e] = a * a; v1[e] = b * b; }
                    *(u32x4*)(H + (size_t)row * 4096 + pn * 256 + bj * HALF + wc * 32 + 8 * fq) = pack8(v0, v1);
                }
            }
    }
};
}

__device__ __forceinline__ void p0_transpose_item(const float* W, int K, int N, const float* gain, bf16* WT, int glu, LAS float* scr, int item, int lane) {
    const int nblk = N / 32, kb = item / nblk, nb = item % nblk, k0 = 64 * kb, n0 = 32 * nb;
#pragma unroll 8
    for (int i = 0; i < 32; ++i) { const int kk = 2 * i + (lane >> 5); float w = W[(size_t)(k0 + kk) * N + n0 + (lane & 31)]; if (gain) w *= gain[k0 + kk]; scr[kk * 33 + (lane & 31)] = w; }
    LDS_WAIT(); asm volatile("" ::: "memory");
    int drow0 = n0; if (glu) { const int bj = n0 / 1024, rem = n0 % 1024; drow0 = (rem / 128) * 256 + bj * 128 + (rem % 128); }
    const int c = lane & 7;
#pragma unroll
    for (int j = 0; j < 4; ++j) { const int n = (lane >> 3) + 8 * j; const LAS float* s = scr + (8 * c) * 33 + n;
        v4u o; o.x = pk2(s[0 * 33], s[1 * 33]); o.y = pk2(s[2 * 33], s[3 * 33]); o.z = pk2(s[4 * 33], s[5 * 33]); o.w = pk2(s[6 * 33], s[7 * 33]);
        *(GAS v4u*)(WT + (size_t)(drow0 + n) * K + k0 + 8 * c) = o; }
    LDS_WAIT(); asm volatile("" ::: "memory");
}

__device__ __forceinline__ void sincos_rr(float x, float& s, float& c) {
    const float q = rintf(x * 0.63661977236758f);
    float r = fmaf(-q, 1.57079637050629f, x); r = fmaf(-q, -4.37113882867379e-8f, r);
    const float r2 = r * r;
    const float sp = r + r * r2 * (-1.6666667163e-1f + r2 * (8.3333337680e-3f + r2 * (-1.9841270114e-4f + r2 * 2.7557314297e-6f)));
    const float cp = 1.0f + r2 * (-0.5f + r2 * (4.1666667908e-2f + r2 * (-1.3888889225e-3f + r2 * (2.4801587642e-5f + r2 * -2.7557314297e-7f))));
    const int qi = (int)q & 3;
    s = (qi == 0) ? sp : (qi == 1) ? cp : (qi == 2) ? -sp : -cp;
    c = (qi == 0) ? cp : (qi == 1) ? -sp : (qi == 2) ? -cp : sp;
}

struct SsmC { const float *A_re, *A_im, *log_dt, *B_re, *B_im, *C_re, *C_im, *Dk, *gain; };
__device__ __forceinline__ void ssm_abar(const SsmC& c, int g, int n, float& abr, float& abi, float& cfr, float& cfi) {
    const float dt = expf(c.log_dt[g]);
    const float ar = c.A_re[g * 64 + n], ai = c.A_im[g * 64 + n];
    const float mag = expf(dt * ar); float sn, cs; sincos_rr(dt * ai, sn, cs);
    abr = mag * cs; abi = mag * sn;
    const float den = ar * ar + ai * ai, nr = abr - 1.0f;
    cfr = (nr * ar + abi * ai) / den; cfi = (abi * ar - nr * ai) / den;
}
__device__ __forceinline__ float gelu_tanh(float y) {
    const float z = 0.7978845608028654f * (y + 0.044715f * y * y * y);
    return y / (1.0f + __expf(-2.0f * z));
}
template <bool FULL>
__device__ __forceinline__ void ssm_unit(LAS float* xs, LAS float* hb, int lane, int g, const SsmC& c, const float* XR, const float* ssp, int row0, int L, float& hr, float& hi, bf16* Gout) {
    float abr, abi, cfr, cfi; ssm_abar(c, g, lane, abr, abi, cfr, cfi);
    float Br[16], Bi[16];
#pragma unroll
    for (int c4 = 0; c4 < 4; ++c4) {
        const f32x4 br = *(const f32x4*)(c.B_re + ((size_t)g * 64 + lane) * 16 + 4 * c4), bi = *(const f32x4*)(c.B_im + ((size_t)g * 64 + lane) * 16 + 4 * c4), gn = *(const f32x4*)(c.gain + g * 16 + 4 * c4);
#pragma unroll
        for (int e = 0; e < 4; ++e) { Br[4 * c4 + e] = (cfr * br[e] - cfi * bi[e]) * gn[e]; Bi[4 * c4 + e] = (cfr * bi[e] + cfi * br[e]) * gn[e]; }
    }
    const int cc = lane & 15, q = lane >> 4;
    float Cq[32]; float Dg = 0.f;
    if (FULL) {
        const float* src = ((q < 2) ? c.C_re : c.C_im) + ((size_t)g * 16 + cc) * 64 + 32 * (q & 1); const float sg = (q < 2) ? 1.0f : -1.0f;
#pragma unroll
        for (int i4 = 0; i4 < 8; ++i4) { const f32x4 v = *(const f32x4*)(src + 4 * i4);
#pragma unroll
            for (int e = 0; e < 4; ++e) Cq[4 * i4 + e] = sg * v[e]; }
        Dg = c.Dk[g * 16 + cc] * c.gain[g * 16 + cc];
    }
    for (int t0 = 0; t0 < L; t0 += 64) {
        const int cnt = (L - t0) < 64 ? (L - t0) : 64;
        if (lane < cnt) {
            const int row = row0 + t0 + lane;
            const float* sp = ssp + (size_t)row * 32;
            const f32x4 s0 = *(const f32x4*)sp, s1 = *(const f32x4*)(sp + 4), s2 = *(const f32x4*)(sp + 8), s3 = *(const f32x4*)(sp + 12);
            const float ss = ((s0[0] + s0[1]) + (s0[2] + s0[3])) + ((s1[0] + s1[1]) + (s1[2] + s1[3])) + ((s2[0] + s2[1]) + (s2[2] + s2[3])) + ((s3[0] + s3[1]) + (s3[2] + s3[3]));
            const float rinv = rsqrtf(ss * (1.0f / 1024.0f) + 1e-6f);
            const float* xr = XR + (size_t)row * 1024 + g * 16;
#pragma unroll
            for (int c4 = 0; c4 < 4; ++c4) { const f32x4 v = *(const f32x4*)(xr + 4 * c4); *(LAS f32x4*)(xs + lane * 16 + 4 * c4) = v * rinv; }
        }
        LDS_WAIT(); asm volatile("" ::: "memory");
        float ykeep = 0.f;
        for (int tt = 0; tt < cnt; ++tt) {
            float inr = 0.f, ini = 0.f;
#pragma unroll
            for (int c4 = 0; c4 < 4; ++c4) { const f32x4 xv = *(const LAS f32x4*)(xs + tt * 16 + 4 * c4);
#pragma unroll
                for (int e = 0; e < 4; ++e) { inr = fmaf(xv[e], Br[4 * c4 + e], inr); ini = fmaf(xv[e], Bi[4 * c4 + e], ini); } }
            const float nhr = abr * hr - abi * hi + inr, nhi = abr * hi + abi * hr + ini; hr = nhr; hi = nhi;
            if (FULL) {
                hb[lane] = hr; hb[64 + lane] = hi;
                LDS_WAIT(); asm volatile("" ::: "memory");
                float part = 0.f;
#pragma unroll
                for (int i4 = 0; i4 < 8; ++i4) { const f32x4 hv = *(const LAS f32x4*)(hb + 32 * q + 4 * i4);
#pragma unroll
                    for (int e = 0; e < 4; ++e) part = fmaf(hv[e], Cq[4 * i4 + e], part); }
                part += __shfl_xor(part, 16); part += __shfl_xor(part, 32);
                const float y = part + Dg * xs[tt * 16 + cc];
                if ((tt & 3) == q) ykeep = y;
                if ((tt & 3) == 3) Gout[(size_t)(row0 + t0 + (tt & ~3) + q) * 1024 + g * 16 + cc] = (bf16)f2bf(gelu_tanh(ykeep));
                asm volatile("" ::: "memory");
            }
        }
        LDS_WAIT(); asm volatile("" ::: "memory");
    }
}

#ifndef EN_P0
#define EN_P0 1
#endif
#ifndef EN_QKV
#define EN_QKV 1
#endif
#ifndef EN_ATT
#define EN_ATT 1
#endif
#ifndef EN_OPJ
#define EN_OPJ 1
#endif
#ifndef EN_S1
#define EN_S1 1
#endif
#ifndef EN_S3
#define EN_S3 1
#endif
#ifndef EN_GLU
#define EN_GLU 1
#endif
#ifndef EN_UP
#define EN_UP 1
#endif
#ifndef EN_DN
#define EN_DN 1
#endif
#ifndef EN_FIN
#define EN_FIN 1
#endif
struct Args { const float* in[23]; float* out; unsigned char* ws; int ph_lo, ph_hi; };

__global__ void __launch_bounds__(512, 2) fwd_kernel(Args args) {
    extern __shared__ __attribute__((aligned(16))) unsigned char lds[];
    LAS unsigned char* const L = (LAS unsigned char*)lds;
#define FRESH_IDS int tid = threadIdx.x; asm volatile("" : "+v"(tid)); const int lane = tid & 63, wave = __builtin_amdgcn_readfirstlane(tid >> 6); const int gw = vcu * 8 + wave; (void)lane; (void)gw
    const int G = gridDim.x, bx = blockIdx.x;
    const int vcu = (G % 8 == 0) ? (bx % 8) * (G / 8) + bx / 8 : bx;
    const int NGW = G * 8;
    for (int u = threadIdx.x; u < (LDS_BYTES - LDSCTL_OFF) / 4; u += 512) ((LAS unsigned*)(L + LDSCTL_OFF))[u] = 0u;
    __syncthreads();
    const int lo = args.ph_lo, hi = args.ph_hi;
    const bool multi = (hi - lo) > 1;
    unsigned char* const ws = args.ws;
    float* const out = args.out;
    XcdBarrier bar; bar.bar = (unsigned*)(ws + WS_CTL) + CW_BAR; bar.x = 0; bar.st = nullptr;
    if (multi) bar = xcd_barrier_post((unsigned*)(ws + WS_CTL) + CW_BAR, (volatile LAS unsigned*)(L + MISC_OFF) + 8);
#define IN(k) (lo <= (k) && (k) < hi)
#define SEAM(k) do { if (IN(k) && IN((k) + 1)) xcd_barrier(bar); } while (0)

    float* const ssp = (float*)(ws + WS_SSP);
    float* const HS = (float*)(ws + WS_HS);
    bf16* const XB = (bf16*)(ws + WS_XB);
    bf16* const Hb = (bf16*)(ws + WS_H);
    bf16* const Qb = (bf16*)(ws + WS_Q); bf16* const Kb = (bf16*)(ws + WS_K); bf16* const Vb = (bf16*)(ws + WS_V); bf16* const Ob = (bf16*)(ws + WS_O);
    const float* const x_p = args.in[0]; const float* const x_s = args.in[1];

    if (EN_P0 && IN(0)) {
        FRESH_IDS;
        LAS float* scr = (LAS float*)(L + wave * 16384);
        constexpr int I_QKV = 16 * 48, I_O = 16 * 32, I_GLU = 16 * 64, I_UP = 16 * 128, I_DN = 64 * 32;
        constexpr int NITEMS = 2 * I_QKV + 2 * I_O + 2 * I_GLU + 4 * I_UP + 4 * I_DN;
        for (int it = gw; it < NITEMS; it += NGW) {
            int r = it;
            if (r < 2 * I_QKV) { const int j = r / I_QKV; r -= j * I_QKV; p0_transpose_item(args.in[9] + (size_t)j * D * NQKV, D, NQKV, args.in[6] + (size_t)(2 * j) * D, (bf16*)(ws + WS_WQKV) + (size_t)j * NQKV * D, 0, scr, r, lane); continue; } r -= 2 * I_QKV;
            if (r < 2 * I_O) { const int j = r / I_O; r -= j * I_O; p0_transpose_item(args.in[10] + (size_t)j * D * D, D, D, nullptr, (bf16*)(ws + WS_WO) + (size_t)j * D * D, 0, scr, r, lane); continue; } r -= 2 * I_O;
            if (r < 2 * I_GLU) { const int j = r / I_GLU; r -= j * I_GLU; p0_transpose_item(args.in[20] + (size_t)j * D * 2 * D, D, 2 * D, nullptr, (bf16*)(ws + WS_WGLU) + (size_t)j * 2 * D * D, 1, scr, r, lane); continue; } r -= 2 * I_GLU;
            if (r < 4 * I_UP) { const int l = r / I_UP; r -= l * I_UP; p0_transpose_item(args.in[21] + (size_t)l * D * FF, D, FF, args.in[7] + (size_t)l * D, (bf16*)(ws + WS_WUP) + (size_t)l * FF * D, 0, scr, r, lane); continue; } r -= 4 * I_UP;
            { const int l = r / I_DN; r -= l * I_DN; p0_transpose_item(args.in[22] + (size_t)l * FF * D, FF, D, nullptr, (bf16*)(ws + WS_WDN) + (size_t)l * D * FF, 0, scr, r, lane); }
        }
        for (int m = gw; m < M; m += NGW) {
            const float* xrow = (m < MP) ? x_p + (size_t)m * D : x_s + (size_t)(m - MP) * D;
            const GAS f32x4* xr = (const GAS f32x4*)xrow + lane;
            f32x4 v[4]; float s = 0.f;
#pragma unroll
            for (int j = 0; j < 4; ++j) { v[j] = xr[64 * j]; s += (v[j][0] * v[j][0] + v[j][1] * v[j][1]) + (v[j][2] * v[j][2] + v[j][3] * v[j][3]); }
            s = wave_sum(s);
            GAS unsigned long long* o8 = (GAS unsigned long long*)(XB + (size_t)m * D) + lane;
#pragma unroll
            for (int j = 0; j < 4; ++j) o8[64 * j] = (unsigned long long)pk2(v[j][0], v[j][1]) | ((unsigned long long)pk2(v[j][2], v[j][3]) << 32);
            if (lane < 16) ssp[(size_t)m * 32 + lane] = (lane == 0) ? s : 0.f;
        }
        {
            constexpr int PER = 120 * 256 / 4;
            constexpr int TOT = 2 * 2 * SB * PER;
            for (int i = bx * 512 + tid; i < TOT; i += G * 512) {
                const int kv = i / (2 * SB * PER), rem = i % (2 * SB * PER), jb = rem / PER, e = rem % PER;
                const f32x4 v = *((const f32x4*)(args.in[2 + kv] + (size_t)jb * 128 * 256 + 8 * 256) + e);
                *((f32x4*)(out + (kv ? O_VS : O_KS) + (size_t)jb * 128 * 256) + e) = v;
            }
        }
    }
    SEAM(0);

    for (int l = 0; l < 4; ++l) {
        const int pb = 1 + 5 * l, j = l >> 1;
        if ((l & 1) == 0) {
            if (EN_QKV && IN(pb)) {
                pg8::Gemm g{XB, (const bf16*)(ws + WS_WQKV) + (size_t)j * NQKV * D, M, NQKV, D}; pg8::StaticOrder S; S.init(M, NQKV, G, bx);
                pg8::EpiQKV E{Qb, Kb, Vb, ssp, 16, out + O_KP + (size_t)j * 2 * 128 * 256, out + O_VP + (size_t)j * 2 * 128 * 256, out + O_KS + (size_t)j * SB * 128 * 256, out + O_VS + (size_t)j * SB * 128 * 256};
                pg8::gemm_phase<pg8::EpiQKV, pg8::StaticOrder, true, true>(L, g, S, E);
            }
            SEAM(pb);
            if (EN_ATT && IN(pb + 1)) {
                FRESH_IDS;
                LAS float* qs = (LAS float*)(L + wave * 4096);
                LAS float* ps = qs + 256;
                const float* ck = args.in[2] + (size_t)j * SB * 128 * 256; const float* cv = args.in[3] + (size_t)j * SB * 128 * 256;
                const float* sinks = args.in[11] + j * 16;
                constexpr int NITEMS = (M / 8) * NKV;
                for (int item = vcu; item < NITEMS; item += G) {
                    const int tg = item >> 2, kvh = item & 3, m = tg * 8 + wave;
                    const bool samp = m >= MP;
                    const int b = samp ? ((m - MP) >> 3) : (m >> 13), t = samp ? ((m - MP) & 7) : (m & 8191);
                    { const uint2 qv = *(const uint2*)(Qb + (size_t)m * 1024 + kvh * 256 + 4 * lane);
                      f32x4 qf; qf[0] = bf_lo(qv.x); qf[1] = bf_hi(qv.x); qf[2] = bf_lo(qv.y); qf[3] = bf_hi(qv.y);
                      *(LAS f32x4*)(qs + 4 * lane) = qf; }
                    LDS_WAIT(); asm volatile("" ::: "memory");
                    float sc[4][3];
#pragma unroll
                    for (int p = 0; p < 3; ++p) {
                        const int jj = lane + 64 * p; const int dist = 128 - jj;
                        bool valid = jj <= 128; const bf16* pb_ = nullptr; const float* pf_ = nullptr;
                        if (!samp) { const int s = t - dist; valid = valid && (s >= 0); pb_ = Kb + (size_t)((b << 13) + s) * 256 + kvh * 64; }
                        else { const int jk = t + jj; if (jk < 128) pf_ = ck + ((size_t)b * 128 + jk) * 256 + kvh * 64; else pb_ = Kb + (size_t)(MP + b * 8 + (jk - 128)) * 256 + kvh * 64; }
                        float a0 = 0.f, a1 = 0.f, a2 = 0.f, a3 = 0.f;
                        if (valid) {
#pragma unroll 2
                            for (int i = 0; i < 8; ++i) {
                                float k8[8];
                                if (pf_) { const f32x4 u0 = *(const f32x4*)(pf_ + 8 * i), u1 = *(const f32x4*)(pf_ + 8 * i + 4);
                                    k8[0] = u0[0]; k8[1] = u0[1]; k8[2] = u0[2]; k8[3] = u0[3]; k8[4] = u1[0]; k8[5] = u1[1]; k8[6] = u1[2]; k8[7] = u1[3]; }
                                else { const v4u v = *(const v4u*)(pb_ + 8 * i);
                                    k8[0] = bf_lo(v.x); k8[1] = bf_hi(v.x); k8[2] = bf_lo(v.y); k8[3] = bf_hi(v.y); k8[4] = bf_lo(v.z); k8[5] = bf_hi(v.z); k8[6] = bf_lo(v.w); k8[7] = bf_hi(v.w); }
#define QDOT(acc_, hq_) do { const f32x4 qa = *(const LAS f32x4*)(qs + (hq_) * 64 + 8 * i), qb = *(const LAS f32x4*)(qs + (hq_) * 64 + 8 * i + 4); \
    acc_ = fmaf(qa[0], k8[0], acc_); acc_ = fmaf(qa[1], k8[1], acc_); acc_ = fmaf(qa[2], k8[2], acc_); acc_ = fmaf(qa[3], k8[3], acc_); \
    acc_ = fmaf(qb[0], k8[4], acc_); acc_ = fmaf(qb[1], k8[5], acc_); acc_ = fmaf(qb[2], k8[6], acc_); acc_ = fmaf(qb[3], k8[7], acc_); } while (0)
                                QDOT(a0, 0); QDOT(a1, 1); QDOT(a2, 2); QDOT(a3, 3);
#undef QDOT
                            }
                        }
                        const float fd = (float)dist; const int h0 = kvh * 4;
                        sc[0][p] = valid ? (a0 * 0.125f - exp2f(-0.5f * (float)(h0 + 1)) * fd) : -1e30f;
                        sc[1][p] = valid ? (a1 * 0.125f - exp2f(-0.5f * (float)(h0 + 2)) * fd) : -1e30f;
                        sc[2][p] = valid ? (a2 * 0.125f - exp2f(-0.5f * (float)(h0 + 3)) * fd) : -1e30f;
                        sc[3][p] = valid ? (a3 * 0.125f - exp2f(-0.5f * (float)(h0 + 4)) * fd) : -1e30f;
                    }
#pragma unroll
                    for (int hq = 0; hq < 4; ++hq) {
                        const float sink = sinks[kvh * 4 + hq];
                        const float mx = fmaxf(wave_max(fmaxf(fmaxf(sc[hq][0], sc[hq][1]), sc[hq][2])), sink);
                        const float e0 = __expf(sc[hq][0] - mx), e1 = __expf(sc[hq][1] - mx), e2 = __expf(sc[hq][2] - mx);
                        const float den = wave_sum(e0 + e1 + e2) + __expf(sink - mx);
                        const float inv = 1.0f / den;
                        ps[(lane) * 4 + hq] = e0 * inv; ps[(lane + 64) * 4 + hq] = e1 * inv; if (lane == 0) ps[128 * 4 + hq] = e2 * inv;
                    }
                    LDS_WAIT(); asm volatile("" ::: "memory");
                    float o0 = 0.f, o1 = 0.f, o2 = 0.f, o3 = 0.f;
                    const int jj0 = samp ? 0 : ((t < 128) ? (128 - t) : 0);
                    for (int jj = jj0; jj <= 128; ++jj) {
                        const f32x4 pv = *(const LAS f32x4*)(ps + 4 * jj);
                        float v;
                        if (!samp) v = bf_lo((unsigned)Vb[(size_t)((b << 13) + t - 128 + jj) * 256 + kvh * 64 + lane]);
                        else { const int jk = t + jj; v = (jk < 128) ? cv[((size_t)b * 128 + jk) * 256 + kvh * 64 + lane] : bf_lo((unsigned)Vb[(size_t)(MP + b * 8 + (jk - 128)) * 256 + kvh * 64 + lane]); }
                        o0 = fmaf(pv[0], v, o0); o1 = fmaf(pv[1], v, o1); o2 = fmaf(pv[2], v, o2); o3 = fmaf(pv[3], v, o3);
                    }
                    bf16* orow = Ob + (size_t)m * 1024 + kvh * 256 + lane;
                    orow[0] = (bf16)f2bf(o0); orow[64] = (bf16)f2bf(o1); orow[128] = (bf16)f2bf(o2); orow[192] = (bf16)f2bf(o3);
                    LDS_WAIT(); asm volatile("" ::: "memory");
                }
                __syncthreads();
            }
            SEAM(pb + 1);
            if (EN_OPJ && IN(pb + 2)) {
                pg8::Gemm g{Ob, (const bf16*)(ws + WS_WO) + (size_t)j * D * D, M, D, D}; pg8::StaticOrder S; S.init(M, D, G, bx);
                pg8::EpiRes E{(l == 0) ? x_p : out, (l == 0) ? x_s : out + (size_t)MP * D, out, XB, ssp};
                pg8::gemm_phase<pg8::EpiRes, pg8::StaticOrder, true, true>(L, g, S, E);
            }
            SEAM(pb + 2);
        } else {
            const SsmC sc{args.in[12] + (size_t)j * NG * NS, args.in[13] + (size_t)j * NG * NS, args.in[14] + (size_t)j * NG, args.in[15] + (size_t)j * NG * NS * GC, args.in[16] + (size_t)j * NG * NS * GC,
                          args.in[17] + (size_t)j * NG * GC * NS, args.in[18] + (size_t)j * NG * GC * NS, args.in[19] + (size_t)j * D, args.in[6] + (size_t)l * D};
            if (EN_S1 && IN(pb)) {
                FRESH_IDS; LAS float* xs = (LAS float*)(L + wave * 8192); LAS float* hb = xs + 1024;
                for (int u = gw; u < NB * (NCH - 1) * NG; u += NGW) {
                    const int g = u & 63, ch = (u >> 6) % (NCH - 1), b = (u >> 6) / (NCH - 1);
                    float hr = 0.f, hi_ = 0.f;
                    ssm_unit<false>(xs, hb, lane, g, sc, out, ssp, b * SEQ + ch * CH, CH, hr, hi_, nullptr);
                    *(float2*)(HS + ((size_t)((b * NCH + ch) * NG + g) * NS + lane) * 2) = make_float2(hr, hi_);
                }
                __syncthreads();
            }
            SEAM(pb);
            if (EN_S3 && IN(pb + 1)) {
                FRESH_IDS; LAS float* xs = (LAS float*)(L + wave * 8192); LAS float* hb = xs + 1024;
                for (int u = gw; u < NB * NCH * NG + SB * NG; u += NGW) {
                    if (u < NB * NCH * NG) {
                        const int g = u & 63, ch = (u >> 6) & (NCH - 1), b = u >> 11;
                        float abr, abi, cfr, cfi; ssm_abar(sc, g, lane, abr, abi, cfr, cfi);
                        float aLr = abr, aLi = abi;
#pragma unroll
                        for (int s = 0; s < 8; ++s) { const float tr = aLr * aLr - aLi * aLi, ti = 2.0f * aLr * aLi; aLr = tr; aLi = ti; }
                        float hr = 0.f, hi_ = 0.f;
                        for (int i = 0; i < ch; ++i) { const float2 e = *(const float2*)(HS + ((size_t)((b * NCH + i) * NG + g) * NS + lane) * 2);
                            const float tr = aLr * hr - aLi * hi_ + e.x, ti = aLr * hi_ + aLi * hr + e.y; hr = tr; hi_ = ti; }
                        ssm_unit<true>(xs, hb, lane, g, sc, out, ssp, b * SEQ + ch * CH, CH, hr, hi_, Ob);
                        if (ch == NCH - 1) { out[O_HRP + ((size_t)(j * NB + b) * NG + g) * NS + lane] = hr; out[O_HIP + ((size_t)(j * NB + b) * NG + g) * NS + lane] = hi_; }
                    } else {
                        const int us = u - NB * NCH * NG, g = us & 63, bs = us >> 6;
                        const size_t si = ((size_t)(j * SB + bs) * NG + g) * NS + lane;
                        float hr = args.in[4][si], hi_ = args.in[5][si];
                        ssm_unit<true>(xs, hb, lane, g, sc, out, ssp, MP + bs * ST, ST, hr, hi_, Ob);
                        out[O_HRS + si] = hr; out[O_HIS + si] = hi_;
                    }
                }
                __syncthreads();
            }
            SEAM(pb + 1);
            if (EN_GLU && IN(pb + 2)) {
                pg8::Gemm g{Ob, (const bf16*)(ws + WS_WGLU) + (size_t)j * 2 * D * D, M, 2 * D, D}; pg8::StaticOrder S; S.init(M, 2 * D, G, bx);
                pg8::EpiGlu E{out, XB, ssp};
                pg8::gemm_phase<pg8::EpiGlu, pg8::StaticOrder, true, true>(L, g, S, E);
            }
            SEAM(pb + 2);
        }
        if (EN_UP && IN(pb + 3)) {
            pg8::Gemm g{XB, (const bf16*)(ws + WS_WUP) + (size_t)l * FF * D, M, FF, D}; pg8::StaticOrder S; S.init(M, FF, G, bx);
            pg8::EpiUp E{Hb, ssp, (l & 1) ? 32 : 16};
            pg8::gemm_phase<pg8::EpiUp, pg8::StaticOrder, true, true>(L, g, S, E);
        }
        SEAM(pb + 3);
        if (EN_DN && IN(pb + 4)) {
            pg8::Gemm g{Hb, (const bf16*)(ws + WS_WDN) + (size_t)l * D * FF, M, D, FF}; pg8::StaticOrder S; S.init(M, D, G, bx);
            pg8::EpiRes E{out, out + (size_t)MP * D, out, XB, ssp};
            pg8::gemm_phase<pg8::EpiRes, pg8::StaticOrder, true, true>(L, g, S, E);
        }
        SEAM(pb + 4);
    }
    if (EN_FIN && IN(21)) {
        FRESH_IDS;
        const float* gf = args.in[8];
        for (int m = gw; m < M; m += NGW) {
            const float pv = (lane < 16) ? ssp[(size_t)m * 32 + lane] : 0.f;
            const float rinv = rsqrtf(wave_sum(pv) * (1.0f / 1024.0f) + 1e-6f);
            GAS f32x4* xr = (GAS f32x4*)(out + (size_t)m * D) + lane;
#pragma unroll
            for (int jx = 0; jx < 4; ++jx) { const f32x4 gv = *((const f32x4*)gf + 64 * jx + lane); f32x4 v = xr[64 * jx]; v = v * rinv * gv; xr[64 * jx] = v; }
        }
    }
#undef IN
#undef SEAM
}

#ifndef MK_SPLIT
#define MK_SPLIT 0
#endif
extern "C" void kernel_launch(void* const* d_in, const int* in_sizes, int n_in, void* d_out, int out_size, void* d_ws, size_t ws_size, hipStream_t stream) {
    static int grid = 0;
    if (grid == 0) {
        if (n_in != 23 || in_sizes[0] != MP * D || (size_t)out_size != O_END || ws_size < WS_END) { fprintf(stderr, "kernel_launch: unexpected shapes (n_in %d, in0 %d, out %d, ws %zu); nothing launched\n", n_in, n_in > 0 ? in_sizes[0] : -1, out_size, ws_size); grid = -1; return; }
        int dev = 0, cus = 0, per_cu = 0;
        if (hipGetDevice(&dev) != hipSuccess || hipDeviceGetAttribute(&cus, hipDeviceAttributeMultiprocessorCount, dev) != hipSuccess) { fprintf(stderr, "kernel_launch: device query failed\n"); grid = -1; return; }
        if (hipFuncSetAttribute((const void*)fwd_kernel, hipFuncAttributeMaxDynamicSharedMemorySize, LDS_BYTES) != hipSuccess) { fprintf(stderr, "kernel_launch: hipFuncSetAttribute failed\n"); grid = -1; return; }
        if (hipOccupancyMaxActiveBlocksPerMultiprocessor(&per_cu, (const void*)fwd_kernel, 512, LDS_BYTES) != hipSuccess || per_cu < 1) fprintf(stderr, "kernel_launch: note: occupancy query reports %d blocks per CU\n", per_cu);
        (void)hipGetLastError();
        grid = cus;
    }
    if (grid < 0) return;
    (void)hipMemsetAsync((char*)d_ws + WS_CTL, 0, CTL_ZERO_BYTES, stream);
    Args a{};
    for (int i = 0; i < 23; ++i) a.in[i] = (const float*)d_in[i];
    a.out = (float*)d_out; a.ws = (unsigned char*)d_ws;
#if MK_SPLIT
    for (int p = 0; p < NPHASE; ++p) { a.ph_lo = p; a.ph_hi = p + 1; hipLaunchKernelGGL(fwd_kernel, dim3(grid), dim3(512), LDS_BYTES, stream, a); }
#else
    a.ph_lo = 0; a.ph_hi = NPHASE; hipLaunchKernelGGL(fwd_kernel, dim3(grid), dim3(512), LDS_BYTES, stream, a);
#endif
}
```

```cpp
#include <hip/hip_runtime.h>
#include <cstdio>
#include <cstdint>
namespace pg8 {
#define PG8_LAS __attribute__((address_space(3)))
typedef unsigned short bf16_t;
typedef short bf16x8 __attribute__((ext_vector_type(8)));
typedef float f32x4 __attribute__((ext_vector_type(4)));
typedef unsigned u32x4 __attribute__((ext_vector_type(4)));
constexpr int BM = 256, BK = 64, HALF = 128, HTB = HALF * BK * 2  , STAGE_BYTES = 8 * HTB, NXCD = 8, WGM = 8;

__host__ __device__ __forceinline__ int lds_byte(int r, int c) { const int st = (r >> 4) * 2 + (c >> 5), rr = r & 15, cc = c & 31, ob = rr * 64 + cc * 2; return st * 1024 + (ob ^ (((ob >> 9) & 1) << 5)); }
__host__ __device__ __forceinline__ void stage_rc(int b, int& R, int& C) { const int st = b / 1024, sb = b % 1024, swz = sb ^ (((sb >> 9) & 1) << 5); R = (st >> 1) * 16 + swz / 64; C = (st & 1) * 32 + (swz % 64) / 2; }
__host__ __device__ __forceinline__ int perm32(int rho) { const int n = rho >> 4, i = rho & 15; return 8 * (i >> 2) + 4 * n + (i & 3); }

struct Unit { int pm, pn; };
struct Gemm { const bf16_t* A; const bf16_t* Bt; int M, N, K; };

struct StaticOrder {
    int nM, nN, nwg, G, c;
    __host__ __device__ void init(int M, int N, int G_, int c_) { nM = M / BM; nN = N / BM; nwg = nM * nN; G = G_; c = c_; }
    __host__ __device__ bool next(int i, Unit& u) const {
        const long L = (long)i * G + c; if (L >= nwg) return false;
        int wgid = (int)L; { const int q = nwg / NXCD, r = nwg % NXCD, xcd = wgid % NXCD, off = wgid / NXCD; wgid = (xcd < r ? xcd * (q + 1) : r * (q + 1) + (xcd - r) * q) + off; }
        const int nig = WGM * nN, gid = wgid / nig, fm = gid * WGM, gsz = (nM - fm) < WGM ? (nM - fm) : WGM;
        u.pm = fm + ((wgid % nig) % gsz); u.pn = (wgid % nig) / gsz; return true;
    }
    __device__ __forceinline__ void a_ready(const Unit&) const {}
    __device__ __forceinline__ void done(const Unit&) const {}
};
__device__ __forceinline__ unsigned cvt_pk_bf16(float lo, float hi) { unsigned r; asm volatile("v_cvt_pk_bf16_f32 %0, %1, %2" : "=v"(r) : "v"(lo), "v"(hi)); return r; }
typedef float f32x2 __attribute__((ext_vector_type(2)));
template <class Epi, class Sched, bool ALIGN_EPI = false, bool SP2 = false>
__device__ __forceinline__ void gemm_phase(PG8_LAS unsigned char* lds, const Gemm g, const Sched& S, const Epi& E) {
    int tid_ = threadIdx.x; asm volatile("" : "+v"(tid_));
    const int tid = tid_, wid = __builtin_amdgcn_readfirstlane(tid >> 6), lane = tid & 63, wr = wid >> 2, wc = wid & 3, fr = lane & 15, fq = lane >> 4;
    const int K = g.K, nt = K / BK;
    unsigned voffA[2], voffB[2];
#pragma unroll
    for (int i = 0; i < 2; ++i) { int R, C; stage_rc(tid * 16 + i * 8192, R, C); const int Rb = Epi::PERM ? ((R & ~31) + perm32(R & 31)) : R;
        voffA[i] = (unsigned)(R * K + C) * 2u; voffB[i] = (unsigned)(Rb * K + C) * 2u; }
    const size_t kstep = (size_t)(BK * 2);
    const size_t hstep = (size_t)HALF * K * 2;
    const size_t tstep = 2 * hstep;
    const unsigned ldsw = (unsigned)wid * 1024u;
    const int aoff = lds_byte(wr * 64 + fr, fq * 8), boff = lds_byte(wc * 32 + fr, fq * 8);
#define PG8_SA(b, h) (((b) * 2 + (h)) * HTB)
#define PG8_SB(b, h) ((4 + (b) * 2 + (h)) * HTB)
#define PG8_STAGE(bufoff, gbase, voff) do { _Pragma("unroll") for (int _i = 0; _i < 2; ++_i) \
        __builtin_amdgcn_global_load_lds((const unsigned*)((const char*)(gbase) + (voff)[_i]), (PG8_LAS unsigned*)(lds + (bufoff) + ldsw + _i * 8192), 16, 0, 0); } while (0)
#define PG8_LDA(dst, b, h) do { _Pragma("unroll") for (int m = 0; m < 4; ++m) _Pragma("unroll") for (int k = 0; k < 2; ++k) dst[m][k] = *(const PG8_LAS bf16x8*)(lds + PG8_SA(b, h) + aoff + m * 2048 + k * 1024); } while (0)
#define PG8_LDB(dst, b, h) do { _Pragma("unroll") for (int n = 0; n < 2; ++n) _Pragma("unroll") for (int k = 0; k < 2; ++k) dst[n][k] = *(const PG8_LAS bf16x8*)(lds + PG8_SB(b, h) + boff + n * 2048 + k * 1024); } while (0)
#define PG8_MMA(ai, bj, At, Bt) do { __builtin_amdgcn_s_setprio(1); _Pragma("unroll") for (int m = 0; m < 4; ++m) _Pragma("unroll") for (int n = 0; n < 2; ++n) _Pragma("unroll") for (int k = 0; k < 2; ++k) \
        acc[ai][bj][m][n] = __builtin_amdgcn_mfma_f32_16x16x32_bf16(Bt[n][k], At[m][k], acc[ai][bj][m][n], 0, 0, 0); __builtin_amdgcn_s_setprio(0); } while (0)
#define PG8_WAIT_V(n) asm volatile("s_waitcnt vmcnt(" #n ")" ::: "memory")
#define PG8_WAIT_L(n) asm volatile("s_waitcnt lgkmcnt(" #n ")" ::: "memory")
#define PG8_BAR __builtin_amdgcn_s_barrier()
#define PG8_SCHED __builtin_amdgcn_sched_barrier(0)
    Unit cur, nxt; int ui = 0;
    if (!S.next(0, cur)) return;
    f32x4 acc[2][2][4][2];
#pragma unroll
    for (int a = 0; a < 2; ++a)
#pragma unroll
        for (int b = 0; b < 2; ++b)
#pragma unroll
            for (int m = 0; m < 4; ++m)
#pragma unroll
                for (int n = 0; n < 2; ++n) acc[a][b][m][n] = (f32x4){0.f, 0.f, 0.f, 0.f};
    bf16x8 At[4][2], B0[2][2], B1[2][2];
    const char* cA = (const char*)g.A + (size_t)cur.pm * tstep; const char* cB = (const char*)g.Bt + (size_t)cur.pn * tstep;
    S.a_ready(cur);
    if constexpr (SP2) {
        PG8_STAGE(PG8_SB(0, 0), cB, voffB); PG8_STAGE(PG8_SB(0, 1), cB + hstep, voffB); PG8_STAGE(PG8_SA(0, 0), cA, voffA); PG8_STAGE(PG8_SA(0, 1), cA + hstep, voffA);
        if (wr == 1) PG8_BAR;
        PG8_WAIT_V(2); PG8_BAR;
        PG8_STAGE(PG8_SB(1, 0), cB + kstep, voffB); PG8_STAGE(PG8_SA(1, 0), cA + kstep, voffA); PG8_STAGE(PG8_SB(1, 1), cB + hstep + kstep, voffB);
        PG8_WAIT_V(6); PG8_BAR;
    } else {
        PG8_STAGE(PG8_SB(0, 0), cB, voffB); PG8_STAGE(PG8_SA(0, 0), cA, voffA); PG8_STAGE(PG8_SB(0, 1), cB + hstep, voffB); PG8_STAGE(PG8_SA(0, 1), cA + hstep, voffA);
        if (wr == 1) PG8_BAR;
        PG8_WAIT_V(4); PG8_BAR;
        PG8_STAGE(PG8_SB(1, 0), cB + kstep, voffB); PG8_STAGE(PG8_SA(1, 0), cA + kstep, voffA); PG8_STAGE(PG8_SB(1, 1), cB + hstep + kstep, voffB);
        PG8_WAIT_V(6); PG8_BAR;
    }
    for (;;) {
        const bool has_next = S.next(ui + 1, nxt);
        const char* nA = has_next ? (const char*)g.A + (size_t)nxt.pm * tstep : cA; const char* nB = has_next ? (const char*)g.Bt + (size_t)nxt.pn * tstep : cB;
        for (int t = 0; t < nt; t += 2) {
            const bool last = (t == nt - 2);
            const char* a1 = cA + (size_t)(t + 1) * kstep;
            const char* a2 = last ? nA : cA + (size_t)(t + 2) * kstep; const char* b2 = last ? nB : cB + (size_t)(t + 2) * kstep;
            const char* a3 = a2 + kstep; const char* b3 = b2 + kstep;
            if (last && has_next) S.a_ready(nxt);
            if constexpr (SP2) {
            PG8_LDB(B0, 0, 0); PG8_LDB(B1, 0, 1); PG8_SCHED; PG8_LDA(At, 0, 0); PG8_STAGE(PG8_SA(1, 1), a1 + hstep, voffA);
            PG8_WAIT_V(8); PG8_WAIT_L(0); PG8_BAR; PG8_MMA(0, 0, At, B0); PG8_MMA(0, 1, At, B1); PG8_BAR; PG8_SCHED;
            PG8_LDA(At, 0, 1); PG8_STAGE(PG8_SB(0, 0), b2, voffB); PG8_STAGE(PG8_SB(0, 1), b2 + hstep, voffB); PG8_STAGE(PG8_SA(0, 0), a2, voffA);
            PG8_WAIT_V(8); PG8_WAIT_L(0); PG8_BAR; PG8_MMA(1, 0, At, B0); PG8_MMA(1, 1, At, B1); PG8_BAR; PG8_SCHED;
            PG8_LDB(B0, 1, 0); PG8_LDB(B1, 1, 1); PG8_SCHED; PG8_LDA(At, 1, 0); PG8_STAGE(PG8_SA(0, 1), a2 + hstep, voffA);
            PG8_WAIT_V(8); PG8_WAIT_L(0); PG8_BAR; PG8_MMA(0, 0, At, B0); PG8_MMA(0, 1, At, B1); PG8_BAR; PG8_SCHED;
            PG8_LDA(At, 1, 1); PG8_STAGE(PG8_SB(1, 0), b3, voffB); PG8_STAGE(PG8_SB(1, 1), b3 + hstep, voffB); PG8_STAGE(PG8_SA(1, 0), a3, voffA);
            PG8_WAIT_V(8); PG8_WAIT_L(0); PG8_BAR; PG8_MMA(1, 0, At, B0); PG8_MMA(1, 1, At, B1); PG8_BAR; PG8_SCHED;
            } else {
            PG8_LDB(B0, 0, 0); PG8_SCHED; PG8_LDA(At, 0, 0); PG8_STAGE(PG8_SA(1, 1), a1 + hstep, voffA);
            PG8_WAIT_L(8); PG8_BAR; PG8_WAIT_L(0); PG8_MMA(0, 0, At, B0); PG8_BAR; PG8_SCHED;
            PG8_LDB(B1, 0, 1); PG8_STAGE(PG8_SB(0, 0), b2, voffB);
            PG8_BAR; PG8_WAIT_L(0); PG8_MMA(0, 1, At, B1); PG8_BAR;
            PG8_LDA(At, 0, 1); PG8_STAGE(PG8_SA(0, 0), a2, voffA);
            PG8_BAR; PG8_WAIT_L(0); PG8_MMA(1, 0, At, B0); PG8_BAR; PG8_SCHED;
            PG8_STAGE(PG8_SB(0, 1), b2 + hstep, voffB);
            PG8_WAIT_V(6); PG8_BAR; PG8_MMA(1, 1, At, B1); PG8_BAR;
            PG8_LDB(B0, 1, 0); PG8_SCHED; PG8_LDA(At, 1, 0); PG8_STAGE(PG8_SA(0, 1), a2 + hstep, voffA);
            PG8_WAIT_L(8); PG8_BAR; PG8_WAIT_L(0); PG8_MMA(0, 0, At, B0); PG8_BAR; PG8_SCHED;
            PG8_LDB(B1, 1, 1); PG8_STAGE(PG8_SB(1, 0), b3, voffB);
            PG8_BAR; PG8_WAIT_L(0); PG8_MMA(0, 1, At, B1); PG8_BAR;
            PG8_LDA(At, 1, 1); PG8_STAGE(PG8_SA(1, 0), a3, voffA);
            PG8_BAR; PG8_WAIT_L(0); PG8_MMA(1, 0, At, B0); PG8_BAR; PG8_SCHED;
            PG8_STAGE(PG8_SB(1, 1), b3 + hstep, voffB);
            PG8_WAIT_V(6); PG8_BAR; PG8_MMA(1, 1, At, B1); PG8_BAR;
            }
        }
        if constexpr (ALIGN_EPI) { if (wr == 0) PG8_BAR; }
        if constexpr (!Epi::AFTER_DRAIN) { E(acc, cur, wr, wc, fr, fq); S.done(cur); }
        if (!has_next) break;
#pragma unroll
        for (int a = 0; a < 2; ++a)
#pragma unroll
            for (int b = 0; b < 2; ++b)
#pragma unroll
                for (int m = 0; m < 4; ++m)
#pragma unroll
                    for (int n = 0; n < 2; ++n) acc[a][b][m][n] = (f32x4){0.f, 0.f, 0.f, 0.f};
        cur = nxt; cA = nA; cB = nB; ++ui;
        if constexpr (ALIGN_EPI) { if (wr == 1) PG8_BAR; }
    }
    PG8_WAIT_V(0);
    if constexpr (!ALIGN_EPI) { if (wr == 0) PG8_BAR; }
    PG8_BAR;
    if constexpr (Epi::AFTER_DRAIN) { E.fused(acc, cur, wr, wc, fr, fq, lds, wid, lane); S.done(cur); }
#undef PG8_SA
#undef PG8_SB
#undef PG8_STAGE
#undef PG8_LDA
#undef PG8_LDB
#undef PG8_MMA
#undef PG8_WAIT_V
#undef PG8_WAIT_L
#undef PG8_BAR
#undef PG8_SCHED
}
}
#define GAS __attribute__((address_space(1)))
#define LAS __attribute__((address_space(3)))
typedef unsigned short bf16;
typedef unsigned v4u __attribute__((ext_vector_type(4)));
typedef float f32x4 __attribute__((ext_vector_type(4)));
typedef short bf16x8 __attribute__((ext_vector_type(8)));
typedef GAS unsigned gu32;
typedef GAS unsigned long long gu64;
#define RLX_AGENT __ATOMIC_RELAXED, __HIP_MEMORY_SCOPE_AGENT
#define LDS_WAIT() asm volatile("s_waitcnt lgkmcnt(0)" ::: "memory")
#define VM_WAIT() asm volatile("s_waitcnt vmcnt(0)" ::: "memory")
__device__ __forceinline__ unsigned long long rt() { return __builtin_amdgcn_s_memrealtime(); }
__device__ __forceinline__ unsigned f2bf(float f) { unsigned u = __builtin_bit_cast(unsigned, f); return (u + 0x7fffu + ((u >> 16) & 1u)) >> 16; }
__device__ __forceinline__ unsigned pk2(float lo, float hi) { return f2bf(lo) | (f2bf(hi) << 16); }
#define XB_TMO      128
#define XB_XCNT(j)  (256  + 64 * (j))
#define XB_XSUB(j)  (1280 + 64 * (j))
#define XB_XGEN(j)  (2304 + 64 * (j))
#define XB_TOP      3328
#define XB_TOPGEN   3392
#define XCD_BAR_WORDS 3456
#define XB_SPIN_CAP (1u << 18)

__device__ __forceinline__ unsigned xb_ld(unsigned* p)              { return __hip_atomic_load(p, __ATOMIC_RELAXED, __HIP_MEMORY_SCOPE_AGENT); }
__device__ __forceinline__ unsigned xb_add(unsigned* p, unsigned v) { return __hip_atomic_fetch_add(p, v, __ATOMIC_RELAXED, __HIP_MEMORY_SCOPE_AGENT); }
__device__ __forceinline__ unsigned xb_xcc_id() { return (unsigned)__builtin_amdgcn_s_getreg((3 << 11) | 20) & 0xFu; }
#define XB_SPIN(cond, bar) do { unsigned _sp = 0; while (cond) { __builtin_amdgcn_s_sleep(1); \
    if ((++_sp & 255u) == 0u) { if (xb_ld(&(bar)[XB_TMO])) break; if (_sp > XB_SPIN_CAP) { atomicAdd(&(bar)[XB_TMO], 1u); break; } } } } while (0)

struct XcdBarrier {
    unsigned* bar; unsigned x;
    volatile LAS unsigned* st;
};

__device__ __forceinline__ XcdBarrier xcd_barrier_post(unsigned* bar, volatile LAS unsigned* st) {
    XcdBarrier b; b.bar = bar; b.x = xb_xcc_id(); b.st = st;
    if (threadIdx.x == 0) (void)xb_add(&bar[XB_XCNT(b.x)], 1u);
    return b;
}
__device__ __forceinline__ void xcd_barrier_complete(unsigned* bar, unsigned x, unsigned& nloc, unsigned& nx) {
    const unsigned G = gridDim.x * gridDim.y * gridDim.z;
    unsigned sum, cnt, mine, sp = 0u;
    for (;;) {
        sum = 0u; cnt = 0u; mine = 0u;
#pragma unroll
        for (unsigned j = 0; j < 16; ++j) { const unsigned c = xb_ld(&bar[XB_XCNT(j)]); sum += c; cnt += (c > 0u) ? 1u : 0u; mine = (j == x) ? c : mine; }
        if (sum == G) break;
        __builtin_amdgcn_s_sleep(1);
        if ((++sp & 255u) == 0u) { if (xb_ld(&bar[XB_TMO])) break; if (sp > XB_SPIN_CAP) { atomicAdd(&bar[XB_TMO], 1u); break; } }
    }
    nloc = mine > 0u ? mine : 1u; nx = cnt > 0u ? cnt : 1u;
}

__device__ __forceinline__ void xcd_barrier(const XcdBarrier& b) {
    asm volatile("s_waitcnt vmcnt(0)" ::: "memory");
    __syncthreads();
    if (threadIdx.x == 0) {
        unsigned* bar = b.bar;
        __builtin_amdgcn_s_waitcnt(0);
        unsigned nloc = b.st[0], nx = b.st[1];
        if (nloc == 0u) { xcd_barrier_complete(bar, b.x, nloc, nx); b.st[0] = nloc; b.st[1] = nx; }
        const unsigned old = xb_add(&bar[XB_XSUB(b.x)], 1u);
        const unsigned gen = old / nloc;
        if (old + 1u == (gen + 1u) * nloc) {
            __builtin_amdgcn_fence(__ATOMIC_RELEASE, "agent");
            asm volatile("s_waitcnt vmcnt(0)" ::: "memory");
            const unsigned og = xb_add(&bar[XB_TOP], 1u);
            const unsigned tg = og / nx;
            if (og + 1u == (tg + 1u) * nx) xb_add(&bar[XB_TOPGEN], 1u);
            else XB_SPIN(xb_ld(&bar[XB_TOPGEN]) == tg, bar);
            __builtin_amdgcn_fence(__ATOMIC_ACQUIRE, "agent");
            xb_add(&bar[XB_XGEN(b.x)], 1u);
            asm volatile("s_waitcnt vmcnt(0)" ::: "memory");
        } else {
            XB_SPIN(xb_ld(&bar[XB_XGEN(b.x)]) == gen, bar);
            __builtin_amdgcn_fence(__ATOMIC_ACQUIRE, "agent");
            asm volatile("s_waitcnt vmcnt(0)" ::: "memory");
        }
    }
    __syncthreads();
}

constexpr int D = 1024, SEQ = 8192, NB = 2, MP = NB * SEQ, SB = 128, ST = 8, MS = SB * ST, M = MP + MS;
constexpr int NQKV = 1536, FF = 4096, NKV = 4, HD = 64, KVW = NKV * HD, NG = 64, GC = 16, NS = 64;
constexpr int CH = 256, NCH = SEQ / CH;
constexpr int NPHASE = 22;
constexpr size_t O_KP = 17825792, O_VP = 17956864, O_HRP = 18087936, O_HIP = 18104320, O_KS = 18120704, O_VS = 26509312, O_HRS = 34897920, O_HIS = 35946496, O_END = 36995072;
constexpr size_t MiB = 1u << 20;
constexpr size_t WS_CTL = 0, CTL_ZERO_BYTES = 64 * 1024;
constexpr size_t WS_SSP = 1 * MiB;
constexpr size_t WS_HS = 4 * MiB;
constexpr size_t WS_WQKV = 8 * MiB, WS_WO = 14 * MiB, WS_WGLU = 18 * MiB, WS_WUP = 26 * MiB, WS_WDN = 58 * MiB;
constexpr size_t WS_XB = 90 * MiB;
constexpr size_t WS_H = 124 * MiB;
constexpr size_t WS_Q = 124 * MiB, WS_K = 158 * MiB, WS_V = 167 * MiB, WS_O = 176 * MiB;
constexpr size_t WS_END = 260 * MiB;
constexpr int CW_BAR = 4096;
static_assert((CW_BAR + XCD_BAR_WORDS) * 4 <= (int)CTL_ZERO_BYTES, "barrier words inside the memset region");
constexpr int RING_BYTES = 131072, LDSCTL_OFF = RING_BYTES, MISC_OFF = LDSCTL_OFF + 320, LDS_BYTES = 147456;

__device__ __forceinline__ float wave_sum(float v) {
#pragma unroll
    for (int o = 1; o < 64; o <<= 1) v += __shfl_xor(v, o);
    return v;
}
__device__ __forceinline__ float wave_max(float v) {
#pragma unroll
    for (int o = 1; o < 64; o <<= 1) v = fmaxf(v, __shfl_xor(v, o));
    return v;
}
__device__ __forceinline__ float bf_lo(unsigned u) { return __uint_as_float(u << 16); }
__device__ __forceinline__ float bf_hi(unsigned u) { return __uint_as_float(u & 0xffff0000u); }

namespace pg8 {
__device__ __forceinline__ float row_rinv(const float* ssp, int row, int np, int fq) {
    const float* p = ssp + (size_t)row * 32;
    const f32x4 v = *(const f32x4*)(p + 4 * fq); float s = (v[0] + v[1]) + (v[2] + v[3]);
    if (np == 32) { const f32x4 w = *(const f32x4*)(p + 16 + 4 * fq); s += (w[0] + w[1]) + (w[2] + w[3]); }
    s += __shfl_xor(s, 16); s += __shfl_xor(s, 32);
    return rsqrtf(s * (1.0f / 1024.0f) + 1e-6f);
}
__device__ __forceinline__ u32x4 pack8(const f32x4 a, const f32x4 b) { u32x4 w; w.x = cvt_pk_bf16(a[0], a[1]); w.y = cvt_pk_bf16(a[2], a[3]); w.z = cvt_pk_bf16(b[0], b[1]); w.w = cvt_pk_bf16(b[2], b[3]); return w; }

struct EpiQKV {
    static constexpr bool PERM = true, AFTER_DRAIN = false;
    bf16_t *Q, *K, *V; const float* ssp; int np; float *kp, *vp, *ks, *vs;
    __device__ __forceinline__ void operator()(const f32x4 (&acc)[2][2][4][2], const Unit& u, int wr, int wc, int fr, int fq) const {
        const int rowb = u.pm * BM + wr * 64 + fr, pn = u.pn;
#pragma unroll
        for (int ai = 0; ai < 2; ++ai)
#pragma unroll
            for (int m = 0; m < 4; ++m) {
                const int row = rowb + ai * HALF + m * 16;
                const float r = row_rinv(ssp, row, np, fq);
#pragma unroll
                for (int bj = 0; bj < 2; ++bj) {
                    const f32x4 v0 = acc[ai][bj][m][0] * r, v1 = acc[ai][bj][m][1] * r;
                    const int cl = bj * HALF + wc * 32 + 8 * fq;
                    const u32x4 w = pack8(v0, v1);
                    if (pn < 4) { *(u32x4*)(Q + (size_t)row * 1024 + pn * 256 + cl) = w; }
                    else {
                        bf16_t* B = (pn == 4) ? K : V;
                        *(u32x4*)(B + (size_t)row * 256 + cl) = w;
                        float* o = nullptr;
                        if (row >= 16384) { const int rs = row - 16384; o = ((pn == 4) ? ks : vs) + ((size_t)(rs >> 3) * 128 + 120 + (rs & 7)) * 256 + cl; }
                        else { const int t = row & 8191; if (t >= 8064) o = ((pn == 4) ? kp : vp) + ((size_t)(row >> 13) * 128 + (t - 8064)) * 256 + cl; }
                        if (o) { *(f32x4*)o = v0; *(f32x4*)(o + 4) = v1; }
                    }
                }
            }
    }
};
struct EpiRes {
    static constexpr bool PERM = true, AFTER_DRAIN = false;
    const float* xp; const float* xs; float* XR; bf16_t* XB; float* ssp;
    __device__ __forceinline__ void operator()(const f32x4 (&acc)[2][2][4][2], const Unit& u, int wr, int wc, int fr, int fq) const {
        const int rowb = u.pm * BM + wr * 64 + fr, pn = u.pn;
#pragma unroll
        for (int ai = 0; ai < 2; ++ai)
#pragma unroll
            for (int m = 0; m < 4; ++m) {
                const int row = rowb + ai * HALF + m * 16;
                const float* old = (row < 16384) ? xp + (size_t)row * 1024 : xs + (size_t)(row - 16384) * 1024;
                float ss = 0.f;
#pragma unroll
                for (int bj = 0; bj < 2; ++bj) {
                    const int col = pn * 256 + bj * HALF + wc * 32 + 8 * fq;
                    const f32x4 o0 = *(const f32x4*)(old + col), o1 = *(const f32x4*)(old + col + 4);
                    const f32x4 v0 = acc[ai][bj][m][0] + o0, v1 = acc[ai][bj][m][1] + o1;
                    *(f32x4*)(XR + (size_t)row * 1024 + col) = v0; *(f32x4*)(XR + (size_t)row * 1024 + col + 4) = v1;
                    *(u32x4*)(XB + (size_t)row * 1024 + col) = pack8(v0, v1);
                    ss += (v0[0] * v0[0] + v0[1] * v0[1]) + (v0[2] * v0[2] + v0[3] * v0[3]) + (v1[0] * v1[0] + v1[1] * v1[1]) + (v1[2] * v1[2] + v1[3] * v1[3]);
                }
                ss += __shfl_xor(ss, 16); ss += __shfl_xor(ss, 32);
                if (fq == 0) ssp[(size_t)row * 32 + pn * 4 + wc] = ss;
            }
    }
};
struct EpiGlu {
    static constexpr bool PERM = true, AFTER_DRAIN = false;
    float* XR; bf16_t* XB; float* ssp;
    __device__ __forceinline__ void operator()(const f32x4 (&acc)[2][2][4][2], const Unit& u, int wr, int wc, int fr, int fq) const {
        const int rowb = u.pm * BM + wr * 64 + fr, pn = u.pn;
#pragma unroll
        for (int ai = 0; ai < 2; ++ai)
#pragma unroll
            for (int m = 0; m < 4; ++m) {
                const int row = rowb + ai * HALF + m * 16;
                const int col = pn * 128 + wc * 32 + 8 * fq;
                float* xr = XR + (size_t)row * 1024 + col;
                const f32x4 o0 = *(const f32x4*)xr, o1 = *(const f32x4*)(xr + 4);
                f32x4 v0, v1;
#pragma unroll
                for (int e = 0; e < 4; ++e) {
                    v0[e] = o0[e] + acc[ai][0][m][0][e] * (1.0f / (1.0f + __expf(-acc[ai][1][m][0][e])));
                    v1[e] = o1[e] + acc[ai][0][m][1][e] * (1.0f / (1.0f + __expf(-acc[ai][1][m][1][e])));
                }
                *(f32x4*)xr = v0; *(f32x4*)(xr + 4) = v1;
                *(u32x4*)(XB + (size_t)row * 1024 + col) = pack8(v0, v1);
                float ss = (v0[0] * v0[0] + v0[1] * v0[1]) + (v0[2] * v0[2] + v0[3] * v0[3]) + (v1[0] * v1[0] + v1[1] * v1[1]) + (v1[2] * v1[2] + v1[3] * v1[3]);
                ss += __shfl_xor(ss, 16); ss += __shfl_xor(ss, 32);
                if (fq == 0) ssp[(size_t)row * 32 + pn * 4 + wc] = ss;
            }
    }
};
struct EpiUp {
    static constexpr bool PERM = true, AFTER_DRAIN = false;
    bf16_t* H; const float* ssp; int np;
    __device__ __forceinline__ void operator()(const f32x4 (&acc)[2][2][4][2], const Unit& u, int wr, int wc, int fr, int fq) const {
        const int rowb = u.pm * BM + wr * 64 + fr, pn = u.pn;
#pragma unroll
        for (int ai = 0; ai < 2; ++ai)
#pragma unroll
            for (int m = 0; m < 4; ++m) {
                const int row = rowb + ai * HALF + m * 16;
                const float r = row_rinv(ssp, row, np, fq);
#pragma unroll
                for (int bj = 0; bj < 2; ++bj) {
                    f32x4 v0 = acc[ai][bj][m][0] * r, v1 = acc[ai][bj][m][1] * r;
#pragma unroll
                    for (int e = 0; e < 4; ++e) { const float a = fmaxf(v0[e], 0.f), b = fmaxf(v1[e], 0.f); v0[e] = a * a; v1[e] = b * b; }
                    *(u32x4*)(H + (size_t)row * 4096 + pn * 256 + bj * HALF + wc * 32 + 8 * fq) = pack8(v0, v1);
                }
            }
    }
};
}

__device__ __forceinline__ void p0_transpose_item(const float* W, int K, int N, const float* gain, bf16* WT, int glu, LAS float* scr, int item, int lane) {
    const int nblk = N / 32, kb = item / nblk, nb = item % nblk, k0 = 64 * kb, n0 = 32 * nb;
#pragma unroll 8
    for (int i = 0; i < 32; ++i) { const int kk = 2 * i + (lane >> 5); float w = W[(size_t)(k0 + kk) * N + n0 + (lane & 31)]; if (gain) w *= gain[k0 + kk]; scr[kk * 33 + (lane & 31)] = w; }
    LDS_WAIT(); asm volatile("" ::: "memory");
    int drow0 = n0; if (glu) { const int bj = n0 / 1024, rem = n0 % 1024; drow0 = (rem / 128) * 256 + bj * 128 + (rem % 128); }
    const int c = lane & 7;
#pragma unroll
    for (int j = 0; j < 4; ++j) { const int n = (lane >> 3) + 8 * j; const LAS float* s = scr + (8 * c) * 33 + n;
        v4u o; o.x = pk2(s[0 * 33], s[1 * 33]); o.y = pk2(s[2 * 33], s[3 * 33]); o.z = pk2(s[4 * 33], s[5 * 33]); o.w = pk2(s[6 * 33], s[7 * 33]);
        *(GAS v4u*)(WT + (size_t)(drow0 + n) * K + k0 + 8 * c) = o; }
    LDS_WAIT(); asm volatile("" ::: "memory");
}

__device__ __forceinline__ void sincos_rr(float x, float& s, float& c) {
    const float q = rintf(x * 0.63661977236758f);
    float r = fmaf(-q, 1.57079637050629f, x); r = fmaf(-q, -4.37113882867379e-8f, r);
    const float r2 = r * r;
    const float sp = r + r * r2 * (-1.6666667163e-1f + r2 * (8.3333337680e-3f + r2 * (-1.9841270114e-4f + r2 * 2.7557314297e-6f)));
    const float cp = 1.0f + r2 * (-0.5f + r2 * (4.1666667908e-2f + r2 * (-1.3888889225e-3f + r2 * (2.4801587642e-5f + r2 * -2.7557314297e-7f))));
    const int qi = (int)q & 3;
    s = (qi == 0) ? sp : (qi == 1) ? cp : (qi == 2) ? -sp : -cp;
    c = (qi == 0) ? cp : (qi == 1) ? -sp : (qi == 2) ? -cp : sp;
}

typedef float f32x16 __attribute__((ext_vector_type(16)));
typedef unsigned u32x2 __attribute__((ext_vector_type(2)));
struct SsmC { const float *A_re, *A_im, *log_dt, *B_re, *B_im, *C_re, *C_im, *Dk, *gain; };
__device__ __forceinline__ void ssm_abar(const SsmC& c, int g, int n, float& abr, float& abi, float& cfr, float& cfi) {
    const float dt = expf(c.log_dt[g]);
    const float ar = c.A_re[g * 64 + n], ai = c.A_im[g * 64 + n];
    const float mag = expf(dt * ar); float sn, cs; sincos_rr(dt * ai, sn, cs);
    abr = mag * cs; abi = mag * sn;
    const float den = ar * ar + ai * ai, nr = abr - 1.0f;
    cfr = (nr * ar + abi * ai) / den; cfi = (abi * ar - nr * ai) / den;
}
__device__ __forceinline__ float gelu_tanh(float y) {
    const float z = 0.7978845608028654f * (y + 0.044715f * y * y * y);
    return y / (1.0f + __expf(-2.0f * z));
}
template <bool FULL>
__device__ __forceinline__ void ssm_unit(LAS float* xs, LAS float* hb, int lane, int g, const SsmC& c, const float* XR, const float* ssp, int row0, int L, float& hr, float& hi, bf16* Gout) {
    float abr, abi, cfr, cfi; ssm_abar(c, g, lane, abr, abi, cfr, cfi);
    float Br[16], Bi[16];
#pragma unroll
    for (int c4 = 0; c4 < 4; ++c4) {
        const f32x4 br = *(const f32x4*)(c.B_re + ((size_t)g * 64 + lane) * 16 + 4 * c4), bi = *(const f32x4*)(c.B_im + ((size_t)g * 64 + lane) * 16 + 4 * c4), gn = *(const f32x4*)(c.gain + g * 16 + 4 * c4);
#pragma unroll
        for (int e = 0; e < 4; ++e) { Br[4 * c4 + e] = (cfr * br[e] - cfi * bi[e]) * gn[e]; Bi[4 * c4 + e] = (cfr * bi[e] + cfi * br[e]) * gn[e]; }
    }
    const int cc = lane & 15, q = lane >> 4;
    float Cq[32]; float Dg = 0.f;
    if (FULL) {
        const float* src = ((q < 2) ? c.C_re : c.C_im) + ((size_t)g * 16 + cc) * 64 + 32 * (q & 1); const float sg = (q < 2) ? 1.0f : -1.0f;
#pragma unroll
        for (int i4 = 0; i4 < 8; ++i4) { const f32x4 v = *(const f32x4*)(src + 4 * i4);
#pragma unroll
            for (int e = 0; e < 4; ++e) Cq[4 * i4 + e] = sg * v[e]; }
        Dg = c.Dk[g * 16 + cc] * c.gain[g * 16 + cc];
    }
    for (int t0 = 0; t0 < L; t0 += 64) {
        const int cnt = (L - t0) < 64 ? (L - t0) : 64;
        if (lane < cnt) {
            const int row = row0 + t0 + lane;
            const float* sp = ssp + (size_t)row * 32;
            const f32x4 s0 = *(const f32x4*)sp, s1 = *(const f32x4*)(sp + 4), s2 = *(const f32x4*)(sp + 8), s3 = *(const f32x4*)(sp + 12);
            const float ss = ((s0[0] + s0[1]) + (s0[2] + s0[3])) + ((s1[0] + s1[1]) + (s1[2] + s1[3])) + ((s2[0] + s2[1]) + (s2[2] + s2[3])) + ((s3[0] + s3[1]) + (s3[2] + s3[3]));
            const float rinv = rsqrtf(ss * (1.0f / 1024.0f) + 1e-6f);
            const float* xr = XR + (size_t)row * 1024 + g * 16;
#pragma unroll
            for (int c4 = 0; c4 < 4; ++c4) { const f32x4 v = *(const f32x4*)(xr + 4 * c4); *(LAS f32x4*)(xs + lane * 16 + 4 * c4) = v * rinv; }
        }
        LDS_WAIT(); asm volatile("" ::: "memory");
        float ykeep = 0.f;
        for (int tt = 0; tt < cnt; ++tt) {
            float inr = 0.f, ini = 0.f;
#pragma unroll
            for (int c4 = 0; c4 < 4; ++c4) { const f32x4 xv = *(const LAS f32x4*)(xs + tt * 16 + 4 * c4);
#pragma unroll
                for (int e = 0; e < 4; ++e) { inr = fmaf(xv[e], Br[4 * c4 + e], inr); ini = fmaf(xv[e], Bi[4 * c4 + e], ini); } }
            const float nhr = abr * hr - abi * hi + inr, nhi = abr * hi + abi * hr + ini; hr = nhr; hi = nhi;
            if (FULL) {
                hb[lane] = hr; hb[64 + lane] = hi;
                LDS_WAIT(); asm volatile("" ::: "memory");
                float part = 0.f;
#pragma unroll
                for (int i4 = 0; i4 < 8; ++i4) { const f32x4 hv = *(const LAS f32x4*)(hb + 32 * q + 4 * i4);
#pragma unroll
                    for (int e = 0; e < 4; ++e) part = fmaf(hv[e], Cq[4 * i4 + e], part); }
                part += __shfl_xor(part, 16); part += __shfl_xor(part, 32);
                const float y = part + Dg * xs[tt * 16 + cc];
                if ((tt & 3) == q) ykeep = y;
                if ((tt & 3) == 3) Gout[(size_t)(row0 + t0 + (tt & ~3) + q) * 1024 + g * 16 + cc] = (bf16)f2bf(gelu_tanh(ykeep));
                asm volatile("" ::: "memory");
            }
        }
        LDS_WAIT(); asm volatile("" ::: "memory");
    }
}

#ifndef EN_P0
#define EN_P0 1
#endif
#ifndef EN_QKV
#define EN_QKV 1
#endif
#ifndef EN_ATT
#define EN_ATT 1
#endif
#ifndef EN_OPJ
#define EN_OPJ 1
#endif
#ifndef EN_S1
#define EN_S1 1
#endif
#ifndef EN_S3
#define EN_S3 1
#endif
#ifndef EN_GLU
#define EN_GLU 1
#endif
#ifndef EN_UP
#define EN_UP 1
#endif
#ifndef EN_DN
#define EN_DN 1
#endif
#ifndef EN_FIN
#define EN_FIN 1
#endif
template <class T> __device__ __forceinline__ T karg(const __attribute__((address_space(4))) char* ka, int off) { typedef const __attribute__((address_space(4))) T CT; return *(CT*)(ka + off); }
struct Args { const float* in[23]; float* out; unsigned char* ws; int ph_lo, ph_hi; };
static_assert(sizeof(Args) == 208 && __builtin_offsetof(Args, out) == 184 && __builtin_offsetof(Args, ws) == 192, "kernarg layout used by KARG");

__global__ void __launch_bounds__(512, 2) fwd_kernel(Args args) {
    extern __shared__ __attribute__((aligned(16))) unsigned char lds[];
    LAS unsigned char* const L = (LAS unsigned char*)lds;
#define FRESH_IDS int tid = threadIdx.x; asm volatile("" : "+v"(tid)); const int lane = tid & 63, wave = __builtin_amdgcn_readfirstlane(tid >> 6); const int gw = vcu * 8 + wave; (void)lane; (void)gw
    const int G = gridDim.x, bx = blockIdx.x;
    const int vcu = (G % 8 == 0) ? (bx % 8) * (G / 8) + bx / 8 : bx;
    const int NGW = G * 8;
    for (int u = threadIdx.x; u < (LDS_BYTES - LDSCTL_OFF) / 4; u += 512) ((LAS unsigned*)(L + LDSCTL_OFF))[u] = 0u;
    __syncthreads();
    const int lo = args.ph_lo, hi = args.ph_hi;
    const bool multi = (hi - lo) > 1;
    XcdBarrier bar; bar.bar = (unsigned*)(args.ws + WS_CTL) + CW_BAR; bar.x = 0; bar.st = nullptr;
    if (multi) bar = xcd_barrier_post((unsigned*)(args.ws + WS_CTL) + CW_BAR, (volatile LAS unsigned*)(L + MISC_OFF) + 8);
#define IN(k) (lo <= (k) && (k) < hi)
#define SEAM(k) do { if (IN(k) && IN((k) + 1)) xcd_barrier(bar); } while (0)

#define KARG(T, off) karg<T>(ka, (off))
#define INP(k) karg<const float*>(ka, 8 * (k))
#define FRESH_PTRS const __attribute__((address_space(4))) char* ka = (const __attribute__((address_space(4))) char*)__builtin_amdgcn_kernarg_segment_ptr(); asm volatile("" : "+s"(ka)); \
    unsigned char* const ws = KARG(unsigned char*, 192); float* const out = KARG(float*, 184); \
    float* const ssp = (float*)(ws + WS_SSP); float* const HS = (float*)(ws + WS_HS); bf16* const XB = (bf16*)(ws + WS_XB); bf16* const Hb = (bf16*)(ws + WS_H); \
    bf16* const Qb = (bf16*)(ws + WS_Q); bf16* const Kb = (bf16*)(ws + WS_K); bf16* const Vb = (bf16*)(ws + WS_V); bf16* const Ob = (bf16*)(ws + WS_O); \
    const float* const x_p = INP(0); const float* const x_s = INP(1); (void)ssp; (void)HS; (void)XB; (void)Hb; (void)Qb; (void)Kb; (void)Vb; (void)Ob; (void)x_p; (void)x_s
    if (EN_P0 && IN(0)) {
        FRESH_IDS; FRESH_PTRS;
        LAS float* scr = (LAS float*)(L + wave * 16384);
        constexpr int I_QKV = 16 * 48, I_O = 16 * 32, I_GLU = 16 * 64, I_UP = 16 * 128, I_DN = 64 * 32;
        constexpr int NITEMS = 2 * I_QKV + 2 * I_O + 2 * I_GLU + 4 * I_UP + 4 * I_DN;
        for (int it = gw; it < NITEMS; it += NGW) {
            int r = it;
            if (r < 2 * I_QKV) { const int j = r / I_QKV; r -= j * I_QKV; p0_transpose_item(INP(9) + (size_t)j * D * NQKV, D, NQKV, INP(6) + (size_t)(2 * j) * D, (bf16*)(ws + WS_WQKV) + (size_t)j * NQKV * D, 0, scr, r, lane); continue; } r -= 2 * I_QKV;
            if (r < 2 * I_O) { const int j = r / I_O; r -= j * I_O; p0_transpose_item(INP(10) + (size_t)j * D * D, D, D, nullptr, (bf16*)(ws + WS_WO) + (size_t)j * D * D, 0, scr, r, lane); continue; } r -= 2 * I_O;
            if (r < 2 * I_GLU) { const int j = r / I_GLU; r -= j * I_GLU; p0_transpose_item(INP(20) + (size_t)j * D * 2 * D, D, 2 * D, nullptr, (bf16*)(ws + WS_WGLU) + (size_t)j * 2 * D * D, 1, scr, r, lane); continue; } r -= 2 * I_GLU;
            if (r < 4 * I_UP) { const int l = r / I_UP; r -= l * I_UP; p0_transpose_item(INP(21) + (size_t)l * D * FF, D, FF, INP(7) + (size_t)l * D, (bf16*)(ws + WS_WUP) + (size_t)l * FF * D, 0, scr, r, lane); continue; } r -= 4 * I_UP;
            { const int l = r / I_DN; r -= l * I_DN; p0_transpose_item(INP(22) + (size_t)l * FF * D, FF, D, nullptr, (bf16*)(ws + WS_WDN) + (size_t)l * D * FF, 0, scr, r, lane); }
        }
        for (int m = gw; m < M; m += NGW) {
            const float* xrow = (m < MP) ? x_p + (size_t)m * D : x_s + (size_t)(m - MP) * D;
            const GAS f32x4* xr = (const GAS f32x4*)xrow + lane;
            f32x4 v[4]; float s = 0.f;
#pragma unroll
            for (int j = 0; j < 4; ++j) { v[j] = xr[64 * j]; s += (v[j][0] * v[j][0] + v[j][1] * v[j][1]) + (v[j][2] * v[j][2] + v[j][3] * v[j][3]); }
            s = wave_sum(s);
            GAS unsigned long long* o8 = (GAS unsigned long long*)(XB + (size_t)m * D) + lane;
#pragma unroll
            for (int j = 0; j < 4; ++j) o8[64 * j] = (unsigned long long)pk2(v[j][0], v[j][1]) | ((unsigned long long)pk2(v[j][2], v[j][3]) << 32);
            if (lane < 16) ssp[(size_t)m * 32 + lane] = (lane == 0) ? s : 0.f;
        }
        {
            constexpr int PER = 120 * 256 / 4;
            constexpr int TOT = 2 * 2 * SB * PER;
            for (int i = bx * 512 + tid; i < TOT; i += G * 512) {
                const int kv = i / (2 * SB * PER), rem = i % (2 * SB * PER), jb = rem / PER, e = rem % PER;
                const f32x4 v = *((const f32x4*)(INP(2 + kv) + (size_t)jb * 128 * 256 + 8 * 256) + e);
                *((f32x4*)(out + (kv ? O_VS : O_KS) + (size_t)jb * 128 * 256) + e) = v;
            }
        }
    }
    SEAM(0);

    for (int l = 0; l < 4; ++l) {
        const int pb = 1 + 5 * l, j = l >> 1;
        if ((l & 1) == 0) {
            if (EN_QKV && IN(pb)) {
                FRESH_PTRS;
                pg8::Gemm g{XB, (const bf16*)(ws + WS_WQKV) + (size_t)j * NQKV * D, M, NQKV, D}; pg8::StaticOrder S; S.init(M, NQKV, G, bx);
                pg8::EpiQKV E{Qb, Kb, Vb, ssp, 16, out + O_KP + (size_t)j * 2 * 128 * 256, out + O_VP + (size_t)j * 2 * 128 * 256, out + O_KS + (size_t)j * SB * 128 * 256, out + O_VS + (size_t)j * SB * 128 * 256};
                pg8::gemm_phase<pg8::EpiQKV, pg8::StaticOrder, true, true>(L, g, S, E);
            }
            SEAM(pb);
            if (EN_ATT && IN(pb + 1)) {
                FRESH_IDS; FRESH_PTRS;
                const LAS unsigned char* Kl = L; const LAS unsigned char* Vl = L + 36864;
                const float* ck = INP(2) + (size_t)j * SB * 128 * 256; const float* cv = INP(3) + (size_t)j * SB * 128 * 256;
                const float* sinks = INP(11) + j * 16;
                const int r32 = lane & 31, hi5 = lane >> 5;
                for (int u = vcu; u < 1024; u += G) {
                    const bool samp = u >= 512;
                    int b, qblk = 0, kvh;
                    if (!samp) { kvh = u & 3; qblk = (u >> 2) & 63; b = u >> 8; } else { const int us = u - 512; kvh = us & 3; b = us >> 2; }
                    const int nchunk = samp ? 160 * 8 : 256 * 8;
                    for (int id = tid; id < nchunk; id += 512) {
                        const int key = id >> 3, ch = id & 7;
                        v4u kv = {0u, 0u, 0u, 0u}, vv = {0u, 0u, 0u, 0u};
                        if (!samp) {
                            const int s = qblk * 128 - 128 + key;
                            if (s >= 0) { const size_t off = (size_t)((b << 13) + s) * 256 + kvh * 64 + ch * 8; kv = *(const v4u*)(Kb + off); vv = *(const v4u*)(Vb + off); }
                        } else if (key < 128) {
                            const size_t off = ((size_t)b * 128 + key) * 256 + kvh * 64 + ch * 8;
                            const f32x4 k0 = *(const f32x4*)(ck + off), k1 = *(const f32x4*)(ck + off + 4), v0 = *(const f32x4*)(cv + off), v1 = *(const f32x4*)(cv + off + 4);
                            kv.x = pk2(k0[0], k0[1]); kv.y = pk2(k0[2], k0[3]); kv.z = pk2(k1[0], k1[1]); kv.w = pk2(k1[2], k1[3]);
                            vv.x = pk2(v0[0], v0[1]); vv.y = pk2(v0[2], v0[3]); vv.z = pk2(v1[0], v1[1]); vv.w = pk2(v1[2], v1[3]);
                        } else if (key < 136) {
                            const size_t off = (size_t)(MP + b * 8 + (key - 128)) * 256 + kvh * 64 + ch * 8; kv = *(const v4u*)(Kb + off); vv = *(const v4u*)(Vb + off);
                        }
                        *(LAS v4u*)(L + key * 144 + ch * 16) = kv;
                        LAS unsigned short* vt = (LAS unsigned short*)(L + 36864 + (ch * 8) * 520 + key * 2);
                        vt[0 * 260] = (unsigned short)(vv.x & 0xffffu); vt[1 * 260] = (unsigned short)(vv.x >> 16); vt[2 * 260] = (unsigned short)(vv.y & 0xffffu); vt[3 * 260] = (unsigned short)(vv.y >> 16);
                        vt[4 * 260] = (unsigned short)(vv.z & 0xffffu); vt[5 * 260] = (unsigned short)(vv.z >> 16); vt[6 * 260] = (unsigned short)(vv.w & 0xffffu); vt[7 * 260] = (unsigned short)(vv.w >> 16);
                    }
                    __syncthreads();
                    const int ntask = samp ? ((wave == 0) ? 1 : 0) : 2;
                    for (int ti = 0; ti < ntask; ++ti) {
                        int qrow, head, tloc, kb0, jkmin;
                        if (!samp) { const int sb = 2 * (wave & 1) + ti; head = kvh * 4 + (wave >> 1); tloc = 32 * sb + r32; qrow = (b << 13) + qblk * 128 + tloc; kb0 = sb; jkmin = (qblk == 0) ? 128 : 0; }
                        else { head = kvh * 4 + (r32 >> 3); tloc = r32 & 7; qrow = MP + b * 8 + tloc; kb0 = 0; jkmin = 0; }
                        const float slope2 = exp2f(-0.5f * (float)(head + 1)) * 1.4426950408889634f, sink2 = sinks[head] * 1.4426950408889634f;
                        const bf16* qptr = Qb + (size_t)qrow * 1024 + head * 64 + 8 * hi5;
                        pg8::bf16x8 qf[4];
#pragma unroll
                        for (int ks = 0; ks < 4; ++ks) qf[ks] = *(const pg8::bf16x8*)(qptr + 16 * ks);
                        f32x16 S[5];
#pragma unroll
                        for (int i = 0; i < 5; ++i) {
                            f32x16 acc = {0.f, 0.f, 0.f, 0.f, 0.f, 0.f, 0.f, 0.f, 0.f, 0.f, 0.f, 0.f, 0.f, 0.f, 0.f, 0.f};
#pragma unroll
                            for (int ks = 0; ks < 4; ++ks) { const pg8::bf16x8 kf = *(const LAS pg8::bf16x8*)(Kl + (32 * (kb0 + i) + r32) * 144 + 32 * ks + 16 * hi5); acc = __builtin_amdgcn_mfma_f32_32x32x16_bf16(kf, qf[ks], acc, 0, 0, 0); }
                            S[i] = acc;
                        }
                        float mx = sink2;
#pragma unroll
                        for (int i = 0; i < 5; ++i)
#pragma unroll
                            for (int r = 0; r < 16; ++r) {
                                const int jk = 32 * (kb0 + i) + (r & 3) + 8 * (r >> 2) + 4 * hi5; const int dist = tloc + 128 - jk;
                                const bool valid = (dist >= 0) && (dist <= 128) && (jk >= jkmin);
                                const float sv = valid ? (S[i][r] * 0.18033688011112042f - slope2 * (float)dist) : -1e30f;
                                S[i][r] = sv; mx = fmaxf(mx, sv);
                            }
                        mx = fmaxf(mx, __shfl_xor(mx, 32));
                        float lsum = 0.f;
#pragma unroll
                        for (int i = 0; i < 5; ++i)
#pragma unroll
                            for (int r = 0; r < 16; ++r) { const float p = __builtin_amdgcn_exp2f(S[i][r] - mx); S[i][r] = p; lsum += p; }
                        lsum += __shfl_xor(lsum, 32); lsum += __builtin_amdgcn_exp2f(sink2 - mx);
                        const float inv = 1.0f / lsum;
                        f32x16 O0 = {0.f, 0.f, 0.f, 0.f, 0.f, 0.f, 0.f, 0.f, 0.f, 0.f, 0.f, 0.f, 0.f, 0.f, 0.f, 0.f}, O1 = O0;
#pragma unroll
                        for (int i = 0; i < 5; ++i)
#pragma unroll
                            for (int s2 = 0; s2 < 2; ++s2) {
                                v4u pw; pw.x = pg8::cvt_pk_bf16(S[i][8 * s2 + 0], S[i][8 * s2 + 1]); pw.y = pg8::cvt_pk_bf16(S[i][8 * s2 + 2], S[i][8 * s2 + 3]);
                                pw.z = pg8::cvt_pk_bf16(S[i][8 * s2 + 4], S[i][8 * s2 + 5]); pw.w = pg8::cvt_pk_bf16(S[i][8 * s2 + 6], S[i][8 * s2 + 7]);
                                const pg8::bf16x8 pf = __builtin_bit_cast(pg8::bf16x8, pw);
                                const int keyoff = 32 * (kb0 + i) + 16 * s2 + 4 * hi5;
                                { const u32x2 lo = *(const LAS u32x2*)(Vl + r32 * 520 + keyoff * 2), hh = *(const LAS u32x2*)(Vl + r32 * 520 + (keyoff + 8) * 2);
                                  v4u vw; vw.x = lo.x; vw.y = lo.y; vw.z = hh.x; vw.w = hh.y; O0 = __builtin_amdgcn_mfma_f32_32x32x16_bf16(__builtin_bit_cast(pg8::bf16x8, vw), pf, O0, 0, 0, 0); }
                                { const u32x2 lo = *(const LAS u32x2*)(Vl + (32 + r32) * 520 + keyoff * 2), hh = *(const LAS u32x2*)(Vl + (32 + r32) * 520 + (keyoff + 8) * 2);
                                  v4u vw; vw.x = lo.x; vw.y = lo.y; vw.z = hh.x; vw.w = hh.y; O1 = __builtin_amdgcn_mfma_f32_32x32x16_bf16(__builtin_bit_cast(pg8::bf16x8, vw), pf, O1, 0, 0, 0); }
                            }
                        bf16* optr = Ob + (size_t)qrow * 1024 + head * 64 + 4 * hi5;
#pragma unroll
                        for (int qd = 0; qd < 4; ++qd) {
                            u32x2 w0; w0.x = pg8::cvt_pk_bf16(O0[4 * qd] * inv, O0[4 * qd + 1] * inv); w0.y = pg8::cvt_pk_bf16(O0[4 * qd + 2] * inv, O0[4 * qd + 3] * inv);
                            u32x2 w1; w1.x = pg8::cvt_pk_bf16(O1[4 * qd] * inv, O1[4 * qd + 1] * inv); w1.y = pg8::cvt_pk_bf16(O1[4 * qd + 2] * inv, O1[4 * qd + 3] * inv);
                            *(u32x2*)(optr + 8 * qd) = w0; *(u32x2*)(optr + 32 + 8 * qd) = w1;
                        }
                    }
                    __syncthreads();
                }
            }
            SEAM(pb + 1);
            if (EN_OPJ && IN(pb + 2)) {
                FRESH_PTRS;
                pg8::Gemm g{Ob, (const bf16*)(ws + WS_WO) + (size_t)j * D * D, M, D, D}; pg8::StaticOrder S; S.init(M, D, G, bx);
                pg8::EpiRes E{(l == 0) ? x_p : out, (l == 0) ? x_s : out + (size_t)MP * D, out, XB, ssp};
                pg8::gemm_phase<pg8::EpiRes, pg8::StaticOrder, true, true>(L, g, S, E);
            }
            SEAM(pb + 2);
        } else {
#define SSMC const SsmC sc{INP(12) + (size_t)j * NG * NS, INP(13) + (size_t)j * NG * NS, INP(14) + (size_t)j * NG, INP(15) + (size_t)j * NG * NS * GC, INP(16) + (size_t)j * NG * NS * GC, \
                          INP(17) + (size_t)j * NG * GC * NS, INP(18) + (size_t)j * NG * GC * NS, INP(19) + (size_t)j * D, INP(6) + (size_t)l * D}
            if (EN_S1 && IN(pb)) {
                FRESH_IDS; FRESH_PTRS; SSMC; LAS float* xs = (LAS float*)(L + wave * 8192); LAS float* hb = xs + 1024;
                for (int u = gw; u < NB * (NCH - 1) * NG; u += NGW) {
                    const int g = u & 63, ch = (u >> 6) % (NCH - 1), b = (u >> 6) / (NCH - 1);
                    float hr = 0.f, hi_ = 0.f;
                    ssm_unit<false>(xs, hb, lane, g, sc, out, ssp, b * SEQ + ch * CH, CH, hr, hi_, nullptr);
                    *(float2*)(HS + ((size_t)((b * NCH + ch) * NG + g) * NS + lane) * 2) = make_float2(hr, hi_);
                }
                __syncthreads();
            }
            SEAM(pb);
            if (EN_S3 && IN(pb + 1)) {
                FRESH_IDS; FRESH_PTRS; SSMC; LAS float* xs = (LAS float*)(L + wave * 8192); LAS float* hb = xs + 1024;
                for (int u = gw; u < NB * NCH * NG + SB * NG; u += NGW) {
                    if (u < NB * NCH * NG) {
                        const int g = u & 63, ch = (u >> 6) & (NCH - 1), b = u >> 11;
                        float abr, abi, cfr, cfi; ssm_abar(sc, g, lane, abr, abi, cfr, cfi);
                        float aLr = abr, aLi = abi;
#pragma unroll
                        for (int s = 0; s < 8; ++s) { const float tr = aLr * aLr - aLi * aLi, ti = 2.0f * aLr * aLi; aLr = tr; aLi = ti; }
                        float hr = 0.f, hi_ = 0.f;
                        for (int i = 0; i < ch; ++i) { const float2 e = *(const float2*)(HS + ((size_t)((b * NCH + i) * NG + g) * NS + lane) * 2);
                            const float tr = aLr * hr - aLi * hi_ + e.x, ti = aLr * hi_ + aLi * hr + e.y; hr = tr; hi_ = ti; }
                        ssm_unit<true>(xs, hb, lane, g, sc, out, ssp, b * SEQ + ch * CH, CH, hr, hi_, Ob);
                        if (ch == NCH - 1) { out[O_HRP + ((size_t)(j * NB + b) * NG + g) * NS + lane] = hr; out[O_HIP + ((size_t)(j * NB + b) * NG + g) * NS + lane] = hi_; }
                    } else {
                        const int us = u - NB * NCH * NG, g = us & 63, bs = us >> 6;
                        const size_t si = ((size_t)(j * SB + bs) * NG + g) * NS + lane;
                        float hr = INP(4)[si], hi_ = INP(5)[si];
                        ssm_unit<true>(xs, hb, lane, g, sc, out, ssp, MP + bs * ST, ST, hr, hi_, Ob);
                        out[O_HRS + si] = hr; out[O_HIS + si] = hi_;
                    }
                }
                __syncthreads();
            }
            SEAM(pb + 1);
            if (EN_GLU && IN(pb + 2)) {
                FRESH_PTRS;
                pg8::Gemm g{Ob, (const bf16*)(ws + WS_WGLU) + (size_t)j * 2 * D * D, M, 2 * D, D}; pg8::StaticOrder S; S.init(M, 2 * D, G, bx);
                pg8::EpiGlu E{out, XB, ssp};
                pg8::gemm_phase<pg8::EpiGlu, pg8::StaticOrder, true, true>(L, g, S, E);
            }
            SEAM(pb + 2);
        }
        if (EN_UP && IN(pb + 3)) {
            FRESH_PTRS;
            pg8::Gemm g{XB, (const bf16*)(ws + WS_WUP) + (size_t)l * FF * D, M, FF, D}; pg8::StaticOrder S; S.init(M, FF, G, bx);
            pg8::EpiUp E{Hb, ssp, (l & 1) ? 32 : 16};
            pg8::gemm_phase<pg8::EpiUp, pg8::StaticOrder, true, true>(L, g, S, E);
        }
        SEAM(pb + 3);
        if (EN_DN && IN(pb + 4)) {
            FRESH_PTRS;
            pg8::Gemm g{Hb, (const bf16*)(ws + WS_WDN) + (size_t)l * D * FF, M, D, FF}; pg8::StaticOrder S; S.init(M, D, G, bx);
            pg8::EpiRes E{out, out + (size_t)MP * D, out, XB, ssp};
            pg8::gemm_phase<pg8::EpiRes, pg8::StaticOrder, true, true>(L, g, S, E);
        }
        SEAM(pb + 4);
    }
    if (EN_FIN && IN(21)) {
        FRESH_IDS; FRESH_PTRS;
        const float* gf = INP(8);
        for (int m = gw; m < M; m += NGW) {
            const float pv = (lane < 16) ? ssp[(size_t)m * 32 + lane] : 0.f;
            const float rinv = rsqrtf(wave_sum(pv) * (1.0f / 1024.0f) + 1e-6f);
            GAS f32x4* xr = (GAS f32x4*)(out + (size_t)m * D) + lane;
#pragma unroll
            for (int jx = 0; jx < 4; ++jx) { const f32x4 gv = *((const f32x4*)gf + 64 * jx + lane); f32x4 v = xr[64 * jx]; v = v * rinv * gv; xr[64 * jx] = v; }
        }
    }
#undef IN
#undef SEAM
}

#ifndef MK_SPLIT
#define MK_SPLIT 0
#endif
extern "C" void kernel_launch(void* const* d_in, const int* in_sizes, int n_in, void* d_out, int out_size, void* d_ws, size_t ws_size, hipStream_t stream) {
    static int grid = 0;
    if (grid == 0) {
        if (n_in != 23 || in_sizes[0] != MP * D || (size_t)out_size != O_END || ws_size < WS_END) { fprintf(stderr, "kernel_launch: unexpected shapes (n_in %d, in0 %d, out %d, ws %zu); nothing launched\n", n_in, n_in > 0 ? in_sizes[0] : -1, out_size, ws_size); grid = -1; return; }
        int dev = 0, cus = 0, per_cu = 0;
        if (hipGetDevice(&dev) != hipSuccess || hipDeviceGetAttribute(&cus, hipDeviceAttributeMultiprocessorCount, dev) != hipSuccess) { fprintf(stderr, "kernel_launch: device query failed\n"); grid = -1; return; }
        if (hipFuncSetAttribute((const void*)fwd_kernel, hipFuncAttributeMaxDynamicSharedMemorySize, LDS_BYTES) != hipSuccess) { fprintf(stderr, "kernel_launch: hipFuncSetAttribute failed\n"); grid = -1; return; }
        if (hipOccupancyMaxActiveBlocksPerMultiprocessor(&per_cu, (const void*)fwd_kernel, 512, LDS_BYTES) != hipSuccess || per_cu < 1) fprintf(stderr, "kernel_launch: note: occupancy query reports %d blocks per CU\n", per_cu);
        (void)hipGetLastError();
        grid = cus;
    }
    if (grid < 0) return;
    (void)hipMemsetAsync((char*)d_ws + WS_CTL, 0, CTL_ZERO_BYTES, stream);
    Args a{};
    for (int i = 0; i < 23; ++i) a.in[i] = (const float*)d_in[i];
    a.out = (float*)d_out; a.ws = (unsigned char*)d_ws;
#if MK_SPLIT
    for (int p = 0; p < NPHASE; ++p) { a.ph_lo = p; a.ph_hi = p + 1; hipLaunchKernelGGL(fwd_kernel, dim3(grid), dim3(512), LDS_BYTES, stream, a); }
#else
    a.ph_lo = 0; a.ph_hi = NPHASE; hipLaunchKernelGGL(fwd_kernel, dim3(grid), dim3(512), LDS_BYTES, stream, a);
#endif
}
```

```cpp
#include <hip/hip_runtime.h>
#include <cstdio>
#include <cstdint>
namespace pg8 {
#define PG8_LAS __attribute__((address_space(3)))
typedef unsigned short bf16_t;
typedef short bf16x8 __attribute__((ext_vector_type(8)));
typedef float f32x4 __attribute__((ext_vector_type(4)));
typedef unsigned u32x4 __attribute__((ext_vector_type(4)));
constexpr int BM = 256, BK = 64, HALF = 128, HTB = HALF * BK * 2  , STAGE_BYTES = 8 * HTB, NXCD = 8, WGM = 8;

__host__ __device__ __forceinline__ int lds_byte(int r, int c) { const int st = (r >> 4) * 2 + (c >> 5), rr = r & 15, cc = c & 31, ob = rr * 64 + cc * 2; return st * 1024 + (ob ^ (((ob >> 9) & 1) << 5)); }
__host__ __device__ __forceinline__ void stage_rc(int b, int& R, int& C) { const int st = b / 1024, sb = b % 1024, swz = sb ^ (((sb >> 9) & 1) << 5); R = (st >> 1) * 16 + swz / 64; C = (st & 1) * 32 + (swz % 64) / 2; }
__host__ __device__ __forceinline__ int perm32(int rho) { const int n = rho >> 4, i = rho & 15; return 8 * (i >> 2) + 4 * n + (i & 3); }

struct Unit { int pm, pn; };
struct Gemm { const bf16_t* A; const bf16_t* Bt; int M, N, K; };

struct StaticOrder {
    int nM, nN, nwg, G, c;
    __host__ __device__ void init(int M, int N, int G_, int c_) { nM = M / BM; nN = N / BM; nwg = nM * nN; G = G_; c = c_; }
    __host__ __device__ bool next(int i, Unit& u) const {
        const long L = (long)i * G + c; if (L >= nwg) return false;
        int wgid = (int)L; { const int q = nwg / NXCD, r = nwg % NXCD, xcd = wgid % NXCD, off = wgid / NXCD; wgid = (xcd < r ? xcd * (q + 1) : r * (q + 1) + (xcd - r) * q) + off; }
        const int nig = WGM * nN, gid = wgid / nig, fm = gid * WGM, gsz = (nM - fm) < WGM ? (nM - fm) : WGM;
        u.pm = fm + ((wgid % nig) % gsz); u.pn = (wgid % nig) / gsz; return true;
    }
    __device__ __forceinline__ void a_ready(const Unit&) const {}
    __device__ __forceinline__ void done(const Unit&) const {}
};
__device__ __forceinline__ unsigned cvt_pk_bf16(float lo, float hi) { unsigned r; asm volatile("v_cvt_pk_bf16_f32 %0, %1, %2" : "=v"(r) : "v"(lo), "v"(hi)); return r; }
typedef float f32x2 __attribute__((ext_vector_type(2)));
template <class Epi, class Sched, bool ALIGN_EPI = false, bool SP2 = false>
__device__ __forceinline__ void gemm_phase(PG8_LAS unsigned char* lds, const Gemm g, const Sched& S, const Epi& E) {
    int tid_ = threadIdx.x; asm volatile("" : "+v"(tid_));
    const int tid = tid_, wid = __builtin_amdgcn_readfirstlane(tid >> 6), lane = tid & 63, wr = wid >> 2, wc = wid & 3, fr = lane & 15, fq = lane >> 4;
    const int K = g.K, nt = K / BK;
    unsigned voffA[2], voffB[2];
#pragma unroll
    for (int i = 0; i < 2; ++i) { int R, C; stage_rc(tid * 16 + i * 8192, R, C); const int Rb = Epi::PERM ? ((R & ~31) + perm32(R & 31)) : R;
        voffA[i] = (unsigned)(R * K + C) * 2u; voffB[i] = (unsigned)(Rb * K + C) * 2u; }
    const size_t kstep = (size_t)(BK * 2);
    const size_t hstep = (size_t)HALF * K * 2;
    const size_t tstep = 2 * hstep;
    const unsigned ldsw = (unsigned)wid * 1024u;
    const int aoff = lds_byte(wr * 64 + fr, fq * 8), boff = lds_byte(wc * 32 + fr, fq * 8);
#define PG8_SA(b, h) (((b) * 2 + (h)) * HTB)
#define PG8_SB(b, h) ((4 + (b) * 2 + (h)) * HTB)
#define PG8_STAGE(bufoff, gbase, voff) do { _Pragma("unroll") for (int _i = 0; _i < 2; ++_i) \
        __builtin_amdgcn_global_load_lds((const unsigned*)((const char*)(gbase) + (voff)[_i]), (PG8_LAS unsigned*)(lds + (bufoff) + ldsw + _i * 8192), 16, 0, 0); } while (0)
#define PG8_LDA(dst, b, h) do { _Pragma("unroll") for (int m = 0; m < 4; ++m) _Pragma("unroll") for (int k = 0; k < 2; ++k) dst[m][k] = *(const PG8_LAS bf16x8*)(lds + PG8_SA(b, h) + aoff + m * 2048 + k * 1024); } while (0)
#define PG8_LDB(dst, b, h) do { _Pragma("unroll") for (int n = 0; n < 2; ++n) _Pragma("unroll") for (int k = 0; k < 2; ++k) dst[n][k] = *(const PG8_LAS bf16x8*)(lds + PG8_SB(b, h) + boff + n * 2048 + k * 1024); } while (0)
#define PG8_MMA(ai, bj, At, Bt) do { __builtin_amdgcn_s_setprio(1); _Pragma("unroll") for (int m = 0; m < 4; ++m) _Pragma("unroll") for (int n = 0; n < 2; ++n) _Pragma("unroll") for (int k = 0; k < 2; ++k) \
        acc[ai][bj][m][n] = __builtin_amdgcn_mfma_f32_16x16x32_bf16(Bt[n][k], At[m][k], acc[ai][bj][m][n], 0, 0, 0); __builtin_amdgcn_s_setprio(0); } while (0)
#define PG8_WAIT_V(n) asm volatile("s_waitcnt vmcnt(" #n ")" ::: "memory")
#define PG8_WAIT_L(n) asm volatile("s_waitcnt lgkmcnt(" #n ")" ::: "memory")
#define PG8_BAR __builtin_amdgcn_s_barrier()
#define PG8_SCHED __builtin_amdgcn_sched_barrier(0)
    Unit cur, nxt; int ui = 0;
    if (!S.next(0, cur)) return;
    f32x4 acc[2][2][4][2];
#pragma unroll
    for (int a = 0; a < 2; ++a)
#pragma unroll
        for (int b = 0; b < 2; ++b)
#pragma unroll
            for (int m = 0; m < 4; ++m)
#pragma unroll
                for (int n = 0; n < 2; ++n) acc[a][b][m][n] = (f32x4){0.f, 0.f, 0.f, 0.f};
    bf16x8 At[4][2], B0[2][2], B1[2][2];
    const char* cA = (const char*)g.A + (size_t)cur.pm * tstep; const char* cB = (const char*)g.Bt + (size_t)cur.pn * tstep;
    S.a_ready(cur);
    if constexpr (SP2) {
        PG8_STAGE(PG8_SB(0, 0), cB, voffB); PG8_STAGE(PG8_SB(0, 1), cB + hstep, voffB); PG8_STAGE(PG8_SA(0, 0), cA, voffA); PG8_STAGE(PG8_SA(0, 1), cA + hstep, voffA);
        if (wr == 1) PG8_BAR;
        PG8_WAIT_V(2); PG8_BAR;
        PG8_STAGE(PG8_SB(1, 0), cB + kstep, voffB); PG8_STAGE(PG8_SA(1, 0), cA + kstep, voffA); PG8_STAGE(PG8_SB(1, 1), cB + hstep + kstep, voffB);
        PG8_WAIT_V(6); PG8_BAR;
    } else {
        PG8_STAGE(PG8_SB(0, 0), cB, voffB); PG8_STAGE(PG8_SA(0, 0), cA, voffA); PG8_STAGE(PG8_SB(0, 1), cB + hstep, voffB); PG8_STAGE(PG8_SA(0, 1), cA + hstep, voffA);
        if (wr == 1) PG8_BAR;
        PG8_WAIT_V(4); PG8_BAR;
        PG8_STAGE(PG8_SB(1, 0), cB + kstep, voffB); PG8_STAGE(PG8_SA(1, 0), cA + kstep, voffA); PG8_STAGE(PG8_SB(1, 1), cB + hstep + kstep, voffB);
        PG8_WAIT_V(6); PG8_BAR;
    }
    for (;;) {
        const bool has_next = S.next(ui + 1, nxt);
        const char* nA = has_next ? (const char*)g.A + (size_t)nxt.pm * tstep : cA; const char* nB = has_next ? (const char*)g.Bt + (size_t)nxt.pn * tstep : cB;
        for (int t = 0; t < nt; t += 2) {
            const bool last = (t == nt - 2);
            const char* a1 = cA + (size_t)(t + 1) * kstep;
            const char* a2 = last ? nA : cA + (size_t)(t + 2) * kstep; const char* b2 = last ? nB : cB + (size_t)(t + 2) * kstep;
            const char* a3 = a2 + kstep; const char* b3 = b2 + kstep;
            if (last && has_next) S.a_ready(nxt);
            if constexpr (SP2) {
            PG8_LDB(B0, 0, 0); PG8_LDB(B1, 0, 1); PG8_SCHED; PG8_LDA(At, 0, 0); PG8_STAGE(PG8_SA(1, 1), a1 + hstep, voffA);
            PG8_WAIT_V(8); PG8_WAIT_L(0); PG8_BAR; PG8_MMA(0, 0, At, B0); PG8_MMA(0, 1, At, B1); PG8_BAR; PG8_SCHED;
            PG8_LDA(At, 0, 1); PG8_STAGE(PG8_SB(0, 0), b2, voffB); PG8_STAGE(PG8_SB(0, 1), b2 + hstep, voffB); PG8_STAGE(PG8_SA(0, 0), a2, voffA);
            PG8_WAIT_V(8); PG8_WAIT_L(0); PG8_BAR; PG8_MMA(1, 0, At, B0); PG8_MMA(1, 1, At, B1); PG8_BAR; PG8_SCHED;
            PG8_LDB(B0, 1, 0); PG8_LDB(B1, 1, 1); PG8_SCHED; PG8_LDA(At, 1, 0); PG8_STAGE(PG8_SA(0, 1), a2 + hstep, voffA);
            PG8_WAIT_V(8); PG8_WAIT_L(0); PG8_BAR; PG8_MMA(0, 0, At, B0); PG8_MMA(0, 1, At, B1); PG8_BAR; PG8_SCHED;
            PG8_LDA(At, 1, 1); PG8_STAGE(PG8_SB(1, 0), b3, voffB); PG8_STAGE(PG8_SB(1, 1), b3 + hstep, voffB); PG8_STAGE(PG8_SA(1, 0), a3, voffA);
            PG8_WAIT_V(8); PG8_WAIT_L(0); PG8_BAR; PG8_MMA(1, 0, At, B0); PG8_MMA(1, 1, At, B1); PG8_BAR; PG8_SCHED;
            } else {
            PG8_LDB(B0, 0, 0); PG8_SCHED; PG8_LDA(At, 0, 0); PG8_STAGE(PG8_SA(1, 1), a1 + hstep, voffA);
            PG8_WAIT_L(8); PG8_BAR; PG8_WAIT_L(0); PG8_MMA(0, 0, At, B0); PG8_BAR; PG8_SCHED;
            PG8_LDB(B1, 0, 1); PG8_STAGE(PG8_SB(0, 0), b2, voffB);
            PG8_BAR; PG8_WAIT_L(0); PG8_MMA(0, 1, At, B1); PG8_BAR;
            PG8_LDA(At, 0, 1); PG8_STAGE(PG8_SA(0, 0), a2, voffA);
            PG8_BAR; PG8_WAIT_L(0); PG8_MMA(1, 0, At, B0); PG8_BAR; PG8_SCHED;
            PG8_STAGE(PG8_SB(0, 1), b2 + hstep, voffB);
            PG8_WAIT_V(6); PG8_BAR; PG8_MMA(1, 1, At, B1); PG8_BAR;
            PG8_LDB(B0, 1, 0); PG8_SCHED; PG8_LDA(At, 1, 0); PG8_STAGE(PG8_SA(0, 1), a2 + hstep, voffA);
            PG8_WAIT_L(8); PG8_BAR; PG8_WAIT_L(0); PG8_MMA(0, 0, At, B0); PG8_BAR; PG8_SCHED;
            PG8_LDB(B1, 1, 1); PG8_STAGE(PG8_SB(1, 0), b3, voffB);
            PG8_BAR; PG8_WAIT_L(0); PG8_MMA(0, 1, At, B1); PG8_BAR;
            PG8_LDA(At, 1, 1); PG8_STAGE(PG8_SA(1, 0), a3, voffA);
            PG8_BAR; PG8_WAIT_L(0); PG8_MMA(1, 0, At, B0); PG8_BAR; PG8_SCHED;
            PG8_STAGE(PG8_SB(1, 1), b3 + hstep, voffB);
            PG8_WAIT_V(6); PG8_BAR; PG8_MMA(1, 1, At, B1); PG8_BAR;
            }
        }
        if constexpr (ALIGN_EPI) { if (wr == 0) PG8_BAR; }
        if constexpr (!Epi::AFTER_DRAIN) { E(acc, cur, wr, wc, fr, fq); S.done(cur); }
        if (!has_next) break;
#pragma unroll
        for (int a = 0; a < 2; ++a)
#pragma unroll
            for (int b = 0; b < 2; ++b)
#pragma unroll
                for (int m = 0; m < 4; ++m)
#pragma unroll
                    for (int n = 0; n < 2; ++n) acc[a][b][m][n] = (f32x4){0.f, 0.f, 0.f, 0.f};
        cur = nxt; cA = nA; cB = nB; ++ui;
        if constexpr (ALIGN_EPI) { if (wr == 1) PG8_BAR; }
    }
    PG8_WAIT_V(0);
    if constexpr (!ALIGN_EPI) { if (wr == 0) PG8_BAR; }
    PG8_BAR;
    if constexpr (Epi::AFTER_DRAIN) { E.fused(acc, cur, wr, wc, fr, fq, lds, wid, lane); S.done(cur); }
#undef PG8_SA
#undef PG8_SB
#undef PG8_STAGE
#undef PG8_LDA
#undef PG8_LDB
#undef PG8_MMA
#undef PG8_WAIT_V
#undef PG8_WAIT_L
#undef PG8_BAR
#undef PG8_SCHED
}
}
#define GAS __attribute__((address_space(1)))
#define LAS __attribute__((address_space(3)))
typedef unsigned short bf16;
typedef unsigned v4u __attribute__((ext_vector_type(4)));
typedef float f32x4 __attribute__((ext_vector_type(4)));
typedef short bf16x8 __attribute__((ext_vector_type(8)));
typedef GAS unsigned gu32;
typedef GAS unsigned long long gu64;
#define RLX_AGENT __ATOMIC_RELAXED, __HIP_MEMORY_SCOPE_AGENT
#define LDS_WAIT() asm volatile("s_waitcnt lgkmcnt(0)" ::: "memory")
#define VM_WAIT() asm volatile("s_waitcnt vmcnt(0)" ::: "memory")
__device__ __forceinline__ unsigned long long rt() { return __builtin_amdgcn_s_memrealtime(); }
__device__ __forceinline__ unsigned f2bf(float f) { unsigned u = __builtin_bit_cast(unsigned, f); return (u + 0x7fffu + ((u >> 16) & 1u)) >> 16; }
__device__ __forceinline__ unsigned pk2(float lo, float hi) { return f2bf(lo) | (f2bf(hi) << 16); }
#define XB_TMO      128
#define XB_XCNT(j)  (256  + 64 * (j))
#define XB_XSUB(j)  (1280 + 64 * (j))
#define XB_XGEN(j)  (2304 + 64 * (j))
#define XB_TOP      3328
#define XB_TOPGEN   3392
#define XCD_BAR_WORDS 3456
#define XB_SPIN_CAP (1u << 18)

__device__ __forceinline__ unsigned xb_ld(unsigned* p)              { return __hip_atomic_load(p, __ATOMIC_RELAXED, __HIP_MEMORY_SCOPE_AGENT); }
__device__ __forceinline__ unsigned xb_add(unsigned* p, unsigned v) { return __hip_atomic_fetch_add(p, v, __ATOMIC_RELAXED, __HIP_MEMORY_SCOPE_AGENT); }
__device__ __forceinline__ unsigned xb_xcc_id() { return (unsigned)__builtin_amdgcn_s_getreg((3 << 11) | 20) & 0xFu; }
#define XB_SPIN(cond, bar) do { unsigned _sp = 0; while (cond) { __builtin_amdgcn_s_sleep(1); \
    if ((++_sp & 255u) == 0u) { if (xb_ld(&(bar)[XB_TMO])) break; if (_sp > XB_SPIN_CAP) { atomicAdd(&(bar)[XB_TMO], 1u); break; } } } } while (0)

struct XcdBarrier {
    unsigned* bar; unsigned x;
    volatile LAS unsigned* st;
};

__device__ __forceinline__ XcdBarrier xcd_barrier_post(unsigned* bar, volatile LAS unsigned* st) {
    XcdBarrier b; b.bar = bar; b.x = xb_xcc_id(); b.st = st;
    if (threadIdx.x == 0) (void)xb_add(&bar[XB_XCNT(b.x)], 1u);
    return b;
}
__device__ __forceinline__ void xcd_barrier_complete(unsigned* bar, unsigned x, unsigned& nloc, unsigned& nx) {
    const unsigned G = gridDim.x * gridDim.y * gridDim.z;
    unsigned sum, cnt, mine, sp = 0u;
    for (;;) {
        sum = 0u; cnt = 0u; mine = 0u;
#pragma unroll
        for (unsigned j = 0; j < 16; ++j) { const unsigned c = xb_ld(&bar[XB_XCNT(j)]); sum += c; cnt += (c > 0u) ? 1u : 0u; mine = (j == x) ? c : mine; }
        if (sum == G) break;
        __builtin_amdgcn_s_sleep(1);
        if ((++sp & 255u) == 0u) { if (xb_ld(&bar[XB_TMO])) break; if (sp > XB_SPIN_CAP) { atomicAdd(&bar[XB_TMO], 1u); break; } }
    }
    nloc = mine > 0u ? mine : 1u; nx = cnt > 0u ? cnt : 1u;
}

__device__ __forceinline__ void xcd_barrier(const XcdBarrier& b) {
    asm volatile("s_waitcnt vmcnt(0)" ::: "memory");
    __syncthreads();
    if (threadIdx.x == 0) {
        unsigned* bar = b.bar;
        __builtin_amdgcn_s_waitcnt(0);
        unsigned nloc = b.st[0], nx = b.st[1];
        if (nloc == 0u) { xcd_barrier_complete(bar, b.x, nloc, nx); b.st[0] = nloc; b.st[1] = nx; }
        const unsigned old = xb_add(&bar[XB_XSUB(b.x)], 1u);
        const unsigned gen = old / nloc;
        if (old + 1u == (gen + 1u) * nloc) {
            __builtin_amdgcn_fence(__ATOMIC_RELEASE, "agent");
            asm volatile("s_waitcnt vmcnt(0)" ::: "memory");
            const unsigned og = xb_add(&bar[XB_TOP], 1u);
            const unsigned tg = og / nx;
            if (og + 1u == (tg + 1u) * nx) xb_add(&bar[XB_TOPGEN], 1u);
            else XB_SPIN(xb_ld(&bar[XB_TOPGEN]) == tg, bar);
            __builtin_amdgcn_fence(__ATOMIC_ACQUIRE, "agent");
            xb_add(&bar[XB_XGEN(b.x)], 1u);
            asm volatile("s_waitcnt vmcnt(0)" ::: "memory");
        } else {
            XB_SPIN(xb_ld(&bar[XB_XGEN(b.x)]) == gen, bar);
            __builtin_amdgcn_fence(__ATOMIC_ACQUIRE, "agent");
            asm volatile("s_waitcnt vmcnt(0)" ::: "memory");
        }
    }
    __syncthreads();
}

constexpr int D = 1024, SEQ = 8192, NB = 2, MP = NB * SEQ, SB = 128, ST = 8, MS = SB * ST, M = MP + MS;
constexpr int NQKV = 1536, FF = 4096, NKV = 4, HD = 64, KVW = NKV * HD, NG = 64, GC = 16, NS = 64;
constexpr int CH = 256, NCH = SEQ / CH;
constexpr int NPHASE = 22;
constexpr size_t O_KP = 17825792, O_VP = 17956864, O_HRP = 18087936, O_HIP = 18104320, O_KS = 18120704, O_VS = 26509312, O_HRS = 34897920, O_HIS = 35946496, O_END = 36995072;
constexpr size_t MiB = 1u << 20;
constexpr size_t WS_CTL = 0, CTL_ZERO_BYTES = 64 * 1024;
constexpr size_t WS_SSP = 1 * MiB;
constexpr size_t WS_TAB = 5 * MiB + 512 * 1024;
constexpr size_t WS_HS = 6 * MiB;
constexpr size_t WS_WQKV = 8 * MiB, WS_WO = 14 * MiB, WS_WGLU = 18 * MiB, WS_WUP = 26 * MiB, WS_WDN = 58 * MiB;
constexpr size_t WS_XB = 90 * MiB;
constexpr size_t WS_H = 124 * MiB;
constexpr size_t WS_Q = 124 * MiB, WS_K = 158 * MiB, WS_V = 167 * MiB, WS_O = 176 * MiB;
constexpr size_t WS_END = 260 * MiB;
constexpr int CW_BAR = 4096;
static_assert((CW_BAR + XCD_BAR_WORDS) * 4 <= (int)CTL_ZERO_BYTES, "barrier words inside the memset region");
constexpr int RING_BYTES = 131072, XA_BYTES = 4096, LDSCTL_OFF = RING_BYTES + XA_BYTES, MISC_OFF = LDSCTL_OFF + 320, LDS_BYTES = 147456;

__device__ __forceinline__ float wave_sum(float v) {
#pragma unroll
    for (int o = 1; o < 64; o <<= 1) v += __shfl_xor(v, o);
    return v;
}
__device__ __forceinline__ float wave_max(float v) {
#pragma unroll
    for (int o = 1; o < 64; o <<= 1) v = fmaxf(v, __shfl_xor(v, o));
    return v;
}
__device__ __forceinline__ float bf_lo(unsigned u) { return __uint_as_float(u << 16); }
__device__ __forceinline__ float bf_hi(unsigned u) { return __uint_as_float(u & 0xffff0000u); }

namespace pg8 {
constexpr int XMP = 16384;
__device__ __forceinline__ float row_rinv(const float* ssp, int row, int np, int fq) {
    const float* p = ssp + (size_t)row * 64 + (np >> 2) * fq; float s = 0.f;
    for (int i = 0; i < (np >> 4); ++i) { const f32x4 v = *(const f32x4*)(p + 4 * i); s += (v[0] + v[1]) + (v[2] + v[3]); }
    s += __shfl_xor(s, 16); s += __shfl_xor(s, 32);
    return rsqrtf(s * (1.0f / 1024.0f) + 1e-6f);
}
__device__ __forceinline__ u32x4 pack8(const f32x4 a, const f32x4 b) { u32x4 w; w.x = cvt_pk_bf16(a[0], a[1]); w.y = cvt_pk_bf16(a[2], a[3]); w.z = cvt_pk_bf16(b[0], b[1]); w.w = cvt_pk_bf16(b[2], b[3]); return w; }
typedef unsigned u32x2 __attribute__((ext_vector_type(2)));
__device__ __forceinline__ u32x2 pack4(const f32x4 a) { u32x2 w; w.x = cvt_pk_bf16(a[0], a[1]); w.y = cvt_pk_bf16(a[2], a[3]); return w; }
__device__ __forceinline__ float sumsq4(const f32x4 v) { return (v[0] * v[0] + v[1] * v[1]) + (v[2] * v[2] + v[3] * v[3]); }

struct EpiQKV {
    static constexpr bool PERM = true, AFTER_DRAIN = false;
    bf16_t *Q, *K, *V; const float* ssp; int np, nps; float *kp, *vp, *ks, *vs;
    __device__ __forceinline__ void operator()(const f32x4 (&acc)[2][2][4][2], const f32x4 (&accx)[2], const Unit& u, int wr, int wc, int fr, int fq) const {
        const int rowb = u.pm * BM + wr * 64 + fr, pn = u.pn;
#pragma unroll
        for (int ai = 0; ai < 2; ++ai)
#pragma unroll
            for (int m = 0; m < 4; ++m) {
                const int row = rowb + ai * HALF + m * 16;
                const float r = row_rinv(ssp, row, np, fq);
#pragma unroll
                for (int bj = 0; bj < 2; ++bj) {
                    const f32x4 v0 = acc[ai][bj][m][0] * r, v1 = acc[ai][bj][m][1] * r;
                    const int cl = bj * HALF + wc * 32 + 8 * fq;
                    const u32x4 w = pack8(v0, v1);
                    if (pn < 4) { *(u32x4*)(Q + (size_t)row * 1024 + pn * 256 + cl) = w; }
                    else {
                        bf16_t* B = (pn == 4) ? K : V;
                        *(u32x4*)(B + (size_t)row * 256 + cl) = w;
                        const int t = row & 8191;
                        if (t >= 8064) { float* o = ((pn == 4) ? kp : vp) + ((size_t)(row >> 13) * 128 + (t - 8064)) * 256 + cl; *(f32x4*)o = v0; *(f32x4*)(o + 4) = v1; }
                    }
                }
            }
        {
            const int xrow = u.pm * 16 + fr, row = XMP + xrow;
            const float r = row_rinv(ssp, row, nps, fq);
#pragma unroll
            for (int bj = 0; bj < 2; ++bj) {
                const f32x4 v = accx[bj] * r;
                const int cl = bj * HALF + wc * 32 + 8 * fq + 4 * wr;
                const u32x2 w = pack4(v);
                if (pn < 4) { *(u32x2*)(Q + (size_t)row * 1024 + pn * 256 + cl) = w; }
                else {
                    bf16_t* B = (pn == 4) ? K : V;
                    *(u32x2*)(B + (size_t)row * 256 + cl) = w;
                    float* o = ((pn == 4) ? ks : vs) + ((size_t)(xrow >> 3) * 128 + 120 + (xrow & 7)) * 256 + cl; *(f32x4*)o = v;
                }
            }
        }
    }
};
struct EpiRes {
    static constexpr bool PERM = true, AFTER_DRAIN = false;
    const float* xp; const float* xs; float* XR; bf16_t* XB; float* ssp;
    __device__ __forceinline__ void operator()(const f32x4 (&acc)[2][2][4][2], const f32x4 (&accx)[2], const Unit& u, int wr, int wc, int fr, int fq) const {
        const int rowb = u.pm * BM + wr * 64 + fr, pn = u.pn;
#pragma unroll
        for (int ai = 0; ai < 2; ++ai)
#pragma unroll
            for (int m = 0; m < 4; ++m) {
                const int row = rowb + ai * HALF + m * 16;
                const float* old = xp + (size_t)row * 1024;
                float ss = 0.f;
#pragma unroll
                for (int bj = 0; bj < 2; ++bj) {
                    const int col = pn * 256 + bj * HALF + wc * 32 + 8 * fq;
                    const f32x4 o0 = *(const f32x4*)(old + col), o1 = *(const f32x4*)(old + col + 4);
                    const f32x4 v0 = acc[ai][bj][m][0] + o0, v1 = acc[ai][bj][m][1] + o1;
                    *(f32x4*)(XR + (size_t)row * 1024 + col) = v0; *(f32x4*)(XR + (size_t)row * 1024 + col + 4) = v1;
                    *(u32x4*)(XB + (size_t)row * 1024 + col) = pack8(v0, v1);
                    ss += sumsq4(v0) + sumsq4(v1);
                }
                ss += __shfl_xor(ss, 16); ss += __shfl_xor(ss, 32);
                if (fq == 0) ssp[(size_t)row * 64 + pn * 4 + wc] = ss;
                asm volatile("" ::: "memory");
            }
        {
            const int xrow = u.pm * 16 + fr, row = XMP + xrow;
            const float* old = xs + (size_t)xrow * 1024;
            float ss = 0.f;
#pragma unroll
            for (int bj = 0; bj < 2; ++bj) {
                const int col = pn * 256 + bj * HALF + wc * 32 + 8 * fq + 4 * wr;
                const f32x4 v = accx[bj] + *(const f32x4*)(old + col);
                *(f32x4*)(XR + (size_t)row * 1024 + col) = v;
                *(u32x2*)(XB + (size_t)row * 1024 + col) = pack4(v);
                ss += sumsq4(v);
            }
            ss += __shfl_xor(ss, 16); ss += __shfl_xor(ss, 32);
            if (fq == 0) ssp[(size_t)row * 64 + (pn * 4 + wc) * 2 + wr] = ss;
        }
    }
};
struct EpiGlu {
    static constexpr bool PERM = true, AFTER_DRAIN = false;
    float* XR; bf16_t* XB; float* ssp;
    __device__ __forceinline__ void operator()(const f32x4 (&acc)[2][2][4][2], const f32x4 (&accx)[2], const Unit& u, int wr, int wc, int fr, int fq) const {
        const int rowb = u.pm * BM + wr * 64 + fr, pn = u.pn;
#pragma unroll
        for (int ai = 0; ai < 2; ++ai)
#pragma unroll
            for (int m = 0; m < 4; ++m) {
                const int row = rowb + ai * HALF + m * 16;
                const int col = pn * 128 + wc * 32 + 8 * fq;
                float* xr = XR + (size_t)row * 1024 + col;
                const f32x4 o0 = *(const f32x4*)xr, o1 = *(const f32x4*)(xr + 4);
                f32x4 v0, v1;
#pragma unroll
                for (int e = 0; e < 4; ++e) {
                    v0[e] = o0[e] + acc[ai][0][m][0][e] * (1.0f / (1.0f + __expf(-acc[ai][1][m][0][e])));
                    v1[e] = o1[e] + acc[ai][0][m][1][e] * (1.0f / (1.0f + __expf(-acc[ai][1][m][1][e])));
                }
                *(f32x4*)xr = v0; *(f32x4*)(xr + 4) = v1;
                *(u32x4*)(XB + (size_t)row * 1024 + col) = pack8(v0, v1);
                float ss = sumsq4(v0) + sumsq4(v1);
                ss += __shfl_xor(ss, 16); ss += __shfl_xor(ss, 32);
                if (fq == 0) ssp[(size_t)row * 64 + pn * 4 + wc] = ss;
                asm volatile("" ::: "memory");
            }
        {
            const int xrow = u.pm * 16 + fr, row = XMP + xrow;
            const int col = pn * 128 + wc * 32 + 8 * fq + 4 * wr;
            float* xr = XR + (size_t)row * 1024 + col;
            const f32x4 o0 = *(const f32x4*)xr;
            f32x4 v;
#pragma unroll
            for (int e = 0; e < 4; ++e) v[e] = o0[e] + accx[0][e] * (1.0f / (1.0f + __expf(-accx[1][e])));
            *(f32x4*)xr = v;
            *(u32x2*)(XB + (size_t)row * 1024 + col) = pack4(v);
            float ss = sumsq4(v);
            ss += __shfl_xor(ss, 16); ss += __shfl_xor(ss, 32);
            if (fq == 0) ssp[(size_t)row * 64 + (pn * 4 + wc) * 2 + wr] = ss;
        }
    }
};
struct EpiUp {
    static constexpr bool PERM = true, AFTER_DRAIN = false;
    bf16_t* H; const float* ssp; int np, nps;
    __device__ __forceinline__ void operator()(const f32x4 (&acc)[2][2][4][2], const f32x4 (&accx)[2], const Unit& u, int wr, int wc, int fr, int fq) const {
        const int rowb = u.pm * BM + wr * 64 + fr, pn = u.pn;
#pragma unroll
        for (int ai = 0; ai < 2; ++ai)
#pragma unroll
            for (int m = 0; m < 4; ++m) {
                const int row = rowb + ai * HALF + m * 16;
                const float r = row_rinv(ssp, row, np, fq);
#pragma unroll
                for (int bj = 0; bj < 2; ++bj) {
                    f32x4 v0 = acc[ai][bj][m][0] * r, v1 = acc[ai][bj][m][1] * r;
#pragma unroll
                    for (int e = 0; e < 4; ++e) { const float a = fmaxf(v0[e], 0.f), b = fmaxf(v1[e], 0.f); v0[e] = a * a; v1[e] = b * b; }
                    *(u32x4*)(H + (size_t)row * 4096 + pn * 256 + bj * HALF + wc * 32 + 8 * fq) = pack8(v0, v1);
                }
            }
        {
            const int xrow = u.pm * 16 + fr, row = XMP + xrow;
            const float r = row_rinv(ssp, row, nps, fq);
#pragma unroll
            for (int bj = 0; bj < 2; ++bj) {
                f32x4 v = accx[bj] * r;
#pragma unroll
                for (int e = 0; e < 4; ++e) { const float a = fmaxf(v[e], 0.f); v[e] = a * a; }
                *(u32x2*)(H + (size_t)row * 4096 + pn * 256 + bj * HALF + wc * 32 + 8 * fq + 4 * wr) = pack4(v);
            }
        }
    }
};

template <class Epi, class Sched>
__device__ __forceinline__ void gemm_phase_x(PG8_LAS unsigned char* lds, const Gemm g, const Sched& S, const Epi& E) {
    int tid_ = threadIdx.x; asm volatile("" : "+v"(tid_));
    const int tid = tid_, wid = __builtin_amdgcn_readfirstlane(tid >> 6), lane = tid & 63, wr = wid >> 2, wc = wid & 3, fr = lane & 15, fq = lane >> 4;
    const int K = g.K, nt = K / BK;
    unsigned voffA[2], voffB[2], voffX;
#pragma unroll
    for (int i = 0; i < 2; ++i) { int R, C; stage_rc(tid * 16 + i * 8192, R, C); const int Rb = Epi::PERM ? ((R & ~31) + perm32(R & 31)) : R;
        voffA[i] = (unsigned)(R * K + C) * 2u; voffB[i] = (unsigned)(Rb * K + C) * 2u; }
    { int R, C; const int p = wid * 256 + lane * 4; stage_rc(p & ~15, R, C); voffX = (unsigned)(R * K + C) * 2u + (unsigned)(p & 15); }
    const size_t kstep = (size_t)(BK * 2);
    const size_t hstep = (size_t)HALF * K * 2;
    const size_t tstep = 2 * hstep;
    const size_t xstep = (size_t)16 * K * 2;
    const unsigned ldsw = (unsigned)wid * 1024u, ldsx = (unsigned)wid * 256u;
    const int aoff = lds_byte(wr * 64 + fr, fq * 8), boff = lds_byte(wc * 32 + fr, fq * 8), xoff = lds_byte(fr, fq * 8);
#define PG8_SA(b, h) (((b) * 2 + (h)) * HTB)
#define PG8_SB(b, h) ((4 + (b) * 2 + (h)) * HTB)
#define PG8_XA(b) (STAGE_BYTES + (b) * 2048)
#define PG8_STAGE(bufoff, gbase, voff) do { _Pragma("unroll") for (int _i = 0; _i < 2; ++_i) \
        __builtin_amdgcn_global_load_lds((const unsigned*)((const char*)(gbase) + (voff)[_i]), (PG8_LAS unsigned*)(lds + (bufoff) + ldsw + _i * 8192), 16, 0, 0); } while (0)
#define PG8_STAGEX(b, gbase) __builtin_amdgcn_global_load_lds((const unsigned*)((const char*)(gbase) + voffX), (PG8_LAS unsigned*)(lds + PG8_XA(b) + ldsx), 4, 0, 0)
#define PG8_LDA(dst, b, h) do { _Pragma("unroll") for (int m = 0; m < 4; ++m) _Pragma("unroll") for (int k = 0; k < 2; ++k) dst[m][k] = *(const PG8_LAS bf16x8*)(lds + PG8_SA(b, h) + aoff + m * 2048 + k * 1024); } while (0)
#define PG8_LDB(dst, b, h) do { _Pragma("unroll") for (int n = 0; n < 2; ++n) _Pragma("unroll") for (int k = 0; k < 2; ++k) dst[n][k] = *(const PG8_LAS bf16x8*)(lds + PG8_SB(b, h) + boff + n * 2048 + k * 1024); } while (0)
#define PG8_LDX(dst, b) do { _Pragma("unroll") for (int k = 0; k < 2; ++k) dst[k] = *(const PG8_LAS bf16x8*)(lds + PG8_XA(b) + xoff + k * 1024); } while (0)
#define PG8_MMA(ai, bj, At, Bt) do { __builtin_amdgcn_s_setprio(1); _Pragma("unroll") for (int m = 0; m < 4; ++m) _Pragma("unroll") for (int n = 0; n < 2; ++n) _Pragma("unroll") for (int k = 0; k < 2; ++k) \
        acc[ai][bj][m][n] = __builtin_amdgcn_mfma_f32_16x16x32_bf16(Bt[n][k], At[m][k], acc[ai][bj][m][n], 0, 0, 0); __builtin_amdgcn_s_setprio(0); } while (0)
#define PG8_XMMA() do { if (wr == 0) { _Pragma("unroll") for (int k = 0; k < 2; ++k) { accx[0] = __builtin_amdgcn_mfma_f32_16x16x32_bf16(B0[0][k], Ax[k], accx[0], 0, 0, 0); accx[1] = __builtin_amdgcn_mfma_f32_16x16x32_bf16(B1[0][k], Ax[k], accx[1], 0, 0, 0); } } \
        else { _Pragma("unroll") for (int k = 0; k < 2; ++k) { accx[0] = __builtin_amdgcn_mfma_f32_16x16x32_bf16(B0[1][k], Ax[k], accx[0], 0, 0, 0); accx[1] = __builtin_amdgcn_mfma_f32_16x16x32_bf16(B1[1][k], Ax[k], accx[1], 0, 0, 0); } } } while (0)
#define PG8_WAIT_V(n) asm volatile("s_waitcnt vmcnt(" #n ")" ::: "memory")
#define PG8_WAIT_L(n) asm volatile("s_waitcnt lgkmcnt(" #n ")" ::: "memory")
#define PG8_BAR __builtin_amdgcn_s_barrier()
#define PG8_SCHED __builtin_amdgcn_sched_barrier(0)
    Unit cur, nxt; int ui = 0;
    if (!S.next(0, cur)) return;
    f32x4 acc[2][2][4][2]; f32x4 accx[2];
#pragma unroll
    for (int a = 0; a < 2; ++a)
#pragma unroll
        for (int b = 0; b < 2; ++b)
#pragma unroll
            for (int m = 0; m < 4; ++m)
#pragma unroll
                for (int n = 0; n < 2; ++n) acc[a][b][m][n] = (f32x4){0.f, 0.f, 0.f, 0.f};
    accx[0] = (f32x4){0.f, 0.f, 0.f, 0.f}; accx[1] = (f32x4){0.f, 0.f, 0.f, 0.f};
    bf16x8 At[4][2], B0[2][2], B1[2][2], Ax[2];
    const char* const xbase = (const char*)g.A + (size_t)XMP * K * 2;
    const char* cA = (const char*)g.A + (size_t)cur.pm * tstep; const char* cB = (const char*)g.Bt + (size_t)cur.pn * tstep; const char* cX = xbase + (size_t)cur.pm * xstep;
    S.a_ready(cur);
    PG8_STAGE(PG8_SB(0, 0), cB, voffB); PG8_STAGE(PG8_SB(0, 1), cB + hstep, voffB); PG8_STAGE(PG8_SA(0, 0), cA, voffA); PG8_STAGEX(0, cX); PG8_STAGE(PG8_SA(0, 1), cA + hstep, voffA);
    if (wr == 1) PG8_BAR;
    PG8_WAIT_V(2); PG8_BAR;
    PG8_STAGE(PG8_SB(1, 0), cB + kstep, voffB); PG8_STAGE(PG8_SA(1, 0), cA + kstep, voffA); PG8_STAGE(PG8_SB(1, 1), cB + hstep + kstep, voffB); PG8_STAGEX(1, cX + kstep);
    PG8_WAIT_V(7); PG8_BAR;
    for (;;) {
        const bool has_next = S.next(ui + 1, nxt);
        const char* nA = has_next ? (const char*)g.A + (size_t)nxt.pm * tstep : cA; const char* nB = has_next ? (const char*)g.Bt + (size_t)nxt.pn * tstep : cB; const char* nX = has_next ? xbase + (size_t)nxt.pm * xstep : cX;
        for (int t = 0; t < nt; t += 2) {
            const bool last = (t == nt - 2);
            const char* a1 = cA + (size_t)(t + 1) * kstep;
            const char* a2 = last ? nA : cA + (size_t)(t + 2) * kstep; const char* b2 = last ? nB : cB + (size_t)(t + 2) * kstep; const char* x2 = last ? nX : cX + (size_t)(t + 2) * kstep;
            const char* a3 = a2 + kstep; const char* b3 = b2 + kstep; const char* x3 = x2 + kstep;
            if (last && has_next) S.a_ready(nxt);
            PG8_LDB(B0, 0, 0); PG8_LDB(B1, 0, 1); PG8_SCHED; PG8_LDA(At, 0, 0); PG8_LDX(Ax, 0); PG8_STAGE(PG8_SA(1, 1), a1 + hstep, voffA);
            PG8_WAIT_V(9); PG8_WAIT_L(0); PG8_BAR; PG8_MMA(0, 0, At, B0); PG8_MMA(0, 1, At, B1); PG8_XMMA(); PG8_BAR; PG8_SCHED;
            PG8_LDA(At, 0, 1); PG8_STAGE(PG8_SB(0, 0), b2, voffB); PG8_STAGE(PG8_SB(0, 1), b2 + hstep, voffB); PG8_STAGE(PG8_SA(0, 0), a2, voffA); PG8_STAGEX(0, x2);
            PG8_WAIT_V(9); PG8_WAIT_L(0); PG8_BAR; PG8_MMA(1, 0, At, B0); PG8_MMA(1, 1, At, B1); PG8_BAR; PG8_SCHED;
            PG8_LDB(B0, 1, 0); PG8_LDB(B1, 1, 1); PG8_SCHED; PG8_LDA(At, 1, 0); PG8_LDX(Ax, 1); PG8_STAGE(PG8_SA(0, 1), a2 + hstep, voffA);
            PG8_WAIT_V(9); PG8_WAIT_L(0); PG8_BAR; PG8_MMA(0, 0, At, B0); PG8_MMA(0, 1, At, B1); PG8_XMMA(); PG8_BAR; PG8_SCHED;
            PG8_LDA(At, 1, 1); PG8_STAGE(PG8_SB(1, 0), b3, voffB); PG8_STAGE(PG8_SB(1, 1), b3 + hstep, voffB); PG8_STAGE(PG8_SA(1, 0), a3, voffA); PG8_STAGEX(1, x3);
            PG8_WAIT_V(9); PG8_WAIT_L(0); PG8_BAR; PG8_MMA(1, 0, At, B0); PG8_MMA(1, 1, At, B1); PG8_BAR; PG8_SCHED;
        }
        if (wr == 0) PG8_BAR;
        { int fr_ = fr, fq_ = fq; asm volatile("" : "+v"(fr_), "+v"(fq_));
          E(acc, accx, cur, wr, wc, fr_, fq_); } S.done(cur);
        if (!has_next) break;
#pragma unroll
        for (int a = 0; a < 2; ++a)
#pragma unroll
            for (int b = 0; b < 2; ++b)
#pragma unroll
                for (int m = 0; m < 4; ++m)
#pragma unroll
                    for (int n = 0; n < 2; ++n) acc[a][b][m][n] = (f32x4){0.f, 0.f, 0.f, 0.f};
        accx[0] = (f32x4){0.f, 0.f, 0.f, 0.f}; accx[1] = (f32x4){0.f, 0.f, 0.f, 0.f};
        cur = nxt; cA = nA; cB = nB; cX = nX; ++ui;
        if (wr == 1) PG8_BAR;
    }
    PG8_WAIT_V(0);
    PG8_BAR;
#undef PG8_SA
#undef PG8_SB
#undef PG8_XA
#undef PG8_STAGE
#undef PG8_STAGEX
#undef PG8_LDA
#undef PG8_LDB
#undef PG8_LDX
#undef PG8_MMA
#undef PG8_XMMA
#undef PG8_WAIT_V
#undef PG8_WAIT_L
#undef PG8_BAR
#undef PG8_SCHED
}
}

__device__ __forceinline__ void p0_transpose_item(const float* W, int K, int N, const float* gain, bf16* WT, int glu, LAS float* scr, int item, int lane) {
    const int nblk = N / 32, kb = item / nblk, nb = item % nblk, k0 = 64 * kb, n0 = 32 * nb;
#pragma unroll 8
    for (int i = 0; i < 32; ++i) { const int kk = 2 * i + (lane >> 5); float w = W[(size_t)(k0 + kk) * N + n0 + (lane & 31)]; if (gain) w *= gain[k0 + kk]; scr[kk * 33 + (lane & 31)] = w; }
    LDS_WAIT(); asm volatile("" ::: "memory");
    int drow0 = n0; if (glu) { const int bj = n0 / 1024, rem = n0 % 1024; drow0 = (rem / 128) * 256 + bj * 128 + (rem % 128); }
    const int c = lane & 7;
#pragma unroll
    for (int j = 0; j < 4; ++j) { const int n = (lane >> 3) + 8 * j; const LAS float* s = scr + (8 * c) * 33 + n;
        v4u o; o.x = pk2(s[0 * 33], s[1 * 33]); o.y = pk2(s[2 * 33], s[3 * 33]); o.z = pk2(s[4 * 33], s[5 * 33]); o.w = pk2(s[6 * 33], s[7 * 33]);
        *(GAS v4u*)(WT + (size_t)(drow0 + n) * K + k0 + 8 * c) = o; }
    LDS_WAIT(); asm volatile("" ::: "memory");
}

__device__ __forceinline__ void sincos_rr(float x, float& s, float& c) {
    const float q = rintf(x * 0.63661977236758f);
    float r = fmaf(-q, 1.57079637050629f, x); r = fmaf(-q, -4.37113882867379e-8f, r);
    const float r2 = r * r;
    const float sp = r + r * r2 * (-1.6666667163e-1f + r2 * (8.3333337680e-3f + r2 * (-1.9841270114e-4f + r2 * 2.7557314297e-6f)));
    const float cp = 1.0f + r2 * (-0.5f + r2 * (4.1666667908e-2f + r2 * (-1.3888889225e-3f + r2 * (2.4801587642e-5f + r2 * -2.7557314297e-7f))));
    const int qi = (int)q & 3;
    s = (qi == 0) ? sp : (qi == 1) ? cp : (qi == 2) ? -sp : -cp;
    c = (qi == 0) ? cp : (qi == 1) ? -sp : (qi == 2) ? -cp : sp;
}

typedef float f32x16 __attribute__((ext_vector_type(16)));
typedef unsigned u32x2 __attribute__((ext_vector_type(2)));
struct SsmC { const float *tab, *B_re, *B_im, *C_re, *C_im, *Dk, *gain; };
__device__ __forceinline__ void ssm_abar_calc(const float* A_re, const float* A_im, const float* log_dt, int g, int n, float& abr, float& abi, float& cfr, float& cfi) {
    const float dt = expf(log_dt[g]);
    const float ar = A_re[g * 64 + n], ai = A_im[g * 64 + n];
    const float mag = expf(dt * ar); float sn, cs; sincos_rr(dt * ai, sn, cs);
    abr = mag * cs; abi = mag * sn;
    const float den = ar * ar + ai * ai, nr = abr - 1.0f;
    cfr = (nr * ar + abi * ai) / den; cfi = (abi * ar - nr * ai) / den;
}
__device__ __forceinline__ void ssm_abar(const SsmC& c, int g, int n, float& abr, float& abi, float& cfr, float& cfi) {
    const f32x4 v = *(const f32x4*)(c.tab + ((size_t)g * 64 + n) * 4); abr = v[0]; abi = v[1]; cfr = v[2]; cfi = v[3];
}
__device__ __forceinline__ float gelu_tanh(float y) {
    const float z = 0.7978845608028654f * (y + 0.044715f * y * y * y);
    return y / (1.0f + __expf(-2.0f * z));
}
template <bool FULL>
__device__ __forceinline__ void ssm_unit(LAS float* xs, LAS float* hb, int lane, int g, const SsmC& c, const float* XR, const float* ssp, int nsl, int row0, int L, float& hr, float& hi, bf16* Gout) {
    float abr, abi, cfr, cfi; ssm_abar(c, g, lane, abr, abi, cfr, cfi);
    float Br[16], Bi[16];
#pragma unroll
    for (int c4 = 0; c4 < 4; ++c4) {
        const f32x4 br = *(const f32x4*)(c.B_re + ((size_t)g * 64 + lane) * 16 + 4 * c4), bi = *(const f32x4*)(c.B_im + ((size_t)g * 64 + lane) * 16 + 4 * c4), gn = *(const f32x4*)(c.gain + g * 16 + 4 * c4);
#pragma unroll
        for (int e = 0; e < 4; ++e) { Br[4 * c4 + e] = (cfr * br[e] - cfi * bi[e]) * gn[e]; Bi[4 * c4 + e] = (cfr * bi[e] + cfi * br[e]) * gn[e]; }
    }
    const int cc = lane & 15, q = lane >> 4;
    float Cq[32]; float Dg = 0.f;
    if (FULL) {
        const float* src = ((q < 2) ? c.C_re : c.C_im) + ((size_t)g * 16 + cc) * 64 + 32 * (q & 1); const float sg = (q < 2) ? 1.0f : -1.0f;
#pragma unroll
        for (int i4 = 0; i4 < 8; ++i4) { const f32x4 v = *(const f32x4*)(src + 4 * i4);
#pragma unroll
            for (int e = 0; e < 4; ++e) Cq[4 * i4 + e] = sg * v[e]; }
        Dg = c.Dk[g * 16 + cc] * c.gain[g * 16 + cc];
    }
    for (int t0 = 0; t0 < L; t0 += 64) {
        const int cnt = (L - t0) < 64 ? (L - t0) : 64;
        if (lane < cnt) {
            const int row = row0 + t0 + lane;
            const float* sp = ssp + (size_t)row * 64; float ss = 0.f;
            for (int i4 = 0; i4 < (nsl >> 2); ++i4) { const f32x4 sv = *(const f32x4*)(sp + 4 * i4); ss += (sv[0] + sv[1]) + (sv[2] + sv[3]); }
            const float rinv = rsqrtf(ss * (1.0f / 1024.0f) + 1e-6f);
            const float* xr = XR + (size_t)row * 1024 + g * 16;
#pragma unroll
            for (int c4 = 0; c4 < 4; ++c4) { const f32x4 v = *(const f32x4*)(xr + 4 * c4); *(LAS f32x4*)(xs + lane * 16 + 4 * c4) = v * rinv; }
        }
        LDS_WAIT(); asm volatile("" ::: "memory");
        float ykeep = 0.f;
        for (int tt = 0; tt < cnt; ++tt) {
            float inr = 0.f, ini = 0.f;
#pragma unroll
            for (int c4 = 0; c4 < 4; ++c4) { const f32x4 xv = *(const LAS f32x4*)(xs + tt * 16 + 4 * c4);
#pragma unroll
                for (int e = 0; e < 4; ++e) { inr = fmaf(xv[e], Br[4 * c4 + e], inr); ini = fmaf(xv[e], Bi[4 * c4 + e], ini); } }
            const float nhr = abr * hr - abi * hi + inr, nhi = abr * hi + abi * hr + ini; hr = nhr; hi = nhi;
            if (FULL) {
                hb[lane] = hr; hb[64 + lane] = hi;
                LDS_WAIT(); asm volatile("" ::: "memory");
                float part = 0.f;
#pragma unroll
                for (int i4 = 0; i4 < 8; ++i4) { const f32x4 hv = *(const LAS f32x4*)(hb + 32 * q + 4 * i4);
#pragma unroll
                    for (int e = 0; e < 4; ++e) part = fmaf(hv[e], Cq[4 * i4 + e], part); }
                part += __shfl_xor(part, 16); part += __shfl_xor(part, 32);
                const float y = part + Dg * xs[tt * 16 + cc];
                if ((tt & 3) == q) ykeep = y;
                if ((tt & 3) == 3) Gout[(size_t)(row0 + t0 + (tt & ~3) + q) * 1024 + g * 16 + cc] = (bf16)f2bf(gelu_tanh(ykeep));
                asm volatile("" ::: "memory");
            }
        }
        LDS_WAIT(); asm volatile("" ::: "memory");
    }
}

#ifndef EN_P0
#define EN_P0 1
#endif
#ifndef EN_QKV
#define EN_QKV 1
#endif
#ifndef EN_ATT
#define EN_ATT 1
#endif
#ifndef EN_OPJ
#define EN_OPJ 1
#endif
#ifndef EN_S1
#define EN_S1 1
#endif
#ifndef EN_S3
#define EN_S3 1
#endif
#ifndef EN_GLU
#define EN_GLU 1
#endif
#ifndef EN_UP
#define EN_UP 1
#endif
#ifndef EN_DN
#define EN_DN 1
#endif
#ifndef EN_FIN
#define EN_FIN 1
#endif
template <class T> __device__ __forceinline__ T karg(const __attribute__((address_space(4))) char* ka, int off) { typedef const __attribute__((address_space(4))) T CT; return *(CT*)(ka + off); }
struct Args { const float* in[23]; float* out; unsigned char* ws; int ph_lo, ph_hi; };
static_assert(sizeof(Args) == 208 && __builtin_offsetof(Args, out) == 184 && __builtin_offsetof(Args, ws) == 192, "kernarg layout used by KARG");

__global__ void __launch_bounds__(512, 2) fwd_kernel(Args args) {
    extern __shared__ __attribute__((aligned(16))) unsigned char lds[];
    LAS unsigned char* const L = (LAS unsigned char*)lds;
#define FRESH_IDS int tid = threadIdx.x; asm volatile("" : "+v"(tid)); const int lane = tid & 63, wave = __builtin_amdgcn_readfirstlane(tid >> 6); const int gw = vcu * 8 + wave; (void)lane; (void)gw
    const int G = gridDim.x, bx = blockIdx.x;
    const int vcu = (G % 8 == 0) ? (bx % 8) * (G / 8) + bx / 8 : bx;
    const int NGW = G * 8;
    for (int u = threadIdx.x; u < (LDS_BYTES - LDSCTL_OFF) / 4; u += 512) ((LAS unsigned*)(L + LDSCTL_OFF))[u] = 0u;
    __syncthreads();
    const int lo = args.ph_lo, hi = args.ph_hi;
    const bool multi = (hi - lo) > 1;
    XcdBarrier bar; bar.bar = (unsigned*)(args.ws + WS_CTL) + CW_BAR; bar.x = 0; bar.st = nullptr;
    if (multi) bar = xcd_barrier_post((unsigned*)(args.ws + WS_CTL) + CW_BAR, (volatile LAS unsigned*)(L + MISC_OFF) + 8);
#define IN(k) (lo <= (k) && (k) < hi)
#define SEAM(k) do { if (IN(k) && IN((k) + 1)) xcd_barrier(bar); } while (0)

#define KARG(T, off) karg<T>(ka, (off))
#define INP(k) karg<const float*>(ka, 8 * (k))
#define FRESH_PTRS const __attribute__((address_space(4))) char* ka = (const __attribute__((address_space(4))) char*)__builtin_amdgcn_kernarg_segment_ptr(); asm volatile("" : "+s"(ka)); \
    unsigned char* const ws = KARG(unsigned char*, 192); float* const out = KARG(float*, 184); \
    float* const ssp = (float*)(ws + WS_SSP); float* const HS = (float*)(ws + WS_HS); bf16* const XB = (bf16*)(ws + WS_XB); bf16* const Hb = (bf16*)(ws + WS_H); \
    bf16* const Qb = (bf16*)(ws + WS_Q); bf16* const Kb = (bf16*)(ws + WS_K); bf16* const Vb = (bf16*)(ws + WS_V); bf16* const Ob = (bf16*)(ws + WS_O); \
    const float* const x_p = INP(0); const float* const x_s = INP(1); (void)ssp; (void)HS; (void)XB; (void)Hb; (void)Qb; (void)Kb; (void)Vb; (void)Ob; (void)x_p; (void)x_s
    if (EN_P0 && IN(0)) {
        FRESH_IDS; FRESH_PTRS;
        LAS float* scr = (LAS float*)(L + wave * 16384);
        constexpr int I_QKV = 16 * 48, I_O = 16 * 32, I_GLU = 16 * 64, I_UP = 16 * 128, I_DN = 64 * 32;
        constexpr int NITEMS = 2 * I_QKV + 2 * I_O + 2 * I_GLU + 4 * I_UP + 4 * I_DN;
        for (int it = gw; it < NITEMS; it += NGW) {
            int r = it;
            if (r < 2 * I_QKV) { const int j = r / I_QKV; r -= j * I_QKV; p0_transpose_item(INP(9) + (size_t)j * D * NQKV, D, NQKV, INP(6) + (size_t)(2 * j) * D, (bf16*)(ws + WS_WQKV) + (size_t)j * NQKV * D, 0, scr, r, lane); continue; } r -= 2 * I_QKV;
            if (r < 2 * I_O) { const int j = r / I_O; r -= j * I_O; p0_transpose_item(INP(10) + (size_t)j * D * D, D, D, nullptr, (bf16*)(ws + WS_WO) + (size_t)j * D * D, 0, scr, r, lane); continue; } r -= 2 * I_O;
            if (r < 2 * I_GLU) { const int j = r / I_GLU; r -= j * I_GLU; p0_transpose_item(INP(20) + (size_t)j * D * 2 * D, D, 2 * D, nullptr, (bf16*)(ws + WS_WGLU) + (size_t)j * 2 * D * D, 1, scr, r, lane); continue; } r -= 2 * I_GLU;
            if (r < 4 * I_UP) { const int l = r / I_UP; r -= l * I_UP; p0_transpose_item(INP(21) + (size_t)l * D * FF, D, FF, INP(7) + (size_t)l * D, (bf16*)(ws + WS_WUP) + (size_t)l * FF * D, 0, scr, r, lane); continue; } r -= 4 * I_UP;
            { const int l = r / I_DN; r -= l * I_DN; p0_transpose_item(INP(22) + (size_t)l * FF * D, FF, D, nullptr, (bf16*)(ws + WS_WDN) + (size_t)l * D * FF, 0, scr, r, lane); }
        }
        for (int m = gw; m < M; m += NGW) {
            const float* xrow = (m < MP) ? x_p + (size_t)m * D : x_s + (size_t)(m - MP) * D;
            const GAS f32x4* xr = (const GAS f32x4*)xrow + lane;
            f32x4 v[4]; float s = 0.f;
#pragma unroll
            for (int j = 0; j < 4; ++j) { v[j] = xr[64 * j]; s += (v[j][0] * v[j][0] + v[j][1] * v[j][1]) + (v[j][2] * v[j][2] + v[j][3] * v[j][3]); }
            s = wave_sum(s);
            GAS unsigned long long* o8 = (GAS unsigned long long*)(XB + (size_t)m * D) + lane;
#pragma unroll
            for (int j = 0; j < 4; ++j) o8[64 * j] = (unsigned long long)pk2(v[j][0], v[j][1]) | ((unsigned long long)pk2(v[j][2], v[j][3]) << 32);
            if (lane < 32) ssp[(size_t)m * 64 + lane] = (lane == 0) ? s : 0.f;
        }
        for (int i = bx * 512 + tid; i < 2 * NG * NS; i += G * 512) {
            const int jj = i >> 12, gn = i & 4095; float abr, abi, cfr, cfi;
            ssm_abar_calc(INP(12) + (size_t)jj * NG * NS, INP(13) + (size_t)jj * NG * NS, INP(14) + (size_t)jj * NG, gn >> 6, gn & 63, abr, abi, cfr, cfi);
            f32x4 v; v[0] = abr; v[1] = abi; v[2] = cfr; v[3] = cfi; *(f32x4*)((float*)(ws + WS_TAB) + (size_t)i * 4) = v;
        }
        {
            constexpr int PER = 120 * 256 / 4;
            constexpr int TOT = 2 * 2 * SB * PER;
            for (int i = bx * 512 + tid; i < TOT; i += G * 512) {
                const int kv = i / (2 * SB * PER), rem = i % (2 * SB * PER), jb = rem / PER, e = rem % PER;
                const f32x4 v = *((const f32x4*)(INP(2 + kv) + (size_t)jb * 128 * 256 + 8 * 256) + e);
                *((f32x4*)(out + (kv ? O_VS : O_KS) + (size_t)jb * 128 * 256) + e) = v;
            }
        }
    }
    SEAM(0);

    for (int l = 0; l < 4; ++l) {
        const int pb = 1 + 5 * l, j = l >> 1;
        if ((l & 1) == 0) {
            if (EN_QKV && IN(pb)) {
                FRESH_PTRS;
                pg8::Gemm g{XB, (const bf16*)(ws + WS_WQKV) + (size_t)j * NQKV * D, M, NQKV, D}; pg8::StaticOrder S; S.init(MP, NQKV, G, bx);
                pg8::EpiQKV E{Qb, Kb, Vb, ssp, 16, 32, out + O_KP + (size_t)j * 2 * 128 * 256, out + O_VP + (size_t)j * 2 * 128 * 256, out + O_KS + (size_t)j * SB * 128 * 256, out + O_VS + (size_t)j * SB * 128 * 256};
                pg8::gemm_phase_x<pg8::EpiQKV, pg8::StaticOrder>(L, g, S, E);
            }
            SEAM(pb);
            if (EN_ATT && IN(pb + 1)) {
                FRESH_IDS; FRESH_PTRS;
                const LAS unsigned char* Kl = L; const LAS unsigned char* Vl = L + 36864;
                const float* ck = INP(2) + (size_t)j * SB * 128 * 256; const float* cv = INP(3) + (size_t)j * SB * 128 * 256;
                const float* sinks = INP(11) + j * 16;
                const int r32 = lane & 31, hi5 = lane >> 5;
                for (int u = vcu; u < 1024; u += G) {
                    const bool samp = u >= 512;
                    int b, qblk = 0, kvh;
                    if (!samp) { kvh = u & 3; qblk = (u >> 2) & 63; b = u >> 8; } else { const int us = u - 512; kvh = us & 3; b = us >> 2; }
                    const int nchunk = samp ? 160 * 8 : 256 * 8;
                    for (int id = tid; id < nchunk; id += 512) {
                        const int key = id >> 3, ch = id & 7;
                        v4u kv = {0u, 0u, 0u, 0u}, vv = {0u, 0u, 0u, 0u};
                        if (!samp) {
                            const int s = qblk * 128 - 128 + key;
                            if (s >= 0) { const size_t off = (size_t)((b << 13) + s) * 256 + kvh * 64 + ch * 8; kv = *(const v4u*)(Kb + off); vv = *(const v4u*)(Vb + off); }
                        } else if (key < 128) {
                            const size_t off = ((size_t)b * 128 + key) * 256 + kvh * 64 + ch * 8;
                            const f32x4 k0 = *(const f32x4*)(ck + off), k1 = *(const f32x4*)(ck + off + 4), v0 = *(const f32x4*)(cv + off), v1 = *(const f32x4*)(cv + off + 4);
                            kv.x = pk2(k0[0], k0[1]); kv.y = pk2(k0[2], k0[3]); kv.z = pk2(k1[0], k1[1]); kv.w = pk2(k1[2], k1[3]);
                            vv.x = pk2(v0[0], v0[1]); vv.y = pk2(v0[2], v0[3]); vv.z = pk2(v1[0], v1[1]); vv.w = pk2(v1[2], v1[3]);
                        } else if (key < 136) {
                            const size_t off = (size_t)(MP + b * 8 + (key - 128)) * 256 + kvh * 64 + ch * 8; kv = *(const v4u*)(Kb + off); vv = *(const v4u*)(Vb + off);
                        }
                        *(LAS v4u*)(L + key * 144 + ch * 16) = kv;
                        LAS unsigned short* vt = (LAS unsigned short*)(L + 36864 + (ch * 8) * 520 + key * 2);
                        vt[0 * 260] = (unsigned short)(vv.x & 0xffffu); vt[1 * 260] = (unsigned short)(vv.x >> 16); vt[2 * 260] = (unsigned short)(vv.y & 0xffffu); vt[3 * 260] = (unsigned short)(vv.y >> 16);
                        vt[4 * 260] = (unsigned short)(vv.z & 0xffffu); vt[5 * 260] = (unsigned short)(vv.z >> 16); vt[6 * 260] = (unsigned short)(vv.w & 0xffffu); vt[7 * 260] = (unsigned short)(vv.w >> 16);
                    }
                    __syncthreads();
                    const int ntask = samp ? ((wave == 0) ? 1 : 0) : 2;
                    for (int ti = 0; ti < ntask; ++ti) {
                        int qrow, head, tloc, kb0, jkmin;
                        if (!samp) { const int sb = 2 * (wave & 1) + ti; head = kvh * 4 + (wave >> 1); tloc = 32 * sb + r32; qrow = (b << 13) + qblk * 128 + tloc; kb0 = sb; jkmin = (qblk == 0) ? 128 : 0; }
                        else { head = kvh * 4 + (r32 >> 3); tloc = r32 & 7; qrow = MP + b * 8 + tloc; kb0 = 0; jkmin = 0; }
                        const float slope2 = exp2f(-0.5f * (float)(head + 1)) * 1.4426950408889634f, sink2 = sinks[head] * 1.4426950408889634f;
                        const bf16* qptr = Qb + (size_t)qrow * 1024 + head * 64 + 8 * hi5;
                        pg8::bf16x8 qf[4];
#pragma unroll
                        for (int ks = 0; ks < 4; ++ks) qf[ks] = *(const pg8::bf16x8*)(qptr + 16 * ks);
                        f32x16 S[5];
#pragma unroll
                        for (int i = 0; i < 5; ++i) {
                            f32x16 acc = {0.f, 0.f, 0.f, 0.f, 0.f, 0.f, 0.f, 0.f, 0.f, 0.f, 0.f, 0.f, 0.f, 0.f, 0.f, 0.f};
#pragma unroll
                            for (int ks = 0; ks < 4; ++ks) { const pg8::bf16x8 kf = *(const LAS pg8::bf16x8*)(Kl + (32 * (kb0 + i) + r32) * 144 + 32 * ks + 16 * hi5); acc = __builtin_amdgcn_mfma_f32_32x32x16_bf16(kf, qf[ks], acc, 0, 0, 0); }
                            S[i] = acc;
                        }
                        float mx = sink2;
#pragma unroll
                        for (int i = 0; i < 5; ++i)
#pragma unroll
                            for (int r = 0; r < 16; ++r) {
                                const int jk = 32 * (kb0 + i) + (r & 3) + 8 * (r >> 2) + 4 * hi5; const int dist = tloc + 128 - jk;
                                const bool valid = (dist >= 0) && (dist <= 128) && (jk >= jkmin);
                                const float sv = valid ? (S[i][r] * 0.18033688011112042f - slope2 * (float)dist) : -1e30f;
                                S[i][r] = sv; mx = fmaxf(mx, sv);
                            }
                        mx = fmaxf(mx, __shfl_xor(mx, 32));
                        float lsum = 0.f;
#pragma unroll
                        for (int i = 0; i < 5; ++i)
#pragma unroll
                            for (int r = 0; r < 16; ++r) { const float p = __builtin_amdgcn_exp2f(S[i][r] - mx); S[i][r] = p; lsum += p; }
                        lsum += __shfl_xor(lsum, 32); lsum += __builtin_amdgcn_exp2f(sink2 - mx);
                        const float inv = 1.0f / lsum;
                        f32x16 O0 = {0.f, 0.f, 0.f, 0.f, 0.f, 0.f, 0.f, 0.f, 0.f, 0.f, 0.f, 0.f, 0.f, 0.f, 0.f, 0.f}, O1 = O0;
#pragma unroll
                        for (int i = 0; i < 5; ++i)
#pragma unroll
                            for (int s2 = 0; s2 < 2; ++s2) {
                                v4u pw; pw.x = pg8::cvt_pk_bf16(S[i][8 * s2 + 0], S[i][8 * s2 + 1]); pw.y = pg8::cvt_pk_bf16(S[i][8 * s2 + 2], S[i][8 * s2 + 3]);
                                pw.z = pg8::cvt_pk_bf16(S[i][8 * s2 + 4], S[i][8 * s2 + 5]); pw.w = pg8::cvt_pk_bf16(S[i][8 * s2 + 6], S[i][8 * s2 + 7]);
                                const pg8::bf16x8 pf = __builtin_bit_cast(pg8::bf16x8, pw);
                                const int keyoff = 32 * (kb0 + i) + 16 * s2 + 4 * hi5;
                                { const u32x2 lo = *(const LAS u32x2*)(Vl + r32 * 520 + keyoff * 2), hh = *(const LAS u32x2*)(Vl + r32 * 520 + (keyoff + 8) * 2);
                                  v4u vw; vw.x = lo.x; vw.y = lo.y; vw.z = hh.x; vw.w = hh.y; O0 = __builtin_amdgcn_mfma_f32_32x32x16_bf16(__builtin_bit_cast(pg8::bf16x8, vw), pf, O0, 0, 0, 0); }
                                { const u32x2 lo = *(const LAS u32x2*)(Vl + (32 + r32) * 520 + keyoff * 2), hh = *(const LAS u32x2*)(Vl + (32 + r32) * 520 + (keyoff + 8) * 2);
                                  v4u vw; vw.x = lo.x; vw.y = lo.y; vw.z = hh.x; vw.w = hh.y; O1 = __builtin_amdgcn_mfma_f32_32x32x16_bf16(__builtin_bit_cast(pg8::bf16x8, vw), pf, O1, 0, 0, 0); }
                            }
                        bf16* optr = Ob + (size_t)qrow * 1024 + head * 64 + 4 * hi5;
#pragma unroll
                        for (int qd = 0; qd < 4; ++qd) {
                            u32x2 w0; w0.x = pg8::cvt_pk_bf16(O0[4 * qd] * inv, O0[4 * qd + 1] * inv); w0.y = pg8::cvt_pk_bf16(O0[4 * qd + 2] * inv, O0[4 * qd + 3] * inv);
                            u32x2 w1; w1.x = pg8::cvt_pk_bf16(O1[4 * qd] * inv, O1[4 * qd + 1] * inv); w1.y = pg8::cvt_pk_bf16(O1[4 * qd + 2] * inv, O1[4 * qd + 3] * inv);
                            *(u32x2*)(optr + 8 * qd) = w0; *(u32x2*)(optr + 32 + 8 * qd) = w1;
                        }
                    }
                    __syncthreads();
                }
            }
            SEAM(pb + 1);
            if (EN_OPJ && IN(pb + 2)) {
                FRESH_PTRS;
                pg8::Gemm g{Ob, (const bf16*)(ws + WS_WO) + (size_t)j * D * D, M, D, D}; pg8::StaticOrder S; S.init(MP, D, G, bx);
                pg8::EpiRes E{(l == 0) ? x_p : out, (l == 0) ? x_s : out + (size_t)MP * D, out, XB, ssp};
                pg8::gemm_phase_x<pg8::EpiRes, pg8::StaticOrder>(L, g, S, E);
            }
            SEAM(pb + 2);
        } else {
#define SSMC const SsmC sc{(const float*)(ws + WS_TAB) + (size_t)j * NG * NS * 4, INP(15) + (size_t)j * NG * NS * GC, INP(16) + (size_t)j * NG * NS * GC, \
                          INP(17) + (size_t)j * NG * GC * NS, INP(18) + (size_t)j * NG * GC * NS, INP(19) + (size_t)j * D, INP(6) + (size_t)l * D}
            if (EN_S1 && IN(pb)) {
                FRESH_IDS; FRESH_PTRS; SSMC; LAS float* xs = (LAS float*)(L + wave * 8192); LAS float* hb = xs + 1024;
                for (int u = gw; u < NB * (NCH - 1) * NG; u += NGW) {
                    int lane = tid & 63; asm volatile("" : "+v"(lane));
                    const int g = u & 63, ch = (u >> 6) % (NCH - 1), b = (u >> 6) / (NCH - 1);
                    float hr = 0.f, hi_ = 0.f;
                    ssm_unit<false>(xs, hb, lane, g, sc, out, ssp, 16, b * SEQ + ch * CH, CH, hr, hi_, nullptr);
                    *(float2*)(HS + ((size_t)((b * NCH + ch) * NG + g) * NS + lane) * 2) = make_float2(hr, hi_);
                }
                __syncthreads();
            }
            SEAM(pb);
            if (EN_S3 && IN(pb + 1)) {
                FRESH_IDS; FRESH_PTRS; SSMC; LAS float* xs = (LAS float*)(L + wave * 8192); LAS float* hb = xs + 1024;
                for (int u = gw; u < NB * NCH * NG + SB * NG; u += NGW) {
                    int lane = tid & 63; asm volatile("" : "+v"(lane));
                    if (u < NB * NCH * NG) {
                        const int g = u & 63, ch = (u >> 6) & (NCH - 1), b = u >> 11;
                        float abr, abi, cfr, cfi; ssm_abar(sc, g, lane, abr, abi, cfr, cfi);
                        float aLr = abr, aLi = abi;
#pragma unroll
                        for (int s = 0; s < 8; ++s) { const float tr = aLr * aLr - aLi * aLi, ti = 2.0f * aLr * aLi; aLr = tr; aLi = ti; }
                        float hr = 0.f, hi_ = 0.f;
                        for (int i = 0; i < ch; ++i) { const float2 e = *(const float2*)(HS + ((size_t)((b * NCH + i) * NG + g) * NS + lane) * 2);
                            const float tr = aLr * hr - aLi * hi_ + e.x, ti = aLr * hi_ + aLi * hr + e.y; hr = tr; hi_ = ti; }
                        ssm_unit<true>(xs, hb, lane, g, sc, out, ssp, 16, b * SEQ + ch * CH, CH, hr, hi_, Ob);
                        if (ch == NCH - 1) { out[O_HRP + ((size_t)(j * NB + b) * NG + g) * NS + lane] = hr; out[O_HIP + ((size_t)(j * NB + b) * NG + g) * NS + lane] = hi_; }
                    } else {
                        const int us = u - NB * NCH * NG, g = us & 63, bs = us >> 6;
                        const size_t si = ((size_t)(j * SB + bs) * NG + g) * NS + lane;
                        float hr = INP(4)[si], hi_ = INP(5)[si];
                        ssm_unit<true>(xs, hb, lane, g, sc, out, ssp, 32, MP + bs * ST, ST, hr, hi_, Ob);
                        out[O_HRS + si] = hr; out[O_HIS + si] = hi_;
                    }
                }
                __syncthreads();
            }
            SEAM(pb + 1);
            if (EN_GLU && IN(pb + 2)) {
                FRESH_PTRS;
                pg8::Gemm g{Ob, (const bf16*)(ws + WS_WGLU) + (size_t)j * 2 * D * D, M, 2 * D, D}; pg8::StaticOrder S; S.init(MP, 2 * D, G, bx);
                pg8::EpiGlu E{out, XB, ssp};
                pg8::gemm_phase_x<pg8::EpiGlu, pg8::StaticOrder>(L, g, S, E);
            }
            SEAM(pb + 2);
        }
        if (EN_UP && IN(pb + 3)) {
            FRESH_PTRS;
            pg8::Gemm g{XB, (const bf16*)(ws + WS_WUP) + (size_t)l * FF * D, M, FF, D}; pg8::StaticOrder S; S.init(MP, FF, G, bx);
            pg8::EpiUp E{Hb, ssp, (l & 1) ? 32 : 16, (l & 1) ? 64 : 32};
            pg8::gemm_phase_x<pg8::EpiUp, pg8::StaticOrder>(L, g, S, E);
        }
        SEAM(pb + 3);
        if (EN_DN && IN(pb + 4)) {
            FRESH_PTRS;
            pg8::Gemm g{Hb, (const bf16*)(ws + WS_WDN) + (size_t)l * D * FF, M, D, FF}; pg8::StaticOrder S; S.init(MP, D, G, bx);
            pg8::EpiRes E{out, out + (size_t)MP * D, out, XB, ssp};
            pg8::gemm_phase_x<pg8::EpiRes, pg8::StaticOrder>(L, g, S, E);
        }
        SEAM(pb + 4);
    }
    if (EN_FIN && IN(21)) {
        FRESH_IDS; FRESH_PTRS;
        const float* gf = INP(8);
        for (int m = gw; m < M; m += NGW) {
            const float pv = (lane < ((m < MP) ? 16 : 32)) ? ssp[(size_t)m * 64 + lane] : 0.f;
            const float rinv = rsqrtf(wave_sum(pv) * (1.0f / 1024.0f) + 1e-6f);
            GAS f32x4* xr = (GAS f32x4*)(out + (size_t)m * D) + lane;
#pragma unroll
            for (int jx = 0; jx < 4; ++jx) { const f32x4 gv = *((const f32x4*)gf + 64 * jx + lane); f32x4 v = xr[64 * jx]; v = v * rinv * gv; xr[64 * jx] = v; }
        }
    }
#undef IN
#undef SEAM
}

#ifndef MK_SPLIT
#define MK_SPLIT 0
#endif
extern "C" void kernel_launch(void* const* d_in, const int* in_sizes, int n_in, void* d_out, int out_size, void* d_ws, size_t ws_size, hipStream_t stream) {
    static int grid = 0;
    if (grid == 0) {
        if (n_in != 23 || in_sizes[0] != MP * D || (size_t)out_size != O_END || ws_size < WS_END) { fprintf(stderr, "kernel_launch: unexpected shapes (n_in %d, in0 %d, out %d, ws %zu); nothing launched\n", n_in, n_in > 0 ? in_sizes[0] : -1, out_size, ws_size); grid = -1; return; }
        int dev = 0, cus = 0, per_cu = 0;
        if (hipGetDevice(&dev) != hipSuccess || hipDeviceGetAttribute(&cus, hipDeviceAttributeMultiprocessorCount, dev) != hipSuccess) { fprintf(stderr, "kernel_launch: device query failed\n"); grid = -1; return; }
        if (hipFuncSetAttribute((const void*)fwd_kernel, hipFuncAttributeMaxDynamicSharedMemorySize, LDS_BYTES) != hipSuccess) { fprintf(stderr, "kernel_launch: hipFuncSetAttribute failed\n"); grid = -1; return; }
        if (hipOccupancyMaxActiveBlocksPerMultiprocessor(&per_cu, (const void*)fwd_kernel, 512, LDS_BYTES) != hipSuccess || per_cu < 1) fprintf(stderr, "kernel_launch: note: occupancy query reports %d blocks per CU\n", per_cu);
        (void)hipGetLastError();
        grid = cus;
    }
    if (grid < 0) return;
    (void)hipMemsetAsync((char*)d_ws + WS_CTL, 0, CTL_ZERO_BYTES, stream);
    Args a{};
    for (int i = 0; i < 23; ++i) a.in[i] = (const float*)d_in[i];
    a.out = (float*)d_out; a.ws = (unsigned char*)d_ws;
#if MK_SPLIT
    for (int p = 0; p < NPHASE; ++p) { a.ph_lo = p; a.ph_hi = p + 1; hipLaunchKernelGGL(fwd_kernel, dim3(grid), dim3(512), LDS_BYTES, stream, a); }
#else
    a.ph_lo = 0; a.ph_hi = NPHASE; hipLaunchKernelGGL(fwd_kernel, dim3(grid), dim3(512), LDS_BYTES, stream, a);
#endif
}
```

```cpp
#include <hip/hip_runtime.h>
#include <cstdio>
#include <cstdint>
namespace pg8 {
#define PG8_LAS __attribute__((address_space(3)))
typedef unsigned short bf16_t;
typedef short bf16x8 __attribute__((ext_vector_type(8)));
typedef float f32x4 __attribute__((ext_vector_type(4)));
typedef unsigned u32x4 __attribute__((ext_vector_type(4)));
constexpr int BM = 256, BK = 64, HALF = 128, HTB = HALF * BK * 2  , STAGE_BYTES = 8 * HTB, NXCD = 8, WGM = 8;

__host__ __device__ __forceinline__ int lds_byte(int r, int c) { const int st = (r >> 4) * 2 + (c >> 5), rr = r & 15, cc = c & 31, ob = rr * 64 + cc * 2; return st * 1024 + (ob ^ (((ob >> 9) & 1) << 5)); }
__host__ __device__ __forceinline__ void stage_rc(int b, int& R, int& C) { const int st = b / 1024, sb = b % 1024, swz = sb ^ (((sb >> 9) & 1) << 5); R = (st >> 1) * 16 + swz / 64; C = (st & 1) * 32 + (swz % 64) / 2; }
__host__ __device__ __forceinline__ int perm32(int rho) { const int n = rho >> 4, i = rho & 15; return 8 * (i >> 2) + 4 * n + (i & 3); }

struct Unit { int pm, pn; };
struct Gemm { const bf16_t* A; const bf16_t* Bt; int M, N, K; };

struct StaticOrder {
    int nM, nN, nwg, G, c;
    __host__ __device__ void init(int M, int N, int G_, int c_) { nM = M / BM; nN = N / BM; nwg = nM * nN; G = G_; c = c_; }
    __host__ __device__ bool next(int i, Unit& u) const {
        const long L = (long)i * G + c; if (L >= nwg) return false;
        int wgid = (int)L; { const int q = nwg / NXCD, r = nwg % NXCD, xcd = wgid % NXCD, off = wgid / NXCD; wgid = (xcd < r ? xcd * (q + 1) : r * (q + 1) + (xcd - r) * q) + off; }
        const int nig = WGM * nN, gid = wgid / nig, fm = gid * WGM, gsz = (nM - fm) < WGM ? (nM - fm) : WGM;
        u.pm = fm + ((wgid % nig) % gsz); u.pn = (wgid % nig) / gsz; return true;
    }
    __device__ __forceinline__ void a_ready(const Unit&) const {}
    __device__ __forceinline__ void done(const Unit&) const {}
};
__device__ __forceinline__ unsigned cvt_pk_bf16(float lo, float hi) { unsigned r; asm volatile("v_cvt_pk_bf16_f32 %0, %1, %2" : "=v"(r) : "v"(lo), "v"(hi)); return r; }
typedef float f32x2 __attribute__((ext_vector_type(2)));
template <class Epi, class Sched, bool ALIGN_EPI = false, bool SP2 = false>
__device__ __forceinline__ void gemm_phase(PG8_LAS unsigned char* lds, const Gemm g, const Sched& S, const Epi& E) {
    int tid_ = threadIdx.x; asm volatile("" : "+v"(tid_));
    const int tid = tid_, wid = __builtin_amdgcn_readfirstlane(tid >> 6), lane = tid & 63, wr = wid >> 2, wc = wid & 3, fr = lane & 15, fq = lane >> 4;
    const int K = g.K, nt = K / BK;
    unsigned voffA[2], voffB[2];
#pragma unroll
    for (int i = 0; i < 2; ++i) { int R, C; stage_rc(tid * 16 + i * 8192, R, C); const int Rb = Epi::PERM ? ((R & ~31) + perm32(R & 31)) : R;
        voffA[i] = (unsigned)(R * K + C) * 2u; voffB[i] = (unsigned)(Rb * K + C) * 2u; }
    const size_t kstep = (size_t)(BK * 2);
    const size_t hstep = (size_t)HALF * K * 2;
    const size_t tstep = 2 * hstep;
    const unsigned ldsw = (unsigned)wid * 1024u;
    const int aoff = lds_byte(wr * 64 + fr, fq * 8), boff = lds_byte(wc * 32 + fr, fq * 8);
#define PG8_SA(b, h) (((b) * 2 + (h)) * HTB)
#define PG8_SB(b, h) ((4 + (b) * 2 + (h)) * HTB)
#define PG8_STAGE(bufoff, gbase, voff) do { _Pragma("unroll") for (int _i = 0; _i < 2; ++_i) \
        __builtin_amdgcn_global_load_lds((const unsigned*)((const char*)(gbase) + (voff)[_i]), (PG8_LAS unsigned*)(lds + (bufoff) + ldsw + _i * 8192), 16, 0, 0); } while (0)
#define PG8_LDA(dst, b, h) do { _Pragma("unroll") for (int m = 0; m < 4; ++m) _Pragma("unroll") for (int k = 0; k < 2; ++k) dst[m][k] = *(const PG8_LAS bf16x8*)(lds + PG8_SA(b, h) + aoff + m * 2048 + k * 1024); } while (0)
#define PG8_LDB(dst, b, h) do { _Pragma("unroll") for (int n = 0; n < 2; ++n) _Pragma("unroll") for (int k = 0; k < 2; ++k) dst[n][k] = *(const PG8_LAS bf16x8*)(lds + PG8_SB(b, h) + boff + n * 2048 + k * 1024); } while (0)
#define PG8_MMA(ai, bj, At, Bt) do { __builtin_amdgcn_s_setprio(1); _Pragma("unroll") for (int m = 0; m < 4; ++m) _Pragma("unroll") for (int n = 0; n < 2; ++n) _Pragma("unroll") for (int k = 0; k < 2; ++k) \
        acc[ai][bj][m][n] = __builtin_amdgcn_mfma_f32_16x16x32_bf16(Bt[n][k], At[m][k], acc[ai][bj][m][n], 0, 0, 0); __builtin_amdgcn_s_setprio(0); } while (0)
#define PG8_WAIT_V(n) asm volatile("s_waitcnt vmcnt(" #n ")" ::: "memory")
#define PG8_WAIT_L(n) asm volatile("s_waitcnt lgkmcnt(" #n ")" ::: "memory")
#define PG8_BAR __builtin_amdgcn_s_barrier()
#define PG8_SCHED __builtin_amdgcn_sched_barrier(0)
    Unit cur, nxt; int ui = 0;
    if (!S.next(0, cur)) return;
    f32x4 acc[2][2][4][2];
#pragma unroll
    for (int a = 0; a < 2; ++a)
#pragma unroll
        for (int b = 0; b < 2; ++b)
#pragma unroll
            for (int m = 0; m < 4; ++m)
#pragma unroll
                for (int n = 0; n < 2; ++n) acc[a][b][m][n] = (f32x4){0.f, 0.f, 0.f, 0.f};
    bf16x8 At[4][2], B0[2][2], B1[2][2];
    const char* cA = (const char*)g.A + (size_t)cur.pm * tstep; const char* cB = (const char*)g.Bt + (size_t)cur.pn * tstep;
    S.a_ready(cur);
    if constexpr (SP2) {
        PG8_STAGE(PG8_SB(0, 0), cB, voffB); PG8_STAGE(PG8_SB(0, 1), cB + hstep, voffB); PG8_STAGE(PG8_SA(0, 0), cA, voffA); PG8_STAGE(PG8_SA(0, 1), cA + hstep, voffA);
        if (wr == 1) PG8_BAR;
        PG8_WAIT_V(2); PG8_BAR;
        PG8_STAGE(PG8_SB(1, 0), cB + kstep, voffB); PG8_STAGE(PG8_SA(1, 0), cA + kstep, voffA); PG8_STAGE(PG8_SB(1, 1), cB + hstep + kstep, voffB);
        PG8_WAIT_V(6); PG8_BAR;
    } else {
        PG8_STAGE(PG8_SB(0, 0), cB, voffB); PG8_STAGE(PG8_SA(0, 0), cA, voffA); PG8_STAGE(PG8_SB(0, 1), cB + hstep, voffB); PG8_STAGE(PG8_SA(0, 1), cA + hstep, voffA);
        if (wr == 1) PG8_BAR;
        PG8_WAIT_V(4); PG8_BAR;
        PG8_STAGE(PG8_SB(1, 0), cB + kstep, voffB); PG8_STAGE(PG8_SA(1, 0), cA + kstep, voffA); PG8_STAGE(PG8_SB(1, 1), cB + hstep + kstep, voffB);
        PG8_WAIT_V(6); PG8_BAR;
    }
    for (;;) {
        const bool has_next = S.next(ui + 1, nxt);
        const char* nA = has_next ? (const char*)g.A + (size_t)nxt.pm * tstep : cA; const char* nB = has_next ? (const char*)g.Bt + (size_t)nxt.pn * tstep : cB;
        for (int t = 0; t < nt; t += 2) {
            const bool last = (t == nt - 2);
            const char* a1 = cA + (size_t)(t + 1) * kstep;
            const char* a2 = last ? nA : cA + (size_t)(t + 2) * kstep; const char* b2 = last ? nB : cB + (size_t)(t + 2) * kstep;
            const char* a3 = a2 + kstep; const char* b3 = b2 + kstep;
            if (last && has_next) S.a_ready(nxt);
            if constexpr (SP2) {
            PG8_LDB(B0, 0, 0); PG8_LDB(B1, 0, 1); PG8_SCHED; PG8_LDA(At, 0, 0); PG8_STAGE(PG8_SA(1, 1), a1 + hstep, voffA);
            PG8_WAIT_V(8); PG8_WAIT_L(0); PG8_BAR; PG8_MMA(0, 0, At, B0); PG8_MMA(0, 1, At, B1); PG8_BAR; PG8_SCHED;
            PG8_LDA(At, 0, 1); PG8_STAGE(PG8_SB(0, 0), b2, voffB); PG8_STAGE(PG8_SB(0, 1), b2 + hstep, voffB); PG8_STAGE(PG8_SA(0, 0), a2, voffA);
            PG8_WAIT_V(8); PG8_WAIT_L(0); PG8_BAR; PG8_MMA(1, 0, At, B0); PG8_MMA(1, 1, At, B1); PG8_BAR; PG8_SCHED;
            PG8_LDB(B0, 1, 0); PG8_LDB(B1, 1, 1); PG8_SCHED; PG8_LDA(At, 1, 0); PG8_STAGE(PG8_SA(0, 1), a2 + hstep, voffA);
            PG8_WAIT_V(8); PG8_WAIT_L(0); PG8_BAR; PG8_MMA(0, 0, At, B0); PG8_MMA(0, 1, At, B1); PG8_BAR; PG8_SCHED;
            PG8_LDA(At, 1, 1); PG8_STAGE(PG8_SB(1, 0), b3, voffB); PG8_STAGE(PG8_SB(1, 1), b3 + hstep, voffB); PG8_STAGE(PG8_SA(1, 0), a3, voffA);
            PG8_WAIT_V(8); PG8_WAIT_L(0); PG8_BAR; PG8_MMA(1, 0, At, B0); PG8_MMA(1, 1, At, B1); PG8_BAR; PG8_SCHED;
            } else {
            PG8_LDB(B0, 0, 0); PG8_SCHED; PG8_LDA(At, 0, 0); PG8_STAGE(PG8_SA(1, 1), a1 + hstep, voffA);
            PG8_WAIT_L(8); PG8_BAR; PG8_WAIT_L(0); PG8_MMA(0, 0, At, B0); PG8_BAR; PG8_SCHED;
            PG8_LDB(B1, 0, 1); PG8_STAGE(PG8_SB(0, 0), b2, voffB);
            PG8_BAR; PG8_WAIT_L(0); PG8_MMA(0, 1, At, B1); PG8_BAR;
            PG8_LDA(At, 0, 1); PG8_STAGE(PG8_SA(0, 0), a2, voffA);
            PG8_BAR; PG8_WAIT_L(0); PG8_MMA(1, 0, At, B0); PG8_BAR; PG8_SCHED;
            PG8_STAGE(PG8_SB(0, 1), b2 + hstep, voffB);
            PG8_WAIT_V(6); PG8_BAR; PG8_MMA(1, 1, At, B1); PG8_BAR;
            PG8_LDB(B0, 1, 0); PG8_SCHED; PG8_LDA(At, 1, 0); PG8_STAGE(PG8_SA(0, 1), a2 + hstep, voffA);
            PG8_WAIT_L(8); PG8_BAR; PG8_WAIT_L(0); PG8_MMA(0, 0, At, B0); PG8_BAR; PG8_SCHED;
            PG8_LDB(B1, 1, 1); PG8_STAGE(PG8_SB(1, 0), b3, voffB);
            PG8_BAR; PG8_WAIT_L(0); PG8_MMA(0, 1, At, B1); PG8_BAR;
            PG8_LDA(At, 1, 1); PG8_STAGE(PG8_SA(1, 0), a3, voffA);
            PG8_BAR; PG8_WAIT_L(0); PG8_MMA(1, 0, At, B0); PG8_BAR; PG8_SCHED;
            PG8_STAGE(PG8_SB(1, 1), b3 + hstep, voffB);
            PG8_WAIT_V(6); PG8_BAR; PG8_MMA(1, 1, At, B1); PG8_BAR;
            }
        }
        if constexpr (ALIGN_EPI) { if (wr == 0) PG8_BAR; }
        if constexpr (!Epi::AFTER_DRAIN) { E(acc, cur, wr, wc, fr, fq); S.done(cur); }
        if (!has_next) break;
#pragma unroll
        for (int a = 0; a < 2; ++a)
#pragma unroll
            for (int b = 0; b < 2; ++b)
#pragma unroll
                for (int m = 0; m < 4; ++m)
#pragma unroll
                    for (int n = 0; n < 2; ++n) acc[a][b][m][n] = (f32x4){0.f, 0.f, 0.f, 0.f};
        cur = nxt; cA = nA; cB = nB; ++ui;
        if constexpr (ALIGN_EPI) { if (wr == 1) PG8_BAR; }
    }
    PG8_WAIT_V(0);
    if constexpr (!ALIGN_EPI) { if (wr == 0) PG8_BAR; }
    PG8_BAR;
    if constexpr (Epi::AFTER_DRAIN) { E.fused(acc, cur, wr, wc, fr, fq, lds, wid, lane); S.done(cur); }
#undef PG8_SA
#undef PG8_SB
#undef PG8_STAGE
#undef PG8_LDA
#undef PG8_LDB
#undef PG8_MMA
#undef PG8_WAIT_V
#undef PG8_WAIT_L
#undef PG8_BAR
#undef PG8_SCHED
}
}
#define GAS __attribute__((address_space(1)))
#define LAS __attribute__((address_space(3)))
typedef unsigned short bf16;
typedef unsigned v4u __attribute__((ext_vector_type(4)));
typedef float f32x4 __attribute__((ext_vector_type(4)));
typedef short bf16x8 __attribute__((ext_vector_type(8)));
typedef GAS unsigned gu32;
typedef GAS unsigned long long gu64;
#define RLX_AGENT __ATOMIC_RELAXED, __HIP_MEMORY_SCOPE_AGENT
#define LDS_WAIT() asm volatile("s_waitcnt lgkmcnt(0)" ::: "memory")
#define VM_WAIT() asm volatile("s_waitcnt vmcnt(0)" ::: "memory")
__device__ __forceinline__ unsigned long long rt() { return __builtin_amdgcn_s_memrealtime(); }
__device__ __forceinline__ unsigned f2bf(float f) { unsigned u = __builtin_bit_cast(unsigned, f); return (u + 0x7fffu + ((u >> 16) & 1u)) >> 16; }
__device__ __forceinline__ unsigned pk2(float lo, float hi) { return f2bf(lo) | (f2bf(hi) << 16); }
#define XB_TMO      128
#define XB_XCNT(j)  (256  + 64 * (j))
#define XB_XSUB(j)  (1280 + 64 * (j))
#define XB_XGEN(j)  (2304 + 64 * (j))
#define XB_TOP      3328
#define XB_TOPGEN   3392
#define XCD_BAR_WORDS 3456
#define XB_SPIN_CAP (1u << 18)

__device__ __forceinline__ unsigned xb_ld(unsigned* p)              { return __hip_atomic_load(p, __ATOMIC_RELAXED, __HIP_MEMORY_SCOPE_AGENT); }
__device__ __forceinline__ unsigned xb_add(unsigned* p, unsigned v) { return __hip_atomic_fetch_add(p, v, __ATOMIC_RELAXED, __HIP_MEMORY_SCOPE_AGENT); }
__device__ __forceinline__ unsigned xb_xcc_id() { return (unsigned)__builtin_amdgcn_s_getreg((3 << 11) | 20) & 0xFu; }
#define XB_SPIN(cond, bar) do { unsigned _sp = 0; while (cond) { __builtin_amdgcn_s_sleep(1); \
    if ((++_sp & 255u) == 0u) { if (xb_ld(&(bar)[XB_TMO])) break; if (_sp > XB_SPIN_CAP) { atomicAdd(&(bar)[XB_TMO], 1u); break; } } } } while (0)

struct XcdBarrier {
    unsigned* bar; unsigned x;
    volatile LAS unsigned* st;
};

__device__ __forceinline__ XcdBarrier xcd_barrier_post(unsigned* bar, volatile LAS unsigned* st) {
    XcdBarrier b; b.bar = bar; b.x = xb_xcc_id(); b.st = st;
    if (threadIdx.x == 0) (void)xb_add(&bar[XB_XCNT(b.x)], 1u);
    return b;
}
__device__ __forceinline__ void xcd_barrier_complete(unsigned* bar, unsigned x, unsigned& nloc, unsigned& nx) {
    const unsigned G = gridDim.x * gridDim.y * gridDim.z;
    unsigned sum, cnt, mine, sp = 0u;
    for (;;) {
        sum = 0u; cnt = 0u; mine = 0u;
#pragma unroll
        for (unsigned j = 0; j < 16; ++j) { const unsigned c = xb_ld(&bar[XB_XCNT(j)]); sum += c; cnt += (c > 0u) ? 1u : 0u; mine = (j == x) ? c : mine; }
        if (sum == G) break;
        __builtin_amdgcn_s_sleep(1);
        if ((++sp & 255u) == 0u) { if (xb_ld(&bar[XB_TMO])) break; if (sp > XB_SPIN_CAP) { atomicAdd(&bar[XB_TMO], 1u); break; } }
    }
    nloc = mine > 0u ? mine : 1u; nx = cnt > 0u ? cnt : 1u;
}

__device__ __forceinline__ void xcd_barrier(const XcdBarrier& b) {
    asm volatile("s_waitcnt vmcnt(0)" ::: "memory");
    __syncthreads();
    if (threadIdx.x == 0) {
        unsigned* bar = b.bar;
        __builtin_amdgcn_s_waitcnt(0);
        unsigned nloc = b.st[0], nx = b.st[1];
        if (nloc == 0u) { xcd_barrier_complete(bar, b.x, nloc, nx); b.st[0] = nloc; b.st[1] = nx; }
        const unsigned old = xb_add(&bar[XB_XSUB(b.x)], 1u);
        const unsigned gen = old / nloc;
        if (old + 1u == (gen + 1u) * nloc) {
            __builtin_amdgcn_fence(__ATOMIC_RELEASE, "agent");
            asm volatile("s_waitcnt vmcnt(0)" ::: "memory");
            const unsigned og = xb_add(&bar[XB_TOP], 1u);
            const unsigned tg = og / nx;
            if (og + 1u == (tg + 1u) * nx) xb_add(&bar[XB_TOPGEN], 1u);
            else XB_SPIN(xb_ld(&bar[XB_TOPGEN]) == tg, bar);
            __builtin_amdgcn_fence(__ATOMIC_ACQUIRE, "agent");
            xb_add(&bar[XB_XGEN(b.x)], 1u);
            asm volatile("s_waitcnt vmcnt(0)" ::: "memory");
        } else {
            XB_SPIN(xb_ld(&bar[XB_XGEN(b.x)]) == gen, bar);
            __builtin_amdgcn_fence(__ATOMIC_ACQUIRE, "agent");
            asm volatile("s_waitcnt vmcnt(0)" ::: "memory");
        }
    }
    __syncthreads();
}

constexpr int D = 1024, SEQ = 8192, NB = 2, MP = NB * SEQ, SB = 128, ST = 8, MS = SB * ST, M = MP + MS;
constexpr int NQKV = 1536, FF = 4096, NKV = 4, HD = 64, KVW = NKV * HD, NG = 64, GC = 16, NS = 64;
constexpr int CH = 256, NCH = SEQ / CH;
constexpr int NPHASE = 22;
constexpr size_t O_KP = 17825792, O_VP = 17956864, O_HRP = 18087936, O_HIP = 18104320, O_KS = 18120704, O_VS = 26509312, O_HRS = 34897920, O_HIS = 35946496, O_END = 36995072;
constexpr size_t MiB = 1u << 20;
constexpr size_t WS_CTL = 0, CTL_ZERO_BYTES = 64 * 1024;
constexpr size_t WS_SSP = 1 * MiB;
constexpr size_t WS_TAB = 5 * MiB + 512 * 1024;
constexpr size_t WS_HS = 6 * MiB;
constexpr size_t WS_WQKV = 8 * MiB, WS_WO = 14 * MiB, WS_WGLU = 18 * MiB, WS_WUP = 26 * MiB, WS_WDN = 58 * MiB;
constexpr size_t WS_XB = 90 * MiB;
constexpr size_t WS_H = 124 * MiB;
constexpr size_t WS_Q = 124 * MiB, WS_K = 158 * MiB, WS_V = 167 * MiB, WS_O = 176 * MiB;
constexpr size_t WS_BT = 260 * MiB, WS_CT = 261 * MiB;
constexpr size_t WS_END = 262 * MiB;
constexpr int CW_BAR = 4096;
static_assert((CW_BAR + XCD_BAR_WORDS) * 4 <= (int)CTL_ZERO_BYTES, "barrier words inside the memset region");
constexpr int RING_BYTES = 131072, XA_BYTES = 4096, LDSCTL_OFF = RING_BYTES + XA_BYTES, MISC_OFF = LDSCTL_OFF + 320, LDS_BYTES = 147456;

__device__ __forceinline__ float wave_sum(float v) {
#pragma unroll
    for (int o = 1; o < 64; o <<= 1) v += __shfl_xor(v, o);
    return v;
}
__device__ __forceinline__ float wave_max(float v) {
#pragma unroll
    for (int o = 1; o < 64; o <<= 1) v = fmaxf(v, __shfl_xor(v, o));
    return v;
}
__device__ __forceinline__ float bf_lo(unsigned u) { return __uint_as_float(u << 16); }
__device__ __forceinline__ float bf_hi(unsigned u) { return __uint_as_float(u & 0xffff0000u); }

namespace pg8 {
constexpr int XMP = 16384;
__device__ __forceinline__ float row_rinv(const float* ssp, int row, int np, int fq) {
    const float* p = ssp + (size_t)row * 64 + (np >> 2) * fq; float s = 0.f;
    for (int i = 0; i < (np >> 4); ++i) { const f32x4 v = *(const f32x4*)(p + 4 * i); s += (v[0] + v[1]) + (v[2] + v[3]); }
    s += __shfl_xor(s, 16); s += __shfl_xor(s, 32);
    return rsqrtf(s * (1.0f / 1024.0f) + 1e-6f);
}
__device__ __forceinline__ u32x4 pack8(const f32x4 a, const f32x4 b) { u32x4 w; w.x = cvt_pk_bf16(a[0], a[1]); w.y = cvt_pk_bf16(a[2], a[3]); w.z = cvt_pk_bf16(b[0], b[1]); w.w = cvt_pk_bf16(b[2], b[3]); return w; }
typedef unsigned u32x2 __attribute__((ext_vector_type(2)));
__device__ __forceinline__ u32x2 pack4(const f32x4 a) { u32x2 w; w.x = cvt_pk_bf16(a[0], a[1]); w.y = cvt_pk_bf16(a[2], a[3]); return w; }
__device__ __forceinline__ float sumsq4(const f32x4 v) { return (v[0] * v[0] + v[1] * v[1]) + (v[2] * v[2] + v[3] * v[3]); }

struct EpiQKV {
    static constexpr bool PERM = true, AFTER_DRAIN = false;
    bf16_t *Q, *K, *V; const float* ssp; int np, nps; float *kp, *vp, *ks, *vs;
    __device__ __forceinline__ void operator()(const f32x4 (&acc)[2][2][4][2], const f32x4 (&accx)[2], const Unit& u, int wr, int wc, int fr, int fq) const {
        const int rowb = u.pm * BM + wr * 64 + fr, pn = u.pn;
#pragma unroll
        for (int ai = 0; ai < 2; ++ai)
#pragma unroll
            for (int m = 0; m < 4; ++m) {
                const int row = rowb + ai * HALF + m * 16;
                const float r = row_rinv(ssp, row, np, fq);
#pragma unroll
                for (int bj = 0; bj < 2; ++bj) {
                    const f32x4 v0 = acc[ai][bj][m][0] * r, v1 = acc[ai][bj][m][1] * r;
                    const int cl = bj * HALF + wc * 32 + 8 * fq;
                    const u32x4 w = pack8(v0, v1);
                    if (pn < 4) { *(u32x4*)(Q + (size_t)row * 1024 + pn * 256 + cl) = w; }
                    else {
                        bf16_t* B = (pn == 4) ? K : V;
                        *(u32x4*)(B + (size_t)row * 256 + cl) = w;
                        const int t = row & 8191;
                        if (t >= 8064) { float* o = ((pn == 4) ? kp : vp) + ((size_t)(row >> 13) * 128 + (t - 8064)) * 256 + cl; *(f32x4*)o = v0; *(f32x4*)(o + 4) = v1; }
                    }
                }
            }
        {
            const int xrow = u.pm * 16 + fr, row = XMP + xrow;
            const float r = row_rinv(ssp, row, nps, fq);
#pragma unroll
            for (int bj = 0; bj < 2; ++bj) {
                const f32x4 v = accx[bj] * r;
                const int cl = bj * HALF + wc * 32 + 8 * fq + 4 * wr;
                const u32x2 w = pack4(v);
                if (pn < 4) { *(u32x2*)(Q + (size_t)row * 1024 + pn * 256 + cl) = w; }
                else {
                    bf16_t* B = (pn == 4) ? K : V;
                    *(u32x2*)(B + (size_t)row * 256 + cl) = w;
                    float* o = ((pn == 4) ? ks : vs) + ((size_t)(xrow >> 3) * 128 + 120 + (xrow & 7)) * 256 + cl; *(f32x4*)o = v;
                }
            }
        }
    }
};
struct EpiRes {
    static constexpr bool PERM = true, AFTER_DRAIN = false;
    const float* xp; const float* xs; float* XR; bf16_t* XB; float* ssp;
    __device__ __forceinline__ void operator()(const f32x4 (&acc)[2][2][4][2], const f32x4 (&accx)[2], const Unit& u, int wr, int wc, int fr, int fq) const {
        const int rowb = u.pm * BM + wr * 64 + fr, pn = u.pn;
#pragma unroll
        for (int ai = 0; ai < 2; ++ai)
#pragma unroll
            for (int m = 0; m < 4; ++m) {
                const int row = rowb + ai * HALF + m * 16;
                const float* old = xp + (size_t)row * 1024;
                float ss = 0.f;
#pragma unroll
                for (int bj = 0; bj < 2; ++bj) {
                    const int col = pn * 256 + bj * HALF + wc * 32 + 8 * fq;
                    const f32x4 o0 = *(const f32x4*)(old + col), o1 = *(const f32x4*)(old + col + 4);
                    const f32x4 v0 = acc[ai][bj][m][0] + o0, v1 = acc[ai][bj][m][1] + o1;
                    *(f32x4*)(XR + (size_t)row * 1024 + col) = v0; *(f32x4*)(XR + (size_t)row * 1024 + col + 4) = v1;
                    *(u32x4*)(XB + (size_t)row * 1024 + col) = pack8(v0, v1);
                    ss += sumsq4(v0) + sumsq4(v1);
                }
                ss += __shfl_xor(ss, 16); ss += __shfl_xor(ss, 32);
                if (fq == 0) ssp[(size_t)row * 64 + pn * 4 + wc] = ss;
                asm volatile("" ::: "memory");
            }
        {
            const int xrow = u.pm * 16 + fr, row = XMP + xrow;
            const float* old = xs + (size_t)xrow * 1024;
            float ss = 0.f;
#pragma unroll
            for (int bj = 0; bj < 2; ++bj) {
                const int col = pn * 256 + bj * HALF + wc * 32 + 8 * fq + 4 * wr;
                const f32x4 v = accx[bj] + *(const f32x4*)(old + col);
                *(f32x4*)(XR + (size_t)row * 1024 + col) = v;
                *(u32x2*)(XB + (size_t)row * 1024 + col) = pack4(v);
                ss += sumsq4(v);
            }
            ss += __shfl_xor(ss, 16); ss += __shfl_xor(ss, 32);
            if (fq == 0) ssp[(size_t)row * 64 + (pn * 4 + wc) * 2 + wr] = ss;
        }
    }
};
struct EpiGlu {
    static constexpr bool PERM = true, AFTER_DRAIN = false;
    float* XR; bf16_t* XB; float* ssp;
    __device__ __forceinline__ void operator()(const f32x4 (&acc)[2][2][4][2], const f32x4 (&accx)[2], const Unit& u, int wr, int wc, int fr, int fq) const {
        const int rowb = u.pm * BM + wr * 64 + fr, pn = u.pn;
#pragma unroll
        for (int ai = 0; ai < 2; ++ai)
#pragma unroll
            for (int m = 0; m < 4; ++m) {
                const int row = rowb + ai * HALF + m * 16;
                const int col = pn * 128 + wc * 32 + 8 * fq;
                float* xr = XR + (size_t)row * 1024 + col;
                const f32x4 o0 = *(const f32x4*)xr, o1 = *(const f32x4*)(xr + 4);
                f32x4 v0, v1;
#pragma unroll
                for (int e = 0; e < 4; ++e) {
                    v0[e] = o0[e] + acc[ai][0][m][0][e] * (1.0f / (1.0f + __expf(-acc[ai][1][m][0][e])));
                    v1[e] = o1[e] + acc[ai][0][m][1][e] * (1.0f / (1.0f + __expf(-acc[ai][1][m][1][e])));
                }
                *(f32x4*)xr = v0; *(f32x4*)(xr + 4) = v1;
                *(u32x4*)(XB + (size_t)row * 1024 + col) = pack8(v0, v1);
                float ss = sumsq4(v0) + sumsq4(v1);
                ss += __shfl_xor(ss, 16); ss += __shfl_xor(ss, 32);
                if (fq == 0) ssp[(size_t)row * 64 + pn * 4 + wc] = ss;
                asm volatile("" ::: "memory");
            }
        {
            const int xrow = u.pm * 16 + fr, row = XMP + xrow;
            const int col = pn * 128 + wc * 32 + 8 * fq + 4 * wr;
            float* xr = XR + (size_t)row * 1024 + col;
            const f32x4 o0 = *(const f32x4*)xr;
            f32x4 v;
#pragma unroll
            for (int e = 0; e < 4; ++e) v[e] = o0[e] + accx[0][e] * (1.0f / (1.0f + __expf(-accx[1][e])));
            *(f32x4*)xr = v;
            *(u32x2*)(XB + (size_t)row * 1024 + col) = pack4(v);
            float ss = sumsq4(v);
            ss += __shfl_xor(ss, 16); ss += __shfl_xor(ss, 32);
            if (fq == 0) ssp[(size_t)row * 64 + (pn * 4 + wc) * 2 + wr] = ss;
        }
    }
};
struct EpiUp {
    static constexpr bool PERM = true, AFTER_DRAIN = false;
    bf16_t* H; const float* ssp; int np, nps;
    __device__ __forceinline__ void operator()(const f32x4 (&acc)[2][2][4][2], const f32x4 (&accx)[2], const Unit& u, int wr, int wc, int fr, int fq) const {
        const int rowb = u.pm * BM + wr * 64 + fr, pn = u.pn;
#pragma unroll
        for (int ai = 0; ai < 2; ++ai)
#pragma unroll
            for (int m = 0; m < 4; ++m) {
                const int row = rowb + ai * HALF + m * 16;
                const float r = row_rinv(ssp, row, np, fq);
#pragma unroll
                for (int bj = 0; bj < 2; ++bj) {
                    f32x4 v0 = acc[ai][bj][m][0] * r, v1 = acc[ai][bj][m][1] * r;
#pragma unroll
                    for (int e = 0; e < 4; ++e) { const float a = fmaxf(v0[e], 0.f), b = fmaxf(v1[e], 0.f); v0[e] = a * a; v1[e] = b * b; }
                    *(u32x4*)(H + (size_t)row * 4096 + pn * 256 + bj * HALF + wc * 32 + 8 * fq) = pack8(v0, v1);
                }
            }
        {
            const int xrow = u.pm * 16 + fr, row = XMP + xrow;
            const float r = row_rinv(ssp, row, nps, fq);
#pragma unroll
            for (int bj = 0; bj < 2; ++bj) {
                f32x4 v = accx[bj] * r;
#pragma unroll
                for (int e = 0; e < 4; ++e) { const float a = fmaxf(v[e], 0.f); v[e] = a * a; }
                *(u32x2*)(H + (size_t)row * 4096 + pn * 256 + bj * HALF + wc * 32 + 8 * fq + 4 * wr) = pack4(v);
            }
        }
    }
};

template <class Epi, class Sched>
__device__ __forceinline__ void gemm_phase_x(PG8_LAS unsigned char* lds, const Gemm g, const Sched& S, const Epi& E) {
    int tid_ = threadIdx.x; asm volatile("" : "+v"(tid_));
    const int tid = tid_, wid = __builtin_amdgcn_readfirstlane(tid >> 6), lane = tid & 63, wr = wid >> 2, wc = wid & 3, fr = lane & 15, fq = lane >> 4;
    const int K = g.K, nt = K / BK;
    unsigned voffA[2], voffB[2], voffX;
#pragma unroll
    for (int i = 0; i < 2; ++i) { int R, C; stage_rc(tid * 16 + i * 8192, R, C); const int Rb = Epi::PERM ? ((R & ~31) + perm32(R & 31)) : R;
        voffA[i] = (unsigned)(R * K + C) * 2u; voffB[i] = (unsigned)(Rb * K + C) * 2u; }
    { int R, C; const int p = wid * 256 + lane * 4; stage_rc(p & ~15, R, C); voffX = (unsigned)(R * K + C) * 2u + (unsigned)(p & 15); }
    const size_t kstep = (size_t)(BK * 2);
    const size_t hstep = (size_t)HALF * K * 2;
    const size_t tstep = 2 * hstep;
    const size_t xstep = (size_t)16 * K * 2;
    const unsigned ldsw = (unsigned)wid * 1024u, ldsx = (unsigned)wid * 256u;
    const int aoff = lds_byte(wr * 64 + fr, fq * 8), boff = lds_byte(wc * 32 + fr, fq * 8), xoff = lds_byte(fr, fq * 8);
#define PG8_SA(b, h) (((b) * 2 + (h)) * HTB)
#define PG8_SB(b, h) ((4 + (b) * 2 + (h)) * HTB)
#define PG8_XA(b) (STAGE_BYTES + (b) * 2048)
#define PG8_STAGE(bufoff, gbase, voff) do { _Pragma("unroll") for (int _i = 0; _i < 2; ++_i) \
        __builtin_amdgcn_global_load_lds((const unsigned*)((const char*)(gbase) + (voff)[_i]), (PG8_LAS unsigned*)(lds + (bufoff) + ldsw + _i * 8192), 16, 0, 0); } while (0)
#define PG8_STAGEX(b, gbase) __builtin_amdgcn_global_load_lds((const unsigned*)((const char*)(gbase) + voffX), (PG8_LAS unsigned*)(lds + PG8_XA(b) + ldsx), 4, 0, 0)
#define PG8_LDA(dst, b, h) do { _Pragma("unroll") for (int m = 0; m < 4; ++m) _Pragma("unroll") for (int k = 0; k < 2; ++k) dst[m][k] = *(const PG8_LAS bf16x8*)(lds + PG8_SA(b, h) + aoff + m * 2048 + k * 1024); } while (0)
#define PG8_LDB(dst, b, h) do { _Pragma("unroll") for (int n = 0; n < 2; ++n) _Pragma("unroll") for (int k = 0; k < 2; ++k) dst[n][k] = *(const PG8_LAS bf16x8*)(lds + PG8_SB(b, h) + boff + n * 2048 + k * 1024); } while (0)
#define PG8_LDX(dst, b) do { _Pragma("unroll") for (int k = 0; k < 2; ++k) dst[k] = *(const PG8_LAS bf16x8*)(lds + PG8_XA(b) + xoff + k * 1024); } while (0)
#define PG8_MMA(ai, bj, At, Bt) do { __builtin_amdgcn_s_setprio(1); _Pragma("unroll") for (int m = 0; m < 4; ++m) _Pragma("unroll") for (int n = 0; n < 2; ++n) _Pragma("unroll") for (int k = 0; k < 2; ++k) \
        acc[ai][bj][m][n] = __builtin_amdgcn_mfma_f32_16x16x32_bf16(Bt[n][k], At[m][k], acc[ai][bj][m][n], 0, 0, 0); __builtin_amdgcn_s_setprio(0); } while (0)
#define PG8_XMMA() do { if (wr == 0) { _Pragma("unroll") for (int k = 0; k < 2; ++k) { accx[0] = __builtin_amdgcn_mfma_f32_16x16x32_bf16(B0[0][k], Ax[k], accx[0], 0, 0, 0); accx[1] = __builtin_amdgcn_mfma_f32_16x16x32_bf16(B1[0][k], Ax[k], accx[1], 0, 0, 0); } } \
        else { _Pragma("unroll") for (int k = 0; k < 2; ++k) { accx[0] = __builtin_amdgcn_mfma_f32_16x16x32_bf16(B0[1][k], Ax[k], accx[0], 0, 0, 0); accx[1] = __builtin_amdgcn_mfma_f32_16x16x32_bf16(B1[1][k], Ax[k], accx[1], 0, 0, 0); } } } while (0)
#define PG8_WAIT_V(n) asm volatile("s_waitcnt vmcnt(" #n ")" ::: "memory")
#define PG8_WAIT_L(n) asm volatile("s_waitcnt lgkmcnt(" #n ")" ::: "memory")
#define PG8_BAR __builtin_amdgcn_s_barrier()
#define PG8_SCHED __builtin_amdgcn_sched_barrier(0)
    Unit cur, nxt; int ui = 0;
    if (!S.next(0, cur)) return;
    f32x4 acc[2][2][4][2]; f32x4 accx[2];
#pragma unroll
    for (int a = 0; a < 2; ++a)
#pragma unroll
        for (int b = 0; b < 2; ++b)
#pragma unroll
            for (int m = 0; m < 4; ++m)
#pragma unroll
                for (int n = 0; n < 2; ++n) acc[a][b][m][n] = (f32x4){0.f, 0.f, 0.f, 0.f};
    accx[0] = (f32x4){0.f, 0.f, 0.f, 0.f}; accx[1] = (f32x4){0.f, 0.f, 0.f, 0.f};
    bf16x8 At[4][2], B0[2][2], B1[2][2], Ax[2];
    const char* const xbase = (const char*)g.A + (size_t)XMP * K * 2;
    const char* cA = (const char*)g.A + (size_t)cur.pm * tstep; const char* cB = (const char*)g.Bt + (size_t)cur.pn * tstep; const char* cX = xbase + (size_t)cur.pm * xstep;
    S.a_ready(cur);
    PG8_STAGE(PG8_SB(0, 0), cB, voffB); PG8_STAGE(PG8_SB(0, 1), cB + hstep, voffB); PG8_STAGE(PG8_SA(0, 0), cA, voffA); PG8_STAGEX(0, cX); PG8_STAGE(PG8_SA(0, 1), cA + hstep, voffA);
    if (wr == 1) PG8_BAR;
    PG8_WAIT_V(2); PG8_BAR;
    PG8_STAGE(PG8_SB(1, 0), cB + kstep, voffB); PG8_STAGE(PG8_SA(1, 0), cA + kstep, voffA); PG8_STAGE(PG8_SB(1, 1), cB + hstep + kstep, voffB); PG8_STAGEX(1, cX + kstep);
    PG8_WAIT_V(7); PG8_BAR;
    for (;;) {
        const bool has_next = S.next(ui + 1, nxt);
        const char* nA = has_next ? (const char*)g.A + (size_t)nxt.pm * tstep : cA; const char* nB = has_next ? (const char*)g.Bt + (size_t)nxt.pn * tstep : cB; const char* nX = has_next ? xbase + (size_t)nxt.pm * xstep : cX;
        for (int t = 0; t < nt; t += 2) {
            const bool last = (t == nt - 2);
            const char* a1 = cA + (size_t)(t + 1) * kstep;
            const char* a2 = last ? nA : cA + (size_t)(t + 2) * kstep; const char* b2 = last ? nB : cB + (size_t)(t + 2) * kstep; const char* x2 = last ? nX : cX + (size_t)(t + 2) * kstep;
            const char* a3 = a2 + kstep; const char* b3 = b2 + kstep; const char* x3 = x2 + kstep;
            if (last && has_next) S.a_ready(nxt);
            PG8_LDB(B0, 0, 0); PG8_LDB(B1, 0, 1); PG8_SCHED; PG8_LDA(At, 0, 0); PG8_LDX(Ax, 0); PG8_STAGE(PG8_SA(1, 1), a1 + hstep, voffA);
            PG8_WAIT_V(9); PG8_WAIT_L(0); PG8_BAR; PG8_MMA(0, 0, At, B0); PG8_MMA(0, 1, At, B1); PG8_XMMA(); PG8_BAR; PG8_SCHED;
            PG8_LDA(At, 0, 1); PG8_STAGE(PG8_SB(0, 0), b2, voffB); PG8_STAGE(PG8_SB(0, 1), b2 + hstep, voffB); PG8_STAGE(PG8_SA(0, 0), a2, voffA); PG8_STAGEX(0, x2);
            PG8_WAIT_V(9); PG8_WAIT_L(0); PG8_BAR; PG8_MMA(1, 0, At, B0); PG8_MMA(1, 1, At, B1); PG8_BAR; PG8_SCHED;
            PG8_LDB(B0, 1, 0); PG8_LDB(B1, 1, 1); PG8_SCHED; PG8_LDA(At, 1, 0); PG8_LDX(Ax, 1); PG8_STAGE(PG8_SA(0, 1), a2 + hstep, voffA);
            PG8_WAIT_V(9); PG8_WAIT_L(0); PG8_BAR; PG8_MMA(0, 0, At, B0); PG8_MMA(0, 1, At, B1); PG8_XMMA(); PG8_BAR; PG8_SCHED;
            PG8_LDA(At, 1, 1); PG8_STAGE(PG8_SB(1, 0), b3, voffB); PG8_STAGE(PG8_SB(1, 1), b3 + hstep, voffB); PG8_STAGE(PG8_SA(1, 0), a3, voffA); PG8_STAGEX(1, x3);
            PG8_WAIT_V(9); PG8_WAIT_L(0); PG8_BAR; PG8_MMA(1, 0, At, B0); PG8_MMA(1, 1, At, B1); PG8_BAR; PG8_SCHED;
        }
        if (wr == 0) PG8_BAR;
        { int fr_ = fr, fq_ = fq; asm volatile("" : "+v"(fr_), "+v"(fq_));
          E(acc, accx, cur, wr, wc, fr_, fq_); } S.done(cur);
        if (!has_next) break;
#pragma unroll
        for (int a = 0; a < 2; ++a)
#pragma unroll
            for (int b = 0; b < 2; ++b)
#pragma unroll
                for (int m = 0; m < 4; ++m)
#pragma unroll
                    for (int n = 0; n < 2; ++n) acc[a][b][m][n] = (f32x4){0.f, 0.f, 0.f, 0.f};
        accx[0] = (f32x4){0.f, 0.f, 0.f, 0.f}; accx[1] = (f32x4){0.f, 0.f, 0.f, 0.f};
        cur = nxt; cA = nA; cB = nB; cX = nX; ++ui;
        if (wr == 1) PG8_BAR;
    }
    PG8_WAIT_V(0);
    PG8_BAR;
#undef PG8_SA
#undef PG8_SB
#undef PG8_XA
#undef PG8_STAGE
#undef PG8_STAGEX
#undef PG8_LDA
#undef PG8_LDB
#undef PG8_LDX
#undef PG8_MMA
#undef PG8_XMMA
#undef PG8_WAIT_V
#undef PG8_WAIT_L
#undef PG8_BAR
#undef PG8_SCHED
}
}

__device__ __forceinline__ void p0_transpose_item(const float* W, int K, int N, const float* gain, bf16* WT, int glu, LAS float* scr, int item, int lane) {
    const int nblk = N / 32, kb = item / nblk, nb = item % nblk, k0 = 64 * kb, n0 = 32 * nb;
#pragma unroll 8
    for (int i = 0; i < 32; ++i) { const int kk = 2 * i + (lane >> 5); float w = W[(size_t)(k0 + kk) * N + n0 + (lane & 31)]; if (gain) w *= gain[k0 + kk]; scr[kk * 33 + (lane & 31)] = w; }
    LDS_WAIT(); asm volatile("" ::: "memory");
    int drow0 = n0; if (glu) { const int bj = n0 / 1024, rem = n0 % 1024; drow0 = (rem / 128) * 256 + bj * 128 + (rem % 128); }
    const int c = lane & 7;
#pragma unroll
    for (int j = 0; j < 4; ++j) { const int n = (lane >> 3) + 8 * j; const LAS float* s = scr + (8 * c) * 33 + n;
        v4u o; o.x = pk2(s[0 * 33], s[1 * 33]); o.y = pk2(s[2 * 33], s[3 * 33]); o.z = pk2(s[4 * 33], s[5 * 33]); o.w = pk2(s[6 * 33], s[7 * 33]);
        *(GAS v4u*)(WT + (size_t)(drow0 + n) * K + k0 + 8 * c) = o; }
    LDS_WAIT(); asm volatile("" ::: "memory");
}

__device__ __forceinline__ void sincos_rr(float x, float& s, float& c) {
    const float q = rintf(x * 0.63661977236758f);
    float r = fmaf(-q, 1.57079637050629f, x); r = fmaf(-q, -4.37113882867379e-8f, r);
    const float r2 = r * r;
    const float sp = r + r * r2 * (-1.6666667163e-1f + r2 * (8.3333337680e-3f + r2 * (-1.9841270114e-4f + r2 * 2.7557314297e-6f)));
    const float cp = 1.0f + r2 * (-0.5f + r2 * (4.1666667908e-2f + r2 * (-1.3888889225e-3f + r2 * (2.4801587642e-5f + r2 * -2.7557314297e-7f))));
    const int qi = (int)q & 3;
    s = (qi == 0) ? sp : (qi == 1) ? cp : (qi == 2) ? -sp : -cp;
    c = (qi == 0) ? cp : (qi == 1) ? -sp : (qi == 2) ? -cp : sp;
}

typedef float f32x16 __attribute__((ext_vector_type(16)));
typedef unsigned u32x2 __attribute__((ext_vector_type(2)));
__device__ __forceinline__ void ssm_abar_calc(const float* A_re, const float* A_im, const float* log_dt, int g, int n, float& abr, float& abi, float& cfr, float& cfi) {
    const float dt = expf(log_dt[g]);
    const float ar = A_re[g * 64 + n], ai = A_im[g * 64 + n];
    const float mag = expf(dt * ar); float sn, cs; sincos_rr(dt * ai, sn, cs);
    abr = mag * cs; abi = mag * sn;
    const float den = ar * ar + ai * ai, nr = abr - 1.0f;
    cfr = (nr * ar + abi * ai) / den; cfi = (abi * ar - nr * ai) / den;
}
__device__ __forceinline__ float gelu_tanh(float y) {
    const float z = 0.7978845608028654f * (y + 0.044715f * y * y * y);
    return y / (1.0f + __expf(-2.0f * z));
}
struct SsmT { const bf16* BT; const bf16* CT; const float* tab; const float* Dk; const float* gain; };
template <int MODE>
__device__ __forceinline__ void ssm_mfma_unit(LAS unsigned char* wl, int lane, int g, const SsmT& T, const bf16* XB, const float* XR, const float* ssp, int np, int row0, int nblk,
                                              float (&st)[4]  , bf16* Gout, const float* h0r, const float* h0i, float* hor, float* hoi  , int b0) {
    const int r32 = lane & 31, hi5 = lane >> 5, c16 = lane & 15, kq = lane >> 4;
    LAS float* rv = (LAS float*)(wl + 8704);
    pg8::bf16x8 bt[4], ct[4];
#pragma unroll
    for (int tn = 0; tn < 4; ++tn) bt[tn] = *(const pg8::bf16x8*)(T.BT + (size_t)(tn * 32 + r32) * 16 + 8 * hi5);
    if (MODE != 0) {
#pragma unroll
        for (int ks = 0; ks < 4; ++ks) ct[ks] = *(const pg8::bf16x8*)(T.CT + (size_t)c16 * 128 + 32 * ks + 8 * kq);
    }
    float ar[2], ai[2];
    { const f32x4 t0 = *(const f32x4*)(T.tab + (size_t)r32 * 4), t1 = *(const f32x4*)(T.tab + (size_t)(32 + r32) * 4); ar[0] = t0[0]; ai[0] = t0[1]; ar[1] = t1[0]; ai[1] = t1[1]; }
    f32x4 Dg = {0.f, 0.f, 0.f, 0.f};
    if (MODE != 0) { const f32x4 dv = *(const f32x4*)(T.Dk + 4 * kq), gv = *(const f32x4*)(T.gain + 4 * kq); Dg = dv * gv; }
    for (int blk = 0; blk < nblk; ++blk) {
        const int rowb = row0 + 32 * blk;
        if (lane < 32) {
            const float* sp = ssp + (size_t)(rowb + lane) * 64; float ss = 0.f;
            for (int i4 = 0; i4 < (np >> 2); ++i4) { const f32x4 sv = *(const f32x4*)(sp + 4 * i4); ss += (sv[0] + sv[1]) + (sv[2] + sv[3]); }
            rv[lane] = rsqrtf(ss * (1.0f / 1024.0f) + 1e-6f);
        }
        const pg8::bf16x8 xa = *(const pg8::bf16x8*)(XB + (size_t)(rowb + r32) * 1024 + g * 16 + 8 * hi5);
        f32x16 IN[4];
#pragma unroll
        for (int tn = 0; tn < 4; ++tn) { const f32x16 z = {0.f, 0.f, 0.f, 0.f, 0.f, 0.f, 0.f, 0.f, 0.f, 0.f, 0.f, 0.f, 0.f, 0.f, 0.f, 0.f}; IN[tn] = __builtin_amdgcn_mfma_f32_32x32x16_bf16(xa, bt[tn], z, 0, 0, 0); }
        LDS_WAIT(); asm volatile("" ::: "memory");
        {
            f32x4 rq[4];
#pragma unroll
            for (int Q = 0; Q < 4; ++Q) rq[Q] = *(const LAS f32x4*)(rv + 8 * Q + 4 * hi5);
#pragma unroll
            for (int tn = 0; tn < 4; ++tn)
#pragma unroll
                for (int r = 0; r < 16; ++r) IN[tn][r] *= rq[r >> 2][r & 3];
        }
#pragma unroll
        for (int p = 0; p < 2; ++p) {
            float sr = st[2 * p], si = st[2 * p + 1];
            const float a_r = ar[p], a_i = ai[p];
#pragma unroll
            for (int Q = 0; Q < 4; ++Q) {
                if (MODE == 2) { const size_t hidx = ((size_t)(b0 + Q) * 64 + g) * 64 + 32 * p + r32; sr = h0r[hidx]; si = h0i[hidx]; }
                if (hi5 == 0) {
#pragma unroll
                    for (int e = 0; e < 4; ++e) { const float tr = a_r * sr - a_i * si + IN[2 * p][4 * Q + e], ti = a_r * si + a_i * sr + IN[2 * p + 1][4 * Q + e]; sr = tr; si = ti; IN[2 * p][4 * Q + e] = sr; IN[2 * p + 1][4 * Q + e] = si; }
                }
                { auto w0 = __builtin_amdgcn_permlane32_swap(__float_as_uint(sr), __float_as_uint(sr), false, false); sr = __uint_as_float(w0[0]);
                  auto w1 = __builtin_amdgcn_permlane32_swap(__float_as_uint(si), __float_as_uint(si), false, false); si = __uint_as_float(w1[0]); }
                if (hi5 == 1) {
#pragma unroll
                    for (int e = 0; e < 4; ++e) { const float tr = a_r * sr - a_i * si + IN[2 * p][4 * Q + e], ti = a_r * si + a_i * sr + IN[2 * p + 1][4 * Q + e]; sr = tr; si = ti; IN[2 * p][4 * Q + e] = sr; IN[2 * p + 1][4 * Q + e] = si; }
                }
                { auto w0 = __builtin_amdgcn_permlane32_swap(__float_as_uint(sr), __float_as_uint(sr), false, false); sr = __uint_as_float(w0[1]);
                  auto w1 = __builtin_amdgcn_permlane32_swap(__float_as_uint(si), __float_as_uint(si), false, false); si = __uint_as_float(w1[1]); }
                if (MODE == 2) { if (hi5 == 0) { const size_t hidx = ((size_t)(b0 + Q) * 64 + g) * 64 + 32 * p + r32; hor[hidx] = sr; hoi[hidx] = si; } }
            }
            st[2 * p] = sr; st[2 * p + 1] = si;
        }
        if (MODE != 0) {
#pragma unroll
            for (int p = 0; p < 2; ++p)
#pragma unroll
                for (int r = 0; r < 16; ++r) { const int tau = 8 * (r >> 2) + 4 * hi5 + (r & 3); *(LAS unsigned*)(wl + tau * 272 + 4 * (32 * p + r32)) = pg8::cvt_pk_bf16(IN[2 * p][r], IN[2 * p + 1][r]); }
            LDS_WAIT(); asm volatile("" ::: "memory");
#pragma unroll
            for (int tt = 0; tt < 2; ++tt) {
                f32x4 y = {0.f, 0.f, 0.f, 0.f};
#pragma unroll
                for (int ks = 0; ks < 4; ++ks) { const pg8::bf16x8 hf = *(const LAS pg8::bf16x8*)(wl + (16 * tt + c16) * 272 + (32 * ks + 8 * kq) * 2); y = __builtin_amdgcn_mfma_f32_16x16x32_bf16(ct[ks], hf, y, 0, 0, 0); }
                const int token = rowb + 16 * tt + c16;
                const float rinv = rv[16 * tt + c16];
                const f32x4 xv = *(const f32x4*)(XR + (size_t)token * 1024 + g * 16 + 4 * kq);
                f32x4 o;
#pragma unroll
                for (int e = 0; e < 4; ++e) o[e] = gelu_tanh(y[e] + Dg[e] * (xv[e] * rinv));
                *(u32x2*)(Gout + (size_t)token * 1024 + g * 16 + 4 * kq) = pg8::pack4(o);
            }
        }
        LDS_WAIT(); asm volatile("" ::: "memory");
    }
}

#ifndef PROBE_DUP
#define PROBE_DUP 0
#endif
#define NREP(bit) (((PROBE_DUP) >> (bit)) & 1 ? 2 : 1)
#ifndef EN_P0
#define EN_P0 1
#endif
#ifndef EN_QKV
#define EN_QKV 1
#endif
#ifndef EN_ATT
#define EN_ATT 1
#endif
#ifndef EN_OPJ
#define EN_OPJ 1
#endif
#ifndef EN_S1
#define EN_S1 1
#endif
#ifndef EN_S3
#define EN_S3 1
#endif
#ifndef EN_GLU
#define EN_GLU 1
#endif
#ifndef EN_UP
#define EN_UP 1
#endif
#ifndef EN_DN
#define EN_DN 1
#endif
#ifndef EN_FIN
#define EN_FIN 1
#endif
template <class T> __device__ __forceinline__ T karg(const __attribute__((address_space(4))) char* ka, int off) { typedef const __attribute__((address_space(4))) T CT; return *(CT*)(ka + off); }
struct Args { const float* in[23]; float* out; unsigned char* ws; int ph_lo, ph_hi; };
static_assert(sizeof(Args) == 208 && __builtin_offsetof(Args, out) == 184 && __builtin_offsetof(Args, ws) == 192, "kernarg layout used by KARG");

__global__ void __launch_bounds__(512, 2) fwd_kernel(Args args) {
    extern __shared__ __attribute__((aligned(16))) unsigned char lds[];
    LAS unsigned char* const L = (LAS unsigned char*)lds;
#define FRESH_IDS int tid = threadIdx.x; asm volatile("" : "+v"(tid)); const int lane = tid & 63, wave = __builtin_amdgcn_readfirstlane(tid >> 6); const int gw = vcu * 8 + wave; (void)lane; (void)gw
    const int G = gridDim.x, bx = blockIdx.x;
    const int vcu = (G % 8 == 0) ? (bx % 8) * (G / 8) + bx / 8 : bx;
    const int NGW = G * 8;
    for (int u = threadIdx.x; u < (LDS_BYTES - LDSCTL_OFF) / 4; u += 512) ((LAS unsigned*)(L + LDSCTL_OFF))[u] = 0u;
    __syncthreads();
    const int lo = args.ph_lo, hi = args.ph_hi;
    const bool multi = (hi - lo) > 1;
    XcdBarrier bar; bar.bar = (unsigned*)(args.ws + WS_CTL) + CW_BAR; bar.x = 0; bar.st = nullptr;
    if (multi) bar = xcd_barrier_post((unsigned*)(args.ws + WS_CTL) + CW_BAR, (volatile LAS unsigned*)(L + MISC_OFF) + 8);
#define IN(k) (lo <= (k) && (k) < hi)
#define SEAM(k) do { if (IN(k) && IN((k) + 1)) xcd_barrier(bar); } while (0)

#define KARG(T, off) karg<T>(ka, (off))
#define INP(k) karg<const float*>(ka, 8 * (k))
#define FRESH_PTRS const __attribute__((address_space(4))) char* ka = (const __attribute__((address_space(4))) char*)__builtin_amdgcn_kernarg_segment_ptr(); asm volatile("" : "+s"(ka)); \
    unsigned char* const ws = KARG(unsigned char*, 192); float* const out = KARG(float*, 184); \
    float* const ssp = (float*)(ws + WS_SSP); float* const HS = (float*)(ws + WS_HS); bf16* const XB = (bf16*)(ws + WS_XB); bf16* const Hb = (bf16*)(ws + WS_H); \
    bf16* const Qb = (bf16*)(ws + WS_Q); bf16* const Kb = (bf16*)(ws + WS_K); bf16* const Vb = (bf16*)(ws + WS_V); bf16* const Ob = (bf16*)(ws + WS_O); \
    const float* const x_p = INP(0); const float* const x_s = INP(1); (void)ssp; (void)HS; (void)XB; (void)Hb; (void)Qb; (void)Kb; (void)Vb; (void)Ob; (void)x_p; (void)x_s
    if (EN_P0 && IN(0)) for (int rp = 0; rp < NREP(0); ++rp) {
        FRESH_IDS; FRESH_PTRS;
        LAS float* scr = (LAS float*)(L + wave * 16384);
        constexpr int I_QKV = 16 * 48, I_O = 16 * 32, I_GLU = 16 * 64, I_UP = 16 * 128, I_DN = 64 * 32;
        constexpr int NITEMS = 2 * I_QKV + 2 * I_O + 2 * I_GLU + 4 * I_UP + 4 * I_DN;
        for (int it = gw; it < NITEMS; it += NGW) {
            int r = it;
            if (r < 2 * I_QKV) { const int j = r / I_QKV; r -= j * I_QKV; p0_transpose_item(INP(9) + (size_t)j * D * NQKV, D, NQKV, INP(6) + (size_t)(2 * j) * D, (bf16*)(ws + WS_WQKV) + (size_t)j * NQKV * D, 0, scr, r, lane); continue; } r -= 2 * I_QKV;
            if (r < 2 * I_O) { const int j = r / I_O; r -= j * I_O; p0_transpose_item(INP(10) + (size_t)j * D * D, D, D, nullptr, (bf16*)(ws + WS_WO) + (size_t)j * D * D, 0, scr, r, lane); continue; } r -= 2 * I_O;
            if (r < 2 * I_GLU) { const int j = r / I_GLU; r -= j * I_GLU; p0_transpose_item(INP(20) + (size_t)j * D * 2 * D, D, 2 * D, nullptr, (bf16*)(ws + WS_WGLU) + (size_t)j * 2 * D * D, 1, scr, r, lane); continue; } r -= 2 * I_GLU;
            if (r < 4 * I_UP) { const int l = r / I_UP; r -= l * I_UP; p0_transpose_item(INP(21) + (size_t)l * D * FF, D, FF, INP(7) + (size_t)l * D, (bf16*)(ws + WS_WUP) + (size_t)l * FF * D, 0, scr, r, lane); continue; } r -= 4 * I_UP;
            { const int l = r / I_DN; r -= l * I_DN; p0_transpose_item(INP(22) + (size_t)l * FF * D, FF, D, nullptr, (bf16*)(ws + WS_WDN) + (size_t)l * D * FF, 0, scr, r, lane); }
        }
        for (int m = gw; m < M; m += NGW) {
            const float* xrow = (m < MP) ? x_p + (size_t)m * D : x_s + (size_t)(m - MP) * D;
            const GAS f32x4* xr = (const GAS f32x4*)xrow + lane;
            f32x4 v[4]; float s = 0.f;
#pragma unroll
            for (int j = 0; j < 4; ++j) { v[j] = xr[64 * j]; s += (v[j][0] * v[j][0] + v[j][1] * v[j][1]) + (v[j][2] * v[j][2] + v[j][3] * v[j][3]); }
            s = wave_sum(s);
            GAS unsigned long long* o8 = (GAS unsigned long long*)(XB + (size_t)m * D) + lane;
#pragma unroll
            for (int j = 0; j < 4; ++j) o8[64 * j] = (unsigned long long)pk2(v[j][0], v[j][1]) | ((unsigned long long)pk2(v[j][2], v[j][3]) << 32);
            if (lane < 32) ssp[(size_t)m * 64 + lane] = (lane == 0) ? s : 0.f;
        }
        for (int i = bx * 512 + tid; i < 2 * NG * NS; i += G * 512) {
            const int jj = i >> 12, gn = i & 4095, g = gn >> 6, n = gn & 63; float abr, abi, cfr, cfi;
            ssm_abar_calc(INP(12) + (size_t)jj * NG * NS, INP(13) + (size_t)jj * NG * NS, INP(14) + (size_t)jj * NG, g, n, abr, abi, cfr, cfi);
            f32x4 v; v[0] = abr; v[1] = abi; v[2] = cfr; v[3] = cfi; *(f32x4*)((float*)(ws + WS_TAB) + (size_t)i * 4) = v;
            const float* bre = INP(15) + (size_t)i * 16; const float* bim = INP(16) + (size_t)i * 16; const float* gn_ = INP(6) + (size_t)(2 * jj + 1) * D + g * 16;
            bf16* btr = (bf16*)(ws + WS_BT) + ((size_t)(jj * NG + g) * 128 + (2 * (n >> 5)) * 32 + (n & 31)) * 16; bf16* bti = btr + 32 * 16;
#pragma unroll
            for (int c8 = 0; c8 < 2; ++c8) {
                float wr_[8], wi_[8];
#pragma unroll
                for (int c4 = 0; c4 < 2; ++c4) { const f32x4 br = *(const f32x4*)(bre + 8 * c8 + 4 * c4), bi = *(const f32x4*)(bim + 8 * c8 + 4 * c4), gv = *(const f32x4*)(gn_ + 8 * c8 + 4 * c4);
#pragma unroll
                    for (int e = 0; e < 4; ++e) { wr_[4 * c4 + e] = (cfr * br[e] - cfi * bi[e]) * gv[e]; wi_[4 * c4 + e] = (cfr * bi[e] + cfi * br[e]) * gv[e]; } }
                v4u o; o.x = pk2(wr_[0], wr_[1]); o.y = pk2(wr_[2], wr_[3]); o.z = pk2(wr_[4], wr_[5]); o.w = pk2(wr_[6], wr_[7]); *(v4u*)(btr + 8 * c8) = o;
                o.x = pk2(wi_[0], wi_[1]); o.y = pk2(wi_[2], wi_[3]); o.z = pk2(wi_[4], wi_[5]); o.w = pk2(wi_[6], wi_[7]); *(v4u*)(bti + 8 * c8) = o;
            }
        }
        for (int i = bx * 512 + tid; i < 2 * NG * GC * 16; i += G * 512) {
            const int n4 = i & 15; const size_t rowi = (size_t)(i >> 4);
            const f32x4 cr = *(const f32x4*)(INP(17) + rowi * 64 + 4 * n4), ci = *(const f32x4*)(INP(18) + rowi * 64 + 4 * n4);
            v4u o; o.x = pk2(cr[0], -ci[0]); o.y = pk2(cr[1], -ci[1]); o.z = pk2(cr[2], -ci[2]); o.w = pk2(cr[3], -ci[3]);
            *(v4u*)((bf16*)(ws + WS_CT) + rowi * 128 + 8 * n4) = o;
        }
        {
            constexpr int PER = 120 * 256 / 4;
            constexpr int TOT = 2 * 2 * SB * PER;
            for (int i = bx * 512 + tid; i < TOT; i += G * 512) {
                const int kv = i / (2 * SB * PER), rem = i % (2 * SB * PER), jb = rem / PER, e = rem % PER;
                const f32x4 v = *((const f32x4*)(INP(2 + kv) + (size_t)jb * 128 * 256 + 8 * 256) + e);
                *((f32x4*)(out + (kv ? O_VS : O_KS) + (size_t)jb * 128 * 256) + e) = v;
            }
        }
        __syncthreads();
    }
    SEAM(0);

    for (int l = 0; l < 4; ++l) {
        const int pb = 1 + 5 * l, j = l >> 1;
        if ((l & 1) == 0) {
            if (EN_QKV && IN(pb)) for (int rp = 0; rp < NREP(3); ++rp) {
                FRESH_PTRS;
                pg8::Gemm g{XB, (const bf16*)(ws + WS_WQKV) + (size_t)j * NQKV * D, M, NQKV, D}; pg8::StaticOrder S; S.init(MP, NQKV, G, bx);
                pg8::EpiQKV E{Qb, Kb, Vb, ssp, 16, 32, out + O_KP + (size_t)j * 2 * 128 * 256, out + O_VP + (size_t)j * 2 * 128 * 256, out + O_KS + (size_t)j * SB * 128 * 256, out + O_VS + (size_t)j * SB * 128 * 256};
                pg8::gemm_phase_x<pg8::EpiQKV, pg8::StaticOrder>(L, g, S, E);
            }
            SEAM(pb);
            if (EN_ATT && IN(pb + 1)) for (int rp = 0; rp < NREP(1); ++rp) {
                FRESH_IDS; FRESH_PTRS;
                const LAS unsigned char* Kl = L; const LAS unsigned char* Vl = L + 36864;
                const float* ck = INP(2) + (size_t)j * SB * 128 * 256; const float* cv = INP(3) + (size_t)j * SB * 128 * 256;
                const float* sinks = INP(11) + j * 16;
                const int r32 = lane & 31, hi5 = lane >> 5;
                for (int u = vcu; u < 1024; u += G) {
                    const bool samp = u >= 512;
                    int b, qblk = 0, kvh;
                    if (!samp) { kvh = u & 3; qblk = (u >> 2) & 63; b = u >> 8; } else { const int us = u - 512; kvh = us & 3; b = us >> 2; }
                    const int nchunk = samp ? 160 * 8 : 256 * 8;
                    for (int id = tid; id < nchunk; id += 512) {
                        const int key = id >> 3, ch = id & 7;
                        v4u kv = {0u, 0u, 0u, 0u}, vv = {0u, 0u, 0u, 0u};
                        if (!samp) {
                            const int s = qblk * 128 - 128 + key;
                            if (s >= 0) { const size_t off = (size_t)((b << 13) + s) * 256 + kvh * 64 + ch * 8; kv = *(const v4u*)(Kb + off); vv = *(const v4u*)(Vb + off); }
                        } else if (key < 128) {
                            const size_t off = ((size_t)b * 128 + key) * 256 + kvh * 64 + ch * 8;
                            const f32x4 k0 = *(const f32x4*)(ck + off), k1 = *(const f32x4*)(ck + off + 4), v0 = *(const f32x4*)(cv + off), v1 = *(const f32x4*)(cv + off + 4);
                            kv.x = pk2(k0[0], k0[1]); kv.y = pk2(k0[2], k0[3]); kv.z = pk2(k1[0], k1[1]); kv.w = pk2(k1[2], k1[3]);
                            vv.x = pk2(v0[0], v0[1]); vv.y = pk2(v0[2], v0[3]); vv.z = pk2(v1[0], v1[1]); vv.w = pk2(v1[2], v1[3]);
                        } else if (key < 136) {
                            const size_t off = (size_t)(MP + b * 8 + (key - 128)) * 256 + kvh * 64 + ch * 8; kv = *(const v4u*)(Kb + off); vv = *(const v4u*)(Vb + off);
                        }
                        *(LAS v4u*)(L + key * 144 + ch * 16) = kv;
                        LAS unsigned short* vt = (LAS unsigned short*)(L + 36864 + (ch * 8) * 520 + key * 2);
                        vt[0 * 260] = (unsigned short)(vv.x & 0xffffu); vt[1 * 260] = (unsigned short)(vv.x >> 16); vt[2 * 260] = (unsigned short)(vv.y & 0xffffu); vt[3 * 260] = (unsigned short)(vv.y >> 16);
                        vt[4 * 260] = (unsigned short)(vv.z & 0xffffu); vt[5 * 260] = (unsigned short)(vv.z >> 16); vt[6 * 260] = (unsigned short)(vv.w & 0xffffu); vt[7 * 260] = (unsigned short)(vv.w >> 16);
                    }
                    __syncthreads();
                    const int ntask = samp ? ((wave == 0) ? 1 : 0) : 2;
                    for (int ti = 0; ti < ntask; ++ti) {
                        int qrow, head, tloc, kb0, jkmin;
                        if (!samp) { const int sb = 2 * (wave & 1) + ti; head = kvh * 4 + (wave >> 1); tloc = 32 * sb + r32; qrow = (b << 13) + qblk * 128 + tloc; kb0 = sb; jkmin = (qblk == 0) ? 128 : 0; }
                        else { head = kvh * 4 + (r32 >> 3); tloc = r32 & 7; qrow = MP + b * 8 + tloc; kb0 = 0; jkmin = 0; }
                        const float slope2 = exp2f(-0.5f * (float)(head + 1)) * 1.4426950408889634f, sink2 = sinks[head] * 1.4426950408889634f;
                        const bf16* qptr = Qb + (size_t)qrow * 1024 + head * 64 + 8 * hi5;
                        pg8::bf16x8 qf[4];
#pragma unroll
                        for (int ks = 0; ks < 4; ++ks) qf[ks] = *(const pg8::bf16x8*)(qptr + 16 * ks);
                        f32x16 S[5];
#pragma unroll
                        for (int i = 0; i < 5; ++i) {
                            f32x16 acc = {0.f, 0.f, 0.f, 0.f, 0.f, 0.f, 0.f, 0.f, 0.f, 0.f, 0.f, 0.f, 0.f, 0.f, 0.f, 0.f};
#pragma unroll
                            for (int ks = 0; ks < 4; ++ks) { const pg8::bf16x8 kf = *(const LAS pg8::bf16x8*)(Kl + (32 * (kb0 + i) + r32) * 144 + 32 * ks + 16 * hi5); acc = __builtin_amdgcn_mfma_f32_32x32x16_bf16(kf, qf[ks], acc, 0, 0, 0); }
                            S[i] = acc;
                        }
                        float mx = sink2;
#pragma unroll
                        for (int i = 0; i < 5; ++i)
#pragma unroll
                            for (int r = 0; r < 16; ++r) {
                                const int jk = 32 * (kb0 + i) + (r & 3) + 8 * (r >> 2) + 4 * hi5; const int dist = tloc + 128 - jk;
                                const bool valid = (dist >= 0) && (dist <= 128) && (jk >= jkmin);
                                const float sv = valid ? (S[i][r] * 0.18033688011112042f - slope2 * (float)dist) : -1e30f;
                                S[i][r] = sv; mx = fmaxf(mx, sv);
                            }
                        mx = fmaxf(mx, __shfl_xor(mx, 32));
                        float lsum = 0.f;
#pragma unroll
                        for (int i = 0; i < 5; ++i)
#pragma unroll
                            for (int r = 0; r < 16; ++r) { const float p = __builtin_amdgcn_exp2f(S[i][r] - mx); S[i][r] = p; lsum += p; }
                        lsum += __shfl_xor(lsum, 32); lsum += __builtin_amdgcn_exp2f(sink2 - mx);
                        const float inv = 1.0f / lsum;
                        f32x16 O0 = {0.f, 0.f, 0.f, 0.f, 0.f, 0.f, 0.f, 0.f, 0.f, 0.f, 0.f, 0.f, 0.f, 0.f, 0.f, 0.f}, O1 = O0;
#pragma unroll
                        for (int i = 0; i < 5; ++i)
#pragma unroll
                            for (int s2 = 0; s2 < 2; ++s2) {
                                v4u pw; pw.x = pg8::cvt_pk_bf16(S[i][8 * s2 + 0], S[i][8 * s2 + 1]); pw.y = pg8::cvt_pk_bf16(S[i][8 * s2 + 2], S[i][8 * s2 + 3]);
                                pw.z = pg8::cvt_pk_bf16(S[i][8 * s2 + 4], S[i][8 * s2 + 5]); pw.w = pg8::cvt_pk_bf16(S[i][8 * s2 + 6], S[i][8 * s2 + 7]);
                                const pg8::bf16x8 pf = __builtin_bit_cast(pg8::bf16x8, pw);
                                const int keyoff = 32 * (kb0 + i) + 16 * s2 + 4 * hi5;
                                { const u32x2 lo = *(const LAS u32x2*)(Vl + r32 * 520 + keyoff * 2), hh = *(const LAS u32x2*)(Vl + r32 * 520 + (keyoff + 8) * 2);
                                  v4u vw; vw.x = lo.x; vw.y = lo.y; vw.z = hh.x; vw.w = hh.y; O0 = __builtin_amdgcn_mfma_f32_32x32x16_bf16(__builtin_bit_cast(pg8::bf16x8, vw), pf, O0, 0, 0, 0); }
                                { const u32x2 lo = *(const LAS u32x2*)(Vl + (32 + r32) * 520 + keyoff * 2), hh = *(const LAS u32x2*)(Vl + (32 + r32) * 520 + (keyoff + 8) * 2);
                                  v4u vw; vw.x = lo.x; vw.y = lo.y; vw.z = hh.x; vw.w = hh.y; O1 = __builtin_amdgcn_mfma_f32_32x32x16_bf16(__builtin_bit_cast(pg8::bf16x8, vw), pf, O1, 0, 0, 0); }
                            }
                        bf16* optr = Ob + (size_t)qrow * 1024 + head * 64 + 4 * hi5;
#pragma unroll
                        for (int qd = 0; qd < 4; ++qd) {
                            u32x2 w0; w0.x = pg8::cvt_pk_bf16(O0[4 * qd] * inv, O0[4 * qd + 1] * inv); w0.y = pg8::cvt_pk_bf16(O0[4 * qd + 2] * inv, O0[4 * qd + 3] * inv);
                            u32x2 w1; w1.x = pg8::cvt_pk_bf16(O1[4 * qd] * inv, O1[4 * qd + 1] * inv); w1.y = pg8::cvt_pk_bf16(O1[4 * qd + 2] * inv, O1[4 * qd + 3] * inv);
                            *(u32x2*)(optr + 8 * qd) = w0; *(u32x2*)(optr + 32 + 8 * qd) = w1;
                        }
                    }
                    __syncthreads();
                }
            }
            SEAM(pb + 1);
            if (EN_OPJ && IN(pb + 2)) {
                FRESH_PTRS;
                pg8::Gemm g{Ob, (const bf16*)(ws + WS_WO) + (size_t)j * D * D, M, D, D}; pg8::StaticOrder S; S.init(MP, D, G, bx);
                pg8::EpiRes E{(l == 0) ? x_p : out, (l == 0) ? x_s : out + (size_t)MP * D, out, XB, ssp};
                pg8::gemm_phase_x<pg8::EpiRes, pg8::StaticOrder>(L, g, S, E);
            }
            SEAM(pb + 2);
        } else {
#define SSMT(gg) const SsmT T_{(const bf16*)(ws + WS_BT) + ((size_t)j * NG + (gg)) * 128 * 16, (const bf16*)(ws + WS_CT) + ((size_t)j * NG + (gg)) * 16 * 128, (const float*)(ws + WS_TAB) + ((size_t)j * NG + (gg)) * NS * 4, \
                          INP(19) + (size_t)j * D + (gg) * 16, INP(6) + (size_t)l * D + (gg) * 16}
            if (EN_S1 && IN(pb)) for (int rp = 0; rp < NREP(2); ++rp) {
                FRESH_IDS; FRESH_PTRS; LAS unsigned char* wl = L + wave * 9216;
                for (int u = gw; u < NB * (NCH - 1) * NG; u += NGW) {
                    int lane = tid & 63; asm volatile("" : "+v"(lane));
                    const int g = u & 63, ch = (u >> 6) % (NCH - 1), b = (u >> 6) / (NCH - 1);
                    SSMT(g);
                    float st[4] = {0.f, 0.f, 0.f, 0.f};
                    ssm_mfma_unit<0>(wl, lane, g, T_, XB, out, ssp, 16, b * SEQ + ch * CH, CH / 32, st, nullptr, nullptr, nullptr, nullptr, nullptr, 0);
                    if (lane < 32) { float* hs = HS + ((size_t)((b * NCH + ch) * NG + g) * NS) * 2; *(float2*)(hs + 2 * lane) = make_float2(st[0], st[1]); *(float2*)(hs + 2 * (32 + lane)) = make_float2(st[2], st[3]); }
                }
                __syncthreads();
            }
            SEAM(pb);
            if (EN_S3 && IN(pb + 1)) for (int rp = 0; rp < NREP(2); ++rp) {
                FRESH_IDS; FRESH_PTRS; LAS unsigned char* wl = L + wave * 9216;
                for (int u = gw; u < NB * NCH * NG + (SB / 4) * NG; u += NGW) {
                    int lane = tid & 63; asm volatile("" : "+v"(lane));
                    if (u < NB * NCH * NG) {
                        const int g = u & 63, ch = (u >> 6) & (NCH - 1), b = u >> 11, r32 = lane & 31;
                        SSMT(g);
                        float st[4] = {0.f, 0.f, 0.f, 0.f};
#pragma unroll
                        for (int p = 0; p < 2; ++p) {
                            const f32x4 tv = *(const f32x4*)(T_.tab + (size_t)(32 * p + r32) * 4);
                            float aLr = tv[0], aLi = tv[1];
#pragma unroll
                            for (int sq = 0; sq < 8; ++sq) { const float tr = aLr * aLr - aLi * aLi, ti = 2.0f * aLr * aLi; aLr = tr; aLi = ti; }
                            float hr = 0.f, hi_ = 0.f;
                            for (int i = 0; i < ch; ++i) { const float2 e = *(const float2*)(HS + ((size_t)((b * NCH + i) * NG + g) * NS + 32 * p + r32) * 2);
                                const float tr = aLr * hr - aLi * hi_ + e.x, ti = aLr * hi_ + aLi * hr + e.y; hr = tr; hi_ = ti; }
                            st[2 * p] = hr; st[2 * p + 1] = hi_;
                        }
                        ssm_mfma_unit<1>(wl, lane, g, T_, XB, out, ssp, 16, b * SEQ + ch * CH, CH / 32, st, Ob, nullptr, nullptr, nullptr, nullptr, 0);
                        if (ch == NCH - 1 && lane < 32) { float* hr_o = out + O_HRP + ((size_t)(j * NB + b) * NG + g) * NS; float* hi_o = out + O_HIP + ((size_t)(j * NB + b) * NG + g) * NS;
                            hr_o[lane] = st[0]; hi_o[lane] = st[1]; hr_o[32 + lane] = st[2]; hi_o[32 + lane] = st[3]; }
                    } else {
                        const int us = u - NB * NCH * NG, g = us & 63, bb = us >> 6;
                        SSMT(g);
                        float st[4] = {0.f, 0.f, 0.f, 0.f};
                        ssm_mfma_unit<2>(wl, lane, g, T_, XB, out, ssp, 32, MP + bb * 32, 1, st, Ob, INP(4) + (size_t)j * SB * NG * NS, INP(5) + (size_t)j * SB * NG * NS, out + O_HRS + (size_t)j * SB * NG * NS, out + O_HIS + (size_t)j * SB * NG * NS, bb * 4);
                    }
                }
                __syncthreads();
            }
            SEAM(pb + 1);
            if (EN_GLU && IN(pb + 2)) {
                FRESH_PTRS;
                pg8::Gemm g{Ob, (const bf16*)(ws + WS_WGLU) + (size_t)j * 2 * D * D, M, 2 * D, D}; pg8::StaticOrder S; S.init(MP, 2 * D, G, bx);
                pg8::EpiGlu E{out, XB, ssp};
                pg8::gemm_phase_x<pg8::EpiGlu, pg8::StaticOrder>(L, g, S, E);
            }
            SEAM(pb + 2);
        }
        if (EN_UP && IN(pb + 3)) for (int rp = 0; rp < NREP(4); ++rp) {
            FRESH_PTRS;
            pg8::Gemm g{XB, (const bf16*)(ws + WS_WUP) + (size_t)l * FF * D, M, FF, D}; pg8::StaticOrder S; S.init(MP, FF, G, bx);
            pg8::EpiUp E{Hb, ssp, (l & 1) ? 32 : 16, (l & 1) ? 64 : 32};
            pg8::gemm_phase_x<pg8::EpiUp, pg8::StaticOrder>(L, g, S, E);
        }
        SEAM(pb + 3);
        if (EN_DN && IN(pb + 4)) {
            FRESH_PTRS;
            pg8::Gemm g{Hb, (const bf16*)(ws + WS_WDN) + (size_t)l * D * FF, M, D, FF}; pg8::StaticOrder S; S.init(MP, D, G, bx);
            pg8::EpiRes E{out, out + (size_t)MP * D, out, XB, ssp};
            pg8::gemm_phase_x<pg8::EpiRes, pg8::StaticOrder>(L, g, S, E);
        }
        SEAM(pb + 4);
    }
    if (EN_FIN && IN(21)) {
        FRESH_IDS; FRESH_PTRS;
        const float* gf = INP(8);
        for (int m = gw; m < M; m += NGW) {
            const float pv = (lane < ((m < MP) ? 16 : 32)) ? ssp[(size_t)m * 64 + lane] : 0.f;
            const float rinv = rsqrtf(wave_sum(pv) * (1.0f / 1024.0f) + 1e-6f);
            GAS f32x4* xr = (GAS f32x4*)(out + (size_t)m * D) + lane;
#pragma unroll
            for (int jx = 0; jx < 4; ++jx) { const f32x4 gv = *((const f32x4*)gf + 64 * jx + lane); f32x4 v = xr[64 * jx]; v = v * rinv * gv; xr[64 * jx] = v; }
        }
    }
#undef IN
#undef SEAM
}

#ifndef MK_SPLIT
#define MK_SPLIT 0
#endif
extern "C" void kernel_launch(void* const* d_in, const int* in_sizes, int n_in, void* d_out, int out_size, void* d_ws, size_t ws_size, hipStream_t stream) {
    static int grid = 0;
    if (grid == 0) {
        if (n_in != 23 || in_sizes[0] != MP * D || (size_t)out_size != O_END || ws_size < WS_END) { fprintf(stderr, "kernel_launch: unexpected shapes (n_in %d, in0 %d, out %d, ws %zu); nothing launched\n", n_in, n_in > 0 ? in_sizes[0] : -1, out_size, ws_size); grid = -1; return; }
        int dev = 0, cus = 0, per_cu = 0;
        if (hipGetDevice(&dev) != hipSuccess || hipDeviceGetAttribute(&cus, hipDeviceAttributeMultiprocessorCount, dev) != hipSuccess) { fprintf(stderr, "kernel_launch: device query failed\n"); grid = -1; return; }
        if (hipFuncSetAttribute((const void*)fwd_kernel, hipFuncAttributeMaxDynamicSharedMemorySize, LDS_BYTES) != hipSuccess) { fprintf(stderr, "kernel_launch: hipFuncSetAttribute failed\n"); grid = -1; return; }
        if (hipOccupancyMaxActiveBlocksPerMultiprocessor(&per_cu, (const void*)fwd_kernel, 512, LDS_BYTES) != hipSuccess || per_cu < 1) fprintf(stderr, "kernel_launch: note: occupancy query reports %d blocks per CU\n", per_cu);
        (void)hipGetLastError();
        grid = cus;
    }
    if (grid < 0) return;
    (void)hipMemsetAsync((char*)d_ws + WS_CTL, 0, CTL_ZERO_BYTES, stream);
    Args a{};
    for (int i = 0; i < 23; ++i) a.in[i] = (const float*)d_in[i];
    a.out = (float*)d_out; a.ws = (unsigned char*)d_ws;
#if MK_SPLIT
    for (int p = 0; p < NPHASE; ++p) { a.ph_lo = p; a.ph_hi = p + 1; hipLaunchKernelGGL(fwd_kernel, dim3(grid), dim3(512), LDS_BYTES, stream, a); }
#else
    a.ph_lo = 0; a.ph_hi = NPHASE; hipLaunchKernelGGL(fwd_kernel, dim3(grid), dim3(512), LDS_BYTES, stream, a);
#endif
}
```

```cpp
#include <hip/hip_runtime.h>
#include <cstdio>
#include <cstdint>
namespace pg8 {
#define PG8_LAS __attribute__((address_space(3)))
typedef unsigned short bf16_t;
typedef short bf16x8 __attribute__((ext_vector_type(8)));
typedef float f32x4 __attribute__((ext_vector_type(4)));
typedef unsigned u32x4 __attribute__((ext_vector_type(4)));
constexpr int BM = 256, BK = 64, HALF = 128, HTB = HALF * BK * 2  , STAGE_BYTES = 8 * HTB, NXCD = 8, WGM = 8;

__host__ __device__ __forceinline__ int lds_byte(int r, int c) { const int st = (r >> 4) * 2 + (c >> 5), rr = r & 15, cc = c & 31, ob = rr * 64 + cc * 2; return st * 1024 + (ob ^ (((ob >> 9) & 1) << 5)); }
__host__ __device__ __forceinline__ void stage_rc(int b, int& R, int& C) { const int st = b / 1024, sb = b % 1024, swz = sb ^ (((sb >> 9) & 1) << 5); R = (st >> 1) * 16 + swz / 64; C = (st & 1) * 32 + (swz % 64) / 2; }
__host__ __device__ __forceinline__ int perm32(int rho) { const int n = rho >> 4, i = rho & 15; return 8 * (i >> 2) + 4 * n + (i & 3); }

struct Unit { int pm, pn; };
struct Gemm { const bf16_t* A; const bf16_t* Bt; int M, N, K; };

struct StaticOrder {
    int nM, nN, nwg, G, c;
    __host__ __device__ void init(int M, int N, int G_, int c_) { nM = M / BM; nN = N / BM; nwg = nM * nN; G = G_; c = c_; }
    __host__ __device__ bool next(int i, Unit& u) const {
        const long L = (long)i * G + c; if (L >= nwg) return false;
        int wgid = (int)L; { const int q = nwg / NXCD, r = nwg % NXCD, xcd = wgid % NXCD, off = wgid / NXCD; wgid = (xcd < r ? xcd * (q + 1) : r * (q + 1) + (xcd - r) * q) + off; }
        const int nig = WGM * nN, gid = wgid / nig, fm = gid * WGM, gsz = (nM - fm) < WGM ? (nM - fm) : WGM;
        u.pm = fm + ((wgid % nig) % gsz); u.pn = (wgid % nig) / gsz; return true;
    }
    __device__ __forceinline__ void a_ready(const Unit&) const {}
    __device__ __forceinline__ void done(const Unit&) const {}
};
__device__ __forceinline__ unsigned cvt_pk_bf16(float lo, float hi) { unsigned r; asm volatile("v_cvt_pk_bf16_f32 %0, %1, %2" : "=v"(r) : "v"(lo), "v"(hi)); return r; }
typedef float f32x2 __attribute__((ext_vector_type(2)));
template <class Epi, class Sched, bool ALIGN_EPI = false, bool SP2 = false>
__device__ __forceinline__ void gemm_phase(PG8_LAS unsigned char* lds, const Gemm g, const Sched& S, const Epi& E) {
    int tid_ = threadIdx.x; asm volatile("" : "+v"(tid_));
    const int tid = tid_, wid = __builtin_amdgcn_readfirstlane(tid >> 6), lane = tid & 63, wr = wid >> 2, wc = wid & 3, fr = lane & 15, fq = lane >> 4;
    const int K = g.K, nt = K / BK;
    unsigned voffA[2], voffB[2];
#pragma unroll
    for (int i = 0; i < 2; ++i) { int R, C; stage_rc(tid * 16 + i * 8192, R, C); const int Rb = Epi::PERM ? ((R & ~31) + perm32(R & 31)) : R;
        voffA[i] = (unsigned)(R * K + C) * 2u; voffB[i] = (unsigned)(Rb * K + C) * 2u; }
    const size_t kstep = (size_t)(BK * 2);
    const size_t hstep = (size_t)HALF * K * 2;
    const size_t tstep = 2 * hstep;
    const unsigned ldsw = (unsigned)wid * 1024u;
    const int aoff = lds_byte(wr * 64 + fr, fq * 8), boff = lds_byte(wc * 32 + fr, fq * 8);
#define PG8_SA(b, h) (((b) * 2 + (h)) * HTB)
#define PG8_SB(b, h) ((4 + (b) * 2 + (h)) * HTB)
#define PG8_STAGE(bufoff, gbase, voff) do { _Pragma("unroll") for (int _i = 0; _i < 2; ++_i) \
        __builtin_amdgcn_global_load_lds((const unsigned*)((const char*)(gbase) + (voff)[_i]), (PG8_LAS unsigned*)(lds + (bufoff) + ldsw + _i * 8192), 16, 0, 0); } while (0)
#define PG8_LDA(dst, b, h) do { _Pragma("unroll") for (int m = 0; m < 4; ++m) _Pragma("unroll") for (int k = 0; k < 2; ++k) dst[m][k] = *(const PG8_LAS bf16x8*)(lds + PG8_SA(b, h) + aoff + m * 2048 + k * 1024); } while (0)
#define PG8_LDB(dst, b, h) do { _Pragma("unroll") for (int n = 0; n < 2; ++n) _Pragma("unroll") for (int k = 0; k < 2; ++k) dst[n][k] = *(const PG8_LAS bf16x8*)(lds + PG8_SB(b, h) + boff + n * 2048 + k * 1024); } while (0)
#define PG8_MMA(ai, bj, At, Bt) do { __builtin_amdgcn_s_setprio(1); _Pragma("unroll") for (int m = 0; m < 4; ++m) _Pragma("unroll") for (int n = 0; n < 2; ++n) _Pragma("unroll") for (int k = 0; k < 2; ++k) \
        acc[ai][bj][m][n] = __builtin_amdgcn_mfma_f32_16x16x32_bf16(Bt[n][k], At[m][k], acc[ai][bj][m][n], 0, 0, 0); __builtin_amdgcn_s_setprio(0); } while (0)
#define PG8_WAIT_V(n) asm volatile("s_waitcnt vmcnt(" #n ")" ::: "memory")
#define PG8_WAIT_L(n) asm volatile("s_waitcnt lgkmcnt(" #n ")" ::: "memory")
#define PG8_BAR __builtin_amdgcn_s_barrier()
#define PG8_SCHED __builtin_amdgcn_sched_barrier(0)
    Unit cur, nxt; int ui = 0;
    if (!S.next(0, cur)) return;
    f32x4 acc[2][2][4][2];
#pragma unroll
    for (int a = 0; a < 2; ++a)
#pragma unroll
        for (int b = 0; b < 2; ++b)
#pragma unroll
            for (int m = 0; m < 4; ++m)
#pragma unroll
                for (int n = 0; n < 2; ++n) acc[a][b][m][n] = (f32x4){0.f, 0.f, 0.f, 0.f};
    bf16x8 At[4][2], B0[2][2], B1[2][2];
    const char* cA = (const char*)g.A + (size_t)cur.pm * tstep; const char* cB = (const char*)g.Bt + (size_t)cur.pn * tstep;
    S.a_ready(cur);
    if constexpr (SP2) {
        PG8_STAGE(PG8_SB(0, 0), cB, voffB); PG8_STAGE(PG8_SB(0, 1), cB + hstep, voffB); PG8_STAGE(PG8_SA(0, 0), cA, voffA); PG8_STAGE(PG8_SA(0, 1), cA + hstep, voffA);
        if (wr == 1) PG8_BAR;
        PG8_WAIT_V(2); PG8_BAR;
        PG8_STAGE(PG8_SB(1, 0), cB + kstep, voffB); PG8_STAGE(PG8_SA(1, 0), cA + kstep, voffA); PG8_STAGE(PG8_SB(1, 1), cB + hstep + kstep, voffB);
        PG8_WAIT_V(6); PG8_BAR;
    } else {
        PG8_STAGE(PG8_SB(0, 0), cB, voffB); PG8_STAGE(PG8_SA(0, 0), cA, voffA); PG8_STAGE(PG8_SB(0, 1), cB + hstep, voffB); PG8_STAGE(PG8_SA(0, 1), cA + hstep, voffA);
        if (wr == 1) PG8_BAR;
        PG8_WAIT_V(4); PG8_BAR;
        PG8_STAGE(PG8_SB(1, 0), cB + kstep, voffB); PG8_STAGE(PG8_SA(1, 0), cA + kstep, voffA); PG8_STAGE(PG8_SB(1, 1), cB + hstep + kstep, voffB);
        PG8_WAIT_V(6); PG8_BAR;
    }
    for (;;) {
        const bool has_next = S.next(ui + 1, nxt);
        const char* nA = has_next ? (const char*)g.A + (size_t)nxt.pm * tstep : cA; const char* nB = has_next ? (const char*)g.Bt + (size_t)nxt.pn * tstep : cB;
        for (int t = 0; t < nt; t += 2) {
            const bool last = (t == nt - 2);
            const char* a1 = cA + (size_t)(t + 1) * kstep;
            const char* a2 = last ? nA : cA + (size_t)(t + 2) * kstep; const char* b2 = last ? nB : cB + (size_t)(t + 2) * kstep;
            const char* a3 = a2 + kstep; const char* b3 = b2 + kstep;
            if (last && has_next) S.a_ready(nxt);
            if constexpr (SP2) {
            PG8_LDB(B0, 0, 0); PG8_LDB(B1, 0, 1); PG8_SCHED; PG8_LDA(At, 0, 0); PG8_STAGE(PG8_SA(1, 1), a1 + hstep, voffA);
            PG8_WAIT_V(8); PG8_WAIT_L(0); PG8_BAR; PG8_MMA(0, 0, At, B0); PG8_MMA(0, 1, At, B1); PG8_BAR; PG8_SCHED;
            PG8_LDA(At, 0, 1); PG8_STAGE(PG8_SB(0, 0), b2, voffB); PG8_STAGE(PG8_SB(0, 1), b2 + hstep, voffB); PG8_STAGE(PG8_SA(0, 0), a2, voffA);
            PG8_WAIT_V(8); PG8_WAIT_L(0); PG8_BAR; PG8_MMA(1, 0, At, B0); PG8_MMA(1, 1, At, B1); PG8_BAR; PG8_SCHED;
            PG8_LDB(B0, 1, 0); PG8_LDB(B1, 1, 1); PG8_SCHED; PG8_LDA(At, 1, 0); PG8_STAGE(PG8_SA(0, 1), a2 + hstep, voffA);
            PG8_WAIT_V(8); PG8_WAIT_L(0); PG8_BAR; PG8_MMA(0, 0, At, B0); PG8_MMA(0, 1, At, B1); PG8_BAR; PG8_SCHED;
            PG8_LDA(At, 1, 1); PG8_STAGE(PG8_SB(1, 0), b3, voffB); PG8_STAGE(PG8_SB(1, 1), b3 + hstep, voffB); PG8_STAGE(PG8_SA(1, 0), a3, voffA);
            PG8_WAIT_V(8); PG8_WAIT_L(0); PG8_BAR; PG8_MMA(1, 0, At, B0); PG8_MMA(1, 1, At, B1); PG8_BAR; PG8_SCHED;
            } else {
            PG8_LDB(B0, 0, 0); PG8_SCHED; PG8_LDA(At, 0, 0); PG8_STAGE(PG8_SA(1, 1), a1 + hstep, voffA);
            PG8_WAIT_L(8); PG8_BAR; PG8_WAIT_L(0); PG8_MMA(0, 0, At, B0); PG8_BAR; PG8_SCHED;
            PG8_LDB(B1, 0, 1); PG8_STAGE(PG8_SB(0, 0), b2, voffB);
            PG8_BAR; PG8_WAIT_L(0); PG8_MMA(0, 1, At, B1); PG8_BAR;
            PG8_LDA(At, 0, 1); PG8_STAGE(PG8_SA(0, 0), a2, voffA);
            PG8_BAR; PG8_WAIT_L(0); PG8_MMA(1, 0, At, B0); PG8_BAR; PG8_SCHED;
            PG8_STAGE(PG8_SB(0, 1), b2 + hstep, voffB);
            PG8_WAIT_V(6); PG8_BAR; PG8_MMA(1, 1, At, B1); PG8_BAR;
            PG8_LDB(B0, 1, 0); PG8_SCHED; PG8_LDA(At, 1, 0); PG8_STAGE(PG8_SA(0, 1), a2 + hstep, voffA);
            PG8_WAIT_L(8); PG8_BAR; PG8_WAIT_L(0); PG8_MMA(0, 0, At, B0); PG8_BAR; PG8_SCHED;
            PG8_LDB(B1, 1, 1); PG8_STAGE(PG8_SB(1, 0), b3, voffB);
            PG8_BAR; PG8_WAIT_L(0); PG8_MMA(0, 1, At, B1); PG8_BAR;
            PG8_LDA(At, 1, 1); PG8_STAGE(PG8_SA(1, 0), a3, voffA);
            PG8_BAR; PG8_WAIT_L(0); PG8_MMA(1, 0, At, B0); PG8_BAR; PG8_SCHED;
            PG8_STAGE(PG8_SB(1, 1), b3 + hstep, voffB);
            PG8_WAIT_V(6); PG8_BAR; PG8_MMA(1, 1, At, B1); PG8_BAR;
            }
        }
        if constexpr (ALIGN_EPI) { if (wr == 0) PG8_BAR; }
        if constexpr (!Epi::AFTER_DRAIN) { E(acc, cur, wr, wc, fr, fq); S.done(cur); }
        if (!has_next) break;
#pragma unroll
        for (int a = 0; a < 2; ++a)
#pragma unroll
            for (int b = 0; b < 2; ++b)
#pragma unroll
                for (int m = 0; m < 4; ++m)
#pragma unroll
                    for (int n = 0; n < 2; ++n) acc[a][b][m][n] = (f32x4){0.f, 0.f, 0.f, 0.f};
        cur = nxt; cA = nA; cB = nB; ++ui;
        if constexpr (ALIGN_EPI) { if (wr == 1) PG8_BAR; }
    }
    PG8_WAIT_V(0);
    if constexpr (!ALIGN_EPI) { if (wr == 0) PG8_BAR; }
    PG8_BAR;
    if constexpr (Epi::AFTER_DRAIN) { E.fused(acc, cur, wr, wc, fr, fq, lds, wid, lane); S.done(cur); }
#undef PG8_SA
#undef PG8_SB
#undef PG8_STAGE
#undef PG8_LDA
#undef PG8_LDB
#undef PG8_MMA
#undef PG8_WAIT_V
#undef PG8_WAIT_L
#undef PG8_BAR
#undef PG8_SCHED
}
}
#define GAS __attribute__((address_space(1)))
#define LAS __attribute__((address_space(3)))
typedef unsigned short bf16;
typedef unsigned v4u __attribute__((ext_vector_type(4)));
typedef float f32x4 __attribute__((ext_vector_type(4)));
typedef short bf16x8 __attribute__((ext_vector_type(8)));
typedef GAS unsigned gu32;
typedef GAS unsigned long long gu64;
#define RLX_AGENT __ATOMIC_RELAXED, __HIP_MEMORY_SCOPE_AGENT
#define LDS_WAIT() asm volatile("s_waitcnt lgkmcnt(0)" ::: "memory")
#define VM_WAIT() asm volatile("s_waitcnt vmcnt(0)" ::: "memory")
__device__ __forceinline__ unsigned long long rt() { return __builtin_amdgcn_s_memrealtime(); }
__device__ __forceinline__ unsigned f2bf(float f) { unsigned u = __builtin_bit_cast(unsigned, f); return (u + 0x7fffu + ((u >> 16) & 1u)) >> 16; }
__device__ __forceinline__ unsigned pk2(float lo, float hi) { return f2bf(lo) | (f2bf(hi) << 16); }
#define XB_TMO      128
#define XB_XCNT(j)  (256  + 64 * (j))
#define XB_XSUB(j)  (1280 + 64 * (j))
#define XB_XGEN(j)  (2304 + 64 * (j))
#define XB_TOP      3328
#define XB_TOPGEN   3392
#define XCD_BAR_WORDS 3456
#define XB_SPIN_CAP (1u << 18)

__device__ __forceinline__ unsigned xb_ld(unsigned* p)              { return __hip_atomic_load(p, __ATOMIC_RELAXED, __HIP_MEMORY_SCOPE_AGENT); }
__device__ __forceinline__ unsigned xb_add(unsigned* p, unsigned v) { return __hip_atomic_fetch_add(p, v, __ATOMIC_RELAXED, __HIP_MEMORY_SCOPE_AGENT); }
__device__ __forceinline__ unsigned xb_xcc_id() { return (unsigned)__builtin_amdgcn_s_getreg((3 << 11) | 20) & 0xFu; }
#define XB_SPIN(cond, bar) do { unsigned _sp = 0; while (cond) { __builtin_amdgcn_s_sleep(1); \
    if ((++_sp & 255u) == 0u) { if (xb_ld(&(bar)[XB_TMO])) break; if (_sp > XB_SPIN_CAP) { atomicAdd(&(bar)[XB_TMO], 1u); break; } } } } while (0)

struct XcdBarrier {
    unsigned* bar; unsigned x;
    volatile LAS unsigned* st;
};

__device__ __forceinline__ XcdBarrier xcd_barrier_post(unsigned* bar, volatile LAS unsigned* st) {
    XcdBarrier b; b.bar = bar; b.x = xb_xcc_id(); b.st = st;
    if (threadIdx.x == 0) (void)xb_add(&bar[XB_XCNT(b.x)], 1u);
    return b;
}
__device__ __forceinline__ void xcd_barrier_complete(unsigned* bar, unsigned x, unsigned& nloc, unsigned& nx) {
    const unsigned G = gridDim.x * gridDim.y * gridDim.z;
    unsigned sum, cnt, mine, sp = 0u;
    for (;;) {
        sum = 0u; cnt = 0u; mine = 0u;
#pragma unroll
        for (unsigned j = 0; j < 16; ++j) { const unsigned c = xb_ld(&bar[XB_XCNT(j)]); sum += c; cnt += (c > 0u) ? 1u : 0u; mine = (j == x) ? c : mine; }
        if (sum == G) break;
        __builtin_amdgcn_s_sleep(1);
        if ((++sp & 255u) == 0u) { if (xb_ld(&bar[XB_TMO])) break; if (sp > XB_SPIN_CAP) { atomicAdd(&bar[XB_TMO], 1u); break; } }
    }
    nloc = mine > 0u ? mine : 1u; nx = cnt > 0u ? cnt : 1u;
}

__device__ __forceinline__ void xcd_barrier(const XcdBarrier& b) {
    asm volatile("s_waitcnt vmcnt(0)" ::: "memory");
    __syncthreads();
    if (threadIdx.x == 0) {
        unsigned* bar = b.bar;
        __builtin_amdgcn_s_waitcnt(0);
        unsigned nloc = b.st[0], nx = b.st[1];
        if (nloc == 0u) { xcd_barrier_complete(bar, b.x, nloc, nx); b.st[0] = nloc; b.st[1] = nx; }
        const unsigned old = xb_add(&bar[XB_XSUB(b.x)], 1u);
        const unsigned gen = old / nloc;
        if (old + 1u == (gen + 1u) * nloc) {
            __builtin_amdgcn_fence(__ATOMIC_RELEASE, "agent");
            asm volatile("s_waitcnt vmcnt(0)" ::: "memory");
            const unsigned og = xb_add(&bar[XB_TOP], 1u);
            const unsigned tg = og / nx;
            if (og + 1u == (tg + 1u) * nx) xb_add(&bar[XB_TOPGEN], 1u);
            else XB_SPIN(xb_ld(&bar[XB_TOPGEN]) == tg, bar);
            __builtin_amdgcn_fence(__ATOMIC_ACQUIRE, "agent");
            xb_add(&bar[XB_XGEN(b.x)], 1u);
            asm volatile("s_waitcnt vmcnt(0)" ::: "memory");
        } else {
            XB_SPIN(xb_ld(&bar[XB_XGEN(b.x)]) == gen, bar);
            __builtin_amdgcn_fence(__ATOMIC_ACQUIRE, "agent");
            asm volatile("s_waitcnt vmcnt(0)" ::: "memory");
        }
    }
    __syncthreads();
}

constexpr int D = 1024, SEQ = 8192, NB = 2, MP = NB * SEQ, SB = 128, ST = 8, MS = SB * ST, M = MP + MS;
constexpr int NQKV = 1536, FF = 4096, NKV = 4, HD = 64, KVW = NKV * HD, NG = 64, GC = 16, NS = 64;
constexpr int CH = 256, NCH = SEQ / CH;
constexpr int NPHASE = 22;
constexpr size_t O_KP = 17825792, O_VP = 17956864, O_HRP = 18087936, O_HIP = 18104320, O_KS = 18120704, O_VS = 26509312, O_HRS = 34897920, O_HIS = 35946496, O_END = 36995072;
constexpr size_t MiB = 1u << 20;
constexpr size_t WS_CTL = 0, CTL_ZERO_BYTES = 64 * 1024;
constexpr size_t WS_SSP = 1 * MiB;
constexpr size_t WS_TAB = 5 * MiB + 512 * 1024;
constexpr size_t WS_HS = 6 * MiB;
constexpr size_t WS_WQKV = 8 * MiB, WS_WO = 14 * MiB, WS_WGLU = 18 * MiB, WS_WUP = 26 * MiB, WS_WDN = 58 * MiB;
constexpr size_t WS_XB = 90 * MiB;
constexpr size_t WS_H = 124 * MiB;
constexpr size_t WS_Q = 124 * MiB, WS_K = 158 * MiB, WS_V = 167 * MiB, WS_O = 176 * MiB;
constexpr size_t WS_BT = 260 * MiB, WS_CT = 261 * MiB;
constexpr size_t WS_END = 262 * MiB;
constexpr int CW_BAR = 4096;
static_assert((CW_BAR + XCD_BAR_WORDS) * 4 <= (int)CTL_ZERO_BYTES, "barrier words inside the memset region");
constexpr int RING_BYTES = 131072, XA_BYTES = 4096, LDSCTL_OFF = RING_BYTES + XA_BYTES, MISC_OFF = LDSCTL_OFF + 320, LDS_BYTES = 147456;

__device__ __forceinline__ float wave_sum(float v) {
#pragma unroll
    for (int o = 1; o < 64; o <<= 1) v += __shfl_xor(v, o);
    return v;
}
__device__ __forceinline__ float wave_max(float v) {
#pragma unroll
    for (int o = 1; o < 64; o <<= 1) v = fmaxf(v, __shfl_xor(v, o));
    return v;
}
__device__ __forceinline__ float bf_lo(unsigned u) { return __uint_as_float(u << 16); }
__device__ __forceinline__ float bf_hi(unsigned u) { return __uint_as_float(u & 0xffff0000u); }

namespace pg8 {
constexpr int XMP = 16384;
__device__ __forceinline__ float row_rinv(const float* ssp, int row, int np, int fq) {
    const float* p = ssp + (size_t)row * 64 + (np >> 2) * fq; float s = 0.f;
    for (int i = 0; i < (np >> 4); ++i) { const f32x4 v = *(const f32x4*)(p + 4 * i); s += (v[0] + v[1]) + (v[2] + v[3]); }
    s += __shfl_xor(s, 16); s += __shfl_xor(s, 32);
    return rsqrtf(s * (1.0f / 1024.0f) + 1e-6f);
}
__device__ __forceinline__ u32x4 pack8(const f32x4 a, const f32x4 b) { u32x4 w; w.x = cvt_pk_bf16(a[0], a[1]); w.y = cvt_pk_bf16(a[2], a[3]); w.z = cvt_pk_bf16(b[0], b[1]); w.w = cvt_pk_bf16(b[2], b[3]); return w; }
typedef unsigned u32x2 __attribute__((ext_vector_type(2)));
__device__ __forceinline__ u32x2 pack4(const f32x4 a) { u32x2 w; w.x = cvt_pk_bf16(a[0], a[1]); w.y = cvt_pk_bf16(a[2], a[3]); return w; }
__device__ __forceinline__ float sumsq4(const f32x4 v) { return (v[0] * v[0] + v[1] * v[1]) + (v[2] * v[2] + v[3] * v[3]); }

struct EpiQKV {
    static constexpr bool PERM = true, AFTER_DRAIN = false;
    bf16_t *Q, *K, *V; const float* ssp; int np, nps; float *kp, *vp, *ks, *vs;
    __device__ __forceinline__ void operator()(const f32x4 (&acc)[2][2][4][2], const f32x4 (&accx)[2], const Unit& u, int wr, int wc, int fr, int fq) const {
        const int rowb = u.pm * BM + wr * 64 + fr, pn = u.pn;
#pragma unroll
        for (int ai = 0; ai < 2; ++ai)
#pragma unroll
            for (int m = 0; m < 4; ++m) {
                const int row = rowb + ai * HALF + m * 16;
                const float r = row_rinv(ssp, row, np, fq);
#pragma unroll
                for (int bj = 0; bj < 2; ++bj) {
                    const f32x4 v0 = acc[ai][bj][m][0] * r, v1 = acc[ai][bj][m][1] * r;
                    const int cl = bj * HALF + wc * 32 + 8 * fq;
                    const u32x4 w = pack8(v0, v1);
                    if (pn < 4) { *(u32x4*)(Q + (size_t)row * 1024 + pn * 256 + cl) = w; }
                    else {
                        bf16_t* B = (pn == 4) ? K : V;
                        *(u32x4*)(B + (size_t)row * 256 + cl) = w;
                        const int t = row & 8191;
                        if (t >= 8064) { float* o = ((pn == 4) ? kp : vp) + ((size_t)(row >> 13) * 128 + (t - 8064)) * 256 + cl; *(f32x4*)o = v0; *(f32x4*)(o + 4) = v1; }
                    }
                }
            }
        {
            const int xrow = u.pm * 16 + fr, row = XMP + xrow;
            const float r = row_rinv(ssp, row, nps, fq);
#pragma unroll
            for (int bj = 0; bj < 2; ++bj) {
                const f32x4 v = accx[bj] * r;
                const int cl = bj * HALF + wc * 32 + 8 * fq + 4 * wr;
                const u32x2 w = pack4(v);
                if (pn < 4) { *(u32x2*)(Q + (size_t)row * 1024 + pn * 256 + cl) = w; }
                else {
                    bf16_t* B = (pn == 4) ? K : V;
                    *(u32x2*)(B + (size_t)row * 256 + cl) = w;
                    float* o = ((pn == 4) ? ks : vs) + ((size_t)(xrow >> 3) * 128 + 120 + (xrow & 7)) * 256 + cl; *(f32x4*)o = v;
                }
            }
        }
    }
};
struct EpiRes {
    static constexpr bool PERM = true, AFTER_DRAIN = false;
    const float* xp; const float* xs; float* XR; bf16_t* XB; float* ssp;
    __device__ __forceinline__ void operator()(const f32x4 (&acc)[2][2][4][2], const f32x4 (&accx)[2], const Unit& u, int wr, int wc, int fr, int fq) const {
        const int rowb = u.pm * BM + wr * 64 + fr, pn = u.pn;
#pragma unroll
        for (int ai = 0; ai < 2; ++ai)
#pragma unroll
            for (int m = 0; m < 4; ++m) {
                const int row = rowb + ai * HALF + m * 16;
                const float* old = xp + (size_t)row * 1024;
                float ss = 0.f;
#pragma unroll
                for (int bj = 0; bj < 2; ++bj) {
                    const int col = pn * 256 + bj * HALF + wc * 32 + 8 * fq;
                    const f32x4 o0 = *(const f32x4*)(old + col), o1 = *(const f32x4*)(old + col + 4);
                    const f32x4 v0 = acc[ai][bj][m][0] + o0, v1 = acc[ai][bj][m][1] + o1;
                    *(f32x4*)(XR + (size_t)row * 1024 + col) = v0; *(f32x4*)(XR + (size_t)row * 1024 + col + 4) = v1;
                    *(u32x4*)(XB + (size_t)row * 1024 + col) = pack8(v0, v1);
                    ss += sumsq4(v0) + sumsq4(v1);
                }
                ss += __shfl_xor(ss, 16); ss += __shfl_xor(ss, 32);
                if (fq == 0) ssp[(size_t)row * 64 + pn * 4 + wc] = ss;
                asm volatile("" ::: "memory");
            }
        {
            const int xrow = u.pm * 16 + fr, row = XMP + xrow;
            const float* old = xs + (size_t)xrow * 1024;
            float ss = 0.f;
#pragma unroll
            for (int bj = 0; bj < 2; ++bj) {
                const int col = pn * 256 + bj * HALF + wc * 32 + 8 * fq + 4 * wr;
                const f32x4 v = accx[bj] + *(const f32x4*)(old + col);
                *(f32x4*)(XR + (size_t)row * 1024 + col) = v;
                *(u32x2*)(XB + (size_t)row * 1024 + col) = pack4(v);
                ss += sumsq4(v);
            }
            ss += __shfl_xor(ss, 16); ss += __shfl_xor(ss, 32);
            if (fq == 0) ssp[(size_t)row * 64 + (pn * 4 + wc) * 2 + wr] = ss;
        }
    }
};
struct EpiGlu {
    static constexpr bool PERM = true, AFTER_DRAIN = false;
    float* XR; bf16_t* XB; float* ssp;
    __device__ __forceinline__ void operator()(const f32x4 (&acc)[2][2][4][2], const f32x4 (&accx)[2], const Unit& u, int wr, int wc, int fr, int fq) const {
        const int rowb = u.pm * BM + wr * 64 + fr, pn = u.pn;
#pragma unroll
        for (int ai = 0; ai < 2; ++ai)
#pragma unroll
            for (int m = 0; m < 4; ++m) {
                const int row = rowb + ai * HALF + m * 16;
                const int col = pn * 128 + wc * 32 + 8 * fq;
                float* xr = XR + (size_t)row * 1024 + col;
                const f32x4 o0 = *(const f32x4*)xr, o1 = *(const f32x4*)(xr + 4);
                f32x4 v0, v1;
#pragma unroll
                for (int e = 0; e < 4; ++e) {
                    v0[e] = o0[e] + acc[ai][0][m][0][e] * (1.0f / (1.0f + __expf(-acc[ai][1][m][0][e])));
                    v1[e] = o1[e] + acc[ai][0][m][1][e] * (1.0f / (1.0f + __expf(-acc[ai][1][m][1][e])));
                }
                *(f32x4*)xr = v0; *(f32x4*)(xr + 4) = v1;
                *(u32x4*)(XB + (size_t)row * 1024 + col) = pack8(v0, v1);
                float ss = sumsq4(v0) + sumsq4(v1);
                ss += __shfl_xor(ss, 16); ss += __shfl_xor(ss, 32);
                if (fq == 0) ssp[(size_t)row * 64 + pn * 4 + wc] = ss;
                asm volatile("" ::: "memory");
            }
        {
            const int xrow = u.pm * 16 + fr, row = XMP + xrow;
            const int col = pn * 128 + wc * 32 + 8 * fq + 4 * wr;
            float* xr = XR + (size_t)row * 1024 + col;
            const f32x4 o0 = *(const f32x4*)xr;
            f32x4 v;
#pragma unroll
            for (int e = 0; e < 4; ++e) v[e] = o0[e] + accx[0][e] * (1.0f / (1.0f + __expf(-accx[1][e])));
            *(f32x4*)xr = v;
            *(u32x2*)(XB + (size_t)row * 1024 + col) = pack4(v);
            float ss = sumsq4(v);
            ss += __shfl_xor(ss, 16); ss += __shfl_xor(ss, 32);
            if (fq == 0) ssp[(size_t)row * 64 + (pn * 4 + wc) * 2 + wr] = ss;
        }
    }
};
struct EpiUp {
    static constexpr bool PERM = true, AFTER_DRAIN = false;
    bf16_t* H; const float* ssp; int np, nps;
    __device__ __forceinline__ void operator()(const f32x4 (&acc)[2][2][4][2], const f32x4 (&accx)[2], const Unit& u, int wr, int wc, int fr, int fq) const {
        const int rowb = u.pm * BM + wr * 64 + fr, pn = u.pn;
#pragma unroll
        for (int ai = 0; ai < 2; ++ai)
#pragma unroll
            for (int m = 0; m < 4; ++m) {
                const int row = rowb + ai * HALF + m * 16;
                const float r = row_rinv(ssp, row, np, fq);
#pragma unroll
                for (int bj = 0; bj < 2; ++bj) {
                    f32x4 v0 = acc[ai][bj][m][0] * r, v1 = acc[ai][bj][m][1] * r;
#pragma unroll
                    for (int e = 0; e < 4; ++e) { const float a = fmaxf(v0[e], 0.f), b = fmaxf(v1[e], 0.f); v0[e] = a * a; v1[e] = b * b; }
                    *(u32x4*)(H + (size_t)row * 4096 + pn * 256 + bj * HALF + wc * 32 + 8 * fq) = pack8(v0, v1);
                }
            }
        {
            const int xrow = u.pm * 16 + fr, row = XMP + xrow;
            const float r = row_rinv(ssp, row, nps, fq);
#pragma unroll
            for (int bj = 0; bj < 2; ++bj) {
                f32x4 v = accx[bj] * r;
#pragma unroll
                for (int e = 0; e < 4; ++e) { const float a = fmaxf(v[e], 0.f); v[e] = a * a; }
                *(u32x2*)(H + (size_t)row * 4096 + pn * 256 + bj * HALF + wc * 32 + 8 * fq + 4 * wr) = pack4(v);
            }
        }
    }
};

template <class Epi, class Sched>
__device__ __forceinline__ void gemm_phase_x(PG8_LAS unsigned char* lds, const Gemm g, const Sched& S, const Epi& E) {
    int tid_ = threadIdx.x; asm volatile("" : "+v"(tid_));
    const int tid = tid_, wid = __builtin_amdgcn_readfirstlane(tid >> 6), lane = tid & 63, wr = wid >> 2, wc = wid & 3, fr = lane & 15, fq = lane >> 4;
    const int K = g.K, nt = K / BK;
    unsigned voffA[2], voffB[2], voffX;
#pragma unroll
    for (int i = 0; i < 2; ++i) { int R, C; stage_rc(tid * 16 + i * 8192, R, C); const int Rb = Epi::PERM ? ((R & ~31) + perm32(R & 31)) : R;
        voffA[i] = (unsigned)(R * K + C) * 2u; voffB[i] = (unsigned)(Rb * K + C) * 2u; }
    { int R, C; const int p = wid * 256 + lane * 4; stage_rc(p & ~15, R, C); voffX = (unsigned)(R * K + C) * 2u + (unsigned)(p & 15); }
    const size_t kstep = (size_t)(BK * 2);
    const size_t hstep = (size_t)HALF * K * 2;
    const size_t tstep = 2 * hstep;
    const size_t xstep = (size_t)16 * K * 2;
    const unsigned ldsw = (unsigned)wid * 1024u, ldsx = (unsigned)wid * 256u;
    const int aoff = lds_byte(wr * 64 + fr, fq * 8), boff = lds_byte(wc * 32 + fr, fq * 8), xoff = lds_byte(fr, fq * 8);
#define PG8_SA(b, h) (((b) * 2 + (h)) * HTB)
#define PG8_SB(b, h) ((4 + (b) * 2 + (h)) * HTB)
#define PG8_XA(b) (STAGE_BYTES + (b) * 2048)
#define PG8_STAGE(bufoff, gbase, voff) do { _Pragma("unroll") for (int _i = 0; _i < 2; ++_i) \
        __builtin_amdgcn_global_load_lds((const unsigned*)((const char*)(gbase) + (voff)[_i]), (PG8_LAS unsigned*)(lds + (bufoff) + ldsw + _i * 8192), 16, 0, 0); } while (0)
#define PG8_STAGEX(b, gbase) __builtin_amdgcn_global_load_lds((const unsigned*)((const char*)(gbase) + voffX), (PG8_LAS unsigned*)(lds + PG8_XA(b) + ldsx), 4, 0, 0)
#define PG8_LDA(dst, b, h) do { _Pragma("unroll") for (int m = 0; m < 4; ++m) _Pragma("unroll") for (int k = 0; k < 2; ++k) dst[m][k] = *(const PG8_LAS bf16x8*)(lds + PG8_SA(b, h) + aoff + m * 2048 + k * 1024); } while (0)
#define PG8_LDB(dst, b, h) do { _Pragma("unroll") for (int n = 0; n < 2; ++n) _Pragma("unroll") for (int k = 0; k < 2; ++k) dst[n][k] = *(const PG8_LAS bf16x8*)(lds + PG8_SB(b, h) + boff + n * 2048 + k * 1024); } while (0)
#define PG8_LDX(dst, b) do { _Pragma("unroll") for (int k = 0; k < 2; ++k) dst[k] = *(const PG8_LAS bf16x8*)(lds + PG8_XA(b) + xoff + k * 1024); } while (0)
#define PG8_MMA(ai, bj, At, Bt) do { __builtin_amdgcn_s_setprio(1); _Pragma("unroll") for (int m = 0; m < 4; ++m) _Pragma("unroll") for (int n = 0; n < 2; ++n) _Pragma("unroll") for (int k = 0; k < 2; ++k) \
        acc[ai][bj][m][n] = __builtin_amdgcn_mfma_f32_16x16x32_bf16(Bt[n][k], At[m][k], acc[ai][bj][m][n], 0, 0, 0); __builtin_amdgcn_s_setprio(0); } while (0)
#define PG8_XMMA() do { if (wr == 0) { _Pragma("unroll") for (int k = 0; k < 2; ++k) { accx[0] = __builtin_amdgcn_mfma_f32_16x16x32_bf16(B0[0][k], Ax[k], accx[0], 0, 0, 0); accx[1] = __builtin_amdgcn_mfma_f32_16x16x32_bf16(B1[0][k], Ax[k], accx[1], 0, 0, 0); } } \
        else { _Pragma("unroll") for (int k = 0; k < 2; ++k) { accx[0] = __builtin_amdgcn_mfma_f32_16x16x32_bf16(B0[1][k], Ax[k], accx[0], 0, 0, 0); accx[1] = __builtin_amdgcn_mfma_f32_16x16x32_bf16(B1[1][k], Ax[k], accx[1], 0, 0, 0); } } } while (0)
#define PG8_WAIT_V(n) asm volatile("s_waitcnt vmcnt(" #n ")" ::: "memory")
#define PG8_WAIT_L(n) asm volatile("s_waitcnt lgkmcnt(" #n ")" ::: "memory")
#define PG8_BAR __builtin_amdgcn_s_barrier()
#define PG8_SCHED __builtin_amdgcn_sched_barrier(0)
    Unit cur, nxt; int ui = 0;
    if (!S.next(0, cur)) return;
    f32x4 acc[2][2][4][2]; f32x4 accx[2];
#pragma unroll
    for (int a = 0; a < 2; ++a)
#pragma unroll
        for (int b = 0; b < 2; ++b)
#pragma unroll
            for (int m = 0; m < 4; ++m)
#pragma unroll
                for (int n = 0; n < 2; ++n) acc[a][b][m][n] = (f32x4){0.f, 0.f, 0.f, 0.f};
    accx[0] = (f32x4){0.f, 0.f, 0.f, 0.f}; accx[1] = (f32x4){0.f, 0.f, 0.f, 0.f};
    bf16x8 At[4][2], B0[2][2], B1[2][2], Ax[2];
    const char* const xbase = (const char*)g.A + (size_t)XMP * K * 2;
    const char* cA = (const char*)g.A + (size_t)cur.pm * tstep; const char* cB = (const char*)g.Bt + (size_t)cur.pn * tstep; const char* cX = xbase + (size_t)cur.pm * xstep;
    S.a_ready(cur);
    PG8_STAGE(PG8_SB(0, 0), cB, voffB); PG8_STAGE(PG8_SB(0, 1), cB + hstep, voffB); PG8_STAGE(PG8_SA(0, 0), cA, voffA); PG8_STAGEX(0, cX); PG8_STAGE(PG8_SA(0, 1), cA + hstep, voffA);
    if (wr == 1) PG8_BAR;
    PG8_WAIT_V(2); PG8_BAR;
    PG8_STAGE(PG8_SB(1, 0), cB + kstep, voffB); PG8_STAGE(PG8_SA(1, 0), cA + kstep, voffA); PG8_STAGE(PG8_SB(1, 1), cB + hstep + kstep, voffB); PG8_STAGEX(1, cX + kstep);
    PG8_WAIT_V(7); PG8_BAR;
    for (;;) {
        const bool has_next = S.next(ui + 1, nxt);
        const char* nA = has_next ? (const char*)g.A + (size_t)nxt.pm * tstep : cA; const char* nB = has_next ? (const char*)g.Bt + (size_t)nxt.pn * tstep : cB; const char* nX = has_next ? xbase + (size_t)nxt.pm * xstep : cX;
        for (int t = 0; t < nt; t += 2) {
            const bool last = (t == nt - 2);
            const char* a1 = cA + (size_t)(t + 1) * kstep;
            const char* a2 = last ? nA : cA + (size_t)(t + 2) * kstep; const char* b2 = last ? nB : cB + (size_t)(t + 2) * kstep; const char* x2 = last ? nX : cX + (size_t)(t + 2) * kstep;
            const char* a3 = a2 + kstep; const char* b3 = b2 + kstep; const char* x3 = x2 + kstep;
            if (last && has_next) S.a_ready(nxt);
            PG8_LDB(B0, 0, 0); PG8_LDB(B1, 0, 1); PG8_SCHED; PG8_LDA(At, 0, 0); PG8_LDX(Ax, 0); PG8_STAGE(PG8_SA(1, 1), a1 + hstep, voffA);
            PG8_WAIT_V(9); PG8_WAIT_L(0); PG8_BAR; PG8_MMA(0, 0, At, B0); PG8_MMA(0, 1, At, B1); PG8_XMMA(); PG8_BAR; PG8_SCHED;
            PG8_LDA(At, 0, 1); PG8_STAGE(PG8_SB(0, 0), b2, voffB); PG8_STAGE(PG8_SB(0, 1), b2 + hstep, voffB); PG8_STAGE(PG8_SA(0, 0), a2, voffA); PG8_STAGEX(0, x2);
            PG8_WAIT_V(9); PG8_WAIT_L(0); PG8_BAR; PG8_MMA(1, 0, At, B0); PG8_MMA(1, 1, At, B1); PG8_BAR; PG8_SCHED;
            PG8_LDB(B0, 1, 0); PG8_LDB(B1, 1, 1); PG8_SCHED; PG8_LDA(At, 1, 0); PG8_LDX(Ax, 1); PG8_STAGE(PG8_SA(0, 1), a2 + hstep, voffA);
            PG8_WAIT_V(9); PG8_WAIT_L(0); PG8_BAR; PG8_MMA(0, 0, At, B0); PG8_MMA(0, 1, At, B1); PG8_XMMA(); PG8_BAR; PG8_SCHED;
            PG8_LDA(At, 1, 1); PG8_STAGE(PG8_SB(1, 0), b3, voffB); PG8_STAGE(PG8_SB(1, 1), b3 + hstep, voffB); PG8_STAGE(PG8_SA(1, 0), a3, voffA); PG8_STAGEX(1, x3);
            PG8_WAIT_V(9); PG8_WAIT_L(0); PG8_BAR; PG8_MMA(1, 0, At, B0); PG8_MMA(1, 1, At, B1); PG8_BAR; PG8_SCHED;
        }
        if (wr == 0) PG8_BAR;
        { int fr_ = fr, fq_ = fq; asm volatile("" : "+v"(fr_), "+v"(fq_));
          E(acc, accx, cur, wr, wc, fr_, fq_); } S.done(cur);
        if (!has_next) break;
#pragma unroll
        for (int a = 0; a < 2; ++a)
#pragma unroll
            for (int b = 0; b < 2; ++b)
#pragma unroll
                for (int m = 0; m < 4; ++m)
#pragma unroll
                    for (int n = 0; n < 2; ++n) acc[a][b][m][n] = (f32x4){0.f, 0.f, 0.f, 0.f};
        accx[0] = (f32x4){0.f, 0.f, 0.f, 0.f}; accx[1] = (f32x4){0.f, 0.f, 0.f, 0.f};
        cur = nxt; cA = nA; cB = nB; cX = nX; ++ui;
        if (wr == 1) PG8_BAR;
    }
    PG8_WAIT_V(0);
    PG8_BAR;
#undef PG8_SA
#undef PG8_SB
#undef PG8_XA
#undef PG8_STAGE
#undef PG8_STAGEX
#undef PG8_LDA
#undef PG8_LDB
#undef PG8_LDX
#undef PG8_MMA
#undef PG8_XMMA
#undef PG8_WAIT_V
#undef PG8_WAIT_L
#undef PG8_BAR
#undef PG8_SCHED
}
}

__device__ __forceinline__ void p0_transpose_item(const float* W, int K, int N, const float* gain, bf16* WT, int glu, LAS float* scr, int item, int lane) {
    const int nblk = N / 32, kb = item / nblk, nb = item % nblk, k0 = 64 * kb, n0 = 32 * nb;
#pragma unroll 8
    for (int i = 0; i < 32; ++i) { const int kk = 2 * i + (lane >> 5); float w = W[(size_t)(k0 + kk) * N + n0 + (lane & 31)]; if (gain) w *= gain[k0 + kk]; scr[kk * 33 + (lane & 31)] = w; }
    LDS_WAIT(); asm volatile("" ::: "memory");
    int drow0 = n0; if (glu) { const int bj = n0 / 1024, rem = n0 % 1024; drow0 = (rem / 128) * 256 + bj * 128 + (rem % 128); }
    const int c = lane & 7;
#pragma unroll
    for (int j = 0; j < 4; ++j) { const int n = (lane >> 3) + 8 * j; const LAS float* s = scr + (8 * c) * 33 + n;
        v4u o; o.x = pk2(s[0 * 33], s[1 * 33]); o.y = pk2(s[2 * 33], s[3 * 33]); o.z = pk2(s[4 * 33], s[5 * 33]); o.w = pk2(s[6 * 33], s[7 * 33]);
        *(GAS v4u*)(WT + (size_t)(drow0 + n) * K + k0 + 8 * c) = o; }
    LDS_WAIT(); asm volatile("" ::: "memory");
}

__device__ __forceinline__ void sincos_rr(float x, float& s, float& c) {
    const float q = rintf(x * 0.63661977236758f);
    float r = fmaf(-q, 1.57079637050629f, x); r = fmaf(-q, -4.37113882867379e-8f, r);
    const float r2 = r * r;
    const float sp = r + r * r2 * (-1.6666667163e-1f + r2 * (8.3333337680e-3f + r2 * (-1.9841270114e-4f + r2 * 2.7557314297e-6f)));
    const float cp = 1.0f + r2 * (-0.5f + r2 * (4.1666667908e-2f + r2 * (-1.3888889225e-3f + r2 * (2.4801587642e-5f + r2 * -2.7557314297e-7f))));
    const int qi = (int)q & 3;
    s = (qi == 0) ? sp : (qi == 1) ? cp : (qi == 2) ? -sp : -cp;
    c = (qi == 0) ? cp : (qi == 1) ? -sp : (qi == 2) ? -cp : sp;
}

typedef float f32x16 __attribute__((ext_vector_type(16)));
typedef unsigned u32x2 __attribute__((ext_vector_type(2)));
__device__ __forceinline__ void ssm_abar_calc(const float* A_re, const float* A_im, const float* log_dt, int g, int n, float& abr, float& abi, float& cfr, float& cfi) {
    const float dt = expf(log_dt[g]);
    const float ar = A_re[g * 64 + n], ai = A_im[g * 64 + n];
    const float mag = expf(dt * ar); float sn, cs; sincos_rr(dt * ai, sn, cs);
    abr = mag * cs; abi = mag * sn;
    const float den = ar * ar + ai * ai, nr = abr - 1.0f;
    cfr = (nr * ar + abi * ai) / den; cfi = (abi * ar - nr * ai) / den;
}
__device__ __forceinline__ float gelu_tanh(float y) {
    const float z = 0.7978845608028654f * (y + 0.044715f * y * y * y);
    return y / (1.0f + __expf(-2.0f * z));
}
struct SsmT { const bf16* BT; const bf16* CT; const float* tab; const float* Dk; const float* gain; };
template <int MODE>
__device__ __forceinline__ void ssm_mfma_unit(LAS unsigned char* wl, int lane, int g, const SsmT& T, const bf16* XB, const float* XR, const float* ssp, int np, int row0, int nblk,
                                              float (&st)[4]  , bf16* Gout, const float* h0r, const float* h0i, float* hor, float* hoi  , int b0) {
    const int r32 = lane & 31, hi5 = lane >> 5, c16 = lane & 15, kq = lane >> 4;
    LAS float* rv = (LAS float*)(wl + 8704);
    pg8::bf16x8 bt[4], ct[4];
#pragma unroll
    for (int tn = 0; tn < 4; ++tn) bt[tn] = *(const pg8::bf16x8*)(T.BT + (size_t)(tn * 32 + r32) * 16 + 8 * hi5);
    if (MODE != 0) {
#pragma unroll
        for (int ks = 0; ks < 4; ++ks) ct[ks] = *(const pg8::bf16x8*)(T.CT + (size_t)c16 * 128 + 32 * ks + 8 * kq);
    }
    float ar[2], ai[2];
    { const f32x4 t0 = *(const f32x4*)(T.tab + (size_t)r32 * 4), t1 = *(const f32x4*)(T.tab + (size_t)(32 + r32) * 4); ar[0] = t0[0]; ai[0] = t0[1]; ar[1] = t1[0]; ai[1] = t1[1]; }
    f32x4 Dg = {0.f, 0.f, 0.f, 0.f};
    if (MODE != 0) { const f32x4 dv = *(const f32x4*)(T.Dk + 4 * kq), gv = *(const f32x4*)(T.gain + 4 * kq); Dg = dv * gv; }
    constexpr int NSV = (MODE == 2) ? 8 : 4;
    pg8::bf16x8 xa_n = *(const pg8::bf16x8*)(XB + (size_t)(row0 + r32) * 1024 + g * 16 + 8 * hi5);
    f32x4 sv_n[NSV];
#pragma unroll
    for (int i4 = 0; i4 < NSV; ++i4) sv_n[i4] = *(const f32x4*)(ssp + (size_t)(row0 + r32) * 64 + 4 * i4);
    f32x4 xr_n[2] = {{0.f, 0.f, 0.f, 0.f}, {0.f, 0.f, 0.f, 0.f}};
    if (MODE != 0) {
#pragma unroll
        for (int tt = 0; tt < 2; ++tt) xr_n[tt] = *(const f32x4*)(XR + (size_t)(row0 + 16 * tt + c16) * 1024 + g * 16 + 4 * kq);
    }
    for (int blk = 0; blk < nblk; ++blk) {
        const int rowb = row0 + 32 * blk;
        const pg8::bf16x8 xa = xa_n; f32x4 sv[NSV], xr_c[2];
#pragma unroll
        for (int i4 = 0; i4 < NSV; ++i4) sv[i4] = sv_n[i4];
        xr_c[0] = xr_n[0]; xr_c[1] = xr_n[1];
        if (blk + 1 < nblk) {
            const int rown = rowb + 32;
            xa_n = *(const pg8::bf16x8*)(XB + (size_t)(rown + r32) * 1024 + g * 16 + 8 * hi5);
#pragma unroll
            for (int i4 = 0; i4 < NSV; ++i4) sv_n[i4] = *(const f32x4*)(ssp + (size_t)(rown + r32) * 64 + 4 * i4);
            if (MODE != 0) {
#pragma unroll
                for (int tt = 0; tt < 2; ++tt) xr_n[tt] = *(const f32x4*)(XR + (size_t)(rown + 16 * tt + c16) * 1024 + g * 16 + 4 * kq);
            }
        }
        {
            float ss = 0.f;
#pragma unroll
            for (int i4 = 0; i4 < NSV; ++i4) ss += (sv[i4][0] + sv[i4][1]) + (sv[i4][2] + sv[i4][3]);
            if (lane < 32) rv[lane] = rsqrtf(ss * (1.0f / 1024.0f) + 1e-6f);
        }
        f32x16 IN[4];
#pragma unroll
        for (int tn = 0; tn < 4; ++tn) { const f32x16 z = {0.f, 0.f, 0.f, 0.f, 0.f, 0.f, 0.f, 0.f, 0.f, 0.f, 0.f, 0.f, 0.f, 0.f, 0.f, 0.f}; IN[tn] = __builtin_amdgcn_mfma_f32_32x32x16_bf16(xa, bt[tn], z, 0, 0, 0); }
        LDS_WAIT(); asm volatile("" ::: "memory");
        {
            f32x4 rq[4];
#pragma unroll
            for (int Q = 0; Q < 4; ++Q) rq[Q] = *(const LAS f32x4*)(rv + 8 * Q + 4 * hi5);
#pragma unroll
            for (int tn = 0; tn < 4; ++tn)
#pragma unroll
                for (int r = 0; r < 16; ++r) IN[tn][r] *= rq[r >> 2][r & 3];
        }
#pragma unroll
        for (int p = 0; p < 2; ++p) {
            float sr = st[2 * p], si = st[2 * p + 1];
            const float a_r = ar[p], a_i = ai[p];
            const bool up = (hi5 != 0);
#pragma unroll
            for (int Q = 0; Q < 4; ++Q) {
                if (MODE == 2) { const size_t hidx = ((size_t)(b0 + Q) * 64 + g) * 64 + 32 * p + r32; sr = h0r[hidx]; si = h0i[hidx]; }
                float xr_[4], xi_[4], yr_[4], yi_[4];
                float cr = sr, ci = si;
#pragma unroll
                for (int e = 0; e < 4; ++e) { float tr = fmaf(a_r, cr, IN[2 * p][4 * Q + e]); asm volatile("" : "+v"(tr)); tr = fmaf(-a_i, ci, tr); asm volatile("" : "+v"(tr)); float ti = fmaf(a_r, ci, IN[2 * p + 1][4 * Q + e]); asm volatile("" : "+v"(ti)); ti = fmaf(a_i, cr, ti); asm volatile("" : "+v"(ti)); cr = tr; ci = ti; xr_[e] = cr; xi_[e] = ci; }
                { auto w0 = __builtin_amdgcn_permlane32_swap(__float_as_uint(cr), __float_as_uint(cr), false, false); cr = __uint_as_float(w0[0]);
                  auto w1 = __builtin_amdgcn_permlane32_swap(__float_as_uint(ci), __float_as_uint(ci), false, false); ci = __uint_as_float(w1[0]); }
#pragma unroll
                for (int e = 0; e < 4; ++e) { float tr = fmaf(a_r, cr, IN[2 * p][4 * Q + e]); asm volatile("" : "+v"(tr)); tr = fmaf(-a_i, ci, tr); asm volatile("" : "+v"(tr)); float ti = fmaf(a_r, ci, IN[2 * p + 1][4 * Q + e]); asm volatile("" : "+v"(ti)); ti = fmaf(a_i, cr, ti); asm volatile("" : "+v"(ti)); cr = tr; ci = ti; yr_[e] = cr; yi_[e] = ci; }
                { auto w0 = __builtin_amdgcn_permlane32_swap(__float_as_uint(cr), __float_as_uint(cr), false, false); sr = __uint_as_float(w0[1]);
                  auto w1 = __builtin_amdgcn_permlane32_swap(__float_as_uint(ci), __float_as_uint(ci), false, false); si = __uint_as_float(w1[1]); }
#pragma unroll
                for (int e = 0; e < 4; ++e) { IN[2 * p][4 * Q + e] = up ? yr_[e] : xr_[e]; IN[2 * p + 1][4 * Q + e] = up ? yi_[e] : xi_[e]; }
                if (MODE == 2) { if (hi5 == 0) { const size_t hidx = ((size_t)(b0 + Q) * 64 + g) * 64 + 32 * p + r32; hor[hidx] = sr; hoi[hidx] = si; } }
            }
            st[2 * p] = sr; st[2 * p + 1] = si;
        }
        if (MODE != 0) {
#pragma unroll
            for (int p = 0; p < 2; ++p)
#pragma unroll
                for (int r = 0; r < 16; ++r) { const int tau = 8 * (r >> 2) + 4 * hi5 + (r & 3); *(LAS unsigned*)(wl + tau * 272 + 4 * (32 * p + r32)) = pg8::cvt_pk_bf16(IN[2 * p][r], IN[2 * p + 1][r]); }
            LDS_WAIT(); asm volatile("" ::: "memory");
#pragma unroll
            for (int tt = 0; tt < 2; ++tt) {
                f32x4 y = {0.f, 0.f, 0.f, 0.f};
#pragma unroll
                for (int ks = 0; ks < 4; ++ks) { const pg8::bf16x8 hf = *(const LAS pg8::bf16x8*)(wl + (16 * tt + c16) * 272 + (32 * ks + 8 * kq) * 2); y = __builtin_amdgcn_mfma_f32_16x16x32_bf16(ct[ks], hf, y, 0, 0, 0); }
                const int token = rowb + 16 * tt + c16;
                const float rinv = rv[16 * tt + c16];
                const f32x4 xv = xr_c[tt];
                f32x4 o;
#pragma unroll
                for (int e = 0; e < 4; ++e) o[e] = gelu_tanh(y[e] + Dg[e] * (xv[e] * rinv));
                *(u32x2*)(Gout + (size_t)token * 1024 + g * 16 + 4 * kq) = pg8::pack4(o);
            }
        }
        LDS_WAIT(); asm volatile("" ::: "memory");
    }
}

#ifndef PROBE_DUP
#define PROBE_DUP 0
#endif
#define NREP(bit) (((PROBE_DUP) >> (bit)) & 1 ? 2 : 1)
#ifndef EN_P0
#define EN_P0 1
#endif
#ifndef EN_QKV
#define EN_QKV 1
#endif
#ifndef EN_ATT
#define EN_ATT 1
#endif
#ifndef EN_OPJ
#define EN_OPJ 1
#endif
#ifndef EN_S1
#define EN_S1 1
#endif
#ifndef EN_S3
#define EN_S3 1
#endif
#ifndef EN_GLU
#define EN_GLU 1
#endif
#ifndef EN_UP
#define EN_UP 1
#endif
#ifndef EN_DN
#define EN_DN 1
#endif
#ifndef EN_FIN
#define EN_FIN 1
#endif
template <class T> __device__ __forceinline__ T karg(const __attribute__((address_space(4))) char* ka, int off) { typedef const __attribute__((address_space(4))) T CT; return *(CT*)(ka + off); }
struct Args { const float* in[23]; float* out; unsigned char* ws; int ph_lo, ph_hi; };
static_assert(sizeof(Args) == 208 && __builtin_offsetof(Args, out) == 184 && __builtin_offsetof(Args, ws) == 192, "kernarg layout used by KARG");

__global__ void __launch_bounds__(512, 2) fwd_kernel(Args args) {
    extern __shared__ __attribute__((aligned(16))) unsigned char lds[];
    LAS unsigned char* const L = (LAS unsigned char*)lds;
#define FRESH_IDS int tid = threadIdx.x; asm volatile("" : "+v"(tid)); const int lane = tid & 63, wave = __builtin_amdgcn_readfirstlane(tid >> 6); const int gw = vcu * 8 + wave; (void)lane; (void)gw
    const int G = gridDim.x, bx = blockIdx.x;
    const int vcu = (G % 8 == 0) ? (bx % 8) * (G / 8) + bx / 8 : bx;
    const int NGW = G * 8;
    for (int u = threadIdx.x; u < (LDS_BYTES - LDSCTL_OFF) / 4; u += 512) ((LAS unsigned*)(L + LDSCTL_OFF))[u] = 0u;
    __syncthreads();
    const int lo = args.ph_lo, hi = args.ph_hi;
    const bool multi = (hi - lo) > 1;
    XcdBarrier bar; bar.bar = (unsigned*)(args.ws + WS_CTL) + CW_BAR; bar.x = 0; bar.st = nullptr;
    if (multi) bar = xcd_barrier_post((unsigned*)(args.ws + WS_CTL) + CW_BAR, (volatile LAS unsigned*)(L + MISC_OFF) + 8);
#define IN(k) (lo <= (k) && (k) < hi)
#define SEAM(k) do { if (IN(k) && IN((k) + 1)) xcd_barrier(bar); } while (0)

#define KARG(T, off) karg<T>(ka, (off))
#define INP(k) karg<const float*>(ka, 8 * (k))
#define FRESH_PTRS const __attribute__((address_space(4))) char* ka = (const __attribute__((address_space(4))) char*)__builtin_amdgcn_kernarg_segment_ptr(); asm volatile("" : "+s"(ka)); \
    unsigned char* const ws = KARG(unsigned char*, 192); float* const out = KARG(float*, 184); \
    float* const ssp = (float*)(ws + WS_SSP); float* const HS = (float*)(ws + WS_HS); bf16* const XB = (bf16*)(ws + WS_XB); bf16* const Hb = (bf16*)(ws + WS_H); \
    bf16* const Qb = (bf16*)(ws + WS_Q); bf16* const Kb = (bf16*)(ws + WS_K); bf16* const Vb = (bf16*)(ws + WS_V); bf16* const Ob = (bf16*)(ws + WS_O); \
    const float* const x_p = INP(0); const float* const x_s = INP(1); (void)ssp; (void)HS; (void)XB; (void)Hb; (void)Qb; (void)Kb; (void)Vb; (void)Ob; (void)x_p; (void)x_s
    if (EN_P0 && IN(0)) for (int rp = 0; rp < NREP(0); ++rp) {
        FRESH_IDS; FRESH_PTRS;
        LAS float* scr = (LAS float*)(L + wave * 16384);
        constexpr int I_QKV = 16 * 48, I_O = 16 * 32, I_GLU = 16 * 64, I_UP = 16 * 128, I_DN = 64 * 32;
        constexpr int NITEMS = 2 * I_QKV + 2 * I_O + 2 * I_GLU + 4 * I_UP + 4 * I_DN;
        for (int it = gw; it < NITEMS; it += NGW) {
            int r = it;
            if (r < 2 * I_QKV) { const int j = r / I_QKV; r -= j * I_QKV; p0_transpose_item(INP(9) + (size_t)j * D * NQKV, D, NQKV, INP(6) + (size_t)(2 * j) * D, (bf16*)(ws + WS_WQKV) + (size_t)j * NQKV * D, 0, scr, r, lane); continue; } r -= 2 * I_QKV;
            if (r < 2 * I_O) { const int j = r / I_O; r -= j * I_O; p0_transpose_item(INP(10) + (size_t)j * D * D, D, D, nullptr, (bf16*)(ws + WS_WO) + (size_t)j * D * D, 0, scr, r, lane); continue; } r -= 2 * I_O;
            if (r < 2 * I_GLU) { const int j = r / I_GLU; r -= j * I_GLU; p0_transpose_item(INP(20) + (size_t)j * D * 2 * D, D, 2 * D, nullptr, (bf16*)(ws + WS_WGLU) + (size_t)j * 2 * D * D, 1, scr, r, lane); continue; } r -= 2 * I_GLU;
            if (r < 4 * I_UP) { const int l = r / I_UP; r -= l * I_UP; p0_transpose_item(INP(21) + (size_t)l * D * FF, D, FF, INP(7) + (size_t)l * D, (bf16*)(ws + WS_WUP) + (size_t)l * FF * D, 0, scr, r, lane); continue; } r -= 4 * I_UP;
            { const int l = r / I_DN; r -= l * I_DN; p0_transpose_item(INP(22) + (size_t)l * FF * D, FF, D, nullptr, (bf16*)(ws + WS_WDN) + (size_t)l * D * FF, 0, scr, r, lane); }
        }
        for (int m = gw; m < M; m += NGW) {
            const float* xrow = (m < MP) ? x_p + (size_t)m * D : x_s + (size_t)(m - MP) * D;
            const GAS f32x4* xr = (const GAS f32x4*)xrow + lane;
            f32x4 v[4]; float s = 0.f;
#pragma unroll
            for (int j = 0; j < 4; ++j) { v[j] = xr[64 * j]; s += (v[j][0] * v[j][0] + v[j][1] * v[j][1]) + (v[j][2] * v[j][2] + v[j][3] * v[j][3]); }
            s = wave_sum(s);
            GAS unsigned long long* o8 = (GAS unsigned long long*)(XB + (size_t)m * D) + lane;
#pragma unroll
            for (int j = 0; j < 4; ++j) o8[64 * j] = (unsigned long long)pk2(v[j][0], v[j][1]) | ((unsigned long long)pk2(v[j][2], v[j][3]) << 32);
            if (lane < 32) ssp[(size_t)m * 64 + lane] = (lane == 0) ? s : 0.f;
        }
        for (int i = bx * 512 + tid; i < 2 * NG * NS; i += G * 512) {
            const int jj = i >> 12, gn = i & 4095, g = gn >> 6, n = gn & 63; float abr, abi, cfr, cfi;
            ssm_abar_calc(INP(12) + (size_t)jj * NG * NS, INP(13) + (size_t)jj * NG * NS, INP(14) + (size_t)jj * NG, g, n, abr, abi, cfr, cfi);
            f32x4 v; v[0] = abr; v[1] = abi; v[2] = cfr; v[3] = cfi; *(f32x4*)((float*)(ws + WS_TAB) + (size_t)i * 4) = v;
            const float* bre = INP(15) + (size_t)i * 16; const float* bim = INP(16) + (size_t)i * 16; const float* gn_ = INP(6) + (size_t)(2 * jj + 1) * D + g * 16;
            bf16* btr = (bf16*)(ws + WS_BT) + ((size_t)(jj * NG + g) * 128 + (2 * (n >> 5)) * 32 + (n & 31)) * 16; bf16* bti = btr + 32 * 16;
#pragma unroll
            for (int c8 = 0; c8 < 2; ++c8) {
                float wr_[8], wi_[8];
#pragma unroll
                for (int c4 = 0; c4 < 2; ++c4) { const f32x4 br = *(const f32x4*)(bre + 8 * c8 + 4 * c4), bi = *(const f32x4*)(bim + 8 * c8 + 4 * c4), gv = *(const f32x4*)(gn_ + 8 * c8 + 4 * c4);
#pragma unroll
                    for (int e = 0; e < 4; ++e) { wr_[4 * c4 + e] = (cfr * br[e] - cfi * bi[e]) * gv[e]; wi_[4 * c4 + e] = (cfr * bi[e] + cfi * br[e]) * gv[e]; } }
                v4u o; o.x = pk2(wr_[0], wr_[1]); o.y = pk2(wr_[2], wr_[3]); o.z = pk2(wr_[4], wr_[5]); o.w = pk2(wr_[6], wr_[7]); *(v4u*)(btr + 8 * c8) = o;
                o.x = pk2(wi_[0], wi_[1]); o.y = pk2(wi_[2], wi_[3]); o.z = pk2(wi_[4], wi_[5]); o.w = pk2(wi_[6], wi_[7]); *(v4u*)(bti + 8 * c8) = o;
            }
        }
        for (int i = bx * 512 + tid; i < 2 * NG * GC * 16; i += G * 512) {
            const int n4 = i & 15; const size_t rowi = (size_t)(i >> 4);
            const f32x4 cr = *(const f32x4*)(INP(17) + rowi * 64 + 4 * n4), ci = *(const f32x4*)(INP(18) + rowi * 64 + 4 * n4);
            v4u o; o.x = pk2(cr[0], -ci[0]); o.y = pk2(cr[1], -ci[1]); o.z = pk2(cr[2], -ci[2]); o.w = pk2(cr[3], -ci[3]);
            *(v4u*)((bf16*)(ws + WS_CT) + rowi * 128 + 8 * n4) = o;
        }
        {
            constexpr int PER = 120 * 256 / 4;
            constexpr int TOT = 2 * 2 * SB * PER;
            for (int i = bx * 512 + tid; i < TOT; i += G * 512) {
                const int kv = i / (2 * SB * PER), rem = i % (2 * SB * PER), jb = rem / PER, e = rem % PER;
                const f32x4 v = *((const f32x4*)(INP(2 + kv) + (size_t)jb * 128 * 256 + 8 * 256) + e);
                *((f32x4*)(out + (kv ? O_VS : O_KS) + (size_t)jb * 128 * 256) + e) = v;
            }
        }
        __syncthreads();
    }
    SEAM(0);

    for (int l = 0; l < 4; ++l) {
        const int pb = 1 + 5 * l, j = l >> 1;
        if ((l & 1) == 0) {
            if (EN_QKV && IN(pb)) for (int rp = 0; rp < NREP(3); ++rp) {
                FRESH_PTRS;
                pg8::Gemm g{XB, (const bf16*)(ws + WS_WQKV) + (size_t)j * NQKV * D, M, NQKV, D}; pg8::StaticOrder S; S.init(MP, NQKV, G, bx);
                pg8::EpiQKV E{Qb, Kb, Vb, ssp, 16, 32, out + O_KP + (size_t)j * 2 * 128 * 256, out + O_VP + (size_t)j * 2 * 128 * 256, out + O_KS + (size_t)j * SB * 128 * 256, out + O_VS + (size_t)j * SB * 128 * 256};
                pg8::gemm_phase_x<pg8::EpiQKV, pg8::StaticOrder>(L, g, S, E);
            }
            SEAM(pb);
            if (EN_ATT && IN(pb + 1)) for (int rp = 0; rp < NREP(1); ++rp) {
                FRESH_IDS; FRESH_PTRS;
                const LAS unsigned char* Kl = L; const LAS unsigned char* Vl = L + 36864;
                const float* ck = INP(2) + (size_t)j * SB * 128 * 256; const float* cv = INP(3) + (size_t)j * SB * 128 * 256;
                const float* sinks = INP(11) + j * 16;
                const int r32 = lane & 31, hi5 = lane >> 5;
                for (int u = vcu; u < 1024; u += G) {
                    const bool samp = u >= 512;
                    int b, qblk = 0, kvh;
                    if (!samp) { kvh = u & 3; qblk = (u >> 2) & 63; b = u >> 8; } else { const int us = u - 512; kvh = us & 3; b = us >> 2; }
                    const int nchunk = samp ? 160 * 8 : 256 * 8;
                    for (int id = tid; id < nchunk; id += 512) {
                        const int key = id >> 3, ch = id & 7;
                        v4u kv = {0u, 0u, 0u, 0u}, vv = {0u, 0u, 0u, 0u};
                        if (!samp) {
                            const int s = qblk * 128 - 128 + key;
                            if (s >= 0) { const size_t off = (size_t)((b << 13) + s) * 256 + kvh * 64 + ch * 8; kv = *(const v4u*)(Kb + off); vv = *(const v4u*)(Vb + off); }
                        } else if (key < 128) {
                            const size_t off = ((size_t)b * 128 + key) * 256 + kvh * 64 + ch * 8;
                            const f32x4 k0 = *(const f32x4*)(ck + off), k1 = *(const f32x4*)(ck + off + 4), v0 = *(const f32x4*)(cv + off), v1 = *(const f32x4*)(cv + off + 4);
                            kv.x = pk2(k0[0], k0[1]); kv.y = pk2(k0[2], k0[3]); kv.z = pk2(k1[0], k1[1]); kv.w = pk2(k1[2], k1[3]);
                            vv.x = pk2(v0[0], v0[1]); vv.y = pk2(v0[2], v0[3]); vv.z = pk2(v1[0], v1[1]); vv.w = pk2(v1[2], v1[3]);
                        } else if (key < 136) {
                            const size_t off = (size_t)(MP + b * 8 + (key - 128)) * 256 + kvh * 64 + ch * 8; kv = *(const v4u*)(Kb + off); vv = *(const v4u*)(Vb + off);
                        }
                        *(LAS v4u*)(L + key * 144 + ch * 16) = kv;
                        LAS unsigned short* vt = (LAS unsigned short*)(L + 36864 + (ch * 8) * 520 + key * 2);
                        vt[0 * 260] = (unsigned short)(vv.x & 0xffffu); vt[1 * 260] = (unsigned short)(vv.x >> 16); vt[2 * 260] = (unsigned short)(vv.y & 0xffffu); vt[3 * 260] = (unsigned short)(vv.y >> 16);
                        vt[4 * 260] = (unsigned short)(vv.z & 0xffffu); vt[5 * 260] = (unsigned short)(vv.z >> 16); vt[6 * 260] = (unsigned short)(vv.w & 0xffffu); vt[7 * 260] = (unsigned short)(vv.w >> 16);
                    }
                    __syncthreads();
                    const int ntask = samp ? ((wave == 0) ? 1 : 0) : 2;
                    for (int ti = 0; ti < ntask; ++ti) {
                        int qrow, head, tloc, kb0, jkmin;
                        if (!samp) { const int sb = 2 * (wave & 1) + ti; head = kvh * 4 + (wave >> 1); tloc = 32 * sb + r32; qrow = (b << 13) + qblk * 128 + tloc; kb0 = sb; jkmin = (qblk == 0) ? 128 : 0; }
                        else { head = kvh * 4 + (r32 >> 3); tloc = r32 & 7; qrow = MP + b * 8 + tloc; kb0 = 0; jkmin = 0; }
                        const float slope2 = exp2f(-0.5f * (float)(head + 1)) * 1.4426950408889634f, sink2 = sinks[head] * 1.4426950408889634f;
                        const bf16* qptr = Qb + (size_t)qrow * 1024 + head * 64 + 8 * hi5;
                        pg8::bf16x8 qf[4];
#pragma unroll
                        for (int ks = 0; ks < 4; ++ks) qf[ks] = *(const pg8::bf16x8*)(qptr + 16 * ks);
                        f32x16 S[5];
#pragma unroll
                        for (int i = 0; i < 5; ++i) {
                            f32x16 acc = {0.f, 0.f, 0.f, 0.f, 0.f, 0.f, 0.f, 0.f, 0.f, 0.f, 0.f, 0.f, 0.f, 0.f, 0.f, 0.f};
#pragma unroll
                            for (int ks = 0; ks < 4; ++ks) { const pg8::bf16x8 kf = *(const LAS pg8::bf16x8*)(Kl + (32 * (kb0 + i) + r32) * 144 + 32 * ks + 16 * hi5); acc = __builtin_amdgcn_mfma_f32_32x32x16_bf16(kf, qf[ks], acc, 0, 0, 0); }
                            S[i] = acc;
                        }
                        float mx = sink2;
#pragma unroll
                        for (int i = 0; i < 5; ++i)
#pragma unroll
                            for (int r = 0; r < 16; ++r) {
                                const int jk = 32 * (kb0 + i) + (r & 3) + 8 * (r >> 2) + 4 * hi5; const int dist = tloc + 128 - jk;
                                const bool valid = (dist >= 0) && (dist <= 128) && (jk >= jkmin);
                                const float sv = valid ? (S[i][r] * 0.18033688011112042f - slope2 * (float)dist) : -1e30f;
                                S[i][r] = sv; mx = fmaxf(mx, sv);
                            }
                        mx = fmaxf(mx, __shfl_xor(mx, 32));
                        float lsum = 0.f;
#pragma unroll
                        for (int i = 0; i < 5; ++i)
#pragma unroll
                            for (int r = 0; r < 16; ++r) { const float p = __builtin_amdgcn_exp2f(S[i][r] - mx); S[i][r] = p; lsum += p; }
                        lsum += __shfl_xor(lsum, 32); lsum += __builtin_amdgcn_exp2f(sink2 - mx);
                        const float inv = 1.0f / lsum;
                        f32x16 O0 = {0.f, 0.f, 0.f, 0.f, 0.f, 0.f, 0.f, 0.f, 0.f, 0.f, 0.f, 0.f, 0.f, 0.f, 0.f, 0.f}, O1 = O0;
#pragma unroll
                        for (int i = 0; i < 5; ++i)
#pragma unroll
                            for (int s2 = 0; s2 < 2; ++s2) {
                                v4u pw; pw.x = pg8::cvt_pk_bf16(S[i][8 * s2 + 0], S[i][8 * s2 + 1]); pw.y = pg8::cvt_pk_bf16(S[i][8 * s2 + 2], S[i][8 * s2 + 3]);
                                pw.z = pg8::cvt_pk_bf16(S[i][8 * s2 + 4], S[i][8 * s2 + 5]); pw.w = pg8::cvt_pk_bf16(S[i][8 * s2 + 6], S[i][8 * s2 + 7]);
                                const pg8::bf16x8 pf = __builtin_bit_cast(pg8::bf16x8, pw);
                                const int keyoff = 32 * (kb0 + i) + 16 * s2 + 4 * hi5;
                                { const u32x2 lo = *(const LAS u32x2*)(Vl + r32 * 520 + keyoff * 2), hh = *(const LAS u32x2*)(Vl + r32 * 520 + (keyoff + 8) * 2);
                                  v4u vw; vw.x = lo.x; vw.y = lo.y; vw.z = hh.x; vw.w = hh.y; O0 = __builtin_amdgcn_mfma_f32_32x32x16_bf16(__builtin_bit_cast(pg8::bf16x8, vw), pf, O0, 0, 0, 0); }
                                { const u32x2 lo = *(const LAS u32x2*)(Vl + (32 + r32) * 520 + keyoff * 2), hh = *(const LAS u32x2*)(Vl + (32 + r32) * 520 + (keyoff + 8) * 2);
                                  v4u vw; vw.x = lo.x; vw.y = lo.y; vw.z = hh.x; vw.w = hh.y; O1 = __builtin_amdgcn_mfma_f32_32x32x16_bf16(__builtin_bit_cast(pg8::bf16x8, vw), pf, O1, 0, 0, 0); }
                            }
                        bf16* optr = Ob + (size_t)qrow * 1024 + head * 64 + 4 * hi5;
#pragma unroll
                        for (int qd = 0; qd < 4; ++qd) {
                            u32x2 w0; w0.x = pg8::cvt_pk_bf16(O0[4 * qd] * inv, O0[4 * qd + 1] * inv); w0.y = pg8::cvt_pk_bf16(O0[4 * qd + 2] * inv, O0[4 * qd + 3] * inv);
                            u32x2 w1; w1.x = pg8::cvt_pk_bf16(O1[4 * qd] * inv, O1[4 * qd + 1] * inv); w1.y = pg8::cvt_pk_bf16(O1[4 * qd + 2] * inv, O1[4 * qd + 3] * inv);
                            *(u32x2*)(optr + 8 * qd) = w0; *(u32x2*)(optr + 32 + 8 * qd) = w1;
                        }
                    }
                    __syncthreads();
                }
            }
            SEAM(pb + 1);
            if (EN_OPJ && IN(pb + 2)) {
                FRESH_PTRS;
                pg8::Gemm g{Ob, (const bf16*)(ws + WS_WO) + (size_t)j * D * D, M, D, D}; pg8::StaticOrder S; S.init(MP, D, G, bx);
                pg8::EpiRes E{(l == 0) ? x_p : out, (l == 0) ? x_s : out + (size_t)MP * D, out, XB, ssp};
                pg8::gemm_phase_x<pg8::EpiRes, pg8::StaticOrder>(L, g, S, E);
            }
            SEAM(pb + 2);
        } else {
#define SSMT(gg) const SsmT T_{(const bf16*)(ws + WS_BT) + ((size_t)j * NG + (gg)) * 128 * 16, (const bf16*)(ws + WS_CT) + ((size_t)j * NG + (gg)) * 16 * 128, (const float*)(ws + WS_TAB) + ((size_t)j * NG + (gg)) * NS * 4, \
                          INP(19) + (size_t)j * D + (gg) * 16, INP(6) + (size_t)l * D + (gg) * 16}
            if (EN_S1 && IN(pb)) for (int rp = 0; rp < NREP(2); ++rp) {
                FRESH_IDS; FRESH_PTRS; LAS unsigned char* wl = L + wave * 9216;
                for (int u = gw; u < NB * (NCH - 1) * NG; u += NGW) {
                    int lane = tid & 63; asm volatile("" : "+v"(lane));
                    const int g = u & 63, ch = (u >> 6) % (NCH - 1), b = (u >> 6) / (NCH - 1);
                    SSMT(g);
                    float st[4] = {0.f, 0.f, 0.f, 0.f};
                    ssm_mfma_unit<0>(wl, lane, g, T_, XB, out, ssp, 16, b * SEQ + ch * CH, CH / 32, st, nullptr, nullptr, nullptr, nullptr, nullptr, 0);
                    if (lane < 32) { float* hs = HS + ((size_t)((b * NCH + ch) * NG + g) * NS) * 2; *(float2*)(hs + 2 * lane) = make_float2(st[0], st[1]); *(float2*)(hs + 2 * (32 + lane)) = make_float2(st[2], st[3]); }
                }
                __syncthreads();
            }
            SEAM(pb);
            if (EN_S3 && IN(pb + 1)) for (int rp = 0; rp < NREP(2); ++rp) {
                FRESH_IDS; FRESH_PTRS; LAS unsigned char* wl = L + wave * 9216;
                for (int u = gw; u < NB * NCH * NG + (SB / 4) * NG; u += NGW) {
                    int lane = tid & 63; asm volatile("" : "+v"(lane));
                    if (u < NB * NCH * NG) {
                        const int g = u & 63, ch = (u >> 6) & (NCH - 1), b = u >> 11, r32 = lane & 31;
                        SSMT(g);
                        float st[4] = {0.f, 0.f, 0.f, 0.f};
#pragma unroll
                        for (int p = 0; p < 2; ++p) {
                            const f32x4 tv = *(const f32x4*)(T_.tab + (size_t)(32 * p + r32) * 4);
                            float aLr = tv[0], aLi = tv[1];
#pragma unroll
                            for (int sq = 0; sq < 8; ++sq) { const float tr = aLr * aLr - aLi * aLi, ti = 2.0f * aLr * aLi; aLr = tr; aLi = ti; }
                            float hr = 0.f, hi_ = 0.f;
                            for (int i0 = 0; i0 < ch; i0 += 8) {
                                float2 e[8];
#pragma unroll
                                for (int k = 0; k < 8; ++k) e[k] = (i0 + k < ch) ? *(const float2*)(HS + ((size_t)((b * NCH + i0 + k) * NG + g) * NS + 32 * p + r32) * 2) : make_float2(0.f, 0.f);
#pragma unroll
                                for (int k = 0; k < 8; ++k) if (i0 + k < ch) { const float tr = aLr * hr - aLi * hi_ + e[k].x, ti = aLr * hi_ + aLi * hr + e[k].y; hr = tr; hi_ = ti; }
                            }
                            st[2 * p] = hr; st[2 * p + 1] = hi_;
                        }
                        ssm_mfma_unit<1>(wl, lane, g, T_, XB, out, ssp, 16, b * SEQ + ch * CH, CH / 32, st, Ob, nullptr, nullptr, nullptr, nullptr, 0);
                        if (ch == NCH - 1 && lane < 32) { float* hr_o = out + O_HRP + ((size_t)(j * NB + b) * NG + g) * NS; float* hi_o = out + O_HIP + ((size_t)(j * NB + b) * NG + g) * NS;
                            hr_o[lane] = st[0]; hi_o[lane] = st[1]; hr_o[32 + lane] = st[2]; hi_o[32 + lane] = st[3]; }
                    } else {
                        const int us = u - NB * NCH * NG, g = us & 63, bb = us >> 6;
                        SSMT(g);
                        float st[4] = {0.f, 0.f, 0.f, 0.f};
                        ssm_mfma_unit<2>(wl, lane, g, T_, XB, out, ssp, 32, MP + bb * 32, 1, st, Ob, INP(4) + (size_t)j * SB * NG * NS, INP(5) + (size_t)j * SB * NG * NS, out + O_HRS + (size_t)j * SB * NG * NS, out + O_HIS + (size_t)j * SB * NG * NS, bb * 4);
                    }
                }
                __syncthreads();
            }
            SEAM(pb + 1);
            if (EN_GLU && IN(pb + 2)) {
                FRESH_PTRS;
                pg8::Gemm g{Ob, (const bf16*)(ws + WS_WGLU) + (size_t)j * 2 * D * D, M, 2 * D, D}; pg8::StaticOrder S; S.init(MP, 2 * D, G, bx);
                pg8::EpiGlu E{out, XB, ssp};
                pg8::gemm_phase_x<pg8::EpiGlu, pg8::StaticOrder>(L, g, S, E);
            }
            SEAM(pb + 2);
        }
        if (EN_UP && IN(pb + 3)) for (int rp = 0; rp < NREP(4); ++rp) {
            FRESH_PTRS;
            pg8::Gemm g{XB, (const bf16*)(ws + WS_WUP) + (size_t)l * FF * D, M, FF, D}; pg8::StaticOrder S; S.init(MP, FF, G, bx);
            pg8::EpiUp E{Hb, ssp, (l & 1) ? 32 : 16, (l & 1) ? 64 : 32};
            pg8::gemm_phase_x<pg8::EpiUp, pg8::StaticOrder>(L, g, S, E);
        }
        SEAM(pb + 3);
        if (EN_DN && IN(pb + 4)) {
            FRESH_PTRS;
            pg8::Gemm g{Hb, (const bf16*)(ws + WS_WDN) + (size_t)l * D * FF, M, D, FF}; pg8::StaticOrder S; S.init(MP, D, G, bx);
            pg8::EpiRes E{out, out + (size_t)MP * D, out, XB, ssp};
            pg8::gemm_phase_x<pg8::EpiRes, pg8::StaticOrder>(L, g, S, E);
        }
        SEAM(pb + 4);
    }
    if (EN_FIN && IN(21)) {
        FRESH_IDS; FRESH_PTRS;
        const float* gf = INP(8);
        for (int m = gw; m < M; m += NGW) {
            const float pv = (lane < ((m < MP) ? 16 : 32)) ? ssp[(size_t)m * 64 + lane] : 0.f;
            const float rinv = rsqrtf(wave_sum(pv) * (1.0f / 1024.0f) + 1e-6f);
            GAS f32x4* xr = (GAS f32x4*)(out + (size_t)m * D) + lane;
#pragma unroll
            for (int jx = 0; jx < 4; ++jx) { const f32x4 gv = *((const f32x4*)gf + 64 * jx + lane); f32x4 v = xr[64 * jx]; v = v * rinv * gv; xr[64 * jx] = v; }
        }
    }
#undef IN
#undef SEAM
}

#ifndef MK_SPLIT
#define MK_SPLIT 0
#endif
extern "C" void kernel_launch(void* const* d_in, const int* in_sizes, int n_in, void* d_out, int out_size, void* d_ws, size_t ws_size, hipStream_t stream) {
    static int grid = 0;
    if (grid == 0) {
        if (n_in != 23 || in_sizes[0] != MP * D || (size_t)out_size != O_END || ws_size < WS_END) { fprintf(stderr, "kernel_launch: unexpected shapes (n_in %d, in0 %d, out %d, ws %zu); nothing launched\n", n_in, n_in > 0 ? in_sizes[0] : -1, out_size, ws_size); grid = -1; return; }
        int dev = 0, cus = 0, per_cu = 0;
        if (hipGetDevice(&dev) != hipSuccess || hipDeviceGetAttribute(&cus, hipDeviceAttributeMultiprocessorCount, dev) != hipSuccess) { fprintf(stderr, "kernel_launch: device query failed\n"); grid = -1; return; }
        if (hipFuncSetAttribute((const void*)fwd_kernel, hipFuncAttributeMaxDynamicSharedMemorySize, LDS_BYTES) != hipSuccess) { fprintf(stderr, "kernel_launch: hipFuncSetAttribute failed\n"); grid = -1; return; }
        if (hipOccupancyMaxActiveBlocksPerMultiprocessor(&per_cu, (const void*)fwd_kernel, 512, LDS_BYTES) != hipSuccess || per_cu < 1) fprintf(stderr, "kernel_launch: note: occupancy query reports %d blocks per CU\n", per_cu);
        (void)hipGetLastError();
        grid = cus;
    }
    if (grid < 0) return;
    (void)hipMemsetAsync((char*)d_ws + WS_CTL, 0, CTL_ZERO_BYTES, stream);
    Args a{};
    for (int i = 0; i < 23; ++i) a.in[i] = (const float*)d_in[i];
    a.out = (float*)d_out; a.ws = (unsigned char*)d_ws;
#if MK_SPLIT
    for (int p = 0; p < NPHASE; ++p) { a.ph_lo = p; a.ph_hi = p + 1; hipLaunchKernelGGL(fwd_kernel, dim3(grid), dim3(512), LDS_BYTES, stream, a); }
#else
    a.ph_lo = 0; a.ph_hi = NPHASE; hipLaunchKernelGGL(fwd_kernel, dim3(grid), dim3(512), LDS_BYTES, stream, a);
#endif
}
```

```cpp
#include <hip/hip_runtime.h>
#include <cstdio>
#include <cstdint>
namespace pg8 {
#define PG8_LAS __attribute__((address_space(3)))
typedef unsigned short bf16_t;
typedef short bf16x8 __attribute__((ext_vector_type(8)));
typedef float f32x4 __attribute__((ext_vector_type(4)));
typedef unsigned u32x4 __attribute__((ext_vector_type(4)));
constexpr int BM = 256, BK = 64, HALF = 128, HTB = HALF * BK * 2  , STAGE_BYTES = 8 * HTB, NXCD = 8, WGM = 8;

__host__ __device__ __forceinline__ int lds_byte(int r, int c) { const int st = (r >> 4) * 2 + (c >> 5), rr = r & 15, cc = c & 31, ob = rr * 64 + cc * 2; return st * 1024 + (ob ^ (((ob >> 9) & 1) << 5)); }
__host__ __device__ __forceinline__ void stage_rc(int b, int& R, int& C) { const int st = b / 1024, sb = b % 1024, swz = sb ^ (((sb >> 9) & 1) << 5); R = (st >> 1) * 16 + swz / 64; C = (st & 1) * 32 + (swz % 64) / 2; }
__host__ __device__ __forceinline__ int perm32(int rho) { const int n = rho >> 4, i = rho & 15; return 8 * (i >> 2) + 4 * n + (i & 3); }

struct Unit { int pm, pn; };
struct Gemm { const bf16_t* A; const bf16_t* Bt; int M, N, K; };

struct StaticOrder {
    int nM, nN, nwg, G, c;
    __host__ __device__ void init(int M, int N, int G_, int c_) { nM = M / BM; nN = N / BM; nwg = nM * nN; G = G_; c = c_; }
    __host__ __device__ bool next(int i, Unit& u) const {
        const long L = (long)i * G + c; if (L >= nwg) return false;
        int wgid = (int)L; { const int q = nwg / NXCD, r = nwg % NXCD, xcd = wgid % NXCD, off = wgid / NXCD; wgid = (xcd < r ? xcd * (q + 1) : r * (q + 1) + (xcd - r) * q) + off; }
        const int nig = WGM * nN, gid = wgid / nig, fm = gid * WGM, gsz = (nM - fm) < WGM ? (nM - fm) : WGM;
        u.pm = fm + ((wgid % nig) % gsz); u.pn = (wgid % nig) / gsz; return true;
    }
    __device__ __forceinline__ void a_ready(const Unit&) const {}
    __device__ __forceinline__ void done(const Unit&) const {}
};
__device__ __forceinline__ unsigned cvt_pk_bf16(float lo, float hi) { unsigned r; asm volatile("v_cvt_pk_bf16_f32 %0, %1, %2" : "=v"(r) : "v"(lo), "v"(hi)); return r; }
typedef float f32x2 __attribute__((ext_vector_type(2)));
template <class Epi, class Sched, bool ALIGN_EPI = false, bool SP2 = false>
__device__ __forceinline__ void gemm_phase(PG8_LAS unsigned char* lds, const Gemm g, const Sched& S, const Epi& E) {
    int tid_ = threadIdx.x; asm volatile("" : "+v"(tid_));
    const int tid = tid_, wid = __builtin_amdgcn_readfirstlane(tid >> 6), lane = tid & 63, wr = wid >> 2, wc = wid & 3, fr = lane & 15, fq = lane >> 4;
    const int K = g.K, nt = K / BK;
    unsigned voffA[2], voffB[2];
#pragma unroll
    for (int i = 0; i < 2; ++i) { int R, C; stage_rc(tid * 16 + i * 8192, R, C); const int Rb = Epi::PERM ? ((R & ~31) + perm32(R & 31)) : R;
        voffA[i] = (unsigned)(R * K + C) * 2u; voffB[i] = (unsigned)(Rb * K + C) * 2u; }
    const size_t kstep = (size_t)(BK * 2);
    const size_t hstep = (size_t)HALF * K * 2;
    const size_t tstep = 2 * hstep;
    const unsigned ldsw = (unsigned)wid * 1024u;
    const int aoff = lds_byte(wr * 64 + fr, fq * 8), boff = lds_byte(wc * 32 + fr, fq * 8);
#define PG8_SA(b, h) (((b) * 2 + (h)) * HTB)
#define PG8_SB(b, h) ((4 + (b) * 2 + (h)) * HTB)
#define PG8_STAGE(bufoff, gbase, voff) do { _Pragma("unroll") for (int _i = 0; _i < 2; ++_i) \
        __builtin_amdgcn_global_load_lds((const unsigned*)((const char*)(gbase) + (voff)[_i]), (PG8_LAS unsigned*)(lds + (bufoff) + ldsw + _i * 8192), 16, 0, 0); } while (0)
#define PG8_LDA(dst, b, h) do { _Pragma("unroll") for (int m = 0; m < 4; ++m) _Pragma("unroll") for (int k = 0; k < 2; ++k) dst[m][k] = *(const PG8_LAS bf16x8*)(lds + PG8_SA(b, h) + aoff + m * 2048 + k * 1024); } while (0)
#define PG8_LDB(dst, b, h) do { _Pragma("unroll") for (int n = 0; n < 2; ++n) _Pragma("unroll") for (int k = 0; k < 2; ++k) dst[n][k] = *(const PG8_LAS bf16x8*)(lds + PG8_SB(b, h) + boff + n * 2048 + k * 1024); } while (0)
#define PG8_MMA(ai, bj, At, Bt) do { __builtin_amdgcn_s_setprio(1); _Pragma("unroll") for (int m = 0; m < 4; ++m) _Pragma("unroll") for (int n = 0; n < 2; ++n) _Pragma("unroll") for (int k = 0; k < 2; ++k) \
        acc[ai][bj][m][n] = __builtin_amdgcn_mfma_f32_16x16x32_bf16(Bt[n][k], At[m][k], acc[ai][bj][m][n], 0, 0, 0); __builtin_amdgcn_s_setprio(0); } while (0)
#define PG8_WAIT_V(n) asm volatile("s_waitcnt vmcnt(" #n ")" ::: "memory")
#define PG8_WAIT_L(n) asm volatile("s_waitcnt lgkmcnt(" #n ")" ::: "memory")
#define PG8_BAR __builtin_amdgcn_s_barrier()
#define PG8_SCHED __builtin_amdgcn_sched_barrier(0)
    Unit cur, nxt; int ui = 0;
    if (!S.next(0, cur)) return;
    f32x4 acc[2][2][4][2];
#pragma unroll
    for (int a = 0; a < 2; ++a)
#pragma unroll
        for (int b = 0; b < 2; ++b)
#pragma unroll
            for (int m = 0; m < 4; ++m)
#pragma unroll
                for (int n = 0; n < 2; ++n) acc[a][b][m][n] = (f32x4){0.f, 0.f, 0.f, 0.f};
    bf16x8 At[4][2], B0[2][2], B1[2][2];
    const char* cA = (const char*)g.A + (size_t)cur.pm * tstep; const char* cB = (const char*)g.Bt + (size_t)cur.pn * tstep;
    S.a_ready(cur);
    if constexpr (SP2) {
        PG8_STAGE(PG8_SB(0, 0), cB, voffB); PG8_STAGE(PG8_SB(0, 1), cB + hstep, voffB); PG8_STAGE(PG8_SA(0, 0), cA, voffA); PG8_STAGE(PG8_SA(0, 1), cA + hstep, voffA);
        if (wr == 1) PG8_BAR;
        PG8_WAIT_V(2); PG8_BAR;
        PG8_STAGE(PG8_SB(1, 0), cB + kstep, voffB); PG8_STAGE(PG8_SA(1, 0), cA + kstep, voffA); PG8_STAGE(PG8_SB(1, 1), cB + hstep + kstep, voffB);
        PG8_WAIT_V(6); PG8_BAR;
    } else {
        PG8_STAGE(PG8_SB(0, 0), cB, voffB); PG8_STAGE(PG8_SA(0, 0), cA, voffA); PG8_STAGE(PG8_SB(0, 1), cB + hstep, voffB); PG8_STAGE(PG8_SA(0, 1), cA + hstep, voffA);
        if (wr == 1) PG8_BAR;
        PG8_WAIT_V(4); PG8_BAR;
        PG8_STAGE(PG8_SB(1, 0), cB + kstep, voffB); PG8_STAGE(PG8_SA(1, 0), cA + kstep, voffA); PG8_STAGE(PG8_SB(1, 1), cB + hstep + kstep, voffB);
        PG8_WAIT_V(6); PG8_BAR;
    }
    for (;;) {
        const bool has_next = S.next(ui + 1, nxt);
        const char* nA = has_next ? (const char*)g.A + (size_t)nxt.pm * tstep : cA; const char* nB = has_next ? (const char*)g.Bt + (size_t)nxt.pn * tstep : cB;
        for (int t = 0; t < nt; t += 2) {
            const bool last = (t == nt - 2);
            const char* a1 = cA + (size_t)(t + 1) * kstep;
            const char* a2 = last ? nA : cA + (size_t)(t + 2) * kstep; const char* b2 = last ? nB : cB + (size_t)(t + 2) * kstep;
            const char* a3 = a2 + kstep; const char* b3 = b2 + kstep;
            if (last && has_next) S.a_ready(nxt);
            if constexpr (SP2) {
            PG8_LDB(B0, 0, 0); PG8_LDB(B1, 0, 1); PG8_SCHED; PG8_LDA(At, 0, 0); PG8_STAGE(PG8_SA(1, 1), a1 + hstep, voffA);
            PG8_WAIT_V(8); PG8_WAIT_L(0); PG8_BAR; PG8_MMA(0, 0, At, B0); PG8_MMA(0, 1, At, B1); PG8_BAR; PG8_SCHED;
            PG8_LDA(At, 0, 1); PG8_STAGE(PG8_SB(0, 0), b2, voffB); PG8_STAGE(PG8_SB(0, 1), b2 + hstep, voffB); PG8_STAGE(PG8_SA(0, 0), a2, voffA);
            PG8_WAIT_V(8); PG8_WAIT_L(0); PG8_BAR; PG8_MMA(1, 0, At, B0); PG8_MMA(1, 1, At, B1); PG8_BAR; PG8_SCHED;
            PG8_LDB(B0, 1, 0); PG8_LDB(B1, 1, 1); PG8_SCHED; PG8_LDA(At, 1, 0); PG8_STAGE(PG8_SA(0, 1), a2 + hstep, voffA);
            PG8_WAIT_V(8); PG8_WAIT_L(0); PG8_BAR; PG8_MMA(0, 0, At, B0); PG8_MMA(0, 1, At, B1); PG8_BAR; PG8_SCHED;
            PG8_LDA(At, 1, 1); PG8_STAGE(PG8_SB(1, 0), b3, voffB); PG8_STAGE(PG8_SB(1, 1), b3 + hstep, voffB); PG8_STAGE(PG8_SA(1, 0), a3, voffA);
            PG8_WAIT_V(8); PG8_WAIT_L(0); PG8_BAR; PG8_MMA(1, 0, At, B0); PG8_MMA(1, 1, At, B1); PG8_BAR; PG8_SCHED;
            } else {
            PG8_LDB(B0, 0, 0); PG8_SCHED; PG8_LDA(At, 0, 0); PG8_STAGE(PG8_SA(1, 1), a1 + hstep, voffA);
            PG8_WAIT_L(8); PG8_BAR; PG8_WAIT_L(0); PG8_MMA(0, 0, At, B0); PG8_BAR; PG8_SCHED;
            PG8_LDB(B1, 0, 1); PG8_STAGE(PG8_SB(0, 0), b2, voffB);
            PG8_BAR; PG8_WAIT_L(0); PG8_MMA(0, 1, At, B1); PG8_BAR;
            PG8_LDA(At, 0, 1); PG8_STAGE(PG8_SA(0, 0), a2, voffA);
            PG8_BAR; PG8_WAIT_L(0); PG8_MMA(1, 0, At, B0); PG8_BAR; PG8_SCHED;
            PG8_STAGE(PG8_SB(0, 1), b2 + hstep, voffB);
            PG8_WAIT_V(6); PG8_BAR; PG8_MMA(1, 1, At, B1); PG8_BAR;
            PG8_LDB(B0, 1, 0); PG8_SCHED; PG8_LDA(At, 1, 0); PG8_STAGE(PG8_SA(0, 1), a2 + hstep, voffA);
            PG8_WAIT_L(8); PG8_BAR; PG8_WAIT_L(0); PG8_MMA(0, 0, At, B0); PG8_BAR; PG8_SCHED;
            PG8_LDB(B1, 1, 1); PG8_STAGE(PG8_SB(1, 0), b3, voffB);
            PG8_BAR; PG8_WAIT_L(0); PG8_MMA(0, 1, At, B1); PG8_BAR;
            PG8_LDA(At, 1, 1); PG8_STAGE(PG8_SA(1, 0), a3, voffA);
            PG8_BAR; PG8_WAIT_L(0); PG8_MMA(1, 0, At, B0); PG8_BAR; PG8_SCHED;
            PG8_STAGE(PG8_SB(1, 1), b3 + hstep, voffB);
            PG8_WAIT_V(6); PG8_BAR; PG8_MMA(1, 1, At, B1); PG8_BAR;
            }
        }
        if constexpr (ALIGN_EPI) { if (wr == 0) PG8_BAR; }
        if constexpr (!Epi::AFTER_DRAIN) { E(acc, cur, wr, wc, fr, fq); S.done(cur); }
        if (!has_next) break;
#pragma unroll
        for (int a = 0; a < 2; ++a)
#pragma unroll
            for (int b = 0; b < 2; ++b)
#pragma unroll
                for (int m = 0; m < 4; ++m)
#pragma unroll
                    for (int n = 0; n < 2; ++n) acc[a][b][m][n] = (f32x4){0.f, 0.f, 0.f, 0.f};
        cur = nxt; cA = nA; cB = nB; ++ui;
        if constexpr (ALIGN_EPI) { if (wr == 1) PG8_BAR; }
    }
    PG8_WAIT_V(0);
    if constexpr (!ALIGN_EPI) { if (wr == 0) PG8_BAR; }
    PG8_BAR;
    if constexpr (Epi::AFTER_DRAIN) { E.fused(acc, cur, wr, wc, fr, fq, lds, wid, lane); S.done(cur); }
#undef PG8_SA
#undef PG8_SB
#undef PG8_STAGE
#undef PG8_LDA
#undef PG8_LDB
#undef PG8_MMA
#undef PG8_WAIT_V
#undef PG8_WAIT_L
#undef PG8_BAR
#undef PG8_SCHED
}
}
#define GAS __attribute__((address_space(1)))
#define LAS __attribute__((address_space(3)))
typedef unsigned short bf16;
typedef unsigned v4u __attribute__((ext_vector_type(4)));
typedef float f32x4 __attribute__((ext_vector_type(4)));
typedef short bf16x8 __attribute__((ext_vector_type(8)));
typedef GAS unsigned gu32;
typedef GAS unsigned long long gu64;
#define RLX_AGENT __ATOMIC_RELAXED, __HIP_MEMORY_SCOPE_AGENT
#define LDS_WAIT() asm volatile("s_waitcnt lgkmcnt(0)" ::: "memory")
#define VM_WAIT() asm volatile("s_waitcnt vmcnt(0)" ::: "memory")
__device__ __forceinline__ unsigned long long rt() { return __builtin_amdgcn_s_memrealtime(); }
__device__ __forceinline__ unsigned f2bf(float f) { unsigned u = __builtin_bit_cast(unsigned, f); return (u + 0x7fffu + ((u >> 16) & 1u)) >> 16; }
__device__ __forceinline__ unsigned pk2(float lo, float hi) { return f2bf(lo) | (f2bf(hi) << 16); }
#define XB_TMO      128
#define XB_XCNT(j)  (256  + 64 * (j))
#define XB_XSUB(j)  (1280 + 64 * (j))
#define XB_XGEN(j)  (2304 + 64 * (j))
#define XB_TOP      3328
#define XB_TOPGEN   3392
#define XCD_BAR_WORDS 3456
#define XB_SPIN_CAP (1u << 18)

__device__ __forceinline__ unsigned xb_ld(unsigned* p)              { return __hip_atomic_load(p, __ATOMIC_RELAXED, __HIP_MEMORY_SCOPE_AGENT); }
__device__ __forceinline__ unsigned xb_add(unsigned* p, unsigned v) { return __hip_atomic_fetch_add(p, v, __ATOMIC_RELAXED, __HIP_MEMORY_SCOPE_AGENT); }
__device__ __forceinline__ unsigned xb_xcc_id() { return (unsigned)__builtin_amdgcn_s_getreg((3 << 11) | 20) & 0xFu; }
#define XB_SPIN(cond, bar) do { unsigned _sp = 0; while (cond) { __builtin_amdgcn_s_sleep(1); \
    if ((++_sp & 255u) == 0u) { if (xb_ld(&(bar)[XB_TMO])) break; if (_sp > XB_SPIN_CAP) { atomicAdd(&(bar)[XB_TMO], 1u); break; } } } } while (0)

struct XcdBarrier {
    unsigned* bar; unsigned x;
    volatile LAS unsigned* st;
};

__device__ __forceinline__ XcdBarrier xcd_barrier_post(unsigned* bar, volatile LAS unsigned* st) {
    XcdBarrier b; b.bar = bar; b.x = xb_xcc_id(); b.st = st;
    if (threadIdx.x == 0) (void)xb_add(&bar[XB_XCNT(b.x)], 1u);
    return b;
}
__device__ __forceinline__ void xcd_barrier_complete(unsigned* bar, unsigned x, unsigned& nloc, unsigned& nx) {
    const unsigned G = gridDim.x * gridDim.y * gridDim.z;
    unsigned sum, cnt, mine, sp = 0u;
    for (;;) {
        sum = 0u; cnt = 0u; mine = 0u;
#pragma unroll
        for (unsigned j = 0; j < 16; ++j) { const unsigned c = xb_ld(&bar[XB_XCNT(j)]); sum += c; cnt += (c > 0u) ? 1u : 0u; mine = (j == x) ? c : mine; }
        if (sum == G) break;
        __builtin_amdgcn_s_sleep(1);
        if ((++sp & 255u) == 0u) { if (xb_ld(&bar[XB_TMO])) break; if (sp > XB_SPIN_CAP) { atomicAdd(&bar[XB_TMO], 1u); break; } }
    }
    nloc = mine > 0u ? mine : 1u; nx = cnt > 0u ? cnt : 1u;
}

__device__ __forceinline__ void xcd_barrier(const XcdBarrier& b) {
    asm volatile("s_waitcnt vmcnt(0)" ::: "memory");
    __syncthreads();
    if (threadIdx.x == 0) {
        unsigned* bar = b.bar;
        __builtin_amdgcn_s_waitcnt(0);
        unsigned nloc = b.st[0], nx = b.st[1];
        if (nloc == 0u) { xcd_barrier_complete(bar, b.x, nloc, nx); b.st[0] = nloc; b.st[1] = nx; }
        const unsigned old = xb_add(&bar[XB_XSUB(b.x)], 1u);
        const unsigned gen = old / nloc;
        if (old + 1u == (gen + 1u) * nloc) {
            __builtin_amdgcn_fence(__ATOMIC_RELEASE, "agent");
            asm volatile("s_waitcnt vmcnt(0)" ::: "memory");
            const unsigned og = xb_add(&bar[XB_TOP], 1u);
            const unsigned tg = og / nx;
            if (og + 1u == (tg + 1u) * nx) xb_add(&bar[XB_TOPGEN], 1u);
            else XB_SPIN(xb_ld(&bar[XB_TOPGEN]) == tg, bar);
            __builtin_amdgcn_fence(__ATOMIC_ACQUIRE, "agent");
            xb_add(&bar[XB_XGEN(b.x)], 1u);
            asm volatile("s_waitcnt vmcnt(0)" ::: "memory");
        } else {
            XB_SPIN(xb_ld(&bar[XB_XGEN(b.x)]) == gen, bar);
            __builtin_amdgcn_fence(__ATOMIC_ACQUIRE, "agent");
            asm volatile("s_waitcnt vmcnt(0)" ::: "memory");
        }
    }
    __syncthreads();
}

constexpr int D = 1024, SEQ = 8192, NB = 2, MP = NB * SEQ, SB = 128, ST = 8, MS = SB * ST, M = MP + MS;
constexpr int NQKV = 1536, FF = 4096, NKV = 4, HD = 64, KVW = NKV * HD, NG = 64, GC = 16, NS = 64;
constexpr int CH = 256, NCH = SEQ / CH;
constexpr int NPHASE = 22;
constexpr size_t O_KP = 17825792, O_VP = 17956864, O_HRP = 18087936, O_HIP = 18104320, O_KS = 18120704, O_VS = 26509312, O_HRS = 34897920, O_HIS = 35946496, O_END = 36995072;
constexpr size_t MiB = 1u << 20;
constexpr size_t WS_CTL = 0, CTL_ZERO_BYTES = 64 * 1024;
constexpr size_t WS_SSP = 1 * MiB;
constexpr size_t WS_TAB = 5 * MiB + 512 * 1024;
constexpr size_t WS_HS = 6 * MiB;
constexpr size_t WS_WQKV = 8 * MiB, WS_WO = 14 * MiB, WS_WGLU = 18 * MiB, WS_WUP = 26 * MiB, WS_WDN = 58 * MiB;
constexpr size_t WS_XB = 90 * MiB;
constexpr size_t WS_H = 124 * MiB;
constexpr size_t WS_Q = 124 * MiB, WS_K = 158 * MiB, WS_V = 167 * MiB, WS_O = 176 * MiB;
constexpr size_t WS_BT = 260 * MiB, WS_CT = 261 * MiB;
constexpr size_t WS_END = 262 * MiB;
constexpr int CW_BAR = 4096;
static_assert((CW_BAR + XCD_BAR_WORDS) * 4 <= (int)CTL_ZERO_BYTES, "barrier words inside the memset region");
constexpr int RING_BYTES = 131072, XA_BYTES = 4096, LDSCTL_OFF = RING_BYTES + XA_BYTES, MISC_OFF = LDSCTL_OFF + 320, LDS_BYTES = 147456;

__device__ __forceinline__ float wave_sum(float v) {
#pragma unroll
    for (int o = 1; o < 64; o <<= 1) v += __shfl_xor(v, o);
    return v;
}
__device__ __forceinline__ float wave_max(float v) {
#pragma unroll
    for (int o = 1; o < 64; o <<= 1) v = fmaxf(v, __shfl_xor(v, o));
    return v;
}
__device__ __forceinline__ float bf_lo(unsigned u) { return __uint_as_float(u << 16); }
__device__ __forceinline__ float bf_hi(unsigned u) { return __uint_as_float(u & 0xffff0000u); }

namespace pg8 {
constexpr int XMP = 16384;
template <int NL>
__device__ __forceinline__ float row_rinv(const float* ssp, int row, int np, int fq) {
    const float* p = ssp + (size_t)row * 64 + (np >> 2) * fq;
    f32x4 v[NL];
#pragma unroll
    for (int i = 0; i < NL; ++i) v[i] = *(const f32x4*)(p + 4 * i);
    float s = 0.f, s2 = 0.f;
#pragma unroll
    for (int i = 0; i < NL / 2; ++i) { s += (v[i][0] + v[i][1]) + (v[i][2] + v[i][3]); s2 += (v[NL / 2 + i][0] + v[NL / 2 + i][1]) + (v[NL / 2 + i][2] + v[NL / 2 + i][3]); }
    s += (np == 16 * NL) ? s2 : 0.f;
    s += __shfl_xor(s, 16); s += __shfl_xor(s, 32);
    return rsqrtf(s * (1.0f / 1024.0f) + 1e-6f);
}
__device__ __forceinline__ u32x4 pack8(const f32x4 a, const f32x4 b) { u32x4 w; w.x = cvt_pk_bf16(a[0], a[1]); w.y = cvt_pk_bf16(a[2], a[3]); w.z = cvt_pk_bf16(b[0], b[1]); w.w = cvt_pk_bf16(b[2], b[3]); return w; }
typedef unsigned u32x2 __attribute__((ext_vector_type(2)));
__device__ __forceinline__ u32x2 pack4(const f32x4 a) { u32x2 w; w.x = cvt_pk_bf16(a[0], a[1]); w.y = cvt_pk_bf16(a[2], a[3]); return w; }
__device__ __forceinline__ float sumsq4(const f32x4 v) { return (v[0] * v[0] + v[1] * v[1]) + (v[2] * v[2] + v[3] * v[3]); }

struct EpiQKV {
    static constexpr bool PERM = true, AFTER_DRAIN = false;
    bf16_t *Q, *K, *V; const float* ssp; int np, nps; float *kp, *vp, *ks, *vs;
    __device__ __forceinline__ void operator()(const f32x4 (&acc)[2][2][4][2], const f32x4 (&accx)[2], const Unit& u, int wr, int wc, int fr, int fq) const {
        const int rowb = u.pm * BM + wr * 64 + fr, pn = u.pn;
        float rr[2][4];
#pragma unroll
        for (int ai = 0; ai < 2; ++ai)
#pragma unroll
            for (int m = 0; m < 4; ++m) rr[ai][m] = row_rinv<2>(ssp, rowb + ai * HALF + m * 16, np, fq);
        const float rx = row_rinv<4>(ssp, XMP + u.pm * 16 + fr, nps, fq);
#pragma unroll
        for (int ai = 0; ai < 2; ++ai)
#pragma unroll
            for (int m = 0; m < 4; ++m) {
                const int row = rowb + ai * HALF + m * 16;
                const float r = rr[ai][m];
#pragma unroll
                for (int bj = 0; bj < 2; ++bj) {
                    const f32x4 v0 = acc[ai][bj][m][0] * r, v1 = acc[ai][bj][m][1] * r;
                    const int cl = bj * HALF + wc * 32 + 8 * fq;
                    const u32x4 w = pack8(v0, v1);
                    if (pn < 4) { *(u32x4*)(Q + (size_t)row * 1024 + pn * 256 + cl) = w; }
                    else {
                        bf16_t* B = (pn == 4) ? K : V;
                        *(u32x4*)(B + (size_t)row * 256 + cl) = w;
                        const int t = row & 8191;
                        if (t >= 8064) { float* o = ((pn == 4) ? kp : vp) + ((size_t)(row >> 13) * 128 + (t - 8064)) * 256 + cl; *(f32x4*)o = v0; *(f32x4*)(o + 4) = v1; }
                    }
                }
            }
        {
            const int xrow = u.pm * 16 + fr, row = XMP + xrow;
            const float r = rx;
#pragma unroll
            for (int bj = 0; bj < 2; ++bj) {
                const f32x4 v = accx[bj] * r;
                const int cl = bj * HALF + wc * 32 + 8 * fq + 4 * wr;
                const u32x2 w = pack4(v);
                if (pn < 4) { *(u32x2*)(Q + (size_t)row * 1024 + pn * 256 + cl) = w; }
                else {
                    bf16_t* B = (pn == 4) ? K : V;
                    *(u32x2*)(B + (size_t)row * 256 + cl) = w;
                    float* o = ((pn == 4) ? ks : vs) + ((size_t)(xrow >> 3) * 128 + 120 + (xrow & 7)) * 256 + cl; *(f32x4*)o = v;
                }
            }
        }
    }
};
__device__ __forceinline__ void unpack8(const u32x4 w, f32x4& a, f32x4& b) {
    a[0] = __uint_as_float(w.x << 16); a[1] = __uint_as_float(w.x & 0xffff0000u); a[2] = __uint_as_float(w.y << 16); a[3] = __uint_as_float(w.y & 0xffff0000u);
    b[0] = __uint_as_float(w.z << 16); b[1] = __uint_as_float(w.z & 0xffff0000u); b[2] = __uint_as_float(w.w << 16); b[3] = __uint_as_float(w.w & 0xffff0000u); }
__device__ __forceinline__ f32x4 unpack4(const u32x2 w) { f32x4 a; a[0] = __uint_as_float(w.x << 16); a[1] = __uint_as_float(w.x & 0xffff0000u); a[2] = __uint_as_float(w.y << 16); a[3] = __uint_as_float(w.y & 0xffff0000u); return a; }
struct EpiRes {
    static constexpr bool PERM = true, AFTER_DRAIN = false;
    bf16_t* XB; float* ssp;
    __device__ __forceinline__ void operator()(const f32x4 (&acc)[2][2][4][2], const f32x4 (&accx)[2], const Unit& u, int wr, int wc, int fr, int fq) const {
        const int rowb = u.pm * BM + wr * 64 + fr, pn = u.pn;
        const int colb = pn * 256 + wc * 32 + 8 * fq;
        const int xrow = u.pm * 16 + fr;
        bf16_t* xbx = XB + (size_t)(XMP + xrow) * 1024 + colb + 4 * wr;
        u32x2 ox[2];
#pragma unroll
        for (int bj = 0; bj < 2; ++bj) ox[bj] = *(const u32x2*)(xbx + bj * HALF);
#pragma unroll
        for (int am = 0; am < 8; am += 4) {
            u32x4 o[4][2];
#pragma unroll
            for (int h = 0; h < 4; ++h)
#pragma unroll
                for (int bj = 0; bj < 2; ++bj) o[h][bj] = *(const u32x4*)(XB + (size_t)(rowb + ((am + h) >> 2) * HALF + ((am + h) & 3) * 16) * 1024 + colb + bj * HALF);
#pragma unroll
            for (int h = 0; h < 4; ++h) {
                const int ai = (am + h) >> 2, m = (am + h) & 3;
                const int row = rowb + ai * HALF + m * 16;
                float ss = 0.f;
#pragma unroll
                for (int bj = 0; bj < 2; ++bj) {
                    f32x4 o0, o1; unpack8(o[h][bj], o0, o1);
                    const f32x4 v0 = acc[ai][bj][m][0] + o0, v1 = acc[ai][bj][m][1] + o1;
                    *(u32x4*)(XB + (size_t)row * 1024 + colb + bj * HALF) = pack8(v0, v1);
                    ss += sumsq4(v0) + sumsq4(v1);
                }
                ss += __shfl_xor(ss, 16); ss += __shfl_xor(ss, 32);
                if (fq == 0) ssp[(size_t)row * 64 + pn * 4 + wc] = ss;
            }
            asm volatile("" ::: "memory");
        }
        {
            const int row = XMP + xrow;
            float ss = 0.f;
#pragma unroll
            for (int bj = 0; bj < 2; ++bj) {
                const f32x4 v = accx[bj] + unpack4(ox[bj]);
                *(u32x2*)(xbx + bj * HALF) = pack4(v);
                ss += sumsq4(v);
            }
            ss += __shfl_xor(ss, 16); ss += __shfl_xor(ss, 32);
            if (fq == 0) ssp[(size_t)row * 64 + (pn * 4 + wc) * 2 + wr] = ss;
        }
    }
};
struct EpiGlu {
    static constexpr bool PERM = true, AFTER_DRAIN = false;
    bf16_t* XB; float* ssp;
    __device__ __forceinline__ void operator()(const f32x4 (&acc)[2][2][4][2], const f32x4 (&accx)[2], const Unit& u, int wr, int wc, int fr, int fq) const {
        const int rowb = u.pm * BM + wr * 64 + fr, pn = u.pn;
        const int col = pn * 128 + wc * 32 + 8 * fq;
        const int xrow = u.pm * 16 + fr;
        bf16_t* xbx = XB + (size_t)(XMP + xrow) * 1024 + col + 4 * wr;
        const u32x2 ox = *(const u32x2*)xbx;
#pragma unroll
        for (int am = 0; am < 8; am += 4) {
            u32x4 o[4];
#pragma unroll
            for (int h = 0; h < 4; ++h) o[h] = *(const u32x4*)(XB + (size_t)(rowb + ((am + h) >> 2) * HALF + ((am + h) & 3) * 16) * 1024 + col);
#pragma unroll
            for (int h = 0; h < 4; ++h) {
                const int ai = (am + h) >> 2, m = (am + h) & 3;
                const int row = rowb + ai * HALF + m * 16;
                f32x4 v0, v1; unpack8(o[h], v0, v1);
#pragma unroll
                for (int e = 0; e < 4; ++e) {
                    v0[e] += acc[ai][0][m][0][e] * (1.0f / (1.0f + __expf(-acc[ai][1][m][0][e])));
                    v1[e] += acc[ai][0][m][1][e] * (1.0f / (1.0f + __expf(-acc[ai][1][m][1][e])));
                }
                *(u32x4*)(XB + (size_t)row * 1024 + col) = pack8(v0, v1);
                float ss = sumsq4(v0) + sumsq4(v1);
                ss += __shfl_xor(ss, 16); ss += __shfl_xor(ss, 32);
                if (fq == 0) ssp[(size_t)row * 64 + pn * 4 + wc] = ss;
            }
            asm volatile("" ::: "memory");
        }
        {
            const int row = XMP + xrow;
            f32x4 v = unpack4(ox);
#pragma unroll
            for (int e = 0; e < 4; ++e) v[e] += accx[0][e] * (1.0f / (1.0f + __expf(-accx[1][e])));
            *(u32x2*)xbx = pack4(v);
            float ss = sumsq4(v);
            ss += __shfl_xor(ss, 16); ss += __shfl_xor(ss, 32);
            if (fq == 0) ssp[(size_t)row * 64 + (pn * 4 + wc) * 2 + wr] = ss;
        }
    }
};
struct EpiUp {
    static constexpr bool PERM = true, AFTER_DRAIN = false;
    bf16_t* H; const float* ssp; int np, nps;
    __device__ __forceinline__ void operator()(const f32x4 (&acc)[2][2][4][2], const f32x4 (&accx)[2], const Unit& u, int wr, int wc, int fr, int fq) const {
        const int rowb = u.pm * BM + wr * 64 + fr, pn = u.pn;
        float rr[2][4];
#pragma unroll
        for (int ai = 0; ai < 2; ++ai)
#pragma unroll
            for (int m = 0; m < 4; ++m) rr[ai][m] = row_rinv<2>(ssp, rowb + ai * HALF + m * 16, np, fq);
        const float rx = row_rinv<4>(ssp, XMP + u.pm * 16 + fr, nps, fq);
#pragma unroll
        for (int ai = 0; ai < 2; ++ai)
#pragma unroll
            for (int m = 0; m < 4; ++m) {
                const int row = rowb + ai * HALF + m * 16;
                const float r = rr[ai][m];
#pragma unroll
                for (int bj = 0; bj < 2; ++bj) {
                    f32x4 v0 = acc[ai][bj][m][0] * r, v1 = acc[ai][bj][m][1] * r;
#pragma unroll
                    for (int e = 0; e < 4; ++e) { const float a = fmaxf(v0[e], 0.f), b = fmaxf(v1[e], 0.f); v0[e] = a * a; v1[e] = b * b; }
                    *(u32x4*)(H + (size_t)row * 4096 + pn * 256 + bj * HALF + wc * 32 + 8 * fq) = pack8(v0, v1);
                }
            }
        {
            const int xrow = u.pm * 16 + fr, row = XMP + xrow;
            const float r = rx;
#pragma unroll
            for (int bj = 0; bj < 2; ++bj) {
                f32x4 v = accx[bj] * r;
#pragma unroll
                for (int e = 0; e < 4; ++e) { const float a = fmaxf(v[e], 0.f); v[e] = a * a; }
                *(u32x2*)(H + (size_t)row * 4096 + pn * 256 + bj * HALF + wc * 32 + 8 * fq + 4 * wr) = pack4(v);
            }
        }
    }
};

template <class Epi, class Sched, int KREP = 1, int EREP = 1>
__device__ __forceinline__ void gemm_phase_x(PG8_LAS unsigned char* lds, const Gemm g, const Sched& S, const Epi& E) {
    int tid_ = threadIdx.x; asm volatile("" : "+v"(tid_));
    const int tid = tid_, wid = __builtin_amdgcn_readfirstlane(tid >> 6), lane = tid & 63, wr = wid >> 2, wc = wid & 3, fr = lane & 15, fq = lane >> 4;
    const int K = g.K, nt = K / BK;
    unsigned voffA[2], voffB[2], voffX;
#pragma unroll
    for (int i = 0; i < 2; ++i) { int R, C; stage_rc(tid * 16 + i * 8192, R, C); const int Rb = Epi::PERM ? ((R & ~31) + perm32(R & 31)) : R;
        voffA[i] = (unsigned)(R * K + C) * 2u; voffB[i] = (unsigned)(Rb * K + C) * 2u; }
    { int R, C; const int p = wid * 256 + lane * 4; stage_rc(p & ~15, R, C); voffX = (unsigned)(R * K + C) * 2u + (unsigned)(p & 15); }
    const size_t kstep = (size_t)(BK * 2);
    const size_t hstep = (size_t)HALF * K * 2;
    const size_t tstep = 2 * hstep;
    const size_t xstep = (size_t)16 * K * 2;
    const unsigned ldsw = (unsigned)wid * 1024u, ldsx = (unsigned)wid * 256u;
    const int aoff = lds_byte(wr * 64 + fr, fq * 8), boff = lds_byte(wc * 32 + fr, fq * 8), xoff = lds_byte(fr, fq * 8);
#define PG8_SA(b, h) (((b) * 2 + (h)) * HTB)
#define PG8_SB(b, h) ((4 + (b) * 2 + (h)) * HTB)
#define PG8_XA(b) (STAGE_BYTES + (b) * 2048)
#define PG8_STAGE(bufoff, gbase, voff) do { _Pragma("unroll") for (int _i = 0; _i < 2; ++_i) \
        __builtin_amdgcn_global_load_lds((const unsigned*)((const char*)(gbase) + (voff)[_i]), (PG8_LAS unsigned*)(lds + (bufoff) + ldsw + _i * 8192), 16, 0, 0); } while (0)
#define PG8_STAGEX(b, gbase) __builtin_amdgcn_global_load_lds((const unsigned*)((const char*)(gbase) + voffX), (PG8_LAS unsigned*)(lds + PG8_XA(b) + ldsx), 4, 0, 0)
#define PG8_LDA(dst, b, h) do { _Pragma("unroll") for (int m = 0; m < 4; ++m) _Pragma("unroll") for (int k = 0; k < 2; ++k) dst[m][k] = *(const PG8_LAS bf16x8*)(lds + PG8_SA(b, h) + aoff + m * 2048 + k * 1024); } while (0)
#define PG8_LDB(dst, b, h) do { _Pragma("unroll") for (int n = 0; n < 2; ++n) _Pragma("unroll") for (int k = 0; k < 2; ++k) dst[n][k] = *(const PG8_LAS bf16x8*)(lds + PG8_SB(b, h) + boff + n * 2048 + k * 1024); } while (0)
#define PG8_LDX(dst, b) do { _Pragma("unroll") for (int k = 0; k < 2; ++k) dst[k] = *(const PG8_LAS bf16x8*)(lds + PG8_XA(b) + xoff + k * 1024); } while (0)
#define PG8_MMA(ai, bj, At, Bt) do { __builtin_amdgcn_s_setprio(1); _Pragma("unroll") for (int m = 0; m < 4; ++m) _Pragma("unroll") for (int n = 0; n < 2; ++n) _Pragma("unroll") for (int k = 0; k < 2; ++k) \
        acc[ai][bj][m][n] = __builtin_amdgcn_mfma_f32_16x16x32_bf16(Bt[n][k], At[m][k], acc[ai][bj][m][n], 0, 0, 0); __builtin_amdgcn_s_setprio(0); } while (0)
#define PG8_XMMA() do { if (wr == 0) { _Pragma("unroll") for (int k = 0; k < 2; ++k) { accx[0] = __builtin_amdgcn_mfma_f32_16x16x32_bf16(B0[0][k], Ax[k], accx[0], 0, 0, 0); accx[1] = __builtin_amdgcn_mfma_f32_16x16x32_bf16(B1[0][k], Ax[k], accx[1], 0, 0, 0); } } \
        else { _Pragma("unroll") for (int k = 0; k < 2; ++k) { accx[0] = __builtin_amdgcn_mfma_f32_16x16x32_bf16(B0[1][k], Ax[k], accx[0], 0, 0, 0); accx[1] = __builtin_amdgcn_mfma_f32_16x16x32_bf16(B1[1][k], Ax[k], accx[1], 0, 0, 0); } } } while (0)
#define PG8_WAIT_V(n) asm volatile("s_waitcnt vmcnt(" #n ")" ::: "memory")
#define PG8_WAIT_L(n) asm volatile("s_waitcnt lgkmcnt(" #n ")" ::: "memory")
#define PG8_BAR __builtin_amdgcn_s_barrier()
#define PG8_SCHED __builtin_amdgcn_sched_barrier(0)
    Unit cur, nxt; int ui = 0;
    if (!S.next(0, cur)) return;
    f32x4 acc[2][2][4][2]; f32x4 accx[2];
#pragma unroll
    for (int a = 0; a < 2; ++a)
#pragma unroll
        for (int b = 0; b < 2; ++b)
#pragma unroll
            for (int m = 0; m < 4; ++m)
#pragma unroll
                for (int n = 0; n < 2; ++n) acc[a][b][m][n] = (f32x4){0.f, 0.f, 0.f, 0.f};
    accx[0] = (f32x4){0.f, 0.f, 0.f, 0.f}; accx[1] = (f32x4){0.f, 0.f, 0.f, 0.f};
    bf16x8 At[4][2], B0[2][2], B1[2][2], Ax[2];
    const char* const xbase = (const char*)g.A + (size_t)XMP * K * 2;
    const char* cA = (const char*)g.A + (size_t)cur.pm * tstep; const char* cB = (const char*)g.Bt + (size_t)cur.pn * tstep; const char* cX = xbase + (size_t)cur.pm * xstep;
    S.a_ready(cur);
    PG8_STAGE(PG8_SB(0, 0), cB, voffB); PG8_STAGE(PG8_SB(0, 1), cB + hstep, voffB); PG8_STAGE(PG8_SA(0, 0), cA, voffA); PG8_STAGEX(0, cX); PG8_STAGE(PG8_SA(0, 1), cA + hstep, voffA);
    if (wr == 1) PG8_BAR;
    PG8_WAIT_V(2); PG8_BAR;
    PG8_STAGE(PG8_SB(1, 0), cB + kstep, voffB); PG8_STAGE(PG8_SA(1, 0), cA + kstep, voffA); PG8_STAGE(PG8_SB(1, 1), cB + hstep + kstep, voffB); PG8_STAGEX(1, cX + kstep);
    PG8_WAIT_V(7); PG8_BAR;
    for (;;) {
        const bool has_next = S.next(ui + 1, nxt);
        const char* nA = has_next ? (const char*)g.A + (size_t)nxt.pm * tstep : cA; const char* nB = has_next ? (const char*)g.Bt + (size_t)nxt.pn * tstep : cB; const char* nX = has_next ? xbase + (size_t)nxt.pm * xstep : cX;
        for (int kr = 0; kr < KREP; ++kr) {
        const bool fin = (kr == KREP - 1);
        if (KREP > 1 && kr > 0) {
#pragma unroll
            for (int a = 0; a < 2; ++a)
#pragma unroll
                for (int b = 0; b < 2; ++b)
#pragma unroll
                    for (int m = 0; m < 4; ++m)
#pragma unroll
                        for (int n = 0; n < 2; ++n) acc[a][b][m][n] = (f32x4){0.f, 0.f, 0.f, 0.f};
            accx[0] = (f32x4){0.f, 0.f, 0.f, 0.f}; accx[1] = (f32x4){0.f, 0.f, 0.f, 0.f};
        }
        for (int t = 0; t < nt; t += 2) {
            const bool last = (t == nt - 2);
            const char* a1 = cA + (size_t)(t + 1) * kstep;
            const char* a2 = last ? (fin ? nA : cA) : cA + (size_t)(t + 2) * kstep; const char* b2 = last ? (fin ? nB : cB) : cB + (size_t)(t + 2) * kstep; const char* x2 = last ? (fin ? nX : cX) : cX + (size_t)(t + 2) * kstep;
            const char* a3 = a2 + kstep; const char* b3 = b2 + kstep; const char* x3 = x2 + kstep;
            if (last && has_next && fin) S.a_ready(nxt);
            PG8_LDB(B0, 0, 0); PG8_LDB(B1, 0, 1); PG8_SCHED; PG8_LDA(At, 0, 0); PG8_LDX(Ax, 0); PG8_STAGE(PG8_SA(1, 1), a1 + hstep, voffA);
            PG8_WAIT_V(9); PG8_WAIT_L(0); PG8_BAR; PG8_MMA(0, 0, At, B0); PG8_MMA(0, 1, At, B1); PG8_XMMA(); PG8_BAR; PG8_SCHED;
            PG8_LDA(At, 0, 1); PG8_STAGE(PG8_SB(0, 0), b2, voffB); PG8_STAGE(PG8_SB(0, 1), b2 + hstep, voffB); PG8_STAGE(PG8_SA(0, 0), a2, voffA); PG8_STAGEX(0, x2);
            PG8_WAIT_V(9); PG8_WAIT_L(0); PG8_BAR; PG8_MMA(1, 0, At, B0); PG8_MMA(1, 1, At, B1); PG8_BAR; PG8_SCHED;
            PG8_LDB(B0, 1, 0); PG8_LDB(B1, 1, 1); PG8_SCHED; PG8_LDA(At, 1, 0); PG8_LDX(Ax, 1); PG8_STAGE(PG8_SA(0, 1), a2 + hstep, voffA);
            PG8_WAIT_V(9); PG8_WAIT_L(0); PG8_BAR; PG8_MMA(0, 0, At, B0); PG8_MMA(0, 1, At, B1); PG8_XMMA(); PG8_BAR; PG8_SCHED;
            PG8_LDA(At, 1, 1); PG8_STAGE(PG8_SB(1, 0), b3, voffB); PG8_STAGE(PG8_SB(1, 1), b3 + hstep, voffB); PG8_STAGE(PG8_SA(1, 0), a3, voffA); PG8_STAGEX(1, x3);
            PG8_WAIT_V(9); PG8_WAIT_L(0); PG8_BAR; PG8_MMA(1, 0, At, B0); PG8_MMA(1, 1, At, B1); PG8_BAR; PG8_SCHED;
        }
        }
        if (wr == 0) PG8_BAR;
        { int fr_ = fr, fq_ = fq; asm volatile("" : "+v"(fr_), "+v"(fq_));
          for (int er = 0; er < EREP; ++er) E(acc, accx, cur, wr, wc, fr_, fq_); } S.done(cur);
        if (!has_next) break;
#pragma unroll
        for (int a = 0; a < 2; ++a)
#pragma unroll
            for (int b = 0; b < 2; ++b)
#pragma unroll
                for (int m = 0; m < 4; ++m)
#pragma unroll
                    for (int n = 0; n < 2; ++n) acc[a][b][m][n] = (f32x4){0.f, 0.f, 0.f, 0.f};
        accx[0] = (f32x4){0.f, 0.f, 0.f, 0.f}; accx[1] = (f32x4){0.f, 0.f, 0.f, 0.f};
        cur = nxt; cA = nA; cB = nB; cX = nX; ++ui;
        if (wr == 1) PG8_BAR;
    }
    PG8_WAIT_V(0);
    PG8_BAR;
#undef PG8_SA
#undef PG8_SB
#undef PG8_XA
#undef PG8_STAGE
#undef PG8_STAGEX
#undef PG8_LDA
#undef PG8_LDB
#undef PG8_LDX
#undef PG8_MMA
#undef PG8_XMMA
#undef PG8_WAIT_V
#undef PG8_WAIT_L
#undef PG8_BAR
#undef PG8_SCHED
}
}

__device__ __forceinline__ void p0_transpose_item(const float* W, int K, int N, const float* gain, bf16* WT, int glu, LAS float* scr, int item, int lane) {
    const int nblk = N / 32, kb = item / nblk, nb = item % nblk, k0 = 64 * kb, n0 = 32 * nb;
#pragma unroll 8
    for (int i = 0; i < 32; ++i) { const int kk = 2 * i + (lane >> 5); float w = W[(size_t)(k0 + kk) * N + n0 + (lane & 31)]; if (gain) w *= gain[k0 + kk]; scr[kk * 33 + (lane & 31)] = w; }
    LDS_WAIT(); asm volatile("" ::: "memory");
    int drow0 = n0; if (glu) { const int bj = n0 / 1024, rem = n0 % 1024; drow0 = (rem / 128) * 256 + bj * 128 + (rem % 128); }
    const int c = lane & 7;
#pragma unroll
    for (int j = 0; j < 4; ++j) { const int n = (lane >> 3) + 8 * j; const LAS float* s = scr + (8 * c) * 33 + n;
        v4u o; o.x = pk2(s[0 * 33], s[1 * 33]); o.y = pk2(s[2 * 33], s[3 * 33]); o.z = pk2(s[4 * 33], s[5 * 33]); o.w = pk2(s[6 * 33], s[7 * 33]);
        *(GAS v4u*)(WT + (size_t)(drow0 + n) * K + k0 + 8 * c) = o; }
    LDS_WAIT(); asm volatile("" ::: "memory");
}

__device__ __forceinline__ void sincos_rr(float x, float& s, float& c) {
    const float q = rintf(x * 0.63661977236758f);
    float r = fmaf(-q, 1.57079637050629f, x); r = fmaf(-q, -4.37113882867379e-8f, r);
    const float r2 = r * r;
    const float sp = r + r * r2 * (-1.6666667163e-1f + r2 * (8.3333337680e-3f + r2 * (-1.9841270114e-4f + r2 * 2.7557314297e-6f)));
    const float cp = 1.0f + r2 * (-0.5f + r2 * (4.1666667908e-2f + r2 * (-1.3888889225e-3f + r2 * (2.4801587642e-5f + r2 * -2.7557314297e-7f))));
    const int qi = (int)q & 3;
    s = (qi == 0) ? sp : (qi == 1) ? cp : (qi == 2) ? -sp : -cp;
    c = (qi == 0) ? cp : (qi == 1) ? -sp : (qi == 2) ? -cp : sp;
}

typedef float f32x16 __attribute__((ext_vector_type(16)));
typedef unsigned u32x2 __attribute__((ext_vector_type(2)));
__device__ __forceinline__ void ssm_abar_calc(const float* A_re, const float* A_im, const float* log_dt, int g, int n, float& abr, float& abi, float& cfr, float& cfi) {
    const float dt = expf(log_dt[g]);
    const float ar = A_re[g * 64 + n], ai = A_im[g * 64 + n];
    const float mag = expf(dt * ar); float sn, cs; sincos_rr(dt * ai, sn, cs);
    abr = mag * cs; abi = mag * sn;
    const float den = ar * ar + ai * ai, nr = abr - 1.0f;
    cfr = (nr * ar + abi * ai) / den; cfi = (abi * ar - nr * ai) / den;
}
__device__ __forceinline__ float gelu_tanh(float y) {
    const float z = 0.7978845608028654f * (y + 0.044715f * y * y * y);
    return y / (1.0f + __expf(-2.0f * z));
}
struct SsmT { const bf16* BT; const bf16* CT; const float* tab; const float* Dk; const float* gain; };
template <int MODE>
__device__ __forceinline__ void ssm_mfma_unit(LAS unsigned char* wl, int lane, int g, const SsmT& T, const bf16* XB, const float* XR, const float* ssp, int np, int row0, int nblk,
                                              float (&st)[4]  , bf16* Gout, const float* h0r, const float* h0i, float* hor, float* hoi  , int b0) {
    const int r32 = lane & 31, hi5 = lane >> 5, c16 = lane & 15, kq = lane >> 4;
    LAS float* rv = (LAS float*)(wl + 8704);
    pg8::bf16x8 bt[4], ct[4];
#pragma unroll
    for (int tn = 0; tn < 4; ++tn) bt[tn] = *(const pg8::bf16x8*)(T.BT + (size_t)(tn * 32 + r32) * 16 + 8 * hi5);
    if (MODE != 0) {
#pragma unroll
        for (int ks = 0; ks < 4; ++ks) ct[ks] = *(const pg8::bf16x8*)(T.CT + (size_t)c16 * 128 + 32 * ks + 8 * kq);
    }
    float ar[2], ai[2];
    { const f32x4 t0 = *(const f32x4*)(T.tab + (size_t)r32 * 4), t1 = *(const f32x4*)(T.tab + (size_t)(32 + r32) * 4); ar[0] = t0[0]; ai[0] = t0[1]; ar[1] = t1[0]; ai[1] = t1[1]; }
    f32x4 Dg = {0.f, 0.f, 0.f, 0.f};
    if (MODE != 0) { const f32x4 dv = *(const f32x4*)(T.Dk + 4 * kq), gv = *(const f32x4*)(T.gain + 4 * kq); Dg = dv * gv; }
    constexpr int NSV = (MODE == 2) ? 8 : 4;
    pg8::bf16x8 xa_n = *(const pg8::bf16x8*)(XB + (size_t)(row0 + r32) * 1024 + g * 16 + 8 * hi5);
    f32x4 sv_n[NSV];
#pragma unroll
    for (int i4 = 0; i4 < NSV; ++i4) sv_n[i4] = *(const f32x4*)(ssp + (size_t)(row0 + r32) * 64 + 4 * i4);
    u32x2 xr_n[2] = {{0u, 0u}, {0u, 0u}};
    if (MODE != 0) {
#pragma unroll
        for (int tt = 0; tt < 2; ++tt) xr_n[tt] = *(const u32x2*)(XB + (size_t)(row0 + 16 * tt + c16) * 1024 + g * 16 + 4 * kq);
    }
    for (int blk = 0; blk < nblk; ++blk) {
        const int rowb = row0 + 32 * blk;
        const pg8::bf16x8 xa = xa_n; f32x4 sv[NSV]; u32x2 xr_c[2];
#pragma unroll
        for (int i4 = 0; i4 < NSV; ++i4) sv[i4] = sv_n[i4];
        xr_c[0] = xr_n[0]; xr_c[1] = xr_n[1];
        if (blk + 1 < nblk) {
            const int rown = rowb + 32;
            xa_n = *(const pg8::bf16x8*)(XB + (size_t)(rown + r32) * 1024 + g * 16 + 8 * hi5);
#pragma unroll
            for (int i4 = 0; i4 < NSV; ++i4) sv_n[i4] = *(const f32x4*)(ssp + (size_t)(rown + r32) * 64 + 4 * i4);
            if (MODE != 0) {
#pragma unroll
                for (int tt = 0; tt < 2; ++tt) xr_n[tt] = *(const u32x2*)(XB + (size_t)(rown + 16 * tt + c16) * 1024 + g * 16 + 4 * kq);
            }
        }
        {
            float ss = 0.f;
#pragma unroll
            for (int i4 = 0; i4 < NSV; ++i4) ss += (sv[i4][0] + sv[i4][1]) + (sv[i4][2] + sv[i4][3]);
            if (lane < 32) rv[lane] = rsqrtf(ss * (1.0f / 1024.0f) + 1e-6f);
        }
        f32x16 IN[4];
#pragma unroll
        for (int tn = 0; tn < 4; ++tn) { const f32x16 z = {0.f, 0.f, 0.f, 0.f, 0.f, 0.f, 0.f, 0.f, 0.f, 0.f, 0.f, 0.f, 0.f, 0.f, 0.f, 0.f}; IN[tn] = __builtin_amdgcn_mfma_f32_32x32x16_bf16(xa, bt[tn], z, 0, 0, 0); }
        LDS_WAIT(); asm volatile("" ::: "memory");
        {
            f32x4 rq[4];
#pragma unroll
            for (int Q = 0; Q < 4; ++Q) rq[Q] = *(const LAS f32x4*)(rv + 8 * Q + 4 * hi5);
#pragma unroll
            for (int tn = 0; tn < 4; ++tn)
#pragma unroll
                for (int r = 0; r < 16; ++r) IN[tn][r] *= rq[r >> 2][r & 3];
        }
#pragma unroll
        for (int p = 0; p < 2; ++p) {
            float sr = st[2 * p], si = st[2 * p + 1];
            const float a_r = ar[p], a_i = ai[p];
            const bool up = (hi5 != 0);
#pragma unroll
            for (int Q = 0; Q < 4; ++Q) {
                if (MODE == 2) { const size_t hidx = ((size_t)(b0 + Q) * 64 + g) * 64 + 32 * p + r32; sr = h0r[hidx]; si = h0i[hidx]; }
                float xr_[4], xi_[4], yr_[4], yi_[4];
                float cr = sr, ci = si;
#pragma unroll
                for (int e = 0; e < 4; ++e) { float tr = fmaf(a_r, cr, IN[2 * p][4 * Q + e]); asm volatile("" : "+v"(tr)); tr = fmaf(-a_i, ci, tr); asm volatile("" : "+v"(tr)); float ti = fmaf(a_r, ci, IN[2 * p + 1][4 * Q + e]); asm volatile("" : "+v"(ti)); ti = fmaf(a_i, cr, ti); asm volatile("" : "+v"(ti)); cr = tr; ci = ti; xr_[e] = cr; xi_[e] = ci; }
                { auto w0 = __builtin_amdgcn_permlane32_swap(__float_as_uint(cr), __float_as_uint(cr), false, false); cr = __uint_as_float(w0[0]);
                  auto w1 = __builtin_amdgcn_permlane32_swap(__float_as_uint(ci), __float_as_uint(ci), false, false); ci = __uint_as_float(w1[0]); }
#pragma unroll
                for (int e = 0; e < 4; ++e) { float tr = fmaf(a_r, cr, IN[2 * p][4 * Q + e]); asm volatile("" : "+v"(tr)); tr = fmaf(-a_i, ci, tr); asm volatile("" : "+v"(tr)); float ti = fmaf(a_r, ci, IN[2 * p + 1][4 * Q + e]); asm volatile("" : "+v"(ti)); ti = fmaf(a_i, cr, ti); asm volatile("" : "+v"(ti)); cr = tr; ci = ti; yr_[e] = cr; yi_[e] = ci; }
                { auto w0 = __builtin_amdgcn_permlane32_swap(__float_as_uint(cr), __float_as_uint(cr), false, false); sr = __uint_as_float(w0[1]);
                  auto w1 = __builtin_amdgcn_permlane32_swap(__float_as_uint(ci), __float_as_uint(ci), false, false); si = __uint_as_float(w1[1]); }
#pragma unroll
                for (int e = 0; e < 4; ++e) { IN[2 * p][4 * Q + e] = up ? yr_[e] : xr_[e]; IN[2 * p + 1][4 * Q + e] = up ? yi_[e] : xi_[e]; }
                if (MODE == 2) { if (hi5 == 0) { const size_t hidx = ((size_t)(b0 + Q) * 64 + g) * 64 + 32 * p + r32; hor[hidx] = sr; hoi[hidx] = si; } }
            }
            st[2 * p] = sr; st[2 * p + 1] = si;
        }
        if (MODE != 0) {
#pragma unroll
            for (int p = 0; p < 2; ++p)
#pragma unroll
                for (int r = 0; r < 16; ++r) { const int tau = 8 * (r >> 2) + 4 * hi5 + (r & 3); *(LAS unsigned*)(wl + tau * 272 + 4 * (32 * p + r32)) = pg8::cvt_pk_bf16(IN[2 * p][r], IN[2 * p + 1][r]); }
            LDS_WAIT(); asm volatile("" ::: "memory");
#pragma unroll
            for (int tt = 0; tt < 2; ++tt) {
                f32x4 y = {0.f, 0.f, 0.f, 0.f};
#pragma unroll
                for (int ks = 0; ks < 4; ++ks) { const pg8::bf16x8 hf = *(const LAS pg8::bf16x8*)(wl + (16 * tt + c16) * 272 + (32 * ks + 8 * kq) * 2); y = __builtin_amdgcn_mfma_f32_16x16x32_bf16(ct[ks], hf, y, 0, 0, 0); }
                const int token = rowb + 16 * tt + c16;
                const float rinv = rv[16 * tt + c16];
                const f32x4 xv = pg8::unpack4(xr_c[tt]);
                f32x4 o;
#pragma unroll
                for (int e = 0; e < 4; ++e) o[e] = gelu_tanh(y[e] + Dg[e] * (xv[e] * rinv));
                *(u32x2*)(Gout + (size_t)token * 1024 + g * 16 + 4 * kq) = pg8::pack4(o);
            }
        }
        LDS_WAIT(); asm volatile("" ::: "memory");
    }
}

#ifndef PROBE_DUP
#define PROBE_DUP 0
#endif
#define NREP(bit) (((PROBE_DUP) >> (bit)) & 1 ? 2 : 1)
#ifndef EN_P0
#define EN_P0 1
#endif
#ifndef EN_QKV
#define EN_QKV 1
#endif
#ifndef EN_ATT
#define EN_ATT 1
#endif
#ifndef EN_OPJ
#define EN_OPJ 1
#endif
#ifndef EN_S1
#define EN_S1 1
#endif
#ifndef EN_S3
#define EN_S3 1
#endif
#ifndef EN_GLU
#define EN_GLU 1
#endif
#ifndef EN_UP
#define EN_UP 1
#endif
#ifndef EN_DN
#define EN_DN 1
#endif
#ifndef EN_FIN
#define EN_FIN 1
#endif
template <class T> __device__ __forceinline__ T karg(const __attribute__((address_space(4))) char* ka, int off) { typedef const __attribute__((address_space(4))) T CT; return *(CT*)(ka + off); }
struct Args { const float* in[23]; float* out; unsigned char* ws; int ph_lo, ph_hi; };
static_assert(sizeof(Args) == 208 && __builtin_offsetof(Args, out) == 184 && __builtin_offsetof(Args, ws) == 192, "kernarg layout used by KARG");

__global__ void __launch_bounds__(512, 2) fwd_kernel(Args args) {
    extern __shared__ __attribute__((aligned(16))) unsigned char lds[];
    LAS unsigned char* const L = (LAS unsigned char*)lds;
#define FRESH_IDS int tid = threadIdx.x; asm volatile("" : "+v"(tid)); const int lane = tid & 63, wave = __builtin_amdgcn_readfirstlane(tid >> 6); const int gw = vcu * 8 + wave; (void)lane; (void)gw
    const int G = gridDim.x, bx = blockIdx.x;
    const int vcu = (G % 8 == 0) ? (bx % 8) * (G / 8) + bx / 8 : bx;
    const int NGW = G * 8;
    for (int u = threadIdx.x; u < (LDS_BYTES - LDSCTL_OFF) / 4; u += 512) ((LAS unsigned*)(L + LDSCTL_OFF))[u] = 0u;
    __syncthreads();
    const int lo = args.ph_lo, hi = args.ph_hi;
    const bool multi = (hi - lo) > 1;
    XcdBarrier bar; bar.bar = (unsigned*)(args.ws + WS_CTL) + CW_BAR; bar.x = 0; bar.st = nullptr;
    if (multi) bar = xcd_barrier_post((unsigned*)(args.ws + WS_CTL) + CW_BAR, (volatile LAS unsigned*)(L + MISC_OFF) + 8);
#define IN(k) (lo <= (k) && (k) < hi)
#define SEAM(k) do { if (IN(k) && IN((k) + 1)) xcd_barrier(bar); } while (0)

#define KARG(T, off) karg<T>(ka, (off))
#define INP(k) karg<const float*>(ka, 8 * (k))
#define FRESH_PTRS const __attribute__((address_space(4))) char* ka = (const __attribute__((address_space(4))) char*)__builtin_amdgcn_kernarg_segment_ptr(); asm volatile("" : "+s"(ka)); \
    unsigned char* const ws = KARG(unsigned char*, 192); float* const out = KARG(float*, 184); \
    float* const ssp = (float*)(ws + WS_SSP); float* const HS = (float*)(ws + WS_HS); bf16* const XB = (bf16*)(ws + WS_XB); bf16* const Hb = (bf16*)(ws + WS_H); \
    bf16* const Qb = (bf16*)(ws + WS_Q); bf16* const Kb = (bf16*)(ws + WS_K); bf16* const Vb = (bf16*)(ws + WS_V); bf16* const Ob = (bf16*)(ws + WS_O); \
    const float* const x_p = INP(0); const float* const x_s = INP(1); (void)ssp; (void)HS; (void)XB; (void)Hb; (void)Qb; (void)Kb; (void)Vb; (void)Ob; (void)x_p; (void)x_s
    if (EN_P0 && IN(0)) for (int rp = 0; rp < NREP(0); ++rp) {
        FRESH_IDS; FRESH_PTRS;
        LAS float* scr = (LAS float*)(L + wave * 16384);
        constexpr int I_QKV = 16 * 48, I_O = 16 * 32, I_GLU = 16 * 64, I_UP = 16 * 128, I_DN = 64 * 32;
        constexpr int NITEMS = 2 * I_QKV + 2 * I_O + 2 * I_GLU + 4 * I_UP + 4 * I_DN;
        for (int it = gw; it < NITEMS; it += NGW) {
            int r = it;
            if (r < 2 * I_QKV) { const int j = r / I_QKV; r -= j * I_QKV; p0_transpose_item(INP(9) + (size_t)j * D * NQKV, D, NQKV, INP(6) + (size_t)(2 * j) * D, (bf16*)(ws + WS_WQKV) + (size_t)j * NQKV * D, 0, scr, r, lane); continue; } r -= 2 * I_QKV;
            if (r < 2 * I_O) { const int j = r / I_O; r -= j * I_O; p0_transpose_item(INP(10) + (size_t)j * D * D, D, D, nullptr, (bf16*)(ws + WS_WO) + (size_t)j * D * D, 0, scr, r, lane); continue; } r -= 2 * I_O;
            if (r < 2 * I_GLU) { const int j = r / I_GLU; r -= j * I_GLU; p0_transpose_item(INP(20) + (size_t)j * D * 2 * D, D, 2 * D, nullptr, (bf16*)(ws + WS_WGLU) + (size_t)j * 2 * D * D, 1, scr, r, lane); continue; } r -= 2 * I_GLU;
            if (r < 4 * I_UP) { const int l = r / I_UP; r -= l * I_UP; p0_transpose_item(INP(21) + (size_t)l * D * FF, D, FF, INP(7) + (size_t)l * D, (bf16*)(ws + WS_WUP) + (size_t)l * FF * D, 0, scr, r, lane); continue; } r -= 4 * I_UP;
            { const int l = r / I_DN; r -= l * I_DN; p0_transpose_item(INP(22) + (size_t)l * FF * D, FF, D, nullptr, (bf16*)(ws + WS_WDN) + (size_t)l * D * FF, 0, scr, r, lane); }
        }
        for (int m = gw; m < M; m += NGW) {
            const float* xrow = (m < MP) ? x_p + (size_t)m * D : x_s + (size_t)(m - MP) * D;
            const GAS f32x4* xr = (const GAS f32x4*)xrow + lane;
            f32x4 v[4]; float s = 0.f;
#pragma unroll
            for (int j = 0; j < 4; ++j) { v[j] = xr[64 * j]; s += (v[j][0] * v[j][0] + v[j][1] * v[j][1]) + (v[j][2] * v[j][2] + v[j][3] * v[j][3]); }
            s = wave_sum(s);
            GAS unsigned long long* o8 = (GAS unsigned long long*)(XB + (size_t)m * D) + lane;
#pragma unroll
            for (int j = 0; j < 4; ++j) o8[64 * j] = (unsigned long long)pk2(v[j][0], v[j][1]) | ((unsigned long long)pk2(v[j][2], v[j][3]) << 32);
            if (lane < 32) ssp[(size_t)m * 64 + lane] = (lane == 0) ? s : 0.f;
        }
        for (int i = bx * 512 + tid; i < 2 * NG * NS; i += G * 512) {
            const int jj = i >> 12, gn = i & 4095, g = gn >> 6, n = gn & 63; float abr, abi, cfr, cfi;
            ssm_abar_calc(INP(12) + (size_t)jj * NG * NS, INP(13) + (size_t)jj * NG * NS, INP(14) + (size_t)jj * NG, g, n, abr, abi, cfr, cfi);
            f32x4 v; v[0] = abr; v[1] = abi; v[2] = cfr; v[3] = cfi; *(f32x4*)((float*)(ws + WS_TAB) + (size_t)i * 4) = v;
            const float* bre = INP(15) + (size_t)i * 16; const float* bim = INP(16) + (size_t)i * 16; const float* gn_ = INP(6) + (size_t)(2 * jj + 1) * D + g * 16;
            bf16* btr = (bf16*)(ws + WS_BT) + ((size_t)(jj * NG + g) * 128 + (2 * (n >> 5)) * 32 + (n & 31)) * 16; bf16* bti = btr + 32 * 16;
#pragma unroll
            for (int c8 = 0; c8 < 2; ++c8) {
                float wr_[8], wi_[8];
#pragma unroll
                for (int c4 = 0; c4 < 2; ++c4) { const f32x4 br = *(const f32x4*)(bre + 8 * c8 + 4 * c4), bi = *(const f32x4*)(bim + 8 * c8 + 4 * c4), gv = *(const f32x4*)(gn_ + 8 * c8 + 4 * c4);
#pragma unroll
                    for (int e = 0; e < 4; ++e) { wr_[4 * c4 + e] = (cfr * br[e] - cfi * bi[e]) * gv[e]; wi_[4 * c4 + e] = (cfr * bi[e] + cfi * br[e]) * gv[e]; } }
                v4u o; o.x = pk2(wr_[0], wr_[1]); o.y = pk2(wr_[2], wr_[3]); o.z = pk2(wr_[4], wr_[5]); o.w = pk2(wr_[6], wr_[7]); *(v4u*)(btr + 8 * c8) = o;
                o.x = pk2(wi_[0], wi_[1]); o.y = pk2(wi_[2], wi_[3]); o.z = pk2(wi_[4], wi_[5]); o.w = pk2(wi_[6], wi_[7]); *(v4u*)(bti + 8 * c8) = o;
            }
        }
        for (int i = bx * 512 + tid; i < 2 * NG * GC * 16; i += G * 512) {
            const int n4 = i & 15; const size_t rowi = (size_t)(i >> 4);
            const f32x4 cr = *(const f32x4*)(INP(17) + rowi * 64 + 4 * n4), ci = *(const f32x4*)(INP(18) + rowi * 64 + 4 * n4);
            v4u o; o.x = pk2(cr[0], -ci[0]); o.y = pk2(cr[1], -ci[1]); o.z = pk2(cr[2], -ci[2]); o.w = pk2(cr[3], -ci[3]);
            *(v4u*)((bf16*)(ws + WS_CT) + rowi * 128 + 8 * n4) = o;
        }
        {
            constexpr int PER = 120 * 256 / 4;
            constexpr int TOT = 2 * 2 * SB * PER;
            for (int i = bx * 512 + tid; i < TOT; i += G * 512) {
                const int kv = i / (2 * SB * PER), rem = i % (2 * SB * PER), jb = rem / PER, e = rem % PER;
                const f32x4 v = *((const f32x4*)(INP(2 + kv) + (size_t)jb * 128 * 256 + 8 * 256) + e);
                *((f32x4*)(out + (kv ? O_VS : O_KS) + (size_t)jb * 128 * 256) + e) = v;
            }
        }
        __syncthreads();
    }
    SEAM(0);

    for (int l = 0; l < 4; ++l) {
        const int pb = 1 + 5 * l, j = l >> 1;
        if ((l & 1) == 0) {
            if (EN_QKV && IN(pb)) for (int rp = 0; rp < NREP(3); ++rp) {
                FRESH_PTRS;
                pg8::Gemm g{XB, (const bf16*)(ws + WS_WQKV) + (size_t)j * NQKV * D, M, NQKV, D}; pg8::StaticOrder S; S.init(MP, NQKV, G, bx);
                pg8::EpiQKV E{Qb, Kb, Vb, ssp, 16, 32, out + O_KP + (size_t)j * 2 * 128 * 256, out + O_VP + (size_t)j * 2 * 128 * 256, out + O_KS + (size_t)j * SB * 128 * 256, out + O_VS + (size_t)j * SB * 128 * 256};
                pg8::gemm_phase_x<pg8::EpiQKV, pg8::StaticOrder>(L, g, S, E);
            }
            SEAM(pb);
            if (EN_ATT && IN(pb + 1)) for (int rp = 0; rp < NREP(1); ++rp) {
                FRESH_IDS; FRESH_PTRS;
                const LAS unsigned char* Kl = L; const LAS unsigned char* Vl = L + 36864;
                const float* ck = INP(2) + (size_t)j * SB * 128 * 256; const float* cv = INP(3) + (size_t)j * SB * 128 * 256;
                const float* sinks = INP(11) + j * 16;
                const int r32 = lane & 31, hi5 = lane >> 5;
                for (int u = vcu; u < 1024; u += G) {
                    const bool samp = u >= 512;
                    int b, qblk = 0, kvh;
                    if (!samp) { kvh = u & 3; qblk = (u >> 2) & 63; b = u >> 8; } else { const int us = u - 512; kvh = us & 3; b = us >> 2; }
                    const int nchunk = samp ? 160 * 8 : 256 * 8;
                    for (int id = tid; id < nchunk; id += 512) {
                        const int key = id >> 3, ch = id & 7;
                        v4u kv = {0u, 0u, 0u, 0u}, vv = {0u, 0u, 0u, 0u};
                        if (!samp) {
                            const int s = qblk * 128 - 128 + key;
                            if (s >= 0) { const size_t off = (size_t)((b << 13) + s) * 256 + kvh * 64 + ch * 8; kv = *(const v4u*)(Kb + off); vv = *(const v4u*)(Vb + off); }
                        } else if (key < 128) {
                            const size_t off = ((size_t)b * 128 + key) * 256 + kvh * 64 + ch * 8;
                            const f32x4 k0 = *(const f32x4*)(ck + off), k1 = *(const f32x4*)(ck + off + 4), v0 = *(const f32x4*)(cv + off), v1 = *(const f32x4*)(cv + off + 4);
                            kv.x = pk2(k0[0], k0[1]); kv.y = pk2(k0[2], k0[3]); kv.z = pk2(k1[0], k1[1]); kv.w = pk2(k1[2], k1[3]);
                            vv.x = pk2(v0[0], v0[1]); vv.y = pk2(v0[2], v0[3]); vv.z = pk2(v1[0], v1[1]); vv.w = pk2(v1[2], v1[3]);
                        } else if (key < 136) {
                            const size_t off = (size_t)(MP + b * 8 + (key - 128)) * 256 + kvh * 64 + ch * 8; kv = *(const v4u*)(Kb + off); vv = *(const v4u*)(Vb + off);
                        }
                        *(LAS v4u*)(L + key * 144 + ch * 16) = kv;
                        LAS unsigned short* vt = (LAS unsigned short*)(L + 36864 + (ch * 8) * 520 + key * 2);
                        vt[0 * 260] = (unsigned short)(vv.x & 0xffffu); vt[1 * 260] = (unsigned short)(vv.x >> 16); vt[2 * 260] = (unsigned short)(vv.y & 0xffffu); vt[3 * 260] = (unsigned short)(vv.y >> 16);
                        vt[4 * 260] = (unsigned short)(vv.z & 0xffffu); vt[5 * 260] = (unsigned short)(vv.z >> 16); vt[6 * 260] = (unsigned short)(vv.w & 0xffffu); vt[7 * 260] = (unsigned short)(vv.w >> 16);
                    }
                    __syncthreads();
                    const int ntask = samp ? ((wave == 0) ? 1 : 0) : 2;
                    for (int ti = 0; ti < ntask; ++ti) {
                        int qrow, head, tloc, kb0, jkmin;
                        if (!samp) { const int sb = 2 * (wave & 1) + ti; head = kvh * 4 + (wave >> 1); tloc = 32 * sb + r32; qrow = (b << 13) + qblk * 128 + tloc; kb0 = sb; jkmin = (qblk == 0) ? 128 : 0; }
                        else { head = kvh * 4 + (r32 >> 3); tloc = r32 & 7; qrow = MP + b * 8 + tloc; kb0 = 0; jkmin = 0; }
                        const float slope2 = exp2f(-0.5f * (float)(head + 1)) * 1.4426950408889634f, sink2 = sinks[head] * 1.4426950408889634f;
                        const bf16* qptr = Qb + (size_t)qrow * 1024 + head * 64 + 8 * hi5;
                        pg8::bf16x8 qf[4];
#pragma unroll
                        for (int ks = 0; ks < 4; ++ks) qf[ks] = *(const pg8::bf16x8*)(qptr + 16 * ks);
                        f32x16 S[5];
#pragma unroll
                        for (int i = 0; i < 5; ++i) {
                            f32x16 acc = {0.f, 0.f, 0.f, 0.f, 0.f, 0.f, 0.f, 0.f, 0.f, 0.f, 0.f, 0.f, 0.f, 0.f, 0.f, 0.f};
#pragma unroll
                            for (int ks = 0; ks < 4; ++ks) { const pg8::bf16x8 kf = *(const LAS pg8::bf16x8*)(Kl + (32 * (kb0 + i) + r32) * 144 + 32 * ks + 16 * hi5); acc = __builtin_amdgcn_mfma_f32_32x32x16_bf16(kf, qf[ks], acc, 0, 0, 0); }
                            S[i] = acc;
                        }
                        float mx = sink2;
#pragma unroll
                        for (int i = 0; i < 5; ++i)
#pragma unroll
                            for (int r = 0; r < 16; ++r) {
                                const int jk = 32 * (kb0 + i) + (r & 3) + 8 * (r >> 2) + 4 * hi5; const int dist = tloc + 128 - jk;
                                const bool valid = (dist >= 0) && (dist <= 128) && (jk >= jkmin);
                                const float sv = valid ? (S[i][r] * 0.18033688011112042f - slope2 * (float)dist) : -1e30f;
                                S[i][r] = sv; mx = fmaxf(mx, sv);
                            }
                        mx = fmaxf(mx, __shfl_xor(mx, 32));
                        float lsum = 0.f;
#pragma unroll
                        for (int i = 0; i < 5; ++i)
#pragma unroll
                            for (int r = 0; r < 16; ++r) { const float p = __builtin_amdgcn_exp2f(S[i][r] - mx); S[i][r] = p; lsum += p; }
                        lsum += __shfl_xor(lsum, 32); lsum += __builtin_amdgcn_exp2f(sink2 - mx);
                        const float inv = 1.0f / lsum;
                        f32x16 O0 = {0.f, 0.f, 0.f, 0.f, 0.f, 0.f, 0.f, 0.f, 0.f, 0.f, 0.f, 0.f, 0.f, 0.f, 0.f, 0.f}, O1 = O0;
#pragma unroll
                        for (int i = 0; i < 5; ++i)
#pragma unroll
                            for (int s2 = 0; s2 < 2; ++s2) {
                                v4u pw; pw.x = pg8::cvt_pk_bf16(S[i][8 * s2 + 0], S[i][8 * s2 + 1]); pw.y = pg8::cvt_pk_bf16(S[i][8 * s2 + 2], S[i][8 * s2 + 3]);
                                pw.z = pg8::cvt_pk_bf16(S[i][8 * s2 + 4], S[i][8 * s2 + 5]); pw.w = pg8::cvt_pk_bf16(S[i][8 * s2 + 6], S[i][8 * s2 + 7]);
                                const pg8::bf16x8 pf = __builtin_bit_cast(pg8::bf16x8, pw);
                                const int keyoff = 32 * (kb0 + i) + 16 * s2 + 4 * hi5;
                                { const u32x2 lo = *(const LAS u32x2*)(Vl + r32 * 520 + keyoff * 2), hh = *(const LAS u32x2*)(Vl + r32 * 520 + (keyoff + 8) * 2);
                                  v4u vw; vw.x = lo.x; vw.y = lo.y; vw.z = hh.x; vw.w = hh.y; O0 = __builtin_amdgcn_mfma_f32_32x32x16_bf16(__builtin_bit_cast(pg8::bf16x8, vw), pf, O0, 0, 0, 0); }
                                { const u32x2 lo = *(const LAS u32x2*)(Vl + (32 + r32) * 520 + keyoff * 2), hh = *(const LAS u32x2*)(Vl + (32 + r32) * 520 + (keyoff + 8) * 2);
                                  v4u vw; vw.x = lo.x; vw.y = lo.y; vw.z = hh.x; vw.w = hh.y; O1 = __builtin_amdgcn_mfma_f32_32x32x16_bf16(__builtin_bit_cast(pg8::bf16x8, vw), pf, O1, 0, 0, 0); }
                            }
                        bf16* optr = Ob + (size_t)qrow * 1024 + head * 64 + 4 * hi5;
#pragma unroll
                        for (int qd = 0; qd < 4; ++qd) {
                            u32x2 w0; w0.x = pg8::cvt_pk_bf16(O0[4 * qd] * inv, O0[4 * qd + 1] * inv); w0.y = pg8::cvt_pk_bf16(O0[4 * qd + 2] * inv, O0[4 * qd + 3] * inv);
                            u32x2 w1; w1.x = pg8::cvt_pk_bf16(O1[4 * qd] * inv, O1[4 * qd + 1] * inv); w1.y = pg8::cvt_pk_bf16(O1[4 * qd + 2] * inv, O1[4 * qd + 3] * inv);
                            *(u32x2*)(optr + 8 * qd) = w0; *(u32x2*)(optr + 32 + 8 * qd) = w1;
                        }
                    }
                    __syncthreads();
                }
            }
            SEAM(pb + 1);
            if (EN_OPJ && IN(pb + 2)) {
                FRESH_PTRS;
                pg8::Gemm g{Ob, (const bf16*)(ws + WS_WO) + (size_t)j * D * D, M, D, D}; pg8::StaticOrder S; S.init(MP, D, G, bx);
                pg8::EpiRes E{XB, ssp};
                pg8::gemm_phase_x<pg8::EpiRes, pg8::StaticOrder>(L, g, S, E);
            }
            SEAM(pb + 2);
        } else {
#define SSMT(gg) const SsmT T_{(const bf16*)(ws + WS_BT) + ((size_t)j * NG + (gg)) * 128 * 16, (const bf16*)(ws + WS_CT) + ((size_t)j * NG + (gg)) * 16 * 128, (const float*)(ws + WS_TAB) + ((size_t)j * NG + (gg)) * NS * 4, \
                          INP(19) + (size_t)j * D + (gg) * 16, INP(6) + (size_t)l * D + (gg) * 16}
            if (EN_S1 && IN(pb)) for (int rp = 0; rp < NREP(2); ++rp) {
                FRESH_IDS; FRESH_PTRS; LAS unsigned char* wl = L + wave * 9216;
                for (int u = gw; u < NB * (NCH - 1) * NG; u += NGW) {
                    int lane = tid & 63; asm volatile("" : "+v"(lane));
                    const int g = u & 63, ch = (u >> 6) % (NCH - 1), b = (u >> 6) / (NCH - 1);
                    SSMT(g);
                    float st[4] = {0.f, 0.f, 0.f, 0.f};
                    ssm_mfma_unit<0>(wl, lane, g, T_, XB, out, ssp, 16, b * SEQ + ch * CH, CH / 32, st, nullptr, nullptr, nullptr, nullptr, nullptr, 0);
                    if (lane < 32) { float* hs = HS + ((size_t)((b * NCH + ch) * NG + g) * NS) * 2; *(float2*)(hs + 2 * lane) = make_float2(st[0], st[1]); *(float2*)(hs + 2 * (32 + lane)) = make_float2(st[2], st[3]); }
                }
                __syncthreads();
            }
            SEAM(pb);
            if (EN_S3 && IN(pb + 1)) for (int rp = 0; rp < NREP(2); ++rp) {
                FRESH_IDS; FRESH_PTRS; LAS unsigned char* wl = L + wave * 9216;
                for (int u = gw; u < NB * NCH * NG + (SB / 4) * NG; u += NGW) {
                    int lane = tid & 63; asm volatile("" : "+v"(lane));
                    if (u < NB * NCH * NG) {
                        const int g = u & 63, ch = (u >> 6) & (NCH - 1), b = u >> 11, r32 = lane & 31;
                        SSMT(g);
                        float st[4] = {0.f, 0.f, 0.f, 0.f};
#pragma unroll
                        for (int p = 0; p < 2; ++p) {
                            const f32x4 tv = *(const f32x4*)(T_.tab + (size_t)(32 * p + r32) * 4);
                            float aLr = tv[0], aLi = tv[1];
#pragma unroll
                            for (int sq = 0; sq < 8; ++sq) { const float tr = aLr * aLr - aLi * aLi, ti = 2.0f * aLr * aLi; aLr = tr; aLi = ti; }
                            float hr = 0.f, hi_ = 0.f;
                            for (int i0 = 0; i0 < ch; i0 += 8) {
                                float2 e[8];
#pragma unroll
                                for (int k = 0; k < 8; ++k) e[k] = (i0 + k < ch) ? *(const float2*)(HS + ((size_t)((b * NCH + i0 + k) * NG + g) * NS + 32 * p + r32) * 2) : make_float2(0.f, 0.f);
#pragma unroll
                                for (int k = 0; k < 8; ++k) if (i0 + k < ch) { const float tr = aLr * hr - aLi * hi_ + e[k].x, ti = aLr * hi_ + aLi * hr + e[k].y; hr = tr; hi_ = ti; }
                            }
                            st[2 * p] = hr; st[2 * p + 1] = hi_;
                        }
                        ssm_mfma_unit<1>(wl, lane, g, T_, XB, out, ssp, 16, b * SEQ + ch * CH, CH / 32, st, Ob, nullptr, nullptr, nullptr, nullptr, 0);
                        if (ch == NCH - 1 && lane < 32) { float* hr_o = out + O_HRP + ((size_t)(j * NB + b) * NG + g) * NS; float* hi_o = out + O_HIP + ((size_t)(j * NB + b) * NG + g) * NS;
                            hr_o[lane] = st[0]; hi_o[lane] = st[1]; hr_o[32 + lane] = st[2]; hi_o[32 + lane] = st[3]; }
                    } else {
                        const int us = u - NB * NCH * NG, g = us & 63, bb = us >> 6;
                        SSMT(g);
                        float st[4] = {0.f, 0.f, 0.f, 0.f};
                        ssm_mfma_unit<2>(wl, lane, g, T_, XB, out, ssp, 32, MP + bb * 32, 1, st, Ob, INP(4) + (size_t)j * SB * NG * NS, INP(5) + (size_t)j * SB * NG * NS, out + O_HRS + (size_t)j * SB * NG * NS, out + O_HIS + (size_t)j * SB * NG * NS, bb * 4);
                    }
                }
                __syncthreads();
            }
            SEAM(pb + 1);
            if (EN_GLU && IN(pb + 2)) {
                FRESH_PTRS;
                pg8::Gemm g{Ob, (const bf16*)(ws + WS_WGLU) + (size_t)j * 2 * D * D, M, 2 * D, D}; pg8::StaticOrder S; S.init(MP, 2 * D, G, bx);
                pg8::EpiGlu E{XB, ssp};
                pg8::gemm_phase_x<pg8::EpiGlu, pg8::StaticOrder>(L, g, S, E);
            }
            SEAM(pb + 2);
        }
        if (EN_UP && IN(pb + 3)) for (int rp = 0; rp < NREP(4); ++rp) {
            FRESH_PTRS;
            pg8::Gemm g{XB, (const bf16*)(ws + WS_WUP) + (size_t)l * FF * D, M, FF, D}; pg8::StaticOrder S; S.init(MP, FF, G, bx);
            pg8::EpiUp E{Hb, ssp, (l & 1) ? 32 : 16, (l & 1) ? 64 : 32};
            pg8::gemm_phase_x<pg8::EpiUp, pg8::StaticOrder, NREP(5), NREP(6)>(L, g, S, E);
        }
        SEAM(pb + 3);
        if (EN_DN && IN(pb + 4)) {
            FRESH_PTRS;
            pg8::Gemm g{Hb, (const bf16*)(ws + WS_WDN) + (size_t)l * D * FF, M, D, FF}; pg8::StaticOrder S; S.init(MP, D, G, bx);
            pg8::EpiRes E{XB, ssp};
            pg8::gemm_phase_x<pg8::EpiRes, pg8::StaticOrder>(L, g, S, E);
        }
        SEAM(pb + 4);
    }
    if (EN_FIN && IN(21)) {
        FRESH_IDS; FRESH_PTRS;
        const float* gf = INP(8);
        for (int m = gw; m < M; m += NGW) {
            const float pv = (lane < ((m < MP) ? 16 : 32)) ? ssp[(size_t)m * 64 + lane] : 0.f;
            const float rinv = rsqrtf(wave_sum(pv) * (1.0f / 1024.0f) + 1e-6f);
            const bf16* xb = XB + (size_t)m * D + 4 * lane; float* yo = out + (size_t)m * D + 4 * lane;
#pragma unroll
            for (int jx = 0; jx < 4; ++jx) { const f32x4 gv = *(const f32x4*)(gf + 256 * jx + 4 * lane); const f32x4 v = pg8::unpack4(*(const u32x2*)(xb + 256 * jx)) * rinv * gv; *(f32x4*)(yo + 256 * jx) = v; }
        }
    }
#undef IN
#undef SEAM
}

#ifndef MK_SPLIT
#define MK_SPLIT 0
#endif
extern "C" void kernel_launch(void* const* d_in, const int* in_sizes, int n_in, void* d_out, int out_size, void* d_ws, size_t ws_size, hipStream_t stream) {
    static int grid = 0;
    if (grid == 0) {
        if (n_in != 23 || in_sizes[0] != MP * D || (size_t)out_size != O_END || ws_size < WS_END) { fprintf(stderr, "kernel_launch: unexpected shapes (n_in %d, in0 %d, out %d, ws %zu); nothing launched\n", n_in, n_in > 0 ? in_sizes[0] : -1, out_size, ws_size); grid = -1; return; }
        int dev = 0, cus = 0, per_cu = 0;
        if (hipGetDevice(&dev) != hipSuccess || hipDeviceGetAttribute(&cus, hipDeviceAttributeMultiprocessorCount, dev) != hipSuccess) { fprintf(stderr, "kernel_launch: device query failed\n"); grid = -1; return; }
        if (hipFuncSetAttribute((const void*)fwd_kernel, hipFuncAttributeMaxDynamicSharedMemorySize, LDS_BYTES) != hipSuccess) { fprintf(stderr, "kernel_launch: hipFuncSetAttribute failed\n"); grid = -1; return; }
        if (hipOccupancyMaxActiveBlocksPerMultiprocessor(&per_cu, (const void*)fwd_kernel, 512, LDS_BYTES) != hipSuccess || per_cu < 1) fprintf(stderr, "kernel_launch: note: occupancy query reports %d blocks per CU\n", per_cu);
        (void)hipGetLastError();
        grid = cus;
    }
    if (grid < 0) return;
    (void)hipMemsetAsync((char*)d_ws + WS_CTL, 0, CTL_ZERO_BYTES, stream);
    Args a{};
    for (int i = 0; i < 23; ++i) a.in[i] = (const float*)d_in[i];
    a.out = (float*)d_out; a.ws = (unsigned char*)d_ws;
#if MK_SPLIT
    for (int p = 0; p < NPHASE; ++p) { a.ph_lo = p; a.ph_hi = p + 1; hipLaunchKernelGGL(fwd_kernel, dim3(grid), dim3(512), LDS_BYTES, stream, a); }
#else
    a.ph_lo = 0; a.ph_hi = NPHASE; hipLaunchKernelGGL(fwd_kernel, dim3(grid), dim3(512), LDS_BYTES, stream, a);
#endif
}
```

```cpp
#include <hip/hip_runtime.h>
#include <cstdio>
#include <cstdint>
namespace pg8 {
#define PG8_LAS __attribute__((address_space(3)))
typedef unsigned short bf16_t;
typedef short bf16x8 __attribute__((ext_vector_type(8)));
typedef float f32x4 __attribute__((ext_vector_type(4)));
typedef unsigned u32x4 __attribute__((ext_vector_type(4)));
constexpr int BM = 256, BK = 64, HALF = 128, HTB = HALF * BK * 2  , STAGE_BYTES = 8 * HTB, NXCD = 8, WGM = 8;

__host__ __device__ __forceinline__ int lds_byte(int r, int c) { const int st = (r >> 4) * 2 + (c >> 5), rr = r & 15, cc = c & 31, ob = rr * 64 + cc * 2; return st * 1024 + (ob ^ (((ob >> 9) & 1) << 5)); }
__host__ __device__ __forceinline__ void stage_rc(int b, int& R, int& C) { const int st = b / 1024, sb = b % 1024, swz = sb ^ (((sb >> 9) & 1) << 5); R = (st >> 1) * 16 + swz / 64; C = (st & 1) * 32 + (swz % 64) / 2; }
__host__ __device__ __forceinline__ int perm32(int rho) { const int n = rho >> 4, i = rho & 15; return 8 * (i >> 2) + 4 * n + (i & 3); }

struct Unit { int pm, pn; };
struct Gemm { const bf16_t* A; const bf16_t* Bt; int M, N, K; };

struct StaticOrder {
    int nM, nN, nwg, G, c;
    __host__ __device__ void init(int M, int N, int G_, int c_) { nM = M / BM; nN = N / BM; nwg = nM * nN; G = G_; c = c_; }
    __host__ __device__ bool next(int i, Unit& u) const {
        const long L = (long)i * G + c; if (L >= nwg) return false;
        int wgid = (int)L; { const int q = nwg / NXCD, r = nwg % NXCD, xcd = wgid % NXCD, off = wgid / NXCD; wgid = (xcd < r ? xcd * (q + 1) : r * (q + 1) + (xcd - r) * q) + off; }
        const int nig = WGM * nN, gid = wgid / nig, fm = gid * WGM, gsz = (nM - fm) < WGM ? (nM - fm) : WGM;
        u.pm = fm + ((wgid % nig) % gsz); u.pn = (wgid % nig) / gsz; return true;
    }
    __device__ __forceinline__ void a_ready(const Unit&) const {}
    __device__ __forceinline__ void done(const Unit&) const {}
};
__device__ __forceinline__ unsigned cvt_pk_bf16(float lo, float hi) { unsigned r; asm volatile("v_cvt_pk_bf16_f32 %0, %1, %2" : "=v"(r) : "v"(lo), "v"(hi)); return r; }
typedef float f32x2 __attribute__((ext_vector_type(2)));
template <class Epi, class Sched, bool ALIGN_EPI = false, bool SP2 = false>
__device__ __forceinline__ void gemm_phase(PG8_LAS unsigned char* lds, const Gemm g, const Sched& S, const Epi& E) {
    int tid_ = threadIdx.x; asm volatile("" : "+v"(tid_));
    const int tid = tid_, wid = __builtin_amdgcn_readfirstlane(tid >> 6), lane = tid & 63, wr = wid >> 2, wc = wid & 3, fr = lane & 15, fq = lane >> 4;
    const int K = g.K, nt = K / BK;
    unsigned voffA[2], voffB[2];
#pragma unroll
    for (int i = 0; i < 2; ++i) { int R, C; stage_rc(tid * 16 + i * 8192, R, C); const int Rb = Epi::PERM ? ((R & ~31) + perm32(R & 31)) : R;
        voffA[i] = (unsigned)(R * K + C) * 2u; voffB[i] = (unsigned)(Rb * K + C) * 2u; }
    const size_t kstep = (size_t)(BK * 2);
    const size_t hstep = (size_t)HALF * K * 2;
    const size_t tstep = 2 * hstep;
    const unsigned ldsw = (unsigned)wid * 1024u;
    const int aoff = lds_byte(wr * 64 + fr, fq * 8), boff = lds_byte(wc * 32 + fr, fq * 8);
#define PG8_SA(b, h) (((b) * 2 + (h)) * HTB)
#define PG8_SB(b, h) ((4 + (b) * 2 + (h)) * HTB)
#define PG8_STAGE(bufoff, gbase, voff) do { _Pragma("unroll") for (int _i = 0; _i < 2; ++_i) \
        __builtin_amdgcn_global_load_lds((const unsigned*)((const char*)(gbase) + (voff)[_i]), (PG8_LAS unsigned*)(lds + (bufoff) + ldsw + _i * 8192), 16, 0, 0); } while (0)
#define PG8_LDA(dst, b, h) do { _Pragma("unroll") for (int m = 0; m < 4; ++m) _Pragma("unroll") for (int k = 0; k < 2; ++k) dst[m][k] = *(const PG8_LAS bf16x8*)(lds + PG8_SA(b, h) + aoff + m * 2048 + k * 1024); } while (0)
#define PG8_LDB(dst, b, h) do { _Pragma("unroll") for (int n = 0; n < 2; ++n) _Pragma("unroll") for (int k = 0; k < 2; ++k) dst[n][k] = *(const PG8_LAS bf16x8*)(lds + PG8_SB(b, h) + boff + n * 2048 + k * 1024); } while (0)
#define PG8_MMA(ai, bj, At, Bt) do { __builtin_amdgcn_s_setprio(1); _Pragma("unroll") for (int m = 0; m < 4; ++m) _Pragma("unroll") for (int n = 0; n < 2; ++n) _Pragma("unroll") for (int k = 0; k < 2; ++k) \
        acc[ai][bj][m][n] = __builtin_amdgcn_mfma_f32_16x16x32_bf16(Bt[n][k], At[m][k], acc[ai][bj][m][n], 0, 0, 0); __builtin_amdgcn_s_setprio(0); } while (0)
#define PG8_WAIT_V(n) asm volatile("s_waitcnt vmcnt(" #n ")" ::: "memory")
#define PG8_WAIT_L(n) asm volatile("s_waitcnt lgkmcnt(" #n ")" ::: "memory")
#define PG8_BAR __builtin_amdgcn_s_barrier()
#define PG8_SCHED __builtin_amdgcn_sched_barrier(0)
    Unit cur, nxt; int ui = 0;
    if (!S.next(0, cur)) return;
    f32x4 acc[2][2][4][2];
#pragma unroll
    for (int a = 0; a < 2; ++a)
#pragma unroll
        for (int b = 0; b < 2; ++b)
#pragma unroll
            for (int m = 0; m < 4; ++m)
#pragma unroll
                for (int n = 0; n < 2; ++n) acc[a][b][m][n] = (f32x4){0.f, 0.f, 0.f, 0.f};
    bf16x8 At[4][2], B0[2][2], B1[2][2];
    const char* cA = (const char*)g.A + (size_t)cur.pm * tstep; const char* cB = (const char*)g.Bt + (size_t)cur.pn * tstep;
    S.a_ready(cur);
    if constexpr (SP2) {
        PG8_STAGE(PG8_SB(0, 0), cB, voffB); PG8_STAGE(PG8_SB(0, 1), cB + hstep, voffB); PG8_STAGE(PG8_SA(0, 0), cA, voffA); PG8_STAGE(PG8_SA(0, 1), cA + hstep, voffA);
        if (wr == 1) PG8_BAR;
        PG8_WAIT_V(2); PG8_BAR;
        PG8_STAGE(PG8_SB(1, 0), cB + kstep, voffB); PG8_STAGE(PG8_SA(1, 0), cA + kstep, voffA); PG8_STAGE(PG8_SB(1, 1), cB + hstep + kstep, voffB);
        PG8_WAIT_V(6); PG8_BAR;
    } else {
        PG8_STAGE(PG8_SB(0, 0), cB, voffB); PG8_STAGE(PG8_SA(0, 0), cA, voffA); PG8_STAGE(PG8_SB(0, 1), cB + hstep, voffB); PG8_STAGE(PG8_SA(0, 1), cA + hstep, voffA);
        if (wr == 1) PG8_BAR;
        PG8_WAIT_V(4); PG8_BAR;
        PG8_STAGE(PG8_SB(1, 0), cB + kstep, voffB); PG8_STAGE(PG8_SA(1, 0), cA + kstep, voffA); PG8_STAGE(PG8_SB(1, 1), cB + hstep + kstep, voffB);
        PG8_WAIT_V(6); PG8_BAR;
    }
    for (;;) {
        const bool has_next = S.next(ui + 1, nxt);
        const char* nA = has_next ? (const char*)g.A + (size_t)nxt.pm * tstep : cA; const char* nB = has_next ? (const char*)g.Bt + (size_t)nxt.pn * tstep : cB;
        for (int t = 0; t < nt; t += 2) {
            const bool last = (t == nt - 2);
            const char* a1 = cA + (size_t)(t + 1) * kstep;
            const char* a2 = last ? nA : cA + (size_t)(t + 2) * kstep; const char* b2 = last ? nB : cB + (size_t)(t + 2) * kstep;
            const char* a3 = a2 + kstep; const char* b3 = b2 + kstep;
            if (last && has_next) S.a_ready(nxt);
            if constexpr (SP2) {
            PG8_LDB(B0, 0, 0); PG8_LDB(B1, 0, 1); PG8_SCHED; PG8_LDA(At, 0, 0); PG8_STAGE(PG8_SA(1, 1), a1 + hstep, voffA);
            PG8_WAIT_V(8); PG8_WAIT_L(0); PG8_BAR; PG8_MMA(0, 0, At, B0); PG8_MMA(0, 1, At, B1); PG8_BAR; PG8_SCHED;
            PG8_LDA(At, 0, 1); PG8_STAGE(PG8_SB(0, 0), b2, voffB); PG8_STAGE(PG8_SB(0, 1), b2 + hstep, voffB); PG8_STAGE(PG8_SA(0, 0), a2, voffA);
            PG8_WAIT_V(8); PG8_WAIT_L(0); PG8_BAR; PG8_MMA(1, 0, At, B0); PG8_MMA(1, 1, At, B1); PG8_BAR; PG8_SCHED;
            PG8_LDB(B0, 1, 0); PG8_LDB(B1, 1, 1); PG8_SCHED; PG8_LDA(At, 1, 0); PG8_STAGE(PG8_SA(0, 1), a2 + hstep, voffA);
            PG8_WAIT_V(8); PG8_WAIT_L(0); PG8_BAR; PG8_MMA(0, 0, At, B0); PG8_MMA(0, 1, At, B1); PG8_BAR; PG8_SCHED;
            PG8_LDA(At, 1, 1); PG8_STAGE(PG8_SB(1, 0), b3, voffB); PG8_STAGE(PG8_SB(1, 1), b3 + hstep, voffB); PG8_STAGE(PG8_SA(1, 0), a3, voffA);
            PG8_WAIT_V(8); PG8_WAIT_L(0); PG8_BAR; PG8_MMA(1, 0, At, B0); PG8_MMA(1, 1, At, B1); PG8_BAR; PG8_SCHED;
            } else {
            PG8_LDB(B0, 0, 0); PG8_SCHED; PG8_LDA(At, 0, 0); PG8_STAGE(PG8_SA(1, 1), a1 + hstep, voffA);
            PG8_WAIT_L(8); PG8_BAR; PG8_WAIT_L(0); PG8_MMA(0, 0, At, B0); PG8_BAR; PG8_SCHED;
            PG8_LDB(B1, 0, 1); PG8_STAGE(PG8_SB(0, 0), b2, voffB);
            PG8_BAR; PG8_WAIT_L(0); PG8_MMA(0, 1, At, B1); PG8_BAR;
            PG8_LDA(At, 0, 1); PG8_STAGE(PG8_SA(0, 0), a2, voffA);
            PG8_BAR; PG8_WAIT_L(0); PG8_MMA(1, 0, At, B0); PG8_BAR; PG8_SCHED;
            PG8_STAGE(PG8_SB(0, 1), b2 + hstep, voffB);
            PG8_WAIT_V(6); PG8_BAR; PG8_MMA(1, 1, At, B1); PG8_BAR;
            PG8_LDB(B0, 1, 0); PG8_SCHED; PG8_LDA(At, 1, 0); PG8_STAGE(PG8_SA(0, 1), a2 + hstep, voffA);
            PG8_WAIT_L(8); PG8_BAR; PG8_WAIT_L(0); PG8_MMA(0, 0, At, B0); PG8_BAR; PG8_SCHED;
            PG8_LDB(B1, 1, 1); PG8_STAGE(PG8_SB(1, 0), b3, voffB);
            PG8_BAR; PG8_WAIT_L(0); PG8_MMA(0, 1, At, B1); PG8_BAR;
            PG8_LDA(At, 1, 1); PG8_STAGE(PG8_SA(1, 0), a3, voffA);
            PG8_BAR; PG8_WAIT_L(0); PG8_MMA(1, 0, At, B0); PG8_BAR; PG8_SCHED;
            PG8_STAGE(PG8_SB(1, 1), b3 + hstep, voffB);
            PG8_WAIT_V(6); PG8_BAR; PG8_MMA(1, 1, At, B1); PG8_BAR;
            }
        }
        if constexpr (ALIGN_EPI) { if (wr == 0) PG8_BAR; }
        if constexpr (!Epi::AFTER_DRAIN) { E(acc, cur, wr, wc, fr, fq); S.done(cur); }
        if (!has_next) break;
#pragma unroll
        for (int a = 0; a < 2; ++a)
#pragma unroll
            for (int b = 0; b < 2; ++b)
#pragma unroll
                for (int m = 0; m < 4; ++m)
#pragma unroll
                    for (int n = 0; n < 2; ++n) acc[a][b][m][n] = (f32x4){0.f, 0.f, 0.f, 0.f};
        cur = nxt; cA = nA; cB = nB; ++ui;
        if constexpr (ALIGN_EPI) { if (wr == 1) PG8_BAR; }
    }
    PG8_WAIT_V(0);
    if constexpr (!ALIGN_EPI) { if (wr == 0) PG8_BAR; }
    PG8_BAR;
    if constexpr (Epi::AFTER_DRAIN) { E.fused(acc, cur, wr, wc, fr, fq, lds, wid, lane); S.done(cur); }
#undef PG8_SA
#undef PG8_SB
#undef PG8_STAGE
#undef PG8_LDA
#undef PG8_LDB
#undef PG8_MMA
#undef PG8_WAIT_V
#undef PG8_WAIT_L
#undef PG8_BAR
#undef PG8_SCHED
}
}
#define GAS __attribute__((address_space(1)))
#define LAS __attribute__((address_space(3)))
typedef unsigned short bf16;
typedef unsigned v4u __attribute__((ext_vector_type(4)));
typedef float f32x4 __attribute__((ext_vector_type(4)));
typedef short bf16x8 __attribute__((ext_vector_type(8)));
typedef GAS unsigned gu32;
typedef GAS unsigned long long gu64;
#define RLX_AGENT __ATOMIC_RELAXED, __HIP_MEMORY_SCOPE_AGENT
#define LDS_WAIT() asm volatile("s_waitcnt lgkmcnt(0)" ::: "memory")
#define VM_WAIT() asm volatile("s_waitcnt vmcnt(0)" ::: "memory")
__device__ __forceinline__ unsigned long long rt() { return __builtin_amdgcn_s_memrealtime(); }
__device__ __forceinline__ unsigned f2bf(float f) { unsigned u = __builtin_bit_cast(unsigned, f); return (u + 0x7fffu + ((u >> 16) & 1u)) >> 16; }
__device__ __forceinline__ unsigned pk2(float lo, float hi) { return f2bf(lo) | (f2bf(hi) << 16); }
#define XB_TMO      128
#define XB_XCNT(j)  (256  + 64 * (j))
#define XB_XSUB(j)  (1280 + 64 * (j))
#define XB_XGEN(j)  (2304 + 64 * (j))
#define XB_TOP      3328
#define XB_TOPGEN   3392
#define XCD_BAR_WORDS 3456
#define XB_SPIN_CAP (1u << 18)

__device__ __forceinline__ unsigned xb_ld(unsigned* p)              { return __hip_atomic_load(p, __ATOMIC_RELAXED, __HIP_MEMORY_SCOPE_AGENT); }
__device__ __forceinline__ unsigned xb_add(unsigned* p, unsigned v) { return __hip_atomic_fetch_add(p, v, __ATOMIC_RELAXED, __HIP_MEMORY_SCOPE_AGENT); }
__device__ __forceinline__ unsigned xb_xcc_id() { return (unsigned)__builtin_amdgcn_s_getreg((3 << 11) | 20) & 0xFu; }
#define XB_SPIN(cond, bar) do { unsigned _sp = 0; while (cond) { __builtin_amdgcn_s_sleep(1); \
    if ((++_sp & 255u) == 0u) { if (xb_ld(&(bar)[XB_TMO])) break; if (_sp > XB_SPIN_CAP) { atomicAdd(&(bar)[XB_TMO], 1u); break; } } } } while (0)

struct XcdBarrier {
    unsigned* bar; unsigned x;
    volatile LAS unsigned* st;
};

__device__ __forceinline__ XcdBarrier xcd_barrier_post(unsigned* bar, volatile LAS unsigned* st) {
    XcdBarrier b; b.bar = bar; b.x = xb_xcc_id(); b.st = st;
    if (threadIdx.x == 0) (void)xb_add(&bar[XB_XCNT(b.x)], 1u);
    return b;
}
__device__ __forceinline__ void xcd_barrier_complete(unsigned* bar, unsigned x, unsigned& nloc, unsigned& nx) {
    const unsigned G = gridDim.x * gridDim.y * gridDim.z;
    unsigned sum, cnt, mine, sp = 0u;
    for (;;) {
        sum = 0u; cnt = 0u; mine = 0u;
#pragma unroll
        for (unsigned j = 0; j < 16; ++j) { const unsigned c = xb_ld(&bar[XB_XCNT(j)]); sum += c; cnt += (c > 0u) ? 1u : 0u; mine = (j == x) ? c : mine; }
        if (sum == G) break;
        __builtin_amdgcn_s_sleep(1);
        if ((++sp & 255u) == 0u) { if (xb_ld(&bar[XB_TMO])) break; if (sp > XB_SPIN_CAP) { atomicAdd(&bar[XB_TMO], 1u); break; } }
    }
    nloc = mine > 0u ? mine : 1u; nx = cnt > 0u ? cnt : 1u;
}

__device__ __forceinline__ void xcd_barrier(const XcdBarrier& b) {
    asm volatile("s_waitcnt vmcnt(0)" ::: "memory");
    __syncthreads();
    if (threadIdx.x == 0) {
        unsigned* bar = b.bar;
        __builtin_amdgcn_s_waitcnt(0);
        unsigned nloc = b.st[0], nx = b.st[1];
        if (nloc == 0u) { xcd_barrier_complete(bar, b.x, nloc, nx); b.st[0] = nloc; b.st[1] = nx; }
        const unsigned old = xb_add(&bar[XB_XSUB(b.x)], 1u);
        const unsigned gen = old / nloc;
        if (old + 1u == (gen + 1u) * nloc) {
            __builtin_amdgcn_fence(__ATOMIC_RELEASE, "agent");
            asm volatile("s_waitcnt vmcnt(0)" ::: "memory");
            const unsigned og = xb_add(&bar[XB_TOP], 1u);
            const unsigned tg = og / nx;
            if (og + 1u == (tg + 1u) * nx) xb_add(&bar[XB_TOPGEN], 1u);
            else XB_SPIN(xb_ld(&bar[XB_TOPGEN]) == tg, bar);
            __builtin_amdgcn_fence(__ATOMIC_ACQUIRE, "agent");
            xb_add(&bar[XB_XGEN(b.x)], 1u);
            asm volatile("s_waitcnt vmcnt(0)" ::: "memory");
        } else {
            XB_SPIN(xb_ld(&bar[XB_XGEN(b.x)]) == gen, bar);
            __builtin_amdgcn_fence(__ATOMIC_ACQUIRE, "agent");
            asm volatile("s_waitcnt vmcnt(0)" ::: "memory");
        }
    }
    __syncthreads();
}

constexpr int D = 1024, SEQ = 8192, NB = 2, MP = NB * SEQ, SB = 128, ST = 8, MS = SB * ST, M = MP + MS;
constexpr int NQKV = 1536, FF = 4096, NKV = 4, HD = 64, KVW = NKV * HD, NG = 64, GC = 16, NS = 64;
constexpr int CH = 256, NCH = SEQ / CH;
constexpr int NPHASE = 22;
constexpr size_t O_KP = 17825792, O_VP = 17956864, O_HRP = 18087936, O_HIP = 18104320, O_KS = 18120704, O_VS = 26509312, O_HRS = 34897920, O_HIS = 35946496, O_END = 36995072;
constexpr size_t MiB = 1u << 20;
constexpr size_t WS_CTL = 0, CTL_ZERO_BYTES = 64 * 1024;
constexpr size_t WS_SSP = 1 * MiB;
constexpr size_t WS_TAB = 5 * MiB + 512 * 1024;
constexpr size_t WS_HS = 6 * MiB;
constexpr size_t WS_WQKV = 8 * MiB, WS_WO = 14 * MiB, WS_WGLU = 18 * MiB, WS_WUP = 26 * MiB, WS_WDN = 58 * MiB;
constexpr size_t WS_XB = 90 * MiB;
constexpr size_t WS_H = 124 * MiB;
constexpr size_t WS_Q = 124 * MiB, WS_K = 158 * MiB, WS_V = 167 * MiB, WS_O = 176 * MiB;
constexpr size_t WS_BT = 260 * MiB, WS_CT = 261 * MiB;
constexpr size_t WS_END = 262 * MiB;
constexpr int CW_BAR = 4096;
static_assert((CW_BAR + XCD_BAR_WORDS) * 4 <= (int)CTL_ZERO_BYTES, "barrier words inside the memset region");
constexpr int RING_BYTES = 131072, XA_BYTES = 4096, LDSCTL_OFF = RING_BYTES + XA_BYTES  , MISC_OFF = LDSCTL_OFF + 320, LDS_BYTES = 147456;

__device__ __forceinline__ float wave_sum(float v) {
#pragma unroll
    for (int o = 1; o < 64; o <<= 1) v += __shfl_xor(v, o);
    return v;
}
__device__ __forceinline__ float wave_max(float v) {
#pragma unroll
    for (int o = 1; o < 64; o <<= 1) v = fmaxf(v, __shfl_xor(v, o));
    return v;
}
__device__ __forceinline__ float bf_lo(unsigned u) { return __uint_as_float(u << 16); }
__device__ __forceinline__ float bf_hi(unsigned u) { return __uint_as_float(u & 0xffff0000u); }

namespace pg8 {
constexpr int XMP = 16384;
template <int NL>
__device__ __forceinline__ float row_rinv(const float* ssp, int row, int np, int fq) {
    const float* p = ssp + (size_t)row * 64 + (np >> 2) * fq;
    f32x4 v[NL];
#pragma unroll
    for (int i = 0; i < NL; ++i) v[i] = *(const f32x4*)(p + 4 * i);
    float s = 0.f, s2 = 0.f;
#pragma unroll
    for (int i = 0; i < NL / 2; ++i) { s += (v[i][0] + v[i][1]) + (v[i][2] + v[i][3]); s2 += (v[NL / 2 + i][0] + v[NL / 2 + i][1]) + (v[NL / 2 + i][2] + v[NL / 2 + i][3]); }
    s += (np == 16 * NL) ? s2 : 0.f;
    s += __shfl_xor(s, 16); s += __shfl_xor(s, 32);
    return rsqrtf(s * (1.0f / 1024.0f) + 1e-6f);
}
constexpr int RINV_TAB_OFF = 135680;
__device__ __forceinline__ void unit_rinv_to_lds(PG8_LAS unsigned char* lds, const float* ssp, int pm, int np, int nps) {
    int t = threadIdx.x; asm volatile("" : "+v"(t));
    PG8_LAS float* tab = (PG8_LAS float*)(lds + RINV_TAB_OFF);
    if (t < 288) {
        const bool smp = t >= 256; const int hf = smp ? ((t - 256) >> 4) : 0;
        const int row = smp ? XMP + pm * 16 + (t & 15) : pm * BM + t; const int n = (smp ? nps : np) - 32 * hf;
        const float* p = ssp + (size_t)row * 64 + 32 * hf;
        f32x4 v[8];
#pragma unroll
        for (int i = 0; i < 8; ++i) v[i] = *(const f32x4*)(p + 4 * i);
        float s = 0.f;
#pragma unroll
        for (int i = 0; i < 8; ++i) { const float si = (v[i][0] + v[i][1]) + (v[i][2] + v[i][3]); s += (4 * i < n) ? si : 0.f; }
        if (smp) s += __shfl_xor(s, 16);
        if (t < 272) tab[t] = rsqrtf(s * (1.0f / 1024.0f) + 1e-6f);
    }
    asm volatile("s_waitcnt lgkmcnt(0)" ::: "memory"); __builtin_amdgcn_s_barrier(); asm volatile("" ::: "memory");
}
__device__ __forceinline__ u32x4 pack8(const f32x4 a, const f32x4 b) { u32x4 w; w.x = cvt_pk_bf16(a[0], a[1]); w.y = cvt_pk_bf16(a[2], a[3]); w.z = cvt_pk_bf16(b[0], b[1]); w.w = cvt_pk_bf16(b[2], b[3]); return w; }
typedef unsigned u32x2 __attribute__((ext_vector_type(2)));
__device__ __forceinline__ u32x2 pack4(const f32x4 a) { u32x2 w; w.x = cvt_pk_bf16(a[0], a[1]); w.y = cvt_pk_bf16(a[2], a[3]); return w; }
__device__ __forceinline__ float sumsq4(const f32x4 v) { return (v[0] * v[0] + v[1] * v[1]) + (v[2] * v[2] + v[3] * v[3]); }

struct EpiQKV {
    static constexpr bool PERM = true, AFTER_DRAIN = false;
    bf16_t *Q, *K, *V; const float* ssp; int np, nps; float *kp, *vp, *ks, *vs;
    __device__ __forceinline__ void operator()(const f32x4 (&acc)[2][2][4][2], const f32x4 (&accx)[2], const Unit& u, int wr, int wc, int fr, int fq, PG8_LAS unsigned char* lds) const {
        const int rowb = u.pm * BM + wr * 64 + fr, pn = u.pn;
        { PG8_LAS int* lastpm = (PG8_LAS int*)(lds + RINV_TAB_OFF + 1088 + 64);
          if (*lastpm != u.pm) { unit_rinv_to_lds(lds, ssp, u.pm, np, nps); if (threadIdx.x == 0) *lastpm = u.pm; } }
        float rr[2][4];
        { const PG8_LAS float* tab = (const PG8_LAS float*)(lds + RINV_TAB_OFF);
#pragma unroll
          for (int ai = 0; ai < 2; ++ai)
#pragma unroll
              for (int m = 0; m < 4; ++m) rr[ai][m] = tab[ai * HALF + wr * 64 + m * 16 + fr]; }
        const float rx = ((const PG8_LAS float*)(lds + RINV_TAB_OFF))[256 + fr];
#pragma unroll
        for (int ai = 0; ai < 2; ++ai)
#pragma unroll
            for (int m = 0; m < 4; ++m) {
                const int row = rowb + ai * HALF + m * 16;
                const float r = rr[ai][m];
#pragma unroll
                for (int bj = 0; bj < 2; ++bj) {
                    const f32x4 v0 = acc[ai][bj][m][0] * r, v1 = acc[ai][bj][m][1] * r;
                    const int cl = bj * HALF + wc * 32 + 8 * fq;
                    const u32x4 w = pack8(v0, v1);
                    if (pn < 4) { *(u32x4*)(Q + (size_t)row * 1024 + pn * 256 + cl) = w; }
                    else {
                        bf16_t* B = (pn == 4) ? K : V;
                        *(u32x4*)(B + (size_t)row * 256 + cl) = w;
                        const int t = row & 8191;
                        if (t >= 8064) { float* o = ((pn == 4) ? kp : vp) + ((size_t)(row >> 13) * 128 + (t - 8064)) * 256 + cl; *(f32x4*)o = v0; *(f32x4*)(o + 4) = v1; }
                    }
                }
            }
        {
            const int xrow = u.pm * 16 + fr, row = XMP + xrow;
            const float r = rx;
#pragma unroll
            for (int bj = 0; bj < 2; ++bj) {
                const f32x4 v = accx[bj] * r;
                const int cl = bj * HALF + wc * 32 + 8 * fq + 4 * wr;
                const u32x2 w = pack4(v);
                if (pn < 4) { *(u32x2*)(Q + (size_t)row * 1024 + pn * 256 + cl) = w; }
                else {
                    bf16_t* B = (pn == 4) ? K : V;
                    *(u32x2*)(B + (size_t)row * 256 + cl) = w;
                    float* o = ((pn == 4) ? ks : vs) + ((size_t)(xrow >> 3) * 128 + 120 + (xrow & 7)) * 256 + cl; *(f32x4*)o = v;
                }
            }
        }
    }
};
__device__ __forceinline__ void unpack8(const u32x4 w, f32x4& a, f32x4& b) {
    a[0] = __uint_as_float(w.x << 16); a[1] = __uint_as_float(w.x & 0xffff0000u); a[2] = __uint_as_float(w.y << 16); a[3] = __uint_as_float(w.y & 0xffff0000u);
    b[0] = __uint_as_float(w.z << 16); b[1] = __uint_as_float(w.z & 0xffff0000u); b[2] = __uint_as_float(w.w << 16); b[3] = __uint_as_float(w.w & 0xffff0000u); }
__device__ __forceinline__ f32x4 unpack4(const u32x2 w) { f32x4 a; a[0] = __uint_as_float(w.x << 16); a[1] = __uint_as_float(w.x & 0xffff0000u); a[2] = __uint_as_float(w.y << 16); a[3] = __uint_as_float(w.y & 0xffff0000u); return a; }
struct EpiRes {
    static constexpr bool PERM = true, AFTER_DRAIN = false;
    bf16_t* XB; float* ssp;
    __device__ __forceinline__ void operator()(const f32x4 (&acc)[2][2][4][2], const f32x4 (&accx)[2], const Unit& u, int wr, int wc, int fr, int fq, PG8_LAS unsigned char* lds) const {
        const int rowb = u.pm * BM + wr * 64 + fr, pn = u.pn;
        const int colb = pn * 256 + wc * 32 + 8 * fq;
        const int xrow = u.pm * 16 + fr;
        bf16_t* xbx = XB + (size_t)(XMP + xrow) * 1024 + colb + 4 * wr;
        u32x2 ox[2];
#pragma unroll
        for (int bj = 0; bj < 2; ++bj) ox[bj] = *(const u32x2*)(xbx + bj * HALF);
#pragma unroll
        for (int am = 0; am < 8; am += 4) {
            u32x4 o[4][2];
#pragma unroll
            for (int h = 0; h < 4; ++h)
#pragma unroll
                for (int bj = 0; bj < 2; ++bj) o[h][bj] = *(const u32x4*)(XB + (size_t)(rowb + ((am + h) >> 2) * HALF + ((am + h) & 3) * 16) * 1024 + colb + bj * HALF);
#pragma unroll
            for (int h = 0; h < 4; ++h) {
                const int ai = (am + h) >> 2, m = (am + h) & 3;
                const int row = rowb + ai * HALF + m * 16;
                float ss = 0.f;
#pragma unroll
                for (int bj = 0; bj < 2; ++bj) {
                    f32x4 o0, o1; unpack8(o[h][bj], o0, o1);
                    const f32x4 v0 = acc[ai][bj][m][0] + o0, v1 = acc[ai][bj][m][1] + o1;
                    *(u32x4*)(XB + (size_t)row * 1024 + colb + bj * HALF) = pack8(v0, v1);
                    ss += sumsq4(v0) + sumsq4(v1);
                }
                ss += __shfl_xor(ss, 16); ss += __shfl_xor(ss, 32);
                if (fq == 0) ssp[(size_t)row * 64 + pn * 4 + wc] = ss;
            }
            asm volatile("" ::: "memory");
        }
        {
            const int row = XMP + xrow;
            float ss = 0.f;
#pragma unroll
            for (int bj = 0; bj < 2; ++bj) {
                const f32x4 v = accx[bj] + unpack4(ox[bj]);
                *(u32x2*)(xbx + bj * HALF) = pack4(v);
                ss += sumsq4(v);
            }
            ss += __shfl_xor(ss, 16); ss += __shfl_xor(ss, 32);
            if (fq == 0) ssp[(size_t)row * 64 + (pn * 4 + wc) * 2 + wr] = ss;
        }
    }
};
struct EpiGlu {
    static constexpr bool PERM = true, AFTER_DRAIN = false;
    bf16_t* XB; float* ssp;
    __device__ __forceinline__ void operator()(const f32x4 (&acc)[2][2][4][2], const f32x4 (&accx)[2], const Unit& u, int wr, int wc, int fr, int fq, PG8_LAS unsigned char* lds) const {
        const int rowb = u.pm * BM + wr * 64 + fr, pn = u.pn;
        const int col = pn * 128 + wc * 32 + 8 * fq;
        const int xrow = u.pm * 16 + fr;
        bf16_t* xbx = XB + (size_t)(XMP + xrow) * 1024 + col + 4 * wr;
        const u32x2 ox = *(const u32x2*)xbx;
#pragma unroll
        for (int am = 0; am < 8; am += 4) {
            u32x4 o[4];
#pragma unroll
            for (int h = 0; h < 4; ++h) o[h] = *(const u32x4*)(XB + (size_t)(rowb + ((am + h) >> 2) * HALF + ((am + h) & 3) * 16) * 1024 + col);
#pragma unroll
            for (int h = 0; h < 4; ++h) {
                const int ai = (am + h) >> 2, m = (am + h) & 3;
                const int row = rowb + ai * HALF + m * 16;
                f32x4 v0, v1; unpack8(o[h], v0, v1);
#pragma unroll
                for (int e = 0; e < 4; ++e) {
                    v0[e] += acc[ai][0][m][0][e] * __builtin_amdgcn_rcpf(1.0f + __expf(-acc[ai][1][m][0][e]));
                    v1[e] += acc[ai][0][m][1][e] * __builtin_amdgcn_rcpf(1.0f + __expf(-acc[ai][1][m][1][e]));
                }
                *(u32x4*)(XB + (size_t)row * 1024 + col) = pack8(v0, v1);
                float ss = sumsq4(v0) + sumsq4(v1);
                ss += __shfl_xor(ss, 16); ss += __shfl_xor(ss, 32);
                if (fq == 0) ssp[(size_t)row * 64 + pn * 4 + wc] = ss;
            }
            asm volatile("" ::: "memory");
        }
        {
            const int row = XMP + xrow;
            f32x4 v = unpack4(ox);
#pragma unroll
            for (int e = 0; e < 4; ++e) v[e] += accx[0][e] * __builtin_amdgcn_rcpf(1.0f + __expf(-accx[1][e]));
            *(u32x2*)xbx = pack4(v);
            float ss = sumsq4(v);
            ss += __shfl_xor(ss, 16); ss += __shfl_xor(ss, 32);
            if (fq == 0) ssp[(size_t)row * 64 + (pn * 4 + wc) * 2 + wr] = ss;
        }
    }
};
struct EpiUp {
    static constexpr bool PERM = true, AFTER_DRAIN = false;
    bf16_t* H; bf16_t* Hx; const float* ssp; int np, nps;
    __device__ __forceinline__ void operator()(const f32x4 (&acc)[2][2][4][2], const f32x4 (&accx)[2], const Unit& u, int wr, int wc, int fr, int fq, PG8_LAS unsigned char* lds) const {
        const int rowb = u.pm * BM + wr * 64 + fr, pn = u.pn;
        { PG8_LAS int* lastpm = (PG8_LAS int*)(lds + RINV_TAB_OFF + 1088 + 64);
          if (*lastpm != u.pm) { unit_rinv_to_lds(lds, ssp, u.pm, np, nps); if (threadIdx.x == 0) *lastpm = u.pm; } }
        float rr[2][4];
        { const PG8_LAS float* tab = (const PG8_LAS float*)(lds + RINV_TAB_OFF);
#pragma unroll
          for (int ai = 0; ai < 2; ++ai)
#pragma unroll
              for (int m = 0; m < 4; ++m) rr[ai][m] = tab[ai * HALF + wr * 64 + m * 16 + fr]; }
        const float rx = ((const PG8_LAS float*)(lds + RINV_TAB_OFF))[256 + fr];
#pragma unroll
        for (int ai = 0; ai < 2; ++ai)
#pragma unroll
            for (int m = 0; m < 4; ++m) {
                const int row = rowb + ai * HALF + m * 16;
                const float r = rr[ai][m];
#pragma unroll
                for (int bj = 0; bj < 2; ++bj) {
                    f32x4 v0 = acc[ai][bj][m][0] * r, v1 = acc[ai][bj][m][1] * r;
#pragma unroll
                    for (int e = 0; e < 4; ++e) { const float a = fmaxf(v0[e], 0.f), b = fmaxf(v1[e], 0.f); v0[e] = a * a; v1[e] = b * b; }
                    *(u32x4*)((char*)H + (((size_t)u.pm * 64 + (4 * pn + 2 * bj + (wc >> 1))) * 2 + ai) * 16384 + lds_byte(wr * 64 + m * 16 + fr, 32 * (wc & 1) + 8 * fq)) = pack8(v0, v1);
                }
            }
        {
            const int xrow = u.pm * 16 + fr, row = XMP + xrow;
            const float r = rx;
#pragma unroll
            for (int bj = 0; bj < 2; ++bj) {
                f32x4 v = accx[bj] * r;
#pragma unroll
                for (int e = 0; e < 4; ++e) { const float a = fmaxf(v[e], 0.f); v[e] = a * a; }
                *(u32x2*)((char*)Hx + ((size_t)u.pm * 64 + (4 * pn + 2 * bj + (wc >> 1))) * 2048 + lds_byte(fr, 32 * (wc & 1) + 8 * fq) + 8 * wr) = pack4(v);
            }
        }
    }
};

struct GemmX { const bf16_t* A; const bf16_t* Bt; const bf16_t* Ax; int K; };
template <class Epi, class Sched, int KREP = 1, int EREP = 1, int SKEW_TICKS = 0, bool ATILED = false>
__device__ __forceinline__ void gemm_phase_x(PG8_LAS unsigned char* lds, const GemmX g, const Sched& S, const Epi& E) {
    int tid_ = threadIdx.x; asm volatile("" : "+v"(tid_));
    const int tid = tid_, wid = __builtin_amdgcn_readfirstlane(tid >> 6), lane = tid & 63, wr = wid >> 2, wc = wid & 3, fr = lane & 15, fq = lane >> 4;
    const int K = g.K, nt = K / BK;
    unsigned voffA[2], voffB[2], voffX;
#pragma unroll
    for (int i = 0; i < 2; ++i) { int R, C; stage_rc(tid * 16 + i * 8192, R, C); const int Rb = Epi::PERM ? ((R & ~31) + perm32(R & 31)) : R;
        voffA[i] = ATILED ? (unsigned)(tid * 16 + i * 8192) : (unsigned)(R * K + C) * 2u; voffB[i] = (unsigned)(Rb * K + C) * 2u; }
    { int R, C; const int p = wid * 256 + lane * 4; stage_rc(p & ~15, R, C); voffX = ATILED ? (unsigned)p : (unsigned)(R * K + C) * 2u + (unsigned)(p & 15); }
    const size_t kstepB = (size_t)(BK * 2), hstepB = (size_t)HALF * K * 2, tstepB = 2 * hstepB;
    const size_t kstepA = ATILED ? (size_t)32768 : kstepB, hstepA = ATILED ? (size_t)16384 : hstepB, tstepA = ATILED ? (size_t)nt * 32768 : tstepB;
    const size_t kstepX = ATILED ? (size_t)2048 : kstepB, xstep = ATILED ? (size_t)nt * 2048 : (size_t)16 * K * 2;
    const unsigned ldsw = (unsigned)wid * 1024u, ldsx = (unsigned)wid * 256u;
    const int aoff = lds_byte(wr * 64 + fr, fq * 8), boff = lds_byte(wc * 32 + fr, fq * 8), xoff = lds_byte(fr, fq * 8);
#define PG8_SA(b, h) (((b) * 2 + (h)) * HTB)
#define PG8_SB(b, h) ((4 + (b) * 2 + (h)) * HTB)
#define PG8_XA(b) (STAGE_BYTES + (b) * 2048)
#define PG8_STAGE(bufoff, gbase, voff) do { _Pragma("unroll") for (int _i = 0; _i < 2; ++_i) \
        __builtin_amdgcn_global_load_lds((const unsigned*)((const char*)(gbase) + (voff)[_i]), (PG8_LAS unsigned*)(lds + (bufoff) + ldsw + _i * 8192), 16, 0, 0); } while (0)
#define PG8_STAGEX(b, gbase) __builtin_amdgcn_global_load_lds((const unsigned*)((const char*)(gbase) + voffX), (PG8_LAS unsigned*)(lds + PG8_XA(b) + ldsx), 4, 0, 0)
#define PG8_LDA(dst, b, h) do { _Pragma("unroll") for (int m = 0; m < 4; ++m) _Pragma("unroll") for (int k = 0; k < 2; ++k) dst[m][k] = *(const PG8_LAS bf16x8*)(lds + PG8_SA(b, h) + aoff + m * 2048 + k * 1024); } while (0)
#define PG8_LDB(dst, b, h) do { _Pragma("unroll") for (int n = 0; n < 2; ++n) _Pragma("unroll") for (int k = 0; k < 2; ++k) dst[n][k] = *(const PG8_LAS bf16x8*)(lds + PG8_SB(b, h) + boff + n * 2048 + k * 1024); } while (0)
#define PG8_LDX(dst, b) do { _Pragma("unroll") for (int k = 0; k < 2; ++k) dst[k] = *(const PG8_LAS bf16x8*)(lds + PG8_XA(b) + xoff + k * 1024); } while (0)
#define PG8_MMA(ai, bj, At, Bt) do { __builtin_amdgcn_s_setprio(1); _Pragma("unroll") for (int m = 0; m < 4; ++m) _Pragma("unroll") for (int n = 0; n < 2; ++n) _Pragma("unroll") for (int k = 0; k < 2; ++k) \
        acc[ai][bj][m][n] = __builtin_amdgcn_mfma_f32_16x16x32_bf16(Bt[n][k], At[m][k], acc[ai][bj][m][n], 0, 0, 0); __builtin_amdgcn_s_setprio(0); } while (0)
#define PG8_XMMA() do { if (wr == 0) { _Pragma("unroll") for (int k = 0; k < 2; ++k) { accx[0] = __builtin_amdgcn_mfma_f32_16x16x32_bf16(B0[0][k], Ax[k], accx[0], 0, 0, 0); accx[1] = __builtin_amdgcn_mfma_f32_16x16x32_bf16(B1[0][k], Ax[k], accx[1], 0, 0, 0); } } \
        else { _Pragma("unroll") for (int k = 0; k < 2; ++k) { accx[0] = __builtin_amdgcn_mfma_f32_16x16x32_bf16(B0[1][k], Ax[k], accx[0], 0, 0, 0); accx[1] = __builtin_amdgcn_mfma_f32_16x16x32_bf16(B1[1][k], Ax[k], accx[1], 0, 0, 0); } } } while (0)
#define PG8_WAIT_V(n) asm volatile("s_waitcnt vmcnt(" #n ")" ::: "memory")
#define PG8_WAIT_L(n) asm volatile("s_waitcnt lgkmcnt(" #n ")" ::: "memory")
#define PG8_BAR __builtin_amdgcn_s_barrier()
#define PG8_SCHED __builtin_amdgcn_sched_barrier(0)
    Unit cur, nxt; int ui = 0;
    if (!S.next(0, cur)) return;
    if (SKEW_TICKS > 0) { const unsigned long long t0 = __builtin_amdgcn_s_memrealtime(); const unsigned long long dl = (unsigned long long)SKEW_TICKS * (unsigned)((blockIdx.x >> 3) & 3);
        while (__builtin_amdgcn_s_memrealtime() - t0 < dl) __builtin_amdgcn_s_sleep(8); }
    f32x4 acc[2][2][4][2]; f32x4 accx[2];
#pragma unroll
    for (int a = 0; a < 2; ++a)
#pragma unroll
        for (int b = 0; b < 2; ++b)
#pragma unroll
            for (int m = 0; m < 4; ++m)
#pragma unroll
                for (int n = 0; n < 2; ++n) acc[a][b][m][n] = (f32x4){0.f, 0.f, 0.f, 0.f};
    accx[0] = (f32x4){0.f, 0.f, 0.f, 0.f}; accx[1] = (f32x4){0.f, 0.f, 0.f, 0.f};
    bf16x8 At[4][2], B0[2][2], B1[2][2], Ax[2];
    const char* const xbase = ATILED ? (const char*)g.Ax : (const char*)g.A + (size_t)XMP * K * 2;
    const char* cA = (const char*)g.A + (size_t)cur.pm * tstepA; const char* cB = (const char*)g.Bt + (size_t)cur.pn * tstepB; const char* cX = xbase + (size_t)cur.pm * xstep;
    S.a_ready(cur);
    PG8_STAGE(PG8_SB(0, 0), cB, voffB); PG8_STAGE(PG8_SB(0, 1), cB + hstepB, voffB); PG8_STAGE(PG8_SA(0, 0), cA, voffA); PG8_STAGEX(0, cX); PG8_STAGE(PG8_SA(0, 1), cA + hstepA, voffA);
    if (wr == 1) PG8_BAR;
    PG8_WAIT_V(2); PG8_BAR;
    PG8_STAGE(PG8_SB(1, 0), cB + kstepB, voffB); PG8_STAGE(PG8_SA(1, 0), cA + kstepA, voffA); PG8_STAGE(PG8_SB(1, 1), cB + hstepB + kstepB, voffB); PG8_STAGEX(1, cX + kstepX);
    PG8_WAIT_V(7); PG8_BAR;
    for (;;) {
        const bool has_next = S.next(ui + 1, nxt);
        const char* nA = has_next ? (const char*)g.A + (size_t)nxt.pm * tstepA : cA; const char* nB = has_next ? (const char*)g.Bt + (size_t)nxt.pn * tstepB : cB; const char* nX = has_next ? xbase + (size_t)nxt.pm * xstep : cX;
        for (int kr = 0; kr < KREP; ++kr) {
        const bool fin = (kr == KREP - 1);
        if (KREP > 1 && kr > 0) {
#pragma unroll
            for (int a = 0; a < 2; ++a)
#pragma unroll
                for (int b = 0; b < 2; ++b)
#pragma unroll
                    for (int m = 0; m < 4; ++m)
#pragma unroll
                        for (int n = 0; n < 2; ++n) acc[a][b][m][n] = (f32x4){0.f, 0.f, 0.f, 0.f};
            accx[0] = (f32x4){0.f, 0.f, 0.f, 0.f}; accx[1] = (f32x4){0.f, 0.f, 0.f, 0.f};
        }
        for (int t = 0; t < nt; t += 2) {
            const bool last = (t == nt - 2);
            const char* a1 = cA + (size_t)(t + 1) * kstepA;
            const char* a2 = last ? (fin ? nA : cA) : cA + (size_t)(t + 2) * kstepA; const char* b2 = last ? (fin ? nB : cB) : cB + (size_t)(t + 2) * kstepB; const char* x2 = last ? (fin ? nX : cX) : cX + (size_t)(t + 2) * kstepX;
            const char* a3 = a2 + kstepA; const char* b3 = b2 + kstepB; const char* x3 = x2 + kstepX;
            if (last && has_next && fin) S.a_ready(nxt);
            PG8_LDB(B0, 0, 0); PG8_LDB(B1, 0, 1); PG8_SCHED; PG8_LDA(At, 0, 0); PG8_LDX(Ax, 0); PG8_STAGE(PG8_SA(1, 1), a1 + hstepA, voffA);
            PG8_WAIT_V(9); PG8_WAIT_L(0); PG8_BAR; PG8_MMA(0, 0, At, B0); PG8_MMA(0, 1, At, B1); PG8_XMMA(); PG8_BAR; PG8_SCHED;
            PG8_LDA(At, 0, 1); PG8_STAGE(PG8_SB(0, 0), b2, voffB); PG8_STAGE(PG8_SB(0, 1), b2 + hstepB, voffB); PG8_STAGE(PG8_SA(0, 0), a2, voffA); PG8_STAGEX(0, x2);
            PG8_WAIT_V(9); PG8_WAIT_L(0); PG8_BAR; PG8_MMA(1, 0, At, B0); PG8_MMA(1, 1, At, B1); PG8_BAR; PG8_SCHED;
            PG8_LDB(B0, 1, 0); PG8_LDB(B1, 1, 1); PG8_SCHED; PG8_LDA(At, 1, 0); PG8_LDX(Ax, 1); PG8_STAGE(PG8_SA(0, 1), a2 + hstepA, voffA);
            PG8_WAIT_V(9); PG8_WAIT_L(0); PG8_BAR; PG8_MMA(0, 0, At, B0); PG8_MMA(0, 1, At, B1); PG8_XMMA(); PG8_BAR; PG8_SCHED;
            PG8_LDA(At, 1, 1); PG8_STAGE(PG8_SB(1, 0), b3, voffB); PG8_STAGE(PG8_SB(1, 1), b3 + hstepB, voffB); PG8_STAGE(PG8_SA(1, 0), a3, voffA); PG8_STAGEX(1, x3);
            PG8_WAIT_V(9); PG8_WAIT_L(0); PG8_BAR; PG8_MMA(1, 0, At, B0); PG8_MMA(1, 1, At, B1); PG8_BAR; PG8_SCHED;
        }
        }
        if (wr == 0) PG8_BAR;
        { int fr_ = fr, fq_ = fq; asm volatile("" : "+v"(fr_), "+v"(fq_));
          for (int er = 0; er < EREP; ++er) E(acc, accx, cur, wr, wc, fr_, fq_, lds); } S.done(cur);
        if (!has_next) break;
#pragma unroll
        for (int a = 0; a < 2; ++a)
#pragma unroll
            for (int b = 0; b < 2; ++b)
#pragma unroll
                for (int m = 0; m < 4; ++m)
#pragma unroll
                    for (int n = 0; n < 2; ++n) acc[a][b][m][n] = (f32x4){0.f, 0.f, 0.f, 0.f};
        accx[0] = (f32x4){0.f, 0.f, 0.f, 0.f}; accx[1] = (f32x4){0.f, 0.f, 0.f, 0.f};
        cur = nxt; cA = nA; cB = nB; cX = nX; ++ui;
        if (wr == 1) PG8_BAR;
    }
    PG8_WAIT_V(0);
    PG8_BAR;
#undef PG8_SA
#undef PG8_SB
#undef PG8_XA
#undef PG8_STAGE
#undef PG8_STAGEX
#undef PG8_LDA
#undef PG8_LDB
#undef PG8_LDX
#undef PG8_MMA
#undef PG8_XMMA
#undef PG8_WAIT_V
#undef PG8_WAIT_L
#undef PG8_BAR
#undef PG8_SCHED
}
}

__device__ __forceinline__ void p0_transpose_item(const float* W, int K, int N, const float* gain, bf16* WT, int glu, LAS float* scr, int item, int lane) {
    const int nblk = N / 64, kb = item / nblk, nb = item % nblk, k0 = 64 * kb, n0 = 64 * nb;
    const int q = lane & 15, kr = lane >> 4;
    f32x4 v[16];
#pragma unroll
    for (int i = 0; i < 16; ++i) v[i] = *(const f32x4*)(W + (size_t)(k0 + 4 * i + kr) * N + n0 + 4 * q);
    if (gain) {
#pragma unroll
        for (int i = 0; i < 16; ++i) v[i] = v[i] * gain[k0 + 4 * i + kr];
    }
#pragma unroll
    for (int i = 0; i < 16; ++i) { LAS float* d = scr + (4 * i + kr) * 65 + 4 * q; d[0] = v[i][0]; d[1] = v[i][1]; d[2] = v[i][2]; d[3] = v[i][3]; }
    LDS_WAIT(); asm volatile("" ::: "memory");
    int drow0 = n0; if (glu) { const int bj = n0 / 1024, rem = n0 % 1024; drow0 = (rem / 128) * 256 + bj * 128 + (rem % 128); }
    const int c = lane & 7;
#pragma unroll
    for (int j = 0; j < 8; ++j) { const int n = (lane >> 3) + 8 * j; const LAS float* sp = scr + (8 * c) * 65 + n;
        v4u o; o.x = pk2(sp[0 * 65], sp[1 * 65]); o.y = pk2(sp[2 * 65], sp[3 * 65]); o.z = pk2(sp[4 * 65], sp[5 * 65]); o.w = pk2(sp[6 * 65], sp[7 * 65]);
        *(GAS v4u*)(WT + (size_t)(drow0 + n) * K + k0 + 8 * c) = o; }
    LDS_WAIT(); asm volatile("" ::: "memory");
}

__device__ __forceinline__ void sincos_rr(float x, float& s, float& c) {
    const float q = rintf(x * 0.63661977236758f);
    float r = fmaf(-q, 1.57079637050629f, x); r = fmaf(-q, -4.37113882867379e-8f, r);
    const float r2 = r * r;
    const float sp = r + r * r2 * (-1.6666667163e-1f + r2 * (8.3333337680e-3f + r2 * (-1.9841270114e-4f + r2 * 2.7557314297e-6f)));
    const float cp = 1.0f + r2 * (-0.5f + r2 * (4.1666667908e-2f + r2 * (-1.3888889225e-3f + r2 * (2.4801587642e-5f + r2 * -2.7557314297e-7f))));
    const int qi = (int)q & 3;
    s = (qi == 0) ? sp : (qi == 1) ? cp : (qi == 2) ? -sp : -cp;
    c = (qi == 0) ? cp : (qi == 1) ? -sp : (qi == 2) ? -cp : sp;
}

typedef float f32x16 __attribute__((ext_vector_type(16)));
typedef float f32x2_t __attribute__((ext_vector_type(2))); typedef __bf16 bf16x2_t __attribute__((ext_vector_type(2)));
__device__ __forceinline__ unsigned cvtpk_c(float lo, float hi) { f32x2_t v = {lo, hi}; bf16x2_t b = __builtin_convertvector(v, bf16x2_t); return __builtin_bit_cast(unsigned, b); }
typedef unsigned u32x2 __attribute__((ext_vector_type(2)));
__device__ __forceinline__ void ssm_abar_calc(const float* A_re, const float* A_im, const float* log_dt, int g, int n, float& abr, float& abi, float& cfr, float& cfi) {
    const float dt = expf(log_dt[g]);
    const float ar = A_re[g * 64 + n], ai = A_im[g * 64 + n];
    const float mag = expf(dt * ar); float sn, cs; sincos_rr(dt * ai, sn, cs);
    abr = mag * cs; abi = mag * sn;
    const float den = ar * ar + ai * ai, nr = abr - 1.0f;
    cfr = (nr * ar + abi * ai) / den; cfi = (abi * ar - nr * ai) / den;
}
__device__ __forceinline__ float gelu_tanh(float y) {
    const float z = 0.7978845608028654f * (y + 0.044715f * y * y * y);
    return y * __builtin_amdgcn_rcpf(1.0f + __expf(-2.0f * z));
}
__device__ __forceinline__ void wg_rinv(LAS float* tab, const float* ssp, int row0, int nrows, int np, int tid) {
    __syncthreads();
    const int row = tid >> 1, hf = tid & 1;
    if (row < nrows) {
        const float* p = ssp + (size_t)(row0 + row) * 64 + (np >> 1) * hf;
        f32x4 v[4];
#pragma unroll
        for (int i = 0; i < 4; ++i) v[i] = *(const f32x4*)(p + 4 * i);
        float s_ = ((v[0][0] + v[0][1]) + (v[0][2] + v[0][3])) + ((v[1][0] + v[1][1]) + (v[1][2] + v[1][3]));
        const float s2 = ((v[2][0] + v[2][1]) + (v[2][2] + v[2][3])) + ((v[3][0] + v[3][1]) + (v[3][2] + v[3][3]));
        s_ += (np == 32) ? s2 : 0.f;
        s_ += __shfl_xor(s_, 1);
        if (hf == 0) tab[row] = rsqrtf(s_ * (1.0f / 1024.0f) + 1e-6f);
    }
    __syncthreads();
}
struct SsmT { const bf16* BT; const bf16* CT; const float* tab; const float* Dk; const float* gain; };
template <int MODE>
__device__ __forceinline__ void ssm_mfma_unit(LAS unsigned char* wl, int lane, int g, const SsmT& T, const bf16* XB, const LAS float* rv, int row0, int nblk,
                                              float (&st)[4]  , bf16* Gout, const float* h0r, const float* h0i, float* hor, float* hoi  , int b0) {
    const int r32 = lane & 31, hi5 = lane >> 5, c16 = lane & 15, kq = lane >> 4;
    pg8::bf16x8 bt[4], ct[4];
#pragma unroll
    for (int tn = 0; tn < 4; ++tn) bt[tn] = *(const pg8::bf16x8*)(T.BT + (size_t)(tn * 32 + r32) * 16 + 8 * hi5);
    if (MODE != 0) {
#pragma unroll
        for (int ks = 0; ks < 4; ++ks) ct[ks] = *(const pg8::bf16x8*)(T.CT + (size_t)c16 * 128 + 32 * ks + 8 * kq);
    }
    float ar[2], ai[2];
    { const f32x4 t0 = *(const f32x4*)(T.tab + (size_t)r32 * 4), t1 = *(const f32x4*)(T.tab + (size_t)(32 + r32) * 4); ar[0] = t0[0]; ai[0] = t0[1]; ar[1] = t1[0]; ai[1] = t1[1]; }
    f32x4 Dg = {0.f, 0.f, 0.f, 0.f};
    if (MODE != 0) { const f32x4 dv = *(const f32x4*)(T.Dk + 4 * kq), gv = *(const f32x4*)(T.gain + 4 * kq); Dg = dv * gv; }
    float pwr[2][16], pwi[2][16], a32r[2], a32i[2];
    if (MODE == 0) {
#pragma unroll
        for (int p = 0; p < 2; ++p) {
            const float a_r = ar[p], a_i = ai[p];
            float a2r = a_r * a_r - a_i * a_i, a2i = 2.0f * a_r * a_i;
            float a4r = a2r * a2r - a2i * a2i, a4i = 2.0f * a2r * a2i;
            const float a5r = a4r * a_r - a4i * a_i, a5i = a4r * a_i + a4i * a_r;
            float cr = hi5 ? 1.0f : a4r, ci = hi5 ? 0.0f : a4i;
#pragma unroll
            for (int Q = 3; Q >= 0; --Q) {
#pragma unroll
                for (int e = 3; e >= 0; --e) {
                    pwr[p][4 * Q + e] = cr; pwi[p][4 * Q + e] = ci;
                    const float mr = (e == 0) ? a5r : a_r, mi = (e == 0) ? a5i : a_i;
                    const float tr = cr * mr - ci * mi, ti = cr * mi + ci * mr; cr = tr; ci = ti;
                }
            }
            float t8r = a4r * a4r - a4i * a4i, t8i = 2.0f * a4r * a4i;
            float t16r = t8r * t8r - t8i * t8i, t16i = 2.0f * t8r * t8i;
            a32r[p] = t16r * t16r - t16i * t16i; a32i[p] = 2.0f * t16r * t16i;
        }
    }
    pg8::bf16x8 xa_all[8];
    if (MODE != 2) {
#pragma unroll
        for (int k = 0; k < 8; ++k) xa_all[k] = *(const pg8::bf16x8*)(XB + (size_t)(row0 + 32 * k + r32) * 1024 + g * 16 + 8 * hi5);
    } else {
        xa_all[0] = *(const pg8::bf16x8*)(XB + (size_t)(row0 + r32) * 1024 + g * 16 + 8 * hi5);
    }
    for (int blk = 0; blk < nblk; ++blk) {
        const int rowb = row0 + 32 * blk;
        const pg8::bf16x8 xa = xa_all[0];
        if (MODE != 2) {
#pragma unroll
            for (int k = 0; k < 7; ++k) xa_all[k] = xa_all[k + 1];
        }
        if (MODE != 0) *(LAS pg8::bf16x8*)(wl + 9728 + r32 * 32 + hi5 * 16) = xa;
        const LAS float* rvb = rv + ((MODE == 2) ? 0 : 32 * blk);
        pg8::bf16x8 xs_;
        { const float rin = rvb[r32]; const v4u xw = __builtin_bit_cast(v4u, xa); v4u ow;
          ow.x = cvtpk_c(bf_lo(xw.x) * rin, bf_hi(xw.x) * rin); ow.y = cvtpk_c(bf_lo(xw.y) * rin, bf_hi(xw.y) * rin);
          ow.z = cvtpk_c(bf_lo(xw.z) * rin, bf_hi(xw.z) * rin); ow.w = cvtpk_c(bf_lo(xw.w) * rin, bf_hi(xw.w) * rin); xs_ = __builtin_bit_cast(pg8::bf16x8, ow); }
        f32x16 IN[4];
#pragma unroll
        for (int tn = 0; tn < 4; ++tn) { const f32x16 z = {0.f, 0.f, 0.f, 0.f, 0.f, 0.f, 0.f, 0.f, 0.f, 0.f, 0.f, 0.f, 0.f, 0.f, 0.f, 0.f}; IN[tn] = __builtin_amdgcn_mfma_f32_32x32x16_bf16(xs_, bt[tn], z, 0, 0, 0); }
        if (MODE == 0) {
#pragma unroll
            for (int p = 0; p < 2; ++p) {
                float er[2] = {0.f, 0.f}, ei[2] = {0.f, 0.f};
#pragma unroll
                for (int r = 0; r < 16; ++r) {
                    const float xr_ = IN[2 * p][r], xi_ = IN[2 * p + 1][r], wr_ = pwr[p][r], wi_ = pwi[p][r];
                    float t = fmaf(wr_, xr_, er[r & 1]); asm volatile("" : "+v"(t)); t = fmaf(-wi_, xi_, t); asm volatile("" : "+v"(t)); er[r & 1] = t;
                    float u = fmaf(wr_, xi_, ei[r & 1]); asm volatile("" : "+v"(u)); u = fmaf(wi_, xr_, u); asm volatile("" : "+v"(u)); ei[r & 1] = u;
                }
                float e_r = er[0] + er[1], e_i = ei[0] + ei[1];
                asm volatile("" : "+v"(e_r), "+v"(e_i));
                { auto w0 = __builtin_amdgcn_permlane32_swap(__float_as_uint(e_r), __float_as_uint(e_r), false, false); e_r = __uint_as_float(w0[0]) + __uint_as_float(w0[1]);
                  auto w1 = __builtin_amdgcn_permlane32_swap(__float_as_uint(e_i), __float_as_uint(e_i), false, false); e_i = __uint_as_float(w1[0]) + __uint_as_float(w1[1]); }
                asm volatile("" : "+v"(e_r), "+v"(e_i));
                const float sr = st[2 * p], si = st[2 * p + 1];
                float nr = fmaf(a32r[p], sr, e_r); asm volatile("" : "+v"(nr)); nr = fmaf(-a32i[p], si, nr); asm volatile("" : "+v"(nr));
                float ni = fmaf(a32r[p], si, e_i); asm volatile("" : "+v"(ni)); ni = fmaf(a32i[p], sr, ni); asm volatile("" : "+v"(ni));
                st[2 * p] = nr; st[2 * p + 1] = ni;
            }
        } else
#pragma unroll
        for (int p = 0; p < 2; ++p) {
            float sr = st[2 * p], si = st[2 * p + 1];
            const float a_r = ar[p], a_i = ai[p];
            const bool up = (hi5 != 0);
#pragma unroll
            for (int Q = 0; Q < 4; ++Q) {
                if (MODE == 2) { const size_t hidx = ((size_t)(b0 + Q) * 64 + g) * 64 + 32 * p + r32; sr = h0r[hidx]; si = h0i[hidx]; }
                float xr_[4], xi_[4], yr_[4], yi_[4];
                float cr = sr, ci = si;
#pragma unroll
                for (int e = 0; e < 4; ++e) { float tr = fmaf(a_r, cr, IN[2 * p][4 * Q + e]); asm volatile("" : "+v"(tr)); tr = fmaf(-a_i, ci, tr); asm volatile("" : "+v"(tr)); float ti = fmaf(a_r, ci, IN[2 * p + 1][4 * Q + e]); asm volatile("" : "+v"(ti)); ti = fmaf(a_i, cr, ti); asm volatile("" : "+v"(ti)); cr = tr; ci = ti; xr_[e] = cr; xi_[e] = ci; }
                { auto w0 = __builtin_amdgcn_permlane32_swap(__float_as_uint(cr), __float_as_uint(cr), false, false); cr = __uint_as_float(w0[0]);
                  auto w1 = __builtin_amdgcn_permlane32_swap(__float_as_uint(ci), __float_as_uint(ci), false, false); ci = __uint_as_float(w1[0]); }
#pragma unroll
                for (int e = 0; e < 4; ++e) { float tr = fmaf(a_r, cr, IN[2 * p][4 * Q + e]); asm volatile("" : "+v"(tr)); tr = fmaf(-a_i, ci, tr); asm volatile("" : "+v"(tr)); float ti = fmaf(a_r, ci, IN[2 * p + 1][4 * Q + e]); asm volatile("" : "+v"(ti)); ti = fmaf(a_i, cr, ti); asm volatile("" : "+v"(ti)); cr = tr; ci = ti; yr_[e] = cr; yi_[e] = ci; }
                { auto w0 = __builtin_amdgcn_permlane32_swap(__float_as_uint(cr), __float_as_uint(cr), false, false); sr = __uint_as_float(w0[1]);
                  auto w1 = __builtin_amdgcn_permlane32_swap(__float_as_uint(ci), __float_as_uint(ci), false, false); si = __uint_as_float(w1[1]); }
#pragma unroll
                for (int e = 0; e < 4; ++e) { IN[2 * p][4 * Q + e] = up ? yr_[e] : xr_[e]; IN[2 * p + 1][4 * Q + e] = up ? yi_[e] : xi_[e]; }
                if (MODE == 2) { if (hi5 == 0) { const size_t hidx = ((size_t)(b0 + Q) * 64 + g) * 64 + 32 * p + r32; hor[hidx] = sr; hoi[hidx] = si; } }
            }
            st[2 * p] = sr; st[2 * p + 1] = si;
        }
        if (MODE != 0) {
#pragma unroll
            for (int p = 0; p < 2; ++p)
#pragma unroll
                for (int r = 0; r < 16; ++r) { const int tau = 8 * (r >> 2) + 4 * hi5 + (r & 3); *(LAS unsigned*)(wl + tau * 272 + 4 * (32 * p + r32)) = pg8::cvt_pk_bf16(IN[2 * p][r], IN[2 * p + 1][r]); }
            LDS_WAIT(); asm volatile("" ::: "memory");
#pragma unroll
            for (int tt = 0; tt < 2; ++tt) {
                f32x4 y = {0.f, 0.f, 0.f, 0.f};
#pragma unroll
                for (int ks = 0; ks < 4; ++ks) { const pg8::bf16x8 hf = *(const LAS pg8::bf16x8*)(wl + (16 * tt + c16) * 272 + (32 * ks + 8 * kq) * 2); y = __builtin_amdgcn_mfma_f32_16x16x32_bf16(ct[ks], hf, y, 0, 0, 0); }
                const int token = rowb + 16 * tt + c16;
                const float rinv = rvb[16 * tt + c16];
                const f32x4 xv = pg8::unpack4(*(const LAS u32x2*)(wl + 9728 + (16 * tt + c16) * 32 + kq * 8));
                f32x4 o;
#pragma unroll
                for (int e = 0; e < 4; ++e) o[e] = gelu_tanh(y[e] + Dg[e] * (xv[e] * rinv));
                *(u32x2*)(Gout + (size_t)token * 1024 + g * 16 + 4 * kq) = pg8::pack4(o);
            }
        }
        LDS_WAIT(); asm volatile("" ::: "memory");
    }
}

#ifndef SKEW_UP
#define SKEW_UP 250
#define SKEW_GLU 250
#endif
#ifndef PROBE_DUP
#define PROBE_DUP 0
#endif
#define NREP(bit) (((PROBE_DUP) >> (bit)) & 1 ? 2 : 1)
#ifndef EN_P0
#define EN_P0 1
#endif
#ifndef EN_QKV
#define EN_QKV 1
#endif
#ifndef EN_ATT
#define EN_ATT 1
#endif
#ifndef EN_OPJ
#define EN_OPJ 1
#endif
#ifndef EN_S1
#define EN_S1 1
#endif
#ifndef EN_S3
#define EN_S3 1
#endif
#ifndef EN_GLU
#define EN_GLU 1
#endif
#ifndef EN_UP
#define EN_UP 1
#endif
#ifndef EN_DN
#define EN_DN 1
#endif
#ifndef EN_FIN
#define EN_FIN 1
#endif
template <class T> __device__ __forceinline__ T karg(const __attribute__((address_space(4))) char* ka, int off) { typedef const __attribute__((address_space(4))) T CT; return *(CT*)(ka + off); }
struct Args { const float* in[23]; float* out; unsigned char* ws; int ph_lo, ph_hi; };
static_assert(sizeof(Args) == 208 && __builtin_offsetof(Args, out) == 184 && __builtin_offsetof(Args, ws) == 192, "kernarg layout used by KARG");

__global__ void __launch_bounds__(512, 2) fwd_kernel(Args args) {
    extern __shared__ __attribute__((aligned(16))) unsigned char lds[];
    LAS unsigned char* const L = (LAS unsigned char*)lds;
#define FRESH_IDS int tid = threadIdx.x; asm volatile("" : "+v"(tid)); const int lane = tid & 63, wave = __builtin_amdgcn_readfirstlane(tid >> 6); const int gw = vcu * 8 + wave; (void)lane; (void)gw
    const int G = gridDim.x, bx = blockIdx.x;
    const int vcu = (G % 8 == 0) ? (bx % 8) * (G / 8) + bx / 8 : bx;
    const int NGW = G * 8;
    for (int u = threadIdx.x; u < (LDS_BYTES - LDSCTL_OFF) / 4; u += 512) ((LAS unsigned*)(L + LDSCTL_OFF))[u] = 0u;
    __syncthreads();
    const int lo = args.ph_lo, hi = args.ph_hi;
    const bool multi = (hi - lo) > 1;
    XcdBarrier bar; bar.bar = (unsigned*)(args.ws + WS_CTL) + CW_BAR; bar.x = 0; bar.st = nullptr;
    if (multi) bar = xcd_barrier_post((unsigned*)(args.ws + WS_CTL) + CW_BAR, (volatile LAS unsigned*)(L + MISC_OFF) + 8);
#define IN(k) (lo <= (k) && (k) < hi)
#define SEAM(k) do { if (IN(k) && IN((k) + 1)) xcd_barrier(bar); } while (0)

#define KARG(T, off) karg<T>(ka, (off))
#define INP(k) karg<const float*>(ka, 8 * (k))
#define FRESH_PTRS const __attribute__((address_space(4))) char* ka = (const __attribute__((address_space(4))) char*)__builtin_amdgcn_kernarg_segment_ptr(); asm volatile("" : "+s"(ka)); \
    unsigned char* const ws = KARG(unsigned char*, 192); float* const out = KARG(float*, 184); \
    float* const ssp = (float*)(ws + WS_SSP); float* const HS = (float*)(ws + WS_HS); bf16* const XB = (bf16*)(ws + WS_XB); bf16* const Hb = (bf16*)(ws + WS_H); \
    bf16* const Qb = (bf16*)(ws + WS_Q); bf16* const Kb = (bf16*)(ws + WS_K); bf16* const Vb = (bf16*)(ws + WS_V); bf16* const Ob = (bf16*)(ws + WS_O); \
    const float* const x_p = INP(0); const float* const x_s = INP(1); (void)ssp; (void)HS; (void)XB; (void)Hb; (void)Qb; (void)Kb; (void)Vb; (void)Ob; (void)x_p; (void)x_s
    if (EN_P0 && IN(0)) for (int rp = 0; rp < NREP(0); ++rp) {
        FRESH_IDS; FRESH_PTRS;
        LAS float* scr = (LAS float*)(L + wave * 16640);
        constexpr int I_QKV = 16 * 24, I_O = 16 * 16, I_GLU = 16 * 32, I_UP = 16 * 64, I_DN = 64 * 16;
        constexpr int NITEMS = 2 * I_QKV + 2 * I_O + 2 * I_GLU + 4 * I_UP + 4 * I_DN;
        for (int it = gw; it < NITEMS; it += NGW) {
            int r = it;
            if (r < 2 * I_QKV) { const int j = r / I_QKV; r -= j * I_QKV; p0_transpose_item(INP(9) + (size_t)j * D * NQKV, D, NQKV, INP(6) + (size_t)(2 * j) * D, (bf16*)(ws + WS_WQKV) + (size_t)j * NQKV * D, 0, scr, r, lane); continue; } r -= 2 * I_QKV;
            if (r < 2 * I_O) { const int j = r / I_O; r -= j * I_O; p0_transpose_item(INP(10) + (size_t)j * D * D, D, D, nullptr, (bf16*)(ws + WS_WO) + (size_t)j * D * D, 0, scr, r, lane); continue; } r -= 2 * I_O;
            if (r < 2 * I_GLU) { const int j = r / I_GLU; r -= j * I_GLU; p0_transpose_item(INP(20) + (size_t)j * D * 2 * D, D, 2 * D, nullptr, (bf16*)(ws + WS_WGLU) + (size_t)j * 2 * D * D, 1, scr, r, lane); continue; } r -= 2 * I_GLU;
            if (r < 4 * I_UP) { const int l = r / I_UP; r -= l * I_UP; p0_transpose_item(INP(21) + (size_t)l * D * FF, D, FF, INP(7) + (size_t)l * D, (bf16*)(ws + WS_WUP) + (size_t)l * FF * D, 0, scr, r, lane); continue; } r -= 4 * I_UP;
            { const int l = r / I_DN; r -= l * I_DN; p0_transpose_item(INP(22) + (size_t)l * FF * D, FF, D, nullptr, (bf16*)(ws + WS_WDN) + (size_t)l * D * FF, 0, scr, r, lane); }
        }
        for (int m0 = 2 * gw; m0 < M; m0 += 2 * NGW) {
            f32x4 v[2][4];
#pragma unroll
            for (int rr = 0; rr < 2; ++rr) { const int m = m0 + rr; const float* xrow = (m < MP) ? x_p + (size_t)m * D : x_s + (size_t)(m - MP) * D;
#pragma unroll
                for (int j = 0; j < 4; ++j) v[rr][j] = *((const GAS f32x4*)xrow + lane + 64 * j); }
#pragma unroll
            for (int rr = 0; rr < 2; ++rr) { const int m = m0 + rr; float sq = 0.f;
#pragma unroll
                for (int j = 0; j < 4; ++j) sq += (v[rr][j][0] * v[rr][j][0] + v[rr][j][1] * v[rr][j][1]) + (v[rr][j][2] * v[rr][j][2] + v[rr][j][3] * v[rr][j][3]);
                sq = wave_sum(sq);
                GAS unsigned long long* o8 = (GAS unsigned long long*)(XB + (size_t)m * D) + lane;
#pragma unroll
                for (int j = 0; j < 4; ++j) o8[64 * j] = (unsigned long long)pk2(v[rr][j][0], v[rr][j][1]) | ((unsigned long long)pk2(v[rr][j][2], v[rr][j][3]) << 32);
                if (lane < 32) ssp[(size_t)m * 64 + lane] = (lane == 0) ? sq : 0.f; }
        }
        for (int i = bx * 512 + tid; i < 2 * NG * NS; i += G * 512) {
            const int jj = i >> 12, gn = i & 4095, g = gn >> 6, n = gn & 63; float abr, abi, cfr, cfi;
            ssm_abar_calc(INP(12) + (size_t)jj * NG * NS, INP(13) + (size_t)jj * NG * NS, INP(14) + (size_t)jj * NG, g, n, abr, abi, cfr, cfi);
            f32x4 v; v[0] = abr; v[1] = abi; v[2] = cfr; v[3] = cfi; *(f32x4*)((float*)(ws + WS_TAB) + (size_t)i * 4) = v;
            const float* bre = INP(15) + (size_t)i * 16; const float* bim = INP(16) + (size_t)i * 16; const float* gn_ = INP(6) + (size_t)(2 * jj + 1) * D + g * 16;
            bf16* btr = (bf16*)(ws + WS_BT) + ((size_t)(jj * NG + g) * 128 + (2 * (n >> 5)) * 32 + (n & 31)) * 16; bf16* bti = btr + 32 * 16;
#pragma unroll
            for (int c8 = 0; c8 < 2; ++c8) {
                float wr_[8], wi_[8];
#pragma unroll
                for (int c4 = 0; c4 < 2; ++c4) { const f32x4 br = *(const f32x4*)(bre + 8 * c8 + 4 * c4), bi = *(const f32x4*)(bim + 8 * c8 + 4 * c4), gv = *(const f32x4*)(gn_ + 8 * c8 + 4 * c4);
#pragma unroll
                    for (int e = 0; e < 4; ++e) { wr_[4 * c4 + e] = (cfr * br[e] - cfi * bi[e]) * gv[e]; wi_[4 * c4 + e] = (cfr * bi[e] + cfi * br[e]) * gv[e]; } }
                v4u o; o.x = pk2(wr_[0], wr_[1]); o.y = pk2(wr_[2], wr_[3]); o.z = pk2(wr_[4], wr_[5]); o.w = pk2(wr_[6], wr_[7]); *(v4u*)(btr + 8 * c8) = o;
                o.x = pk2(wi_[0], wi_[1]); o.y = pk2(wi_[2], wi_[3]); o.z = pk2(wi_[4], wi_[5]); o.w = pk2(wi_[6], wi_[7]); *(v4u*)(bti + 8 * c8) = o;
            }
        }
        for (int i = bx * 512 + tid; i < 2 * NG * GC * 16; i += G * 512) {
            const int n4 = i & 15; const size_t rowi = (size_t)(i >> 4);
            const f32x4 cr = *(const f32x4*)(INP(17) + rowi * 64 + 4 * n4), ci = *(const f32x4*)(INP(18) + rowi * 64 + 4 * n4);
            v4u o; o.x = pk2(cr[0], -ci[0]); o.y = pk2(cr[1], -ci[1]); o.z = pk2(cr[2], -ci[2]); o.w = pk2(cr[3], -ci[3]);
            *(v4u*)((bf16*)(ws + WS_CT) + rowi * 128 + 8 * n4) = o;
        }
        {
            constexpr int PER = 120 * 256 / 4;
            constexpr int TOT = 2 * 2 * SB * PER;
            const int STRIDE = G * 512;
            for (int i0 = bx * 512 + tid; i0 < TOT; i0 += 8 * STRIDE) {
                f32x4 v[8];
#pragma unroll
                for (int k = 0; k < 8; ++k) { const int i = i0 + k * STRIDE; if (i < TOT) { const int kv = i / (2 * SB * PER), rem = i % (2 * SB * PER), jb = rem / PER, e = rem % PER;
                    v[k] = *((const f32x4*)(INP(2 + kv) + (size_t)jb * 128 * 256 + 8 * 256) + e); } }
#pragma unroll
                for (int k = 0; k < 8; ++k) { const int i = i0 + k * STRIDE; if (i < TOT) { const int kv = i / (2 * SB * PER), rem = i % (2 * SB * PER), jb = rem / PER, e = rem % PER;
                    *((f32x4*)(out + (kv ? O_VS : O_KS) + (size_t)jb * 128 * 256) + e) = v[k]; } }
            }
        }
        __syncthreads();
    }
    SEAM(0);

    for (int l = 0; l < 4; ++l) {
        const int pb = 1 + 5 * l, j = l >> 1;
        if ((l & 1) == 0) {
            if (EN_QKV && IN(pb)) for (int rp = 0; rp < NREP(3); ++rp) {
                FRESH_PTRS;
                pg8::GemmX g{XB, (const bf16*)(ws + WS_WQKV) + (size_t)j * NQKV * D, nullptr, D}; pg8::StaticOrder S; S.init(MP, NQKV, G, bx);
                pg8::EpiQKV E{Qb, Kb, Vb, ssp, 16, 32, out + O_KP + (size_t)j * 2 * 128 * 256, out + O_VP + (size_t)j * 2 * 128 * 256, out + O_KS + (size_t)j * SB * 128 * 256, out + O_VS + (size_t)j * SB * 128 * 256};
                if (threadIdx.x == 0) *(LAS int*)(L + pg8::RINV_TAB_OFF + 1152) = -1;
                __syncthreads();
                pg8::gemm_phase_x<pg8::EpiQKV, pg8::StaticOrder>(L, g, S, E);
            }
            SEAM(pb);
            if (EN_ATT && IN(pb + 1)) for (int rp = 0; rp < NREP(1); ++rp) {
                FRESH_IDS; FRESH_PTRS;
                const LAS unsigned char* Kl = L; const LAS unsigned char* Vl = L + 36864;
                const float* ck = INP(2) + (size_t)j * SB * 128 * 256; const float* cv = INP(3) + (size_t)j * SB * 128 * 256;
                const float* sinks = INP(11) + j * 16;
                const int r32 = lane & 31, hi5 = lane >> 5;
                for (int u = vcu; u < 1024; u += G) {
                    const bool samp = u >= 512;
                    int b, qblk = 0, kvh;
                    if (!samp) { kvh = u & 3; qblk = (u >> 2) & 63; b = u >> 8; } else { const int us = u - 512; kvh = us & 3; b = us >> 2; }
                    const int nchunk = samp ? 160 * 8 : 256 * 8;
                    for (int id = tid; id < nchunk; id += 512) {
                        const int key = id >> 3, ch = id & 7;
                        v4u kv = {0u, 0u, 0u, 0u}, vv = {0u, 0u, 0u, 0u};
                        if (!samp) {
                            const int s = qblk * 128 - 128 + key;
                            if (s >= 0) { const size_t off = (size_t)((b << 13) + s) * 256 + kvh * 64 + ch * 8; kv = *(const v4u*)(Kb + off); vv = *(const v4u*)(Vb + off); }
                        } else if (key < 128) {
                            const size_t off = ((size_t)b * 128 + key) * 256 + kvh * 64 + ch * 8;
                            const f32x4 k0 = *(const f32x4*)(ck + off), k1 = *(const f32x4*)(ck + off + 4), v0 = *(const f32x4*)(cv + off), v1 = *(const f32x4*)(cv + off + 4);
                            kv.x = pk2(k0[0], k0[1]); kv.y = pk2(k0[2], k0[3]); kv.z = pk2(k1[0], k1[1]); kv.w = pk2(k1[2], k1[3]);
                            vv.x = pk2(v0[0], v0[1]); vv.y = pk2(v0[2], v0[3]); vv.z = pk2(v1[0], v1[1]); vv.w = pk2(v1[2], v1[3]);
                        } else if (key < 136) {
                            const size_t off = (size_t)(MP + b * 8 + (key - 128)) * 256 + kvh * 64 + ch * 8; kv = *(const v4u*)(Kb + off); vv = *(const v4u*)(Vb + off);
                        }
                        *(LAS v4u*)(L + key * 144 + ch * 16) = kv;
                        LAS unsigned short* vt = (LAS unsigned short*)(L + 36864 + (ch * 8) * 520 + key * 2);
                        vt[0 * 260] = (unsigned short)(vv.x & 0xffffu); vt[1 * 260] = (unsigned short)(vv.x >> 16); vt[2 * 260] = (unsigned short)(vv.y & 0xffffu); vt[3 * 260] = (unsigned short)(vv.y >> 16);
                        vt[4 * 260] = (unsigned short)(vv.z & 0xffffu); vt[5 * 260] = (unsigned short)(vv.z >> 16); vt[6 * 260] = (unsigned short)(vv.w & 0xffffu); vt[7 * 260] = (unsigned short)(vv.w >> 16);
                    }
                    __syncthreads();
                    const int ntask = samp ? ((wave == 0) ? 1 : 0) : 2;
                    for (int ti = 0; ti < ntask; ++ti) {
                        int qrow, head, tloc, kb0, jkmin;
                        if (!samp) { const int sb = 2 * (wave & 1) + ti; head = kvh * 4 + (wave >> 1); tloc = 32 * sb + r32; qrow = (b << 13) + qblk * 128 + tloc; kb0 = sb; jkmin = (qblk == 0) ? 128 : 0; }
                        else { head = kvh * 4 + (r32 >> 3); tloc = r32 & 7; qrow = MP + b * 8 + tloc; kb0 = 0; jkmin = 0; }
                        const float slope2 = exp2f(-0.5f * (float)(head + 1)) * 1.4426950408889634f, sink2 = sinks[head] * 1.4426950408889634f;
                        const bf16* qptr = Qb + (size_t)qrow * 1024 + head * 64 + 8 * hi5;
                        pg8::bf16x8 qf[4];
#pragma unroll
                        for (int ks = 0; ks < 4; ++ks) qf[ks] = *(const pg8::bf16x8*)(qptr + 16 * ks);
                        f32x16 S[5];
#pragma unroll
                        for (int i = 0; i < 5; ++i) {
                            f32x16 acc = {0.f, 0.f, 0.f, 0.f, 0.f, 0.f, 0.f, 0.f, 0.f, 0.f, 0.f, 0.f, 0.f, 0.f, 0.f, 0.f};
#pragma unroll
                            for (int ks = 0; ks < 4; ++ks) { const pg8::bf16x8 kf = *(const LAS pg8::bf16x8*)(Kl + (32 * (kb0 + i) + r32) * 144 + 32 * ks + 16 * hi5); acc = __builtin_amdgcn_mfma_f32_32x32x16_bf16(kf, qf[ks], acc, 0, 0, 0); }
                            S[i] = acc;
                        }
                        float mx = sink2;
#pragma unroll
                        for (int i = 0; i < 5; ++i)
#pragma unroll
                            for (int r = 0; r < 16; ++r) {
                                const int jk = 32 * (kb0 + i) + (r & 3) + 8 * (r >> 2) + 4 * hi5; const int dist = tloc + 128 - jk;
                                const bool valid = (dist >= 0) && (dist <= 128) && (jk >= jkmin);
                                const float sv = valid ? (S[i][r] * 0.18033688011112042f - slope2 * (float)dist) : -1e30f;
                                S[i][r] = sv; mx = fmaxf(mx, sv);
                            }
                        mx = fmaxf(mx, __shfl_xor(mx, 32));
                        float lsum = 0.f;
#pragma unroll
                        for (int i = 0; i < 5; ++i)
#pragma unroll
                            for (int r = 0; r < 16; ++r) { const float p = __builtin_amdgcn_exp2f(S[i][r] - mx); S[i][r] = p; lsum += p; }
                        lsum += __shfl_xor(lsum, 32); lsum += __builtin_amdgcn_exp2f(sink2 - mx);
                        const float inv = 1.0f / lsum;
                        f32x16 O0 = {0.f, 0.f, 0.f, 0.f, 0.f, 0.f, 0.f, 0.f, 0.f, 0.f, 0.f, 0.f, 0.f, 0.f, 0.f, 0.f}, O1 = O0;
#pragma unroll
                        for (int i = 0; i < 5; ++i)
#pragma unroll
                            for (int s2 = 0; s2 < 2; ++s2) {
                                v4u pw; pw.x = pg8::cvt_pk_bf16(S[i][8 * s2 + 0], S[i][8 * s2 + 1]); pw.y = pg8::cvt_pk_bf16(S[i][8 * s2 + 2], S[i][8 * s2 + 3]);
                                pw.z = pg8::cvt_pk_bf16(S[i][8 * s2 + 4], S[i][8 * s2 + 5]); pw.w = pg8::cvt_pk_bf16(S[i][8 * s2 + 6], S[i][8 * s2 + 7]);
                                const pg8::bf16x8 pf = __builtin_bit_cast(pg8::bf16x8, pw);
                                const int keyoff = 32 * (kb0 + i) + 16 * s2 + 4 * hi5;
                                { const u32x2 lo = *(const LAS u32x2*)(Vl + r32 * 520 + keyoff * 2), hh = *(const LAS u32x2*)(Vl + r32 * 520 + (keyoff + 8) * 2);
                                  v4u vw; vw.x = lo.x; vw.y = lo.y; vw.z = hh.x; vw.w = hh.y; O0 = __builtin_amdgcn_mfma_f32_32x32x16_bf16(__builtin_bit_cast(pg8::bf16x8, vw), pf, O0, 0, 0, 0); }
                                { const u32x2 lo = *(const LAS u32x2*)(Vl + (32 + r32) * 520 + keyoff * 2), hh = *(const LAS u32x2*)(Vl + (32 + r32) * 520 + (keyoff + 8) * 2);
                                  v4u vw; vw.x = lo.x; vw.y = lo.y; vw.z = hh.x; vw.w = hh.y; O1 = __builtin_amdgcn_mfma_f32_32x32x16_bf16(__builtin_bit_cast(pg8::bf16x8, vw), pf, O1, 0, 0, 0); }
                            }
                        bf16* optr = Ob + (size_t)qrow * 1024 + head * 64 + 4 * hi5;
#pragma unroll
                        for (int qd = 0; qd < 4; ++qd) {
                            u32x2 w0; w0.x = pg8::cvt_pk_bf16(O0[4 * qd] * inv, O0[4 * qd + 1] * inv); w0.y = pg8::cvt_pk_bf16(O0[4 * qd + 2] * inv, O0[4 * qd + 3] * inv);
                            u32x2 w1; w1.x = pg8::cvt_pk_bf16(O1[4 * qd] * inv, O1[4 * qd + 1] * inv); w1.y = pg8::cvt_pk_bf16(O1[4 * qd + 2] * inv, O1[4 * qd + 3] * inv);
                            *(u32x2*)(optr + 8 * qd) = w0; *(u32x2*)(optr + 32 + 8 * qd) = w1;
                        }
                    }
                    __syncthreads();
                }
            }
            SEAM(pb + 1);
            if (EN_OPJ && IN(pb + 2)) {
                FRESH_PTRS;
                pg8::GemmX g{Ob, (const bf16*)(ws + WS_WO) + (size_t)j * D * D, nullptr, D}; pg8::StaticOrder S; S.init(MP, D, G, bx);
                pg8::EpiRes E{XB, ssp};
                pg8::gemm_phase_x<pg8::EpiRes, pg8::StaticOrder>(L, g, S, E);
            }
            SEAM(pb + 2);
        } else {
#define SSMT(gg) const SsmT T_{(const bf16*)(ws + WS_BT) + ((size_t)j * NG + (gg)) * 128 * 16, (const bf16*)(ws + WS_CT) + ((size_t)j * NG + (gg)) * 16 * 128, (const float*)(ws + WS_TAB) + ((size_t)j * NG + (gg)) * NS * 4, \
                          INP(19) + (size_t)j * D + (gg) * 16, INP(6) + (size_t)l * D + (gg) * 16}
            if (EN_S1 && IN(pb)) for (int rp = 0; rp < NREP(2); ++rp) {
                FRESH_IDS; FRESH_PTRS; LAS unsigned char* wl = L + wave * 10752; LAS float* rvs = (LAS float*)(L + 8 * 10752);
                for (int u = gw; u < NB * (NCH - 1) * NG; u += NGW) {
                    int lane = tid & 63; asm volatile("" : "+v"(lane));
                    const int g = u & 63, ch = (u >> 6) % (NCH - 1), b = (u >> 6) / (NCH - 1);
                    wg_rinv(rvs, ssp, b * SEQ + ch * CH, CH, 16, tid);
                    SSMT(g);
                    float st[4] = {0.f, 0.f, 0.f, 0.f};
                    ssm_mfma_unit<0>(wl, lane, g, T_, XB, rvs, b * SEQ + ch * CH, CH / 32, st, nullptr, nullptr, nullptr, nullptr, nullptr, 0);
                    if (lane < 32) { float* hs = HS + ((size_t)((b * NCH + ch) * NG + g) * NS) * 2; *(float2*)(hs + 2 * lane) = make_float2(st[0], st[1]); *(float2*)(hs + 2 * (32 + lane)) = make_float2(st[2], st[3]); }
                }
                __syncthreads();
            }
            SEAM(pb);
            if (EN_S3 && IN(pb + 1)) for (int rp = 0; rp < NREP(2); ++rp) {
                FRESH_IDS; FRESH_PTRS; LAS unsigned char* wl = L + wave * 10752; LAS float* rvs = (LAS float*)(L + 8 * 10752);
                for (int u = gw; u < NB * NCH * NG + (SB / 4) * NG; u += NGW) {
                    int lane = tid & 63; asm volatile("" : "+v"(lane));
                    if (u < NB * NCH * NG) {
                        const int g = u & 63, b = u >> 11, ch = b ? (NCH - 1 - ((u >> 6) & (NCH - 1))) : ((u >> 6) & (NCH - 1)), r32 = lane & 31;
                        wg_rinv(rvs, ssp, b * SEQ + ch * CH, CH, 16, tid);
                        SSMT(g);
                        float st[4] = {0.f, 0.f, 0.f, 0.f};
                        float aLr[2], aLi[2];
#pragma unroll
                        for (int p = 0; p < 2; ++p) {
                            const f32x4 tv = *(const f32x4*)(T_.tab + (size_t)(32 * p + r32) * 4);
                            float xr_ = tv[0], xi_ = tv[1];
#pragma unroll
                            for (int sq = 0; sq < 8; ++sq) { const float tr = xr_ * xr_ - xi_ * xi_, ti = 2.0f * xr_ * xi_; xr_ = tr; xi_ = ti; }
                            aLr[p] = xr_; aLi[p] = xi_;
                        }
                        for (int i0 = 0; i0 < ch; i0 += 8) {
                            float2 e[8][2];
#pragma unroll
                            for (int k = 0; k < 8; ++k)
#pragma unroll
                                for (int p = 0; p < 2; ++p) e[k][p] = (i0 + k < ch) ? *(const float2*)(HS + ((size_t)((b * NCH + i0 + k) * NG + g) * NS + 32 * p + r32) * 2) : make_float2(0.f, 0.f);
#pragma unroll
                            for (int k = 0; k < 8; ++k) if (i0 + k < ch) {
#pragma unroll
                                for (int p = 0; p < 2; ++p) { const float tr = aLr[p] * st[2 * p] - aLi[p] * st[2 * p + 1] + e[k][p].x, ti = aLr[p] * st[2 * p + 1] + aLi[p] * st[2 * p] + e[k][p].y; st[2 * p] = tr; st[2 * p + 1] = ti; }
                            }
                        }
                        ssm_mfma_unit<1>(wl, lane, g, T_, XB, rvs, b * SEQ + ch * CH, CH / 32, st, Ob, nullptr, nullptr, nullptr, nullptr, 0);
                        if (ch == NCH - 1 && lane < 32) { float* hr_o = out + O_HRP + ((size_t)(j * NB + b) * NG + g) * NS; float* hi_o = out + O_HIP + ((size_t)(j * NB + b) * NG + g) * NS;
                            hr_o[lane] = st[0]; hi_o[lane] = st[1]; hr_o[32 + lane] = st[2]; hi_o[32 + lane] = st[3]; }
                    } else {
                        const int us = u - NB * NCH * NG, g = us & 63, bb = us >> 6;
                        wg_rinv(rvs, ssp, MP + bb * 32, 32, 32, tid);
                        SSMT(g);
                        float st[4] = {0.f, 0.f, 0.f, 0.f};
                        ssm_mfma_unit<2>(wl, lane, g, T_, XB, rvs, MP + bb * 32, 1, st, Ob, INP(4) + (size_t)j * SB * NG * NS, INP(5) + (size_t)j * SB * NG * NS, out + O_HRS + (size_t)j * SB * NG * NS, out + O_HIS + (size_t)j * SB * NG * NS, bb * 4);
                    }
                }
                __syncthreads();
            }
            SEAM(pb + 1);
            if (EN_GLU && IN(pb + 2)) {
                FRESH_PTRS;
                pg8::GemmX g{Ob, (const bf16*)(ws + WS_WGLU) + (size_t)j * 2 * D * D, nullptr, D}; pg8::StaticOrder S; S.init(MP, 2 * D, G, bx);
                pg8::EpiGlu E{XB, ssp};
                pg8::gemm_phase_x<pg8::EpiGlu, pg8::StaticOrder>(L, g, S, E);
            }
            SEAM(pb + 2);
        }
        if (EN_UP && IN(pb + 3)) for (int rp = 0; rp < NREP(4); ++rp) {
            FRESH_PTRS;
            pg8::GemmX g{XB, (const bf16*)(ws + WS_WUP) + (size_t)l * FF * D, nullptr, D}; pg8::StaticOrder S; S.init(MP, FF, G, bx);
            pg8::EpiUp E{Hb, (bf16*)(ws + WS_H + 128 * MiB), ssp, (l & 1) ? 32 : 16, (l & 1) ? 64 : 32};
            if (threadIdx.x == 0) *(LAS int*)(L + pg8::RINV_TAB_OFF + 1152) = -1;
            __syncthreads();
            pg8::gemm_phase_x<pg8::EpiUp, pg8::StaticOrder, NREP(5), NREP(6), 0>(L, g, S, E);
        }
        SEAM(pb + 3);
        if (EN_DN && IN(pb + 4)) {
            FRESH_PTRS;
            pg8::GemmX g{Hb, (const bf16*)(ws + WS_WDN) + (size_t)l * D * FF, (const bf16*)(ws + WS_H + 128 * MiB), FF}; pg8::StaticOrder S; S.init(MP, D, G, bx);
            pg8::EpiRes E{XB, ssp};
            pg8::gemm_phase_x<pg8::EpiRes, pg8::StaticOrder, 1, 1, 0, true>(L, g, S, E);
        }
        SEAM(pb + 4);
    }
    if (EN_FIN && IN(21)) {
        FRESH_IDS; FRESH_PTRS;
        const float* gf = INP(8);
        for (int m = gw; m < M; m += NGW) {
            const float pv = (lane < ((m < MP) ? 16 : 32)) ? ssp[(size_t)m * 64 + lane] : 0.f;
            const float rinv = rsqrtf(wave_sum(pv) * (1.0f / 1024.0f) + 1e-6f);
            const bf16* xb = XB + (size_t)m * D + 4 * lane; float* yo = out + (size_t)m * D + 4 * lane;
#pragma unroll
            for (int jx = 0; jx < 4; ++jx) { const f32x4 gv = *(const f32x4*)(gf + 256 * jx + 4 * lane); const f32x4 v = pg8::unpack4(*(const u32x2*)(xb + 256 * jx)) * rinv * gv; *(f32x4*)(yo + 256 * jx) = v; }
        }
    }
#undef IN
#undef SEAM
}

#ifndef MK_SPLIT
#define MK_SPLIT 0
#endif
extern "C" void kernel_launch(void* const* d_in, const int* in_sizes, int n_in, void* d_out, int out_size, void* d_ws, size_t ws_size, hipStream_t stream) {
    static int grid = 0;
    if (grid == 0) {
        if (n_in != 23 || in_sizes[0] != MP * D || (size_t)out_size != O_END || ws_size < WS_END) { fprintf(stderr, "kernel_launch: unexpected shapes (n_in %d, in0 %d, out %d, ws %zu); nothing launched\n", n_in, n_in > 0 ? in_sizes[0] : -1, out_size, ws_size); grid = -1; return; }
        int dev = 0, cus = 0, per_cu = 0;
        if (hipGetDevice(&dev) != hipSuccess || hipDeviceGetAttribute(&cus, hipDeviceAttributeMultiprocessorCount, dev) != hipSuccess) { fprintf(stderr, "kernel_launch: device query failed\n"); grid = -1; return; }
        if (hipFuncSetAttribute((const void*)fwd_kernel, hipFuncAttributeMaxDynamicSharedMemorySize, LDS_BYTES) != hipSuccess) { fprintf(stderr, "kernel_launch: hipFuncSetAttribute failed\n"); grid = -1; return; }
        if (hipOccupancyMaxActiveBlocksPerMultiprocessor(&per_cu, (const void*)fwd_kernel, 512, LDS_BYTES) != hipSuccess || per_cu < 1) fprintf(stderr, "kernel_launch: note: occupancy query reports %d blocks per CU\n", per_cu);
        (void)hipGetLastError();
        grid = cus;
    }
    if (grid < 0) return;
    (void)hipMemsetAsync((char*)d_ws + WS_CTL, 0, CTL_ZERO_BYTES, stream);
    Args a{};
    for (int i = 0; i < 23; ++i) a.in[i] = (const float*)d_in[i];
    a.out = (float*)d_out; a.ws = (unsigned char*)d_ws;
#if MK_SPLIT
    for (int p = 0; p < NPHASE; ++p) { a.ph_lo = p; a.ph_hi = p + 1; hipLaunchKernelGGL(fwd_kernel, dim3(grid), dim3(512), LDS_BYTES, stream, a); }
#else
    a.ph_lo = 0; a.ph_hi = NPHASE; hipLaunchKernelGGL(fwd_kernel, dim3(grid), dim3(512), LDS_BYTES, stream, a);
#endif
}
```

```cpp
#include <hip/hip_runtime.h>
#include <cstdio>
#include <cstdint>
namespace pg8 {
#define PG8_LAS __attribute__((address_space(3)))
typedef unsigned short bf16_t;
typedef short bf16x8 __attribute__((ext_vector_type(8)));
typedef float f32x4 __attribute__((ext_vector_type(4)));
typedef unsigned u32x4 __attribute__((ext_vector_type(4)));
constexpr int BM = 256, BK = 64, HALF = 128, HTB = HALF * BK * 2  , STAGE_BYTES = 8 * HTB, NXCD = 8, WGM = 8;

__host__ __device__ __forceinline__ int lds_byte(int r, int c) { const int st = (r >> 4) * 2 + (c >> 5), rr = r & 15, cc = c & 31, ob = rr * 64 + cc * 2; return st * 1024 + (ob ^ (((ob >> 9) & 1) << 5)); }
__host__ __device__ __forceinline__ void stage_rc(int b, int& R, int& C) { const int st = b / 1024, sb = b % 1024, swz = sb ^ (((sb >> 9) & 1) << 5); R = (st >> 1) * 16 + swz / 64; C = (st & 1) * 32 + (swz % 64) / 2; }
__host__ __device__ __forceinline__ int perm32(int rho) { const int n = rho >> 4, i = rho & 15; return 8 * (i >> 2) + 4 * n + (i & 3); }

struct Unit { int pm, pn; };
struct Gemm { const bf16_t* A; const bf16_t* Bt; int M, N, K; };

struct StaticOrder {
    int nM, nN, nwg, G, c;
    __host__ __device__ void init(int M, int N, int G_, int c_) { nM = M / BM; nN = N / BM; nwg = nM * nN; G = G_; c = c_; }
    __host__ __device__ bool next(int i, Unit& u) const {
        const long L = (long)i * G + c; if (L >= nwg) return false;
        int wgid = (int)L; { const int q = nwg / NXCD, r = nwg % NXCD, xcd = wgid % NXCD, off = wgid / NXCD; wgid = (xcd < r ? xcd * (q + 1) : r * (q + 1) + (xcd - r) * q) + off; }
        const int nig = WGM * nN, gid = wgid / nig, fm = gid * WGM, gsz = (nM - fm) < WGM ? (nM - fm) : WGM;
        u.pm = fm + ((wgid % nig) % gsz); u.pn = (wgid % nig) / gsz; return true;
    }
    __device__ __forceinline__ void a_ready(const Unit&) const {}
    __device__ __forceinline__ void done(const Unit&) const {}
};
__device__ __forceinline__ unsigned cvt_pk_bf16(float lo, float hi) { unsigned r; asm volatile("v_cvt_pk_bf16_f32 %0, %1, %2" : "=v"(r) : "v"(lo), "v"(hi)); return r; }
typedef float f32x2 __attribute__((ext_vector_type(2)));
template <class Epi, class Sched, bool ALIGN_EPI = false, bool SP2 = false>
__device__ __forceinline__ void gemm_phase(PG8_LAS unsigned char* lds, const Gemm g, const Sched& S, const Epi& E) {
    int tid_ = threadIdx.x; asm volatile("" : "+v"(tid_));
    const int tid = tid_, wid = __builtin_amdgcn_readfirstlane(tid >> 6), lane = tid & 63, wr = wid >> 2, wc = wid & 3, fr = lane & 15, fq = lane >> 4;
    const int K = g.K, nt = K / BK;
    unsigned voffA[2], voffB[2];
#pragma unroll
    for (int i = 0; i < 2; ++i) { int R, C; stage_rc(tid * 16 + i * 8192, R, C); const int Rb = Epi::PERM ? ((R & ~31) + perm32(R & 31)) : R;
        voffA[i] = (unsigned)(R * K + C) * 2u; voffB[i] = (unsigned)(Rb * K + C) * 2u; }
    const size_t kstep = (size_t)(BK * 2);
    const size_t hstep = (size_t)HALF * K * 2;
    const size_t tstep = 2 * hstep;
    const unsigned ldsw = (unsigned)wid * 1024u;
    const int aoff = lds_byte(wr * 64 + fr, fq * 8), boff = lds_byte(wc * 32 + fr, fq * 8);
#define PG8_SA(b, h) (((b) * 2 + (h)) * HTB)
#define PG8_SB(b, h) ((4 + (b) * 2 + (h)) * HTB)
#define PG8_STAGE(bufoff, gbase, voff) do { _Pragma("unroll") for (int _i = 0; _i < 2; ++_i) \
        __builtin_amdgcn_global_load_lds((const unsigned*)((const char*)(gbase) + (voff)[_i]), (PG8_LAS unsigned*)(lds + (bufoff) + ldsw + _i * 8192), 16, 0, 0); } while (0)
#define PG8_LDA(dst, b, h) do { _Pragma("unroll") for (int m = 0; m < 4; ++m) _Pragma("unroll") for (int k = 0; k < 2; ++k) dst[m][k] = *(const PG8_LAS bf16x8*)(lds + PG8_SA(b, h) + aoff + m * 2048 + k * 1024); } while (0)
#define PG8_LDB(dst, b, h) do { _Pragma("unroll") for (int n = 0; n < 2; ++n) _Pragma("unroll") for (int k = 0; k < 2; ++k) dst[n][k] = *(const PG8_LAS bf16x8*)(lds + PG8_SB(b, h) + boff + n * 2048 + k * 1024); } while (0)
#define PG8_MMA(ai, bj, At, Bt) do { __builtin_amdgcn_s_setprio(1); _Pragma("unroll") for (int m = 0; m < 4; ++m) _Pragma("unroll") for (int n = 0; n < 2; ++n) _Pragma("unroll") for (int k = 0; k < 2; ++k) \
        acc[ai][bj][m][n] = __builtin_amdgcn_mfma_f32_16x16x32_bf16(Bt[n][k], At[m][k], acc[ai][bj][m][n], 0, 0, 0); __builtin_amdgcn_s_setprio(0); } while (0)
#define PG8_WAIT_V(n) asm volatile("s_waitcnt vmcnt(" #n ")" ::: "memory")
#define PG8_WAIT_L(n) asm volatile("s_waitcnt lgkmcnt(" #n ")" ::: "memory")
#define PG8_BAR __builtin_amdgcn_s_barrier()
#define PG8_SCHED __builtin_amdgcn_sched_barrier(0)
    Unit cur, nxt; int ui = 0;
    if (!S.next(0, cur)) return;
    f32x4 acc[2][2][4][2];
#pragma unroll
    for (int a = 0; a < 2; ++a)
#pragma unroll
        for (int b = 0; b < 2; ++b)
#pragma unroll
            for (int m = 0; m < 4; ++m)
#pragma unroll
                for (int n = 0; n < 2; ++n) acc[a][b][m][n] = (f32x4){0.f, 0.f, 0.f, 0.f};
    bf16x8 At[4][2], B0[2][2], B1[2][2];
    const char* cA = (const char*)g.A + (size_t)cur.pm * tstep; const char* cB = (const char*)g.Bt + (size_t)cur.pn * tstep;
    S.a_ready(cur);
    if constexpr (SP2) {
        PG8_STAGE(PG8_SB(0, 0), cB, voffB); PG8_STAGE(PG8_SB(0, 1), cB + hstep, voffB); PG8_STAGE(PG8_SA(0, 0), cA, voffA); PG8_STAGE(PG8_SA(0, 1), cA + hstep, voffA);
        if (wr == 1) PG8_BAR;
        PG8_WAIT_V(2); PG8_BAR;
        PG8_STAGE(PG8_SB(1, 0), cB + kstep, voffB); PG8_STAGE(PG8_SA(1, 0), cA + kstep, voffA); PG8_STAGE(PG8_SB(1, 1), cB + hstep + kstep, voffB);
        PG8_WAIT_V(6); PG8_BAR;
    } else {
        PG8_STAGE(PG8_SB(0, 0), cB, voffB); PG8_STAGE(PG8_SA(0, 0), cA, voffA); PG8_STAGE(PG8_SB(0, 1), cB + hstep, voffB); PG8_STAGE(PG8_SA(0, 1), cA + hstep, voffA);
        if (wr == 1) PG8_BAR;
        PG8_WAIT_V(4); PG8_BAR;
        PG8_STAGE(PG8_SB(1, 0), cB + kstep, voffB); PG8_STAGE(PG8_SA(1, 0), cA + kstep, voffA); PG8_STAGE(PG8_SB(1, 1), cB + hstep + kstep, voffB);
        PG8_WAIT_V(6); PG8_BAR;
    }
    for (;;) {
        const bool has_next = S.next(ui + 1, nxt);
        const char* nA = has_next ? (const char*)g.A + (size_t)nxt.pm * tstep : cA; const char* nB = has_next ? (const char*)g.Bt + (size_t)nxt.pn * tstep : cB;
        for (int t = 0; t < nt; t += 2) {
            const bool last = (t == nt - 2);
            const char* a1 = cA + (size_t)(t + 1) * kstep;
            const char* a2 = last ? nA : cA + (size_t)(t + 2) * kstep; const char* b2 = last ? nB : cB + (size_t)(t + 2) * kstep;
            const char* a3 = a2 + kstep; const char* b3 = b2 + kstep;
            if (last && has_next) S.a_ready(nxt);
            if constexpr (SP2) {
            PG8_LDB(B0, 0, 0); PG8_LDB(B1, 0, 1); PG8_SCHED; PG8_LDA(At, 0, 0); PG8_STAGE(PG8_SA(1, 1), a1 + hstep, voffA);
            PG8_WAIT_V(8); PG8_WAIT_L(0); PG8_BAR; PG8_MMA(0, 0, At, B0); PG8_MMA(0, 1, At, B1); PG8_BAR; PG8_SCHED;
            PG8_LDA(At, 0, 1); PG8_STAGE(PG8_SB(0, 0), b2, voffB); PG8_STAGE(PG8_SB(0, 1), b2 + hstep, voffB); PG8_STAGE(PG8_SA(0, 0), a2, voffA);
            PG8_WAIT_V(8); PG8_WAIT_L(0); PG8_BAR; PG8_MMA(1, 0, At, B0); PG8_MMA(1, 1, At, B1); PG8_BAR; PG8_SCHED;
            PG8_LDB(B0, 1, 0); PG8_LDB(B1, 1, 1); PG8_SCHED; PG8_LDA(At, 1, 0); PG8_STAGE(PG8_SA(0, 1), a2 + hstep, voffA);
            PG8_WAIT_V(8); PG8_WAIT_L(0); PG8_BAR; PG8_MMA(0, 0, At, B0); PG8_MMA(0, 1, At, B1); PG8_BAR; PG8_SCHED;
            PG8_LDA(At, 1, 1); PG8_STAGE(PG8_SB(1, 0), b3, voffB); PG8_STAGE(PG8_SB(1, 1), b3 + hstep, voffB); PG8_STAGE(PG8_SA(1, 0), a3, voffA);
            PG8_WAIT_V(8); PG8_WAIT_L(0); PG8_BAR; PG8_MMA(1, 0, At, B0); PG8_MMA(1, 1, At, B1); PG8_BAR; PG8_SCHED;
            } else {
            PG8_LDB(B0, 0, 0); PG8_SCHED; PG8_LDA(At, 0, 0); PG8_STAGE(PG8_SA(1, 1), a1 + hstep, voffA);
            PG8_WAIT_L(8); PG8_BAR; PG8_WAIT_L(0); PG8_MMA(0, 0, At, B0); PG8_BAR; PG8_SCHED;
            PG8_LDB(B1, 0, 1); PG8_STAGE(PG8_SB(0, 0), b2, voffB);
            PG8_BAR; PG8_WAIT_L(0); PG8_MMA(0, 1, At, B1); PG8_BAR;
            PG8_LDA(At, 0, 1); PG8_STAGE(PG8_SA(0, 0), a2, voffA);
            PG8_BAR; PG8_WAIT_L(0); PG8_MMA(1, 0, At, B0); PG8_BAR; PG8_SCHED;
            PG8_STAGE(PG8_SB(0, 1), b2 + hstep, voffB);
            PG8_WAIT_V(6); PG8_BAR; PG8_MMA(1, 1, At, B1); PG8_BAR;
            PG8_LDB(B0, 1, 0); PG8_SCHED; PG8_LDA(At, 1, 0); PG8_STAGE(PG8_SA(0, 1), a2 + hstep, voffA);
            PG8_WAIT_L(8); PG8_BAR; PG8_WAIT_L(0); PG8_MMA(0, 0, At, B0); PG8_BAR; PG8_SCHED;
            PG8_LDB(B1, 1, 1); PG8_STAGE(PG8_SB(1, 0), b3, voffB);
            PG8_BAR; PG8_WAIT_L(0); PG8_MMA(0, 1, At, B1); PG8_BAR;
            PG8_LDA(At, 1, 1); PG8_STAGE(PG8_SA(1, 0), a3, voffA);
            PG8_BAR; PG8_WAIT_L(0); PG8_MMA(1, 0, At, B0); PG8_BAR; PG8_SCHED;
            PG8_STAGE(PG8_SB(1, 1), b3 + hstep, voffB);
            PG8_WAIT_V(6); PG8_BAR; PG8_MMA(1, 1, At, B1); PG8_BAR;
            }
        }
        if constexpr (ALIGN_EPI) { if (wr == 0) PG8_BAR; }
        if constexpr (!Epi::AFTER_DRAIN) { E(acc, cur, wr, wc, fr, fq); S.done(cur); }
        if (!has_next) break;
#pragma unroll
        for (int a = 0; a < 2; ++a)
#pragma unroll
            for (int b = 0; b < 2; ++b)
#pragma unroll
                for (int m = 0; m < 4; ++m)
#pragma unroll
                    for (int n = 0; n < 2; ++n) acc[a][b][m][n] = (f32x4){0.f, 0.f, 0.f, 0.f};
        cur = nxt; cA = nA; cB = nB; ++ui;
        if constexpr (ALIGN_EPI) { if (wr == 1) PG8_BAR; }
    }
    PG8_WAIT_V(0);
    if constexpr (!ALIGN_EPI) { if (wr == 0) PG8_BAR; }
    PG8_BAR;
    if constexpr (Epi::AFTER_DRAIN) { E.fused(acc, cur, wr, wc, fr, fq, lds, wid, lane); S.done(cur); }
#undef PG8_SA
#undef PG8_SB
#undef PG8_STAGE
#undef PG8_LDA
#undef PG8_LDB
#undef PG8_MMA
#undef PG8_WAIT_V
#undef PG8_WAIT_L
#undef PG8_BAR
#undef PG8_SCHED
}
}
#define GAS __attribute__((address_space(1)))
#define LAS __attribute__((address_space(3)))
typedef unsigned short bf16;
typedef unsigned v4u __attribute__((ext_vector_type(4)));
typedef float f32x4 __attribute__((ext_vector_type(4)));
typedef short bf16x8 __attribute__((ext_vector_type(8)));
typedef GAS unsigned gu32;
typedef GAS unsigned long long gu64;
#define RLX_AGENT __ATOMIC_RELAXED, __HIP_MEMORY_SCOPE_AGENT
#define LDS_WAIT() asm volatile("s_waitcnt lgkmcnt(0)" ::: "memory")
#define VM_WAIT() asm volatile("s_waitcnt vmcnt(0)" ::: "memory")
__device__ __forceinline__ unsigned long long rt() { return __builtin_amdgcn_s_memrealtime(); }
__device__ __forceinline__ unsigned f2bf(float f) { unsigned u = __builtin_bit_cast(unsigned, f); return (u + 0x7fffu + ((u >> 16) & 1u)) >> 16; }
__device__ __forceinline__ unsigned pk2(float lo, float hi) { return f2bf(lo) | (f2bf(hi) << 16); }
#define XB_TMO      128
#define XB_XCNT(j)  (256  + 64 * (j))
#define XB_XSUB(j)  (1280 + 64 * (j))
#define XB_XGEN(j)  (2304 + 64 * (j))
#define XB_TOP      3328
#define XB_TOPGEN   3392
#define XCD_BAR_WORDS 3456
#define XB_SPIN_CAP (1u << 18)

__device__ __forceinline__ unsigned xb_ld(unsigned* p)              { return __hip_atomic_load(p, __ATOMIC_RELAXED, __HIP_MEMORY_SCOPE_AGENT); }
__device__ __forceinline__ unsigned xb_add(unsigned* p, unsigned v) { return __hip_atomic_fetch_add(p, v, __ATOMIC_RELAXED, __HIP_MEMORY_SCOPE_AGENT); }
__device__ __forceinline__ unsigned xb_xcc_id() { return (unsigned)__builtin_amdgcn_s_getreg((3 << 11) | 20) & 0xFu; }
#define XB_SPIN(cond, bar) do { unsigned _sp = 0; while (cond) { __builtin_amdgcn_s_sleep(1); \
    if ((++_sp & 255u) == 0u) { if (xb_ld(&(bar)[XB_TMO])) break; if (_sp > XB_SPIN_CAP) { atomicAdd(&(bar)[XB_TMO], 1u); break; } } } } while (0)

struct XcdBarrier {
    unsigned* bar; unsigned x;
    volatile LAS unsigned* st;
};

__device__ __forceinline__ XcdBarrier xcd_barrier_post(unsigned* bar, volatile LAS unsigned* st) {
    XcdBarrier b; b.bar = bar; b.x = xb_xcc_id(); b.st = st;
    if (threadIdx.x == 0) (void)xb_add(&bar[XB_XCNT(b.x)], 1u);
    return b;
}
__device__ __forceinline__ void xcd_barrier_complete(unsigned* bar, unsigned x, unsigned& nloc, unsigned& nx) {
    const unsigned G = gridDim.x * gridDim.y * gridDim.z;
    unsigned sum, cnt, mine, sp = 0u;
    for (;;) {
        sum = 0u; cnt = 0u; mine = 0u;
#pragma unroll
        for (unsigned j = 0; j < 16; ++j) { const unsigned c = xb_ld(&bar[XB_XCNT(j)]); sum += c; cnt += (c > 0u) ? 1u : 0u; mine = (j == x) ? c : mine; }
        if (sum == G) break;
        __builtin_amdgcn_s_sleep(1);
        if ((++sp & 255u) == 0u) { if (xb_ld(&bar[XB_TMO])) break; if (sp > XB_SPIN_CAP) { atomicAdd(&bar[XB_TMO], 1u); break; } }
    }
    nloc = mine > 0u ? mine : 1u; nx = cnt > 0u ? cnt : 1u;
}

__device__ __forceinline__ void xcd_barrier(const XcdBarrier& b) {
    asm volatile("s_waitcnt vmcnt(0)" ::: "memory");
    __syncthreads();
    if (threadIdx.x == 0) {
        unsigned* bar = b.bar;
        __builtin_amdgcn_s_waitcnt(0);
        unsigned nloc = b.st[0], nx = b.st[1];
        if (nloc == 0u) { xcd_barrier_complete(bar, b.x, nloc, nx); b.st[0] = nloc; b.st[1] = nx; }
        const unsigned old = xb_add(&bar[XB_XSUB(b.x)], 1u);
        const unsigned gen = old / nloc;
        if (old + 1u == (gen + 1u) * nloc) {
            __builtin_amdgcn_fence(__ATOMIC_RELEASE, "agent");
            asm volatile("s_waitcnt vmcnt(0)" ::: "memory");
            const unsigned og = xb_add(&bar[XB_TOP], 1u);
            const unsigned tg = og / nx;
            if (og + 1u == (tg + 1u) * nx) xb_add(&bar[XB_TOPGEN], 1u);
            else XB_SPIN(xb_ld(&bar[XB_TOPGEN]) == tg, bar);
            __builtin_amdgcn_fence(__ATOMIC_ACQUIRE, "agent");
            xb_add(&bar[XB_XGEN(b.x)], 1u);
            asm volatile("s_waitcnt vmcnt(0)" ::: "memory");
        } else {
            XB_SPIN(xb_ld(&bar[XB_XGEN(b.x)]) == gen, bar);
            __builtin_amdgcn_fence(__ATOMIC_ACQUIRE, "agent");
            asm volatile("s_waitcnt vmcnt(0)" ::: "memory");
        }
    }
    __syncthreads();
}

constexpr int D = 1024, SEQ = 8192, NB = 2, MP = NB * SEQ, SB = 128, ST = 8, MS = SB * ST, M = MP + MS;
constexpr int NQKV = 1536, FF = 4096, NKV = 4, HD = 64, KVW = NKV * HD, NG = 64, GC = 16, NS = 64;
constexpr int CH = 256, NCH = SEQ / CH;
constexpr int NPHASE = 22;
constexpr size_t O_KP = 17825792, O_VP = 17956864, O_HRP = 18087936, O_HIP = 18104320, O_KS = 18120704, O_VS = 26509312, O_HRS = 34897920, O_HIS = 35946496, O_END = 36995072;
constexpr size_t MiB = 1u << 20;
constexpr size_t WS_CTL = 0, CTL_ZERO_BYTES = 64 * 1024;
constexpr size_t WS_SSP = 1 * MiB;
constexpr size_t WS_TAB = 5 * MiB + 512 * 1024;
constexpr size_t WS_HS = 6 * MiB;
constexpr size_t WS_WQKV = 8 * MiB, WS_WO = 14 * MiB, WS_WGLU = 18 * MiB, WS_WUP = 26 * MiB, WS_WDN = 58 * MiB;
constexpr size_t WS_XB = 90 * MiB;
constexpr size_t WS_H = 124 * MiB;
constexpr size_t WS_Q = 124 * MiB, WS_K = 158 * MiB, WS_V = 167 * MiB, WS_O = 176 * MiB;
constexpr size_t WS_BT = 260 * MiB, WS_CT = 261 * MiB;
constexpr size_t WS_END = 262 * MiB;
constexpr int CW_BAR = 4096;
static_assert((CW_BAR + XCD_BAR_WORDS) * 4 <= (int)CTL_ZERO_BYTES, "barrier words inside the memset region");
constexpr int RING_BYTES = 131072, XA_BYTES = 4096, LDSCTL_OFF = RING_BYTES + XA_BYTES  , MISC_OFF = LDSCTL_OFF + 320, LDS_BYTES = 147456;

__device__ __forceinline__ float wave_sum(float v) {
#pragma unroll
    for (int o = 1; o < 64; o <<= 1) v += __shfl_xor(v, o);
    return v;
}
__device__ __forceinline__ float wave_max(float v) {
#pragma unroll
    for (int o = 1; o < 64; o <<= 1) v = fmaxf(v, __shfl_xor(v, o));
    return v;
}
__device__ __forceinline__ float bf_lo(unsigned u) { return __uint_as_float(u << 16); }
__device__ __forceinline__ float bf_hi(unsigned u) { return __uint_as_float(u & 0xffff0000u); }

namespace pg8 {
constexpr int XMP = 16384;
template <int NL>
__device__ __forceinline__ float row_rinv(const float* ssp, int row, int np, int fq) {
    const float* p = ssp + (size_t)row * 64 + (np >> 2) * fq;
    f32x4 v[NL];
#pragma unroll
    for (int i = 0; i < NL; ++i) v[i] = *(const f32x4*)(p + 4 * i);
    float s = 0.f, s2 = 0.f;
#pragma unroll
    for (int i = 0; i < NL / 2; ++i) { s += (v[i][0] + v[i][1]) + (v[i][2] + v[i][3]); s2 += (v[NL / 2 + i][0] + v[NL / 2 + i][1]) + (v[NL / 2 + i][2] + v[NL / 2 + i][3]); }
    s += (np == 16 * NL) ? s2 : 0.f;
    s += __shfl_xor(s, 16); s += __shfl_xor(s, 32);
    return rsqrtf(s * (1.0f / 1024.0f) + 1e-6f);
}
constexpr int RINV_TAB_OFF = 135680;
__device__ __forceinline__ void unit_rinv_to_lds(PG8_LAS unsigned char* lds, const float* ssp, int pm, int np, int nps) {
    int t = threadIdx.x; asm volatile("" : "+v"(t));
    PG8_LAS float* tab = (PG8_LAS float*)(lds + RINV_TAB_OFF);
    if (t < 288) {
        const bool smp = t >= 256; const int hf = smp ? ((t - 256) >> 4) : 0;
        const int row = smp ? XMP + pm * 16 + (t & 15) : pm * BM + t; const int n = (smp ? nps : np) - 32 * hf;
        const float* p = ssp + (size_t)row * 64 + 32 * hf;
        f32x4 v[8];
#pragma unroll
        for (int i = 0; i < 8; ++i) v[i] = *(const f32x4*)(p + 4 * i);
        float s = 0.f;
#pragma unroll
        for (int i = 0; i < 8; ++i) { const float si = (v[i][0] + v[i][1]) + (v[i][2] + v[i][3]); s += (4 * i < n) ? si : 0.f; }
        if (smp) s += __shfl_xor(s, 16);
        if (t < 272) tab[t] = rsqrtf(s * (1.0f / 1024.0f) + 1e-6f);
    }
    asm volatile("s_waitcnt lgkmcnt(0)" ::: "memory"); __builtin_amdgcn_s_barrier(); asm volatile("" ::: "memory");
}
__device__ __forceinline__ u32x4 pack8(const f32x4 a, const f32x4 b) { u32x4 w; w.x = cvt_pk_bf16(a[0], a[1]); w.y = cvt_pk_bf16(a[2], a[3]); w.z = cvt_pk_bf16(b[0], b[1]); w.w = cvt_pk_bf16(b[2], b[3]); return w; }
typedef unsigned u32x2 __attribute__((ext_vector_type(2)));
__device__ __forceinline__ u32x2 pack4(const f32x4 a) { u32x2 w; w.x = cvt_pk_bf16(a[0], a[1]); w.y = cvt_pk_bf16(a[2], a[3]); return w; }
__device__ __forceinline__ float sumsq4(const f32x4 v) { return (v[0] * v[0] + v[1] * v[1]) + (v[2] * v[2] + v[3] * v[3]); }

struct EpiQKV {
    static constexpr bool PERM = true, AFTER_DRAIN = false;
    bf16_t *Q, *K, *V; const float* ssp; int np, nps; float *kp, *vp, *ks, *vs;
    __device__ __forceinline__ void operator()(const f32x4 (&acc)[2][2][4][2], const f32x4 (&accx)[2], const Unit& u, int wr, int wc, int fr, int fq, PG8_LAS unsigned char* lds) const {
        const int rowb = u.pm * BM + wr * 64 + fr, pn = u.pn;
        { PG8_LAS int* lastpm = (PG8_LAS int*)(lds + RINV_TAB_OFF + 1088 + 64);
          if (*lastpm != u.pm) { unit_rinv_to_lds(lds, ssp, u.pm, np, nps); if (threadIdx.x == 0) *lastpm = u.pm; } }
        float rr[2][4];
        { const PG8_LAS float* tab = (const PG8_LAS float*)(lds + RINV_TAB_OFF);
#pragma unroll
          for (int ai = 0; ai < 2; ++ai)
#pragma unroll
              for (int m = 0; m < 4; ++m) rr[ai][m] = tab[ai * HALF + wr * 64 + m * 16 + fr]; }
        const float rx = ((const PG8_LAS float*)(lds + RINV_TAB_OFF))[256 + fr];
#pragma unroll
        for (int ai = 0; ai < 2; ++ai)
#pragma unroll
            for (int m = 0; m < 4; ++m) {
                const int row = rowb + ai * HALF + m * 16;
                const float r = rr[ai][m];
#pragma unroll
                for (int bj = 0; bj < 2; ++bj) {
                    const f32x4 v0 = acc[ai][bj][m][0] * r, v1 = acc[ai][bj][m][1] * r;
                    const int cl = bj * HALF + wc * 32 + 8 * fq;
                    const u32x4 w = pack8(v0, v1);
                    if (pn < 4) { *(u32x4*)(Q + (size_t)row * 1024 + pn * 256 + cl) = w; }
                    else {
                        bf16_t* B = (pn == 4) ? K : V;
                        *(u32x4*)(B + (size_t)row * 256 + cl) = w;
                        const int t = row & 8191;
                        if (t >= 8064) { float* o = ((pn == 4) ? kp : vp) + ((size_t)(row >> 13) * 128 + (t - 8064)) * 256 + cl; *(f32x4*)o = v0; *(f32x4*)(o + 4) = v1; }
                    }
                }
            }
        {
            const int xrow = u.pm * 16 + fr, row = XMP + xrow;
            const float r = rx;
#pragma unroll
            for (int bj = 0; bj < 2; ++bj) {
                const f32x4 v = accx[bj] * r;
                const int cl = bj * HALF + wc * 32 + 8 * fq + 4 * wr;
                const u32x2 w = pack4(v);
                if (pn < 4) { *(u32x2*)(Q + (size_t)row * 1024 + pn * 256 + cl) = w; }
                else {
                    bf16_t* B = (pn == 4) ? K : V;
                    *(u32x2*)(B + (size_t)row * 256 + cl) = w;
                    float* o = ((pn == 4) ? ks : vs) + ((size_t)(xrow >> 3) * 128 + 120 + (xrow & 7)) * 256 + cl; *(f32x4*)o = v;
                }
            }
        }
    }
};
__device__ __forceinline__ void unpack8(const u32x4 w, f32x4& a, f32x4& b) {
    a[0] = __uint_as_float(w.x << 16); a[1] = __uint_as_float(w.x & 0xffff0000u); a[2] = __uint_as_float(w.y << 16); a[3] = __uint_as_float(w.y & 0xffff0000u);
    b[0] = __uint_as_float(w.z << 16); b[1] = __uint_as_float(w.z & 0xffff0000u); b[2] = __uint_as_float(w.w << 16); b[3] = __uint_as_float(w.w & 0xffff0000u); }
__device__ __forceinline__ f32x4 unpack4(const u32x2 w) { f32x4 a; a[0] = __uint_as_float(w.x << 16); a[1] = __uint_as_float(w.x & 0xffff0000u); a[2] = __uint_as_float(w.y << 16); a[3] = __uint_as_float(w.y & 0xffff0000u); return a; }
struct EpiRes {
    static constexpr bool PERM = true, AFTER_DRAIN = false;
    bf16_t* XB; float* ssp;
    __device__ __forceinline__ void operator()(const f32x4 (&acc)[2][2][4][2], const f32x4 (&accx)[2], const Unit& u, int wr, int wc, int fr, int fq, PG8_LAS unsigned char* lds) const {
        const int rowb = u.pm * BM + wr * 64 + fr, pn = u.pn;
        const int colb = pn * 256 + wc * 32 + 8 * fq;
        const int xrow = u.pm * 16 + fr;
        bf16_t* xbx = XB + (size_t)(XMP + xrow) * 1024 + colb + 4 * wr;
        u32x2 ox[2];
#pragma unroll
        for (int bj = 0; bj < 2; ++bj) ox[bj] = *(const u32x2*)(xbx + bj * HALF);
#pragma unroll
        for (int am = 0; am < 8; am += 4) {
            u32x4 o[4][2];
#pragma unroll
            for (int h = 0; h < 4; ++h)
#pragma unroll
                for (int bj = 0; bj < 2; ++bj) o[h][bj] = *(const u32x4*)(XB + (size_t)(rowb + ((am + h) >> 2) * HALF + ((am + h) & 3) * 16) * 1024 + colb + bj * HALF);
#pragma unroll
            for (int h = 0; h < 4; ++h) {
                const int ai = (am + h) >> 2, m = (am + h) & 3;
                const int row = rowb + ai * HALF + m * 16;
                float ss = 0.f;
#pragma unroll
                for (int bj = 0; bj < 2; ++bj) {
                    f32x4 o0, o1; unpack8(o[h][bj], o0, o1);
                    const f32x4 v0 = acc[ai][bj][m][0] + o0, v1 = acc[ai][bj][m][1] + o1;
                    *(u32x4*)(XB + (size_t)row * 1024 + colb + bj * HALF) = pack8(v0, v1);
                    ss += sumsq4(v0) + sumsq4(v1);
                }
                ss += __shfl_xor(ss, 16); ss += __shfl_xor(ss, 32);
                if (fq == 0) ssp[(size_t)row * 64 + pn * 4 + wc] = ss;
            }
            asm volatile("" ::: "memory");
        }
        {
            const int row = XMP + xrow;
            float ss = 0.f;
#pragma unroll
            for (int bj = 0; bj < 2; ++bj) {
                const f32x4 v = accx[bj] + unpack4(ox[bj]);
                *(u32x2*)(xbx + bj * HALF) = pack4(v);
                ss += sumsq4(v);
            }
            ss += __shfl_xor(ss, 16); ss += __shfl_xor(ss, 32);
            if (fq == 0) ssp[(size_t)row * 64 + (pn * 4 + wc) * 2 + wr] = ss;
        }
    }
};
struct EpiGlu {
    static constexpr bool PERM = true, AFTER_DRAIN = false;
    bf16_t* XB; float* ssp;
    __device__ __forceinline__ void operator()(const f32x4 (&acc)[2][2][4][2], const f32x4 (&accx)[2], const Unit& u, int wr, int wc, int fr, int fq, PG8_LAS unsigned char* lds) const {
        const int rowb = u.pm * BM + wr * 64 + fr, pn = u.pn;
        const int col = pn * 128 + wc * 32 + 8 * fq;
        const int xrow = u.pm * 16 + fr;
        bf16_t* xbx = XB + (size_t)(XMP + xrow) * 1024 + col + 4 * wr;
        const u32x2 ox = *(const u32x2*)xbx;
#pragma unroll
        for (int am = 0; am < 8; am += 4) {
            u32x4 o[4];
#pragma unroll
            for (int h = 0; h < 4; ++h) o[h] = *(const u32x4*)(XB + (size_t)(rowb + ((am + h) >> 2) * HALF + ((am + h) & 3) * 16) * 1024 + col);
#pragma unroll
            for (int h = 0; h < 4; ++h) {
                const int ai = (am + h) >> 2, m = (am + h) & 3;
                const int row = rowb + ai * HALF + m * 16;
                f32x4 v0, v1; unpack8(o[h], v0, v1);
#pragma unroll
                for (int e = 0; e < 4; ++e) {
                    v0[e] += acc[ai][0][m][0][e] * __builtin_amdgcn_rcpf(1.0f + __expf(-acc[ai][1][m][0][e]));
                    v1[e] += acc[ai][0][m][1][e] * __builtin_amdgcn_rcpf(1.0f + __expf(-acc[ai][1][m][1][e]));
                }
                *(u32x4*)(XB + (size_t)row * 1024 + col) = pack8(v0, v1);
                float ss = sumsq4(v0) + sumsq4(v1);
                ss += __shfl_xor(ss, 16); ss += __shfl_xor(ss, 32);
                if (fq == 0) ssp[(size_t)row * 64 + pn * 4 + wc] = ss;
            }
            asm volatile("" ::: "memory");
        }
        {
            const int row = XMP + xrow;
            f32x4 v = unpack4(ox);
#pragma unroll
            for (int e = 0; e < 4; ++e) v[e] += accx[0][e] * __builtin_amdgcn_rcpf(1.0f + __expf(-accx[1][e]));
            *(u32x2*)xbx = pack4(v);
            float ss = sumsq4(v);
            ss += __shfl_xor(ss, 16); ss += __shfl_xor(ss, 32);
            if (fq == 0) ssp[(size_t)row * 64 + (pn * 4 + wc) * 2 + wr] = ss;
        }
    }
};
struct EpiUp {
    static constexpr bool PERM = true, AFTER_DRAIN = false;
    bf16_t* H; bf16_t* Hx; const float* ssp; int np, nps;
    __device__ __forceinline__ void operator()(const f32x4 (&acc)[2][2][4][2], const f32x4 (&accx)[2], const Unit& u, int wr, int wc, int fr, int fq, PG8_LAS unsigned char* lds) const {
        const int rowb = u.pm * BM + wr * 64 + fr, pn = u.pn;
        { PG8_LAS int* lastpm = (PG8_LAS int*)(lds + RINV_TAB_OFF + 1088 + 64);
          if (*lastpm != u.pm) { unit_rinv_to_lds(lds, ssp, u.pm, np, nps); if (threadIdx.x == 0) *lastpm = u.pm; } }
        float rr[2][4];
        { const PG8_LAS float* tab = (const PG8_LAS float*)(lds + RINV_TAB_OFF);
#pragma unroll
          for (int ai = 0; ai < 2; ++ai)
#pragma unroll
              for (int m = 0; m < 4; ++m) rr[ai][m] = tab[ai * HALF + wr * 64 + m * 16 + fr]; }
        const float rx = ((const PG8_LAS float*)(lds + RINV_TAB_OFF))[256 + fr];
#pragma unroll
        for (int ai = 0; ai < 2; ++ai)
#pragma unroll
            for (int m = 0; m < 4; ++m) {
                const int row = rowb + ai * HALF + m * 16;
                const float r = rr[ai][m];
#pragma unroll
                for (int bj = 0; bj < 2; ++bj) {
                    f32x4 v0 = acc[ai][bj][m][0] * r, v1 = acc[ai][bj][m][1] * r;
#pragma unroll
                    for (int e = 0; e < 4; ++e) { const float a = fmaxf(v0[e], 0.f), b = fmaxf(v1[e], 0.f); v0[e] = a * a; v1[e] = b * b; }
                    *(u32x4*)((char*)H + (((size_t)u.pm * 64 + (4 * pn + 2 * bj + (wc >> 1))) * 2 + ai) * 16384 + lds_byte(wr * 64 + m * 16 + fr, 32 * (wc & 1) + 8 * fq)) = pack8(v0, v1);
                }
            }
        {
            const int xrow = u.pm * 16 + fr, row = XMP + xrow;
            const float r = rx;
#pragma unroll
            for (int bj = 0; bj < 2; ++bj) {
                f32x4 v = accx[bj] * r;
#pragma unroll
                for (int e = 0; e < 4; ++e) { const float a = fmaxf(v[e], 0.f); v[e] = a * a; }
                *(u32x2*)((char*)Hx + ((size_t)u.pm * 64 + (4 * pn + 2 * bj + (wc >> 1))) * 2048 + lds_byte(fr, 32 * (wc & 1) + 8 * fq) + 8 * wr) = pack4(v);
            }
        }
    }
};

struct GemmX { const bf16_t* A; const bf16_t* Bt; const bf16_t* Ax; int K; };
template <class Epi, class Sched, int KREP = 1, int EREP = 1, int SKEW_TICKS = 0, bool ATILED = false>
__device__ __forceinline__ void gemm_phase_x(PG8_LAS unsigned char* lds, const GemmX g, const Sched& S, const Epi& E) {
    int tid_ = threadIdx.x; asm volatile("" : "+v"(tid_));
    const int tid = tid_, wid = __builtin_amdgcn_readfirstlane(tid >> 6), lane = tid & 63, wr = wid >> 2, wc = wid & 3, fr = lane & 15, fq = lane >> 4;
    const int K = g.K, nt = K / BK;
    unsigned voffA[2], voffB[2], voffX;
#pragma unroll
    for (int i = 0; i < 2; ++i) { int R, C; stage_rc(tid * 16 + i * 8192, R, C); const int Rb = Epi::PERM ? ((R & ~31) + perm32(R & 31)) : R;
        voffA[i] = ATILED ? (unsigned)(tid * 16 + i * 8192) : (unsigned)(R * K + C) * 2u; voffB[i] = (unsigned)(Rb * K + C) * 2u; }
    { int R, C; const int p = wid * 256 + lane * 4; stage_rc(p & ~15, R, C); voffX = ATILED ? (unsigned)p : (unsigned)(R * K + C) * 2u + (unsigned)(p & 15); }
    const size_t kstepB = (size_t)(BK * 2), hstepB = (size_t)HALF * K * 2, tstepB = 2 * hstepB;
    const size_t kstepA = ATILED ? (size_t)32768 : kstepB, hstepA = ATILED ? (size_t)16384 : hstepB, tstepA = ATILED ? (size_t)nt * 32768 : tstepB;
    const size_t kstepX = ATILED ? (size_t)2048 : kstepB, xstep = ATILED ? (size_t)nt * 2048 : (size_t)16 * K * 2;
    const unsigned ldsw = (unsigned)wid * 1024u, ldsx = (unsigned)wid * 256u;
    const int aoff = lds_byte(wr * 64 + fr, fq * 8), boff = lds_byte(wc * 32 + fr, fq * 8), xoff = lds_byte(fr, fq * 8);
#define PG8_SA(b, h) (((b) * 2 + (h)) * HTB)
#define PG8_SB(b, h) ((4 + (b) * 2 + (h)) * HTB)
#define PG8_XA(b) (STAGE_BYTES + (b) * 2048)
#define PG8_STAGE(bufoff, gbase, voff) do { _Pragma("unroll") for (int _i = 0; _i < 2; ++_i) \
        __builtin_amdgcn_global_load_lds((const unsigned*)((const char*)(gbase) + (voff)[_i]), (PG8_LAS unsigned*)(lds + (bufoff) + ldsw + _i * 8192), 16, 0, 0); } while (0)
#define PG8_STAGEX(b, gbase) __builtin_amdgcn_global_load_lds((const unsigned*)((const char*)(gbase) + voffX), (PG8_LAS unsigned*)(lds + PG8_XA(b) + ldsx), 4, 0, 0)
#define PG8_LDA(dst, b, h) do { _Pragma("unroll") for (int m = 0; m < 4; ++m) _Pragma("unroll") for (int k = 0; k < 2; ++k) dst[m][k] = *(const PG8_LAS bf16x8*)(lds + PG8_SA(b, h) + aoff + m * 2048 + k * 1024); } while (0)
#define PG8_LDB(dst, b, h) do { _Pragma("unroll") for (int n = 0; n < 2; ++n) _Pragma("unroll") for (int k = 0; k < 2; ++k) dst[n][k] = *(const PG8_LAS bf16x8*)(lds + PG8_SB(b, h) + boff + n * 2048 + k * 1024); } while (0)
#define PG8_LDX(dst, b) do { _Pragma("unroll") for (int k = 0; k < 2; ++k) dst[k] = *(const PG8_LAS bf16x8*)(lds + PG8_XA(b) + xoff + k * 1024); } while (0)
#define PG8_MMA(ai, bj, At, Bt) do { __builtin_amdgcn_s_setprio(1); _Pragma("unroll") for (int m = 0; m < 4; ++m) _Pragma("unroll") for (int n = 0; n < 2; ++n) _Pragma("unroll") for (int k = 0; k < 2; ++k) \
        acc[ai][bj][m][n] = __builtin_amdgcn_mfma_f32_16x16x32_bf16(Bt[n][k], At[m][k], acc[ai][bj][m][n], 0, 0, 0); __builtin_amdgcn_s_setprio(0); } while (0)
#define PG8_XMMA() do { if (wr == 0) { _Pragma("unroll") for (int k = 0; k < 2; ++k) { accx[0] = __builtin_amdgcn_mfma_f32_16x16x32_bf16(B0[0][k], Ax[k], accx[0], 0, 0, 0); accx[1] = __builtin_amdgcn_mfma_f32_16x16x32_bf16(B1[0][k], Ax[k], accx[1], 0, 0, 0); } } \
        else { _Pragma("unroll") for (int k = 0; k < 2; ++k) { accx[0] = __builtin_amdgcn_mfma_f32_16x16x32_bf16(B0[1][k], Ax[k], accx[0], 0, 0, 0); accx[1] = __builtin_amdgcn_mfma_f32_16x16x32_bf16(B1[1][k], Ax[k], accx[1], 0, 0, 0); } } } while (0)
#define PG8_WAIT_V(n) asm volatile("s_waitcnt vmcnt(" #n ")" ::: "memory")
#define PG8_WAIT_L(n) asm volatile("s_waitcnt lgkmcnt(" #n ")" ::: "memory")
#define PG8_BAR __builtin_amdgcn_s_barrier()
#define PG8_SCHED __builtin_amdgcn_sched_barrier(0)
    Unit cur, nxt; int ui = 0;
    if (!S.next(0, cur)) return;
    if (SKEW_TICKS > 0) { const unsigned long long t0 = __builtin_amdgcn_s_memrealtime(); const unsigned long long dl = (unsigned long long)SKEW_TICKS * (unsigned)((blockIdx.x >> 3) & 3);
        while (__builtin_amdgcn_s_memrealtime() - t0 < dl) __builtin_amdgcn_s_sleep(8); }
    f32x4 acc[2][2][4][2]; f32x4 accx[2];
#pragma unroll
    for (int a = 0; a < 2; ++a)
#pragma unroll
        for (int b = 0; b < 2; ++b)
#pragma unroll
            for (int m = 0; m < 4; ++m)
#pragma unroll
                for (int n = 0; n < 2; ++n) acc[a][b][m][n] = (f32x4){0.f, 0.f, 0.f, 0.f};
    accx[0] = (f32x4){0.f, 0.f, 0.f, 0.f}; accx[1] = (f32x4){0.f, 0.f, 0.f, 0.f};
    bf16x8 At[4][2], B0[2][2], B1[2][2], Ax[2];
    const char* const xbase = ATILED ? (const char*)g.Ax : (const char*)g.A + (size_t)XMP * K * 2;
    const char* cA = (const char*)g.A + (size_t)cur.pm * tstepA; const char* cB = (const char*)g.Bt + (size_t)cur.pn * tstepB; const char* cX = xbase + (size_t)cur.pm * xstep;
    S.a_ready(cur);
    PG8_STAGE(PG8_SB(0, 0), cB, voffB); PG8_STAGE(PG8_SB(0, 1), cB + hstepB, voffB); PG8_STAGE(PG8_SA(0, 0), cA, voffA); PG8_STAGEX(0, cX); PG8_STAGE(PG8_SA(0, 1), cA + hstepA, voffA);
    if (wr == 1) PG8_BAR;
    PG8_WAIT_V(2); PG8_BAR;
    PG8_STAGE(PG8_SB(1, 0), cB + kstepB, voffB); PG8_STAGE(PG8_SA(1, 0), cA + kstepA, voffA); PG8_STAGE(PG8_SB(1, 1), cB + hstepB + kstepB, voffB); PG8_STAGEX(1, cX + kstepX);
    PG8_WAIT_V(7); PG8_BAR;
    for (;;) {
        const bool has_next = S.next(ui + 1, nxt);
        const char* nA = has_next ? (const char*)g.A + (size_t)nxt.pm * tstepA : cA; const char* nB = has_next ? (const char*)g.Bt + (size_t)nxt.pn * tstepB : cB; const char* nX = has_next ? xbase + (size_t)nxt.pm * xstep : cX;
        for (int kr = 0; kr < KREP; ++kr) {
        const bool fin = (kr == KREP - 1);
        if (KREP > 1 && kr > 0) {
#pragma unroll
            for (int a = 0; a < 2; ++a)
#pragma unroll
                for (int b = 0; b < 2; ++b)
#pragma unroll
                    for (int m = 0; m < 4; ++m)
#pragma unroll
                        for (int n = 0; n < 2; ++n) acc[a][b][m][n] = (f32x4){0.f, 0.f, 0.f, 0.f};
            accx[0] = (f32x4){0.f, 0.f, 0.f, 0.f}; accx[1] = (f32x4){0.f, 0.f, 0.f, 0.f};
        }
        for (int t = 0; t < nt; t += 2) {
            const bool last = (t == nt - 2);
            const char* a1 = cA + (size_t)(t + 1) * kstepA;
            const char* a2 = last ? (fin ? nA : cA) : cA + (size_t)(t + 2) * kstepA; const char* b2 = last ? (fin ? nB : cB) : cB + (size_t)(t + 2) * kstepB; const char* x2 = last ? (fin ? nX : cX) : cX + (size_t)(t + 2) * kstepX;
            const char* a3 = a2 + kstepA; const char* b3 = b2 + kstepB; const char* x3 = x2 + kstepX;
            if (last && has_next && fin) S.a_ready(nxt);
            PG8_LDB(B0, 0, 0); PG8_LDB(B1, 0, 1); PG8_SCHED; PG8_LDA(At, 0, 0); PG8_LDX(Ax, 0); PG8_STAGE(PG8_SA(1, 1), a1 + hstepA, voffA);
            PG8_WAIT_V(9); PG8_WAIT_L(0); PG8_BAR; PG8_MMA(0, 0, At, B0); PG8_MMA(0, 1, At, B1); PG8_XMMA(); PG8_BAR; PG8_SCHED;
            PG8_LDA(At, 0, 1); PG8_STAGE(PG8_SB(0, 0), b2, voffB); PG8_STAGE(PG8_SB(0, 1), b2 + hstepB, voffB); PG8_STAGE(PG8_SA(0, 0), a2, voffA); PG8_STAGEX(0, x2);
            PG8_WAIT_V(9); PG8_WAIT_L(0); PG8_BAR; PG8_MMA(1, 0, At, B0); PG8_MMA(1, 1, At, B1); PG8_BAR; PG8_SCHED;
            PG8_LDB(B0, 1, 0); PG8_LDB(B1, 1, 1); PG8_SCHED; PG8_LDA(At, 1, 0); PG8_LDX(Ax, 1); PG8_STAGE(PG8_SA(0, 1), a2 + hstepA, voffA);
            PG8_WAIT_V(9); PG8_WAIT_L(0); PG8_BAR; PG8_MMA(0, 0, At, B0); PG8_MMA(0, 1, At, B1); PG8_XMMA(); PG8_BAR; PG8_SCHED;
            PG8_LDA(At, 1, 1); PG8_STAGE(PG8_SB(1, 0), b3, voffB); PG8_STAGE(PG8_SB(1, 1), b3 + hstepB, voffB); PG8_STAGE(PG8_SA(1, 0), a3, voffA); PG8_STAGEX(1, x3);
            PG8_WAIT_V(9); PG8_WAIT_L(0); PG8_BAR; PG8_MMA(1, 0, At, B0); PG8_MMA(1, 1, At, B1); PG8_BAR; PG8_SCHED;
        }
        }
        if (wr == 0) PG8_BAR;
        { int fr_ = fr, fq_ = fq; asm volatile("" : "+v"(fr_), "+v"(fq_));
          for (int er = 0; er < EREP; ++er) E(acc, accx, cur, wr, wc, fr_, fq_, lds); } S.done(cur);
        if (!has_next) break;
#pragma unroll
        for (int a = 0; a < 2; ++a)
#pragma unroll
            for (int b = 0; b < 2; ++b)
#pragma unroll
                for (int m = 0; m < 4; ++m)
#pragma unroll
                    for (int n = 0; n < 2; ++n) acc[a][b][m][n] = (f32x4){0.f, 0.f, 0.f, 0.f};
        accx[0] = (f32x4){0.f, 0.f, 0.f, 0.f}; accx[1] = (f32x4){0.f, 0.f, 0.f, 0.f};
        cur = nxt; cA = nA; cB = nB; cX = nX; ++ui;
        if (wr == 1) PG8_BAR;
    }
    PG8_WAIT_V(0);
    PG8_BAR;
#undef PG8_SA
#undef PG8_SB
#undef PG8_XA
#undef PG8_STAGE
#undef PG8_STAGEX
#undef PG8_LDA
#undef PG8_LDB
#undef PG8_LDX
#undef PG8_MMA
#undef PG8_XMMA
#undef PG8_WAIT_V
#undef PG8_WAIT_L
#undef PG8_BAR
#undef PG8_SCHED
}
}

__device__ __forceinline__ void p0_transpose_item(const float* W, int K, int N, const float* gain, bf16* WT, int glu, LAS float* scr, int item, int lane) {
    const int nblk = N / 64, kb = item / nblk, nb = item % nblk, k0 = 64 * kb, n0 = 64 * nb;
    const int q = lane & 15, kr = lane >> 4;
    f32x4 v[16];
#pragma unroll
    for (int i = 0; i < 16; ++i) v[i] = *(const f32x4*)(W + (size_t)(k0 + 4 * i + kr) * N + n0 + 4 * q);
    if (gain) {
#pragma unroll
        for (int i = 0; i < 16; ++i) v[i] = v[i] * gain[k0 + 4 * i + kr];
    }
#pragma unroll
    for (int i = 0; i < 16; ++i) { LAS float* d = scr + (4 * i + kr) * 65 + 4 * q; d[0] = v[i][0]; d[1] = v[i][1]; d[2] = v[i][2]; d[3] = v[i][3]; }
    LDS_WAIT(); asm volatile("" ::: "memory");
    int drow0 = n0; if (glu) { const int bj = n0 / 1024, rem = n0 % 1024; drow0 = (rem / 128) * 256 + bj * 128 + (rem % 128); }
    const int c = lane & 7;
#pragma unroll
    for (int j = 0; j < 8; ++j) { const int n = (lane >> 3) + 8 * j; const LAS float* sp = scr + (8 * c) * 65 + n;
        v4u o; o.x = pk2(sp[0 * 65], sp[1 * 65]); o.y = pk2(sp[2 * 65], sp[3 * 65]); o.z = pk2(sp[4 * 65], sp[5 * 65]); o.w = pk2(sp[6 * 65], sp[7 * 65]);
        *(GAS v4u*)(WT + (size_t)(drow0 + n) * K + k0 + 8 * c) = o; }
    LDS_WAIT(); asm volatile("" ::: "memory");
}

__device__ __forceinline__ void sincos_rr(float x, float& s, float& c) {
    const float q = rintf(x * 0.63661977236758f);
    float r = fmaf(-q, 1.57079637050629f, x); r = fmaf(-q, -4.37113882867379e-8f, r);
    const float r2 = r * r;
    const float sp = r + r * r2 * (-1.6666667163e-1f + r2 * (8.3333337680e-3f + r2 * (-1.9841270114e-4f + r2 * 2.7557314297e-6f)));
    const float cp = 1.0f + r2 * (-0.5f + r2 * (4.1666667908e-2f + r2 * (-1.3888889225e-3f + r2 * (2.4801587642e-5f + r2 * -2.7557314297e-7f))));
    const int qi = (int)q & 3;
    s = (qi == 0) ? sp : (qi == 1) ? cp : (qi == 2) ? -sp : -cp;
    c = (qi == 0) ? cp : (qi == 1) ? -sp : (qi == 2) ? -cp : sp;
}

typedef float f32x16 __attribute__((ext_vector_type(16)));
typedef float f32x2_t __attribute__((ext_vector_type(2))); typedef __bf16 bf16x2_t __attribute__((ext_vector_type(2)));
__device__ __forceinline__ unsigned cvtpk_c(float lo, float hi) { f32x2_t v = {lo, hi}; bf16x2_t b = __builtin_convertvector(v, bf16x2_t); return __builtin_bit_cast(unsigned, b); }
typedef unsigned u32x2 __attribute__((ext_vector_type(2)));
__device__ __forceinline__ void ssm_abar_calc(const float* A_re, const float* A_im, const float* log_dt, int g, int n, float& abr, float& abi, float& cfr, float& cfi) {
    const float dt = expf(log_dt[g]);
    const float ar = A_re[g * 64 + n], ai = A_im[g * 64 + n];
    const float mag = expf(dt * ar); float sn, cs; sincos_rr(dt * ai, sn, cs);
    abr = mag * cs; abi = mag * sn;
    const float den = ar * ar + ai * ai, nr = abr - 1.0f;
    cfr = (nr * ar + abi * ai) / den; cfi = (abi * ar - nr * ai) / den;
}
__device__ __forceinline__ float gelu_tanh(float y) {
    const float z = 0.7978845608028654f * (y + 0.044715f * y * y * y);
    return y * __builtin_amdgcn_rcpf(1.0f + __expf(-2.0f * z));
}
__device__ __forceinline__ void wg_rinv(LAS float* tab, const float* ssp, int row0, int nrows, int np, int tid) {
    __syncthreads();
    const int row = tid >> 1, hf = tid & 1;
    if (row < nrows) {
        const float* p = ssp + (size_t)(row0 + row) * 64 + (np >> 1) * hf;
        f32x4 v[4];
#pragma unroll
        for (int i = 0; i < 4; ++i) v[i] = *(const f32x4*)(p + 4 * i);
        float s_ = ((v[0][0] + v[0][1]) + (v[0][2] + v[0][3])) + ((v[1][0] + v[1][1]) + (v[1][2] + v[1][3]));
        const float s2 = ((v[2][0] + v[2][1]) + (v[2][2] + v[2][3])) + ((v[3][0] + v[3][1]) + (v[3][2] + v[3][3]));
        s_ += (np == 32) ? s2 : 0.f;
        s_ += __shfl_xor(s_, 1);
        if (hf == 0) tab[row] = rsqrtf(s_ * (1.0f / 1024.0f) + 1e-6f);
    }
    __syncthreads();
}
struct SsmT { const bf16* BT; const bf16* CT; const float* tab; const float* Dk; const float* gain; };
template <int MODE>
__device__ __forceinline__ void ssm_mfma_unit(LAS unsigned char* wl, int lane, int g, const SsmT& T, const bf16* XB, const LAS float* rv, int row0, int nblk,
                                              float (&st)[4]  , bf16* Gout, const float* h0r, const float* h0i, float* hor, float* hoi  , int b0) {
    const int r32 = lane & 31, hi5 = lane >> 5, c16 = lane & 15, kq = lane >> 4;
    pg8::bf16x8 bt[4], ct[4];
#pragma unroll
    for (int tn = 0; tn < 4; ++tn) bt[tn] = *(const pg8::bf16x8*)(T.BT + (size_t)(tn * 32 + r32) * 16 + 8 * hi5);
    if (MODE != 0) {
#pragma unroll
        for (int ks = 0; ks < 4; ++ks) ct[ks] = *(const pg8::bf16x8*)(T.CT + (size_t)c16 * 128 + 32 * ks + 8 * kq);
    }
    float ar[2], ai[2];
    { const f32x4 t0 = *(const f32x4*)(T.tab + (size_t)r32 * 4), t1 = *(const f32x4*)(T.tab + (size_t)(32 + r32) * 4); ar[0] = t0[0]; ai[0] = t0[1]; ar[1] = t1[0]; ai[1] = t1[1]; }
    f32x4 Dg = {0.f, 0.f, 0.f, 0.f};
    if (MODE != 0) { const f32x4 dv = *(const f32x4*)(T.Dk + 4 * kq), gv = *(const f32x4*)(T.gain + 4 * kq); Dg = dv * gv; }
    float pwr[2][16], pwi[2][16], a32r[2], a32i[2];
    if (MODE == 0) {
#pragma unroll
        for (int p = 0; p < 2; ++p) {
            const float a_r = ar[p], a_i = ai[p];
            float a2r = a_r * a_r - a_i * a_i, a2i = 2.0f * a_r * a_i;
            float a4r = a2r * a2r - a2i * a2i, a4i = 2.0f * a2r * a2i;
            const float a5r = a4r * a_r - a4i * a_i, a5i = a4r * a_i + a4i * a_r;
            float cr = hi5 ? 1.0f : a4r, ci = hi5 ? 0.0f : a4i;
#pragma unroll
            for (int Q = 3; Q >= 0; --Q) {
#pragma unroll
                for (int e = 3; e >= 0; --e) {
                    pwr[p][4 * Q + e] = cr; pwi[p][4 * Q + e] = ci;
                    const float mr = (e == 0) ? a5r : a_r, mi = (e == 0) ? a5i : a_i;
                    const float tr = cr * mr - ci * mi, ti = cr * mi + ci * mr; cr = tr; ci = ti;
                }
            }
            float t8r = a4r * a4r - a4i * a4i, t8i = 2.0f * a4r * a4i;
            float t16r = t8r * t8r - t8i * t8i, t16i = 2.0f * t8r * t8i;
            a32r[p] = t16r * t16r - t16i * t16i; a32i[p] = 2.0f * t16r * t16i;
        }
    }
    pg8::bf16x8 xa_all[8];
    if (MODE != 2) {
#pragma unroll
        for (int k = 0; k < 8; ++k) xa_all[k] = *(const pg8::bf16x8*)(XB + (size_t)(row0 + 32 * k + r32) * 1024 + g * 16 + 8 * hi5);
    } else {
        xa_all[0] = *(const pg8::bf16x8*)(XB + (size_t)(row0 + r32) * 1024 + g * 16 + 8 * hi5);
    }
    for (int blk = 0; blk < nblk; ++blk) {
        const int rowb = row0 + 32 * blk;
        const pg8::bf16x8 xa = xa_all[0];
        if (MODE != 2) {
#pragma unroll
            for (int k = 0; k < 7; ++k) xa_all[k] = xa_all[k + 1];
        }
        if (MODE != 0) *(LAS pg8::bf16x8*)(wl + 9728 + r32 * 32 + hi5 * 16) = xa;
        const LAS float* rvb = rv + ((MODE == 2) ? 0 : 32 * blk);
        pg8::bf16x8 xs_;
        { const float rin = rvb[r32]; const v4u xw = __builtin_bit_cast(v4u, xa); v4u ow;
          ow.x = cvtpk_c(bf_lo(xw.x) * rin, bf_hi(xw.x) * rin); ow.y = cvtpk_c(bf_lo(xw.y) * rin, bf_hi(xw.y) * rin);
          ow.z = cvtpk_c(bf_lo(xw.z) * rin, bf_hi(xw.z) * rin); ow.w = cvtpk_c(bf_lo(xw.w) * rin, bf_hi(xw.w) * rin); xs_ = __builtin_bit_cast(pg8::bf16x8, ow); }
        f32x16 IN[4];
#pragma unroll
        for (int tn = 0; tn < 4; ++tn) { const f32x16 z = {0.f, 0.f, 0.f, 0.f, 0.f, 0.f, 0.f, 0.f, 0.f, 0.f, 0.f, 0.f, 0.f, 0.f, 0.f, 0.f}; IN[tn] = __builtin_amdgcn_mfma_f32_32x32x16_bf16(xs_, bt[tn], z, 0, 0, 0); }
        if (MODE == 0) {
#pragma unroll
            for (int p = 0; p < 2; ++p) {
                float er[2] = {0.f, 0.f}, ei[2] = {0.f, 0.f};
#pragma unroll
                for (int r = 0; r < 16; ++r) {
                    const float xr_ = IN[2 * p][r], xi_ = IN[2 * p + 1][r], wr_ = pwr[p][r], wi_ = pwi[p][r];
                    float t = fmaf(wr_, xr_, er[r & 1]); asm volatile("" : "+v"(t)); t = fmaf(-wi_, xi_, t); asm volatile("" : "+v"(t)); er[r & 1] = t;
                    float u = fmaf(wr_, xi_, ei[r & 1]); asm volatile("" : "+v"(u)); u = fmaf(wi_, xr_, u); asm volatile("" : "+v"(u)); ei[r & 1] = u;
                }
                float e_r = er[0] + er[1], e_i = ei[0] + ei[1];
                asm volatile("" : "+v"(e_r), "+v"(e_i));
                { auto w0 = __builtin_amdgcn_permlane32_swap(__float_as_uint(e_r), __float_as_uint(e_r), false, false); e_r = __uint_as_float(w0[0]) + __uint_as_float(w0[1]);
                  auto w1 = __builtin_amdgcn_permlane32_swap(__float_as_uint(e_i), __float_as_uint(e_i), false, false); e_i = __uint_as_float(w1[0]) + __uint_as_float(w1[1]); }
                asm volatile("" : "+v"(e_r), "+v"(e_i));
                const float sr = st[2 * p], si = st[2 * p + 1];
                float nr = fmaf(a32r[p], sr, e_r); asm volatile("" : "+v"(nr)); nr = fmaf(-a32i[p], si, nr); asm volatile("" : "+v"(nr));
                float ni = fmaf(a32r[p], si, e_i); asm volatile("" : "+v"(ni)); ni = fmaf(a32i[p], sr, ni); asm volatile("" : "+v"(ni));
                st[2 * p] = nr; st[2 * p + 1] = ni;
            }
        } else
#pragma unroll
        for (int p = 0; p < 2; ++p) {
            float sr = st[2 * p], si = st[2 * p + 1];
            const float a_r = ar[p], a_i = ai[p];
            const bool up = (hi5 != 0);
#pragma unroll
            for (int Q = 0; Q < 4; ++Q) {
                if (MODE == 2) { const size_t hidx = ((size_t)(b0 + Q) * 64 + g) * 64 + 32 * p + r32; sr = h0r[hidx]; si = h0i[hidx]; }
                float xr_[4], xi_[4], yr_[4], yi_[4];
                float cr = sr, ci = si;
#pragma unroll
                for (int e = 0; e < 4; ++e) { float tr = fmaf(a_r, cr, IN[2 * p][4 * Q + e]); asm volatile("" : "+v"(tr)); tr = fmaf(-a_i, ci, tr); asm volatile("" : "+v"(tr)); float ti = fmaf(a_r, ci, IN[2 * p + 1][4 * Q + e]); asm volatile("" : "+v"(ti)); ti = fmaf(a_i, cr, ti); asm volatile("" : "+v"(ti)); cr = tr; ci = ti; xr_[e] = cr; xi_[e] = ci; }
                { auto w0 = __builtin_amdgcn_permlane32_swap(__float_as_uint(cr), __float_as_uint(cr), false, false); cr = __uint_as_float(w0[0]);
                  auto w1 = __builtin_amdgcn_permlane32_swap(__float_as_uint(ci), __float_as_uint(ci), false, false); ci = __uint_as_float(w1[0]); }
#pragma unroll
                for (int e = 0; e < 4; ++e) { float tr = fmaf(a_r, cr, IN[2 * p][4 * Q + e]); asm volatile("" : "+v"(tr)); tr = fmaf(-a_i, ci, tr); asm volatile("" : "+v"(tr)); float ti = fmaf(a_r, ci, IN[2 * p + 1][4 * Q + e]); asm volatile("" : "+v"(ti)); ti = fmaf(a_i, cr, ti); asm volatile("" : "+v"(ti)); cr = tr; ci = ti; yr_[e] = cr; yi_[e] = ci; }
                { auto w0 = __builtin_amdgcn_permlane32_swap(__float_as_uint(cr), __float_as_uint(cr), false, false); sr = __uint_as_float(w0[1]);
                  auto w1 = __builtin_amdgcn_permlane32_swap(__float_as_uint(ci), __float_as_uint(ci), false, false); si = __uint_as_float(w1[1]); }
#pragma unroll
                for (int e = 0; e < 4; ++e) { IN[2 * p][4 * Q + e] = up ? yr_[e] : xr_[e]; IN[2 * p + 1][4 * Q + e] = up ? yi_[e] : xi_[e]; }
                if (MODE == 2) { if (hi5 == 0) { const size_t hidx = ((size_t)(b0 + Q) * 64 + g) * 64 + 32 * p + r32; hor[hidx] = sr; hoi[hidx] = si; } }
            }
            st[2 * p] = sr; st[2 * p + 1] = si;
        }
        if (MODE != 0) {
#pragma unroll
            for (int p = 0; p < 2; ++p)
#pragma unroll
                for (int r = 0; r < 16; ++r) { const int tau = 8 * (r >> 2) + 4 * hi5 + (r & 3); *(LAS unsigned*)(wl + tau * 272 + 4 * (32 * p + r32)) = pg8::cvt_pk_bf16(IN[2 * p][r], IN[2 * p + 1][r]); }
            LDS_WAIT(); asm volatile("" ::: "memory");
#pragma unroll
            for (int tt = 0; tt < 2; ++tt) {
                f32x4 y = {0.f, 0.f, 0.f, 0.f};
#pragma unroll
                for (int ks = 0; ks < 4; ++ks) { const pg8::bf16x8 hf = *(const LAS pg8::bf16x8*)(wl + (16 * tt + c16) * 272 + (32 * ks + 8 * kq) * 2); y = __builtin_amdgcn_mfma_f32_16x16x32_bf16(ct[ks], hf, y, 0, 0, 0); }
                const int token = rowb + 16 * tt + c16;
                const float rinv = rvb[16 * tt + c16];
                const f32x4 xv = pg8::unpack4(*(const LAS u32x2*)(wl + 9728 + (16 * tt + c16) * 32 + kq * 8));
                f32x4 o;
#pragma unroll
                for (int e = 0; e < 4; ++e) o[e] = gelu_tanh(y[e] + Dg[e] * (xv[e] * rinv));
                *(u32x2*)(Gout + (size_t)token * 1024 + g * 16 + 4 * kq) = pg8::pack4(o);
            }
        }
        LDS_WAIT(); asm volatile("" ::: "memory");
    }
}

#ifndef SKEW_UP
#define SKEW_UP 250
#define SKEW_GLU 250
#endif
#ifndef PROBE_DUP
#define PROBE_DUP 0
#endif
#define NREP(bit) (((PROBE_DUP) >> (bit)) & 1 ? 2 : 1)
#ifndef EN_P0
#define EN_P0 1
#endif
#ifndef EN_QKV
#define EN_QKV 1
#endif
#ifndef EN_ATT
#define EN_ATT 1
#endif
#ifndef EN_OPJ
#define EN_OPJ 1
#endif
#ifndef EN_S1
#define EN_S1 1
#endif
#ifndef EN_S3
#define EN_S3 1
#endif
#ifndef EN_GLU
#define EN_GLU 1
#endif
#ifndef EN_UP
#define EN_UP 1
#endif
#ifndef EN_DN
#define EN_DN 1
#endif
#ifndef EN_FIN
#define EN_FIN 1
#endif
template <class T> __device__ __forceinline__ T karg(const __attribute__((address_space(4))) char* ka, int off) { typedef const __attribute__((address_space(4))) T CT; return *(CT*)(ka + off); }
struct Args { const float* in[23]; float* out; unsigned char* ws; int ph_lo, ph_hi; };
static_assert(sizeof(Args) == 208 && __builtin_offsetof(Args, out) == 184 && __builtin_offsetof(Args, ws) == 192, "kernarg layout used by KARG");

__global__ void __launch_bounds__(512, 2) fwd_kernel(Args args) {
    extern __shared__ __attribute__((aligned(16))) unsigned char lds[];
    LAS unsigned char* const L = (LAS unsigned char*)lds;
#define FRESH_IDS int tid = threadIdx.x; asm volatile("" : "+v"(tid)); const int lane = tid & 63, wave = __builtin_amdgcn_readfirstlane(tid >> 6); const int gw = vcu * 8 + wave; (void)lane; (void)gw
    const int G = gridDim.x, bx = blockIdx.x;
    const int vcu = (G % 8 == 0) ? (bx % 8) * (G / 8) + bx / 8 : bx;
    const int NGW = G * 8;
    for (int u = threadIdx.x; u < (LDS_BYTES - LDSCTL_OFF) / 4; u += 512) ((LAS unsigned*)(L + LDSCTL_OFF))[u] = 0u;
    __syncthreads();
    const int lo = args.ph_lo, hi = args.ph_hi;
    const bool multi = (hi - lo) > 1;
    XcdBarrier bar; bar.bar = (unsigned*)(args.ws + WS_CTL) + CW_BAR; bar.x = 0; bar.st = nullptr;
    if (multi) bar = xcd_barrier_post((unsigned*)(args.ws + WS_CTL) + CW_BAR, (volatile LAS unsigned*)(L + MISC_OFF) + 8);
#define IN(k) (lo <= (k) && (k) < hi)
#define SEAM(k) do { if (IN(k) && IN((k) + 1)) xcd_barrier(bar); } while (0)

#define KARG(T, off) karg<T>(ka, (off))
#define INP(k) karg<const float*>(ka, 8 * (k))
#define FRESH_PTRS const __attribute__((address_space(4))) char* ka = (const __attribute__((address_space(4))) char*)__builtin_amdgcn_kernarg_segment_ptr(); asm volatile("" : "+s"(ka)); \
    unsigned char* const ws = KARG(unsigned char*, 192); float* const out = KARG(float*, 184); \
    float* const ssp = (float*)(ws + WS_SSP); float* const HS = (float*)(ws + WS_HS); bf16* const XB = (bf16*)(ws + WS_XB); bf16* const Hb = (bf16*)(ws + WS_H); \
    bf16* const Qb = (bf16*)(ws + WS_Q); bf16* const Kb = (bf16*)(ws + WS_K); bf16* const Vb = (bf16*)(ws + WS_V); bf16* const Ob = (bf16*)(ws + WS_O); \
    const float* const x_p = INP(0); const float* const x_s = INP(1); (void)ssp; (void)HS; (void)XB; (void)Hb; (void)Qb; (void)Kb; (void)Vb; (void)Ob; (void)x_p; (void)x_s
    if (EN_P0 && IN(0)) for (int rp = 0; rp < NREP(0); ++rp) {
        FRESH_IDS; FRESH_PTRS;
        LAS float* scr = (LAS float*)(L + wave * 16640);
        constexpr int I_QKV = 16 * 24, I_O = 16 * 16, I_GLU = 16 * 32, I_UP = 16 * 64, I_DN = 64 * 16;
        constexpr int NITEMS = 2 * I_QKV + 2 * I_O + 2 * I_GLU + 4 * I_UP + 4 * I_DN;
        for (int it = gw; it < NITEMS; it += NGW) {
            int r = it;
            if (r < 2 * I_QKV) { const int j = r / I_QKV; r -= j * I_QKV; p0_transpose_item(INP(9) + (size_t)j * D * NQKV, D, NQKV, INP(6) + (size_t)(2 * j) * D, (bf16*)(ws + WS_WQKV) + (size_t)j * NQKV * D, 0, scr, r, lane); continue; } r -= 2 * I_QKV;
            if (r < 2 * I_O) { const int j = r / I_O; r -= j * I_O; p0_transpose_item(INP(10) + (size_t)j * D * D, D, D, nullptr, (bf16*)(ws + WS_WO) + (size_t)j * D * D, 0, scr, r, lane); continue; } r -= 2 * I_O;
            if (r < 2 * I_GLU) { const int j = r / I_GLU; r -= j * I_GLU; p0_transpose_item(INP(20) + (size_t)j * D * 2 * D, D, 2 * D, nullptr, (bf16*)(ws + WS_WGLU) + (size_t)j * 2 * D * D, 1, scr, r, lane); continue; } r -= 2 * I_GLU;
            if (r < 4 * I_UP) { const int l = r / I_UP; r -= l * I_UP; p0_transpose_item(INP(21) + (size_t)l * D * FF, D, FF, INP(7) + (size_t)l * D, (bf16*)(ws + WS_WUP) + (size_t)l * FF * D, 0, scr, r, lane); continue; } r -= 4 * I_UP;
            { const int l = r / I_DN; r -= l * I_DN; p0_transpose_item(INP(22) + (size_t)l * FF * D, FF, D, nullptr, (bf16*)(ws + WS_WDN) + (size_t)l * D * FF, 0, scr, r, lane); }
        }
        for (int m0 = 2 * gw; m0 < M; m0 += 2 * NGW) {
            f32x4 v[2][4];
#pragma unroll
            for (int rr = 0; rr < 2; ++rr) { const int m = m0 + rr; const float* xrow = (m < MP) ? x_p + (size_t)m * D : x_s + (size_t)(m - MP) * D;
#pragma unroll
                for (int j = 0; j < 4; ++j) v[rr][j] = *((const GAS f32x4*)xrow + lane + 64 * j); }
#pragma unroll
            for (int rr = 0; rr < 2; ++rr) { const int m = m0 + rr; float sq = 0.f;
#pragma unroll
                for (int j = 0; j < 4; ++j) sq += (v[rr][j][0] * v[rr][j][0] + v[rr][j][1] * v[rr][j][1]) + (v[rr][j][2] * v[rr][j][2] + v[rr][j][3] * v[rr][j][3]);
                sq = wave_sum(sq);
                GAS unsigned long long* o8 = (GAS unsigned long long*)(XB + (size_t)m * D) + lane;
#pragma unroll
                for (int j = 0; j < 4; ++j) o8[64 * j] = (unsigned long long)pk2(v[rr][j][0], v[rr][j][1]) | ((unsigned long long)pk2(v[rr][j][2], v[rr][j][3]) << 32);
                if (lane < 32) ssp[(size_t)m * 64 + lane] = (lane == 0) ? sq : 0.f; }
        }
        for (int i = bx * 512 + tid; i < 2 * NG * NS; i += G * 512) {
            const int jj = i >> 12, gn = i & 4095, g = gn >> 6, n = gn & 63; float abr, abi, cfr, cfi;
            ssm_abar_calc(INP(12) + (size_t)jj * NG * NS, INP(13) + (size_t)jj * NG * NS, INP(14) + (size_t)jj * NG, g, n, abr, abi, cfr, cfi);
            f32x4 v; v[0] = abr; v[1] = abi; v[2] = cfr; v[3] = cfi; *(f32x4*)((float*)(ws + WS_TAB) + (size_t)i * 4) = v;
            const float* bre = INP(15) + (size_t)i * 16; const float* bim = INP(16) + (size_t)i * 16; const float* gn_ = INP(6) + (size_t)(2 * jj + 1) * D + g * 16;
            bf16* btr = (bf16*)(ws + WS_BT) + ((size_t)(jj * NG + g) * 128 + (2 * (n >> 5)) * 32 + (n & 31)) * 16; bf16* bti = btr + 32 * 16;
#pragma unroll
            for (int c8 = 0; c8 < 2; ++c8) {
                float wr_[8], wi_[8];
#pragma unroll
                for (int c4 = 0; c4 < 2; ++c4) { const f32x4 br = *(const f32x4*)(bre + 8 * c8 + 4 * c4), bi = *(const f32x4*)(bim + 8 * c8 + 4 * c4), gv = *(const f32x4*)(gn_ + 8 * c8 + 4 * c4);
#pragma unroll
                    for (int e = 0; e < 4; ++e) { wr_[4 * c4 + e] = (cfr * br[e] - cfi * bi[e]) * gv[e]; wi_[4 * c4 + e] = (cfr * bi[e] + cfi * br[e]) * gv[e]; } }
                v4u o; o.x = pk2(wr_[0], wr_[1]); o.y = pk2(wr_[2], wr_[3]); o.z = pk2(wr_[4], wr_[5]); o.w = pk2(wr_[6], wr_[7]); *(v4u*)(btr + 8 * c8) = o;
                o.x = pk2(wi_[0], wi_[1]); o.y = pk2(wi_[2], wi_[3]); o.z = pk2(wi_[4], wi_[5]); o.w = pk2(wi_[6], wi_[7]); *(v4u*)(bti + 8 * c8) = o;
            }
        }
        for (int i = bx * 512 + tid; i < 2 * NG * GC * 16; i += G * 512) {
            const int n4 = i & 15; const size_t rowi = (size_t)(i >> 4);
            const f32x4 cr = *(const f32x4*)(INP(17) + rowi * 64 + 4 * n4), ci = *(const f32x4*)(INP(18) + rowi * 64 + 4 * n4);
            v4u o; o.x = pk2(cr[0], -ci[0]); o.y = pk2(cr[1], -ci[1]); o.z = pk2(cr[2], -ci[2]); o.w = pk2(cr[3], -ci[3]);
            *(v4u*)((bf16*)(ws + WS_CT) + rowi * 128 + 8 * n4) = o;
        }
        __syncthreads();
    }
    SEAM(0);

    for (int l = 0; l < 4; ++l) {
        const int pb = 1 + 5 * l, j = l >> 1;
        if ((l & 1) == 0) {
            if (EN_QKV && IN(pb)) for (int rp = 0; rp < NREP(3); ++rp) {
                FRESH_PTRS;
                pg8::GemmX g{XB, (const bf16*)(ws + WS_WQKV) + (size_t)j * NQKV * D, nullptr, D}; pg8::StaticOrder S; S.init(MP, NQKV, G, bx);
                pg8::EpiQKV E{Qb, Kb, Vb, ssp, 16, 32, out + O_KP + (size_t)j * 2 * 128 * 256, out + O_VP + (size_t)j * 2 * 128 * 256, out + O_KS + (size_t)j * SB * 128 * 256, out + O_VS + (size_t)j * SB * 128 * 256};
                if (threadIdx.x == 0) *(LAS int*)(L + pg8::RINV_TAB_OFF + 1152) = -1;
                __syncthreads();
                pg8::gemm_phase_x<pg8::EpiQKV, pg8::StaticOrder>(L, g, S, E);
                if (l == 0 && rp == 0 && bx + G >= (MP / 256) * (NQKV / 256) && 2 * G > (MP / 256) * (NQKV / 256)) {
                    FRESH_IDS;
                    const int nwg_ = (MP / 256) * (NQKV / 256), myidx = bx - (nwg_ - G), nidle = 2 * G - nwg_;
                    constexpr int PER = 120 * 256 / 4;
                    for (int slab = myidx; slab < 2 * 2 * SB; slab += nidle) {
                        const int kv = slab >> 8, jb = slab & 255;
                        const f32x4* src = (const f32x4*)(INP(2 + kv) + (size_t)jb * 128 * 256 + 8 * 256) + tid;
                        f32x4* dst = (f32x4*)(out + (kv ? O_VS : O_KS) + (size_t)jb * 128 * 256) + tid;
#pragma unroll 1
                        for (int it = 0; it < 15; it += 5) {
                            f32x4 v[5];
#pragma unroll
                            for (int k = 0; k < 5; ++k) v[k] = src[(it + k) * 512];
#pragma unroll
                            for (int k = 0; k < 5; ++k) dst[(it + k) * 512] = v[k];
                        }
                    }
                }
            }
            SEAM(pb);
            if (EN_ATT && IN(pb + 1)) for (int rp = 0; rp < NREP(1); ++rp) {
                FRESH_IDS; FRESH_PTRS;
                const LAS unsigned char* Kl = L; const LAS unsigned char* Vl = L + 36864;
                const float* ck = INP(2) + (size_t)j * SB * 128 * 256; const float* cv = INP(3) + (size_t)j * SB * 128 * 256;
                const float* sinks = INP(11) + j * 16;
                const int r32 = lane & 31, hi5 = lane >> 5;
                for (int u = vcu; u < 1024; u += G) {
                    const bool samp = u >= 512;
                    int b, qblk = 0, kvh;
                    if (!samp) { kvh = u & 3; qblk = (u >> 2) & 63; b = u >> 8; } else { const int us = u - 512; kvh = us & 3; b = us >> 2; }
                    const int nchunk = samp ? 160 * 8 : 256 * 8;
                    for (int id = tid; id < nchunk; id += 512) {
                        const int key = id >> 3, ch = id & 7;
                        v4u kv = {0u, 0u, 0u, 0u}, vv = {0u, 0u, 0u, 0u};
                        if (!samp) {
                            const int s = qblk * 128 - 128 + key;
                            if (s >= 0) { const size_t off = (size_t)((b << 13) + s) * 256 + kvh * 64 + ch * 8; kv = *(const v4u*)(Kb + off); vv = *(const v4u*)(Vb + off); }
                        } else if (key < 128) {
                            const size_t off = ((size_t)b * 128 + key) * 256 + kvh * 64 + ch * 8;
                            const f32x4 k0 = *(const f32x4*)(ck + off), k1 = *(const f32x4*)(ck + off + 4), v0 = *(const f32x4*)(cv + off), v1 = *(const f32x4*)(cv + off + 4);
                            kv.x = pk2(k0[0], k0[1]); kv.y = pk2(k0[2], k0[3]); kv.z = pk2(k1[0], k1[1]); kv.w = pk2(k1[2], k1[3]);
                            vv.x = pk2(v0[0], v0[1]); vv.y = pk2(v0[2], v0[3]); vv.z = pk2(v1[0], v1[1]); vv.w = pk2(v1[2], v1[3]);
                        } else if (key < 136) {
                            const size_t off = (size_t)(MP + b * 8 + (key - 128)) * 256 + kvh * 64 + ch * 8; kv = *(const v4u*)(Kb + off); vv = *(const v4u*)(Vb + off);
                        }
                        *(LAS v4u*)(L + key * 144 + ch * 16) = kv;
                        LAS unsigned short* vt = (LAS unsigned short*)(L + 36864 + (ch * 8) * 520 + key * 2);
                        vt[0 * 260] = (unsigned short)(vv.x & 0xffffu); vt[1 * 260] = (unsigned short)(vv.x >> 16); vt[2 * 260] = (unsigned short)(vv.y & 0xffffu); vt[3 * 260] = (unsigned short)(vv.y >> 16);
                        vt[4 * 260] = (unsigned short)(vv.z & 0xffffu); vt[5 * 260] = (unsigned short)(vv.z >> 16); vt[6 * 260] = (unsigned short)(vv.w & 0xffffu); vt[7 * 260] = (unsigned short)(vv.w >> 16);
                    }
                    __syncthreads();
                    const int ntask = samp ? ((wave == 0) ? 1 : 0) : 2;
                    for (int ti = 0; ti < ntask; ++ti) {
                        int qrow, head, tloc, kb0, jkmin;
                        if (!samp) { const int sb = 2 * (wave & 1) + ti; head = kvh * 4 + (wave >> 1); tloc = 32 * sb + r32; qrow = (b << 13) + qblk * 128 + tloc; kb0 = sb; jkmin = (qblk == 0) ? 128 : 0; }
                        else { head = kvh * 4 + (r32 >> 3); tloc = r32 & 7; qrow = MP + b * 8 + tloc; kb0 = 0; jkmin = 0; }
                        const float slope2 = exp2f(-0.5f * (float)(head + 1)) * 1.4426950408889634f, sink2 = sinks[head] * 1.4426950408889634f;
                        const bf16* qptr = Qb + (size_t)qrow * 1024 + head * 64 + 8 * hi5;
                        pg8::bf16x8 qf[4];
#pragma unroll
                        for (int ks = 0; ks < 4; ++ks) qf[ks] = *(const pg8::bf16x8*)(qptr + 16 * ks);
                        f32x16 S[5];
#pragma unroll
                        for (int i = 0; i < 5; ++i) {
                            f32x16 acc = {0.f, 0.f, 0.f, 0.f, 0.f, 0.f, 0.f, 0.f, 0.f, 0.f, 0.f, 0.f, 0.f, 0.f, 0.f, 0.f};
#pragma unroll
                            for (int ks = 0; ks < 4; ++ks) { const pg8::bf16x8 kf = *(const LAS pg8::bf16x8*)(Kl + (32 * (kb0 + i) + r32) * 144 + 32 * ks + 16 * hi5); acc = __builtin_amdgcn_mfma_f32_32x32x16_bf16(kf, qf[ks], acc, 0, 0, 0); }
                            S[i] = acc;
                        }
                        float mx = sink2;
#pragma unroll
                        for (int i = 0; i < 5; ++i)
#pragma unroll
                            for (int r = 0; r < 16; ++r) {
                                const int jk = 32 * (kb0 + i) + (r & 3) + 8 * (r >> 2) + 4 * hi5; const int dist = tloc + 128 - jk;
                                const bool valid = (dist >= 0) && (dist <= 128) && (jk >= jkmin);
                                const float sv = valid ? (S[i][r] * 0.18033688011112042f - slope2 * (float)dist) : -1e30f;
                                S[i][r] = sv; mx = fmaxf(mx, sv);
                            }
                        mx = fmaxf(mx, __shfl_xor(mx, 32));
                        float lsum = 0.f;
#pragma unroll
                        for (int i = 0; i < 5; ++i)
#pragma unroll
                            for (int r = 0; r < 16; ++r) { const float p = __builtin_amdgcn_exp2f(S[i][r] - mx); S[i][r] = p; lsum += p; }
                        lsum += __shfl_xor(lsum, 32); lsum += __builtin_amdgcn_exp2f(sink2 - mx);
                        const float inv = 1.0f / lsum;
                        f32x16 O0 = {0.f, 0.f, 0.f, 0.f, 0.f, 0.f, 0.f, 0.f, 0.f, 0.f, 0.f, 0.f, 0.f, 0.f, 0.f, 0.f}, O1 = O0;
#pragma unroll
                        for (int i = 0; i < 5; ++i)
#pragma unroll
                            for (int s2 = 0; s2 < 2; ++s2) {
                                v4u pw; pw.x = pg8::cvt_pk_bf16(S[i][8 * s2 + 0], S[i][8 * s2 + 1]); pw.y = pg8::cvt_pk_bf16(S[i][8 * s2 + 2], S[i][8 * s2 + 3]);
                                pw.z = pg8::cvt_pk_bf16(S[i][8 * s2 + 4], S[i][8 * s2 + 5]); pw.w = pg8::cvt_pk_bf16(S[i][8 * s2 + 6], S[i][8 * s2 + 7]);
                                const pg8::bf16x8 pf = __builtin_bit_cast(pg8::bf16x8, pw);
                                const int keyoff = 32 * (kb0 + i) + 16 * s2 + 4 * hi5;
                                { const u32x2 lo = *(const LAS u32x2*)(Vl + r32 * 520 + keyoff * 2), hh = *(const LAS u32x2*)(Vl + r32 * 520 + (keyoff + 8) * 2);
                                  v4u vw; vw.x = lo.x; vw.y = lo.y; vw.z = hh.x; vw.w = hh.y; O0 = __builtin_amdgcn_mfma_f32_32x32x16_bf16(__builtin_bit_cast(pg8::bf16x8, vw), pf, O0, 0, 0, 0); }
                                { const u32x2 lo = *(const LAS u32x2*)(Vl + (32 + r32) * 520 + keyoff * 2), hh = *(const LAS u32x2*)(Vl + (32 + r32) * 520 + (keyoff + 8) * 2);
                                  v4u vw; vw.x = lo.x; vw.y = lo.y; vw.z = hh.x; vw.w = hh.y; O1 = __builtin_amdgcn_mfma_f32_32x32x16_bf16(__builtin_bit_cast(pg8::bf16x8, vw), pf, O1, 0, 0, 0); }
                            }
                        bf16* optr = Ob + (size_t)qrow * 1024 + head * 64 + 4 * hi5;
#pragma unroll
                        for (int qd = 0; qd < 4; ++qd) {
                            u32x2 w0; w0.x = pg8::cvt_pk_bf16(O0[4 * qd] * inv, O0[4 * qd + 1] * inv); w0.y = pg8::cvt_pk_bf16(O0[4 * qd + 2] * inv, O0[4 * qd + 3] * inv);
                            u32x2 w1; w1.x = pg8::cvt_pk_bf16(O1[4 * qd] * inv, O1[4 * qd + 1] * inv); w1.y = pg8::cvt_pk_bf16(O1[4 * qd + 2] * inv, O1[4 * qd + 3] * inv);
                            *(u32x2*)(optr + 8 * qd) = w0; *(u32x2*)(optr + 32 + 8 * qd) = w1;
                        }
                    }
                    __syncthreads();
                }
            }
            SEAM(pb + 1);
            if (EN_OPJ && IN(pb + 2)) {
                FRESH_PTRS;
                pg8::GemmX g{Ob, (const bf16*)(ws + WS_WO) + (size_t)j * D * D, nullptr, D}; pg8::StaticOrder S; S.init(MP, D, G, bx);
                pg8::EpiRes E{XB, ssp};
                pg8::gemm_phase_x<pg8::EpiRes, pg8::StaticOrder>(L, g, S, E);
            }
            SEAM(pb + 2);
        } else {
#define SSMT(gg) const SsmT T_{(const bf16*)(ws + WS_BT) + ((size_t)j * NG + (gg)) * 128 * 16, (const bf16*)(ws + WS_CT) + ((size_t)j * NG + (gg)) * 16 * 128, (const float*)(ws + WS_TAB) + ((size_t)j * NG + (gg)) * NS * 4, \
                          INP(19) + (size_t)j * D + (gg) * 16, INP(6) + (size_t)l * D + (gg) * 16}
            if (EN_S1 && IN(pb)) for (int rp = 0; rp < NREP(2); ++rp) {
                FRESH_IDS; FRESH_PTRS; LAS unsigned char* wl = L + wave * 10752; LAS float* rvs = (LAS float*)(L + 8 * 10752);
                for (int u = gw; u < NB * (NCH - 1) * NG; u += NGW) {
                    int lane = tid & 63; asm volatile("" : "+v"(lane));
                    const int g = u & 63, ch = (u >> 6) % (NCH - 1), b = (u >> 6) / (NCH - 1);
                    wg_rinv(rvs, ssp, b * SEQ + ch * CH, CH, 16, tid);
                    SSMT(g);
                    float st[4] = {0.f, 0.f, 0.f, 0.f};
                    ssm_mfma_unit<0>(wl, lane, g, T_, XB, rvs, b * SEQ + ch * CH, CH / 32, st, nullptr, nullptr, nullptr, nullptr, nullptr, 0);
                    if (lane < 32) { float* hs = HS + ((size_t)((b * NCH + ch) * NG + g) * NS) * 2; *(float2*)(hs + 2 * lane) = make_float2(st[0], st[1]); *(float2*)(hs + 2 * (32 + lane)) = make_float2(st[2], st[3]); }
                }
                __syncthreads();
            }
            SEAM(pb);
            if (EN_S3 && IN(pb + 1)) for (int rp = 0; rp < NREP(2); ++rp) {
                FRESH_IDS; FRESH_PTRS; LAS unsigned char* wl = L + wave * 10752; LAS float* rvs = (LAS float*)(L + 8 * 10752);
                for (int u = gw; u < NB * NCH * NG + (SB / 4) * NG; u += NGW) {
                    int lane = tid & 63; asm volatile("" : "+v"(lane));
                    if (u < NB * NCH * NG) {
                        const int g = u & 63, b = u >> 11, ch = b ? (NCH - 1 - ((u >> 6) & (NCH - 1))) : ((u >> 6) & (NCH - 1)), r32 = lane & 31;
                        wg_rinv(rvs, ssp, b * SEQ + ch * CH, CH, 16, tid);
                        SSMT(g);
                        float st[4] = {0.f, 0.f, 0.f, 0.f};
                        float aLr[2], aLi[2];
#pragma unroll
                        for (int p = 0; p < 2; ++p) {
                            const f32x4 tv = *(const f32x4*)(T_.tab + (size_t)(32 * p + r32) * 4);
                            float xr_ = tv[0], xi_ = tv[1];
#pragma unroll
                            for (int sq = 0; sq < 8; ++sq) { const float tr = xr_ * xr_ - xi_ * xi_, ti = 2.0f * xr_ * xi_; xr_ = tr; xi_ = ti; }
                            aLr[p] = xr_; aLi[p] = xi_;
                        }
                        for (int i0 = 0; i0 < ch; i0 += 8) {
                            float2 e[8][2];
#pragma unroll
                            for (int k = 0; k < 8; ++k)
#pragma unroll
                                for (int p = 0; p < 2; ++p) e[k][p] = (i0 + k < ch) ? *(const float2*)(HS + ((size_t)((b * NCH + i0 + k) * NG + g) * NS + 32 * p + r32) * 2) : make_float2(0.f, 0.f);
#pragma unroll
                            for (int k = 0; k < 8; ++k) if (i0 + k < ch) {
#pragma unroll
                                for (int p = 0; p < 2; ++p) { const float tr = aLr[p] * st[2 * p] - aLi[p] * st[2 * p + 1] + e[k][p].x, ti = aLr[p] * st[2 * p + 1] + aLi[p] * st[2 * p] + e[k][p].y; st[2 * p] = tr; st[2 * p + 1] = ti; }
                            }
                        }
                        ssm_mfma_unit<1>(wl, lane, g, T_, XB, rvs, b * SEQ + ch * CH, CH / 32, st, Ob, nullptr, nullptr, nullptr, nullptr, 0);
                        if (ch == NCH - 1 && lane < 32) { float* hr_o = out + O_HRP + ((size_t)(j * NB + b) * NG + g) * NS; float* hi_o = out + O_HIP + ((size_t)(j * NB + b) * NG + g) * NS;
                            hr_o[lane] = st[0]; hi_o[lane] = st[1]; hr_o[32 + lane] = st[2]; hi_o[32 + lane] = st[3]; }
                    } else {
                        const int us = u - NB * NCH * NG, g = us & 63, bb = us >> 6;
                        wg_rinv(rvs, ssp, MP + bb * 32, 32, 32, tid);
                        SSMT(g);
                        float st[4] = {0.f, 0.f, 0.f, 0.f};
                        ssm_mfma_unit<2>(wl, lane, g, T_, XB, rvs, MP + bb * 32, 1, st, Ob, INP(4) + (size_t)j * SB * NG * NS, INP(5) + (size_t)j * SB * NG * NS, out + O_HRS + (size_t)j * SB * NG * NS, out + O_HIS + (size_t)j * SB * NG * NS, bb * 4);
                    }
                }
                __syncthreads();
            }
            SEAM(pb + 1);
            if (EN_GLU && IN(pb + 2)) {
                FRESH_PTRS;
                pg8::GemmX g{Ob, (const bf16*)(ws + WS_WGLU) + (size_t)j * 2 * D * D, nullptr, D}; pg8::StaticOrder S; S.init(MP, 2 * D, G, bx);
                pg8::EpiGlu E{XB, ssp};
                pg8::gemm_phase_x<pg8::EpiGlu, pg8::StaticOrder>(L, g, S, E);
            }
            SEAM(pb + 2);
        }
        if (EN_UP && IN(pb + 3)) for (int rp = 0; rp < NREP(4); ++rp) {
            FRESH_PTRS;
            pg8::GemmX g{XB, (const bf16*)(ws + WS_WUP) + (size_t)l * FF * D, nullptr, D}; pg8::StaticOrder S; S.init(MP, FF, G, bx);
            pg8::EpiUp E{Hb, (bf16*)(ws + WS_H + 128 * MiB), ssp, (l & 1) ? 32 : 16, (l & 1) ? 64 : 32};
            if (threadIdx.x == 0) *(LAS int*)(L + pg8::RINV_TAB_OFF + 1152) = -1;
            __syncthreads();
            pg8::gemm_phase_x<pg8::EpiUp, pg8::StaticOrder, NREP(5), NREP(6), 0>(L, g, S, E);
        }
        SEAM(pb + 3);
        if (EN_DN && IN(pb + 4)) {
            FRESH_PTRS;
            pg8::GemmX g{Hb, (const bf16*)(ws + WS_WDN) + (size_t)l * D * FF, (const bf16*)(ws + WS_H + 128 * MiB), FF}; pg8::StaticOrder S; S.init(MP, D, G, bx);
            pg8::EpiRes E{XB, ssp};
            pg8::gemm_phase_x<pg8::EpiRes, pg8::StaticOrder, 1, 1, 0, true>(L, g, S, E);
        }
        SEAM(pb + 4);
    }
    if (EN_FIN && IN(21)) {
        FRESH_IDS; FRESH_PTRS;
        const float* gf = INP(8);
        for (int m = gw; m < M; m += NGW) {
            const float pv = (lane < ((m < MP) ? 16 : 32)) ? ssp[(size_t)m * 64 + lane] : 0.f;
            const float rinv = rsqrtf(wave_sum(pv) * (1.0f / 1024.0f) + 1e-6f);
            const bf16* xb = XB + (size_t)m * D + 4 * lane; float* yo = out + (size_t)m * D + 4 * lane;
#pragma unroll
            for (int jx = 0; jx < 4; ++jx) { const f32x4 gv = *(const f32x4*)(gf + 256 * jx + 4 * lane); const f32x4 v = pg8::unpack4(*(const u32x2*)(xb + 256 * jx)) * rinv * gv; *(f32x4*)(yo + 256 * jx) = v; }
        }
    }
#undef IN
#undef SEAM
}

#ifndef MK_SPLIT
#define MK_SPLIT 0
#endif
extern "C" void kernel_launch(void* const* d_in, const int* in_sizes, int n_in, void* d_out, int out_size, void* d_ws, size_t ws_size, hipStream_t stream) {
    static int grid = 0;
    if (grid == 0) {
        if (n_in != 23 || in_sizes[0] != MP * D || (size_t)out_size != O_END || ws_size < WS_END) { fprintf(stderr, "kernel_launch: unexpected shapes (n_in %d, in0 %d, out %d, ws %zu); nothing launched\n", n_in, n_in > 0 ? in_sizes[0] : -1, out_size, ws_size); grid = -1; return; }
        int dev = 0, cus = 0, per_cu = 0;
        if (hipGetDevice(&dev) != hipSuccess || hipDeviceGetAttribute(&cus, hipDeviceAttributeMultiprocessorCount, dev) != hipSuccess) { fprintf(stderr, "kernel_launch: device query failed\n"); grid = -1; return; }
        if (hipFuncSetAttribute((const void*)fwd_kernel, hipFuncAttributeMaxDynamicSharedMemorySize, LDS_BYTES) != hipSuccess) { fprintf(stderr, "kernel_launch: hipFuncSetAttribute failed\n"); grid = -1; return; }
        if (hipOccupancyMaxActiveBlocksPerMultiprocessor(&per_cu, (const void*)fwd_kernel, 512, LDS_BYTES) != hipSuccess || per_cu < 1) fprintf(stderr, "kernel_launch: note: occupancy query reports %d blocks per CU\n", per_cu);
        (void)hipGetLastError();
        grid = cus;
    }
    if (grid < 0) return;
    (void)hipMemsetAsync((char*)d_ws + WS_CTL, 0, CTL_ZERO_BYTES, stream);
    Args a{};
    for (int i = 0; i < 23; ++i) a.in[i] = (const float*)d_in[i];
    a.out = (float*)d_out; a.ws = (unsigned char*)d_ws;
#if MK_SPLIT
    for (int p = 0; p < NPHASE; ++p) { a.ph_lo = p; a.ph_hi = p + 1; hipLaunchKernelGGL(fwd_kernel, dim3(grid), dim3(512), LDS_BYTES, stream, a); }
#else
    a.ph_lo = 0; a.ph_hi = NPHASE; hipLaunchKernelGGL(fwd_kernel, dim3(grid), dim3(512), LDS_BYTES, stream, a);
#endif
}
```

```cpp
#include <hip/hip_runtime.h>
#include <cstdio>
#include <cstdint>
namespace pg8 {
#define PG8_LAS __attribute__((address_space(3)))
typedef unsigned short bf16_t;
typedef short bf16x8 __attribute__((ext_vector_type(8)));
typedef float f32x4 __attribute__((ext_vector_type(4)));
typedef unsigned u32x4 __attribute__((ext_vector_type(4)));
constexpr int BM = 256, BK = 64, HALF = 128, HTB = HALF * BK * 2  , STAGE_BYTES = 8 * HTB, NXCD = 8, WGM = 8;

__host__ __device__ __forceinline__ int lds_byte(int r, int c) { const int st = (r >> 4) * 2 + (c >> 5), rr = r & 15, cc = c & 31, ob = rr * 64 + cc * 2; return st * 1024 + (ob ^ (((ob >> 9) & 1) << 5)); }
__host__ __device__ __forceinline__ void stage_rc(int b, int& R, int& C) { const int st = b / 1024, sb = b % 1024, swz = sb ^ (((sb >> 9) & 1) << 5); R = (st >> 1) * 16 + swz / 64; C = (st & 1) * 32 + (swz % 64) / 2; }
__host__ __device__ __forceinline__ int perm32(int rho) { const int n = rho >> 4, i = rho & 15; return 8 * (i >> 2) + 4 * n + (i & 3); }

struct Unit { int pm, pn; };
struct Gemm { const bf16_t* A; const bf16_t* Bt; int M, N, K; };

struct StaticOrder {
    int nM, nN, nwg, G, c;
    __host__ __device__ void init(int M, int N, int G_, int c_) { nM = M / BM; nN = N / BM; nwg = nM * nN; G = G_; c = c_; }
    __host__ __device__ bool next(int i, Unit& u) const {
        const long L = (long)i * G + c; if (L >= nwg) return false;
        int wgid = (int)L; { const int q = nwg / NXCD, r = nwg % NXCD, xcd = wgid % NXCD, off = wgid / NXCD; wgid = (xcd < r ? xcd * (q + 1) : r * (q + 1) + (xcd - r) * q) + off; }
        const int nig = WGM * nN, gid = wgid / nig, fm = gid * WGM, gsz = (nM - fm) < WGM ? (nM - fm) : WGM;
        u.pm = fm + ((wgid % nig) % gsz); u.pn = (wgid % nig) / gsz; return true;
    }
    __device__ __forceinline__ void a_ready(const Unit&) const {}
    __device__ __forceinline__ void done(const Unit&) const {}
};
__device__ __forceinline__ unsigned cvt_pk_bf16(float lo, float hi) { unsigned r; asm volatile("v_cvt_pk_bf16_f32 %0, %1, %2" : "=v"(r) : "v"(lo), "v"(hi)); return r; }
typedef float f32x2 __attribute__((ext_vector_type(2)));
template <class Epi, class Sched, bool ALIGN_EPI = false, bool SP2 = false>
__device__ __forceinline__ void gemm_phase(PG8_LAS unsigned char* lds, const Gemm g, const Sched& S, const Epi& E) {
    int tid_ = threadIdx.x; asm volatile("" : "+v"(tid_));
    const int tid = tid_, wid = __builtin_amdgcn_readfirstlane(tid >> 6), lane = tid & 63, wr = wid >> 2, wc = wid & 3, fr = lane & 15, fq = lane >> 4;
    const int K = g.K, nt = K / BK;
    unsigned voffA[2], voffB[2];
#pragma unroll
    for (int i = 0; i < 2; ++i) { int R, C; stage_rc(tid * 16 + i * 8192, R, C); const int Rb = Epi::PERM ? ((R & ~31) + perm32(R & 31)) : R;
        voffA[i] = (unsigned)(R * K + C) * 2u; voffB[i] = (unsigned)(Rb * K + C) * 2u; }
    const size_t kstep = (size_t)(BK * 2);
    const size_t hstep = (size_t)HALF * K * 2;
    const size_t tstep = 2 * hstep;
    const unsigned ldsw = (unsigned)wid * 1024u;
    const int aoff = lds_byte(wr * 64 + fr, fq * 8), boff = lds_byte(wc * 32 + fr, fq * 8);
#define PG8_SA(b, h) (((b) * 2 + (h)) * HTB)
#define PG8_SB(b, h) ((4 + (b) * 2 + (h)) * HTB)
#define PG8_STAGE(bufoff, gbase, voff) do { _Pragma("unroll") for (int _i = 0; _i < 2; ++_i) \
        __builtin_amdgcn_global_load_lds((const unsigned*)((const char*)(gbase) + (voff)[_i]), (PG8_LAS unsigned*)(lds + (bufoff) + ldsw + _i * 8192), 16, 0, 0); } while (0)
#define PG8_LDA(dst, b, h) do { _Pragma("unroll") for (int m = 0; m < 4; ++m) _Pragma("unroll") for (int k = 0; k < 2; ++k) dst[m][k] = *(const PG8_LAS bf16x8*)(lds + PG8_SA(b, h) + aoff + m * 2048 + k * 1024); } while (0)
#define PG8_LDB(dst, b, h) do { _Pragma("unroll") for (int n = 0; n < 2; ++n) _Pragma("unroll") for (int k = 0; k < 2; ++k) dst[n][k] = *(const PG8_LAS bf16x8*)(lds + PG8_SB(b, h) + boff + n * 2048 + k * 1024); } while (0)
#define PG8_MMA(ai, bj, At, Bt) do { __builtin_amdgcn_s_setprio(1); _Pragma("unroll") for (int m = 0; m < 4; ++m) _Pragma("unroll") for (int n = 0; n < 2; ++n) _Pragma("unroll") for (int k = 0; k < 2; ++k) \
        acc[ai][bj][m][n] = __builtin_amdgcn_mfma_f32_16x16x32_bf16(Bt[n][k], At[m][k], acc[ai][bj][m][n], 0, 0, 0); __builtin_amdgcn_s_setprio(0); } while (0)
#define PG8_WAIT_V(n) asm volatile("s_waitcnt vmcnt(" #n ")" ::: "memory")
#define PG8_WAIT_L(n) asm volatile("s_waitcnt lgkmcnt(" #n ")" ::: "memory")
#define PG8_BAR __builtin_amdgcn_s_barrier()
#define PG8_SCHED __builtin_amdgcn_sched_barrier(0)
    Unit cur, nxt; int ui = 0;
    if (!S.next(0, cur)) return;
    f32x4 acc[2][2][4][2];
#pragma unroll
    for (int a = 0; a < 2; ++a)
#pragma unroll
        for (int b = 0; b < 2; ++b)
#pragma unroll
            for (int m = 0; m < 4; ++m)
#pragma unroll
                for (int n = 0; n < 2; ++n) acc[a][b][m][n] = (f32x4){0.f, 0.f, 0.f, 0.f};
    bf16x8 At[4][2], B0[2][2], B1[2][2];
    const char* cA = (const char*)g.A + (size_t)cur.pm * tstep; const char* cB = (const char*)g.Bt + (size_t)cur.pn * tstep;
    S.a_ready(cur);
    if constexpr (SP2) {
        PG8_STAGE(PG8_SB(0, 0), cB, voffB); PG8_STAGE(PG8_SB(0, 1), cB + hstep, voffB); PG8_STAGE(PG8_SA(0, 0), cA, voffA); PG8_STAGE(PG8_SA(0, 1), cA + hstep, voffA);
        if (wr == 1) PG8_BAR;
        PG8_WAIT_V(2); PG8_BAR;
        PG8_STAGE(PG8_SB(1, 0), cB + kstep, voffB); PG8_STAGE(PG8_SA(1, 0), cA + kstep, voffA); PG8_STAGE(PG8_SB(1, 1), cB + hstep + kstep, voffB);
        PG8_WAIT_V(6); PG8_BAR;
    } else {
        PG8_STAGE(PG8_SB(0, 0), cB, voffB); PG8_STAGE(PG8_SA(0, 0), cA, voffA); PG8_STAGE(PG8_SB(0, 1), cB + hstep, voffB); PG8_STAGE(PG8_SA(0, 1), cA + hstep, voffA);
        if (wr == 1) PG8_BAR;
        PG8_WAIT_V(4); PG8_BAR;
        PG8_STAGE(PG8_SB(1, 0), cB + kstep, voffB); PG8_STAGE(PG8_SA(1, 0), cA + kstep, voffA); PG8_STAGE(PG8_SB(1, 1), cB + hstep + kstep, voffB);
        PG8_WAIT_V(6); PG8_BAR;
    }
    for (;;) {
        const bool has_next = S.next(ui + 1, nxt);
        const char* nA = has_next ? (const char*)g.A + (size_t)nxt.pm * tstep : cA; const char* nB = has_next ? (const char*)g.Bt + (size_t)nxt.pn * tstep : cB;
        for (int t = 0; t < nt; t += 2) {
            const bool last = (t == nt - 2);
            const char* a1 = cA + (size_t)(t + 1) * kstep;
            const char* a2 = last ? nA : cA + (size_t)(t + 2) * kstep; const char* b2 = last ? nB : cB + (size_t)(t + 2) * kstep;
            const char* a3 = a2 + kstep; const char* b3 = b2 + kstep;
            if (last && has_next) S.a_ready(nxt);
            if constexpr (SP2) {
            PG8_LDB(B0, 0, 0); PG8_LDB(B1, 0, 1); PG8_SCHED; PG8_LDA(At, 0, 0); PG8_STAGE(PG8_SA(1, 1), a1 + hstep, voffA);
            PG8_WAIT_V(8); PG8_WAIT_L(0); PG8_BAR; PG8_MMA(0, 0, At, B0); PG8_MMA(0, 1, At, B1); PG8_BAR; PG8_SCHED;
            PG8_LDA(At, 0, 1); PG8_STAGE(PG8_SB(0, 0), b2, voffB); PG8_STAGE(PG8_SB(0, 1), b2 + hstep, voffB); PG8_STAGE(PG8_SA(0, 0), a2, voffA);
            PG8_WAIT_V(8); PG8_WAIT_L(0); PG8_BAR; PG8_MMA(1, 0, At, B0); PG8_MMA(1, 1, At, B1); PG8_BAR; PG8_SCHED;
            PG8_LDB(B0, 1, 0); PG8_LDB(B1, 1, 1); PG8_SCHED; PG8_LDA(At, 1, 0); PG8_STAGE(PG8_SA(0, 1), a2 + hstep, voffA);
            PG8_WAIT_V(8); PG8_WAIT_L(0); PG8_BAR; PG8_MMA(0, 0, At, B0); PG8_MMA(0, 1, At, B1); PG8_BAR; PG8_SCHED;
            PG8_LDA(At, 1, 1); PG8_STAGE(PG8_SB(1, 0), b3, voffB); PG8_STAGE(PG8_SB(1, 1), b3 + hstep, voffB); PG8_STAGE(PG8_SA(1, 0), a3, voffA);
            PG8_WAIT_V(8); PG8_WAIT_L(0); PG8_BAR; PG8_MMA(1, 0, At, B0); PG8_MMA(1, 1, At, B1); PG8_BAR; PG8_SCHED;
            } else {
            PG8_LDB(B0, 0, 0); PG8_SCHED; PG8_LDA(At, 0, 0); PG8_STAGE(PG8_SA(1, 1), a1 + hstep, voffA);
            PG8_WAIT_L(8); PG8_BAR; PG8_WAIT_L(0); PG8_MMA(0, 0, At, B0); PG8_BAR; PG8_SCHED;
            PG8_LDB(B1, 0, 1); PG8_STAGE(PG8_SB(0, 0), b2, voffB);
            PG8_BAR; PG8_WAIT_L(0); PG8_MMA(0, 1, At, B1); PG8_BAR;
            PG8_LDA(At, 0, 1); PG8_STAGE(PG8_SA(0, 0), a2, voffA);
            PG8_BAR; PG8_WAIT_L(0); PG8_MMA(1, 0, At, B0); PG8_BAR; PG8_SCHED;
            PG8_STAGE(PG8_SB(0, 1), b2 + hstep, voffB);
            PG8_WAIT_V(6); PG8_BAR; PG8_MMA(1, 1, At, B1); PG8_BAR;
            PG8_LDB(B0, 1, 0); PG8_SCHED; PG8_LDA(At, 1, 0); PG8_STAGE(PG8_SA(0, 1), a2 + hstep, voffA);
            PG8_WAIT_L(8); PG8_BAR; PG8_WAIT_L(0); PG8_MMA(0, 0, At, B0); PG8_BAR; PG8_SCHED;
            PG8_LDB(B1, 1, 1); PG8_STAGE(PG8_SB(1, 0), b3, voffB);
            PG8_BAR; PG8_WAIT_L(0); PG8_MMA(0, 1, At, B1); PG8_BAR;
            PG8_LDA(At, 1, 1); PG8_STAGE(PG8_SA(1, 0), a3, voffA);
            PG8_BAR; PG8_WAIT_L(0); PG8_MMA(1, 0, At, B0); PG8_BAR; PG8_SCHED;
            PG8_STAGE(PG8_SB(1, 1), b3 + hstep, voffB);
            PG8_WAIT_V(6); PG8_BAR; PG8_MMA(1, 1, At, B1); PG8_BAR;
            }
        }
        if constexpr (ALIGN_EPI) { if (wr == 0) PG8_BAR; }
        if constexpr (!Epi::AFTER_DRAIN) { E(acc, cur, wr, wc, fr, fq); S.done(cur); }
        if (!has_next) break;
#pragma unroll
        for (int a = 0; a < 2; ++a)
#pragma unroll
            for (int b = 0; b < 2; ++b)
#pragma unroll
                for (int m = 0; m < 4; ++m)
#pragma unroll
                    for (int n = 0; n < 2; ++n) acc[a][b][m][n] = (f32x4){0.f, 0.f, 0.f, 0.f};
        cur = nxt; cA = nA; cB = nB; ++ui;
        if constexpr (ALIGN_EPI) { if (wr == 1) PG8_BAR; }
    }
    PG8_WAIT_V(0);
    if constexpr (!ALIGN_EPI) { if (wr == 0) PG8_BAR; }
    PG8_BAR;
    if constexpr (Epi::AFTER_DRAIN) { E.fused(acc, cur, wr, wc, fr, fq, lds, wid, lane); S.done(cur); }
#undef PG8_SA
#undef PG8_SB
#undef PG8_STAGE
#undef PG8_LDA
#undef PG8_LDB
#undef PG8_MMA
#undef PG8_WAIT_V
#undef PG8_WAIT_L
#undef PG8_BAR
#undef PG8_SCHED
}
}
#define GAS __attribute__((address_space(1)))
#define LAS __attribute__((address_space(3)))
typedef unsigned short bf16;
typedef unsigned v4u __attribute__((ext_vector_type(4)));
typedef float f32x4 __attribute__((ext_vector_type(4)));
typedef short bf16x8 __attribute__((ext_vector_type(8)));
typedef GAS unsigned gu32;
typedef GAS unsigned long long gu64;
#define RLX_AGENT __ATOMIC_RELAXED, __HIP_MEMORY_SCOPE_AGENT
#define LDS_WAIT() asm volatile("s_waitcnt lgkmcnt(0)" ::: "memory")
#define VM_WAIT() asm volatile("s_waitcnt vmcnt(0)" ::: "memory")
__device__ __forceinline__ unsigned long long rt() { return __builtin_amdgcn_s_memrealtime(); }
__device__ __forceinline__ unsigned f2bf(float f) { unsigned u = __builtin_bit_cast(unsigned, f); return (u + 0x7fffu + ((u >> 16) & 1u)) >> 16; }
__device__ __forceinline__ unsigned pk2(float lo, float hi) { return f2bf(lo) | (f2bf(hi) << 16); }
#define XB_TMO      128
#define XB_XCNT(j)  (256  + 64 * (j))
#define XB_XSUB(j)  (1280 + 64 * (j))
#define XB_XGEN(j)  (2304 + 64 * (j))
#define XB_TOP      3328
#define XB_TOPGEN   3392
#define XCD_BAR_WORDS 3456
#define XB_SPIN_CAP (1u << 18)

__device__ __forceinline__ unsigned xb_ld(unsigned* p)              { return __hip_atomic_load(p, __ATOMIC_RELAXED, __HIP_MEMORY_SCOPE_AGENT); }
__device__ __forceinline__ unsigned xb_add(unsigned* p, unsigned v) { return __hip_atomic_fetch_add(p, v, __ATOMIC_RELAXED, __HIP_MEMORY_SCOPE_AGENT); }
__device__ __forceinline__ unsigned xb_xcc_id() { return (unsigned)__builtin_amdgcn_s_getreg((3 << 11) | 20) & 0xFu; }
#define XB_SPIN(cond, bar) do { unsigned _sp = 0; while (cond) { __builtin_amdgcn_s_sleep(1); \
    if ((++_sp & 255u) == 0u) { if (xb_ld(&(bar)[XB_TMO])) break; if (_sp > XB_SPIN_CAP) { atomicAdd(&(bar)[XB_TMO], 1u); break; } } } } while (0)

struct XcdBarrier {
    unsigned* bar; unsigned x;
    volatile LAS unsigned* st;
};

__device__ __forceinline__ XcdBarrier xcd_barrier_post(unsigned* bar, volatile LAS unsigned* st) {
    XcdBarrier b; b.bar = bar; b.x = xb_xcc_id(); b.st = st;
    if (threadIdx.x == 0) (void)xb_add(&bar[XB_XCNT(b.x)], 1u);
    return b;
}
__device__ __forceinline__ void xcd_barrier_complete(unsigned* bar, unsigned x, unsigned& nloc, unsigned& nx) {
    const unsigned G = gridDim.x * gridDim.y * gridDim.z;
    unsigned sum, cnt, mine, sp = 0u;
    for (;;) {
        sum = 0u; cnt = 0u; mine = 0u;
#pragma unroll
        for (unsigned j = 0; j < 16; ++j) { const unsigned c = xb_ld(&bar[XB_XCNT(j)]); sum += c; cnt += (c > 0u) ? 1u : 0u; mine = (j == x) ? c : mine; }
        if (sum == G) break;
        __builtin_amdgcn_s_sleep(1);
        if ((++sp & 255u) == 0u) { if (xb_ld(&bar[XB_TMO])) break; if (sp > XB_SPIN_CAP) { atomicAdd(&bar[XB_TMO], 1u); break; } }
    }
    nloc = mine > 0u ? mine : 1u; nx = cnt > 0u ? cnt : 1u;
}

__device__ __forceinline__ void xcd_barrier(const XcdBarrier& b) {
    asm volatile("s_waitcnt vmcnt(0)" ::: "memory");
    __syncthreads();
    if (threadIdx.x == 0) {
        unsigned* bar = b.bar;
        __builtin_amdgcn_s_waitcnt(0);
        unsigned nloc = b.st[0], nx = b.st[1];
        if (nloc == 0u) { xcd_barrier_complete(bar, b.x, nloc, nx); b.st[0] = nloc; b.st[1] = nx; }
        const unsigned old = xb_add(&bar[XB_XSUB(b.x)], 1u);
        const unsigned gen = old / nloc;
        if (old + 1u == (gen + 1u) * nloc) {
            __builtin_amdgcn_fence(__ATOMIC_RELEASE, "agent");
            asm volatile("s_waitcnt vmcnt(0)" ::: "memory");
            const unsigned og = xb_add(&bar[XB_TOP], 1u);
            const unsigned tg = og / nx;
            if (og + 1u == (tg + 1u) * nx) xb_add(&bar[XB_TOPGEN], 1u);
            else XB_SPIN(xb_ld(&bar[XB_TOPGEN]) == tg, bar);
            __builtin_amdgcn_fence(__ATOMIC_ACQUIRE, "agent");
            xb_add(&bar[XB_XGEN(b.x)], 1u);
            asm volatile("s_waitcnt vmcnt(0)" ::: "memory");
        } else {
            XB_SPIN(xb_ld(&bar[XB_XGEN(b.x)]) == gen, bar);
            __builtin_amdgcn_fence(__ATOMIC_ACQUIRE, "agent");
            asm volatile("s_waitcnt vmcnt(0)" ::: "memory");
        }
    }
    __syncthreads();
}

constexpr int D = 1024, SEQ = 8192, NB = 2, MP = NB * SEQ, SB = 128, ST = 8, MS = SB * ST, M = MP + MS;
constexpr int NQKV = 1536, FF = 4096, NKV = 4, HD = 64, KVW = NKV * HD, NG = 64, GC = 16, NS = 64;
constexpr int CH = 256, NCH = SEQ / CH;
constexpr int NPHASE = 22;
constexpr size_t O_KP = 17825792, O_VP = 17956864, O_HRP = 18087936, O_HIP = 18104320, O_KS = 18120704, O_VS = 26509312, O_HRS = 34897920, O_HIS = 35946496, O_END = 36995072;
constexpr size_t MiB = 1u << 20;
constexpr size_t WS_CTL = 0, CTL_ZERO_BYTES = 64 * 1024;
constexpr size_t WS_SSP = 1 * MiB;
constexpr size_t WS_TAB = 5 * MiB + 512 * 1024;
constexpr size_t WS_HS = 6 * MiB;
constexpr size_t WS_WQKV = 8 * MiB, WS_WO = 14 * MiB, WS_WGLU = 18 * MiB, WS_WUP = 26 * MiB, WS_WDN = 58 * MiB;
constexpr size_t WS_XB = 90 * MiB;
constexpr size_t WS_H = 124 * MiB;
constexpr size_t WS_Q = 124 * MiB, WS_K = 158 * MiB, WS_V = 167 * MiB, WS_O = 176 * MiB;
constexpr size_t WS_BT = 260 * MiB, WS_CT = 261 * MiB;
constexpr size_t WS_END = 262 * MiB;
constexpr int CW_BAR = 4096;
static_assert((CW_BAR + XCD_BAR_WORDS) * 4 <= (int)CTL_ZERO_BYTES, "barrier words inside the memset region");
constexpr int RING_BYTES = 131072, XA_BYTES = 4096, LDSCTL_OFF = RING_BYTES + XA_BYTES  , MISC_OFF = LDSCTL_OFF + 320, LDS_BYTES = 147456;

__device__ __forceinline__ float wave_sum(float v) {
#pragma unroll
    for (int o = 1; o < 64; o <<= 1) v += __shfl_xor(v, o);
    return v;
}
__device__ __forceinline__ float wave_max(float v) {
#pragma unroll
    for (int o = 1; o < 64; o <<= 1) v = fmaxf(v, __shfl_xor(v, o));
    return v;
}
__device__ __forceinline__ float bf_lo(unsigned u) { return __uint_as_float(u << 16); }
__device__ __forceinline__ float bf_hi(unsigned u) { return __uint_as_float(u & 0xffff0000u); }

namespace pg8 {
constexpr int XMP = 16384;
template <int NL>
__device__ __forceinline__ float row_rinv(const float* ssp, int row, int np, int fq) {
    const float* p = ssp + (size_t)row * 64 + (np >> 2) * fq;
    f32x4 v[NL];
#pragma unroll
    for (int i = 0; i < NL; ++i) v[i] = *(const f32x4*)(p + 4 * i);
    float s = 0.f, s2 = 0.f;
#pragma unroll
    for (int i = 0; i < NL / 2; ++i) { s += (v[i][0] + v[i][1]) + (v[i][2] + v[i][3]); s2 += (v[NL / 2 + i][0] + v[NL / 2 + i][1]) + (v[NL / 2 + i][2] + v[NL / 2 + i][3]); }
    s += (np == 16 * NL) ? s2 : 0.f;
    s += __shfl_xor(s, 16); s += __shfl_xor(s, 32);
    return rsqrtf(s * (1.0f / 1024.0f) + 1e-6f);
}
constexpr int RINV_TAB_OFF = 135680;
__device__ __forceinline__ void unit_rinv_to_lds(PG8_LAS unsigned char* lds, const float* ssp, int pm, int np, int nps) {
    int t = threadIdx.x; asm volatile("" : "+v"(t));
    PG8_LAS float* tab = (PG8_LAS float*)(lds + RINV_TAB_OFF);
    if (t < 288) {
        const bool smp = t >= 256; const int hf = smp ? ((t - 256) >> 4) : 0;
        const int row = smp ? XMP + pm * 16 + (t & 15) : pm * BM + t; const int n = (smp ? nps : np) - 32 * hf;
        const float* p = ssp + (size_t)row * 64 + 32 * hf;
        f32x4 v[8];
#pragma unroll
        for (int i = 0; i < 8; ++i) v[i] = *(const f32x4*)(p + 4 * i);
        float s = 0.f;
#pragma unroll
        for (int i = 0; i < 8; ++i) { const float si = (v[i][0] + v[i][1]) + (v[i][2] + v[i][3]); s += (4 * i < n) ? si : 0.f; }
        if (smp) s += __shfl_xor(s, 16);
        if (t < 272) tab[t] = rsqrtf(s * (1.0f / 1024.0f) + 1e-6f);
    }
    asm volatile("s_waitcnt lgkmcnt(0)" ::: "memory"); __builtin_amdgcn_s_barrier(); asm volatile("" ::: "memory");
}
__device__ __forceinline__ u32x4 pack8(const f32x4 a, const f32x4 b) { u32x4 w; w.x = cvt_pk_bf16(a[0], a[1]); w.y = cvt_pk_bf16(a[2], a[3]); w.z = cvt_pk_bf16(b[0], b[1]); w.w = cvt_pk_bf16(b[2], b[3]); return w; }
typedef unsigned u32x2 __attribute__((ext_vector_type(2)));
__device__ __forceinline__ u32x2 pack4(const f32x4 a) { u32x2 w; w.x = cvt_pk_bf16(a[0], a[1]); w.y = cvt_pk_bf16(a[2], a[3]); return w; }
__device__ __forceinline__ float sumsq4(const f32x4 v) { return (v[0] * v[0] + v[1] * v[1]) + (v[2] * v[2] + v[3] * v[3]); }

struct EpiQKV {
    static constexpr bool PERM = true, AFTER_DRAIN = false;
    bf16_t *Q, *K, *V; const float* ssp; int np, nps; float *kp, *vp, *ks, *vs;
    __device__ __forceinline__ void operator()(const f32x4 (&acc)[2][2][4][2], const f32x4 (&accx)[2], const Unit& u, int wr, int wc, int fr, int fq, PG8_LAS unsigned char* lds) const {
        const int rowb = u.pm * BM + wr * 64 + fr, pn = u.pn;
        { PG8_LAS int* lastpm = (PG8_LAS int*)(lds + RINV_TAB_OFF + 1088 + 64);
          if (*lastpm != u.pm) { unit_rinv_to_lds(lds, ssp, u.pm, np, nps); if (threadIdx.x == 0) *lastpm = u.pm; } }
        float rr[2][4];
        { const PG8_LAS float* tab = (const PG8_LAS float*)(lds + RINV_TAB_OFF);
#pragma unroll
          for (int ai = 0; ai < 2; ++ai)
#pragma unroll
              for (int m = 0; m < 4; ++m) rr[ai][m] = tab[ai * HALF + wr * 64 + m * 16 + fr]; }
        const float rx = ((const PG8_LAS float*)(lds + RINV_TAB_OFF))[256 + fr];
#pragma unroll
        for (int ai = 0; ai < 2; ++ai)
#pragma unroll
            for (int m = 0; m < 4; ++m) {
                const int row = rowb + ai * HALF + m * 16;
                const float r = rr[ai][m];
#pragma unroll
                for (int bj = 0; bj < 2; ++bj) {
                    const f32x4 v0 = acc[ai][bj][m][0] * r, v1 = acc[ai][bj][m][1] * r;
                    const int cl = bj * HALF + wc * 32 + 8 * fq;
                    const u32x4 w = pack8(v0, v1);
                    if (pn < 4) { *(u32x4*)(Q + (size_t)row * 1024 + pn * 256 + cl) = w; }
                    else {
                        bf16_t* B = (pn == 4) ? K : V;
                        *(u32x4*)(B + (size_t)row * 256 + cl) = w;
                        const int t = row & 8191;
                        if (t >= 8064) { float* o = ((pn == 4) ? kp : vp) + ((size_t)(row >> 13) * 128 + (t - 8064)) * 256 + cl; *(f32x4*)o = v0; *(f32x4*)(o + 4) = v1; }
                    }
                }
            }
        {
            const int xrow = u.pm * 16 + fr, row = XMP + xrow;
            const float r = rx;
#pragma unroll
            for (int bj = 0; bj < 2; ++bj) {
                const f32x4 v = accx[bj] * r;
                const int cl = bj * HALF + wc * 32 + 8 * fq + 4 * wr;
                const u32x2 w = pack4(v);
                if (pn < 4) { *(u32x2*)(Q + (size_t)row * 1024 + pn * 256 + cl) = w; }
                else {
                    bf16_t* B = (pn == 4) ? K : V;
                    *(u32x2*)(B + (size_t)row * 256 + cl) = w;
                    float* o = ((pn == 4) ? ks : vs) + ((size_t)(xrow >> 3) * 128 + 120 + (xrow & 7)) * 256 + cl; *(f32x4*)o = v;
                }
            }
        }
    }
};
__device__ __forceinline__ void unpack8(const u32x4 w, f32x4& a, f32x4& b) {
    a[0] = __uint_as_float(w.x << 16); a[1] = __uint_as_float(w.x & 0xffff0000u); a[2] = __uint_as_float(w.y << 16); a[3] = __uint_as_float(w.y & 0xffff0000u);
    b[0] = __uint_as_float(w.z << 16); b[1] = __uint_as_float(w.z & 0xffff0000u); b[2] = __uint_as_float(w.w << 16); b[3] = __uint_as_float(w.w & 0xffff0000u); }
__device__ __forceinline__ f32x4 unpack4(const u32x2 w) { f32x4 a; a[0] = __uint_as_float(w.x << 16); a[1] = __uint_as_float(w.x & 0xffff0000u); a[2] = __uint_as_float(w.y << 16); a[3] = __uint_as_float(w.y & 0xffff0000u); return a; }
struct EpiRes {
    static constexpr bool PERM = true, AFTER_DRAIN = false;
    bf16_t* XB; float* ssp;
    __device__ __forceinline__ void operator()(const f32x4 (&acc)[2][2][4][2], const f32x4 (&accx)[2], const Unit& u, int wr, int wc, int fr, int fq, PG8_LAS unsigned char* lds) const {
        const int rowb = u.pm * BM + wr * 64 + fr, pn = u.pn;
        const int colb = pn * 256 + wc * 32 + 8 * fq;
        const int xrow = u.pm * 16 + fr;
        bf16_t* xbx = XB + (size_t)(XMP + xrow) * 1024 + colb + 4 * wr;
        u32x2 ox[2];
#pragma unroll
        for (int bj = 0; bj < 2; ++bj) ox[bj] = *(const u32x2*)(xbx + bj * HALF);
#pragma unroll
        for (int am = 0; am < 8; am += 4) {
            u32x4 o[4][2];
#pragma unroll
            for (int h = 0; h < 4; ++h)
#pragma unroll
                for (int bj = 0; bj < 2; ++bj) o[h][bj] = *(const u32x4*)(XB + (size_t)(rowb + ((am + h) >> 2) * HALF + ((am + h) & 3) * 16) * 1024 + colb + bj * HALF);
#pragma unroll
            for (int h = 0; h < 4; ++h) {
                const int ai = (am + h) >> 2, m = (am + h) & 3;
                const int row = rowb + ai * HALF + m * 16;
                float ss = 0.f;
#pragma unroll
                for (int bj = 0; bj < 2; ++bj) {
                    f32x4 o0, o1; unpack8(o[h][bj], o0, o1);
                    const f32x4 v0 = acc[ai][bj][m][0] + o0, v1 = acc[ai][bj][m][1] + o1;
                    *(u32x4*)(XB + (size_t)row * 1024 + colb + bj * HALF) = pack8(v0, v1);
                    ss += sumsq4(v0) + sumsq4(v1);
                }
                ss += __shfl_xor(ss, 16); ss += __shfl_xor(ss, 32);
                if (fq == 0) ssp[(size_t)row * 64 + pn * 4 + wc] = ss;
            }
            asm volatile("" ::: "memory");
        }
        {
            const int row = XMP + xrow;
            float ss = 0.f;
#pragma unroll
            for (int bj = 0; bj < 2; ++bj) {
                const f32x4 v = accx[bj] + unpack4(ox[bj]);
                *(u32x2*)(xbx + bj * HALF) = pack4(v);
                ss += sumsq4(v);
            }
            ss += __shfl_xor(ss, 16); ss += __shfl_xor(ss, 32);
            if (fq == 0) ssp[(size_t)row * 64 + (pn * 4 + wc) * 2 + wr] = ss;
        }
    }
};
struct EpiGlu {
    static constexpr bool PERM = true, AFTER_DRAIN = false;
    bf16_t* XB; float* ssp;
    __device__ __forceinline__ void operator()(const f32x4 (&acc)[2][2][4][2], const f32x4 (&accx)[2], const Unit& u, int wr, int wc, int fr, int fq, PG8_LAS unsigned char* lds) const {
        const int rowb = u.pm * BM + wr * 64 + fr, pn = u.pn;
        const int col = pn * 128 + wc * 32 + 8 * fq;
        const int xrow = u.pm * 16 + fr;
        bf16_t* xbx = XB + (size_t)(XMP + xrow) * 1024 + col + 4 * wr;
        const u32x2 ox = *(const u32x2*)xbx;
#pragma unroll
        for (int am = 0; am < 8; am += 4) {
            u32x4 o[4];
#pragma unroll
            for (int h = 0; h < 4; ++h) o[h] = *(const u32x4*)(XB + (size_t)(rowb + ((am + h) >> 2) * HALF + ((am + h) & 3) * 16) * 1024 + col);
#pragma unroll
            for (int h = 0; h < 4; ++h) {
                const int ai = (am + h) >> 2, m = (am + h) & 3;
                const int row = rowb + ai * HALF + m * 16;
                f32x4 v0, v1; unpack8(o[h], v0, v1);
#pragma unroll
                for (int e = 0; e < 4; ++e) {
                    v0[e] += acc[ai][0][m][0][e] * __builtin_amdgcn_rcpf(1.0f + __expf(-acc[ai][1][m][0][e]));
                    v1[e] += acc[ai][0][m][1][e] * __builtin_amdgcn_rcpf(1.0f + __expf(-acc[ai][1][m][1][e]));
                }
                *(u32x4*)(XB + (size_t)row * 1024 + col) = pack8(v0, v1);
                float ss = sumsq4(v0) + sumsq4(v1);
                ss += __shfl_xor(ss, 16); ss += __shfl_xor(ss, 32);
                if (fq == 0) ssp[(size_t)row * 64 + pn * 4 + wc] = ss;
            }
            asm volatile("" ::: "memory");
        }
        {
            const int row = XMP + xrow;
            f32x4 v = unpack4(ox);
#pragma unroll
            for (int e = 0; e < 4; ++e) v[e] += accx[0][e] * __builtin_amdgcn_rcpf(1.0f + __expf(-accx[1][e]));
            *(u32x2*)xbx = pack4(v);
            float ss = sumsq4(v);
            ss += __shfl_xor(ss, 16); ss += __shfl_xor(ss, 32);
            if (fq == 0) ssp[(size_t)row * 64 + (pn * 4 + wc) * 2 + wr] = ss;
        }
    }
};
struct EpiUp {
    static constexpr bool PERM = true, AFTER_DRAIN = false;
    bf16_t* H; bf16_t* Hx; const float* ssp; int np, nps;
    __device__ __forceinline__ void operator()(const f32x4 (&acc)[2][2][4][2], const f32x4 (&accx)[2], const Unit& u, int wr, int wc, int fr, int fq, PG8_LAS unsigned char* lds) const {
        const int rowb = u.pm * BM + wr * 64 + fr, pn = u.pn;
        { PG8_LAS int* lastpm = (PG8_LAS int*)(lds + RINV_TAB_OFF + 1088 + 64);
          if (*lastpm != u.pm) { unit_rinv_to_lds(lds, ssp, u.pm, np, nps); if (threadIdx.x == 0) *lastpm = u.pm; } }
        float rr[2][4];
        { const PG8_LAS float* tab = (const PG8_LAS float*)(lds + RINV_TAB_OFF);
#pragma unroll
          for (int ai = 0; ai < 2; ++ai)
#pragma unroll
              for (int m = 0; m < 4; ++m) rr[ai][m] = tab[ai * HALF + wr * 64 + m * 16 + fr]; }
        const float rx = ((const PG8_LAS float*)(lds + RINV_TAB_OFF))[256 + fr];
#pragma unroll
        for (int ai = 0; ai < 2; ++ai)
#pragma unroll
            for (int m = 0; m < 4; ++m) {
                const int row = rowb + ai * HALF + m * 16;
                const float r = rr[ai][m];
#pragma unroll
                for (int bj = 0; bj < 2; ++bj) {
                    f32x4 v0 = acc[ai][bj][m][0] * r, v1 = acc[ai][bj][m][1] * r;
#pragma unroll
                    for (int e = 0; e < 4; ++e) { const float a = fmaxf(v0[e], 0.f), b = fmaxf(v1[e], 0.f); v0[e] = a * a; v1[e] = b * b; }
                    __builtin_nontemporal_store(pack8(v0, v1), (u32x4*)((char*)H + (((size_t)u.pm * 64 + (4 * pn + 2 * bj + (wc >> 1))) * 2 + ai) * 16384 + lds_byte(wr * 64 + m * 16 + fr, 32 * (wc & 1) + 8 * fq)));
                }
            }
        {
            const int xrow = u.pm * 16 + fr, row = XMP + xrow;
            const float r = rx;
#pragma unroll
            for (int bj = 0; bj < 2; ++bj) {
                f32x4 v = accx[bj] * r;
#pragma unroll
                for (int e = 0; e < 4; ++e) { const float a = fmaxf(v[e], 0.f); v[e] = a * a; }
                *(u32x2*)((char*)Hx + ((size_t)u.pm * 64 + (4 * pn + 2 * bj + (wc >> 1))) * 2048 + lds_byte(fr, 32 * (wc & 1) + 8 * fq) + 8 * wr) = pack4(v);
            }
        }
    }
};

struct GemmX { const bf16_t* A; const bf16_t* Bt; const bf16_t* Ax; int K; };
template <class Epi, class Sched, int KREP = 1, int EREP = 1, int SKEW_TICKS = 0, bool ATILED = false>
__device__ __forceinline__ void gemm_phase_x(PG8_LAS unsigned char* lds, const GemmX g, const Sched& S, const Epi& E) {
    int tid_ = threadIdx.x; asm volatile("" : "+v"(tid_));
    const int tid = tid_, wid = __builtin_amdgcn_readfirstlane(tid >> 6), lane = tid & 63, wr = wid >> 2, wc = wid & 3, fr = lane & 15, fq = lane >> 4;
    const int K = g.K, nt = K / BK;
    unsigned voffA[2], voffB[2], voffX;
#pragma unroll
    for (int i = 0; i < 2; ++i) { int R, C; stage_rc(tid * 16 + i * 8192, R, C); const int Rb = Epi::PERM ? ((R & ~31) + perm32(R & 31)) : R;
        voffA[i] = ATILED ? (unsigned)(tid * 16 + i * 8192) : (unsigned)(R * K + C) * 2u; voffB[i] = (unsigned)(Rb * K + C) * 2u; }
    { int R, C; const int p = wid * 256 + lane * 4; stage_rc(p & ~15, R, C); voffX = ATILED ? (unsigned)p : (unsigned)(R * K + C) * 2u + (unsigned)(p & 15); }
    const size_t kstepB = (size_t)(BK * 2), hstepB = (size_t)HALF * K * 2, tstepB = 2 * hstepB;
    const size_t kstepA = ATILED ? (size_t)32768 : kstepB, hstepA = ATILED ? (size_t)16384 : hstepB, tstepA = ATILED ? (size_t)nt * 32768 : tstepB;
    const size_t kstepX = ATILED ? (size_t)2048 : kstepB, xstep = ATILED ? (size_t)nt * 2048 : (size_t)16 * K * 2;
    const unsigned ldsw = (unsigned)wid * 1024u, ldsx = (unsigned)wid * 256u;
    const int aoff = lds_byte(wr * 64 + fr, fq * 8), boff = lds_byte(wc * 32 + fr, fq * 8), xoff = lds_byte(fr, fq * 8);
#define PG8_SA(b, h) (((b) * 2 + (h)) * HTB)
#define PG8_SB(b, h) ((4 + (b) * 2 + (h)) * HTB)
#define PG8_XA(b) (STAGE_BYTES + (b) * 2048)
#define PG8_STAGE(bufoff, gbase, voff) do { _Pragma("unroll") for (int _i = 0; _i < 2; ++_i) \
        __builtin_amdgcn_global_load_lds((const unsigned*)((const char*)(gbase) + (voff)[_i]), (PG8_LAS unsigned*)(lds + (bufoff) + ldsw + _i * 8192), 16, 0, 0); } while (0)
#define PG8_STAGEX(b, gbase) __builtin_amdgcn_global_load_lds((const unsigned*)((const char*)(gbase) + voffX), (PG8_LAS unsigned*)(lds + PG8_XA(b) + ldsx), 4, 0, 0)
#define PG8_LDA(dst, b, h) do { _Pragma("unroll") for (int m = 0; m < 4; ++m) _Pragma("unroll") for (int k = 0; k < 2; ++k) dst[m][k] = *(const PG8_LAS bf16x8*)(lds + PG8_SA(b, h) + aoff + m * 2048 + k * 1024); } while (0)
#define PG8_LDB(dst, b, h) do { _Pragma("unroll") for (int n = 0; n < 2; ++n) _Pragma("unroll") for (int k = 0; k < 2; ++k) dst[n][k] = *(const PG8_LAS bf16x8*)(lds + PG8_SB(b, h) + boff + n * 2048 + k * 1024); } while (0)
#define PG8_LDX(dst, b) do { _Pragma("unroll") for (int k = 0; k < 2; ++k) dst[k] = *(const PG8_LAS bf16x8*)(lds + PG8_XA(b) + xoff + k * 1024); } while (0)
#define PG8_MMA(ai, bj, At, Bt) do { __builtin_amdgcn_s_setprio(1); _Pragma("unroll") for (int m = 0; m < 4; ++m) _Pragma("unroll") for (int n = 0; n < 2; ++n) _Pragma("unroll") for (int k = 0; k < 2; ++k) \
        acc[ai][bj][m][n] = __builtin_amdgcn_mfma_f32_16x16x32_bf16(Bt[n][k], At[m][k], acc[ai][bj][m][n], 0, 0, 0); __builtin_amdgcn_s_setprio(0); } while (0)
#define PG8_XMMA() do { if (wr == 0) { _Pragma("unroll") for (int k = 0; k < 2; ++k) { accx[0] = __builtin_amdgcn_mfma_f32_16x16x32_bf16(B0[0][k], Ax[k], accx[0], 0, 0, 0); accx[1] = __builtin_amdgcn_mfma_f32_16x16x32_bf16(B1[0][k], Ax[k], accx[1], 0, 0, 0); } } \
        else { _Pragma("unroll") for (int k = 0; k < 2; ++k) { accx[0] = __builtin_amdgcn_mfma_f32_16x16x32_bf16(B0[1][k], Ax[k], accx[0], 0, 0, 0); accx[1] = __builtin_amdgcn_mfma_f32_16x16x32_bf16(B1[1][k], Ax[k], accx[1], 0, 0, 0); } } } while (0)
#define PG8_WAIT_V(n) asm volatile("s_waitcnt vmcnt(" #n ")" ::: "memory")
#define PG8_WAIT_L(n) asm volatile("s_waitcnt lgkmcnt(" #n ")" ::: "memory")
#define PG8_BAR __builtin_amdgcn_s_barrier()
#define PG8_SCHED __builtin_amdgcn_sched_barrier(0)
    Unit cur, nxt; int ui = 0;
    if (!S.next(0, cur)) return;
    if (SKEW_TICKS > 0) { const unsigned long long t0 = __builtin_amdgcn_s_memrealtime(); const unsigned long long dl = (unsigned long long)SKEW_TICKS * (unsigned)((blockIdx.x >> 3) & 3);
        while (__builtin_amdgcn_s_memrealtime() - t0 < dl) __builtin_amdgcn_s_sleep(8); }
    f32x4 acc[2][2][4][2]; f32x4 accx[2];
#pragma unroll
    for (int a = 0; a < 2; ++a)
#pragma unroll
        for (int b = 0; b < 2; ++b)
#pragma unroll
            for (int m = 0; m < 4; ++m)
#pragma unroll
                for (int n = 0; n < 2; ++n) acc[a][b][m][n] = (f32x4){0.f, 0.f, 0.f, 0.f};
    accx[0] = (f32x4){0.f, 0.f, 0.f, 0.f}; accx[1] = (f32x4){0.f, 0.f, 0.f, 0.f};
    bf16x8 At[4][2], B0[2][2], B1[2][2], Ax[2];
    const char* const xbase = ATILED ? (const char*)g.Ax : (const char*)g.A + (size_t)XMP * K * 2;
    const char* cA = (const char*)g.A + (size_t)cur.pm * tstepA; const char* cB = (const char*)g.Bt + (size_t)cur.pn * tstepB; const char* cX = xbase + (size_t)cur.pm * xstep;
    S.a_ready(cur);
    PG8_STAGE(PG8_SB(0, 0), cB, voffB); PG8_STAGE(PG8_SB(0, 1), cB + hstepB, voffB); PG8_STAGE(PG8_SA(0, 0), cA, voffA); PG8_STAGEX(0, cX); PG8_STAGE(PG8_SA(0, 1), cA + hstepA, voffA);
    if (wr == 1) PG8_BAR;
    PG8_WAIT_V(2); PG8_BAR;
    PG8_STAGE(PG8_SB(1, 0), cB + kstepB, voffB); PG8_STAGE(PG8_SA(1, 0), cA + kstepA, voffA); PG8_STAGE(PG8_SB(1, 1), cB + hstepB + kstepB, voffB); PG8_STAGEX(1, cX + kstepX);
    PG8_WAIT_V(7); PG8_BAR;
    for (;;) {
        const bool has_next = S.next(ui + 1, nxt);
        const char* nA = has_next ? (const char*)g.A + (size_t)nxt.pm * tstepA : cA; const char* nB = has_next ? (const char*)g.Bt + (size_t)nxt.pn * tstepB : cB; const char* nX = has_next ? xbase + (size_t)nxt.pm * xstep : cX;
        for (int kr = 0; kr < KREP; ++kr) {
        const bool fin = (kr == KREP - 1);
        if (KREP > 1 && kr > 0) {
#pragma unroll
            for (int a = 0; a < 2; ++a)
#pragma unroll
                for (int b = 0; b < 2; ++b)
#pragma unroll
                    for (int m = 0; m < 4; ++m)
#pragma unroll
                        for (int n = 0; n < 2; ++n) acc[a][b][m][n] = (f32x4){0.f, 0.f, 0.f, 0.f};
            accx[0] = (f32x4){0.f, 0.f, 0.f, 0.f}; accx[1] = (f32x4){0.f, 0.f, 0.f, 0.f};
        }
        for (int t = 0; t < nt; t += 2) {
            const bool last = (t == nt - 2);
            const char* a1 = cA + (size_t)(t + 1) * kstepA;
            const char* a2 = last ? (fin ? nA : cA) : cA + (size_t)(t + 2) * kstepA; const char* b2 = last ? (fin ? nB : cB) : cB + (size_t)(t + 2) * kstepB; const char* x2 = last ? (fin ? nX : cX) : cX + (size_t)(t + 2) * kstepX;
            const char* a3 = a2 + kstepA; const char* b3 = b2 + kstepB; const char* x3 = x2 + kstepX;
            if (last && has_next && fin) S.a_ready(nxt);
            PG8_LDB(B0, 0, 0); PG8_LDB(B1, 0, 1); PG8_SCHED; PG8_LDA(At, 0, 0); PG8_LDX(Ax, 0); PG8_STAGE(PG8_SA(1, 1), a1 + hstepA, voffA);
            PG8_WAIT_V(9); PG8_WAIT_L(0); PG8_BAR; PG8_MMA(0, 0, At, B0); PG8_MMA(0, 1, At, B1); PG8_XMMA(); PG8_BAR; PG8_SCHED;
            PG8_LDA(At, 0, 1); PG8_STAGE(PG8_SB(0, 0), b2, voffB); PG8_STAGE(PG8_SB(0, 1), b2 + hstepB, voffB); PG8_STAGE(PG8_SA(0, 0), a2, voffA); PG8_STAGEX(0, x2);
            PG8_WAIT_V(9); PG8_WAIT_L(0); PG8_BAR; PG8_MMA(1, 0, At, B0); PG8_MMA(1, 1, At, B1); PG8_BAR; PG8_SCHED;
            PG8_LDB(B0, 1, 0); PG8_LDB(B1, 1, 1); PG8_SCHED; PG8_LDA(At, 1, 0); PG8_LDX(Ax, 1); PG8_STAGE(PG8_SA(0, 1), a2 + hstepA, voffA);
            PG8_WAIT_V(9); PG8_WAIT_L(0); PG8_BAR; PG8_MMA(0, 0, At, B0); PG8_MMA(0, 1, At, B1); PG8_XMMA(); PG8_BAR; PG8_SCHED;
            PG8_LDA(At, 1, 1); PG8_STAGE(PG8_SB(1, 0), b3, voffB); PG8_STAGE(PG8_SB(1, 1), b3 + hstepB, voffB); PG8_STAGE(PG8_SA(1, 0), a3, voffA); PG8_STAGEX(1, x3);
            PG8_WAIT_V(9); PG8_WAIT_L(0); PG8_BAR; PG8_MMA(1, 0, At, B0); PG8_MMA(1, 1, At, B1); PG8_BAR; PG8_SCHED;
        }
        }
        if (wr == 0) PG8_BAR;
        { int fr_ = fr, fq_ = fq; asm volatile("" : "+v"(fr_), "+v"(fq_));
          for (int er = 0; er < EREP; ++er) E(acc, accx, cur, wr, wc, fr_, fq_, lds); } S.done(cur);
        if (!has_next) break;
#pragma unroll
        for (int a = 0; a < 2; ++a)
#pragma unroll
            for (int b = 0; b < 2; ++b)
#pragma unroll
                for (int m = 0; m < 4; ++m)
#pragma unroll
                    for (int n = 0; n < 2; ++n) acc[a][b][m][n] = (f32x4){0.f, 0.f, 0.f, 0.f};
        accx[0] = (f32x4){0.f, 0.f, 0.f, 0.f}; accx[1] = (f32x4){0.f, 0.f, 0.f, 0.f};
        cur = nxt; cA = nA; cB = nB; cX = nX; ++ui;
        if (wr == 1) PG8_BAR;
    }
    PG8_WAIT_V(0);
    PG8_BAR;
#undef PG8_SA
#undef PG8_SB
#undef PG8_XA
#undef PG8_STAGE
#undef PG8_STAGEX
#undef PG8_LDA
#undef PG8_LDB
#undef PG8_LDX
#undef PG8_MMA
#undef PG8_XMMA
#undef PG8_WAIT_V
#undef PG8_WAIT_L
#undef PG8_BAR
#undef PG8_SCHED
}
}

__device__ __forceinline__ void p0_transpose_item(const float* W, int K, int N, const float* gain, bf16* WT, int glu, LAS float* scr, int item, int lane) {
    const int nblk = N / 64, kb = item / nblk, nb = item % nblk, k0 = 64 * kb, n0 = 64 * nb;
    const int q = lane & 15, kr = lane >> 4;
    f32x4 v[16];
#pragma unroll
    for (int i = 0; i < 16; ++i) v[i] = *(const f32x4*)(W + (size_t)(k0 + 4 * i + kr) * N + n0 + 4 * q);
    if (gain) {
#pragma unroll
        for (int i = 0; i < 16; ++i) v[i] = v[i] * gain[k0 + 4 * i + kr];
    }
#pragma unroll
    for (int i = 0; i < 16; ++i) { LAS float* d = scr + (4 * i + kr) * 65 + 4 * q; d[0] = v[i][0]; d[1] = v[i][1]; d[2] = v[i][2]; d[3] = v[i][3]; }
    LDS_WAIT(); asm volatile("" ::: "memory");
    int drow0 = n0; if (glu) { const int bj = n0 / 1024, rem = n0 % 1024; drow0 = (rem / 128) * 256 + bj * 128 + (rem % 128); }
    const int c = lane & 7;
#pragma unroll
    for (int j = 0; j < 8; ++j) { const int n = (lane >> 3) + 8 * j; const LAS float* sp = scr + (8 * c) * 65 + n;
        v4u o; o.x = pk2(sp[0 * 65], sp[1 * 65]); o.y = pk2(sp[2 * 65], sp[3 * 65]); o.z = pk2(sp[4 * 65], sp[5 * 65]); o.w = pk2(sp[6 * 65], sp[7 * 65]);
        *(GAS v4u*)(WT + (size_t)(drow0 + n) * K + k0 + 8 * c) = o; }
    LDS_WAIT(); asm volatile("" ::: "memory");
}

__device__ __forceinline__ void sincos_rr(float x, float& s, float& c) {
    const float q = rintf(x * 0.63661977236758f);
    float r = fmaf(-q, 1.57079637050629f, x); r = fmaf(-q, -4.37113882867379e-8f, r);
    const float r2 = r * r;
    const float sp = r + r * r2 * (-1.6666667163e-1f + r2 * (8.3333337680e-3f + r2 * (-1.9841270114e-4f + r2 * 2.7557314297e-6f)));
    const float cp = 1.0f + r2 * (-0.5f + r2 * (4.1666667908e-2f + r2 * (-1.3888889225e-3f + r2 * (2.4801587642e-5f + r2 * -2.7557314297e-7f))));
    const int qi = (int)q & 3;
    s = (qi == 0) ? sp : (qi == 1) ? cp : (qi == 2) ? -sp : -cp;
    c = (qi == 0) ? cp : (qi == 1) ? -sp : (qi == 2) ? -cp : sp;
}

typedef float f32x16 __attribute__((ext_vector_type(16)));
typedef float f32x2_t __attribute__((ext_vector_type(2))); typedef __bf16 bf16x2_t __attribute__((ext_vector_type(2)));
__device__ __forceinline__ unsigned cvtpk_c(float lo, float hi) { f32x2_t v = {lo, hi}; bf16x2_t b = __builtin_convertvector(v, bf16x2_t); return __builtin_bit_cast(unsigned, b); }
typedef unsigned u32x2 __attribute__((ext_vector_type(2)));
__device__ __forceinline__ void ssm_abar_calc(const float* A_re, const float* A_im, const float* log_dt, int g, int n, float& abr, float& abi, float& cfr, float& cfi) {
    const float dt = expf(log_dt[g]);
    const float ar = A_re[g * 64 + n], ai = A_im[g * 64 + n];
    const float mag = expf(dt * ar); float sn, cs; sincos_rr(dt * ai, sn, cs);
    abr = mag * cs; abi = mag * sn;
    const float den = ar * ar + ai * ai, nr = abr - 1.0f;
    cfr = (nr * ar + abi * ai) / den; cfi = (abi * ar - nr * ai) / den;
}
__device__ __forceinline__ float gelu_tanh(float y) {
    const float z = 0.7978845608028654f * (y + 0.044715f * y * y * y);
    return y * __builtin_amdgcn_rcpf(1.0f + __expf(-2.0f * z));
}
__device__ __forceinline__ void wg_rinv(LAS float* tab, const float* ssp, int row0, int nrows, int np, int tid) {
    __syncthreads();
    const int row = tid >> 1, hf = tid & 1;
    if (row < nrows) {
        const float* p = ssp + (size_t)(row0 + row) * 64 + (np >> 1) * hf;
        f32x4 v[4];
#pragma unroll
        for (int i = 0; i < 4; ++i) v[i] = *(const f32x4*)(p + 4 * i);
        float s_ = ((v[0][0] + v[0][1]) + (v[0][2] + v[0][3])) + ((v[1][0] + v[1][1]) + (v[1][2] + v[1][3]));
        const float s2 = ((v[2][0] + v[2][1]) + (v[2][2] + v[2][3])) + ((v[3][0] + v[3][1]) + (v[3][2] + v[3][3]));
        s_ += (np == 32) ? s2 : 0.f;
        s_ += __shfl_xor(s_, 1);
        if (hf == 0) tab[row] = rsqrtf(s_ * (1.0f / 1024.0f) + 1e-6f);
    }
    __syncthreads();
}
struct SsmT { const bf16* BT; const bf16* CT; const float* tab; const float* Dk; const float* gain; };
template <int MODE>
__device__ __forceinline__ void ssm_mfma_unit(LAS unsigned char* wl, int lane, int g, const SsmT& T, const bf16* XB, const LAS float* rv, int row0, int nblk,
                                              float (&st)[4]  , bf16* Gout, const float* h0r, const float* h0i, float* hor, float* hoi  , int b0) {
    const int r32 = lane & 31, hi5 = lane >> 5, c16 = lane & 15, kq = lane >> 4;
    pg8::bf16x8 bt[4], ct[4];
#pragma unroll
    for (int tn = 0; tn < 4; ++tn) bt[tn] = *(const pg8::bf16x8*)(T.BT + (size_t)(tn * 32 + r32) * 16 + 8 * hi5);
    if (MODE != 0) {
#pragma unroll
        for (int ks = 0; ks < 4; ++ks) ct[ks] = *(const pg8::bf16x8*)(T.CT + (size_t)c16 * 128 + 32 * ks + 8 * kq);
    }
    float ar[2], ai[2];
    { const f32x4 t0 = *(const f32x4*)(T.tab + (size_t)r32 * 4), t1 = *(const f32x4*)(T.tab + (size_t)(32 + r32) * 4); ar[0] = t0[0]; ai[0] = t0[1]; ar[1] = t1[0]; ai[1] = t1[1]; }
    f32x4 Dg = {0.f, 0.f, 0.f, 0.f};
    if (MODE != 0) { const f32x4 dv = *(const f32x4*)(T.Dk + 4 * kq), gv = *(const f32x4*)(T.gain + 4 * kq); Dg = dv * gv; }
    float pwr[2][16], pwi[2][16], a32r[2], a32i[2];
    if (MODE == 0) {
#pragma unroll
        for (int p = 0; p < 2; ++p) {
            const float a_r = ar[p], a_i = ai[p];
            float a2r = a_r * a_r - a_i * a_i, a2i = 2.0f * a_r * a_i;
            float a4r = a2r * a2r - a2i * a2i, a4i = 2.0f * a2r * a2i;
            const float a5r = a4r * a_r - a4i * a_i, a5i = a4r * a_i + a4i * a_r;
            float cr = hi5 ? 1.0f : a4r, ci = hi5 ? 0.0f : a4i;
#pragma unroll
            for (int Q = 3; Q >= 0; --Q) {
#pragma unroll
                for (int e = 3; e >= 0; --e) {
                    pwr[p][4 * Q + e] = cr; pwi[p][4 * Q + e] = ci;
                    const float mr = (e == 0) ? a5r : a_r, mi = (e == 0) ? a5i : a_i;
                    const float tr = cr * mr - ci * mi, ti = cr * mi + ci * mr; cr = tr; ci = ti;
                }
            }
            float t8r = a4r * a4r - a4i * a4i, t8i = 2.0f * a4r * a4i;
            float t16r = t8r * t8r - t8i * t8i, t16i = 2.0f * t8r * t8i;
            a32r[p] = t16r * t16r - t16i * t16i; a32i[p] = 2.0f * t16r * t16i;
        }
    }
    pg8::bf16x8 xa_all[8];
    if (MODE != 2) {
#pragma unroll
        for (int k = 0; k < 8; ++k) xa_all[k] = *(const pg8::bf16x8*)(XB + (size_t)(row0 + 32 * k + r32) * 1024 + g * 16 + 8 * hi5);
    } else {
        xa_all[0] = *(const pg8::bf16x8*)(XB + (size_t)(row0 + r32) * 1024 + g * 16 + 8 * hi5);
    }
    for (int blk = 0; blk < nblk; ++blk) {
        const int rowb = row0 + 32 * blk;
        const pg8::bf16x8 xa = xa_all[0];
        if (MODE != 2) {
#pragma unroll
            for (int k = 0; k < 7; ++k) xa_all[k] = xa_all[k + 1];
        }
        if (MODE != 0) *(LAS pg8::bf16x8*)(wl + 9728 + r32 * 32 + hi5 * 16) = xa;
        const LAS float* rvb = rv + ((MODE == 2) ? 0 : 32 * blk);
        pg8::bf16x8 xs_;
        { const float rin = rvb[r32]; const v4u xw = __builtin_bit_cast(v4u, xa); v4u ow;
          ow.x = cvtpk_c(bf_lo(xw.x) * rin, bf_hi(xw.x) * rin); ow.y = cvtpk_c(bf_lo(xw.y) * rin, bf_hi(xw.y) * rin);
          ow.z = cvtpk_c(bf_lo(xw.z) * rin, bf_hi(xw.z) * rin); ow.w = cvtpk_c(bf_lo(xw.w) * rin, bf_hi(xw.w) * rin); xs_ = __builtin_bit_cast(pg8::bf16x8, ow); }
        f32x16 IN[4];
#pragma unroll
        for (int tn = 0; tn < 4; ++tn) { const f32x16 z = {0.f, 0.f, 0.f, 0.f, 0.f, 0.f, 0.f, 0.f, 0.f, 0.f, 0.f, 0.f, 0.f, 0.f, 0.f, 0.f}; IN[tn] = __builtin_amdgcn_mfma_f32_32x32x16_bf16(xs_, bt[tn], z, 0, 0, 0); }
        if (MODE == 0) {
#pragma unroll
            for (int p = 0; p < 2; ++p) {
                float er[2] = {0.f, 0.f}, ei[2] = {0.f, 0.f};
#pragma unroll
                for (int r = 0; r < 16; ++r) {
                    const float xr_ = IN[2 * p][r], xi_ = IN[2 * p + 1][r], wr_ = pwr[p][r], wi_ = pwi[p][r];
                    float t = fmaf(wr_, xr_, er[r & 1]); asm volatile("" : "+v"(t)); t = fmaf(-wi_, xi_, t); asm volatile("" : "+v"(t)); er[r & 1] = t;
                    float u = fmaf(wr_, xi_, ei[r & 1]); asm volatile("" : "+v"(u)); u = fmaf(wi_, xr_, u); asm volatile("" : "+v"(u)); ei[r & 1] = u;
                }
                float e_r = er[0] + er[1], e_i = ei[0] + ei[1];
                asm volatile("" : "+v"(e_r), "+v"(e_i));
                { auto w0 = __builtin_amdgcn_permlane32_swap(__float_as_uint(e_r), __float_as_uint(e_r), false, false); e_r = __uint_as_float(w0[0]) + __uint_as_float(w0[1]);
                  auto w1 = __builtin_amdgcn_permlane32_swap(__float_as_uint(e_i), __float_as_uint(e_i), false, false); e_i = __uint_as_float(w1[0]) + __uint_as_float(w1[1]); }
                asm volatile("" : "+v"(e_r), "+v"(e_i));
                const float sr = st[2 * p], si = st[2 * p + 1];
                float nr = fmaf(a32r[p], sr, e_r); asm volatile("" : "+v"(nr)); nr = fmaf(-a32i[p], si, nr); asm volatile("" : "+v"(nr));
                float ni = fmaf(a32r[p], si, e_i); asm volatile("" : "+v"(ni)); ni = fmaf(a32i[p], sr, ni); asm volatile("" : "+v"(ni));
                st[2 * p] = nr; st[2 * p + 1] = ni;
            }
        } else
        {
            const bool up = (hi5 != 0);
            float sr[2] = {st[0], st[2]}, si[2] = {st[1], st[3]};
#define SSM_STEP(CR, CI, OR_, OI_, e_) do { \
                float tr0 = fmaf(ar[0], CR[0], IN[0][4 * Q + e_]); asm volatile("" : "+v"(tr0)); float tr1 = fmaf(ar[1], CR[1], IN[2][4 * Q + e_]); asm volatile("" : "+v"(tr1)); \
                float ti0 = fmaf(ar[0], CI[0], IN[1][4 * Q + e_]); asm volatile("" : "+v"(ti0)); float ti1 = fmaf(ar[1], CI[1], IN[3][4 * Q + e_]); asm volatile("" : "+v"(ti1)); \
                tr0 = fmaf(-ai[0], CI[0], tr0); asm volatile("" : "+v"(tr0)); tr1 = fmaf(-ai[1], CI[1], tr1); asm volatile("" : "+v"(tr1)); \
                ti0 = fmaf(ai[0], CR[0], ti0); asm volatile("" : "+v"(ti0)); ti1 = fmaf(ai[1], CR[1], ti1); asm volatile("" : "+v"(ti1)); \
                CR[0] = tr0; CR[1] = tr1; CI[0] = ti0; CI[1] = ti1; OR_[0][e_] = tr0; OR_[1][e_] = tr1; OI_[0][e_] = ti0; OI_[1][e_] = ti1; } while (0)
#pragma unroll
            for (int Q = 0; Q < 4; ++Q) {
                if (MODE == 2) {
#pragma unroll
                    for (int p = 0; p < 2; ++p) { const size_t hidx = ((size_t)(b0 + Q) * 64 + g) * 64 + 32 * p + r32; sr[p] = h0r[hidx]; si[p] = h0i[hidx]; } }
                float xr_[2][4], xi_[2][4], yr_[2][4], yi_[2][4];
                float cr[2] = {sr[0], sr[1]}, ci[2] = {si[0], si[1]};
#pragma unroll
                for (int e = 0; e < 4; ++e) SSM_STEP(cr, ci, xr_, xi_, e);
#pragma unroll
                for (int p = 0; p < 2; ++p) {
                    auto w0 = __builtin_amdgcn_permlane32_swap(__float_as_uint(cr[p]), __float_as_uint(cr[p]), false, false); cr[p] = __uint_as_float(w0[0]);
                    auto w1 = __builtin_amdgcn_permlane32_swap(__float_as_uint(ci[p]), __float_as_uint(ci[p]), false, false); ci[p] = __uint_as_float(w1[0]); }
#pragma unroll
                for (int e = 0; e < 4; ++e) SSM_STEP(cr, ci, yr_, yi_, e);
#pragma unroll
                for (int p = 0; p < 2; ++p) {
                    auto w0 = __builtin_amdgcn_permlane32_swap(__float_as_uint(cr[p]), __float_as_uint(cr[p]), false, false); sr[p] = __uint_as_float(w0[1]);
                    auto w1 = __builtin_amdgcn_permlane32_swap(__float_as_uint(ci[p]), __float_as_uint(ci[p]), false, false); si[p] = __uint_as_float(w1[1]); }
#pragma unroll
                for (int p = 0; p < 2; ++p)
#pragma unroll
                    for (int e = 0; e < 4; ++e) { IN[2 * p][4 * Q + e] = up ? yr_[p][e] : xr_[p][e]; IN[2 * p + 1][4 * Q + e] = up ? yi_[p][e] : xi_[p][e]; }
                if (MODE == 2) { if (hi5 == 0) {
#pragma unroll
                    for (int p = 0; p < 2; ++p) { const size_t hidx = ((size_t)(b0 + Q) * 64 + g) * 64 + 32 * p + r32; hor[hidx] = sr[p]; hoi[hidx] = si[p]; } } }
            }
#undef SSM_STEP
            st[0] = sr[0]; st[1] = si[0]; st[2] = sr[1]; st[3] = si[1];
        }
        if (MODE != 0) {
#pragma unroll
            for (int p = 0; p < 2; ++p)
#pragma unroll
                for (int r = 0; r < 16; ++r) { const int tau = 8 * (r >> 2) + 4 * hi5 + (r & 3); *(LAS unsigned*)(wl + tau * 272 + 4 * (32 * p + r32)) = pg8::cvt_pk_bf16(IN[2 * p][r], IN[2 * p + 1][r]); }
            LDS_WAIT(); asm volatile("" ::: "memory");
#pragma unroll
            for (int tt = 0; tt < 2; ++tt) {
                f32x4 y = {0.f, 0.f, 0.f, 0.f};
#pragma unroll
                for (int ks = 0; ks < 4; ++ks) { const pg8::bf16x8 hf = *(const LAS pg8::bf16x8*)(wl + (16 * tt + c16) * 272 + (32 * ks + 8 * kq) * 2); y = __builtin_amdgcn_mfma_f32_16x16x32_bf16(ct[ks], hf, y, 0, 0, 0); }
                const int token = rowb + 16 * tt + c16;
                const float rinv = rvb[16 * tt + c16];
                const f32x4 xv = pg8::unpack4(*(const LAS u32x2*)(wl + 9728 + (16 * tt + c16) * 32 + kq * 8));
                f32x4 o;
#pragma unroll
                for (int e = 0; e < 4; ++e) o[e] = gelu_tanh(y[e] + Dg[e] * (xv[e] * rinv));
                *(u32x2*)(Gout + (size_t)token * 1024 + g * 16 + 4 * kq) = pg8::pack4(o);
            }
        }
        LDS_WAIT(); asm volatile("" ::: "memory");
    }
}

__device__ __forceinline__ void attn_task(const LAS unsigned char* Kl, const LAS unsigned char* Vl, const bf16* Qb, bf16* Ob, const float* sinks, int qrow, int head, int tloc, int kb0, int jkmin, int lane) {
    const int r32 = lane & 31, hi5 = lane >> 5;
    const float slope2 = exp2f(-0.5f * (float)(head + 1)) * 1.4426950408889634f, sink2 = sinks[head] * 1.4426950408889634f;
    const bf16* qptr = Qb + (size_t)qrow * 1024 + head * 64 + 8 * hi5;
    pg8::bf16x8 qf[4];
#pragma unroll
    for (int ks = 0; ks < 4; ++ks) qf[ks] = *(const pg8::bf16x8*)(qptr + 16 * ks);
    f32x16 S[5];
#pragma unroll
    for (int i = 0; i < 5; ++i) {
        f32x16 acc = {0.f, 0.f, 0.f, 0.f, 0.f, 0.f, 0.f, 0.f, 0.f, 0.f, 0.f, 0.f, 0.f, 0.f, 0.f, 0.f};
#pragma unroll
        for (int ks = 0; ks < 4; ++ks) { const pg8::bf16x8 kf = *(const LAS pg8::bf16x8*)(Kl + (32 * (kb0 + i) + r32) * 144 + 32 * ks + 16 * hi5); acc = __builtin_amdgcn_mfma_f32_32x32x16_bf16(kf, qf[ks], acc, 0, 0, 0); }
        S[i] = acc;
    }
    float mx = sink2;
#pragma unroll
    for (int i = 0; i < 5; ++i)
#pragma unroll
        for (int r = 0; r < 16; ++r) {
            const int jk = 32 * (kb0 + i) + (r & 3) + 8 * (r >> 2) + 4 * hi5; const int dist = tloc + 128 - jk;
            const bool valid = (dist >= 0) && (dist <= 128) && (jk >= jkmin);
            const float sv = valid ? (S[i][r] * 0.18033688011112042f - slope2 * (float)dist) : -1e30f;
            S[i][r] = sv; mx = fmaxf(mx, sv);
        }
    mx = fmaxf(mx, __shfl_xor(mx, 32));
    float lsum = 0.f;
#pragma unroll
    for (int i = 0; i < 5; ++i)
#pragma unroll
        for (int r = 0; r < 16; ++r) { const float p = __builtin_amdgcn_exp2f(S[i][r] - mx); S[i][r] = p; lsum += p; }
    lsum += __shfl_xor(lsum, 32); lsum += __builtin_amdgcn_exp2f(sink2 - mx);
    const float inv = 1.0f / lsum;
    f32x16 O0 = {0.f, 0.f, 0.f, 0.f, 0.f, 0.f, 0.f, 0.f, 0.f, 0.f, 0.f, 0.f, 0.f, 0.f, 0.f, 0.f}, O1 = O0;
#pragma unroll
    for (int i = 0; i < 5; ++i)
#pragma unroll
        for (int s2 = 0; s2 < 2; ++s2) {
            v4u pw; pw.x = pg8::cvt_pk_bf16(S[i][8 * s2 + 0], S[i][8 * s2 + 1]); pw.y = pg8::cvt_pk_bf16(S[i][8 * s2 + 2], S[i][8 * s2 + 3]);
            pw.z = pg8::cvt_pk_bf16(S[i][8 * s2 + 4], S[i][8 * s2 + 5]); pw.w = pg8::cvt_pk_bf16(S[i][8 * s2 + 6], S[i][8 * s2 + 7]);
            const pg8::bf16x8 pf = __builtin_bit_cast(pg8::bf16x8, pw);
            const int keyoff = 32 * (kb0 + i) + 16 * s2 + 4 * hi5;
            { const u32x2 lo = *(const LAS u32x2*)(Vl + r32 * 520 + keyoff * 2), hh = *(const LAS u32x2*)(Vl + r32 * 520 + (keyoff + 8) * 2);
              v4u vw; vw.x = lo.x; vw.y = lo.y; vw.z = hh.x; vw.w = hh.y; O0 = __builtin_amdgcn_mfma_f32_32x32x16_bf16(__builtin_bit_cast(pg8::bf16x8, vw), pf, O0, 0, 0, 0); }
            { const u32x2 lo = *(const LAS u32x2*)(Vl + (32 + r32) * 520 + keyoff * 2), hh = *(const LAS u32x2*)(Vl + (32 + r32) * 520 + (keyoff + 8) * 2);
              v4u vw; vw.x = lo.x; vw.y = lo.y; vw.z = hh.x; vw.w = hh.y; O1 = __builtin_amdgcn_mfma_f32_32x32x16_bf16(__builtin_bit_cast(pg8::bf16x8, vw), pf, O1, 0, 0, 0); }
        }
    bf16* optr = Ob + (size_t)qrow * 1024 + head * 64 + 4 * hi5;
#pragma unroll
    for (int qd = 0; qd < 4; ++qd) {
        u32x2 w0; w0.x = pg8::cvt_pk_bf16(O0[4 * qd] * inv, O0[4 * qd + 1] * inv); w0.y = pg8::cvt_pk_bf16(O0[4 * qd + 2] * inv, O0[4 * qd + 3] * inv);
        u32x2 w1; w1.x = pg8::cvt_pk_bf16(O1[4 * qd] * inv, O1[4 * qd + 1] * inv); w1.y = pg8::cvt_pk_bf16(O1[4 * qd + 2] * inv, O1[4 * qd + 3] * inv);
        *(u32x2*)(optr + 8 * qd) = w0; *(u32x2*)(optr + 32 + 8 * qd) = w1;
    }
}

#ifndef SKEW_UP
#define SKEW_UP 250
#define SKEW_GLU 250
#endif
#ifndef PROBE_DUP
#define PROBE_DUP 0
#endif
#define NREP(bit) (((PROBE_DUP) >> (bit)) & 1 ? 2 : 1)
#ifndef EN_P0
#define EN_P0 1
#endif
#ifndef EN_QKV
#define EN_QKV 1
#endif
#ifndef EN_ATT
#define EN_ATT 1
#endif
#ifndef EN_OPJ
#define EN_OPJ 1
#endif
#ifndef EN_S1
#define EN_S1 1
#endif
#ifndef EN_S3
#define EN_S3 1
#endif
#ifndef EN_GLU
#define EN_GLU 1
#endif
#ifndef EN_UP
#define EN_UP 1
#endif
#ifndef EN_DN
#define EN_DN 1
#endif
#ifndef EN_FIN
#define EN_FIN 1
#endif
template <class T> __device__ __forceinline__ T karg(const __attribute__((address_space(4))) char* ka, int off) { typedef const __attribute__((address_space(4))) T CT; return *(CT*)(ka + off); }
struct Args { const float* in[23]; float* out; unsigned char* ws; int ph_lo, ph_hi; };
static_assert(sizeof(Args) == 208 && __builtin_offsetof(Args, out) == 184 && __builtin_offsetof(Args, ws) == 192, "kernarg layout used by KARG");

__global__ void __launch_bounds__(512, 2) fwd_kernel(Args args) {
    extern __shared__ __attribute__((aligned(16))) unsigned char lds[];
    LAS unsigned char* const L = (LAS unsigned char*)lds;
#define FRESH_IDS int tid = threadIdx.x; asm volatile("" : "+v"(tid)); const int lane = tid & 63, wave = __builtin_amdgcn_readfirstlane(tid >> 6); const int gw = vcu * 8 + wave; (void)lane; (void)gw
    const int G = gridDim.x, bx = blockIdx.x;
    const int vcu = (G % 8 == 0) ? (bx % 8) * (G / 8) + bx / 8 : bx;
    const int NGW = G * 8;
    for (int u = threadIdx.x; u < (LDS_BYTES - LDSCTL_OFF) / 4; u += 512) ((LAS unsigned*)(L + LDSCTL_OFF))[u] = 0u;
    __syncthreads();
    const int lo = args.ph_lo, hi = args.ph_hi;
    const bool multi = (hi - lo) > 1;
    XcdBarrier bar; bar.bar = (unsigned*)(args.ws + WS_CTL) + CW_BAR; bar.x = 0; bar.st = nullptr;
    if (multi) bar = xcd_barrier_post((unsigned*)(args.ws + WS_CTL) + CW_BAR, (volatile LAS unsigned*)(L + MISC_OFF) + 8);
#define IN(k) (lo <= (k) && (k) < hi)
#define SEAM(k) do { if (IN(k) && IN((k) + 1)) xcd_barrier(bar); } while (0)

#define KARG(T, off) karg<T>(ka, (off))
#define INP(k) karg<const float*>(ka, 8 * (k))
#define FRESH_PTRS const __attribute__((address_space(4))) char* ka = (const __attribute__((address_space(4))) char*)__builtin_amdgcn_kernarg_segment_ptr(); asm volatile("" : "+s"(ka)); \
    unsigned char* const ws = KARG(unsigned char*, 192); float* const out = KARG(float*, 184); \
    float* const ssp = (float*)(ws + WS_SSP); float* const HS = (float*)(ws + WS_HS); bf16* const XB = (bf16*)(ws + WS_XB); bf16* const Hb = (bf16*)(ws + WS_H); \
    bf16* const Qb = (bf16*)(ws + WS_Q); bf16* const Kb = (bf16*)(ws + WS_K); bf16* const Vb = (bf16*)(ws + WS_V); bf16* const Ob = (bf16*)(ws + WS_O); \
    const float* const x_p = INP(0); const float* const x_s = INP(1); (void)ssp; (void)HS; (void)XB; (void)Hb; (void)Qb; (void)Kb; (void)Vb; (void)Ob; (void)x_p; (void)x_s
    if (EN_P0 && IN(0)) for (int rp = 0; rp < NREP(0); ++rp) {
        FRESH_IDS; FRESH_PTRS;
        LAS float* scr = (LAS float*)(L + wave * 16640);
        constexpr int I_QKV = 16 * 24, I_O = 16 * 16, I_GLU = 16 * 32, I_UP = 16 * 64, I_DN = 64 * 16;
        constexpr int NITEMS = 2 * I_QKV + 2 * I_O + 2 * I_GLU + 4 * I_UP + 4 * I_DN;
        for (int it = gw; it < NITEMS; it += NGW) {
            int r = it;
            if (r < 2 * I_QKV) { const int j = r / I_QKV; r -= j * I_QKV; p0_transpose_item(INP(9) + (size_t)j * D * NQKV, D, NQKV, INP(6) + (size_t)(2 * j) * D, (bf16*)(ws + WS_WQKV) + (size_t)j * NQKV * D, 0, scr, r, lane); continue; } r -= 2 * I_QKV;
            if (r < 2 * I_O) { const int j = r / I_O; r -= j * I_O; p0_transpose_item(INP(10) + (size_t)j * D * D, D, D, nullptr, (bf16*)(ws + WS_WO) + (size_t)j * D * D, 0, scr, r, lane); continue; } r -= 2 * I_O;
            if (r < 2 * I_GLU) { const int j = r / I_GLU; r -= j * I_GLU; p0_transpose_item(INP(20) + (size_t)j * D * 2 * D, D, 2 * D, nullptr, (bf16*)(ws + WS_WGLU) + (size_t)j * 2 * D * D, 1, scr, r, lane); continue; } r -= 2 * I_GLU;
            if (r < 4 * I_UP) { const int l = r / I_UP; r -= l * I_UP; p0_transpose_item(INP(21) + (size_t)l * D * FF, D, FF, INP(7) + (size_t)l * D, (bf16*)(ws + WS_WUP) + (size_t)l * FF * D, 0, scr, r, lane); continue; } r -= 4 * I_UP;
            { const int l = r / I_DN; r -= l * I_DN; p0_transpose_item(INP(22) + (size_t)l * FF * D, FF, D, nullptr, (bf16*)(ws + WS_WDN) + (size_t)l * D * FF, 0, scr, r, lane); }
        }
        for (int m0 = 2 * gw; m0 < M; m0 += 2 * NGW) {
            f32x4 v[2][4];
#pragma unroll
            for (int rr = 0; rr < 2; ++rr) { const int m = m0 + rr; const float* xrow = (m < MP) ? x_p + (size_t)m * D : x_s + (size_t)(m - MP) * D;
#pragma unroll
                for (int j = 0; j < 4; ++j) v[rr][j] = *((const GAS f32x4*)xrow + lane + 64 * j); }
#pragma unroll
            for (int rr = 0; rr < 2; ++rr) { const int m = m0 + rr; float sq = 0.f;
#pragma unroll
                for (int j = 0; j < 4; ++j) sq += (v[rr][j][0] * v[rr][j][0] + v[rr][j][1] * v[rr][j][1]) + (v[rr][j][2] * v[rr][j][2] + v[rr][j][3] * v[rr][j][3]);
                sq = wave_sum(sq);
                GAS unsigned long long* o8 = (GAS unsigned long long*)(XB + (size_t)m * D) + lane;
#pragma unroll
                for (int j = 0; j < 4; ++j) o8[64 * j] = (unsigned long long)pk2(v[rr][j][0], v[rr][j][1]) | ((unsigned long long)pk2(v[rr][j][2], v[rr][j][3]) << 32);
                if (lane < 32) ssp[(size_t)m * 64 + lane] = (lane == 0) ? sq : 0.f; }
        }
        for (int i = bx * 512 + tid; i < 2 * NG * NS; i += G * 512) {
            const int jj = i >> 12, gn = i & 4095, g = gn >> 6, n = gn & 63; float abr, abi, cfr, cfi;
            ssm_abar_calc(INP(12) + (size_t)jj * NG * NS, INP(13) + (size_t)jj * NG * NS, INP(14) + (size_t)jj * NG, g, n, abr, abi, cfr, cfi);
            f32x4 v; v[0] = abr; v[1] = abi; v[2] = cfr; v[3] = cfi; *(f32x4*)((float*)(ws + WS_TAB) + (size_t)i * 4) = v;
            const float* bre = INP(15) + (size_t)i * 16; const float* bim = INP(16) + (size_t)i * 16; const float* gn_ = INP(6) + (size_t)(2 * jj + 1) * D + g * 16;
            bf16* btr = (bf16*)(ws + WS_BT) + ((size_t)(jj * NG + g) * 128 + (2 * (n >> 5)) * 32 + (n & 31)) * 16; bf16* bti = btr + 32 * 16;
#pragma unroll
            for (int c8 = 0; c8 < 2; ++c8) {
                float wr_[8], wi_[8];
#pragma unroll
                for (int c4 = 0; c4 < 2; ++c4) { const f32x4 br = *(const f32x4*)(bre + 8 * c8 + 4 * c4), bi = *(const f32x4*)(bim + 8 * c8 + 4 * c4), gv = *(const f32x4*)(gn_ + 8 * c8 + 4 * c4);
#pragma unroll
                    for (int e = 0; e < 4; ++e) { wr_[4 * c4 + e] = (cfr * br[e] - cfi * bi[e]) * gv[e]; wi_[4 * c4 + e] = (cfr * bi[e] + cfi * br[e]) * gv[e]; } }
                v4u o; o.x = pk2(wr_[0], wr_[1]); o.y = pk2(wr_[2], wr_[3]); o.z = pk2(wr_[4], wr_[5]); o.w = pk2(wr_[6], wr_[7]); *(v4u*)(btr + 8 * c8) = o;
                o.x = pk2(wi_[0], wi_[1]); o.y = pk2(wi_[2], wi_[3]); o.z = pk2(wi_[4], wi_[5]); o.w = pk2(wi_[6], wi_[7]); *(v4u*)(bti + 8 * c8) = o;
            }
        }
        for (int i = bx * 512 + tid; i < 2 * NG * GC * 16; i += G * 512) {
            const int n4 = i & 15; const size_t rowi = (size_t)(i >> 4);
            const f32x4 cr = *(const f32x4*)(INP(17) + rowi * 64 + 4 * n4), ci = *(const f32x4*)(INP(18) + rowi * 64 + 4 * n4);
            v4u o; o.x = pk2(cr[0], -ci[0]); o.y = pk2(cr[1], -ci[1]); o.z = pk2(cr[2], -ci[2]); o.w = pk2(cr[3], -ci[3]);
            *(v4u*)((bf16*)(ws + WS_CT) + rowi * 128 + 8 * n4) = o;
        }
        __syncthreads();
    }
    SEAM(0);

    for (int l = 0; l < 4; ++l) {
        const int pb = 1 + 5 * l, j = l >> 1;
        if ((l & 1) == 0) {
            if (EN_QKV && IN(pb)) for (int rp = 0; rp < NREP(3); ++rp) {
                FRESH_PTRS;
                pg8::GemmX g{XB, (const bf16*)(ws + WS_WQKV) + (size_t)j * NQKV * D, nullptr, D}; pg8::StaticOrder S; S.init(MP, NQKV, G, bx);
                pg8::EpiQKV E{Qb, Kb, Vb, ssp, 16, 32, out + O_KP + (size_t)j * 2 * 128 * 256, out + O_VP + (size_t)j * 2 * 128 * 256, out + O_KS + (size_t)j * SB * 128 * 256, out + O_VS + (size_t)j * SB * 128 * 256};
                if (threadIdx.x == 0) *(LAS int*)(L + pg8::RINV_TAB_OFF + 1152) = -1;
                __syncthreads();
                pg8::gemm_phase_x<pg8::EpiQKV, pg8::StaticOrder>(L, g, S, E);
                if (l == 0 && rp == 0 && bx + G >= (MP / 256) * (NQKV / 256) && 2 * G > (MP / 256) * (NQKV / 256)) {
                    FRESH_IDS;
                    const int nwg_ = (MP / 256) * (NQKV / 256), myidx = bx - (nwg_ - G), nidle = 2 * G - nwg_;
                    constexpr int PER = 120 * 256 / 4;
                    for (int slab = myidx; slab < 2 * 2 * SB; slab += nidle) {
                        const int kv = slab >> 8, jb = slab & 255;
                        const f32x4* src = (const f32x4*)(INP(2 + kv) + (size_t)jb * 128 * 256 + 8 * 256) + tid;
                        f32x4* dst = (f32x4*)(out + (kv ? O_VS : O_KS) + (size_t)jb * 128 * 256) + tid;
#pragma unroll 1
                        for (int it = 0; it < 15; it += 5) {
                            f32x4 v[5];
#pragma unroll
                            for (int k = 0; k < 5; ++k) v[k] = src[(it + k) * 512];
#pragma unroll
                            for (int k = 0; k < 5; ++k) dst[(it + k) * 512] = v[k];
                        }
                    }
                }
            }
            SEAM(pb);
            if (EN_ATT && IN(pb + 1)) for (int rp = 0; rp < NREP(1); ++rp) {
                FRESH_IDS; FRESH_PTRS;
                const float* ck = INP(2) + (size_t)j * SB * 128 * 256; const float* cv = INP(3) + (size_t)j * SB * 128 * 256;
                const float* sinks = INP(11) + j * 16;
                const int r32 = lane & 31;
                for (int u = vcu; u < 512 + 256; u += G) {
                    const bool samp = u >= 512;
                    const int hw = wave >> 2, t256 = tid & 255;
                    int kvh, qblk = 0, b;
                    if (!samp) { kvh = u & 3; qblk = (u >> 2) & 63; b = u >> 8; } else { const int us = 2 * (u - 512) + hw; kvh = us & 3; b = us >> 2; }
                    LAS unsigned char* Ks = samp ? L + hw * 56320 : L; LAS unsigned char* Vs = samp ? Ks + 23040 : L + 36864;
                    if (!samp) {
                        v4u kv[4], vv[4];
#pragma unroll
                        for (int c = 0; c < 4; ++c) { const int id = tid + 512 * c, key = id >> 3, ch = id & 7, s_ = qblk * 128 - 128 + key;
                            kv[c] = (v4u){0u, 0u, 0u, 0u}; vv[c] = (v4u){0u, 0u, 0u, 0u};
                            if (s_ >= 0) { const size_t off = (size_t)((b << 13) + s_) * 256 + kvh * 64 + ch * 8; kv[c] = *(const v4u*)(Kb + off); vv[c] = *(const v4u*)(Vb + off); } }
#pragma unroll
                        for (int c = 0; c < 4; ++c) { const int id = tid + 512 * c, key = id >> 3, ch = id & 7;
                            *(LAS v4u*)(Ks + key * 144 + ch * 16) = kv[c];
                            LAS unsigned short* vt = (LAS unsigned short*)(Vs + (ch * 8) * 520 + key * 2);
                            vt[0 * 260] = (unsigned short)(vv[c].x & 0xffffu); vt[1 * 260] = (unsigned short)(vv[c].x >> 16); vt[2 * 260] = (unsigned short)(vv[c].y & 0xffffu); vt[3 * 260] = (unsigned short)(vv[c].y >> 16);
                            vt[4 * 260] = (unsigned short)(vv[c].z & 0xffffu); vt[5 * 260] = (unsigned short)(vv[c].z >> 16); vt[6 * 260] = (unsigned short)(vv[c].w & 0xffffu); vt[7 * 260] = (unsigned short)(vv[c].w >> 16); }
                    } else {
#pragma unroll 1
                    for (int c0 = 0; c0 < 5; c0 += 3) {
                        v4u kv[3], vv[3];
#pragma unroll
                        for (int c = 0; c < 3; ++c) { const int id = t256 + 256 * (c0 + c), key = id >> 3, ch = id & 7;
                            kv[c] = (v4u){0u, 0u, 0u, 0u}; vv[c] = (v4u){0u, 0u, 0u, 0u};
                            if (c0 + c < 5) {
                            if (key < 128) { const size_t off = ((size_t)b * 128 + key) * 256 + kvh * 64 + ch * 8;
                                const f32x4 k0 = *(const f32x4*)(ck + off), k1 = *(const f32x4*)(ck + off + 4), v0 = *(const f32x4*)(cv + off), v1 = *(const f32x4*)(cv + off + 4);
                                kv[c].x = pk2(k0[0], k0[1]); kv[c].y = pk2(k0[2], k0[3]); kv[c].z = pk2(k1[0], k1[1]); kv[c].w = pk2(k1[2], k1[3]);
                                vv[c].x = pk2(v0[0], v0[1]); vv[c].y = pk2(v0[2], v0[3]); vv[c].z = pk2(v1[0], v1[1]); vv[c].w = pk2(v1[2], v1[3]); }
                            else if (key < 136) { const size_t off = (size_t)(MP + b * 8 + (key - 128)) * 256 + kvh * 64 + ch * 8; kv[c] = *(const v4u*)(Kb + off); vv[c] = *(const v4u*)(Vb + off); } } }
#pragma unroll
                        for (int c = 0; c < 3; ++c) if (c0 + c < 5) { const int id = t256 + 256 * (c0 + c), key = id >> 3, ch = id & 7;
                            *(LAS v4u*)(Ks + key * 144 + ch * 16) = kv[c];
                            LAS unsigned short* vt = (LAS unsigned short*)(Vs + (ch * 8) * 520 + key * 2);
                            vt[0 * 260] = (unsigned short)(vv[c].x & 0xffffu); vt[1 * 260] = (unsigned short)(vv[c].x >> 16); vt[2 * 260] = (unsigned short)(vv[c].y & 0xffffu); vt[3 * 260] = (unsigned short)(vv[c].y >> 16);
                            vt[4 * 260] = (unsigned short)(vv[c].z & 0xffffu); vt[5 * 260] = (unsigned short)(vv[c].z >> 16); vt[6 * 260] = (unsigned short)(vv[c].w & 0xffffu); vt[7 * 260] = (unsigned short)(vv[c].w >> 16); }
                    }
                    }
                    __syncthreads();
                    const int ntask = samp ? (((wave & 3) == 0) ? 1 : 0) : 2;
                    for (int ti = 0; ti < ntask; ++ti) {
                        int qrow, head, tloc, kb0, jkmin;
                        if (!samp) { const int sb = 2 * (wave & 1) + ti; head = kvh * 4 + (wave >> 1); tloc = 32 * sb + r32; qrow = (b << 13) + qblk * 128 + tloc; kb0 = sb; jkmin = (qblk == 0) ? 128 : 0; }
                        else { head = kvh * 4 + (r32 >> 3); tloc = r32 & 7; qrow = MP + b * 8 + tloc; kb0 = 0; jkmin = 0; }
                        attn_task(Ks, Vs, Qb, Ob, sinks, qrow, head, tloc, kb0, jkmin, lane);
                    }
                    __syncthreads();
                }
            }
            SEAM(pb + 1);
            if (EN_OPJ && IN(pb + 2)) {
                FRESH_PTRS;
                pg8::GemmX g{Ob, (const bf16*)(ws + WS_WO) + (size_t)j * D * D, nullptr, D}; pg8::StaticOrder S; S.init(MP, D, G, bx);
                pg8::EpiRes E{XB, ssp};
                pg8::gemm_phase_x<pg8::EpiRes, pg8::StaticOrder>(L, g, S, E);
            }
            SEAM(pb + 2);
        } else {
#define SSMT(gg) const SsmT T_{(const bf16*)(ws + WS_BT) + ((size_t)j * NG + (gg)) * 128 * 16, (const bf16*)(ws + WS_CT) + ((size_t)j * NG + (gg)) * 16 * 128, (const float*)(ws + WS_TAB) + ((size_t)j * NG + (gg)) * NS * 4, \
                          INP(19) + (size_t)j * D + (gg) * 16, INP(6) + (size_t)l * D + (gg) * 16}
            if (EN_S1 && IN(pb)) for (int rp = 0; rp < NREP(2); ++rp) {
                FRESH_IDS; FRESH_PTRS; LAS unsigned char* wl = L + wave * 10752; LAS float* rvs = (LAS float*)(L + 8 * 10752);
                for (int u = gw; u < NB * (NCH - 1) * NG; u += NGW) {
                    int lane = tid & 63; asm volatile("" : "+v"(lane));
                    const int g = u & 63, ch = (u >> 6) % (NCH - 1), b = (u >> 6) / (NCH - 1);
                    wg_rinv(rvs, ssp, b * SEQ + ch * CH, CH, 16, tid);
                    SSMT(g);
                    float st[4] = {0.f, 0.f, 0.f, 0.f};
                    ssm_mfma_unit<0>(wl, lane, g, T_, XB, rvs, b * SEQ + ch * CH, CH / 32, st, nullptr, nullptr, nullptr, nullptr, nullptr, 0);
                    if (lane < 32) { float* hs = HS + ((size_t)((b * NCH + ch) * NG + g) * NS) * 2; *(float2*)(hs + 2 * lane) = make_float2(st[0], st[1]); *(float2*)(hs + 2 * (32 + lane)) = make_float2(st[2], st[3]); }
                }
                __syncthreads();
            }
            SEAM(pb);
            if (EN_S3 && IN(pb + 1)) for (int rp = 0; rp < NREP(2); ++rp) {
                FRESH_IDS; FRESH_PTRS; LAS unsigned char* wl = L + wave * 10752; LAS float* rvs = (LAS float*)(L + 8 * 10752);
                for (int u = gw; u < NB * NCH * NG + (SB / 4) * NG; u += NGW) {
                    int lane = tid & 63; asm volatile("" : "+v"(lane));
                    if (u < NB * NCH * NG) {
                        const int g = u & 63, b = u >> 11, ch = b ? (NCH - 1 - ((u >> 6) & (NCH - 1))) : ((u >> 6) & (NCH - 1)), r32 = lane & 31;
                        wg_rinv(rvs, ssp, b * SEQ + ch * CH, CH, 16, tid);
                        SSMT(g);
                        float st[4] = {0.f, 0.f, 0.f, 0.f};
                        float aLr[2], aLi[2];
#pragma unroll
                        for (int p = 0; p < 2; ++p) {
                            const f32x4 tv = *(const f32x4*)(T_.tab + (size_t)(32 * p + r32) * 4);
                            float xr_ = tv[0], xi_ = tv[1];
#pragma unroll
                            for (int sq = 0; sq < 8; ++sq) { const float tr = xr_ * xr_ - xi_ * xi_, ti = 2.0f * xr_ * xi_; xr_ = tr; xi_ = ti; }
                            aLr[p] = xr_; aLi[p] = xi_;
                        }
                        for (int i0 = 0; i0 < ch; i0 += 8) {
                            float2 e[8][2];
#pragma unroll
                            for (int k = 0; k < 8; ++k)
#pragma unroll
                                for (int p = 0; p < 2; ++p) e[k][p] = (i0 + k < ch) ? *(const float2*)(HS + ((size_t)((b * NCH + i0 + k) * NG + g) * NS + 32 * p + r32) * 2) : make_float2(0.f, 0.f);
#pragma unroll
                            for (int k = 0; k < 8; ++k) if (i0 + k < ch) {
#pragma unroll
                                for (int p = 0; p < 2; ++p) { const float tr = aLr[p] * st[2 * p] - aLi[p] * st[2 * p + 1] + e[k][p].x, ti = aLr[p] * st[2 * p + 1] + aLi[p] * st[2 * p] + e[k][p].y; st[2 * p] = tr; st[2 * p + 1] = ti; }
                            }
                        }
                        ssm_mfma_unit<1>(wl, lane, g, T_, XB, rvs, b * SEQ + ch * CH, CH / 32, st, Ob, nullptr, nullptr, nullptr, nullptr, 0);
                        if (ch == NCH - 1 && lane < 32) { float* hr_o = out + O_HRP + ((size_t)(j * NB + b) * NG + g) * NS; float* hi_o = out + O_HIP + ((size_t)(j * NB + b) * NG + g) * NS;
                            hr_o[lane] = st[0]; hi_o[lane] = st[1]; hr_o[32 + lane] = st[2]; hi_o[32 + lane] = st[3]; }
                    } else {
                        const int us = u - NB * NCH * NG, g = us & 63, bb = us >> 6;
                        wg_rinv(rvs, ssp, MP + bb * 32, 32, 32, tid);
                        SSMT(g);
                        float st[4] = {0.f, 0.f, 0.f, 0.f};
                        ssm_mfma_unit<2>(wl, lane, g, T_, XB, rvs, MP + bb * 32, 1, st, Ob, INP(4) + (size_t)j * SB * NG * NS, INP(5) + (size_t)j * SB * NG * NS, out + O_HRS + (size_t)j * SB * NG * NS, out + O_HIS + (size_t)j * SB * NG * NS, bb * 4);
                    }
                }
                __syncthreads();
            }
            SEAM(pb + 1);
            if (EN_GLU && IN(pb + 2)) {
                FRESH_PTRS;
                pg8::GemmX g{Ob, (const bf16*)(ws + WS_WGLU) + (size_t)j * 2 * D * D, nullptr, D}; pg8::StaticOrder S; S.init(MP, 2 * D, G, bx);
                pg8::EpiGlu E{XB, ssp};
                pg8::gemm_phase_x<pg8::EpiGlu, pg8::StaticOrder>(L, g, S, E);
            }
            SEAM(pb + 2);
        }
        if (EN_UP && IN(pb + 3)) for (int rp = 0; rp < NREP(4); ++rp) {
            FRESH_PTRS;
            pg8::GemmX g{XB, (const bf16*)(ws + WS_WUP) + (size_t)l * FF * D, nullptr, D}; pg8::StaticOrder S; S.init(MP, FF, G, bx);
            pg8::EpiUp E{Hb, (bf16*)(ws + WS_H + 128 * MiB), ssp, (l & 1) ? 32 : 16, (l & 1) ? 64 : 32};
            if (threadIdx.x == 0) *(LAS int*)(L + pg8::RINV_TAB_OFF + 1152) = -1;
            __syncthreads();
            pg8::gemm_phase_x<pg8::EpiUp, pg8::StaticOrder, NREP(5), NREP(6), 0>(L, g, S, E);
        }
        SEAM(pb + 3);
        if (EN_DN && IN(pb + 4)) {
            FRESH_PTRS;
            pg8::GemmX g{Hb, (const bf16*)(ws + WS_WDN) + (size_t)l * D * FF, (const bf16*)(ws + WS_H + 128 * MiB), FF}; pg8::StaticOrder S; S.init(MP, D, G, bx);
            pg8::EpiRes E{XB, ssp};
            pg8::gemm_phase_x<pg8::EpiRes, pg8::StaticOrder, 1, 1, 0, true>(L, g, S, E);
        }
        SEAM(pb + 4);
    }
    if (EN_FIN && IN(21)) {
        FRESH_IDS; FRESH_PTRS;
        const float* gf = INP(8);
        for (int m = gw; m < M; m += NGW) {
            const float pv = (lane < ((m < MP) ? 16 : 32)) ? ssp[(size_t)m * 64 + lane] : 0.f;
            const float rinv = rsqrtf(wave_sum(pv) * (1.0f / 1024.0f) + 1e-6f);
            const bf16* xb = XB + (size_t)m * D + 4 * lane; float* yo = out + (size_t)m * D + 4 * lane;
#pragma unroll
            for (int jx = 0; jx < 4; ++jx) { const f32x4 gv = *(const f32x4*)(gf + 256 * jx + 4 * lane); const f32x4 v = pg8::unpack4(*(const u32x2*)(xb + 256 * jx)) * rinv * gv; *(f32x4*)(yo + 256 * jx) = v; }
        }
    }
#undef IN
#undef SEAM
}

#ifndef MK_SPLIT
#define MK_SPLIT 0
#endif
extern "C" void kernel_launch(void* const* d_in, const int* in_sizes, int n_in, void* d_out, int out_size, void* d_ws, size_t ws_size, hipStream_t stream) {
    static int grid = 0;
    if (grid == 0) {
        if (n_in != 23 || in_sizes[0] != MP * D || (size_t)out_size != O_END || ws_size < WS_END) { fprintf(stderr, "kernel_launch: unexpected shapes (n_in %d, in0 %d, out %d, ws %zu); nothing launched\n", n_in, n_in > 0 ? in_sizes[0] : -1, out_size, ws_size); grid = -1; return; }
        int dev = 0, cus = 0, per_cu = 0;
        if (hipGetDevice(&dev) != hipSuccess || hipDeviceGetAttribute(&cus, hipDeviceAttributeMultiprocessorCount, dev) != hipSuccess) { fprintf(stderr, "kernel_launch: device query failed\n"); grid = -1; return; }
        if (hipFuncSetAttribute((const void*)fwd_kernel, hipFuncAttributeMaxDynamicSharedMemorySize, LDS_BYTES) != hipSuccess) { fprintf(stderr, "kernel_launch: hipFuncSetAttribute failed\n"); grid = -1; return; }
        if (hipOccupancyMaxActiveBlocksPerMultiprocessor(&per_cu, (const void*)fwd_kernel, 512, LDS_BYTES) != hipSuccess || per_cu < 1) fprintf(stderr, "kernel_launch: note: occupancy query reports %d blocks per CU\n", per_cu);
        (void)hipGetLastError();
        grid = cus;
    }
    if (grid < 0) return;
    (void)hipMemsetAsync((char*)d_ws + WS_CTL, 0, CTL_ZERO_BYTES, stream);
    Args a{};
    for (int i = 0; i < 23; ++i) a.in[i] = (const float*)d_in[i];
    a.out = (float*)d_out; a.ws = (unsigned char*)d_ws;
#if MK_SPLIT
    for (int p = 0; p < NPHASE; ++p) { a.ph_lo = p; a.ph_hi = p + 1; hipLaunchKernelGGL(fwd_kernel, dim3(grid), dim3(512), LDS_BYTES, stream, a); }
#else
    a.ph_lo = 0; a.ph_hi = NPHASE; hipLaunchKernelGGL(fwd_kernel, dim3(grid), dim3(512), LDS_BYTES, stream, a);
#endif
}
```

```cpp
#include <hip/hip_runtime.h>
#include <cstdio>
#include <cstdint>
namespace pg8 {
#define PG8_LAS __attribute__((address_space(3)))
typedef unsigned short bf16_t;
typedef short bf16x8 __attribute__((ext_vector_type(8)));
typedef float f32x4 __attribute__((ext_vector_type(4)));
typedef unsigned u32x4 __attribute__((ext_vector_type(4)));
constexpr int BM = 256, BK = 64, HALF = 128, HTB = HALF * BK * 2  , STAGE_BYTES = 8 * HTB, NXCD = 8, WGM = 8;

__host__ __device__ __forceinline__ int lds_byte(int r, int c) { const int st = (r >> 4) * 2 + (c >> 5), rr = r & 15, cc = c & 31, ob = rr * 64 + cc * 2; return st * 1024 + (ob ^ (((ob >> 9) & 1) << 5)); }
__host__ __device__ __forceinline__ void stage_rc(int b, int& R, int& C) { const int st = b / 1024, sb = b % 1024, swz = sb ^ (((sb >> 9) & 1) << 5); R = (st >> 1) * 16 + swz / 64; C = (st & 1) * 32 + (swz % 64) / 2; }
__host__ __device__ __forceinline__ int perm32(int rho) { const int n = rho >> 4, i = rho & 15; return 8 * (i >> 2) + 4 * n + (i & 3); }

struct Unit { int pm, pn; };
struct Gemm { const bf16_t* A; const bf16_t* Bt; int M, N, K; };

struct StaticOrder {
    int nM, nN, nwg, G, c;
    __host__ __device__ void init(int M, int N, int G_, int c_) { nM = M / BM; nN = N / BM; nwg = nM * nN; G = G_; c = c_; }
    __host__ __device__ bool next(int i, Unit& u) const {
        const long L = (long)i * G + c; if (L >= nwg) return false;
        int wgid = (int)L; { const int q = nwg / NXCD, r = nwg % NXCD, xcd = wgid % NXCD, off = wgid / NXCD; wgid = (xcd < r ? xcd * (q + 1) : r * (q + 1) + (xcd - r) * q) + off; }
        const int nig = WGM * nN, gid = wgid / nig, fm = gid * WGM, gsz = (nM - fm) < WGM ? (nM - fm) : WGM;
        u.pm = fm + ((wgid % nig) % gsz); u.pn = (wgid % nig) / gsz; return true;
    }
    __device__ __forceinline__ void a_ready(const Unit&) const {}
    __device__ __forceinline__ void done(const Unit&) const {}
};
__device__ __forceinline__ unsigned cvt_pk_bf16(float lo, float hi) { unsigned r; asm volatile("v_cvt_pk_bf16_f32 %0, %1, %2" : "=v"(r) : "v"(lo), "v"(hi)); return r; }
typedef float f32x2 __attribute__((ext_vector_type(2)));
template <class Epi, class Sched, bool ALIGN_EPI = false, bool SP2 = false>
__device__ __forceinline__ void gemm_phase(PG8_LAS unsigned char* lds, const Gemm g, const Sched& S, const Epi& E) {
    int tid_ = threadIdx.x; asm volatile("" : "+v"(tid_));
    const int tid = tid_, wid = __builtin_amdgcn_readfirstlane(tid >> 6), lane = tid & 63, wr = wid >> 2, wc = wid & 3, fr = lane & 15, fq = lane >> 4;
    const int K = g.K, nt = K / BK;
    unsigned voffA[2], voffB[2];
#pragma unroll
    for (int i = 0; i < 2; ++i) { int R, C; stage_rc(tid * 16 + i * 8192, R, C); const int Rb = Epi::PERM ? ((R & ~31) + perm32(R & 31)) : R;
        voffA[i] = (unsigned)(R * K + C) * 2u; voffB[i] = (unsigned)(Rb * K + C) * 2u; }
    const size_t kstep = (size_t)(BK * 2);
    const size_t hstep = (size_t)HALF * K * 2;
    const size_t tstep = 2 * hstep;
    const unsigned ldsw = (unsigned)wid * 1024u;
    const int aoff = lds_byte(wr * 64 + fr, fq * 8), boff = lds_byte(wc * 32 + fr, fq * 8);
#define PG8_SA(b, h) (((b) * 2 + (h)) * HTB)
#define PG8_SB(b, h) ((4 + (b) * 2 + (h)) * HTB)
#define PG8_STAGE(bufoff, gbase, voff) do { _Pragma("unroll") for (int _i = 0; _i < 2; ++_i) \
        __builtin_amdgcn_global_load_lds((const unsigned*)((const char*)(gbase) + (voff)[_i]), (PG8_LAS unsigned*)(lds + (bufoff) + ldsw + _i * 8192), 16, 0, 0); } while (0)
#define PG8_LDA(dst, b, h) do { _Pragma("unroll") for (int m = 0; m < 4; ++m) _Pragma("unroll") for (int k = 0; k < 2; ++k) dst[m][k] = *(const PG8_LAS bf16x8*)(lds + PG8_SA(b, h) + aoff + m * 2048 + k * 1024); } while (0)
#define PG8_LDB(dst, b, h) do { _Pragma("unroll") for (int n = 0; n < 2; ++n) _Pragma("unroll") for (int k = 0; k < 2; ++k) dst[n][k] = *(const PG8_LAS bf16x8*)(lds + PG8_SB(b, h) + boff + n * 2048 + k * 1024); } while (0)
#define PG8_MMA(ai, bj, At, Bt) do { __builtin_amdgcn_s_setprio(1); _Pragma("unroll") for (int m = 0; m < 4; ++m) _Pragma("unroll") for (int n = 0; n < 2; ++n) _Pragma("unroll") for (int k = 0; k < 2; ++k) \
        acc[ai][bj][m][n] = __builtin_amdgcn_mfma_f32_16x16x32_bf16(Bt[n][k], At[m][k], acc[ai][bj][m][n], 0, 0, 0); __builtin_amdgcn_s_setprio(0); } while (0)
#define PG8_WAIT_V(n) asm volatile("s_waitcnt vmcnt(" #n ")" ::: "memory")
#define PG8_WAIT_L(n) asm volatile("s_waitcnt lgkmcnt(" #n ")" ::: "memory")
#define PG8_BAR __builtin_amdgcn_s_barrier()
#define PG8_SCHED __builtin_amdgcn_sched_barrier(0)
    Unit cur, nxt; int ui = 0;
    if (!S.next(0, cur)) return;
    f32x4 acc[2][2][4][2];
#pragma unroll
    for (int a = 0; a < 2; ++a)
#pragma unroll
        for (int b = 0; b < 2; ++b)
#pragma unroll
            for (int m = 0; m < 4; ++m)
#pragma unroll
                for (int n = 0; n < 2; ++n) acc[a][b][m][n] = (f32x4){0.f, 0.f, 0.f, 0.f};
    bf16x8 At[4][2], B0[2][2], B1[2][2];
    const char* cA = (const char*)g.A + (size_t)cur.pm * tstep; const char* cB = (const char*)g.Bt + (size_t)cur.pn * tstep;
    S.a_ready(cur);
    if constexpr (SP2) {
        PG8_STAGE(PG8_SB(0, 0), cB, voffB); PG8_STAGE(PG8_SB(0, 1), cB + hstep, voffB); PG8_STAGE(PG8_SA(0, 0), cA, voffA); PG8_STAGE(PG8_SA(0, 1), cA + hstep, voffA);
        if (wr == 1) PG8_BAR;
        PG8_WAIT_V(2); PG8_BAR;
        PG8_STAGE(PG8_SB(1, 0), cB + kstep, voffB); PG8_STAGE(PG8_SA(1, 0), cA + kstep, voffA); PG8_STAGE(PG8_SB(1, 1), cB + hstep + kstep, voffB);
        PG8_WAIT_V(6); PG8_BAR;
    } else {
        PG8_STAGE(PG8_SB(0, 0), cB, voffB); PG8_STAGE(PG8_SA(0, 0), cA, voffA); PG8_STAGE(PG8_SB(0, 1), cB + hstep, voffB); PG8_STAGE(PG8_SA(0, 1), cA + hstep, voffA);
        if (wr == 1) PG8_BAR;
        PG8_WAIT_V(4); PG8_BAR;
        PG8_STAGE(PG8_SB(1, 0), cB + kstep, voffB); PG8_STAGE(PG8_SA(1, 0), cA + kstep, voffA); PG8_STAGE(PG8_SB(1, 1), cB + hstep + kstep, voffB);
        PG8_WAIT_V(6); PG8_BAR;
    }
    for (;;) {
        const bool has_next = S.next(ui + 1, nxt);
        const char* nA = has_next ? (const char*)g.A + (size_t)nxt.pm * tstep : cA; const char* nB = has_next ? (const char*)g.Bt + (size_t)nxt.pn * tstep : cB;
        for (int t = 0; t < nt; t += 2) {
            const bool last = (t == nt - 2);
            const char* a1 = cA + (size_t)(t + 1) * kstep;
            const char* a2 = last ? nA : cA + (size_t)(t + 2) * kstep; const char* b2 = last ? nB : cB + (size_t)(t + 2) * kstep;
            const char* a3 = a2 + kstep; const char* b3 = b2 + kstep;
            if (last && has_next) S.a_ready(nxt);
            if constexpr (SP2) {
            PG8_LDB(B0, 0, 0); PG8_LDB(B1, 0, 1); PG8_SCHED; PG8_LDA(At, 0, 0); PG8_STAGE(PG8_SA(1, 1), a1 + hstep, voffA);
            PG8_WAIT_V(8); PG8_WAIT_L(0); PG8_BAR; PG8_MMA(0, 0, At, B0); PG8_MMA(0, 1, At, B1); PG8_BAR; PG8_SCHED;
            PG8_LDA(At, 0, 1); PG8_STAGE(PG8_SB(0, 0), b2, voffB); PG8_STAGE(PG8_SB(0, 1), b2 + hstep, voffB); PG8_STAGE(PG8_SA(0, 0), a2, voffA);
            PG8_WAIT_V(8); PG8_WAIT_L(0); PG8_BAR; PG8_MMA(1, 0, At, B0); PG8_MMA(1, 1, At, B1); PG8_BAR; PG8_SCHED;
            PG8_LDB(B0, 1, 0); PG8_LDB(B1, 1, 1); PG8_SCHED; PG8_LDA(At, 1, 0); PG8_STAGE(PG8_SA(0, 1), a2 + hstep, voffA);
            PG8_WAIT_V(8); PG8_WAIT_L(0); PG8_BAR; PG8_MMA(0, 0, At, B0); PG8_MMA(0, 1, At, B1); PG8_BAR; PG8_SCHED;
            PG8_LDA(At, 1, 1); PG8_STAGE(PG8_SB(1, 0), b3, voffB); PG8_STAGE(PG8_SB(1, 1), b3 + hstep, voffB); PG8_STAGE(PG8_SA(1, 0), a3, voffA);
            PG8_WAIT_V(8); PG8_WAIT_L(0); PG8_BAR; PG8_MMA(1, 0, At, B0); PG8_MMA(1, 1, At, B1); PG8_BAR; PG8_SCHED;
            } else {
            PG8_LDB(B0, 0, 0); PG8_SCHED; PG8_LDA(At, 0, 0); PG8_STAGE(PG8_SA(1, 1), a1 + hstep, voffA);
            PG8_WAIT_L(8); PG8_BAR; PG8_WAIT_L(0); PG8_MMA(0, 0, At, B0); PG8_BAR; PG8_SCHED;
            PG8_LDB(B1, 0, 1); PG8_STAGE(PG8_SB(0, 0), b2, voffB);
            PG8_BAR; PG8_WAIT_L(0); PG8_MMA(0, 1, At, B1); PG8_BAR;
            PG8_LDA(At, 0, 1); PG8_STAGE(PG8_SA(0, 0), a2, voffA);
            PG8_BAR; PG8_WAIT_L(0); PG8_MMA(1, 0, At, B0); PG8_BAR; PG8_SCHED;
            PG8_STAGE(PG8_SB(0, 1), b2 + hstep, voffB);
            PG8_WAIT_V(6); PG8_BAR; PG8_MMA(1, 1, At, B1); PG8_BAR;
            PG8_LDB(B0, 1, 0); PG8_SCHED; PG8_LDA(At, 1, 0); PG8_STAGE(PG8_SA(0, 1), a2 + hstep, voffA);
            PG8_WAIT_L(8); PG8_BAR; PG8_WAIT_L(0); PG8_MMA(0, 0, At, B0); PG8_BAR; PG8_SCHED;
            PG8_LDB(B1, 1, 1); PG8_STAGE(PG8_SB(1, 0), b3, voffB);
            PG8_BAR; PG8_WAIT_L(0); PG8_MMA(0, 1, At, B1); PG8_BAR;
            PG8_LDA(At, 1, 1); PG8_STAGE(PG8_SA(1, 0), a3, voffA);
            PG8_BAR; PG8_WAIT_L(0); PG8_MMA(1, 0, At, B0); PG8_BAR; PG8_SCHED;
            PG8_STAGE(PG8_SB(1, 1), b3 + hstep, voffB);
            PG8_WAIT_V(6); PG8_BAR; PG8_MMA(1, 1, At, B1); PG8_BAR;
            }
        }
        if constexpr (ALIGN_EPI) { if (wr == 0) PG8_BAR; }
        if constexpr (!Epi::AFTER_DRAIN) { E(acc, cur, wr, wc, fr, fq); S.done(cur); }
        if (!has_next) break;
#pragma unroll
        for (int a = 0; a < 2; ++a)
#pragma unroll
            for (int b = 0; b < 2; ++b)
#pragma unroll
                for (int m = 0; m < 4; ++m)
#pragma unroll
                    for (int n = 0; n < 2; ++n) acc[a][b][m][n] = (f32x4){0.f, 0.f, 0.f, 0.f};
        cur = nxt; cA = nA; cB = nB; ++ui;
        if constexpr (ALIGN_EPI) { if (wr == 1) PG8_BAR; }
    }
    PG8_WAIT_V(0);
    if constexpr (!ALIGN_EPI) { if (wr == 0) PG8_BAR; }
    PG8_BAR;
    if constexpr (Epi::AFTER_DRAIN) { E.fused(acc, cur, wr, wc, fr, fq, lds, wid, lane); S.done(cur); }
#undef PG8_SA
#undef PG8_SB
#undef PG8_STAGE
#undef PG8_LDA
#undef PG8_LDB
#undef PG8_MMA
#undef PG8_WAIT_V
#undef PG8_WAIT_L
#undef PG8_BAR
#undef PG8_SCHED
}
}
#define GAS __attribute__((address_space(1)))
#define LAS __attribute__((address_space(3)))
typedef unsigned short bf16;
typedef unsigned v4u __attribute__((ext_vector_type(4)));
typedef float f32x4 __attribute__((ext_vector_type(4)));
typedef short bf16x8 __attribute__((ext_vector_type(8)));
typedef GAS unsigned gu32;
typedef GAS unsigned long long gu64;
#define RLX_AGENT __ATOMIC_RELAXED, __HIP_MEMORY_SCOPE_AGENT
#define LDS_WAIT() asm volatile("s_waitcnt lgkmcnt(0)" ::: "memory")
#define VM_WAIT() asm volatile("s_waitcnt vmcnt(0)" ::: "memory")
__device__ __forceinline__ unsigned long long rt() { return __builtin_amdgcn_s_memrealtime(); }
__device__ __forceinline__ unsigned f2bf(float f) { unsigned u = __builtin_bit_cast(unsigned, f); return (u + 0x7fffu + ((u >> 16) & 1u)) >> 16; }
__device__ __forceinline__ unsigned pk2(float lo, float hi) { return f2bf(lo) | (f2bf(hi) << 16); }
#define XB_TMO      128
#define XB_XCNT(j)  (256  + 64 * (j))
#define XB_XSUB(j)  (1280 + 64 * (j))
#define XB_XGEN(j)  (2304 + 64 * (j))
#define XB_TOP      3328
#define XB_TOPGEN   3392
#define XCD_BAR_WORDS 3456
#define XB_SPIN_CAP (1u << 18)

__device__ __forceinline__ unsigned xb_ld(unsigned* p)              { return __hip_atomic_load(p, __ATOMIC_RELAXED, __HIP_MEMORY_SCOPE_AGENT); }
__device__ __forceinline__ unsigned xb_add(unsigned* p, unsigned v) { return __hip_atomic_fetch_add(p, v, __ATOMIC_RELAXED, __HIP_MEMORY_SCOPE_AGENT); }
__device__ __forceinline__ unsigned xb_xcc_id() { return (unsigned)__builtin_amdgcn_s_getreg((3 << 11) | 20) & 0xFu; }
#define XB_SPIN(cond, bar) do { unsigned _sp = 0; while (cond) { __builtin_amdgcn_s_sleep(1); \
    if ((++_sp & 255u) == 0u) { if (xb_ld(&(bar)[XB_TMO])) break; if (_sp > XB_SPIN_CAP) { atomicAdd(&(bar)[XB_TMO], 1u); break; } } } } while (0)

struct XcdBarrier {
    unsigned* bar; unsigned x;
    volatile LAS unsigned* st;
};

__device__ __forceinline__ XcdBarrier xcd_barrier_post(unsigned* bar, volatile LAS unsigned* st) {
    XcdBarrier b; b.bar = bar; b.x = xb_xcc_id(); b.st = st;
    if (threadIdx.x == 0) (void)xb_add(&bar[XB_XCNT(b.x)], 1u);
    return b;
}
__device__ __forceinline__ void xcd_barrier_complete(unsigned* bar, unsigned x, unsigned& nloc, unsigned& nx) {
    const unsigned G = gridDim.x * gridDim.y * gridDim.z;
    unsigned sum, cnt, mine, sp = 0u;
    for (;;) {
        sum = 0u; cnt = 0u; mine = 0u;
#pragma unroll
        for (unsigned j = 0; j < 16; ++j) { const unsigned c = xb_ld(&bar[XB_XCNT(j)]); sum += c; cnt += (c > 0u) ? 1u : 0u; mine = (j == x) ? c : mine; }
        if (sum == G) break;
        __builtin_amdgcn_s_sleep(1);
        if ((++sp & 255u) == 0u) { if (xb_ld(&bar[XB_TMO])) break; if (sp > XB_SPIN_CAP) { atomicAdd(&bar[XB_TMO], 1u); break; } }
    }
    nloc = mine > 0u ? mine : 1u; nx = cnt > 0u ? cnt : 1u;
}

__device__ __forceinline__ void xcd_barrier(const XcdBarrier& b) {
    asm volatile("s_waitcnt vmcnt(0)" ::: "memory");
    __syncthreads();
    if (threadIdx.x == 0) {
        unsigned* bar = b.bar;
        __builtin_amdgcn_s_waitcnt(0);
        unsigned nloc = b.st[0], nx = b.st[1];
        if (nloc == 0u) { xcd_barrier_complete(bar, b.x, nloc, nx); b.st[0] = nloc; b.st[1] = nx; }
        const unsigned old = xb_add(&bar[XB_XSUB(b.x)], 1u);
        const unsigned gen = old / nloc;
        if (old + 1u == (gen + 1u) * nloc) {
            __builtin_amdgcn_fence(__ATOMIC_RELEASE, "agent");
            asm volatile("s_waitcnt vmcnt(0)" ::: "memory");
            const unsigned og = xb_add(&bar[XB_TOP], 1u);
            const unsigned tg = og / nx;
            if (og + 1u == (tg + 1u) * nx) xb_add(&bar[XB_TOPGEN], 1u);
            else XB_SPIN(xb_ld(&bar[XB_TOPGEN]) == tg, bar);
            __builtin_amdgcn_fence(__ATOMIC_ACQUIRE, "agent");
            xb_add(&bar[XB_XGEN(b.x)], 1u);
            asm volatile("s_waitcnt vmcnt(0)" ::: "memory");
        } else {
            XB_SPIN(xb_ld(&bar[XB_XGEN(b.x)]) == gen, bar);
            __builtin_amdgcn_fence(__ATOMIC_ACQUIRE, "agent");
            asm volatile("s_waitcnt vmcnt(0)" ::: "memory");
        }
    }
    __syncthreads();
}

constexpr int D = 1024, SEQ = 8192, NB = 2, MP = NB * SEQ, SB = 128, ST = 8, MS = SB * ST, M = MP + MS;
constexpr int NQKV = 1536, FF = 4096, NKV = 4, HD = 64, KVW = NKV * HD, NG = 64, GC = 16, NS = 64;
constexpr int CH = 256, NCH = SEQ / CH;
constexpr int NPHASE = 22;
constexpr size_t O_KP = 17825792, O_VP = 17956864, O_HRP = 18087936, O_HIP = 18104320, O_KS = 18120704, O_VS = 26509312, O_HRS = 34897920, O_HIS = 35946496, O_END = 36995072;
constexpr size_t MiB = 1u << 20;
constexpr size_t WS_CTL = 0, CTL_ZERO_BYTES = 64 * 1024;
constexpr size_t WS_SSP = 1 * MiB;
constexpr size_t WS_TAB = 5 * MiB + 512 * 1024;
constexpr size_t WS_HS = 6 * MiB;
constexpr size_t WS_WQKV = 8 * MiB, WS_WO = 14 * MiB, WS_WGLU = 18 * MiB, WS_WUP = 26 * MiB, WS_WDN = 58 * MiB;
constexpr size_t WS_XB = 90 * MiB;
constexpr size_t WS_H = 124 * MiB;
constexpr size_t WS_Q = 124 * MiB, WS_K = 158 * MiB, WS_V = 167 * MiB, WS_O = 176 * MiB;
constexpr size_t WS_BT = 260 * MiB, WS_CT = 261 * MiB;
constexpr size_t WS_END = 262 * MiB;
constexpr int CW_BAR = 4096;
static_assert((CW_BAR + XCD_BAR_WORDS) * 4 <= (int)CTL_ZERO_BYTES, "barrier words inside the memset region");
constexpr int RING_BYTES = 131072, XA_BYTES = 4096, LDSCTL_OFF = RING_BYTES + XA_BYTES  , MISC_OFF = LDSCTL_OFF + 320, LDS_BYTES = 147456;

__device__ __forceinline__ float wave_sum(float v) {
#pragma unroll
    for (int o = 1; o < 64; o <<= 1) v += __shfl_xor(v, o);
    return v;
}
__device__ __forceinline__ float wave_max(float v) {
#pragma unroll
    for (int o = 1; o < 64; o <<= 1) v = fmaxf(v, __shfl_xor(v, o));
    return v;
}
__device__ __forceinline__ float bf_lo(unsigned u) { return __uint_as_float(u << 16); }
__device__ __forceinline__ float bf_hi(unsigned u) { return __uint_as_float(u & 0xffff0000u); }

namespace pg8 {
constexpr int XMP = 16384;
template <int NL>
__device__ __forceinline__ float row_rinv(const float* ssp, int row, int np, int fq) {
    const float* p = ssp + (size_t)row * 64 + (np >> 2) * fq;
    f32x4 v[NL];
#pragma unroll
    for (int i = 0; i < NL; ++i) v[i] = *(const f32x4*)(p + 4 * i);
    float s = 0.f, s2 = 0.f;
#pragma unroll
    for (int i = 0; i < NL / 2; ++i) { s += (v[i][0] + v[i][1]) + (v[i][2] + v[i][3]); s2 += (v[NL / 2 + i][0] + v[NL / 2 + i][1]) + (v[NL / 2 + i][2] + v[NL / 2 + i][3]); }
    s += (np == 16 * NL) ? s2 : 0.f;
    s += __shfl_xor(s, 16); s += __shfl_xor(s, 32);
    return rsqrtf(s * (1.0f / 1024.0f) + 1e-6f);
}
constexpr int RINV_TAB_OFF = 135680;
__device__ __forceinline__ void unit_rinv_to_lds(PG8_LAS unsigned char* lds, const float* ssp, int pm, int np, int nps) {
    int t = threadIdx.x; asm volatile("" : "+v"(t));
    PG8_LAS float* tab = (PG8_LAS float*)(lds + RINV_TAB_OFF);
    if (t < 288) {
        const bool smp = t >= 256; const int hf = smp ? ((t - 256) >> 4) : 0;
        const int row = smp ? XMP + pm * 16 + (t & 15) : pm * BM + t; const int n = (smp ? nps : np) - 32 * hf;
        const float* p = ssp + (size_t)row * 64 + 32 * hf;
        f32x4 v[8];
#pragma unroll
        for (int i = 0; i < 8; ++i) v[i] = *(const f32x4*)(p + 4 * i);
        float s = 0.f;
#pragma unroll
        for (int i = 0; i < 8; ++i) { const float si = (v[i][0] + v[i][1]) + (v[i][2] + v[i][3]); s += (4 * i < n) ? si : 0.f; }
        if (smp) s += __shfl_xor(s, 16);
        if (t < 272) tab[t] = rsqrtf(s * (1.0f / 1024.0f) + 1e-6f);
    }
    asm volatile("s_waitcnt lgkmcnt(0)" ::: "memory"); __builtin_amdgcn_s_barrier(); asm volatile("" ::: "memory");
}
__device__ __forceinline__ u32x4 pack8(const f32x4 a, const f32x4 b) { u32x4 w; w.x = cvt_pk_bf16(a[0], a[1]); w.y = cvt_pk_bf16(a[2], a[3]); w.z = cvt_pk_bf16(b[0], b[1]); w.w = cvt_pk_bf16(b[2], b[3]); return w; }
typedef unsigned u32x2 __attribute__((ext_vector_type(2)));
__device__ __forceinline__ u32x2 pack4(const f32x4 a) { u32x2 w; w.x = cvt_pk_bf16(a[0], a[1]); w.y = cvt_pk_bf16(a[2], a[3]); return w; }
__device__ __forceinline__ float sumsq4(const f32x4 v) { return (v[0] * v[0] + v[1] * v[1]) + (v[2] * v[2] + v[3] * v[3]); }

struct EpiQKV {
    static constexpr bool PERM = true, AFTER_DRAIN = false;
    bf16_t *Q, *K, *V; const float* ssp; int np, nps; float *kp, *vp, *ks, *vs;
    __device__ __forceinline__ void operator()(const f32x4 (&acc)[2][2][4][2], const f32x4 (&accx)[2], const Unit& u, int wr, int wc, int fr, int fq, PG8_LAS unsigned char* lds) const {
        const int rowb = u.pm * BM + wr * 64 + fr, pn = u.pn;
        { PG8_LAS int* lastpm = (PG8_LAS int*)(lds + RINV_TAB_OFF + 1088 + 64);
          if (*lastpm != u.pm) { unit_rinv_to_lds(lds, ssp, u.pm, np, nps); if (threadIdx.x == 0) *lastpm = u.pm; } }
        float rr[2][4];
        { const PG8_LAS float* tab = (const PG8_LAS float*)(lds + RINV_TAB_OFF);
#pragma unroll
          for (int ai = 0; ai < 2; ++ai)
#pragma unroll
              for (int m = 0; m < 4; ++m) rr[ai][m] = tab[ai * HALF + wr * 64 + m * 16 + fr]; }
        const float rx = ((const PG8_LAS float*)(lds + RINV_TAB_OFF))[256 + fr];
#pragma unroll
        for (int ai = 0; ai < 2; ++ai)
#pragma unroll
            for (int m = 0; m < 4; ++m) {
                const int row = rowb + ai * HALF + m * 16;
                const float r = rr[ai][m];
#pragma unroll
                for (int bj = 0; bj < 2; ++bj) {
                    const f32x4 v0 = acc[ai][bj][m][0] * r, v1 = acc[ai][bj][m][1] * r;
                    const int cl = bj * HALF + wc * 32 + 8 * fq;
                    const u32x4 w = pack8(v0, v1);
                    if (pn < 4) { *(u32x4*)(Q + (size_t)row * 1024 + pn * 256 + cl) = w; }
                    else {
                        bf16_t* B = (pn == 4) ? K : V;
                        *(u32x4*)(B + (size_t)row * 256 + cl) = w;
                        const int t = row & 8191;
                        if (t >= 8064) { float* o = ((pn == 4) ? kp : vp) + ((size_t)(row >> 13) * 128 + (t - 8064)) * 256 + cl; *(f32x4*)o = v0; *(f32x4*)(o + 4) = v1; }
                    }
                }
            }
        {
            const int xrow = u.pm * 16 + fr, row = XMP + xrow;
            const float r = rx;
#pragma unroll
            for (int bj = 0; bj < 2; ++bj) {
                const f32x4 v = accx[bj] * r;
                const int cl = bj * HALF + wc * 32 + 8 * fq + 4 * wr;
                const u32x2 w = pack4(v);
                if (pn < 4) { *(u32x2*)(Q + (size_t)row * 1024 + pn * 256 + cl) = w; }
                else {
                    bf16_t* B = (pn == 4) ? K : V;
                    *(u32x2*)(B + (size_t)row * 256 + cl) = w;
                    float* o = ((pn == 4) ? ks : vs) + ((size_t)(xrow >> 3) * 128 + 120 + (xrow & 7)) * 256 + cl; *(f32x4*)o = v;
                }
            }
        }
    }
};
__device__ __forceinline__ void unpack8(const u32x4 w, f32x4& a, f32x4& b) {
    a[0] = __uint_as_float(w.x << 16); a[1] = __uint_as_float(w.x & 0xffff0000u); a[2] = __uint_as_float(w.y << 16); a[3] = __uint_as_float(w.y & 0xffff0000u);
    b[0] = __uint_as_float(w.z << 16); b[1] = __uint_as_float(w.z & 0xffff0000u); b[2] = __uint_as_float(w.w << 16); b[3] = __uint_as_float(w.w & 0xffff0000u); }
__device__ __forceinline__ f32x4 unpack4(const u32x2 w) { f32x4 a; a[0] = __uint_as_float(w.x << 16); a[1] = __uint_as_float(w.x & 0xffff0000u); a[2] = __uint_as_float(w.y << 16); a[3] = __uint_as_float(w.y & 0xffff0000u); return a; }
struct EpiRes {
    static constexpr bool PERM = true, AFTER_DRAIN = false;
    bf16_t* XB; float* ssp;
    __device__ __forceinline__ void operator()(const f32x4 (&acc)[2][2][4][2], const f32x4 (&accx)[2], const Unit& u, int wr, int wc, int fr, int fq, PG8_LAS unsigned char* lds) const {
        const int rowb = u.pm * BM + wr * 64 + fr, pn = u.pn;
        const int colb = pn * 256 + wc * 32 + 8 * fq;
        const int xrow = u.pm * 16 + fr;
        bf16_t* xbx = XB + (size_t)(XMP + xrow) * 1024 + colb + 4 * wr;
        u32x2 ox[2];
#pragma unroll
        for (int bj = 0; bj < 2; ++bj) ox[bj] = *(const u32x2*)(xbx + bj * HALF);
#pragma unroll
        for (int am = 0; am < 8; am += 4) {
            u32x4 o[4][2];
#pragma unroll
            for (int h = 0; h < 4; ++h)
#pragma unroll
                for (int bj = 0; bj < 2; ++bj) o[h][bj] = *(const u32x4*)(XB + (size_t)(rowb + ((am + h) >> 2) * HALF + ((am + h) & 3) * 16) * 1024 + colb + bj * HALF);
#pragma unroll
            for (int h = 0; h < 4; ++h) {
                const int ai = (am + h) >> 2, m = (am + h) & 3;
                const int row = rowb + ai * HALF + m * 16;
                float ss = 0.f;
#pragma unroll
                for (int bj = 0; bj < 2; ++bj) {
                    f32x4 o0, o1; unpack8(o[h][bj], o0, o1);
                    const f32x4 v0 = acc[ai][bj][m][0] + o0, v1 = acc[ai][bj][m][1] + o1;
                    *(u32x4*)(XB + (size_t)row * 1024 + colb + bj * HALF) = pack8(v0, v1);
                    ss += sumsq4(v0) + sumsq4(v1);
                }
                ss += __shfl_xor(ss, 16); ss += __shfl_xor(ss, 32);
                if (fq == 0) ssp[(size_t)row * 64 + pn * 4 + wc] = ss;
            }
            asm volatile("" ::: "memory");
        }
        {
            const int row = XMP + xrow;
            float ss = 0.f;
#pragma unroll
            for (int bj = 0; bj < 2; ++bj) {
                const f32x4 v = accx[bj] + unpack4(ox[bj]);
                *(u32x2*)(xbx + bj * HALF) = pack4(v);
                ss += sumsq4(v);
            }
            ss += __shfl_xor(ss, 16); ss += __shfl_xor(ss, 32);
            if (fq == 0) ssp[(size_t)row * 64 + (pn * 4 + wc) * 2 + wr] = ss;
        }
    }
};
struct EpiGlu {
    static constexpr bool PERM = true, AFTER_DRAIN = false;
    bf16_t* XB; float* ssp;
    __device__ __forceinline__ void operator()(const f32x4 (&acc)[2][2][4][2], const f32x4 (&accx)[2], const Unit& u, int wr, int wc, int fr, int fq, PG8_LAS unsigned char* lds) const {
        const int rowb = u.pm * BM + wr * 64 + fr, pn = u.pn;
        const int col = pn * 128 + wc * 32 + 8 * fq;
        const int xrow = u.pm * 16 + fr;
        bf16_t* xbx = XB + (size_t)(XMP + xrow) * 1024 + col + 4 * wr;
        const u32x2 ox = *(const u32x2*)xbx;
#pragma unroll
        for (int am = 0; am < 8; am += 4) {
            u32x4 o[4];
#pragma unroll
            for (int h = 0; h < 4; ++h) o[h] = *(const u32x4*)(XB + (size_t)(rowb + ((am + h) >> 2) * HALF + ((am + h) & 3) * 16) * 1024 + col);
#pragma unroll
            for (int h = 0; h < 4; ++h) {
                const int ai = (am + h) >> 2, m = (am + h) & 3;
                const int row = rowb + ai * HALF + m * 16;
                f32x4 v0, v1; unpack8(o[h], v0, v1);
#pragma unroll
                for (int e = 0; e < 4; ++e) {
                    v0[e] += acc[ai][0][m][0][e] * __builtin_amdgcn_rcpf(1.0f + __expf(-acc[ai][1][m][0][e]));
                    v1[e] += acc[ai][0][m][1][e] * __builtin_amdgcn_rcpf(1.0f + __expf(-acc[ai][1][m][1][e]));
                }
                *(u32x4*)(XB + (size_t)row * 1024 + col) = pack8(v0, v1);
                float ss = sumsq4(v0) + sumsq4(v1);
                ss += __shfl_xor(ss, 16); ss += __shfl_xor(ss, 32);
                if (fq == 0) ssp[(size_t)row * 64 + pn * 4 + wc] = ss;
            }
            asm volatile("" ::: "memory");
        }
        {
            const int row = XMP + xrow;
            f32x4 v = unpack4(ox);
#pragma unroll
            for (int e = 0; e < 4; ++e) v[e] += accx[0][e] * __builtin_amdgcn_rcpf(1.0f + __expf(-accx[1][e]));
            *(u32x2*)xbx = pack4(v);
            float ss = sumsq4(v);
            ss += __shfl_xor(ss, 16); ss += __shfl_xor(ss, 32);
            if (fq == 0) ssp[(size_t)row * 64 + (pn * 4 + wc) * 2 + wr] = ss;
        }
    }
};
struct EpiUp {
    static constexpr bool PERM = true, AFTER_DRAIN = false;
    bf16_t* H; bf16_t* Hx; const float* ssp; int np, nps;
    __device__ __forceinline__ void operator()(const f32x4 (&acc)[2][2][4][2], const f32x4 (&accx)[2], const Unit& u, int wr, int wc, int fr, int fq, PG8_LAS unsigned char* lds) const {
        const int rowb = u.pm * BM + wr * 64 + fr, pn = u.pn;
        { PG8_LAS int* lastpm = (PG8_LAS int*)(lds + RINV_TAB_OFF + 1088 + 64);
          if (*lastpm != u.pm) { unit_rinv_to_lds(lds, ssp, u.pm, np, nps); if (threadIdx.x == 0) *lastpm = u.pm; } }
        float rr[2][4];
        { const PG8_LAS float* tab = (const PG8_LAS float*)(lds + RINV_TAB_OFF);
#pragma unroll
          for (int ai = 0; ai < 2; ++ai)
#pragma unroll
              for (int m = 0; m < 4; ++m) rr[ai][m] = tab[ai * HALF + wr * 64 + m * 16 + fr]; }
        const float rx = ((const PG8_LAS float*)(lds + RINV_TAB_OFF))[256 + fr];
#pragma unroll
        for (int ai = 0; ai < 2; ++ai)
#pragma unroll
            for (int m = 0; m < 4; ++m) {
                const int row = rowb + ai * HALF + m * 16;
                const float r = rr[ai][m];
#pragma unroll
                for (int bj = 0; bj < 2; ++bj) {
                    f32x4 v0 = acc[ai][bj][m][0] * r, v1 = acc[ai][bj][m][1] * r;
#pragma unroll
                    for (int e = 0; e < 4; ++e) { const float a = fmaxf(v0[e], 0.f), b = fmaxf(v1[e], 0.f); v0[e] = a * a; v1[e] = b * b; }
                    __builtin_nontemporal_store(pack8(v0, v1), (u32x4*)((char*)H + (((size_t)u.pm * 64 + (4 * pn + 2 * bj + (wc >> 1))) * 2 + ai) * 16384 + lds_byte(wr * 64 + m * 16 + fr, 32 * (wc & 1) + 8 * fq)));
                }
            }
        {
            const int xrow = u.pm * 16 + fr, row = XMP + xrow;
            const float r = rx;
#pragma unroll
            for (int bj = 0; bj < 2; ++bj) {
                f32x4 v = accx[bj] * r;
#pragma unroll
                for (int e = 0; e < 4; ++e) { const float a = fmaxf(v[e], 0.f); v[e] = a * a; }
                *(u32x2*)((char*)Hx + ((size_t)u.pm * 64 + (4 * pn + 2 * bj + (wc >> 1))) * 2048 + lds_byte(fr, 32 * (wc & 1) + 8 * fq) + 8 * wr) = pack4(v);
            }
        }
    }
};

struct GemmX { const bf16_t* A; const bf16_t* Bt; const bf16_t* Ax; int K; };
template <class Epi, class Sched, int KREP = 1, int EREP = 1, int SKEW_TICKS = 0, bool ATILED = false>
__device__ __forceinline__ void gemm_phase_x(PG8_LAS unsigned char* lds, const GemmX g, const Sched& S, const Epi& E) {
    int tid_ = threadIdx.x; asm volatile("" : "+v"(tid_));
    const int tid = tid_, wid = __builtin_amdgcn_readfirstlane(tid >> 6), lane = tid & 63, wr = wid >> 2, wc = wid & 3, fr = lane & 15, fq = lane >> 4;
    const int K = g.K, nt = K / BK;
    unsigned voffA[2], voffB[2], voffX;
#pragma unroll
    for (int i = 0; i < 2; ++i) { int R, C; stage_rc(tid * 16 + i * 8192, R, C); const int Rb = Epi::PERM ? ((R & ~31) + perm32(R & 31)) : R;
        voffA[i] = ATILED ? (unsigned)(tid * 16 + i * 8192) : (unsigned)(R * K + C) * 2u; voffB[i] = (unsigned)(Rb * K + C) * 2u; }
    { int R, C; const int p = wid * 256 + lane * 4; stage_rc(p & ~15, R, C); voffX = ATILED ? (unsigned)p : (unsigned)(R * K + C) * 2u + (unsigned)(p & 15); }
    const size_t kstepB = (size_t)(BK * 2), hstepB = (size_t)HALF * K * 2, tstepB = 2 * hstepB;
    const size_t kstepA = ATILED ? (size_t)32768 : kstepB, hstepA = ATILED ? (size_t)16384 : hstepB, tstepA = ATILED ? (size_t)nt * 32768 : tstepB;
    const size_t kstepX = ATILED ? (size_t)2048 : kstepB, xstep = ATILED ? (size_t)nt * 2048 : (size_t)16 * K * 2;
    const unsigned ldsw = (unsigned)wid * 1024u, ldsx = (unsigned)wid * 256u;
    const int aoff = lds_byte(wr * 64 + fr, fq * 8), boff = lds_byte(wc * 32 + fr, fq * 8), xoff = lds_byte(fr, fq * 8);
#define PG8_SA(b, h) (((b) * 2 + (h)) * HTB)
#define PG8_SB(b, h) ((4 + (b) * 2 + (h)) * HTB)
#define PG8_XA(b) (STAGE_BYTES + (b) * 2048)
#define PG8_STAGE(bufoff, gbase, voff) do { _Pragma("unroll") for (int _i = 0; _i < 2; ++_i) \
        __builtin_amdgcn_global_load_lds((const unsigned*)((const char*)(gbase) + (voff)[_i]), (PG8_LAS unsigned*)(lds + (bufoff) + ldsw + _i * 8192), 16, 0, 0); } while (0)
#define PG8_STAGEX(b, gbase) __builtin_amdgcn_global_load_lds((const unsigned*)((const char*)(gbase) + voffX), (PG8_LAS unsigned*)(lds + PG8_XA(b) + ldsx), 4, 0, 0)
#define PG8_LDA(dst, b, h) do { _Pragma("unroll") for (int m = 0; m < 4; ++m) _Pragma("unroll") for (int k = 0; k < 2; ++k) dst[m][k] = *(const PG8_LAS bf16x8*)(lds + PG8_SA(b, h) + aoff + m * 2048 + k * 1024); } while (0)
#define PG8_LDB(dst, b, h) do { _Pragma("unroll") for (int n = 0; n < 2; ++n) _Pragma("unroll") for (int k = 0; k < 2; ++k) dst[n][k] = *(const PG8_LAS bf16x8*)(lds + PG8_SB(b, h) + boff + n * 2048 + k * 1024); } while (0)
#define PG8_LDX(dst, b) do { _Pragma("unroll") for (int k = 0; k < 2; ++k) dst[k] = *(const PG8_LAS bf16x8*)(lds + PG8_XA(b) + xoff + k * 1024); } while (0)
#define PG8_MMA(ai, bj, At, Bt) do { __builtin_amdgcn_s_setprio(1); _Pragma("unroll") for (int m = 0; m < 4; ++m) _Pragma("unroll") for (int n = 0; n < 2; ++n) _Pragma("unroll") for (int k = 0; k < 2; ++k) \
        acc[ai][bj][m][n] = __builtin_amdgcn_mfma_f32_16x16x32_bf16(Bt[n][k], At[m][k], acc[ai][bj][m][n], 0, 0, 0); __builtin_amdgcn_s_setprio(0); } while (0)
#define PG8_XMMA() do { if (wr == 0) { _Pragma("unroll") for (int k = 0; k < 2; ++k) { accx[0] = __builtin_amdgcn_mfma_f32_16x16x32_bf16(B0[0][k], Ax[k], accx[0], 0, 0, 0); accx[1] = __builtin_amdgcn_mfma_f32_16x16x32_bf16(B1[0][k], Ax[k], accx[1], 0, 0, 0); } } \
        else { _Pragma("unroll") for (int k = 0; k < 2; ++k) { accx[0] = __builtin_amdgcn_mfma_f32_16x16x32_bf16(B0[1][k], Ax[k], accx[0], 0, 0, 0); accx[1] = __builtin_amdgcn_mfma_f32_16x16x32_bf16(B1[1][k], Ax[k], accx[1], 0, 0, 0); } } } while (0)
#define PG8_WAIT_V(n) asm volatile("s_waitcnt vmcnt(" #n ")" ::: "memory")
#define PG8_WAIT_L(n) asm volatile("s_waitcnt lgkmcnt(" #n ")" ::: "memory")
#define PG8_BAR __builtin_amdgcn_s_barrier()
#define PG8_SCHED __builtin_amdgcn_sched_barrier(0)
    Unit cur, nxt; int ui = 0;
    if (!S.next(0, cur)) return;
    if (SKEW_TICKS > 0) { const unsigned long long t0 = __builtin_amdgcn_s_memrealtime(); const unsigned long long dl = (unsigned long long)SKEW_TICKS * (unsigned)((blockIdx.x >> 3) & 3);
        while (__builtin_amdgcn_s_memrealtime() - t0 < dl) __builtin_amdgcn_s_sleep(8); }
    f32x4 acc[2][2][4][2]; f32x4 accx[2];
#pragma unroll
    for (int a = 0; a < 2; ++a)
#pragma unroll
        for (int b = 0; b < 2; ++b)
#pragma unroll
            for (int m = 0; m < 4; ++m)
#pragma unroll
                for (int n = 0; n < 2; ++n) acc[a][b][m][n] = (f32x4){0.f, 0.f, 0.f, 0.f};
    accx[0] = (f32x4){0.f, 0.f, 0.f, 0.f}; accx[1] = (f32x4){0.f, 0.f, 0.f, 0.f};
    bf16x8 At[4][2], B0[2][2], B1[2][2], Ax[2];
    const char* const xbase = ATILED ? (const char*)g.Ax : (const char*)g.A + (size_t)XMP * K * 2;
    const char* cA = (const char*)g.A + (size_t)cur.pm * tstepA; const char* cB = (const char*)g.Bt + (size_t)cur.pn * tstepB; const char* cX = xbase + (size_t)cur.pm * xstep;
    S.a_ready(cur);
    PG8_STAGE(PG8_SB(0, 0), cB, voffB); PG8_STAGE(PG8_SB(0, 1), cB + hstepB, voffB); PG8_STAGE(PG8_SA(0, 0), cA, voffA); PG8_STAGEX(0, cX); PG8_STAGE(PG8_SA(0, 1), cA + hstepA, voffA);
    if (wr == 1) PG8_BAR;
    PG8_WAIT_V(2); PG8_BAR;
    PG8_STAGE(PG8_SB(1, 0), cB + kstepB, voffB); PG8_STAGE(PG8_SA(1, 0), cA + kstepA, voffA); PG8_STAGE(PG8_SB(1, 1), cB + hstepB + kstepB, voffB); PG8_STAGEX(1, cX + kstepX);
    PG8_WAIT_V(7); PG8_BAR;
    for (;;) {
        const bool has_next = S.next(ui + 1, nxt);
        const char* nA = has_next ? (const char*)g.A + (size_t)nxt.pm * tstepA : cA; const char* nB = has_next ? (const char*)g.Bt + (size_t)nxt.pn * tstepB : cB; const char* nX = has_next ? xbase + (size_t)nxt.pm * xstep : cX;
        for (int kr = 0; kr < KREP; ++kr) {
        const bool fin = (kr == KREP - 1);
        if (KREP > 1 && kr > 0) {
#pragma unroll
            for (int a = 0; a < 2; ++a)
#pragma unroll
                for (int b = 0; b < 2; ++b)
#pragma unroll
                    for (int m = 0; m < 4; ++m)
#pragma unroll
                        for (int n = 0; n < 2; ++n) acc[a][b][m][n] = (f32x4){0.f, 0.f, 0.f, 0.f};
            accx[0] = (f32x4){0.f, 0.f, 0.f, 0.f}; accx[1] = (f32x4){0.f, 0.f, 0.f, 0.f};
        }
        for (int t = 0; t < nt; t += 2) {
            const bool last = (t == nt - 2);
            const char* a1 = cA + (size_t)(t + 1) * kstepA;
            const char* a2 = last ? (fin ? nA : cA) : cA + (size_t)(t + 2) * kstepA; const char* b2 = last ? (fin ? nB : cB) : cB + (size_t)(t + 2) * kstepB; const char* x2 = last ? (fin ? nX : cX) : cX + (size_t)(t + 2) * kstepX;
            const char* a3 = a2 + kstepA; const char* b3 = b2 + kstepB; const char* x3 = x2 + kstepX;
            if (last && has_next && fin) S.a_ready(nxt);
            PG8_LDB(B0, 0, 0); PG8_LDB(B1, 0, 1); PG8_SCHED; PG8_LDA(At, 0, 0); PG8_LDX(Ax, 0); PG8_STAGE(PG8_SA(1, 1), a1 + hstepA, voffA);
            PG8_WAIT_V(9); PG8_WAIT_L(0); PG8_BAR; PG8_MMA(0, 0, At, B0); PG8_MMA(0, 1, At, B1); PG8_XMMA(); PG8_BAR; PG8_SCHED;
            PG8_LDA(At, 0, 1); PG8_STAGE(PG8_SB(0, 0), b2, voffB); PG8_STAGE(PG8_SB(0, 1), b2 + hstepB, voffB); PG8_STAGE(PG8_SA(0, 0), a2, voffA); PG8_STAGEX(0, x2);
            PG8_WAIT_V(9); PG8_WAIT_L(0); PG8_BAR; PG8_MMA(1, 0, At, B0); PG8_MMA(1, 1, At, B1); PG8_BAR; PG8_SCHED;
            PG8_LDB(B0, 1, 0); PG8_LDB(B1, 1, 1); PG8_SCHED; PG8_LDA(At, 1, 0); PG8_LDX(Ax, 1); PG8_STAGE(PG8_SA(0, 1), a2 + hstepA, voffA);
            PG8_WAIT_V(9); PG8_WAIT_L(0); PG8_BAR; PG8_MMA(0, 0, At, B0); PG8_MMA(0, 1, At, B1); PG8_XMMA(); PG8_BAR; PG8_SCHED;
            PG8_LDA(At, 1, 1); PG8_STAGE(PG8_SB(1, 0), b3, voffB); PG8_STAGE(PG8_SB(1, 1), b3 + hstepB, voffB); PG8_STAGE(PG8_SA(1, 0), a3, voffA); PG8_STAGEX(1, x3);
            PG8_WAIT_V(9); PG8_WAIT_L(0); PG8_BAR; PG8_MMA(1, 0, At, B0); PG8_MMA(1, 1, At, B1); PG8_BAR; PG8_SCHED;
        }
        }
        if (wr == 0) PG8_BAR;
        { int fr_ = fr, fq_ = fq; asm volatile("" : "+v"(fr_), "+v"(fq_));
          for (int er = 0; er < EREP; ++er) E(acc, accx, cur, wr, wc, fr_, fq_, lds); } S.done(cur);
        if (!has_next) break;
#pragma unroll
        for (int a = 0; a < 2; ++a)
#pragma unroll
            for (int b = 0; b < 2; ++b)
#pragma unroll
                for (int m = 0; m < 4; ++m)
#pragma unroll
                    for (int n = 0; n < 2; ++n) acc[a][b][m][n] = (f32x4){0.f, 0.f, 0.f, 0.f};
        accx[0] = (f32x4){0.f, 0.f, 0.f, 0.f}; accx[1] = (f32x4){0.f, 0.f, 0.f, 0.f};
        cur = nxt; cA = nA; cB = nB; cX = nX; ++ui;
        if (wr == 1) PG8_BAR;
    }
    PG8_WAIT_V(0);
    PG8_BAR;
#undef PG8_SA
#undef PG8_SB
#undef PG8_XA
#undef PG8_STAGE
#undef PG8_STAGEX
#undef PG8_LDA
#undef PG8_LDB
#undef PG8_LDX
#undef PG8_MMA
#undef PG8_XMMA
#undef PG8_WAIT_V
#undef PG8_WAIT_L
#undef PG8_BAR
#undef PG8_SCHED
}
}

__device__ __forceinline__ void p0_transpose_item(const float* W, int K, int N, const float* gain, bf16* WT, int glu, LAS float* scr, int item, int lane) {
    const int nblk = N / 64, kb = item / nblk, nb = item % nblk, k0 = 64 * kb, n0 = 64 * nb;
    const int q = lane & 15, kr = lane >> 4;
    f32x4 v[16];
#pragma unroll
    for (int i = 0; i < 16; ++i) v[i] = *(const f32x4*)(W + (size_t)(k0 + 4 * i + kr) * N + n0 + 4 * q);
    if (gain) {
#pragma unroll
        for (int i = 0; i < 16; ++i) v[i] = v[i] * gain[k0 + 4 * i + kr];
    }
#pragma unroll
    for (int i = 0; i < 16; ++i) { LAS float* d = scr + (4 * i + kr) * 65 + 4 * q; d[0] = v[i][0]; d[1] = v[i][1]; d[2] = v[i][2]; d[3] = v[i][3]; }
    LDS_WAIT(); asm volatile("" ::: "memory");
    int drow0 = n0; if (glu) { const int bj = n0 / 1024, rem = n0 % 1024; drow0 = (rem / 128) * 256 + bj * 128 + (rem % 128); }
    const int c = lane & 7;
#pragma unroll
    for (int j = 0; j < 8; ++j) { const int n = (lane >> 3) + 8 * j; const LAS float* sp = scr + (8 * c) * 65 + n;
        v4u o; o.x = pk2(sp[0 * 65], sp[1 * 65]); o.y = pk2(sp[2 * 65], sp[3 * 65]); o.z = pk2(sp[4 * 65], sp[5 * 65]); o.w = pk2(sp[6 * 65], sp[7 * 65]);
        *(GAS v4u*)(WT + (size_t)(drow0 + n) * K + k0 + 8 * c) = o; }
    LDS_WAIT(); asm volatile("" ::: "memory");
}

__device__ __forceinline__ void sincos_rr(float x, float& s, float& c) {
    const float q = rintf(x * 0.63661977236758f);
    float r = fmaf(-q, 1.57079637050629f, x); r = fmaf(-q, -4.37113882867379e-8f, r);
    const float r2 = r * r;
    const float sp = r + r * r2 * (-1.6666667163e-1f + r2 * (8.3333337680e-3f + r2 * (-1.9841270114e-4f + r2 * 2.7557314297e-6f)));
    const float cp = 1.0f + r2 * (-0.5f + r2 * (4.1666667908e-2f + r2 * (-1.3888889225e-3f + r2 * (2.4801587642e-5f + r2 * -2.7557314297e-7f))));
    const int qi = (int)q & 3;
    s = (qi == 0) ? sp : (qi == 1) ? cp : (qi == 2) ? -sp : -cp;
    c = (qi == 0) ? cp : (qi == 1) ? -sp : (qi == 2) ? -cp : sp;
}

typedef float f32x16 __attribute__((ext_vector_type(16)));
typedef float f32x2_t __attribute__((ext_vector_type(2))); typedef __bf16 bf16x2_t __attribute__((ext_vector_type(2)));
__device__ __forceinline__ unsigned cvtpk_c(float lo, float hi) { f32x2_t v = {lo, hi}; bf16x2_t b = __builtin_convertvector(v, bf16x2_t); return __builtin_bit_cast(unsigned, b); }
typedef unsigned u32x2 __attribute__((ext_vector_type(2)));
__device__ __forceinline__ void ssm_abar_calc(const float* A_re, const float* A_im, const float* log_dt, int g, int n, float& abr, float& abi, float& cfr, float& cfi) {
    const float dt = expf(log_dt[g]);
    const float ar = A_re[g * 64 + n], ai = A_im[g * 64 + n];
    const float mag = expf(dt * ar); float sn, cs; sincos_rr(dt * ai, sn, cs);
    abr = mag * cs; abi = mag * sn;
    const float den = ar * ar + ai * ai, nr = abr - 1.0f;
    cfr = (nr * ar + abi * ai) / den; cfi = (abi * ar - nr * ai) / den;
}
__device__ __forceinline__ float gelu_tanh(float y) {
    const float z = 0.7978845608028654f * (y + 0.044715f * y * y * y);
    return y * __builtin_amdgcn_rcpf(1.0f + __expf(-2.0f * z));
}
__device__ __forceinline__ void wg_rinv(LAS float* tab, const float* ssp, int rowL, int rowH, bool sample, int tid) {
    __syncthreads();
    const int row = sample ? (tid >> 1) : tid, hf = sample ? (tid & 1) : 0;
    if (!sample || row < 32) {
        const int grow = sample ? rowL + row : ((row < 256) ? rowL + row : rowH + row - 256);
        const float* p = ssp + (size_t)grow * 64 + 16 * hf;
        f32x4 v[4];
#pragma unroll
        for (int i = 0; i < 4; ++i) v[i] = *(const f32x4*)(p + 4 * i);
        float s_ = (((v[0][0] + v[0][1]) + (v[0][2] + v[0][3])) + ((v[1][0] + v[1][1]) + (v[1][2] + v[1][3]))) + (((v[2][0] + v[2][1]) + (v[2][2] + v[2][3])) + ((v[3][0] + v[3][1]) + (v[3][2] + v[3][3])));
        if (sample) s_ += __shfl_xor(s_, 1);
        if (hf == 0) tab[row] = rsqrtf(s_ * (1.0f / 1024.0f) + 1e-6f);
    }
    __syncthreads();
}
struct SsmT { const bf16* BT; const bf16* CT; const float* tab; const float* Dk; const float* gain; };
template <int MODE>
__device__ __forceinline__ void ssm_mfma_unit(LAS unsigned char* wl, int lane, int g, const SsmT& T, const bf16* XB, const LAS float* rv  , int rowL, int rowH, int nblk,
                                              float (&st)[4]  , bf16* Gout, const float* h0r, const float* h0i, float* hor, float* hoi  , int b0) {
    const int r32 = lane & 31, hi5 = lane >> 5, c16 = lane & 15, kq = lane >> 4;
    const int aseq = (r32 >> 2) & 1, atok = 4 * (r32 >> 3) + (r32 & 3);
    const int arow = (aseq ? rowH : rowL) + atok;
    pg8::bf16x8 bt[4], ct[4];
#pragma unroll
    for (int tn = 0; tn < 4; ++tn) bt[tn] = *(const pg8::bf16x8*)(T.BT + (size_t)(tn * 32 + r32) * 16 + 8 * hi5);
    if (MODE != 0) {
#pragma unroll
        for (int ks = 0; ks < 4; ++ks) ct[ks] = *(const pg8::bf16x8*)(T.CT + (size_t)c16 * 128 + 32 * ks + 8 * kq);
    }
    float ar[2], ai[2];
    { const f32x4 t0 = *(const f32x4*)(T.tab + (size_t)r32 * 4), t1 = *(const f32x4*)(T.tab + (size_t)(32 + r32) * 4); ar[0] = t0[0]; ai[0] = t0[1]; ar[1] = t1[0]; ai[1] = t1[1]; }
    f32x4 Dg = {0.f, 0.f, 0.f, 0.f};
    if (MODE != 0) { const f32x4 dv = *(const f32x4*)(T.Dk + 4 * kq), gv = *(const f32x4*)(T.gain + 4 * kq); Dg = dv * gv; }
    float pwr[2][16], pwi[2][16], a16r[2], a16i[2];
    if (MODE == 0) {
#pragma unroll
        for (int p = 0; p < 2; ++p) {
            float cr = 1.0f, ci = 0.0f;
#pragma unroll
            for (int r = 15; r >= 0; --r) { pwr[p][r] = cr; pwi[p][r] = ci; const float tr = cr * ar[p] - ci * ai[p], ti = cr * ai[p] + ci * ar[p]; cr = tr; ci = ti; }
            a16r[p] = cr; a16i[p] = ci;
        }
    }
    pg8::bf16x8 xa_all[8];
#pragma unroll
    for (int k = 0; k < 8; ++k) if (k < nblk) xa_all[k] = *(const pg8::bf16x8*)(XB + (size_t)(arow + 16 * k) * 1024 + g * 16 + 8 * hi5);
    for (int blk = 0; blk < nblk; ++blk) {
        const pg8::bf16x8 xa = xa_all[0];
        if (MODE != 2) {
#pragma unroll
            for (int k = 0; k < 7; ++k) xa_all[k] = xa_all[k + 1];
            if (blk + 8 < nblk) xa_all[7] = *(const pg8::bf16x8*)(XB + (size_t)(arow + 16 * (blk + 8)) * 1024 + g * 16 + 8 * hi5);
        }
        if (MODE != 0) *(LAS pg8::bf16x8*)(wl + 8704 + r32 * 32 + hi5 * 16) = xa;
        const LAS float* rvb = rv + ((MODE == 2) ? 0 : 16 * blk);
        pg8::bf16x8 xs_;
        { const float rin = rvb[((MODE == 2) ? 16 : 256) * aseq + atok]; const v4u xw = __builtin_bit_cast(v4u, xa); v4u ow;
          ow.x = cvtpk_c(bf_lo(xw.x) * rin, bf_hi(xw.x) * rin); ow.y = cvtpk_c(bf_lo(xw.y) * rin, bf_hi(xw.y) * rin);
          ow.z = cvtpk_c(bf_lo(xw.z) * rin, bf_hi(xw.z) * rin); ow.w = cvtpk_c(bf_lo(xw.w) * rin, bf_hi(xw.w) * rin); xs_ = __builtin_bit_cast(pg8::bf16x8, ow); }
        f32x16 IN[4];
#pragma unroll
        for (int tn = 0; tn < 4; ++tn) { const f32x16 z = {0.f, 0.f, 0.f, 0.f, 0.f, 0.f, 0.f, 0.f, 0.f, 0.f, 0.f, 0.f, 0.f, 0.f, 0.f, 0.f}; IN[tn] = __builtin_amdgcn_mfma_f32_32x32x16_bf16(xs_, bt[tn], z, 0, 0, 0); }
        if (MODE == 0) {
#pragma unroll
            for (int p = 0; p < 2; ++p) {
                float er[2] = {0.f, 0.f}, ei[2] = {0.f, 0.f};
#pragma unroll
                for (int r = 0; r < 16; ++r) {
                    const float xr_ = IN[2 * p][r], xi_ = IN[2 * p + 1][r], wr_ = pwr[p][r], wi_ = pwi[p][r];
                    float t = fmaf(wr_, xr_, er[r & 1]); asm volatile("" : "+v"(t)); t = fmaf(-wi_, xi_, t); asm volatile("" : "+v"(t)); er[r & 1] = t;
                    float u = fmaf(wr_, xi_, ei[r & 1]); asm volatile("" : "+v"(u)); u = fmaf(wi_, xr_, u); asm volatile("" : "+v"(u)); ei[r & 1] = u;
                }
                float e_r = er[0] + er[1], e_i = ei[0] + ei[1];
                asm volatile("" : "+v"(e_r), "+v"(e_i));
                const float sr = st[2 * p], si = st[2 * p + 1];
                float nr = fmaf(a16r[p], sr, e_r); asm volatile("" : "+v"(nr)); nr = fmaf(-a16i[p], si, nr); asm volatile("" : "+v"(nr));
                float ni = fmaf(a16r[p], si, e_i); asm volatile("" : "+v"(ni)); ni = fmaf(a16i[p], sr, ni); asm volatile("" : "+v"(ni));
                st[2 * p] = nr; st[2 * p + 1] = ni;
            }
        } else {
            float cr[2] = {st[0], st[2]}, ci[2] = {st[1], st[3]};
#pragma unroll
            for (int r = 0; r < 16; ++r) {
                if (MODE == 2 && (r & 7) == 0) {
#pragma unroll
                    for (int p = 0; p < 2; ++p) { const size_t hidx = ((size_t)(b0 + 2 * hi5 + (r >> 3)) * 64 + g) * 64 + 32 * p + r32; cr[p] = h0r[hidx]; ci[p] = h0i[hidx]; } }
                float tr0 = fmaf(ar[0], cr[0], IN[0][r]); asm volatile("" : "+v"(tr0)); float tr1 = fmaf(ar[1], cr[1], IN[2][r]); asm volatile("" : "+v"(tr1));
                float ti0 = fmaf(ar[0], ci[0], IN[1][r]); asm volatile("" : "+v"(ti0)); float ti1 = fmaf(ar[1], ci[1], IN[3][r]); asm volatile("" : "+v"(ti1));
                tr0 = fmaf(-ai[0], ci[0], tr0); asm volatile("" : "+v"(tr0)); tr1 = fmaf(-ai[1], ci[1], tr1); asm volatile("" : "+v"(tr1));
                ti0 = fmaf(ai[0], cr[0], ti0); asm volatile("" : "+v"(ti0)); ti1 = fmaf(ai[1], cr[1], ti1); asm volatile("" : "+v"(ti1));
                cr[0] = tr0; cr[1] = tr1; ci[0] = ti0; ci[1] = ti1; IN[0][r] = tr0; IN[2][r] = tr1; IN[1][r] = ti0; IN[3][r] = ti1;
                if (MODE == 2 && (r & 7) == 7) {
#pragma unroll
                    for (int p = 0; p < 2; ++p) { const size_t hidx = ((size_t)(b0 + 2 * hi5 + (r >> 3)) * 64 + g) * 64 + 32 * p + r32; hor[hidx] = cr[p]; hoi[hidx] = ci[p]; } }
            }
            st[0] = cr[0]; st[1] = ci[0]; st[2] = cr[1]; st[3] = ci[1];
#pragma unroll
            for (int p = 0; p < 2; ++p)
#pragma unroll
                for (int r = 0; r < 16; ++r) *(LAS unsigned*)(wl + (16 * hi5 + r) * 272 + 4 * (32 * p + r32)) = pg8::cvt_pk_bf16(IN[2 * p][r], IN[2 * p + 1][r]);
            LDS_WAIT(); asm volatile("" ::: "memory");
#pragma unroll
            for (int tt = 0; tt < 2; ++tt) {
                f32x4 y = {0.f, 0.f, 0.f, 0.f};
#pragma unroll
                for (int ks = 0; ks < 4; ++ks) { const pg8::bf16x8 hf = *(const LAS pg8::bf16x8*)(wl + (16 * tt + c16) * 272 + (32 * ks + 8 * kq) * 2); y = __builtin_amdgcn_mfma_f32_16x16x32_bf16(ct[ks], hf, y, 0, 0, 0); }
                const int token = (tt ? rowH : rowL) + 16 * blk + c16;
                const float rinv = rvb[((MODE == 2) ? 16 : 256) * tt + c16];
                const int xrow = 8 * (c16 >> 2) + 4 * tt + (c16 & 3);
                const f32x4 xv = pg8::unpack4(*(const LAS u32x2*)(wl + 8704 + xrow * 32 + kq * 8));
                f32x4 o;
#pragma unroll
                for (int e = 0; e < 4; ++e) o[e] = gelu_tanh(y[e] + Dg[e] * (xv[e] * rinv));
                *(u32x2*)(Gout + (size_t)token * 1024 + g * 16 + 4 * kq) = pg8::pack4(o);
            }
        }
        LDS_WAIT(); asm volatile("" ::: "memory");
    }
}

__device__ __forceinline__ void attn_task(const LAS unsigned char* Kl, const LAS unsigned char* Vl, const bf16* Qb, bf16* Ob, const float* sinks, int qrow, int head, int tloc, int kb0, int jkmin, int lane) {
    const int r32 = lane & 31, hi5 = lane >> 5;
    const float slope2 = exp2f(-0.5f * (float)(head + 1)) * 1.4426950408889634f, sink2 = sinks[head] * 1.4426950408889634f;
    const bf16* qptr = Qb + (size_t)qrow * 1024 + head * 64 + 8 * hi5;
    pg8::bf16x8 qf[4];
#pragma unroll
    for (int ks = 0; ks < 4; ++ks) qf[ks] = *(const pg8::bf16x8*)(qptr + 16 * ks);
    f32x16 S[5];
#pragma unroll
    for (int i = 0; i < 5; ++i) {
        f32x16 acc = {0.f, 0.f, 0.f, 0.f, 0.f, 0.f, 0.f, 0.f, 0.f, 0.f, 0.f, 0.f, 0.f, 0.f, 0.f, 0.f};
#pragma unroll
        for (int ks = 0; ks < 4; ++ks) { const pg8::bf16x8 kf = *(const LAS pg8::bf16x8*)(Kl + (32 * (kb0 + i) + r32) * 144 + 32 * ks + 16 * hi5); acc = __builtin_amdgcn_mfma_f32_32x32x16_bf16(kf, qf[ks], acc, 0, 0, 0); }
        S[i] = acc;
    }
    float mx = sink2;
#pragma unroll
    for (int i = 0; i < 5; ++i)
#pragma unroll
        for (int r = 0; r < 16; ++r) {
            const int jk = 32 * (kb0 + i) + (r & 3) + 8 * (r >> 2) + 4 * hi5; const int dist = tloc + 128 - jk;
            const bool valid = (dist >= 0) && (dist <= 128) && (jk >= jkmin);
            const float sv = valid ? (S[i][r] * 0.18033688011112042f - slope2 * (float)dist) : -1e30f;
            S[i][r] = sv; mx = fmaxf(mx, sv);
        }
    mx = fmaxf(mx, __shfl_xor(mx, 32));
    float lsum = 0.f;
#pragma unroll
    for (int i = 0; i < 5; ++i)
#pragma unroll
        for (int r = 0; r < 16; ++r) { const float p = __builtin_amdgcn_exp2f(S[i][r] - mx); S[i][r] = p; lsum += p; }
    lsum += __shfl_xor(lsum, 32); lsum += __builtin_amdgcn_exp2f(sink2 - mx);
    const float inv = 1.0f / lsum;
    f32x16 O0 = {0.f, 0.f, 0.f, 0.f, 0.f, 0.f, 0.f, 0.f, 0.f, 0.f, 0.f, 0.f, 0.f, 0.f, 0.f, 0.f}, O1 = O0;
#pragma unroll
    for (int i = 0; i < 5; ++i)
#pragma unroll
        for (int s2 = 0; s2 < 2; ++s2) {
            v4u pw; pw.x = pg8::cvt_pk_bf16(S[i][8 * s2 + 0], S[i][8 * s2 + 1]); pw.y = pg8::cvt_pk_bf16(S[i][8 * s2 + 2], S[i][8 * s2 + 3]);
            pw.z = pg8::cvt_pk_bf16(S[i][8 * s2 + 4], S[i][8 * s2 + 5]); pw.w = pg8::cvt_pk_bf16(S[i][8 * s2 + 6], S[i][8 * s2 + 7]);
            const pg8::bf16x8 pf = __builtin_bit_cast(pg8::bf16x8, pw);
            const int keyoff = 32 * (kb0 + i) + 16 * s2 + 4 * hi5;
            { const u32x2 lo = *(const LAS u32x2*)(Vl + r32 * 520 + keyoff * 2), hh = *(const LAS u32x2*)(Vl + r32 * 520 + (keyoff + 8) * 2);
              v4u vw; vw.x = lo.x; vw.y = lo.y; vw.z = hh.x; vw.w = hh.y; O0 = __builtin_amdgcn_mfma_f32_32x32x16_bf16(__builtin_bit_cast(pg8::bf16x8, vw), pf, O0, 0, 0, 0); }
            { const u32x2 lo = *(const LAS u32x2*)(Vl + (32 + r32) * 520 + keyoff * 2), hh = *(const LAS u32x2*)(Vl + (32 + r32) * 520 + (keyoff + 8) * 2);
              v4u vw; vw.x = lo.x; vw.y = lo.y; vw.z = hh.x; vw.w = hh.y; O1 = __builtin_amdgcn_mfma_f32_32x32x16_bf16(__builtin_bit_cast(pg8::bf16x8, vw), pf, O1, 0, 0, 0); }
        }
    bf16* optr = Ob + (size_t)qrow * 1024 + head * 64 + 4 * hi5;
#pragma unroll
    for (int qd = 0; qd < 4; ++qd) {
        u32x2 w0; w0.x = pg8::cvt_pk_bf16(O0[4 * qd] * inv, O0[4 * qd + 1] * inv); w0.y = pg8::cvt_pk_bf16(O0[4 * qd + 2] * inv, O0[4 * qd + 3] * inv);
        u32x2 w1; w1.x = pg8::cvt_pk_bf16(O1[4 * qd] * inv, O1[4 * qd + 1] * inv); w1.y = pg8::cvt_pk_bf16(O1[4 * qd + 2] * inv, O1[4 * qd + 3] * inv);
        *(u32x2*)(optr + 8 * qd) = w0; *(u32x2*)(optr + 32 + 8 * qd) = w1;
    }
}

#ifndef SKEW_UP
#define SKEW_UP 250
#define SKEW_GLU 250
#endif
#ifndef PROBE_DUP
#define PROBE_DUP 0
#endif
#define NREP(bit) (((PROBE_DUP) >> (bit)) & 1 ? 2 : 1)
#ifndef EN_P0
#define EN_P0 1
#endif
#ifndef EN_QKV
#define EN_QKV 1
#endif
#ifndef EN_ATT
#define EN_ATT 1
#endif
#ifndef EN_OPJ
#define EN_OPJ 1
#endif
#ifndef EN_S1
#define EN_S1 1
#endif
#ifndef EN_S3
#define EN_S3 1
#endif
#ifndef EN_GLU
#define EN_GLU 1
#endif
#ifndef EN_UP
#define EN_UP 1
#endif
#ifndef EN_DN
#define EN_DN 1
#endif
#ifndef EN_FIN
#define EN_FIN 1
#endif
template <class T> __device__ __forceinline__ T karg(const __attribute__((address_space(4))) char* ka, int off) { typedef const __attribute__((address_space(4))) T CT; return *(CT*)(ka + off); }
struct Args { const float* in[23]; float* out; unsigned char* ws; int ph_lo, ph_hi; };
static_assert(sizeof(Args) == 208 && __builtin_offsetof(Args, out) == 184 && __builtin_offsetof(Args, ws) == 192, "kernarg layout used by KARG");

__global__ void __launch_bounds__(512, 2) fwd_kernel(Args args) {
    extern __shared__ __attribute__((aligned(16))) unsigned char lds[];
    LAS unsigned char* const L = (LAS unsigned char*)lds;
#define FRESH_IDS int tid = threadIdx.x; asm volatile("" : "+v"(tid)); const int lane = tid & 63, wave = __builtin_amdgcn_readfirstlane(tid >> 6); const int gw = vcu * 8 + wave; (void)lane; (void)gw
    const int G = gridDim.x, bx = blockIdx.x;
    const int vcu = (G % 8 == 0) ? (bx % 8) * (G / 8) + bx / 8 : bx;
    const int NGW = G * 8;
    for (int u = threadIdx.x; u < (LDS_BYTES - LDSCTL_OFF) / 4; u += 512) ((LAS unsigned*)(L + LDSCTL_OFF))[u] = 0u;
    __syncthreads();
    const int lo = args.ph_lo, hi = args.ph_hi;
    const bool multi = (hi - lo) > 1;
    XcdBarrier bar; bar.bar = (unsigned*)(args.ws + WS_CTL) + CW_BAR; bar.x = 0; bar.st = nullptr;
    if (multi) bar = xcd_barrier_post((unsigned*)(args.ws + WS_CTL) + CW_BAR, (volatile LAS unsigned*)(L + MISC_OFF) + 8);
#define IN(k) (lo <= (k) && (k) < hi)
#define SEAM(k) do { if (IN(k) && IN((k) + 1)) xcd_barrier(bar); } while (0)

#define KARG(T, off) karg<T>(ka, (off))
#define INP(k) karg<const float*>(ka, 8 * (k))
#define FRESH_PTRS const __attribute__((address_space(4))) char* ka = (const __attribute__((address_space(4))) char*)__builtin_amdgcn_kernarg_segment_ptr(); asm volatile("" : "+s"(ka)); \
    unsigned char* const ws = KARG(unsigned char*, 192); float* const out = KARG(float*, 184); \
    float* const ssp = (float*)(ws + WS_SSP); float* const HS = (float*)(ws + WS_HS); bf16* const XB = (bf16*)(ws + WS_XB); bf16* const Hb = (bf16*)(ws + WS_H); \
    bf16* const Qb = (bf16*)(ws + WS_Q); bf16* const Kb = (bf16*)(ws + WS_K); bf16* const Vb = (bf16*)(ws + WS_V); bf16* const Ob = (bf16*)(ws + WS_O); \
    const float* const x_p = INP(0); const float* const x_s = INP(1); (void)ssp; (void)HS; (void)XB; (void)Hb; (void)Qb; (void)Kb; (void)Vb; (void)Ob; (void)x_p; (void)x_s
    if (EN_P0 && IN(0)) for (int rp = 0; rp < NREP(0); ++rp) {
        FRESH_IDS; FRESH_PTRS;
        LAS float* scr = (LAS float*)(L + wave * 16640);
        constexpr int I_QKV = 16 * 24, I_O = 16 * 16, I_GLU = 16 * 32, I_UP = 16 * 64, I_DN = 64 * 16;
        constexpr int NITEMS = 2 * I_QKV + 2 * I_O + 2 * I_GLU + 4 * I_UP + 4 * I_DN;
        for (int it = gw; it < NITEMS; it += NGW) {
            int r = it;
            if (r < 2 * I_QKV) { const int j = r / I_QKV; r -= j * I_QKV; p0_transpose_item(INP(9) + (size_t)j * D * NQKV, D, NQKV, INP(6) + (size_t)(2 * j) * D, (bf16*)(ws + WS_WQKV) + (size_t)j * NQKV * D, 0, scr, r, lane); continue; } r -= 2 * I_QKV;
            if (r < 2 * I_O) { const int j = r / I_O; r -= j * I_O; p0_transpose_item(INP(10) + (size_t)j * D * D, D, D, nullptr, (bf16*)(ws + WS_WO) + (size_t)j * D * D, 0, scr, r, lane); continue; } r -= 2 * I_O;
            if (r < 2 * I_GLU) { const int j = r / I_GLU; r -= j * I_GLU; p0_transpose_item(INP(20) + (size_t)j * D * 2 * D, D, 2 * D, nullptr, (bf16*)(ws + WS_WGLU) + (size_t)j * 2 * D * D, 1, scr, r, lane); continue; } r -= 2 * I_GLU;
            if (r < 4 * I_UP) { const int l = r / I_UP; r -= l * I_UP; p0_transpose_item(INP(21) + (size_t)l * D * FF, D, FF, INP(7) + (size_t)l * D, (bf16*)(ws + WS_WUP) + (size_t)l * FF * D, 0, scr, r, lane); continue; } r -= 4 * I_UP;
            { const int l = r / I_DN; r -= l * I_DN; p0_transpose_item(INP(22) + (size_t)l * FF * D, FF, D, nullptr, (bf16*)(ws + WS_WDN) + (size_t)l * D * FF, 0, scr, r, lane); }
        }
        for (int m0 = 2 * gw; m0 < M; m0 += 2 * NGW) {
            f32x4 v[2][4];
#pragma unroll
            for (int rr = 0; rr < 2; ++rr) { const int m = m0 + rr; const float* xrow = (m < MP) ? x_p + (size_t)m * D : x_s + (size_t)(m - MP) * D;
#pragma unroll
                for (int j = 0; j < 4; ++j) v[rr][j] = *((const GAS f32x4*)xrow + lane + 64 * j); }
#pragma unroll
            for (int rr = 0; rr < 2; ++rr) { const int m = m0 + rr; float sq = 0.f;
#pragma unroll
                for (int j = 0; j < 4; ++j) sq += (v[rr][j][0] * v[rr][j][0] + v[rr][j][1] * v[rr][j][1]) + (v[rr][j][2] * v[rr][j][2] + v[rr][j][3] * v[rr][j][3]);
                sq = wave_sum(sq);
                GAS unsigned long long* o8 = (GAS unsigned long long*)(XB + (size_t)m * D) + lane;
#pragma unroll
                for (int j = 0; j < 4; ++j) o8[64 * j] = (unsigned long long)pk2(v[rr][j][0], v[rr][j][1]) | ((unsigned long long)pk2(v[rr][j][2], v[rr][j][3]) << 32);
                if (lane < 32) ssp[(size_t)m * 64 + lane] = (lane == 0) ? sq : 0.f; }
        }
        for (int i = bx * 512 + tid; i < 2 * NG * NS; i += G * 512) {
            const int jj = i >> 12, gn = i & 4095, g = gn >> 6, n = gn & 63; float abr, abi, cfr, cfi;
            ssm_abar_calc(INP(12) + (size_t)jj * NG * NS, INP(13) + (size_t)jj * NG * NS, INP(14) + (size_t)jj * NG, g, n, abr, abi, cfr, cfi);
            f32x4 v; v[0] = abr; v[1] = abi; v[2] = cfr; v[3] = cfi; *(f32x4*)((float*)(ws + WS_TAB) + (size_t)i * 4) = v;
            const float* bre = INP(15) + (size_t)i * 16; const float* bim = INP(16) + (size_t)i * 16; const float* gn_ = INP(6) + (size_t)(2 * jj + 1) * D + g * 16;
            bf16* btr = (bf16*)(ws + WS_BT) + ((size_t)(jj * NG + g) * 128 + (2 * (n >> 5)) * 32 + (n & 31)) * 16; bf16* bti = btr + 32 * 16;
#pragma unroll
            for (int c8 = 0; c8 < 2; ++c8) {
                float wr_[8], wi_[8];
#pragma unroll
                for (int c4 = 0; c4 < 2; ++c4) { const f32x4 br = *(const f32x4*)(bre + 8 * c8 + 4 * c4), bi = *(const f32x4*)(bim + 8 * c8 + 4 * c4), gv = *(const f32x4*)(gn_ + 8 * c8 + 4 * c4);
#pragma unroll
                    for (int e = 0; e < 4; ++e) { wr_[4 * c4 + e] = (cfr * br[e] - cfi * bi[e]) * gv[e]; wi_[4 * c4 + e] = (cfr * bi[e] + cfi * br[e]) * gv[e]; } }
                v4u o; o.x = pk2(wr_[0], wr_[1]); o.y = pk2(wr_[2], wr_[3]); o.z = pk2(wr_[4], wr_[5]); o.w = pk2(wr_[6], wr_[7]); *(v4u*)(btr + 8 * c8) = o;
                o.x = pk2(wi_[0], wi_[1]); o.y = pk2(wi_[2], wi_[3]); o.z = pk2(wi_[4], wi_[5]); o.w = pk2(wi_[6], wi_[7]); *(v4u*)(bti + 8 * c8) = o;
            }
        }
        for (int i = bx * 512 + tid; i < 2 * NG * GC * 16; i += G * 512) {
            const int n4 = i & 15; const size_t rowi = (size_t)(i >> 4);
            const f32x4 cr = *(const f32x4*)(INP(17) + rowi * 64 + 4 * n4), ci = *(const f32x4*)(INP(18) + rowi * 64 + 4 * n4);
            v4u o; o.x = pk2(cr[0], -ci[0]); o.y = pk2(cr[1], -ci[1]); o.z = pk2(cr[2], -ci[2]); o.w = pk2(cr[3], -ci[3]);
            *(v4u*)((bf16*)(ws + WS_CT) + rowi * 128 + 8 * n4) = o;
        }
        __syncthreads();
    }
    SEAM(0);

    for (int l = 0; l < 4; ++l) {
        const int pb = 1 + 5 * l, j = l >> 1;
        if ((l & 1) == 0) {
            if (EN_QKV && IN(pb)) for (int rp = 0; rp < NREP(3); ++rp) {
                FRESH_PTRS;
                pg8::GemmX g{XB, (const bf16*)(ws + WS_WQKV) + (size_t)j * NQKV * D, nullptr, D}; pg8::StaticOrder S; S.init(MP, NQKV, G, bx);
                pg8::EpiQKV E{Qb, Kb, Vb, ssp, 16, 32, out + O_KP + (size_t)j * 2 * 128 * 256, out + O_VP + (size_t)j * 2 * 128 * 256, out + O_KS + (size_t)j * SB * 128 * 256, out + O_VS + (size_t)j * SB * 128 * 256};
                if (threadIdx.x == 0) *(LAS int*)(L + pg8::RINV_TAB_OFF + 1152) = -1;
                __syncthreads();
                pg8::gemm_phase_x<pg8::EpiQKV, pg8::StaticOrder>(L, g, S, E);
                if (l == 0 && rp == 0 && bx + G >= (MP / 256) * (NQKV / 256) && 2 * G > (MP / 256) * (NQKV / 256)) {
                    FRESH_IDS;
                    const int nwg_ = (MP / 256) * (NQKV / 256), myidx = bx - (nwg_ - G), nidle = 2 * G - nwg_;
                    constexpr int PER = 120 * 256 / 4;
                    for (int slab = myidx; slab < 2 * 2 * SB; slab += nidle) {
                        const int kv = slab >> 8, jb = slab & 255;
                        const f32x4* src = (const f32x4*)(INP(2 + kv) + (size_t)jb * 128 * 256 + 8 * 256) + tid;
                        f32x4* dst = (f32x4*)(out + (kv ? O_VS : O_KS) + (size_t)jb * 128 * 256) + tid;
#pragma unroll 1
                        for (int it = 0; it < 15; it += 5) {
                            f32x4 v[5];
#pragma unroll
                            for (int k = 0; k < 5; ++k) v[k] = src[(it + k) * 512];
#pragma unroll
                            for (int k = 0; k < 5; ++k) dst[(it + k) * 512] = v[k];
                        }
                    }
                }
            }
            SEAM(pb);
            if (EN_ATT && IN(pb + 1)) for (int rp = 0; rp < NREP(1); ++rp) {
                FRESH_IDS; FRESH_PTRS;
                const float* ck = INP(2) + (size_t)j * SB * 128 * 256; const float* cv = INP(3) + (size_t)j * SB * 128 * 256;
                const float* sinks = INP(11) + j * 16;
                const int r32 = lane & 31;
                for (int u = vcu; u < 512 + 256; u += G) {
                    const bool samp = u >= 512;
                    const int hw = wave >> 2, t256 = tid & 255;
                    int kvh, qblk = 0, b;
                    if (!samp) { kvh = u & 3; qblk = (u >> 2) & 63; b = u >> 8; } else { const int us = 2 * (u - 512) + hw; kvh = us & 3; b = us >> 2; }
                    LAS unsigned char* Ks = samp ? L + hw * 56320 : L; LAS unsigned char* Vs = samp ? Ks + 23040 : L + 36864;
                    if (!samp) {
                        v4u kv[4], vv[4];
#pragma unroll
                        for (int c = 0; c < 4; ++c) { const int id = tid + 512 * c, key = id >> 3, ch = id & 7, s_ = qblk * 128 - 128 + key;
                            kv[c] = (v4u){0u, 0u, 0u, 0u}; vv[c] = (v4u){0u, 0u, 0u, 0u};
                            if (s_ >= 0) { const size_t off = (size_t)((b << 13) + s_) * 256 + kvh * 64 + ch * 8; kv[c] = *(const v4u*)(Kb + off); vv[c] = *(const v4u*)(Vb + off); } }
#pragma unroll
                        for (int c = 0; c < 4; ++c) { const int id = tid + 512 * c, key = id >> 3, ch = id & 7;
                            *(LAS v4u*)(Ks + key * 144 + ch * 16) = kv[c];
                            LAS unsigned short* vt = (LAS unsigned short*)(Vs + (ch * 8) * 520 + key * 2);
                            vt[0 * 260] = (unsigned short)(vv[c].x & 0xffffu); vt[1 * 260] = (unsigned short)(vv[c].x >> 16); vt[2 * 260] = (unsigned short)(vv[c].y & 0xffffu); vt[3 * 260] = (unsigned short)(vv[c].y >> 16);
                            vt[4 * 260] = (unsigned short)(vv[c].z & 0xffffu); vt[5 * 260] = (unsigned short)(vv[c].z >> 16); vt[6 * 260] = (unsigned short)(vv[c].w & 0xffffu); vt[7 * 260] = (unsigned short)(vv[c].w >> 16); }
                    } else {
#pragma unroll 1
                    for (int c0 = 0; c0 < 5; c0 += 3) {
                        v4u kv[3], vv[3];
#pragma unroll
                        for (int c = 0; c < 3; ++c) { const int id = t256 + 256 * (c0 + c), key = id >> 3, ch = id & 7;
                            kv[c] = (v4u){0u, 0u, 0u, 0u}; vv[c] = (v4u){0u, 0u, 0u, 0u};
                            if (c0 + c < 5) {
                            if (key < 128) { const size_t off = ((size_t)b * 128 + key) * 256 + kvh * 64 + ch * 8;
                                const f32x4 k0 = *(const f32x4*)(ck + off), k1 = *(const f32x4*)(ck + off + 4), v0 = *(const f32x4*)(cv + off), v1 = *(const f32x4*)(cv + off + 4);
                                kv[c].x = pk2(k0[0], k0[1]); kv[c].y = pk2(k0[2], k0[3]); kv[c].z = pk2(k1[0], k1[1]); kv[c].w = pk2(k1[2], k1[3]);
                                vv[c].x = pk2(v0[0], v0[1]); vv[c].y = pk2(v0[2], v0[3]); vv[c].z = pk2(v1[0], v1[1]); vv[c].w = pk2(v1[2], v1[3]); }
                            else if (key < 136) { const size_t off = (size_t)(MP + b * 8 + (key - 128)) * 256 + kvh * 64 + ch * 8; kv[c] = *(const v4u*)(Kb + off); vv[c] = *(const v4u*)(Vb + off); } } }
#pragma unroll
                        for (int c = 0; c < 3; ++c) if (c0 + c < 5) { const int id = t256 + 256 * (c0 + c), key = id >> 3, ch = id & 7;
                            *(LAS v4u*)(Ks + key * 144 + ch * 16) = kv[c];
                            LAS unsigned short* vt = (LAS unsigned short*)(Vs + (ch * 8) * 520 + key * 2);
                            vt[0 * 260] = (unsigned short)(vv[c].x & 0xffffu); vt[1 * 260] = (unsigned short)(vv[c].x >> 16); vt[2 * 260] = (unsigned short)(vv[c].y & 0xffffu); vt[3 * 260] = (unsigned short)(vv[c].y >> 16);
                            vt[4 * 260] = (unsigned short)(vv[c].z & 0xffffu); vt[5 * 260] = (unsigned short)(vv[c].z >> 16); vt[6 * 260] = (unsigned short)(vv[c].w & 0xffffu); vt[7 * 260] = (unsigned short)(vv[c].w >> 16); }
                    }
                    }
                    __syncthreads();
                    const int ntask = samp ? (((wave & 3) == 0) ? 1 : 0) : 2;
                    for (int ti = 0; ti < ntask; ++ti) {
                        int qrow, head, tloc, kb0, jkmin;
                        if (!samp) { const int sb = 2 * (wave & 1) + ti; head = kvh * 4 + (wave >> 1); tloc = 32 * sb + r32; qrow = (b << 13) + qblk * 128 + tloc; kb0 = sb; jkmin = (qblk == 0) ? 128 : 0; }
                        else { head = kvh * 4 + (r32 >> 3); tloc = r32 & 7; qrow = MP + b * 8 + tloc; kb0 = 0; jkmin = 0; }
                        attn_task(Ks, Vs, Qb, Ob, sinks, qrow, head, tloc, kb0, jkmin, lane);
                    }
                    __syncthreads();
                }
            }
            SEAM(pb + 1);
            if (EN_OPJ && IN(pb + 2)) {
                FRESH_PTRS;
                pg8::GemmX g{Ob, (const bf16*)(ws + WS_WO) + (size_t)j * D * D, nullptr, D}; pg8::StaticOrder S; S.init(MP, D, G, bx);
                pg8::EpiRes E{XB, ssp};
                pg8::gemm_phase_x<pg8::EpiRes, pg8::StaticOrder>(L, g, S, E);
            }
            SEAM(pb + 2);
        } else {
#define SSMT(gg) const SsmT T_{(const bf16*)(ws + WS_BT) + ((size_t)j * NG + (gg)) * 128 * 16, (const bf16*)(ws + WS_CT) + ((size_t)j * NG + (gg)) * 16 * 128, (const float*)(ws + WS_TAB) + ((size_t)j * NG + (gg)) * NS * 4, \
                          INP(19) + (size_t)j * D + (gg) * 16, INP(6) + (size_t)l * D + (gg) * 16}
            if (EN_S1 && IN(pb)) for (int rp = 0; rp < NREP(2); ++rp) {
                FRESH_IDS; FRESH_PTRS; LAS unsigned char* wl = L + wave * 9728; LAS float* rvs = (LAS float*)(L + 8 * 9728);
                for (int u = gw; u < (NCH - 1) * NG; u += NGW) {
                    int lane = tid & 63; asm volatile("" : "+v"(lane));
                    const int g = u & 63, ch = u >> 6, hb = lane >> 5;
                    wg_rinv(rvs, ssp, ch * CH, SEQ + ch * CH, false, tid);
                    SSMT(g);
                    float st[4] = {0.f, 0.f, 0.f, 0.f};
                    ssm_mfma_unit<0>(wl, lane, g, T_, XB, rvs, ch * CH, SEQ + ch * CH, CH / 16, st, nullptr, nullptr, nullptr, nullptr, nullptr, 0);
                    { float* hs = HS + ((size_t)((hb * NCH + ch) * NG + g) * NS) * 2; const int r32 = lane & 31; *(float2*)(hs + 2 * r32) = make_float2(st[0], st[1]); *(float2*)(hs + 2 * (32 + r32)) = make_float2(st[2], st[3]); }
                }
                __syncthreads();
            }
            SEAM(pb);
            if (EN_S3 && IN(pb + 1)) for (int rp = 0; rp < NREP(2); ++rp) {
                FRESH_IDS; FRESH_PTRS; LAS unsigned char* wl = L + wave * 9728; LAS float* rvs = (LAS float*)(L + 8 * 9728);
                for (int u = gw; u < NCH * NG + (SB / 4) * NG; u += NGW) {
                    int lane = tid & 63; asm volatile("" : "+v"(lane));
                    if (u < NCH * NG) {
                        const int g = u & 63, ch = u >> 6, r32 = lane & 31, hb = lane >> 5;
                        wg_rinv(rvs, ssp, ch * CH, SEQ + ch * CH, false, tid);
                        SSMT(g);
                        float st[4] = {0.f, 0.f, 0.f, 0.f};
                        float aLr[2], aLi[2];
#pragma unroll
                        for (int p = 0; p < 2; ++p) {
                            const f32x4 tv = *(const f32x4*)(T_.tab + (size_t)(32 * p + r32) * 4);
                            float xr_ = tv[0], xi_ = tv[1];
#pragma unroll
                            for (int sq = 0; sq < 8; ++sq) { const float tr = xr_ * xr_ - xi_ * xi_, ti = 2.0f * xr_ * xi_; xr_ = tr; xi_ = ti; }
                            aLr[p] = xr_; aLi[p] = xi_;
                        }
                        for (int i0 = 0; i0 < ch; i0 += 8) {
                            float2 e[8][2];
#pragma unroll
                            for (int k = 0; k < 8; ++k)
#pragma unroll
                                for (int p = 0; p < 2; ++p) e[k][p] = (i0 + k < ch) ? *(const float2*)(HS + ((size_t)((hb * NCH + i0 + k) * NG + g) * NS + 32 * p + r32) * 2) : make_float2(0.f, 0.f);
#pragma unroll
                            for (int k = 0; k < 8; ++k) if (i0 + k < ch) {
#pragma unroll
                                for (int p = 0; p < 2; ++p) { const float tr = aLr[p] * st[2 * p] - aLi[p] * st[2 * p + 1] + e[k][p].x, ti = aLr[p] * st[2 * p + 1] + aLi[p] * st[2 * p] + e[k][p].y; st[2 * p] = tr; st[2 * p + 1] = ti; }
                            }
                        }
                        ssm_mfma_unit<1>(wl, lane, g, T_, XB, rvs, ch * CH, SEQ + ch * CH, CH / 16, st, Ob, nullptr, nullptr, nullptr, nullptr, 0);
                        if (ch == NCH - 1) { float* hr_o = out + O_HRP + ((size_t)(j * NB + hb) * NG + g) * NS; float* hi_o = out + O_HIP + ((size_t)(j * NB + hb) * NG + g) * NS;
                            hr_o[r32] = st[0]; hi_o[r32] = st[1]; hr_o[32 + r32] = st[2]; hi_o[32 + r32] = st[3]; }
                    } else {
                        const int us = u - NCH * NG, g = us & 63, bb = us >> 6;
                        wg_rinv(rvs, ssp, MP + bb * 32, 0, true, tid);
                        SSMT(g);
                        float st[4] = {0.f, 0.f, 0.f, 0.f};
                        ssm_mfma_unit<2>(wl, lane, g, T_, XB, rvs, MP + bb * 32, MP + bb * 32 + 16, 1, st, Ob, INP(4) + (size_t)j * SB * NG * NS, INP(5) + (size_t)j * SB * NG * NS, out + O_HRS + (size_t)j * SB * NG * NS, out + O_HIS + (size_t)j * SB * NG * NS, bb * 4);
                    }
                }
                __syncthreads();
            }
            SEAM(pb + 1);
            if (EN_GLU && IN(pb + 2)) {
                FRESH_PTRS;
                pg8::GemmX g{Ob, (const bf16*)(ws + WS_WGLU) + (size_t)j * 2 * D * D, nullptr, D}; pg8::StaticOrder S; S.init(MP, 2 * D, G, bx);
                pg8::EpiGlu E{XB, ssp};
                pg8::gemm_phase_x<pg8::EpiGlu, pg8::StaticOrder>(L, g, S, E);
            }
            SEAM(pb + 2);
        }
        if (EN_UP && IN(pb + 3)) for (int rp = 0; rp < NREP(4); ++rp) {
            FRESH_PTRS;
            pg8::GemmX g{XB, (const bf16*)(ws + WS_WUP) + (size_t)l * FF * D, nullptr, D}; pg8::StaticOrder S; S.init(MP, FF, G, bx);
            pg8::EpiUp E{Hb, (bf16*)(ws + WS_H + 128 * MiB), ssp, (l & 1) ? 32 : 16, (l & 1) ? 64 : 32};
            if (threadIdx.x == 0) *(LAS int*)(L + pg8::RINV_TAB_OFF + 1152) = -1;
            __syncthreads();
            pg8::gemm_phase_x<pg8::EpiUp, pg8::StaticOrder, NREP(5), NREP(6), 0>(L, g, S, E);
        }
        SEAM(pb + 3);
        if (EN_DN && IN(pb + 4)) {
            FRESH_PTRS;
            pg8::GemmX g{Hb, (const bf16*)(ws + WS_WDN) + (size_t)l * D * FF, (const bf16*)(ws + WS_H + 128 * MiB), FF}; pg8::StaticOrder S; S.init(MP, D, G, bx);
            pg8::EpiRes E{XB, ssp};
            pg8::gemm_phase_x<pg8::EpiRes, pg8::StaticOrder, 1, 1, 0, true>(L, g, S, E);
        }
        SEAM(pb + 4);
    }
    if (EN_FIN && IN(21)) {
        FRESH_IDS; FRESH_PTRS;
        const float* gf = INP(8);
        for (int m = gw; m < M; m += NGW) {
            const float pv = (lane < ((m < MP) ? 16 : 32)) ? ssp[(size_t)m * 64 + lane] : 0.f;
            const float rinv = rsqrtf(wave_sum(pv) * (1.0f / 1024.0f) + 1e-6f);
            const bf16* xb = XB + (size_t)m * D + 4 * lane; float* yo = out + (size_t)m * D + 4 * lane;
#pragma unroll
            for (int jx = 0; jx < 4; ++jx) { const f32x4 gv = *(const f32x4*)(gf + 256 * jx + 4 * lane); const f32x4 v = pg8::unpack4(*(const u32x2*)(xb + 256 * jx)) * rinv * gv; *(f32x4*)(yo + 256 * jx) = v; }
        }
    }
#undef IN
#undef SEAM
}

#ifndef MK_SPLIT
#define MK_SPLIT 0
#endif
extern "C" void kernel_launch(void* const* d_in, const int* in_sizes, int n_in, void* d_out, int out_size, void* d_ws, size_t ws_size, hipStream_t stream) {
    static int grid = 0;
    if (grid == 0) {
        if (n_in != 23 || in_sizes[0] != MP * D || (size_t)out_size != O_END || ws_size < WS_END) { fprintf(stderr, "kernel_launch: unexpected shapes (n_in %d, in0 %d, out %d, ws %zu); nothing launched\n", n_in, n_in > 0 ? in_sizes[0] : -1, out_size, ws_size); grid = -1; return; }
        int dev = 0, cus = 0, per_cu = 0;
        if (hipGetDevice(&dev) != hipSuccess || hipDeviceGetAttribute(&cus, hipDeviceAttributeMultiprocessorCount, dev) != hipSuccess) { fprintf(stderr, "kernel_launch: device query failed\n"); grid = -1; return; }
        if (hipFuncSetAttribute((const void*)fwd_kernel, hipFuncAttributeMaxDynamicSharedMemorySize, LDS_BYTES) != hipSuccess) { fprintf(stderr, "kernel_launch: hipFuncSetAttribute failed\n"); grid = -1; return; }
        if (hipOccupancyMaxActiveBlocksPerMultiprocessor(&per_cu, (const void*)fwd_kernel, 512, LDS_BYTES) != hipSuccess || per_cu < 1) fprintf(stderr, "kernel_launch: note: occupancy query reports %d blocks per CU\n", per_cu);
        (void)hipGetLastError();
        grid = cus;
    }
    if (grid < 0) return;
    (void)hipMemsetAsync((char*)d_ws + WS_CTL, 0, CTL_ZERO_BYTES, stream);
    Args a{};
    for (int i = 0; i < 23; ++i) a.in[i] = (const float*)d_in[i];
    a.out = (float*)d_out; a.ws = (unsigned char*)d_ws;
#if MK_SPLIT
    for (int p = 0; p < NPHASE; ++p) { a.ph_lo = p; a.ph_hi = p + 1; hipLaunchKernelGGL(fwd_kernel, dim3(grid), dim3(512), LDS_BYTES, stream, a); }
#else
    a.ph_lo = 0; a.ph_hi = NPHASE; hipLaunchKernelGGL(fwd_kernel, dim3(grid), dim3(512), LDS_BYTES, stream, a);
#endif
}
```

```cpp
#include <hip/hip_runtime.h>
#include <cstdio>
#include <cstdint>
namespace pg8 {
#define PG8_LAS __attribute__((address_space(3)))
typedef unsigned short bf16_t;
typedef short bf16x8 __attribute__((ext_vector_type(8)));
typedef float f32x4 __attribute__((ext_vector_type(4)));
typedef unsigned u32x4 __attribute__((ext_vector_type(4)));
constexpr int BM = 256, BK = 64, HALF = 128, HTB = HALF * BK * 2  , STAGE_BYTES = 8 * HTB, NXCD = 8, WGM = 8;

__host__ __device__ __forceinline__ int lds_byte(int r, int c) { const int st = (r >> 4) * 2 + (c >> 5), rr = r & 15, cc = c & 31, ob = rr * 64 + cc * 2; return st * 1024 + (ob ^ (((ob >> 9) & 1) << 5)); }
__host__ __device__ __forceinline__ void stage_rc(int b, int& R, int& C) { const int st = b / 1024, sb = b % 1024, swz = sb ^ (((sb >> 9) & 1) << 5); R = (st >> 1) * 16 + swz / 64; C = (st & 1) * 32 + (swz % 64) / 2; }
__host__ __device__ __forceinline__ int perm32(int rho) { const int n = rho >> 4, i = rho & 15; return 8 * (i >> 2) + 4 * n + (i & 3); }

struct Unit { int pm, pn; };
struct Gemm { const bf16_t* A; const bf16_t* Bt; int M, N, K; };

struct StaticOrder {
    int nM, nN, nwg, G, c;
    __host__ __device__ void init(int M, int N, int G_, int c_) { nM = M / BM; nN = N / BM; nwg = nM * nN; G = G_; c = c_; }
    __host__ __device__ bool next(int i, Unit& u) const {
        const long L = (long)i * G + c; if (L >= nwg) return false;
        int wgid = (int)L; { const int q = nwg / NXCD, r = nwg % NXCD, xcd = wgid % NXCD, off = wgid / NXCD; wgid = (xcd < r ? xcd * (q + 1) : r * (q + 1) + (xcd - r) * q) + off; }
        const int nig = WGM * nN, gid = wgid / nig, fm = gid * WGM, gsz = (nM - fm) < WGM ? (nM - fm) : WGM;
        u.pm = fm + ((wgid % nig) % gsz); u.pn = (wgid % nig) / gsz; return true;
    }
    __device__ __forceinline__ void a_ready(const Unit&) const {}
    __device__ __forceinline__ void done(const Unit&) const {}
};
__device__ __forceinline__ unsigned cvt_pk_bf16(float lo, float hi) { unsigned r; asm volatile("v_cvt_pk_bf16_f32 %0, %1, %2" : "=v"(r) : "v"(lo), "v"(hi)); return r; }
typedef float f32x2 __attribute__((ext_vector_type(2)));
template <class Epi, class Sched, bool ALIGN_EPI = false, bool SP2 = false>
__device__ __forceinline__ void gemm_phase(PG8_LAS unsigned char* lds, const Gemm g, const Sched& S, const Epi& E) {
    int tid_ = threadIdx.x; asm volatile("" : "+v"(tid_));
    const int tid = tid_, wid = __builtin_amdgcn_readfirstlane(tid >> 6), lane = tid & 63, wr = wid >> 2, wc = wid & 3, fr = lane & 15, fq = lane >> 4;
    const int K = g.K, nt = K / BK;
    unsigned voffA[2], voffB[2];
#pragma unroll
    for (int i = 0; i < 2; ++i) { int R, C; stage_rc(tid * 16 + i * 8192, R, C); const int Rb = Epi::PERM ? ((R & ~31) + perm32(R & 31)) : R;
        voffA[i] = (unsigned)(R * K + C) * 2u; voffB[i] = (unsigned)(Rb * K + C) * 2u; }
    const size_t kstep = (size_t)(BK * 2);
    const size_t hstep = (size_t)HALF * K * 2;
    const size_t tstep = 2 * hstep;
    const unsigned ldsw = (unsigned)wid * 1024u;
    const int aoff = lds_byte(wr * 64 + fr, fq * 8), boff = lds_byte(wc * 32 + fr, fq * 8);
#define PG8_SA(b, h) (((b) * 2 + (h)) * HTB)
#define PG8_SB(b, h) ((4 + (b) * 2 + (h)) * HTB)
#define PG8_STAGE(bufoff, gbase, voff) do { _Pragma("unroll") for (int _i = 0; _i < 2; ++_i) \
        __builtin_amdgcn_global_load_lds((const unsigned*)((const char*)(gbase) + (voff)[_i]), (PG8_LAS unsigned*)(lds + (bufoff) + ldsw + _i * 8192), 16, 0, 0); } while (0)
#define PG8_LDA(dst, b, h) do { _Pragma("unroll") for (int m = 0; m < 4; ++m) _Pragma("unroll") for (int k = 0; k < 2; ++k) dst[m][k] = *(const PG8_LAS bf16x8*)(lds + PG8_SA(b, h) + aoff + m * 2048 + k * 1024); } while (0)
#define PG8_LDB(dst, b, h) do { _Pragma("unroll") for (int n = 0; n < 2; ++n) _Pragma("unroll") for (int k = 0; k < 2; ++k) dst[n][k] = *(const PG8_LAS bf16x8*)(lds + PG8_SB(b, h) + boff + n * 2048 + k * 1024); } while (0)
#define PG8_MMA(ai, bj, At, Bt) do { __builtin_amdgcn_s_setprio(1); _Pragma("unroll") for (int m = 0; m < 4; ++m) _Pragma("unroll") for (int n = 0; n < 2; ++n) _Pragma("unroll") for (int k = 0; k < 2; ++k) \
        acc[ai][bj][m][n] = __builtin_amdgcn_mfma_f32_16x16x32_bf16(Bt[n][k], At[m][k], acc[ai][bj][m][n], 0, 0, 0); __builtin_amdgcn_s_setprio(0); } while (0)
#define PG8_WAIT_V(n) asm volatile("s_waitcnt vmcnt(" #n ")" ::: "memory")
#define PG8_WAIT_L(n) asm volatile("s_waitcnt lgkmcnt(" #n ")" ::: "memory")
#define PG8_BAR __builtin_amdgcn_s_barrier()
#define PG8_SCHED __builtin_amdgcn_sched_barrier(0)
    Unit cur, nxt; int ui = 0;
    if (!S.next(0, cur)) return;
    f32x4 acc[2][2][4][2];
#pragma unroll
    for (int a = 0; a < 2; ++a)
#pragma unroll
        for (int b = 0; b < 2; ++b)
#pragma unroll
            for (int m = 0; m < 4; ++m)
#pragma unroll
                for (int n = 0; n < 2; ++n) acc[a][b][m][n] = (f32x4){0.f, 0.f, 0.f, 0.f};
    bf16x8 At[4][2], B0[2][2], B1[2][2];
    const char* cA = (const char*)g.A + (size_t)cur.pm * tstep; const char* cB = (const char*)g.Bt + (size_t)cur.pn * tstep;
    S.a_ready(cur);
    if constexpr (SP2) {
        PG8_STAGE(PG8_SB(0, 0), cB, voffB); PG8_STAGE(PG8_SB(0, 1), cB + hstep, voffB); PG8_STAGE(PG8_SA(0, 0), cA, voffA); PG8_STAGE(PG8_SA(0, 1), cA + hstep, voffA);
        if (wr == 1) PG8_BAR;
        PG8_WAIT_V(2); PG8_BAR;
        PG8_STAGE(PG8_SB(1, 0), cB + kstep, voffB); PG8_STAGE(PG8_SA(1, 0), cA + kstep, voffA); PG8_STAGE(PG8_SB(1, 1), cB + hstep + kstep, voffB);
        PG8_WAIT_V(6); PG8_BAR;
    } else {
        PG8_STAGE(PG8_SB(0, 0), cB, voffB); PG8_STAGE(PG8_SA(0, 0), cA, voffA); PG8_STAGE(PG8_SB(0, 1), cB + hstep, voffB); PG8_STAGE(PG8_SA(0, 1), cA + hstep, voffA);
        if (wr == 1) PG8_BAR;
        PG8_WAIT_V(4); PG8_BAR;
        PG8_STAGE(PG8_SB(1, 0), cB + kstep, voffB); PG8_STAGE(PG8_SA(1, 0), cA + kstep, voffA); PG8_STAGE(PG8_SB(1, 1), cB + hstep + kstep, voffB);
        PG8_WAIT_V(6); PG8_BAR;
    }
    for (;;) {
        const bool has_next = S.next(ui + 1, nxt);
        const char* nA = has_next ? (const char*)g.A + (size_t)nxt.pm * tstep : cA; const char* nB = has_next ? (const char*)g.Bt + (size_t)nxt.pn * tstep : cB;
        for (int t = 0; t < nt; t += 2) {
            const bool last = (t == nt - 2);
            const char* a1 = cA + (size_t)(t + 1) * kstep;
            const char* a2 = last ? nA : cA + (size_t)(t + 2) * kstep; const char* b2 = last ? nB : cB + (size_t)(t + 2) * kstep;
            const char* a3 = a2 + kstep; const char* b3 = b2 + kstep;
            if (last && has_next) S.a_ready(nxt);
            if constexpr (SP2) {
            PG8_LDB(B0, 0, 0); PG8_LDB(B1, 0, 1); PG8_SCHED; PG8_LDA(At, 0, 0); PG8_STAGE(PG8_SA(1, 1), a1 + hstep, voffA);
            PG8_WAIT_V(8); PG8_WAIT_L(0); PG8_BAR; PG8_MMA(0, 0, At, B0); PG8_MMA(0, 1, At, B1); PG8_BAR; PG8_SCHED;
            PG8_LDA(At, 0, 1); PG8_STAGE(PG8_SB(0, 0), b2, voffB); PG8_STAGE(PG8_SB(0, 1), b2 + hstep, voffB); PG8_STAGE(PG8_SA(0, 0), a2, voffA);
            PG8_WAIT_V(8); PG8_WAIT_L(0); PG8_BAR; PG8_MMA(1, 0, At, B0); PG8_MMA(1, 1, At, B1); PG8_BAR; PG8_SCHED;
            PG8_LDB(B0, 1, 0); PG8_LDB(B1, 1, 1); PG8_SCHED; PG8_LDA(At, 1, 0); PG8_STAGE(PG8_SA(0, 1), a2 + hstep, voffA);
            PG8_WAIT_V(8); PG8_WAIT_L(0); PG8_BAR; PG8_MMA(0, 0, At, B0); PG8_MMA(0, 1, At, B1); PG8_BAR; PG8_SCHED;
            PG8_LDA(At, 1, 1); PG8_STAGE(PG8_SB(1, 0), b3, voffB); PG8_STAGE(PG8_SB(1, 1), b3 + hstep, voffB); PG8_STAGE(PG8_SA(1, 0), a3, voffA);
            PG8_WAIT_V(8); PG8_WAIT_L(0); PG8_BAR; PG8_MMA(1, 0, At, B0); PG8_MMA(1, 1, At, B1); PG8_BAR; PG8_SCHED;
            } else {
            PG8_LDB(B0, 0, 0); PG8_SCHED; PG8_LDA(At, 0, 0); PG8_STAGE(PG8_SA(1, 1), a1 + hstep, voffA);
            PG8_WAIT_L(8); PG8_BAR; PG8_WAIT_L(0); PG8_MMA(0, 0, At, B0); PG8_BAR; PG8_SCHED;
            PG8_LDB(B1, 0, 1); PG8_STAGE(PG8_SB(0, 0), b2, voffB);
            PG8_BAR; PG8_WAIT_L(0); PG8_MMA(0, 1, At, B1); PG8_BAR;
            PG8_LDA(At, 0, 1); PG8_STAGE(PG8_SA(0, 0), a2, voffA);
            PG8_BAR; PG8_WAIT_L(0); PG8_MMA(1, 0, At, B0); PG8_BAR; PG8_SCHED;
            PG8_STAGE(PG8_SB(0, 1), b2 + hstep, voffB);
            PG8_WAIT_V(6); PG8_BAR; PG8_MMA(1, 1, At, B1); PG8_BAR;
            PG8_LDB(B0, 1, 0); PG8_SCHED; PG8_LDA(At, 1, 0); PG8_STAGE(PG8_SA(0, 1), a2 + hstep, voffA);
            PG8_WAIT_L(8); PG8_BAR; PG8_WAIT_L(0); PG8_MMA(0, 0, At, B0); PG8_BAR; PG8_SCHED;
            PG8_LDB(B1, 1, 1); PG8_STAGE(PG8_SB(1, 0), b3, voffB);
            PG8_BAR; PG8_WAIT_L(0); PG8_MMA(0, 1, At, B1); PG8_BAR;
            PG8_LDA(At, 1, 1); PG8_STAGE(PG8_SA(1, 0), a3, voffA);
            PG8_BAR; PG8_WAIT_L(0); PG8_MMA(1, 0, At, B0); PG8_BAR; PG8_SCHED;
            PG8_STAGE(PG8_SB(1, 1), b3 + hstep, voffB);
            PG8_WAIT_V(6); PG8_BAR; PG8_MMA(1, 1, At, B1); PG8_BAR;
            }
        }
        if constexpr (ALIGN_EPI) { if (wr == 0) PG8_BAR; }
        if constexpr (!Epi::AFTER_DRAIN) { E(acc, cur, wr, wc, fr, fq); S.done(cur); }
        if (!has_next) break;
#pragma unroll
        for (int a = 0; a < 2; ++a)
#pragma unroll
            for (int b = 0; b < 2; ++b)
#pragma unroll
                for (int m = 0; m < 4; ++m)
#pragma unroll
                    for (int n = 0; n < 2; ++n) acc[a][b][m][n] = (f32x4){0.f, 0.f, 0.f, 0.f};
        cur = nxt; cA = nA; cB = nB; ++ui;
        if constexpr (ALIGN_EPI) { if (wr == 1) PG8_BAR; }
    }
    PG8_WAIT_V(0);
    if constexpr (!ALIGN_EPI) { if (wr == 0) PG8_BAR; }
    PG8_BAR;
    if constexpr (Epi::AFTER_DRAIN) { E.fused(acc, cur, wr, wc, fr, fq, lds, wid, lane); S.done(cur); }
#undef PG8_SA
#undef PG8_SB
#undef PG8_STAGE
#undef PG8_LDA
#undef PG8_LDB
#undef PG8_MMA
#undef PG8_WAIT_V
#undef PG8_WAIT_L
#undef PG8_BAR
#undef PG8_SCHED
}
}
#define GAS __attribute__((address_space(1)))
#define LAS __attribute__((address_space(3)))
typedef unsigned short bf16;
typedef unsigned v4u __attribute__((ext_vector_type(4)));
typedef float f32x4 __attribute__((ext_vector_type(4)));
typedef short bf16x8 __attribute__((ext_vector_type(8)));
typedef GAS unsigned gu32;
typedef GAS unsigned long long gu64;
#define RLX_AGENT __ATOMIC_RELAXED, __HIP_MEMORY_SCOPE_AGENT
#define LDS_WAIT() asm volatile("s_waitcnt lgkmcnt(0)" ::: "memory")
#define VM_WAIT() asm volatile("s_waitcnt vmcnt(0)" ::: "memory")
__device__ __forceinline__ unsigned long long rt() { return __builtin_amdgcn_s_memrealtime(); }
__device__ __forceinline__ unsigned f2bf(float f) { unsigned u = __builtin_bit_cast(unsigned, f); return (u + 0x7fffu + ((u >> 16) & 1u)) >> 16; }
__device__ __forceinline__ unsigned pk2(float lo, float hi) { return f2bf(lo) | (f2bf(hi) << 16); }
#define XB_TMO      128
#define XB_XCNT(j)  (256  + 64 * (j))
#define XB_XSUB(j)  (1280 + 64 * (j))
#define XB_XGEN(j)  (2304 + 64 * (j))
#define XB_TOP      3328
#define XB_TOPGEN   3392
#define XB_LSUB(j)  (3520 + 64 * (j))
#define XCD_BAR_WORDS (3520 + 64 * 128)
#define XB_SPIN_CAP (1u << 18)
#define BAR_EARLY_INV 1
#define BAR_EARLY_WB 1
#if BAR_EARLY_INV
#define EARLY_INV() asm volatile("buffer_inv sc1" ::: "memory")
#define LATE_ACQ() asm volatile("" ::: "memory")
#else
#define EARLY_INV() do {} while (0)
#define LATE_ACQ() __builtin_amdgcn_fence(__ATOMIC_ACQUIRE, "agent")
#endif
#define BAR_POLL_SLEEP 1

__device__ __forceinline__ unsigned xb_ld(unsigned* p)              { return __hip_atomic_load(p, __ATOMIC_RELAXED, __HIP_MEMORY_SCOPE_AGENT); }
__device__ __forceinline__ unsigned xb_add(unsigned* p, unsigned v) { return __hip_atomic_fetch_add(p, v, __ATOMIC_RELAXED, __HIP_MEMORY_SCOPE_AGENT); }
__device__ __forceinline__ unsigned xb_xcc_id() { return (unsigned)__builtin_amdgcn_s_getreg((3 << 11) | 20) & 0xFu; }
#define XB_SPIN(cond, bar) do { unsigned _sp = 0; while (cond) { __builtin_amdgcn_s_sleep(1); \
    if ((++_sp & 255u) == 0u) { if (xb_ld(&(bar)[XB_TMO])) break; if (_sp > XB_SPIN_CAP) { atomicAdd(&(bar)[XB_TMO], 1u); break; } } } } while (0)

struct XcdBarrier {
    unsigned* bar; unsigned x;
    volatile LAS unsigned* st;
};

__device__ __forceinline__ XcdBarrier xcd_barrier_post(unsigned* bar, volatile LAS unsigned* st) {
    XcdBarrier b; b.bar = bar; b.x = xb_xcc_id(); b.st = st;
    if (threadIdx.x == 0) st[2] = xb_add(&bar[XB_XCNT(b.x)], 1u);
    return b;
}
__device__ __forceinline__ void xcd_barrier_complete(unsigned* bar, unsigned x, unsigned& nloc, unsigned& nx, unsigned& even) {
    const unsigned G = gridDim.x * gridDim.y * gridDim.z;
    unsigned sum, cnt, mine, ev, sp = 0u;
    for (;;) {
        sum = 0u; cnt = 0u; mine = 0u; ev = (G % 64u == 0u) ? 1u : 0u;
#pragma unroll
        for (unsigned j = 0; j < 16; ++j) { const unsigned c = xb_ld(&bar[XB_XCNT(j)]); sum += c; cnt += (c > 0u) ? 1u : 0u; mine = (j == x) ? c : mine; ev = (c == ((j < 8u) ? G / 8u : 0u)) ? ev : 0u; }
        if (sum == G) break;
        __builtin_amdgcn_s_sleep(1);
        if ((++sp & 255u) == 0u) { if (xb_ld(&bar[XB_TMO])) break; if (sp > XB_SPIN_CAP) { atomicAdd(&bar[XB_TMO], 1u); break; } }
    }
    nloc = mine > 0u ? mine : 1u; nx = cnt > 0u ? cnt : 1u; even = (sum == G) ? ev : 0u;
}

__device__ __forceinline__ void xcd_barrier(const XcdBarrier& b) {
    asm volatile("s_waitcnt vmcnt(0)" ::: "memory");
    __syncthreads();
    if (threadIdx.x == 0) {
        unsigned* bar = b.bar;
        __builtin_amdgcn_s_waitcnt(0);
        unsigned nloc = b.st[0], nx = b.st[1];
        if (nloc == 0u) { unsigned ev; xcd_barrier_complete(bar, b.x, nloc, nx, ev); b.st[0] = nloc; b.st[1] = nx; b.st[3] = ev; }
        const unsigned old = xb_add(&bar[XB_XSUB(b.x)], 1u);
        const unsigned gen = old / nloc;
        if (old + 1u == (gen + 1u) * nloc) {
            __builtin_amdgcn_fence(__ATOMIC_RELEASE, "agent");
            asm volatile("s_waitcnt vmcnt(0)" ::: "memory");
            const unsigned og = xb_add(&bar[XB_TOP], 1u);
            const unsigned tg = og / nx;
            if (og + 1u == (tg + 1u) * nx) xb_add(&bar[XB_TOPGEN], 1u);
            else XB_SPIN(xb_ld(&bar[XB_TOPGEN]) == tg, bar);
            __builtin_amdgcn_fence(__ATOMIC_ACQUIRE, "agent");
            xb_add(&bar[XB_XGEN(b.x)], 1u);
            asm volatile("s_waitcnt vmcnt(0)" ::: "memory");
        } else {
            XB_SPIN(xb_ld(&bar[XB_XGEN(b.x)]) == gen, bar);
            __builtin_amdgcn_fence(__ATOMIC_ACQUIRE, "agent");
            asm volatile("s_waitcnt vmcnt(0)" ::: "memory");
        }
    }
    __syncthreads();
}

__device__ __forceinline__ void flat_barrier(const XcdBarrier& b) {
    asm volatile("s_waitcnt vmcnt(0)" ::: "memory");
    __syncthreads();
    if (threadIdx.x == 0) {
        unsigned* bar = b.bar;
        __builtin_amdgcn_s_waitcnt(0);
        const unsigned r = b.st[0] + 1u; b.st[0] = r;
        __builtin_amdgcn_fence(__ATOMIC_RELEASE, "agent");
        asm volatile("s_waitcnt vmcnt(0)" ::: "memory");
        (void)xb_add(&bar[XB_XSUB(b.x & 7u)], 1u);
        const unsigned target = gridDim.x * r;
        unsigned sp = 0u;
        for (;;) {
            unsigned c[8];
#pragma unroll
            for (unsigned j = 0; j < 8; ++j) c[j] = xb_ld(&bar[XB_XSUB(j)]);
            const unsigned sum = ((c[0] + c[1]) + (c[2] + c[3])) + ((c[4] + c[5]) + (c[6] + c[7]));
            if (sum >= target) break;
            __builtin_amdgcn_s_sleep(1);
            if ((++sp & 255u) == 0u) { if (xb_ld(&bar[XB_TMO])) break; if (sp > XB_SPIN_CAP) { atomicAdd(&bar[XB_TMO], 1u); break; } }
        }
        __builtin_amdgcn_fence(__ATOMIC_ACQUIRE, "agent");
        asm volatile("s_waitcnt vmcnt(0)" ::: "memory");
    }
    __syncthreads();
}

__device__ __forceinline__ void xcd_barrier2(const XcdBarrier& b) {
    asm volatile("s_waitcnt vmcnt(0)" ::: "memory");
    __syncthreads();
    if (threadIdx.x == 0) {
        unsigned* bar = b.bar;
        __builtin_amdgcn_s_waitcnt(0);
        unsigned nloc = b.st[0], nx = b.st[1];
        if (nloc == 0u) { unsigned ev; xcd_barrier_complete(bar, b.x, nloc, nx, ev); b.st[0] = nloc; b.st[1] = nx; b.st[3] = ev; }
        EARLY_INV();
        const unsigned old = xb_add(&bar[XB_XSUB(b.x)], 1u);
        const unsigned gen = old / nloc;
        if (old + 1u == (gen + 1u) * nloc) {
            __builtin_amdgcn_fence(__ATOMIC_RELEASE, "agent");
            asm volatile("s_waitcnt vmcnt(0)" ::: "memory");
            (void)xb_add(&bar[XB_TOP], 1u);
        } else if (BAR_EARLY_WB && (old == gen * nloc || old == gen * nloc + (nloc >> 1))) {
            asm volatile("buffer_wbl2 sc1" ::: "memory");
        }
        const unsigned target = (gen + 1u) * nx;
        { unsigned _sp = 0; while (xb_ld(&bar[XB_TOP]) < target) { __builtin_amdgcn_s_sleep(BAR_POLL_SLEEP);
            if ((++_sp & 255u) == 0u) { if (xb_ld(&bar[XB_TMO])) break; if (_sp > XB_SPIN_CAP) { atomicAdd(&bar[XB_TMO], 1u); break; } } } }
        LATE_ACQ();
        asm volatile("s_waitcnt vmcnt(0)" ::: "memory");
    }
    __syncthreads();
}

__device__ __forceinline__ void xcd_local_barrier(const XcdBarrier& b) {
    asm volatile("s_waitcnt vmcnt(0)" ::: "memory");
    __syncthreads();
    if (threadIdx.x == 0) {
        unsigned* bar = b.bar;
        __builtin_amdgcn_s_waitcnt(0);
        const unsigned ngrp = b.st[0] >> 2, j = 4u * b.x + (b.st[2] & 3u);
        EARLY_INV();
        const unsigned old = xb_add(&bar[XB_LSUB(j)], 1u);
        const unsigned target = (old / ngrp + 1u) * ngrp;
        XB_SPIN(xb_ld(&bar[XB_LSUB(j)]) < target, bar);
        LATE_ACQ();
        asm volatile("s_waitcnt vmcnt(0)" ::: "memory");
    }
    __syncthreads();
}

constexpr int D = 1024, SEQ = 8192, NB = 2, MP = NB * SEQ, SB = 128, ST = 8, MS = SB * ST, M = MP + MS;
constexpr int NQKV = 1536, FF = 4096, NKV = 4, HD = 64, KVW = NKV * HD, NG = 64, GC = 16, NS = 64;
constexpr int CH = 256, NCH = SEQ / CH;
constexpr int NPHASE = 22;
constexpr size_t O_KP = 17825792, O_VP = 17956864, O_HRP = 18087936, O_HIP = 18104320, O_KS = 18120704, O_VS = 26509312, O_HRS = 34897920, O_HIS = 35946496, O_END = 36995072;
constexpr size_t MiB = 1u << 20;
constexpr size_t WS_CTL = 0, CTL_ZERO_BYTES = 64 * 1024;
constexpr size_t WS_SSP = 1 * MiB;
constexpr size_t WS_TAB = 5 * MiB + 512 * 1024;
constexpr size_t WS_HS = 6 * MiB;
constexpr size_t WS_WQKV = 8 * MiB, WS_WO = 14 * MiB, WS_WGLU = 18 * MiB, WS_WUP = 26 * MiB, WS_WDN = 58 * MiB;
constexpr size_t WS_XB = 90 * MiB;
constexpr size_t WS_H = 124 * MiB;
constexpr size_t WS_Q = 124 * MiB, WS_K = 158 * MiB, WS_V = 167 * MiB, WS_O = 176 * MiB;
constexpr size_t WS_BT = 260 * MiB, WS_CT = 261 * MiB;
constexpr size_t WS_END = 262 * MiB;
constexpr int CW_BAR = 4096;
static_assert((CW_BAR + XCD_BAR_WORDS) * 4 <= (int)CTL_ZERO_BYTES, "barrier words inside the memset region");
constexpr int RING_BYTES = 131072, XA_BYTES = 4096, LDSCTL_OFF = RING_BYTES + XA_BYTES  , MISC_OFF = LDSCTL_OFF + 320, LDS_BYTES = 147456;

__device__ __forceinline__ float wave_sum(float v) {
#pragma unroll
    for (int o = 1; o < 64; o <<= 1) v += __shfl_xor(v, o);
    return v;
}
__device__ __forceinline__ float wave_max(float v) {
#pragma unroll
    for (int o = 1; o < 64; o <<= 1) v = fmaxf(v, __shfl_xor(v, o));
    return v;
}
__device__ __forceinline__ float bf_lo(unsigned u) { return __uint_as_float(u << 16); }
__device__ __forceinline__ float bf_hi(unsigned u) { return __uint_as_float(u & 0xffff0000u); }

#define PROBE_DUP 0
#define PROBE_SSP2 0
#define PROBE_TM 0
#define PROBE_A 4
#define PROBE_S (((PROBE_DUP) >> 6) & 7)
namespace pg8 {
constexpr int XMP = 16384;
constexpr size_t XBX_OFF = (size_t)32 << 20;
__host__ __device__ __forceinline__ size_t xb_off(int row, int col) {
    return (row < XMP) ? ((size_t)((((row >> 8) * 16 + (col >> 6)) * 2 + ((row >> 7) & 1))) * 16384 + lds_byte(row & 127, col & 63))
                       : XBX_OFF + (size_t)((((row - XMP) >> 4) * 16 + (col >> 6))) * 2048 + lds_byte((row - XMP) & 15, col & 63);
}
struct PanelOrder {
    StaticOrder so; int grp, q, m, nN2;
    __device__ __forceinline__ void init(int M, int N, int G_, int c_, int grp_, int q_, int m_) { so.init(M, N, G_, c_); grp = grp_; q = q_; m = m_; nN2 = 2 * (N / BM); }
    __device__ __forceinline__ bool next(int i, Unit& u) const {
        if (!grp) return so.next(i, u);
        const int idx = m + 8 * i; if (idx >= nN2) return false;
        u.pm = (idx & 1) ? 32 + q : q; u.pn = idx >> 1; return true;
    }
    __device__ __forceinline__ void a_ready(const Unit&) const {}
    __device__ __forceinline__ void done(const Unit&) const {}
};
template <int NL>
__device__ __forceinline__ float row_rinv(const float* ssp, int row, int np, int fq) {
    const float* p = ssp + (size_t)row * 64 + (np >> 2) * fq;
    f32x4 v[NL];
#pragma unroll
    for (int i = 0; i < NL; ++i) v[i] = *(const f32x4*)(p + 4 * i);
    float s = 0.f, s2 = 0.f;
#pragma unroll
    for (int i = 0; i < NL / 2; ++i) { s += (v[i][0] + v[i][1]) + (v[i][2] + v[i][3]); s2 += (v[NL / 2 + i][0] + v[NL / 2 + i][1]) + (v[NL / 2 + i][2] + v[NL / 2 + i][3]); }
    s += (np == 16 * NL) ? s2 : 0.f;
    s += __shfl_xor(s, 16); s += __shfl_xor(s, 32);
    return rsqrtf(s * (1.0f / 1024.0f) + 1e-6f);
}
constexpr int RINV_TAB_OFF = 135680;
__device__ __forceinline__ void unit_rinv_to_lds(PG8_LAS unsigned char* lds, const float* ssp, int pm, int np, int nps) {
    int t = threadIdx.x; asm volatile("" : "+v"(t));
    PG8_LAS float* tab = (PG8_LAS float*)(lds + RINV_TAB_OFF);
    if (t < 288) {
        const bool smp = t >= 256; const int hf = smp ? ((t - 256) >> 4) : 0;
        const int row = smp ? XMP + pm * 16 + (t & 15) : pm * BM + t; const int n = (smp ? nps : np) - 32 * hf;
        const float* p = ssp + (size_t)row * 64 + 32 * hf;
        f32x4 v[8];
#pragma unroll
        for (int i = 0; i < 8; ++i) v[i] = *(const f32x4*)(p + 4 * i);
        float s = 0.f;
#pragma unroll
        for (int i = 0; i < 8; ++i) { const float si = (v[i][0] + v[i][1]) + (v[i][2] + v[i][3]); s += (4 * i < n) ? si : 0.f; }
        if (smp) s += __shfl_xor(s, 16);
        if (t < 272) tab[t] = rsqrtf(s * (1.0f / 1024.0f) + 1e-6f);
    }
    asm volatile("s_waitcnt lgkmcnt(0)" ::: "memory"); __builtin_amdgcn_s_barrier(); asm volatile("" ::: "memory");
}
__device__ __forceinline__ u32x4 pack8(const f32x4 a, const f32x4 b) { u32x4 w; w.x = cvt_pk_bf16(a[0], a[1]); w.y = cvt_pk_bf16(a[2], a[3]); w.z = cvt_pk_bf16(b[0], b[1]); w.w = cvt_pk_bf16(b[2], b[3]); return w; }
typedef unsigned u32x2 __attribute__((ext_vector_type(2)));
__device__ __forceinline__ u32x2 pack4(const f32x4 a) { u32x2 w; w.x = cvt_pk_bf16(a[0], a[1]); w.y = cvt_pk_bf16(a[2], a[3]); return w; }
__device__ __forceinline__ float sumsq4(const f32x4 v) { return (v[0] * v[0] + v[1] * v[1]) + (v[2] * v[2] + v[3] * v[3]); }

struct EpiQKV {
    static constexpr bool PERM = true, AFTER_DRAIN = false, INPLACE = false, RESID = false;
    __device__ __forceinline__ void load_resid(const Unit&, int, int, int, int, u32x4 (&)[8][2], u32x2 (&)[2]) const {}
    bf16_t *Q, *K, *V; const float* ssp; int np, nps; float *kp, *vp, *ks, *vs;
    __device__ __forceinline__ void prefetch(const Unit& u, PG8_LAS unsigned char* lds) const {
        PG8_LAS int* lastpm = (PG8_LAS int*)(lds + RINV_TAB_OFF + 1088 + 64);
        if (*lastpm != u.pm) { unit_rinv_to_lds(lds, ssp, u.pm, np, nps); if (threadIdx.x == 0) *lastpm = u.pm; } }
    __device__ __forceinline__ void operator()(const f32x4 (&acc)[2][2][4][2], const f32x4 (&accx)[2], const Unit& u, int wr, int wc, int fr, int fq, PG8_LAS unsigned char* lds) const {
        const int rowb = u.pm * BM + wr * 64 + fr, pn = u.pn;
        { PG8_LAS int* lastpm = (PG8_LAS int*)(lds + RINV_TAB_OFF + 1088 + 64);
          if (*lastpm != u.pm) { unit_rinv_to_lds(lds, ssp, u.pm, np, nps); if (threadIdx.x == 0) *lastpm = u.pm; } }
        float rr[2][4];
        { const PG8_LAS float* tab = (const PG8_LAS float*)(lds + RINV_TAB_OFF);
#pragma unroll
          for (int ai = 0; ai < 2; ++ai)
#pragma unroll
              for (int m = 0; m < 4; ++m) rr[ai][m] = tab[ai * HALF + wr * 64 + m * 16 + fr]; }
        const float rx = ((const PG8_LAS float*)(lds + RINV_TAB_OFF))[256 + fr];
#pragma unroll
        for (int ai = 0; ai < 2; ++ai)
#pragma unroll
            for (int m = 0; m < 4; ++m) {
                const int row = rowb + ai * HALF + m * 16;
                const float r = rr[ai][m];
#pragma unroll
                for (int bj = 0; bj < 2; ++bj) {
                    const f32x4 v0 = acc[ai][bj][m][0] * r, v1 = acc[ai][bj][m][1] * r;
                    const int cl = bj * HALF + wc * 32 + 8 * fq;
                    const u32x4 w = pack8(v0, v1);
                    if (pn < 4) { *(u32x4*)(Q + (size_t)row * 1024 + pn * 256 + cl) = w; }
                    else {
                        bf16_t* B = (pn == 4) ? K : V;
                        *(u32x4*)(B + (size_t)row * 256 + cl) = w;
                        const int t = row & 8191;
                        if (t >= 8064) { float* o = ((pn == 4) ? kp : vp) + ((size_t)(row >> 13) * 128 + (t - 8064)) * 256 + cl; *(f32x4*)o = v0; *(f32x4*)(o + 4) = v1; }
                    }
                }
            }
        {
            const int xrow = u.pm * 16 + fr, row = XMP + xrow;
            const float r = rx;
#pragma unroll
            for (int bj = 0; bj < 2; ++bj) {
                const f32x4 v = accx[bj] * r;
                const int cl = bj * HALF + wc * 32 + 8 * fq + 4 * wr;
                const u32x2 w = pack4(v);
                if (pn < 4) { *(u32x2*)(Q + (size_t)row * 1024 + pn * 256 + cl) = w; }
                else {
                    bf16_t* B = (pn == 4) ? K : V;
                    *(u32x2*)(B + (size_t)row * 256 + cl) = w;
                    float* o = ((pn == 4) ? ks : vs) + ((size_t)(xrow >> 3) * 128 + 120 + (xrow & 7)) * 256 + cl; *(f32x4*)o = v;
                }
            }
        }
    }
};
__device__ __forceinline__ void unpack8(const u32x4 w, f32x4& a, f32x4& b) {
    a[0] = __uint_as_float(w.x << 16); a[1] = __uint_as_float(w.x & 0xffff0000u); a[2] = __uint_as_float(w.y << 16); a[3] = __uint_as_float(w.y & 0xffff0000u);
    b[0] = __uint_as_float(w.z << 16); b[1] = __uint_as_float(w.z & 0xffff0000u); b[2] = __uint_as_float(w.w << 16); b[3] = __uint_as_float(w.w & 0xffff0000u); }
__device__ __forceinline__ f32x4 unpack4(const u32x2 w) { f32x4 a; a[0] = __uint_as_float(w.x << 16); a[1] = __uint_as_float(w.x & 0xffff0000u); a[2] = __uint_as_float(w.y << 16); a[3] = __uint_as_float(w.y & 0xffff0000u); return a; }
#define XB_STORE_NT 0
#if XB_STORE_NT
__device__ __forceinline__ void XB_STORE(const u32x4 v, u32x4* p) { __builtin_nontemporal_store(v, p); }
#else
__device__ __forceinline__ void XB_STORE(const u32x4 v, u32x4* p) { *p = v; }
#endif
struct EpiRes {
    static constexpr bool PERM = true, AFTER_DRAIN = false, INPLACE = false, RESID = true;
    bf16_t* XB; float* ssp;
    __device__ __forceinline__ void prefetch(const Unit&, PG8_LAS unsigned char*) const {}
    __device__ __forceinline__ void load_resid(const Unit& u, int wr, int wc, int fr, int fq, u32x4 (&o)[8][2], u32x2 (&ox)[2]) const {
        const int rowb = u.pm * BM + wr * 64 + fr, colb = u.pn * 256 + wc * 32 + 8 * fq, xrow = u.pm * 16 + fr;
#pragma unroll
        for (int am = 0; am < 8; ++am)
#pragma unroll
            for (int bj = 0; bj < 2; ++bj) o[am][bj] = *(const u32x4*)((const char*)XB + xb_off(rowb + (am >> 2) * HALF + (am & 3) * 16, colb + bj * HALF));
#pragma unroll
        for (int bj = 0; bj < 2; ++bj) ox[bj] = *(const u32x2*)((const char*)XB + xb_off(XMP + xrow, colb + bj * HALF + 4 * wr));
    }
    __device__ __forceinline__ void operator()(const f32x4 (&acc)[2][2][4][2], const f32x4 (&accx)[2], const Unit& u, int wr, int wc, int fr, int fq, PG8_LAS unsigned char* lds) const {
        const int rowb = u.pm * BM + wr * 64 + fr, pn = u.pn;
        const int colb = pn * 256 + wc * 32 + 8 * fq;
        const int xrow = u.pm * 16 + fr;
#pragma unroll
        for (int am = 0; am < 8; ++am) {
            const int ai = am >> 2, m = am & 3;
            const int row = rowb + ai * HALF + m * 16;
            float ss = 0.f;
#pragma unroll
            for (int bj = 0; bj < 2; ++bj) {
                const f32x4 v0 = acc[ai][bj][m][0], v1 = acc[ai][bj][m][1];
                XB_STORE(pack8(v0, v1), (u32x4*)((char*)XB + xb_off(row, colb + bj * HALF)));
                ss += sumsq4(v0) + sumsq4(v1);
            }
            ss += __shfl_xor(ss, 16); ss += __shfl_xor(ss, 32);
            if (fq == 0) { ssp[(size_t)row * 64 + pn * 4 + wc] = ss; if (PROBE_SSP2) ssp[(size_t)(263 * 262144) + (size_t)row * 64 + pn * 4 + wc] = ss; }
        }
        {
            const int row = XMP + xrow;
            float ss = 0.f;
#pragma unroll
            for (int bj = 0; bj < 2; ++bj) {
                const f32x4 v = accx[bj];
                *(u32x2*)((char*)XB + xb_off(XMP + xrow, colb + bj * HALF + 4 * wr)) = pack4(v);
                ss += sumsq4(v);
            }
            ss += __shfl_xor(ss, 16); ss += __shfl_xor(ss, 32);
            if (fq == 0) ssp[(size_t)row * 64 + (pn * 4 + wc) * 2 + wr] = ss;
        }
    }
};
struct EpiFin {
    static constexpr bool PERM = true, AFTER_DRAIN = false, INPLACE = false, RESID = true;
    const bf16_t* XB; float* ssp; const float* gf; float* out; XcdBarrier bar; bool loc;
    __device__ __forceinline__ void prefetch(const Unit&, PG8_LAS unsigned char*) const {}
    __device__ __forceinline__ void load_resid(const Unit& u, int wr, int wc, int fr, int fq, u32x4 (&o)[8][2], u32x2 (&ox)[2]) const {
        const int rowb = u.pm * BM + wr * 64 + fr, colb = u.pn * 256 + wc * 32 + 8 * fq, xrow = u.pm * 16 + fr;
#pragma unroll
        for (int am = 0; am < 8; ++am)
#pragma unroll
            for (int bj = 0; bj < 2; ++bj) o[am][bj] = *(const u32x4*)((const char*)XB + xb_off(rowb + (am >> 2) * HALF + (am & 3) * 16, colb + bj * HALF));
#pragma unroll
        for (int bj = 0; bj < 2; ++bj) ox[bj] = *(const u32x2*)((const char*)XB + xb_off(XMP + xrow, colb + bj * HALF + 4 * wr));
    }
    __device__ __forceinline__ void operator()(const f32x4 (&acc)[2][2][4][2], const f32x4 (&accx)[2], const Unit& u, int wr, int wc, int fr, int fq, PG8_LAS unsigned char* lds) const {
        const int rowb = u.pm * BM + wr * 64 + fr, pn = u.pn;
        const int colb = pn * 256 + wc * 32 + 8 * fq;
        const int xrow = u.pm * 16 + fr;
#pragma unroll
        for (int am = 0; am < 8; ++am) {
            const int ai = am >> 2, m = am & 3;
            float ss = (sumsq4(acc[ai][0][m][0]) + sumsq4(acc[ai][0][m][1])) + (sumsq4(acc[ai][1][m][0]) + sumsq4(acc[ai][1][m][1]));
            ss += __shfl_xor(ss, 16); ss += __shfl_xor(ss, 32);
            if (fq == 0) ssp[(size_t)(rowb + ai * HALF + m * 16) * 64 + pn * 4 + wc] = ss;
        }
        { float ss = sumsq4(accx[0]) + sumsq4(accx[1]); ss += __shfl_xor(ss, 16); ss += __shfl_xor(ss, 32);
          if (fq == 0) ssp[(size_t)(XMP + xrow) * 64 + (pn * 4 + wc) * 2 + wr] = ss; }
        if (loc) xcd_local_barrier(bar); else xcd_barrier2(bar);
        unit_rinv_to_lds(lds, ssp, u.pm, 16, 32);
        const PG8_LAS float* tab = (const PG8_LAS float*)(lds + RINV_TAB_OFF);
        f32x4 g0[2], g1[2];
#pragma unroll
        for (int bj = 0; bj < 2; ++bj) { g0[bj] = *(const f32x4*)(gf + colb + bj * HALF); g1[bj] = *(const f32x4*)(gf + colb + bj * HALF + 4); }
#pragma unroll
        for (int am = 0; am < 8; ++am) {
            const int ai = am >> 2, m = am & 3;
            const int row = rowb + ai * HALF + m * 16;
            const float r = tab[ai * HALF + wr * 64 + m * 16 + fr];
#pragma unroll
            for (int bj = 0; bj < 2; ++bj) { float* yo = out + (size_t)row * 1024 + colb + bj * HALF; *(f32x4*)yo = acc[ai][bj][m][0] * r * g0[bj]; *(f32x4*)(yo + 4) = acc[ai][bj][m][1] * r * g1[bj]; }
        }
        {
            const float r = tab[256 + fr];
#pragma unroll
            for (int bj = 0; bj < 2; ++bj) { const f32x4 gx = *(const f32x4*)(gf + colb + bj * HALF + 4 * wr); *(f32x4*)(out + (size_t)(XMP + xrow) * 1024 + colb + bj * HALF + 4 * wr) = accx[bj] * r * gx; }
        }
    }
};
#if PROBE_S
#define PS(x) ((x) * s)
#else
#define PS(x) (x)
#endif
struct EpiGlu {
    static constexpr bool PERM = true, AFTER_DRAIN = false, INPLACE = true, RESID = false;
    __device__ __forceinline__ void prefetch(const Unit&, PG8_LAS unsigned char*) const {}
    __device__ __forceinline__ void load_resid(const Unit&, int, int, int, int, u32x4 (&)[8][2], u32x2 (&)[2]) const {}
    bf16_t* XB; float* ssp;
#if PROBE_S
    float s;
#endif
    __device__ __forceinline__ void operator()(const f32x4 (&acc)[2][2][4][2], const f32x4 (&accx)[2], const Unit& u, int wr, int wc, int fr, int fq, PG8_LAS unsigned char* lds) const {
        const int rowb = u.pm * BM + wr * 64 + fr, pn = u.pn;
        const int col = pn * 128 + wc * 32 + 8 * fq;
        const int xrow = u.pm * 16 + fr;
        u32x2* xbx = (u32x2*)((char*)XB + xb_off(XMP + xrow, col + 4 * wr));
        const u32x2 ox = *xbx;
#pragma unroll
        for (int am = 0; am < 8; am += 4) {
            u32x4 o[4];
#pragma unroll
            for (int h = 0; h < 4; ++h) o[h] = *(const u32x4*)((const char*)XB + xb_off(rowb + ((am + h) >> 2) * HALF + ((am + h) & 3) * 16, col));
#pragma unroll
            for (int h = 0; h < 4; ++h) {
                const int ai = (am + h) >> 2, m = (am + h) & 3;
                const int row = rowb + ai * HALF + m * 16;
                f32x4 v0, v1; unpack8(o[h], v0, v1);
#pragma unroll
                for (int e = 0; e < 4; ++e) {
                    v0[e] += PS(acc[ai][0][m][0][e] * __builtin_amdgcn_rcpf(1.0f + __expf(-acc[ai][1][m][0][e])));
                    v1[e] += PS(acc[ai][0][m][1][e] * __builtin_amdgcn_rcpf(1.0f + __expf(-acc[ai][1][m][1][e])));
                }
                XB_STORE(pack8(v0, v1), (u32x4*)((char*)XB + xb_off(row, col)));
                float ss = sumsq4(v0) + sumsq4(v1);
                ss += __shfl_xor(ss, 16); ss += __shfl_xor(ss, 32);
                if (fq == 0) ssp[(size_t)row * 64 + pn * 4 + wc] = ss;
            }
            asm volatile("" ::: "memory");
        }
        {
            const int row = XMP + xrow;
            f32x4 v = unpack4(ox);
#pragma unroll
            for (int e = 0; e < 4; ++e) v[e] += PS(accx[0][e] * __builtin_amdgcn_rcpf(1.0f + __expf(-accx[1][e])));
            *xbx = pack4(v);
            float ss = sumsq4(v);
            ss += __shfl_xor(ss, 16); ss += __shfl_xor(ss, 32);
            if (fq == 0) ssp[(size_t)row * 64 + (pn * 4 + wc) * 2 + wr] = ss;
        }
    }
};
#define H_STORE_MODE 0
#if H_STORE_MODE == 1
__device__ __forceinline__ void H_STORE(const u32x4 v, u32x4* p) { asm volatile("global_store_dwordx4 %0, %1, off sc1" :: "v"(p), "v"(v) : "memory"); }
#else
__device__ __forceinline__ void H_STORE(const u32x4 v, u32x4* p) { __builtin_nontemporal_store(v, p); }
#endif
struct EpiUp {
    static constexpr bool PERM = true, AFTER_DRAIN = false, INPLACE = false, RESID = false;
    __device__ __forceinline__ void load_resid(const Unit&, int, int, int, int, u32x4 (&)[8][2], u32x2 (&)[2]) const {}
    __device__ __forceinline__ void prefetch(const Unit& u, PG8_LAS unsigned char* lds) const {
        PG8_LAS int* lastpm = (PG8_LAS int*)(lds + RINV_TAB_OFF + 1088 + 64);
        if (*lastpm != u.pm) { unit_rinv_to_lds(lds, ssp, u.pm, np, nps); if (threadIdx.x == 0) *lastpm = u.pm; } }
    bf16_t* H; bf16_t* Hx; const float* ssp; int np, nps;
    __device__ __forceinline__ void operator()(const f32x4 (&acc)[2][2][4][2], const f32x4 (&accx)[2], const Unit& u, int wr, int wc, int fr, int fq, PG8_LAS unsigned char* lds) const {
        const int rowb = u.pm * BM + wr * 64 + fr, pn = u.pn;
        { PG8_LAS int* lastpm = (PG8_LAS int*)(lds + RINV_TAB_OFF + 1088 + 64);
          if (*lastpm != u.pm) { unit_rinv_to_lds(lds, ssp, u.pm, np, nps); if (threadIdx.x == 0) *lastpm = u.pm; } }
        float rr[2][4];
        { const PG8_LAS float* tab = (const PG8_LAS float*)(lds + RINV_TAB_OFF);
#pragma unroll
          for (int ai = 0; ai < 2; ++ai)
#pragma unroll
              for (int m = 0; m < 4; ++m) rr[ai][m] = tab[ai * HALF + wr * 64 + m * 16 + fr]; }
        const float rx = ((const PG8_LAS float*)(lds + RINV_TAB_OFF))[256 + fr];
#pragma unroll
        for (int ai = 0; ai < 2; ++ai)
#pragma unroll
            for (int m = 0; m < 4; ++m) {
                const int row = rowb + ai * HALF + m * 16;
                const float r = rr[ai][m];
#pragma unroll
                for (int bj = 0; bj < 2; ++bj) {
                    f32x4 v0 = acc[ai][bj][m][0] * r, v1 = acc[ai][bj][m][1] * r;
#pragma unroll
                    for (int e = 0; e < 4; ++e) { const float a = fmaxf(v0[e], 0.f), b = fmaxf(v1[e], 0.f); v0[e] = a * a; v1[e] = b * b; }
                    H_STORE(pack8(v0, v1), (u32x4*)((char*)H + (((size_t)u.pm * 64 + (4 * pn + 2 * bj + (wc >> 1))) * 2 + ai) * 16384 + lds_byte(wr * 64 + m * 16 + fr, 32 * (wc & 1) + 8 * fq)));
                }
            }
        {
            const int xrow = u.pm * 16 + fr, row = XMP + xrow;
            const float r = rx;
#pragma unroll
            for (int bj = 0; bj < 2; ++bj) {
                f32x4 v = accx[bj] * r;
#pragma unroll
                for (int e = 0; e < 4; ++e) { const float a = fmaxf(v[e], 0.f); v[e] = a * a; }
                *(u32x2*)((char*)Hx + ((size_t)u.pm * 64 + (4 * pn + 2 * bj + (wc >> 1))) * 2048 + lds_byte(fr, 32 * (wc & 1) + 8 * fq) + 8 * wr) = pack4(v);
            }
        }
    }
};

struct GemmX { const bf16_t* A; const bf16_t* Bt; const bf16_t* Ax; int K; };
template <class Epi, class Sched, int KREP = 1, int EREP = 1, int SKEW_TICKS = 0, bool ATILED = false, int KOVR = 0>
__device__ __forceinline__ void gemm_phase_x(PG8_LAS unsigned char* lds, const GemmX g, const Sched& S, const Epi& E) {
    int tid_ = threadIdx.x; asm volatile("" : "+v"(tid_));
    const int tid = tid_, wid = __builtin_amdgcn_readfirstlane(tid >> 6), lane = tid & 63, wr = wid >> 2, wc = wid & 3, fr = lane & 15, fq = lane >> 4;
    int K_ = KOVR ? KOVR : g.K; if (KOVR) asm volatile("" : "+s"(K_));
    const int K = K_, nt = K / BK;
    unsigned voffA[2], voffB[2], voffX;
#pragma unroll
    for (int i = 0; i < 2; ++i) { int R, C; stage_rc(tid * 16 + i * 8192, R, C); const int Rb = Epi::PERM ? ((R & ~31) + perm32(R & 31)) : R;
        voffA[i] = ATILED ? (unsigned)(tid * 16 + i * 8192) : (unsigned)(R * K + C) * 2u; voffB[i] = (unsigned)(Rb * K + C) * 2u; }
    { int R, C; const int p = wid * 256 + lane * 4; stage_rc(p & ~15, R, C); voffX = ATILED ? (unsigned)p : (unsigned)(R * K + C) * 2u + (unsigned)(p & 15); }
    const size_t kstepB = (size_t)(BK * 2), hstepB = (size_t)HALF * K * 2, tstepB = 2 * hstepB;
    const size_t kstepA = ATILED ? (size_t)32768 : kstepB, hstepA = ATILED ? (size_t)16384 : hstepB, tstepA = ATILED ? (size_t)nt * 32768 : tstepB;
    const size_t kstepX = ATILED ? (size_t)2048 : kstepB, xstep = ATILED ? (size_t)nt * 2048 : (size_t)16 * K * 2;
    const unsigned ldsw = (unsigned)wid * 1024u, ldsx = (unsigned)wid * 256u;
    const int aoff = lds_byte(wr * 64 + fr, fq * 8), boff = lds_byte(wc * 32 + fr, fq * 8), xoff = lds_byte(fr, fq * 8);
#define PG8_SA(b, h) (((b) * 2 + (h)) * HTB)
#define PG8_SB(b, h) ((4 + (b) * 2 + (h)) * HTB)
#define PG8_XA(b) (STAGE_BYTES + (b) * 2048)
#define PG8_STAGE(bufoff, gbase, voff) do { _Pragma("unroll") for (int _i = 0; _i < 2; ++_i) \
        __builtin_amdgcn_global_load_lds((const unsigned*)((const char*)(gbase) + (voff)[_i]), (PG8_LAS unsigned*)(lds + (bufoff) + ldsw + _i * 8192), 16, 0, 0); } while (0)
#define PG8_STAGEX(b, gbase) __builtin_amdgcn_global_load_lds((const unsigned*)((const char*)(gbase) + voffX), (PG8_LAS unsigned*)(lds + PG8_XA(b) + ldsx), 4, 0, 0)
#define PG8_LDA(dst, b, h) do { _Pragma("unroll") for (int m = 0; m < 4; ++m) _Pragma("unroll") for (int k = 0; k < 2; ++k) dst[m][k] = *(const PG8_LAS bf16x8*)(lds + PG8_SA(b, h) + aoff + m * 2048 + k * 1024); } while (0)
#define PG8_LDB(dst, b, h) do { _Pragma("unroll") for (int n = 0; n < 2; ++n) _Pragma("unroll") for (int k = 0; k < 2; ++k) dst[n][k] = *(const PG8_LAS bf16x8*)(lds + PG8_SB(b, h) + boff + n * 2048 + k * 1024); } while (0)
#define PG8_LDX(dst, b) do { _Pragma("unroll") for (int k = 0; k < 2; ++k) dst[k] = *(const PG8_LAS bf16x8*)(lds + PG8_XA(b) + xoff + k * 1024); } while (0)
#define PG8_MMA(ai, bj, At, Bt) do { __builtin_amdgcn_s_setprio(1); _Pragma("unroll") for (int m = 0; m < 4; ++m) _Pragma("unroll") for (int n = 0; n < 2; ++n) _Pragma("unroll") for (int k = 0; k < 2; ++k) \
        acc[ai][bj][m][n] = __builtin_amdgcn_mfma_f32_16x16x32_bf16(Bt[n][k], At[m][k], acc[ai][bj][m][n], 0, 0, 0); __builtin_amdgcn_s_setprio(0); } while (0)
#define PG8_XMMA() do { if (wr == 0) { _Pragma("unroll") for (int k = 0; k < 2; ++k) { accx[0] = __builtin_amdgcn_mfma_f32_16x16x32_bf16(B0[0][k], Ax[k], accx[0], 0, 0, 0); accx[1] = __builtin_amdgcn_mfma_f32_16x16x32_bf16(B1[0][k], Ax[k], accx[1], 0, 0, 0); } } \
        else { _Pragma("unroll") for (int k = 0; k < 2; ++k) { accx[0] = __builtin_amdgcn_mfma_f32_16x16x32_bf16(B0[1][k], Ax[k], accx[0], 0, 0, 0); accx[1] = __builtin_amdgcn_mfma_f32_16x16x32_bf16(B1[1][k], Ax[k], accx[1], 0, 0, 0); } } } while (0)
#define PG8_WAIT_V(n) asm volatile("s_waitcnt vmcnt(" #n ")" ::: "memory")
#define PG8_WAIT_L(n) asm volatile("s_waitcnt lgkmcnt(" #n ")" ::: "memory")
#define PG8_BAR __builtin_amdgcn_s_barrier()
#define PG8_SCHED __builtin_amdgcn_sched_barrier(0)
    Unit cur, nxt; int ui = 0;
    if (!S.next(0, cur)) return;
    if (SKEW_TICKS > 0) { const unsigned long long t0 = __builtin_amdgcn_s_memrealtime(); const unsigned idx_ = blockIdx.x >> 3;
        const unsigned long long dl = (unsigned long long)SKEW_TICKS * (unsigned)(idx_ & 31u);
        while (__builtin_amdgcn_s_memrealtime() - t0 < dl) __builtin_amdgcn_s_sleep(8); }
    f32x4 acc[2][2][4][2]; f32x4 accx[2];
#define PG8_ACC_ZERO() do { _Pragma("unroll") for (int a = 0; a < 2; ++a) _Pragma("unroll") for (int b = 0; b < 2; ++b) _Pragma("unroll") for (int m = 0; m < 4; ++m) _Pragma("unroll") for (int n = 0; n < 2; ++n) \
        acc[a][b][m][n] = (f32x4){0.f, 0.f, 0.f, 0.f}; accx[0] = (f32x4){0.f, 0.f, 0.f, 0.f}; accx[1] = (f32x4){0.f, 0.f, 0.f, 0.f}; } while (0)
#define PG8_ACC_RESID() do { _Pragma("unroll") for (int am = 0; am < 8; ++am) _Pragma("unroll") for (int b = 0; b < 2; ++b) unpack8(ro[am][b], acc[am >> 2][b][am & 3][0], acc[am >> 2][b][am & 3][1]); \
        accx[0] = unpack4(rox[0]); accx[1] = unpack4(rox[1]); } while (0)
    u32x4 ro[8][2]; u32x2 rox[2];
    if (Epi::RESID) { int fr_ = fr, fq_ = fq; asm volatile("" : "+v"(fr_), "+v"(fq_)); E.load_resid(cur, wr, wc, fr_, fq_, ro, rox); }
    bf16x8 At[4][2], B0[2][2], B1[2][2], Ax[2];
    const char* const xbase = ATILED ? (const char*)g.Ax : (const char*)g.A + (size_t)XMP * K * 2;
    const char* cA = (const char*)g.A + (size_t)cur.pm * tstepA; const char* cB = (const char*)g.Bt + (size_t)cur.pn * tstepB; const char* cX = xbase + (size_t)cur.pm * xstep;
    S.a_ready(cur);
    PG8_STAGE(PG8_SB(0, 0), cB, voffB); PG8_STAGE(PG8_SB(0, 1), cB + hstepB, voffB); PG8_STAGE(PG8_SA(0, 0), cA, voffA); PG8_STAGEX(0, cX); PG8_STAGE(PG8_SA(0, 1), cA + hstepA, voffA);
    if (wr == 1) PG8_BAR;
    PG8_WAIT_V(2); PG8_BAR;
    PG8_STAGE(PG8_SB(1, 0), cB + kstepB, voffB); PG8_STAGE(PG8_SA(1, 0), cA + kstepA, voffA); PG8_STAGE(PG8_SB(1, 1), cB + hstepB + kstepB, voffB); PG8_STAGEX(1, cX + kstepX);
    PG8_WAIT_V(7); PG8_BAR;
    if (Epi::RESID) PG8_ACC_RESID(); else PG8_ACC_ZERO();
    for (;;) {
        const bool has_next = S.next(ui + 1, nxt);
        const char* nA = has_next ? (const char*)g.A + (size_t)nxt.pm * tstepA : cA; const char* nB = has_next ? (const char*)g.Bt + (size_t)nxt.pn * tstepB : cB; const char* nX = has_next ? xbase + (size_t)nxt.pm * xstep : cX;
        for (int kr = 0; kr < KREP; ++kr) {
        const bool fin = (kr == KREP - 1);
        if (KREP > 1 && kr > 0) {
#pragma unroll
            for (int a = 0; a < 2; ++a)
#pragma unroll
                for (int b = 0; b < 2; ++b)
#pragma unroll
                    for (int m = 0; m < 4; ++m)
#pragma unroll
                        for (int n = 0; n < 2; ++n) acc[a][b][m][n] = (f32x4){0.f, 0.f, 0.f, 0.f};
            accx[0] = (f32x4){0.f, 0.f, 0.f, 0.f}; accx[1] = (f32x4){0.f, 0.f, 0.f, 0.f};
        }
        for (int t = 0; t < nt; t += 2) {
            const bool last = (t == nt - 2);
            const char* a1 = cA + (size_t)(t + 1) * kstepA;
            const char* a2 = last ? (fin ? nA : cA) : cA + (size_t)(t + 2) * kstepA; const char* b2 = last ? (fin ? nB : cB) : cB + (size_t)(t + 2) * kstepB; const char* x2 = last ? (fin ? nX : cX) : cX + (size_t)(t + 2) * kstepX;
            const char* a3 = a2 + kstepA; const char* b3 = b2 + kstepB; const char* x3 = x2 + kstepX;
            if (last && has_next && fin) S.a_ready(nxt);
            PG8_LDB(B0, 0, 0); PG8_LDB(B1, 0, 1); PG8_SCHED; PG8_LDA(At, 0, 0); PG8_LDX(Ax, 0); PG8_STAGE(PG8_SA(1, 1), a1 + hstepA, voffA);
            PG8_WAIT_V(9); PG8_WAIT_L(0); PG8_BAR; PG8_MMA(0, 0, At, B0); PG8_MMA(0, 1, At, B1); PG8_XMMA(); PG8_BAR; PG8_SCHED;
            PG8_LDA(At, 0, 1); PG8_STAGE(PG8_SB(0, 0), b2, voffB); PG8_STAGE(PG8_SB(0, 1), b2 + hstepB, voffB); PG8_STAGE(PG8_SA(0, 0), a2, voffA); PG8_STAGEX(0, x2);
            PG8_WAIT_V(9); PG8_WAIT_L(0); PG8_BAR; PG8_MMA(1, 0, At, B0); PG8_MMA(1, 1, At, B1); PG8_BAR; PG8_SCHED;
            PG8_LDB(B0, 1, 0); PG8_LDB(B1, 1, 1); PG8_SCHED; PG8_LDA(At, 1, 0); PG8_LDX(Ax, 1); PG8_STAGE(PG8_SA(0, 1), a2 + hstepA, voffA);
            PG8_WAIT_V(9); PG8_WAIT_L(0); PG8_BAR; PG8_MMA(0, 0, At, B0); PG8_MMA(0, 1, At, B1); PG8_XMMA(); PG8_BAR; PG8_SCHED;
            PG8_LDA(At, 1, 1); PG8_STAGE(PG8_SB(1, 0), b3, voffB); PG8_STAGE(PG8_SB(1, 1), b3 + hstepB, voffB); PG8_STAGE(PG8_SA(1, 0), a3, voffA); PG8_STAGEX(1, x3);
            PG8_WAIT_V(9); PG8_WAIT_L(0); PG8_BAR; PG8_MMA(1, 0, At, B0); PG8_MMA(1, 1, At, B1); PG8_BAR; PG8_SCHED;
        }
        }
        if (wr == 0) PG8_BAR;
        { int fr_ = fr, fq_ = fq; asm volatile("" : "+v"(fr_), "+v"(fq_));
          for (int er = 0; er < EREP; ++er) { E(acc, accx, cur, wr, wc, fr_, fq_, lds);
              if (EREP > 1 && Epi::INPLACE) {
#pragma unroll
                  for (int a = 0; a < 2; ++a)
#pragma unroll
                      for (int b = 0; b < 2; ++b)
#pragma unroll
                          for (int m = 0; m < 4; ++m)
#pragma unroll
                              for (int n = 0; n < 2; ++n) acc[a][b][m][n] = (f32x4){0.f, 0.f, 0.f, 0.f};
                  accx[0] = (f32x4){0.f, 0.f, 0.f, 0.f}; accx[1] = (f32x4){0.f, 0.f, 0.f, 0.f}; } } } S.done(cur);
        if (!has_next) break;
        cur = nxt; cA = nA; cB = nB; cX = nX; ++ui;
        if (Epi::RESID) { int fr_ = fr, fq_ = fq; asm volatile("" : "+v"(fr_), "+v"(fq_)); E.load_resid(cur, wr, wc, fr_, fq_, ro, rox); PG8_ACC_RESID(); }
        else PG8_ACC_ZERO();
        if (wr == 1) PG8_BAR;
    }
    PG8_WAIT_V(0);
    PG8_BAR;
#undef PG8_ACC_ZERO
#undef PG8_ACC_RESID
#undef PG8_SA
#undef PG8_SB
#undef PG8_XA
#undef PG8_STAGE
#undef PG8_STAGEX
#undef PG8_LDA
#undef PG8_LDB
#undef PG8_LDX
#undef PG8_MMA
#undef PG8_XMMA
#undef PG8_WAIT_V
#undef PG8_WAIT_L
#undef PG8_BAR
#undef PG8_SCHED
}
}

__device__ __forceinline__ void p0_transpose_item(const float* W, int K, int N, const float* gain, bf16* WT, int glu, LAS float* scr, int item, int lane) {
    const int nblk = N / 64, kb = item / nblk, nb = item % nblk, k0 = 64 * kb, n0 = 64 * nb;
    const int q = lane & 15, kr = lane >> 4;
    f32x4 v[16];
#pragma unroll
    for (int i = 0; i < 16; ++i) v[i] = *(const f32x4*)(W + (size_t)(k0 + 4 * i + kr) * N + n0 + 4 * q);
    if (gain) {
#pragma unroll
        for (int i = 0; i < 16; ++i) v[i] = v[i] * gain[k0 + 4 * i + kr];
    }
#pragma unroll
    for (int i = 0; i < 16; ++i) { LAS float* d = scr + (4 * i + kr) * 65 + 4 * q; d[0] = v[i][0]; d[1] = v[i][1]; d[2] = v[i][2]; d[3] = v[i][3]; }
    LDS_WAIT(); asm volatile("" ::: "memory");
    int drow0 = n0; if (glu) { const int bj = n0 / 1024, rem = n0 % 1024; drow0 = (rem / 128) * 256 + bj * 128 + (rem % 128); }
    const int c = lane & 7;
#pragma unroll
    for (int j = 0; j < 8; ++j) { const int n = (lane >> 3) + 8 * j; const LAS float* sp = scr + (8 * c) * 65 + n;
        v4u o; o.x = pk2(sp[0 * 65], sp[1 * 65]); o.y = pk2(sp[2 * 65], sp[3 * 65]); o.z = pk2(sp[4 * 65], sp[5 * 65]); o.w = pk2(sp[6 * 65], sp[7 * 65]);
        *(GAS v4u*)(WT + (size_t)(drow0 + n) * K + k0 + 8 * c) = o; }
    LDS_WAIT(); asm volatile("" ::: "memory");
}

__device__ __forceinline__ void sincos_rr(float x, float& s, float& c) {
    const float q = rintf(x * 0.63661977236758f);
    float r = fmaf(-q, 1.57079637050629f, x); r = fmaf(-q, -4.37113882867379e-8f, r);
    const float r2 = r * r;
    const float sp = r + r * r2 * (-1.6666667163e-1f + r2 * (8.3333337680e-3f + r2 * (-1.9841270114e-4f + r2 * 2.7557314297e-6f)));
    const float cp = 1.0f + r2 * (-0.5f + r2 * (4.1666667908e-2f + r2 * (-1.3888889225e-3f + r2 * (2.4801587642e-5f + r2 * -2.7557314297e-7f))));
    const int qi = (int)q & 3;
    s = (qi == 0) ? sp : (qi == 1) ? cp : (qi == 2) ? -sp : -cp;
    c = (qi == 0) ? cp : (qi == 1) ? -sp : (qi == 2) ? -cp : sp;
}

typedef float f32x16 __attribute__((ext_vector_type(16)));
typedef float f32x2_t __attribute__((ext_vector_type(2))); typedef __bf16 bf16x2_t __attribute__((ext_vector_type(2)));
__device__ __forceinline__ unsigned cvtpk_c(float lo, float hi) { f32x2_t v = {lo, hi}; bf16x2_t b = __builtin_convertvector(v, bf16x2_t); return __builtin_bit_cast(unsigned, b); }
typedef unsigned u32x2 __attribute__((ext_vector_type(2)));
__device__ __forceinline__ void ssm_abar_calc(const float* A_re, const float* A_im, const float* log_dt, int g, int n, float& abr, float& abi, float& cfr, float& cfi) {
    const float dt = expf(log_dt[g]);
    const float ar = A_re[g * 64 + n], ai = A_im[g * 64 + n];
    const float mag = expf(dt * ar); float sn, cs; sincos_rr(dt * ai, sn, cs);
    abr = mag * cs; abi = mag * sn;
    const float den = ar * ar + ai * ai, nr = abr - 1.0f;
    cfr = (nr * ar + abi * ai) / den; cfi = (abi * ar - nr * ai) / den;
}
__device__ __forceinline__ float gelu_tanh(float y) {
    const float z = 0.7978845608028654f * (y + 0.044715f * y * y * y);
    return y * __builtin_amdgcn_rcpf(1.0f + __expf(-2.0f * z));
}
__device__ __forceinline__ void wg_rinv(LAS float* tab, const float* ssp, int rowL, int rowH, bool sample, int tid) {
    __syncthreads();
    const int row = sample ? (tid >> 1) : tid, hf = sample ? (tid & 1) : 0;
    if (!sample || row < 32) {
        const int grow = sample ? ((row < 16) ? rowL + row : rowH + row - 16) : ((row < 256) ? rowL + row : rowH + row - 256);
        const float* p = ssp + (size_t)grow * 64 + 16 * hf;
        f32x4 v[4];
#pragma unroll
        for (int i = 0; i < 4; ++i) v[i] = *(const f32x4*)(p + 4 * i);
        float s_ = (((v[0][0] + v[0][1]) + (v[0][2] + v[0][3])) + ((v[1][0] + v[1][1]) + (v[1][2] + v[1][3]))) + (((v[2][0] + v[2][1]) + (v[2][2] + v[2][3])) + ((v[3][0] + v[3][1]) + (v[3][2] + v[3][3])));
        if (sample) s_ += __shfl_xor(s_, 1);
        if (hf == 0) tab[row] = rsqrtf(s_ * (1.0f / 1024.0f) + 1e-6f);
    }
    __syncthreads();
}
struct SsmT { const bf16* BT; const bf16* CT; const float* tab; const float* Dk; const float* gain; };
template <int MODE>
__device__ __forceinline__ void ssm_mfma_unit(LAS unsigned char* wl, int lane, int g, const SsmT& T, const bf16* XB, LAS float* rv  , const float* ssp, int tid, int rowL, int rowH, int nblk,
                                              float (&st)[4]  , bf16* Gout, const float* h0r, const float* h0i, float* hor, float* hoi  , int b0L, int b0H  ) {
    const int r32 = lane & 31, hi5 = lane >> 5, c16 = lane & 15, kq = lane >> 4;
    const int aseq = (r32 >> 2) & 1, atok = 4 * (r32 >> 3) + (r32 & 3);
    const int arow = (aseq ? rowH : rowL) + atok;
    pg8::bf16x8 bt[4], ct[4];
#pragma unroll
    for (int tn = 0; tn < 4; ++tn) bt[tn] = *(const pg8::bf16x8*)(T.BT + (size_t)(tn * 32 + r32) * 16 + 8 * hi5);
    if (MODE != 0) {
#pragma unroll
        for (int ks = 0; ks < 4; ++ks) ct[ks] = *(const pg8::bf16x8*)(T.CT + (size_t)c16 * 128 + 32 * ks + 8 * kq);
    }
    float ar[2], ai[2];
    { const f32x4 t0 = *(const f32x4*)(T.tab + (size_t)r32 * 4), t1 = *(const f32x4*)(T.tab + (size_t)(32 + r32) * 4); ar[0] = t0[0]; ai[0] = t0[1]; ar[1] = t1[0]; ai[1] = t1[1]; }
    f32x4 Dg = {0.f, 0.f, 0.f, 0.f};
    if (MODE != 0) { const f32x4 dv = *(const f32x4*)(T.Dk + 4 * kq), gv = *(const f32x4*)(T.gain + 4 * kq); Dg = dv * gv; }
    float pwr[2][16], pwi[2][16], a16r[2], a16i[2];
    if (MODE == 0) {
#pragma unroll
        for (int p = 0; p < 2; ++p) {
            float cr = 1.0f, ci = 0.0f;
#pragma unroll
            for (int r = 15; r >= 0; --r) { pwr[p][r] = cr; pwi[p][r] = ci; const float tr = cr * ar[p] - ci * ai[p], ti = cr * ai[p] + ci * ar[p]; cr = tr; ci = ti; }
            a16r[p] = cr; a16i[p] = ci;
        }
    }
    pg8::bf16x8 xa_all[8];
#pragma unroll
    for (int k = 0; k < 8; ++k) if (k < nblk) xa_all[k] = *(const pg8::bf16x8*)((const char*)XB + pg8::xb_off(arow + 16 * k, g * 16 + 8 * hi5));
    float h0v[2][2][2];
    if (MODE == 2) {
#pragma unroll
        for (int w = 0; w < 2; ++w)
#pragma unroll
            for (int p = 0; p < 2; ++p) { const size_t hidx = ((size_t)((hi5 ? b0H : b0L) + w) * 64 + g) * 64 + 32 * p + r32; h0v[w][p][0] = h0r[hidx]; h0v[w][p][1] = h0i[hidx]; }
    }
    wg_rinv(rv, ssp, rowL, rowH, MODE == 2, tid);
    for (int blk = 0; blk < nblk; ++blk) {
        const pg8::bf16x8 xa = xa_all[0];
        if (MODE != 2) {
#pragma unroll
            for (int k = 0; k < 7; ++k) xa_all[k] = xa_all[k + 1];
            if (blk + 8 < nblk) xa_all[7] = *(const pg8::bf16x8*)((const char*)XB + pg8::xb_off(arow + 16 * (blk + 8), g * 16 + 8 * hi5));
        }
        if (MODE != 0) *(LAS pg8::bf16x8*)(wl + 8704 + r32 * 32 + hi5 * 16) = xa;
        const LAS float* rvb = rv + ((MODE == 2) ? 0 : 16 * blk);
        pg8::bf16x8 xs_;
        { const float rin = rvb[((MODE == 2) ? 16 : 256) * aseq + atok]; const v4u xw = __builtin_bit_cast(v4u, xa); v4u ow;
          ow.x = cvtpk_c(bf_lo(xw.x) * rin, bf_hi(xw.x) * rin); ow.y = cvtpk_c(bf_lo(xw.y) * rin, bf_hi(xw.y) * rin);
          ow.z = cvtpk_c(bf_lo(xw.z) * rin, bf_hi(xw.z) * rin); ow.w = cvtpk_c(bf_lo(xw.w) * rin, bf_hi(xw.w) * rin); xs_ = __builtin_bit_cast(pg8::bf16x8, ow); }
        f32x16 IN[4];
#pragma unroll
        for (int tn = 0; tn < 4; ++tn) { const f32x16 z = {0.f, 0.f, 0.f, 0.f, 0.f, 0.f, 0.f, 0.f, 0.f, 0.f, 0.f, 0.f, 0.f, 0.f, 0.f, 0.f}; IN[tn] = __builtin_amdgcn_mfma_f32_32x32x16_bf16(xs_, bt[tn], z, 0, 0, 0); }
        if (MODE == 0) {
#pragma unroll
            for (int p = 0; p < 2; ++p) {
                float er[2] = {0.f, 0.f}, ei[2] = {0.f, 0.f};
#pragma unroll
                for (int r = 0; r < 16; ++r) {
                    const float xr_ = IN[2 * p][r], xi_ = IN[2 * p + 1][r], wr_ = pwr[p][r], wi_ = pwi[p][r];
                    float t = fmaf(wr_, xr_, er[r & 1]); asm volatile("" : "+v"(t)); t = fmaf(-wi_, xi_, t); asm volatile("" : "+v"(t)); er[r & 1] = t;
                    float u = fmaf(wr_, xi_, ei[r & 1]); asm volatile("" : "+v"(u)); u = fmaf(wi_, xr_, u); asm volatile("" : "+v"(u)); ei[r & 1] = u;
                }
                float e_r = er[0] + er[1], e_i = ei[0] + ei[1];
                asm volatile("" : "+v"(e_r), "+v"(e_i));
                const float sr = st[2 * p], si = st[2 * p + 1];
                float nr = fmaf(a16r[p], sr, e_r); asm volatile("" : "+v"(nr)); nr = fmaf(-a16i[p], si, nr); asm volatile("" : "+v"(nr));
                float ni = fmaf(a16r[p], si, e_i); asm volatile("" : "+v"(ni)); ni = fmaf(a16i[p], sr, ni); asm volatile("" : "+v"(ni));
                st[2 * p] = nr; st[2 * p + 1] = ni;
            }
        } else {
            float cr[2] = {st[0], st[2]}, ci[2] = {st[1], st[3]};
#pragma unroll
            for (int r = 0; r < 16; ++r) {
                if (MODE == 2 && (r & 7) == 0) {
#pragma unroll
                    for (int p = 0; p < 2; ++p) { cr[p] = h0v[r >> 3][p][0]; ci[p] = h0v[r >> 3][p][1]; } }
                float tr0 = fmaf(ar[0], cr[0], IN[0][r]); asm volatile("" : "+v"(tr0)); float tr1 = fmaf(ar[1], cr[1], IN[2][r]); asm volatile("" : "+v"(tr1));
                float ti0 = fmaf(ar[0], ci[0], IN[1][r]); asm volatile("" : "+v"(ti0)); float ti1 = fmaf(ar[1], ci[1], IN[3][r]); asm volatile("" : "+v"(ti1));
                tr0 = fmaf(-ai[0], ci[0], tr0); asm volatile("" : "+v"(tr0)); tr1 = fmaf(-ai[1], ci[1], tr1); asm volatile("" : "+v"(tr1));
                ti0 = fmaf(ai[0], cr[0], ti0); asm volatile("" : "+v"(ti0)); ti1 = fmaf(ai[1], cr[1], ti1); asm volatile("" : "+v"(ti1));
                cr[0] = tr0; cr[1] = tr1; ci[0] = ti0; ci[1] = ti1; IN[0][r] = tr0; IN[2][r] = tr1; IN[1][r] = ti0; IN[3][r] = ti1;
                if (MODE == 2 && (r & 7) == 7) {
#pragma unroll
                    for (int p = 0; p < 2; ++p) { const size_t hidx = ((size_t)((hi5 ? b0H : b0L) + (r >> 3)) * 64 + g) * 64 + 32 * p + r32; hor[hidx] = cr[p]; hoi[hidx] = ci[p]; } }
            }
            st[0] = cr[0]; st[1] = ci[0]; st[2] = cr[1]; st[3] = ci[1];
#pragma unroll
            for (int p = 0; p < 2; ++p)
#pragma unroll
                for (int r = 0; r < 16; ++r) *(LAS unsigned*)(wl + (16 * hi5 + r) * 272 + 4 * (32 * p + r32)) = pg8::cvt_pk_bf16(IN[2 * p][r], IN[2 * p + 1][r]);
            LDS_WAIT(); asm volatile("" ::: "memory");
#pragma unroll
            for (int tt = 0; tt < 2; ++tt) {
                f32x4 y = {0.f, 0.f, 0.f, 0.f};
#pragma unroll
                for (int ks = 0; ks < 4; ++ks) { const pg8::bf16x8 hf = *(const LAS pg8::bf16x8*)(wl + (16 * tt + c16) * 272 + (32 * ks + 8 * kq) * 2); y = __builtin_amdgcn_mfma_f32_16x16x32_bf16(ct[ks], hf, y, 0, 0, 0); }
                const int token = (tt ? rowH : rowL) + 16 * blk + c16;
                const float rinv = rvb[((MODE == 2) ? 16 : 256) * tt + c16];
                const int xrow = 8 * (c16 >> 2) + 4 * tt + (c16 & 3);
                const f32x4 xv = pg8::unpack4(*(const LAS u32x2*)(wl + 8704 + xrow * 32 + kq * 8));
                f32x4 o;
#pragma unroll
                for (int e = 0; e < 4; ++e) o[e] = gelu_tanh(y[e] + Dg[e] * (xv[e] * rinv));
                *(u32x2*)(Gout + (size_t)token * 1024 + g * 16 + 4 * kq) = pg8::pack4(o);
            }
        }
        LDS_WAIT(); asm volatile("" ::: "memory");
    }
}

__device__ __forceinline__ void attn_task(const LAS unsigned char* Kl, const LAS unsigned char* Vl, LAS unsigned char* stg  , const pg8::bf16x8 (&qf)[4]  , bf16* Ob, const float* sinks, int head, int tloc, int kb0, int jkmin, int lane, bool samp, int orow0, int ohead0) {
    const int r32 = lane & 31, hi5 = lane >> 5;
    const float slope2 = exp2f(-0.5f * (float)(head + 1)) * 1.4426950408889634f, sink2 = sinks[head] * 1.4426950408889634f;
    f32x16 S[5];
#pragma unroll
    for (int i = 0; i < 5; ++i) {
        f32x16 acc = {0.f, 0.f, 0.f, 0.f, 0.f, 0.f, 0.f, 0.f, 0.f, 0.f, 0.f, 0.f, 0.f, 0.f, 0.f, 0.f};
#pragma unroll
        for (int ks = 0; ks < 4; ++ks) { const pg8::bf16x8 kf = *(const LAS pg8::bf16x8*)(Kl + (32 * (kb0 + i) + r32) * 144 + 32 * ks + 16 * hi5); acc = __builtin_amdgcn_mfma_f32_32x32x16_bf16(kf, qf[ks], acc, 0, 0, 0); }
        S[i] = acc;
    }
    float mx = sink2;
    const int dlim = (tloc + 128 - jkmin < 128) ? (tloc + 128 - jkmin) : 128;
    float so[16];
#pragma unroll
    for (int r = 0; r < 16; ++r) so[r] = slope2 * (float)((r & 3) + 8 * (r >> 2));
#pragma unroll
    for (int i = 0; i < 5; ++i) {
        const int base = tloc + 128 - 32 * (kb0 + i) - 4 * hi5;
        const float nb = -slope2 * (float)base;
        const bool nomask = (jkmin == 0) && (i >= 1) && (i <= 3);
#pragma unroll
        for (int r = 0; r < 16; ++r) {
            float sv = fmaf(S[i][r], 0.18033688011112042f, nb) + so[r];
            if (!nomask) { const unsigned d = (unsigned)(base - ((r & 3) + 8 * (r >> 2))); sv = (d <= (unsigned)dlim) ? sv : -1e30f; }
            S[i][r] = sv; mx = fmaxf(mx, sv);
        }
    }
    mx = fmaxf(mx, __shfl_xor(mx, 32));
    float lsum = 0.f;
#pragma unroll
    for (int i = 0; i < 5; ++i)
#pragma unroll
        for (int r = 0; r < 16; ++r) { const float p = __builtin_amdgcn_exp2f(S[i][r] - mx); S[i][r] = p; lsum += p; }
    lsum += __shfl_xor(lsum, 32); lsum += __builtin_amdgcn_exp2f(sink2 - mx);
    const float inv = __builtin_amdgcn_rcpf(lsum);
    f32x16 O0 = {0.f, 0.f, 0.f, 0.f, 0.f, 0.f, 0.f, 0.f, 0.f, 0.f, 0.f, 0.f, 0.f, 0.f, 0.f, 0.f}, O1 = O0;
#pragma unroll
    for (int i = 0; i < 5; ++i)
#pragma unroll
        for (int s2 = 0; s2 < 2; ++s2) {
            v4u pw; pw.x = cvtpk_c(S[i][8 * s2 + 0], S[i][8 * s2 + 1]); pw.y = cvtpk_c(S[i][8 * s2 + 2], S[i][8 * s2 + 3]);
            pw.z = cvtpk_c(S[i][8 * s2 + 4], S[i][8 * s2 + 5]); pw.w = cvtpk_c(S[i][8 * s2 + 6], S[i][8 * s2 + 7]);
            const pg8::bf16x8 pf = __builtin_bit_cast(pg8::bf16x8, pw);
            const int keyoff = 32 * (kb0 + i) + 16 * s2 + 4 * hi5;
            { const u32x2 lo = *(const LAS u32x2*)(Vl + r32 * 520 + keyoff * 2), hh = *(const LAS u32x2*)(Vl + r32 * 520 + (keyoff + 8) * 2);
              v4u vw; vw.x = lo.x; vw.y = lo.y; vw.z = hh.x; vw.w = hh.y; O0 = __builtin_amdgcn_mfma_f32_32x32x16_bf16(__builtin_bit_cast(pg8::bf16x8, vw), pf, O0, 0, 0, 0); }
            { const u32x2 lo = *(const LAS u32x2*)(Vl + (32 + r32) * 520 + keyoff * 2), hh = *(const LAS u32x2*)(Vl + (32 + r32) * 520 + (keyoff + 8) * 2);
              v4u vw; vw.x = lo.x; vw.y = lo.y; vw.z = hh.x; vw.w = hh.y; O1 = __builtin_amdgcn_mfma_f32_32x32x16_bf16(__builtin_bit_cast(pg8::bf16x8, vw), pf, O1, 0, 0, 0); }
        }
#pragma unroll
    for (int qd = 0; qd < 4; ++qd) {
        u32x2 w0; w0.x = pg8::cvt_pk_bf16(O0[4 * qd] * inv, O0[4 * qd + 1] * inv); w0.y = pg8::cvt_pk_bf16(O0[4 * qd + 2] * inv, O0[4 * qd + 3] * inv);
        u32x2 w1; w1.x = pg8::cvt_pk_bf16(O1[4 * qd] * inv, O1[4 * qd + 1] * inv); w1.y = pg8::cvt_pk_bf16(O1[4 * qd + 2] * inv, O1[4 * qd + 3] * inv);
        *(LAS u32x2*)(stg + r32 * 144 + (8 * qd + 4 * hi5) * 2) = w0; *(LAS u32x2*)(stg + r32 * 144 + (32 + 8 * qd + 4 * hi5) * 2) = w1;
    }
    LDS_WAIT(); asm volatile("" ::: "memory");
#pragma unroll
    for (int i = 0; i < 4; ++i) {
        const int qq = (lane >> 3) + 8 * i, c = lane & 7;
        const v4u w = *(const LAS v4u*)(stg + qq * 144 + c * 16);
        const int orow = orow0 + (samp ? (qq & 7) : qq), ohead = ohead0 + (samp ? (qq >> 3) : 0);
        *(v4u*)(Ob + (size_t)orow * 1024 + ohead * 64 + 8 * c) = w;
    }
    LDS_WAIT(); asm volatile("" ::: "memory");
}

template <class T> __device__ __forceinline__ T karg(const __attribute__((address_space(4))) char* ka, int off) { typedef const __attribute__((address_space(4))) T CT; return *(CT*)(ka + off); }
struct Args { const float* in[23]; float* out; unsigned char* ws; int ph_lo, ph_hi; };
static_assert(sizeof(Args) == 208 && __builtin_offsetof(Args, out) == 184 && __builtin_offsetof(Args, ws) == 192, "kernarg layout used by KARG");

#define KARG(T, off) karg<T>(ka, (off))
#define INP(k) karg<const float*>(ka, 8 * (k))
constexpr int CI_QKV = 16 * 24, CI_O = 16 * 16, CI_GLU = 16 * 32, CI_UP = 16 * 64, CI_DN = 64 * 16, CI_SLOT = CI_O + 2 * CI_UP + 2 * CI_DN + CI_GLU;
__device__ __forceinline__ void convert_gi(const __attribute__((address_space(4))) char* ka, unsigned char* ws, LAS float* scr, int gi, int lane) {
    int r = gi;
    if (r < CI_QKV) { p0_transpose_item(INP(9), D, NQKV, INP(6), (bf16*)(ws + WS_WQKV), 0, scr, r, lane); return; } r -= CI_QKV;
    const int sl = r / CI_SLOT; r -= sl * CI_SLOT;
    if (sl >= 2) { p0_transpose_item(INP(9) + (size_t)D * NQKV, D, NQKV, INP(6) + (size_t)2 * D, (bf16*)(ws + WS_WQKV) + (size_t)NQKV * D, 0, scr, r, lane); return; }
    const int la = 2 * sl, ls = 2 * sl + 1;
    if (r < CI_O) { p0_transpose_item(INP(10) + (size_t)sl * D * D, D, D, nullptr, (bf16*)(ws + WS_WO) + (size_t)sl * D * D, 0, scr, r, lane); return; } r -= CI_O;
    if (r < CI_UP) { p0_transpose_item(INP(21) + (size_t)la * D * FF, D, FF, INP(7) + (size_t)la * D, (bf16*)(ws + WS_WUP) + (size_t)la * FF * D, 0, scr, r, lane); return; } r -= CI_UP;
    if (r < CI_DN) { p0_transpose_item(INP(22) + (size_t)la * FF * D, FF, D, nullptr, (bf16*)(ws + WS_WDN) + (size_t)la * D * FF, 0, scr, r, lane); return; } r -= CI_DN;
    if (r < CI_GLU) { p0_transpose_item(INP(20) + (size_t)sl * D * 2 * D, D, 2 * D, nullptr, (bf16*)(ws + WS_WGLU) + (size_t)sl * 2 * D * D, 1, scr, r, lane); return; } r -= CI_GLU;
    if (r < CI_UP) { p0_transpose_item(INP(21) + (size_t)ls * D * FF, D, FF, INP(7) + (size_t)ls * D, (bf16*)(ws + WS_WUP) + (size_t)ls * FF * D, 0, scr, r, lane); return; } r -= CI_UP;
    p0_transpose_item(INP(22) + (size_t)ls * FF * D, FF, D, nullptr, (bf16*)(ws + WS_WDN) + (size_t)ls * D * FF, 0, scr, r, lane);
}
#ifndef SKEW_UP
#define SKEW_UP 250
#define SKEW_GLU 250
#endif
#ifndef PROBE_DUP
#endif
#define NREP(bit) (((PROBE_DUP) >> (bit)) & 1 ? 2 : 1)
#ifndef EN_P0
#define EN_P0 1
#endif
#ifndef EN_QKV
#define EN_QKV 1
#endif
#ifndef EN_ATT
#define EN_ATT 1
#endif
#ifndef EN_OPJ
#define EN_OPJ 1
#endif
#ifndef EN_S1
#define EN_S1 1
#endif
#ifndef EN_S3
#define EN_S3 1
#endif
#ifndef EN_GLU
#define EN_GLU 1
#endif
#ifndef EN_UP
#define EN_UP 1
#endif
#ifndef EN_DN
#define EN_DN 1
#endif
#ifndef EN_FIN
#define EN_FIN 1
#endif
__global__ void __launch_bounds__(512, 2) fwd_kernel(Args args) {
    extern __shared__ __attribute__((aligned(16))) unsigned char lds[];
    LAS unsigned char* const L = (LAS unsigned char*)lds;
#define FRESH_IDS int tid = threadIdx.x; asm volatile("" : "+v"(tid)); const int lane = tid & 63, wave = __builtin_amdgcn_readfirstlane(tid >> 6); const int gw = vcu * 8 + wave; (void)lane; (void)gw
    const int G = gridDim.x, bx = blockIdx.x;
    const int vcu = (G % 8 == 0) ? (bx % 8) * (G / 8) + bx / 8 : bx;
    const int NGW = G * 8;
    for (int u = threadIdx.x; u < (LDS_BYTES - LDSCTL_OFF) / 4; u += 512) ((LAS unsigned*)(L + LDSCTL_OFF))[u] = 0u;
    __syncthreads();
    const int lo = args.ph_lo, hi = args.ph_hi;
    unsigned long long tacc = 0ull, tlast = PROBE_TM ? __builtin_amdgcn_s_memrealtime() : 0ull; (void)tacc; (void)tlast;
    const bool multi = (hi - lo) > 1;
    XcdBarrier bar; bar.bar = (unsigned*)(args.ws + WS_CTL) + CW_BAR; bar.x = 0; bar.st = nullptr;
#define FLAT_BAR 2
#define USE_LOCAL_SEAMS 1
#define FUSE_FINAL 1
#define SLOT_ONE_PCT 72
#define ATT_ROT 0
#define ATT_KV_PREFETCH 0
#define SAMP_BATCH 5
#define PROBE_UNI 0
#if FLAT_BAR == 1
    bar.x = xb_xcc_id(); bar.st = (volatile LAS unsigned*)(L + MISC_OFF) + 8;
#define GRID_BARRIER flat_barrier
#else
    if (multi) bar = xcd_barrier_post((unsigned*)(args.ws + WS_CTL) + CW_BAR, (volatile LAS unsigned*)(L + MISC_OFF) + 8);
#if FLAT_BAR == 2
#define GRID_BARRIER xcd_barrier2
#else
#define GRID_BARRIER xcd_barrier
#endif
#endif
    (void)multi;
#define IN(k) (lo <= (k) && (k) < hi)
#define MARK(c) do { if (PROBE_TM) { const unsigned long long n_ = __builtin_amdgcn_s_memrealtime(); if (((PROBE_TM) >> (c)) & 1) tacc += n_ - tlast; tlast = n_; } } while (0)
#define SEAM(k, c) do { MARK(c); if (IN(k) && IN((k) + 1)) GRID_BARRIER(bar); MARK(1); } while (0)
#define SEAM_L(k, c) do { MARK(c); if (IN(k) && IN((k) + 1)) { if (uni) { xcd_local_barrier(bar); MARK(2); } else { GRID_BARRIER(bar); MARK(1); } } } while (0)

#define FRESH_PTRS const __attribute__((address_space(4))) char* ka = (const __attribute__((address_space(4))) char*)__builtin_amdgcn_kernarg_segment_ptr(); asm volatile("" : "+s"(ka)); \
    unsigned char* const ws = KARG(unsigned char*, 192); float* const out = KARG(float*, 184); \
    float* const ssp = (float*)(ws + WS_SSP); float* const HS = (float*)(ws + WS_HS); bf16* const XB = (bf16*)(ws + WS_XB); bf16* const Hb = (bf16*)(ws + WS_H); \
    bf16* const Qb = (bf16*)(ws + WS_Q); bf16* const Kb = (bf16*)(ws + WS_K); bf16* const Vb = (bf16*)(ws + WS_V); bf16* const Ob = (bf16*)(ws + WS_O); \
    const float* const x_p = INP(0); const float* const x_s = INP(1); (void)ssp; (void)HS; (void)XB; (void)Hb; (void)Qb; (void)Kb; (void)Vb; (void)Ob; (void)x_p; (void)x_s
    if (EN_P0 && IN(0)) for (int rp = 0; rp < NREP(0); ++rp) {
        FRESH_IDS; FRESH_PTRS;
        LAS float* scr = (LAS float*)(L + wave * 16640);
        for (int it = gw; it < 2 * CI_QKV; it += NGW) convert_gi(ka, ws, scr, (it < CI_QKV) ? it : it - CI_QKV + CI_QKV + 2 * CI_SLOT, lane);
        const int tb = G - 1 - vcu, tc = (tb + G - (16 % G)) % G;
        for (int i = tb * 512 + tid; i < 2 * NG * NS; i += G * 512) {
            const int jj = i >> 12, gn = i & 4095, g = gn >> 6, n = gn & 63; float abr, abi, cfr, cfi;
            ssm_abar_calc(INP(12) + (size_t)jj * NG * NS, INP(13) + (size_t)jj * NG * NS, INP(14) + (size_t)jj * NG, g, n, abr, abi, cfr, cfi);
            f32x4 v; v[0] = abr; v[1] = abi; v[2] = cfr; v[3] = cfi; *(f32x4*)((float*)(ws + WS_TAB) + (size_t)i * 4) = v;
            const float* bre = INP(15) + (size_t)i * 16; const float* bim = INP(16) + (size_t)i * 16; const float* gn_ = INP(6) + (size_t)(2 * jj + 1) * D + g * 16;
            bf16* btr = (bf16*)(ws + WS_BT) + ((size_t)(jj * NG + g) * 128 + (2 * (n >> 5)) * 32 + (n & 31)) * 16; bf16* bti = btr + 32 * 16;
#pragma unroll
            for (int c8 = 0; c8 < 2; ++c8) {
                float wr_[8], wi_[8];
#pragma unroll
                for (int c4 = 0; c4 < 2; ++c4) { const f32x4 br = *(const f32x4*)(bre + 8 * c8 + 4 * c4), bi = *(const f32x4*)(bim + 8 * c8 + 4 * c4), gv = *(const f32x4*)(gn_ + 8 * c8 + 4 * c4);
#pragma unroll
                    for (int e = 0; e < 4; ++e) { wr_[4 * c4 + e] = (cfr * br[e] - cfi * bi[e]) * gv[e]; wi_[4 * c4 + e] = (cfr * bi[e] + cfi * br[e]) * gv[e]; } }
                v4u o; o.x = pk2(wr_[0], wr_[1]); o.y = pk2(wr_[2], wr_[3]); o.z = pk2(wr_[4], wr_[5]); o.w = pk2(wr_[6], wr_[7]); *(v4u*)(btr + 8 * c8) = o;
                o.x = pk2(wi_[0], wi_[1]); o.y = pk2(wi_[2], wi_[3]); o.z = pk2(wi_[4], wi_[5]); o.w = pk2(wi_[6], wi_[7]); *(v4u*)(bti + 8 * c8) = o;
            }
        }
        for (int i = tc * 512 + tid; i < 2 * NG * GC * 16; i += G * 512) {
            const int n4 = i & 15; const size_t rowi = (size_t)(i >> 4);
            const f32x4 cr = *(const f32x4*)(INP(17) + rowi * 64 + 4 * n4), ci = *(const f32x4*)(INP(18) + rowi * 64 + 4 * n4);
            v4u o; o.x = pk2(cr[0], -ci[0]); o.y = pk2(cr[1], -ci[1]); o.z = pk2(cr[2], -ci[2]); o.w = pk2(cr[3], -ci[3]);
            *(v4u*)((bf16*)(ws + WS_CT) + rowi * 128 + 8 * n4) = o;
        }
        __syncthreads();
    }
    SEAM(0, 3);
    int cbx = bx, gq = 0, gm = 0; bool uni = false;
    const bool fusefin = FUSE_FINAL && multi && (G == (MP / 256) * (D / 256));
#if USE_LOCAL_SEAMS
    if (IN(0) && IN(1) && G == 256) { const unsigned ev = bar.st[3], rk = bar.st[2]; uni = __builtin_amdgcn_readfirstlane((int)ev) != 0;
        if (uni) { const int rk_ = __builtin_amdgcn_readfirstlane((int)rk); cbx = (int)bar.x + 8 * rk_; gq = 4 * (int)bar.x + (rk_ & 3); gm = rk_ >> 2; } }
    if (PROBE_UNI && uni) { const unsigned long long t0 = __builtin_amdgcn_s_memrealtime(); while (__builtin_amdgcn_s_memrealtime() - t0 < 20000ull) __builtin_amdgcn_s_sleep(8); }
#endif

    if (EN_P0 && IN(0)) for (int rp = 0; rp < NREP(0); ++rp) {
        FRESH_IDS; FRESH_PTRS;
        const int nunit = uni ? 34 * 8 : (M / 16) * 8, ustart = uni ? gm * 8 + wave : gw, ustep = uni ? 64 : NGW;
        const int r16 = lane >> 2, c4 = lane & 3;
#pragma unroll 1
        for (int u = ustart; u < nunit; u += ustep) {
            const int lg = u >> 3, cb = u & 7;
            const int row0 = uni ? ((lg < 16) ? 256 * gq + 16 * lg : (lg < 32) ? SEQ + 256 * gq + 16 * (lg - 16) : (lg == 32) ? MP + 16 * gq : MP + 16 * (32 + gq)) : 16 * lg;
            const int m = row0 + r16;
            const float* xrow = ((m < MP) ? x_p + (size_t)m * D : x_s + (size_t)(m - MP) * D) + 128 * cb + 8 * c4;
            f32x4 v[4][2];
#pragma unroll
            for (int sc = 0; sc < 4; ++sc) { v[sc][0] = *(const GAS f32x4*)(xrow + 32 * sc); v[sc][1] = *(const GAS f32x4*)(xrow + 32 * sc + 4); }
            float sq = 0.f;
#pragma unroll
            for (int sc = 0; sc < 4; ++sc) {
                sq += pg8::sumsq4(v[sc][0]) + pg8::sumsq4(v[sc][1]);
                v4u o; o.x = pk2(v[sc][0][0], v[sc][0][1]); o.y = pk2(v[sc][0][2], v[sc][0][3]); o.z = pk2(v[sc][1][0], v[sc][1][1]); o.w = pk2(v[sc][1][2], v[sc][1][3]);
                *(v4u*)((char*)XB + pg8::xb_off(m, 128 * cb + 32 * sc + 8 * c4)) = o;
            }
            sq += __shfl_xor(sq, 1); sq += __shfl_xor(sq, 2);
            ssp[(size_t)m * 64 + cb + 8 * c4] = (c4 == 0) ? sq : 0.f;
        }
        __syncthreads();
    }
    SEAM_L(0, 4);

    for (int l = 0; l < 4; ++l) {
        const int pb = 1 + 5 * l, j = l >> 1;
        if ((l & 1) == 0) {
            if (EN_QKV && IN(pb)) for (int rp = 0; rp < NREP(3); ++rp) {
                FRESH_PTRS;
                pg8::GemmX g{XB, (const bf16*)(ws + WS_WQKV) + (size_t)j * NQKV * D, (const bf16*)((const char*)XB + pg8::XBX_OFF), D}; pg8::PanelOrder S; { int cb_ = cbx, q_ = gq, m_ = gm; asm volatile("" : "+s"(cb_), "+s"(q_), "+s"(m_)); S.init(MP, NQKV, G, cb_, uni ? 1 : 0, q_, m_); }
                pg8::EpiQKV E{Qb, Kb, Vb, ssp, 16, 32, out + O_KP + (size_t)j * 2 * 128 * 256, out + O_VP + (size_t)j * 2 * 128 * 256, out + O_KS + (size_t)j * SB * 128 * 256, out + O_VS + (size_t)j * SB * 128 * 256};
                if (threadIdx.x == 0) *(LAS int*)(L + pg8::RINV_TAB_OFF + 1152) = -1;
                __syncthreads();
                pg8::gemm_phase_x<pg8::EpiQKV, pg8::PanelOrder, 1, 1, 0, true>(L, g, S, E);
                if (rp == 0) {
                    FRESH_IDS;
                    LAS float* scr = (LAS float*)(L + wave * 16640);
                    constexpr int NCHUNK = 256 * 24;
                    const bool one = uni && gm >= 4;
                    const int nshare = uni ? 128 : G, myw = (uni ? gq * 4 + (gm & 3) : bx) * 8 + wave;
                    const int csplit = uni ? (CI_SLOT * SLOT_ONE_PCT) / 100 : CI_SLOT, ksplit = uni ? (NCHUNK * SLOT_ONE_PCT) / 100 : NCHUNK;
                    const int clo = (uni && !one) ? csplit : 0, chi = (uni && !one) ? CI_SLOT : csplit, klo = (uni && !one) ? ksplit : 0, khi = (uni && !one) ? NCHUNK : ksplit;
#pragma unroll 1
                    for (int it = clo + myw; it < chi; it += nshare * 8) convert_gi(ka, ws, scr, CI_QKV + j * CI_SLOT + it, lane);
#pragma unroll 1
                    for (int c = klo + myw; c < khi; c += nshare * 8) {
                        const int jb = c / 24, part = c - jb * 24;
                        const f32x4* src = (const f32x4*)(INP(2 + j) + (size_t)jb * 128 * 256 + 8 * 256) + part * 320 + lane;
                        f32x4* dst = (f32x4*)(out + (j ? O_VS : O_KS) + (size_t)jb * 128 * 256) + part * 320 + lane;
                        f32x4 v[5];
#pragma unroll
                        for (int k = 0; k < 5; ++k) v[k] = src[k * 64];
#pragma unroll
                        for (int k = 0; k < 5; ++k) dst[k * 64] = v[k];
                    }
                    __syncthreads();
                }
            }
            SEAM(pb, 5);
            if (EN_ATT && IN(pb + 1)) for (int rp = 0; rp < NREP(1); ++rp) {
                FRESH_IDS; FRESH_PTRS;
                const float* ck = INP(2) + (size_t)j * SB * 128 * 256; const float* cv = INP(3) + (size_t)j * SB * 128 * 256;
                const float* sinks = INP(11) + j * 16;
                const int r32 = lane & 31;
                const int nrounds = (512 + 256 + G - 1) / G;
                const int hw = wave >> 2, t256 = tid & 255;
                int gq_ = gq, gm_ = gm, vcu_ = vcu; asm volatile("" : "+s"(gq_), "+s"(gm_), "+s"(vcu_));
                auto decode = [&](int ur_, bool& valid_, bool& samp_, int& kvh_, int& qblk_, int& b_) {
                    const int u_ = vcu_ + ur_ * G; valid_ = (ur_ < nrounds) && (uni || u_ < 512 + 256); samp_ = uni ? (ur_ == 2) : (u_ >= 512); qblk_ = 0; kvh_ = 0; b_ = 0;
                    if (uni) { if (!samp_) { const int t = gm_ + 8 * ur_; b_ = t & 1; qblk_ = 2 * gq_ + ((t >> 1) & 1); kvh_ = t >> 2; } else { const int usl = 2 * gm_ + hw, bs = usl >> 2; kvh_ = usl & 3; b_ = 2 * gq_ + (bs & 1) + 64 * (bs >> 1); } }
                    else if (!samp_) { kvh_ = u_ & 3; qblk_ = (u_ >> 2) & 63; b_ = u_ >> 8; } else { const int us = 2 * (u_ - 512) + hw; kvh_ = us & 3; b_ = us >> 2; }
                };
                v4u kv[4], vv[4];
                auto issue_kv = [&](int qblk_, int b_, int kvh_) {
#pragma unroll
                    for (int c = 0; c < 4; ++c) { const int id = tid + 512 * c, key = id >> 3, ch = id & 7, s_ = qblk_ * 128 - 128 + key;
                        const int keyv = 32 * wave + (lane >> 1), chv = 2 * c + (lane & 1), sv_ = qblk_ * 128 - 128 + keyv;
                        kv[c] = (v4u){0u, 0u, 0u, 0u}; vv[c] = (v4u){0u, 0u, 0u, 0u};
                        if (s_ >= 0) { const size_t off = (size_t)((b_ << 13) + s_) * 256 + kvh_ * 64 + ch * 8; kv[c] = *(const v4u*)(Kb + off); }
                        if (sv_ >= 0) { const size_t off = (size_t)((b_ << 13) + sv_) * 256 + kvh_ * 64 + chv * 8; vv[c] = *(const v4u*)(Vb + off); } }
                };
                if (ATT_KV_PREFETCH) { bool v0_, s0_; int k0_, q0_, b0_; decode(0, v0_, s0_, k0_, q0_, b0_); if (v0_ && !s0_) issue_kv(q0_, b0_, k0_); }
                for (int ur = 0; ur < nrounds; ++ur) {
                    bool valid, samp; int kvh, qblk, b;
                    decode(ur, valid, samp, kvh, qblk, b);
                    if (!valid) break;
                    LAS unsigned char* Ks = samp ? L + hw * 56320 : L; LAS unsigned char* Vs = samp ? Ks + 23040 : L + 36864;
                    if (!samp) {
                        if (!ATT_KV_PREFETCH) issue_kv(qblk, b, kvh);
#pragma unroll
                        for (int c = 0; c < 4; ++c) { const int id = tid + 512 * c, key = id >> 3, ch = id & 7;
                            *(LAS v4u*)(Ks + key * 144 + ch * 16) = kv[c];
                            const int keyv = 32 * wave + (lane >> 1), chv = 2 * c + (lane & 1);
                            LAS unsigned short* vt = (LAS unsigned short*)(Vs + (chv * 8) * 520 + keyv * 2);
                            vt[0 * 260] = (unsigned short)(vv[c].x & 0xffffu); vt[1 * 260] = (unsigned short)(vv[c].x >> 16); vt[2 * 260] = (unsigned short)(vv[c].y & 0xffffu); vt[3 * 260] = (unsigned short)(vv[c].y >> 16);
                            vt[4 * 260] = (unsigned short)(vv[c].z & 0xffffu); vt[5 * 260] = (unsigned short)(vv[c].z >> 16); vt[6 * 260] = (unsigned short)(vv[c].w & 0xffffu); vt[7 * 260] = (unsigned short)(vv[c].w >> 16); }
                    } else {
#pragma unroll 1
                    for (int c0 = 0; c0 < 5; c0 += SAMP_BATCH) {
                        v4u kv[SAMP_BATCH], vv[SAMP_BATCH];
#pragma unroll
                        for (int c = 0; c < SAMP_BATCH; ++c) { const int id = t256 + 256 * (c0 + c), key = id >> 3, ch = id & 7;
                            kv[c] = (v4u){0u, 0u, 0u, 0u}; vv[c] = (v4u){0u, 0u, 0u, 0u};
                            if (c0 + c < 5) {
                            if (key < 128) { const size_t off = ((size_t)b * 128 + key) * 256 + kvh * 64 + ch * 8;
                                const f32x4 k0 = *(const f32x4*)(ck + off), k1 = *(const f32x4*)(ck + off + 4), v0 = *(const f32x4*)(cv + off), v1 = *(const f32x4*)(cv + off + 4);
                                kv[c].x = pk2(k0[0], k0[1]); kv[c].y = pk2(k0[2], k0[3]); kv[c].z = pk2(k1[0], k1[1]); kv[c].w = pk2(k1[2], k1[3]);
                                vv[c].x = pk2(v0[0], v0[1]); vv[c].y = pk2(v0[2], v0[3]); vv[c].z = pk2(v1[0], v1[1]); vv[c].w = pk2(v1[2], v1[3]); }
                            else if (key < 136) { const size_t off = (size_t)(MP + b * 8 + (key - 128)) * 256 + kvh * 64 + ch * 8; kv[c] = *(const v4u*)(Kb + off); vv[c] = *(const v4u*)(Vb + off); } } }
#pragma unroll
                        for (int c = 0; c < SAMP_BATCH; ++c) if (c0 + c < 5) { const int id = t256 + 256 * (c0 + c), key = id >> 3, ch = id & 7;
                            *(LAS v4u*)(Ks + key * 144 + ch * 16) = kv[c];
                            LAS unsigned short* vt = (LAS unsigned short*)(Vs + (ch * 8) * 520 + key * 2);
                            vt[0 * 260] = (unsigned short)(vv[c].x & 0xffffu); vt[1 * 260] = (unsigned short)(vv[c].x >> 16); vt[2 * 260] = (unsigned short)(vv[c].y & 0xffffu); vt[3 * 260] = (unsigned short)(vv[c].y >> 16);
                            vt[4 * 260] = (unsigned short)(vv[c].z & 0xffffu); vt[5 * 260] = (unsigned short)(vv[c].z >> 16); vt[6 * 260] = (unsigned short)(vv[c].w & 0xffffu); vt[7 * 260] = (unsigned short)(vv[c].w >> 16); }
                    }
                    }
                    const int hi5q = lane >> 5;
                    const int head0 = samp ? kvh * 4 + (r32 >> 3) : kvh * 4 + (wave >> 1), tloc0 = samp ? (r32 & 7) : 32 * (2 * (wave & 1)) + r32;
                    const int qrow0 = samp ? MP + b * 8 + tloc0 : (b << 13) + qblk * 128 + tloc0;
                    pg8::bf16x8 qf[4];
                    const bf16* qp = Qb + (size_t)qrow0 * 1024 + head0 * 64 + 8 * hi5q;
#pragma unroll
                    for (int ks = 0; ks < 4; ++ks) qf[ks] = *(const pg8::bf16x8*)(qp + 16 * ks);
                    __syncthreads();
                    if (ATT_KV_PREFETCH) { bool vn_, sn_; int kn_, qn_, bn_; decode(ur + 1, vn_, sn_, kn_, qn_, bn_); if (vn_ && !sn_) issue_kv(qn_, bn_, kn_); }
                    const int ntask = samp ? (((wave & 3) == 0) ? 1 : 0) : 2;
                    for (int ti = 0; ti < ntask; ++ti) {
                        int head, tloc, kb0, jkmin;
                        if (!samp) { const int sb = 2 * (wave & 1) + ti; head = head0; tloc = 32 * sb + r32; kb0 = sb; jkmin = (qblk == 0) ? 128 : 0; }
                        else { head = head0; tloc = tloc0; kb0 = 0; jkmin = 0; }
                        if (ti > 0) {
#pragma unroll
                            for (int ks = 0; ks < 4; ++ks) qf[ks] = *(const pg8::bf16x8*)(qp + (size_t)32 * 1024 * ti + 16 * ks);
                        }
                        LAS unsigned char* stg = samp ? (L + 112640 + hw * 4608) : (L + 70144 + wave * 4608);
                        attn_task(Ks, Vs, stg, qf, Ob, sinks, head, tloc, kb0, jkmin, lane, samp, samp ? (MP + b * 8) : ((b << 13) + qblk * 128 + 32 * (2 * (wave & 1) + ti)), samp ? kvh * 4 : head);
                    }
                    __syncthreads();
                    MARK(samp ? 14 : 13);
                }
            }
            SEAM_L(pb + 1, 6);
            if (EN_OPJ && IN(pb + 2)) {
                FRESH_PTRS;
                pg8::GemmX g{Ob, (const bf16*)(ws + WS_WO) + (size_t)j * D * D, nullptr, D}; pg8::PanelOrder S; { int cb_ = cbx, q_ = gq, m_ = gm; asm volatile("" : "+s"(cb_), "+s"(q_), "+s"(m_)); S.init(MP, D, G, cb_, uni ? 1 : 0, q_, m_); }
                pg8::EpiRes E{XB, ssp};
                pg8::gemm_phase_x<pg8::EpiRes, pg8::PanelOrder>(L, g, S, E);
            }
            SEAM_L(pb + 2, 7);
        } else {
#define SSMT(gg) const SsmT T_{(const bf16*)(ws + WS_BT) + ((size_t)j * NG + (gg)) * 128 * 16, (const bf16*)(ws + WS_CT) + ((size_t)j * NG + (gg)) * 16 * 128, (const float*)(ws + WS_TAB) + ((size_t)j * NG + (gg)) * NS * 4, \
                          INP(19) + (size_t)j * D + (gg) * 16, INP(6) + (size_t)l * D + (gg) * 16}
            if (EN_S1 && IN(pb)) for (int rp = 0; rp < NREP(2); ++rp) {
                FRESH_IDS; FRESH_PTRS; LAS unsigned char* wl = L + wave * 9728; LAS float* rvs = (LAS float*)(L + 8 * 9728);
                for (int u = uni ? gq * 64 + gm * 8 + wave : gw; u < (NCH - 1) * NG; u += uni ? (NCH * NG) : NGW) {
                    int lane = tid & 63; asm volatile("" : "+v"(lane));
                    const int g = u & 63, ch = u >> 6, hb = lane >> 5;
                    SSMT(g);
                    float st[4] = {0.f, 0.f, 0.f, 0.f};
                    ssm_mfma_unit<0>(wl, lane, g, T_, XB, rvs, ssp, tid, ch * CH, SEQ + ch * CH, CH / 16, st, nullptr, nullptr, nullptr, nullptr, nullptr, 0, 0);
                    { float* hs = HS + ((size_t)((hb * NCH + ch) * NG + g) * NS) * 2; const int r32 = lane & 31; *(float2*)(hs + 2 * r32) = make_float2(st[0], st[1]); *(float2*)(hs + 2 * (32 + r32)) = make_float2(st[2], st[3]); }
                }
                __syncthreads();
            }
            SEAM(pb, 8);
            if (EN_S3 && IN(pb + 1)) for (int rp = 0; rp < NREP(2); ++rp) {
                FRESH_IDS; FRESH_PTRS; LAS unsigned char* wl = L + wave * 9728; LAS float* rvs = (LAS float*)(L + 8 * 9728);
                for (int u = uni ? gq * 64 + gm * 8 + wave : gw; u < NCH * NG + (SB / 4) * NG; u += uni ? (NCH * NG) : NGW) {
                    int lane = tid & 63; asm volatile("" : "+v"(lane));
                    if (u < NCH * NG) {
                        const int g = u & 63, ch = u >> 6, r32 = lane & 31, hb = lane >> 5;
                        SSMT(g);
                        float st[4] = {0.f, 0.f, 0.f, 0.f};
                        f32x4 tv[2]; float2 e[16][2];
#pragma unroll
                        for (int p = 0; p < 2; ++p) tv[p] = *(const f32x4*)(T_.tab + (size_t)(32 * p + r32) * 4);
#pragma unroll
                        for (int k = 0; k < 16; ++k)
#pragma unroll
                            for (int p = 0; p < 2; ++p) e[k][p] = (k < ch) ? *(const float2*)(HS + ((size_t)((hb * NCH + k) * NG + g) * NS + 32 * p + r32) * 2) : make_float2(0.f, 0.f);
                        float aLr[2], aLi[2];
#pragma unroll
                        for (int p = 0; p < 2; ++p) {
                            float xr_ = tv[p][0], xi_ = tv[p][1];
#pragma unroll
                            for (int sq = 0; sq < 8; ++sq) { const float tr = xr_ * xr_ - xi_ * xi_, ti = 2.0f * xr_ * xi_; xr_ = tr; xi_ = ti; }
                            aLr[p] = xr_; aLi[p] = xi_;
                        }
                        for (int i0 = 0; i0 < ch; i0 += 16) {
                            if (i0 > 0) {
#pragma unroll
                                for (int k = 0; k < 16; ++k)
#pragma unroll
                                    for (int p = 0; p < 2; ++p) e[k][p] = (i0 + k < ch) ? *(const float2*)(HS + ((size_t)((hb * NCH + i0 + k) * NG + g) * NS + 32 * p + r32) * 2) : make_float2(0.f, 0.f);
                            }
#pragma unroll
                            for (int k = 0; k < 16; ++k) if (i0 + k < ch) {
#pragma unroll
                                for (int p = 0; p < 2; ++p) { const float tr = aLr[p] * st[2 * p] - aLi[p] * st[2 * p + 1] + e[k][p].x, ti = aLr[p] * st[2 * p + 1] + aLi[p] * st[2 * p] + e[k][p].y; st[2 * p] = tr; st[2 * p + 1] = ti; }
                            }
                        }
                        ssm_mfma_unit<1>(wl, lane, g, T_, XB, rvs, ssp, tid, ch * CH, SEQ + ch * CH, CH / 16, st, Ob, nullptr, nullptr, nullptr, nullptr, 0, 0);
                        if (ch == NCH - 1) { float* hr_o = out + O_HRP + ((size_t)(j * NB + hb) * NG + g) * NS; float* hi_o = out + O_HIP + ((size_t)(j * NB + hb) * NG + g) * NS;
                            hr_o[r32] = st[0]; hi_o[r32] = st[1]; hr_o[32 + r32] = st[2]; hi_o[32 + r32] = st[3]; }
                    } else {
                        const int us = u - NCH * NG, g = us & 63, bb = us >> 6;
                        const int rowL_ = uni ? MP + 16 * bb : MP + bb * 32, rowH_ = uni ? MP + 16 * (32 + bb) : MP + bb * 32 + 16, b0L_ = uni ? 2 * bb : 4 * bb, b0H_ = uni ? 64 + 2 * bb : 4 * bb + 2;
                        SSMT(g);
                        float st[4] = {0.f, 0.f, 0.f, 0.f};
                        ssm_mfma_unit<2>(wl, lane, g, T_, XB, rvs, ssp, tid, rowL_, rowH_, 1, st, Ob, INP(4) + (size_t)j * SB * NG * NS, INP(5) + (size_t)j * SB * NG * NS, out + O_HRS + (size_t)j * SB * NG * NS, out + O_HIS + (size_t)j * SB * NG * NS, b0L_, b0H_);
                    }
                }
                __syncthreads();
            }
            SEAM_L(pb + 1, 9);
            if (EN_GLU && IN(pb + 2)) {
                FRESH_PTRS;
                pg8::GemmX g{Ob, (const bf16*)(ws + WS_WGLU) + (size_t)j * 2 * D * D, nullptr, D}; pg8::PanelOrder S; { int cb_ = cbx, q_ = gq, m_ = gm; asm volatile("" : "+s"(cb_), "+s"(q_), "+s"(m_)); S.init(MP, 2 * D, G, cb_, uni ? 1 : 0, q_, m_); }
#if PROBE_S
                pg8::EpiGlu E{XB, ssp, 1.0f};
                pg8::gemm_phase_x<pg8::EpiGlu, pg8::PanelOrder>(L, g, S, E);
                if (PROBE_S & 4) { GRID_BARRIER(bar); pg8::EpiGlu E0{XB, ssp, 0.0f}; pg8::gemm_phase_x<pg8::EpiGlu, pg8::PanelOrder>(L, g, S, E0); }
#else
                pg8::EpiGlu E{XB, ssp};
                pg8::gemm_phase_x<pg8::EpiGlu, pg8::PanelOrder>(L, g, S, E);
#endif
            }
            SEAM_L(pb + 2, 10);
        }
        if (EN_UP && IN(pb + 3)) for (int rp = 0; rp < NREP(4); ++rp) {
            FRESH_PTRS;
            pg8::GemmX g{XB, (const bf16*)(ws + WS_WUP) + (size_t)l * FF * D, (const bf16*)((const char*)XB + pg8::XBX_OFF), D}; pg8::PanelOrder S; { int cb_ = cbx, q_ = gq, m_ = gm; asm volatile("" : "+s"(cb_), "+s"(q_), "+s"(m_)); S.init(MP, FF, G, cb_, uni ? 1 : 0, q_, m_); }
            pg8::EpiUp E{Hb, (bf16*)(ws + WS_H + 128 * MiB), ssp, (l & 1) ? 32 : 16, (l & 1) ? 64 : 32};
            if (threadIdx.x == 0) *(LAS int*)(L + pg8::RINV_TAB_OFF + 1152) = -1;
            __syncthreads();
            pg8::gemm_phase_x<pg8::EpiUp, pg8::PanelOrder, NREP(5), NREP(6), 0, true>(L, g, S, E);
        }
        SEAM_L(pb + 3, 11);
        if (EN_DN && IN(pb + 4)) {
            FRESH_PTRS;
            pg8::GemmX g{Hb, (const bf16*)(ws + WS_WDN) + (size_t)l * D * FF, (const bf16*)(ws + WS_H + 128 * MiB), FF}; pg8::PanelOrder S; { int cb_ = cbx, q_ = gq, m_ = gm; asm volatile("" : "+s"(cb_), "+s"(q_), "+s"(m_)); S.init(MP, D, G, cb_, uni ? 1 : 0, q_, m_); }
            if (l == 3 && fusefin) { pg8::EpiFin E{XB, ssp, INP(8), out, bar, uni}; pg8::gemm_phase_x<pg8::EpiFin, pg8::PanelOrder, 1, 1, 0, true>(L, g, S, E); }
            else {
            pg8::EpiRes E{XB, ssp};
            pg8::gemm_phase_x<pg8::EpiRes, pg8::PanelOrder, 1, 1, 0, true>(L, g, S, E); }
        }
        if (l < 3) SEAM_L(pb + 4, 12); else if (!fusefin) SEAM(pb + 4, 12); else MARK(12);
    }
    if (EN_FIN && IN(21) && !fusefin) for (int rp = 0; rp < NREP(9); ++rp) {
        FRESH_IDS; FRESH_PTRS;
        const float* gf = INP(8);
        f32x4 gv[4];
#pragma unroll
        for (int jx = 0; jx < 4; ++jx) gv[jx] = *(const f32x4*)(gf + 256 * jx + 4 * lane);
        for (int m0 = gw; m0 < M; m0 += 4 * NGW) {
            float pv[4]; pg8::u32x2 xw[4][4];
#pragma unroll
            for (int r = 0; r < 4; ++r) { const int m = m0 + r * NGW; pv[r] = 0.f;
                if (m < M) { if (lane < ((m < MP) ? 16 : 32)) pv[r] = ssp[(size_t)m * 64 + lane];
#pragma unroll
                    for (int jx = 0; jx < 4; ++jx) xw[r][jx] = *(const pg8::u32x2*)((const char*)XB + pg8::xb_off(m, 4 * lane + 256 * jx)); } }
#pragma unroll
            for (int r = 0; r < 4; ++r) { const int m = m0 + r * NGW;
                if (m < M) { const float rinv = rsqrtf(wave_sum(pv[r]) * (1.0f / 1024.0f) + 1e-6f); float* yo = out + (size_t)m * D + 4 * lane;
#pragma unroll
                    for (int jx = 0; jx < 4; ++jx) *(f32x4*)(yo + 256 * jx) = pg8::unpack4(xw[r][jx]) * rinv * gv[jx]; } }
        }
    }
    if (PROBE_TM) { const unsigned long long t0_ = __builtin_amdgcn_s_memrealtime(), dl_ = (unsigned long long)(PROBE_A) * tacc; while (__builtin_amdgcn_s_memrealtime() - t0_ < dl_) __builtin_amdgcn_s_sleep(8); }
#undef IN
#undef SEAM
}

#ifndef MK_SPLIT
#define MK_SPLIT 0
#endif
extern "C" void kernel_launch(void* const* d_in, const int* in_sizes, int n_in, void* d_out, int out_size, void* d_ws, size_t ws_size, hipStream_t stream) {
    static int grid = 0;
    if (grid == 0) {
        if (n_in != 23 || in_sizes[0] != MP * D || (size_t)out_size != O_END || ws_size < WS_END) { fprintf(stderr, "kernel_launch: unexpected shapes (n_in %d, in0 %d, out %d, ws %zu); nothing launched\n", n_in, n_in > 0 ? in_sizes[0] : -1, out_size, ws_size); grid = -1; return; }
        int dev = 0, cus = 0, per_cu = 0;
        if (hipGetDevice(&dev) != hipSuccess || hipDeviceGetAttribute(&cus, hipDeviceAttributeMultiprocessorCount, dev) != hipSuccess) { fprintf(stderr, "kernel_launch: device query failed\n"); grid = -1; return; }
        if (hipFuncSetAttribute((const void*)fwd_kernel, hipFuncAttributeMaxDynamicSharedMemorySize, LDS_BYTES) != hipSuccess) { fprintf(stderr, "kernel_launch: hipFuncSetAttribute failed\n"); grid = -1; return; }
        if (hipOccupancyMaxActiveBlocksPerMultiprocessor(&per_cu, (const void*)fwd_kernel, 512, LDS_BYTES) != hipSuccess || per_cu < 1) fprintf(stderr, "kernel_launch: note: occupancy query reports %d blocks per CU\n", per_cu);
        (void)hipGetLastError();
        grid = cus;
    }
    if (grid < 0) return;
    (void)hipMemsetAsync((char*)d_ws + WS_CTL, 0, CTL_ZERO_BYTES, stream);
    Args a{};
    for (int i = 0; i < 23; ++i) a.in[i] = (const float*)d_in[i];
    a.out = (float*)d_out; a.ws = (unsigned char*)d_ws;
#if MK_SPLIT
    for (int p = 0; p < NPHASE; ++p) { a.ph_lo = p; a.ph_hi = p + 1; hipLaunchKernelGGL(fwd_kernel, dim3(grid), dim3(512), LDS_BYTES, stream, a); }
#else
    a.ph_lo = 0; a.ph_hi = NPHASE; hipLaunchKernelGGL(fwd_kernel, dim3(grid), dim3(512), LDS_BYTES, stream, a);
#endif
}
```

```cpp
#include <hip/hip_runtime.h>
#include <cstdio>
#include <cstdint>
namespace pg8 {
#define PG8_LAS __attribute__((address_space(3)))
typedef unsigned short bf16_t;
typedef short bf16x8 __attribute__((ext_vector_type(8)));
typedef float f32x4 __attribute__((ext_vector_type(4)));
typedef unsigned u32x4 __attribute__((ext_vector_type(4)));
constexpr int BM = 256, BK = 64, HALF = 128, HTB = HALF * BK * 2  , STAGE_BYTES = 8 * HTB, NXCD = 8, WGM = 8;

__host__ __device__ __forceinline__ int lds_byte(int r, int c) { const int st = (r >> 4) * 2 + (c >> 5), rr = r & 15, cc = c & 31, ob = rr * 64 + cc * 2; return st * 1024 + (ob ^ (((ob >> 9) & 1) << 5)); }
__host__ __device__ __forceinline__ void stage_rc(int b, int& R, int& C) { const int st = b / 1024, sb = b % 1024, swz = sb ^ (((sb >> 9) & 1) << 5); R = (st >> 1) * 16 + swz / 64; C = (st & 1) * 32 + (swz % 64) / 2; }
__host__ __device__ __forceinline__ int perm32(int rho) { const int n = rho >> 4, i = rho & 15; return 8 * (i >> 2) + 4 * n + (i & 3); }

struct Unit { int pm, pn; };
struct Gemm { const bf16_t* A; const bf16_t* Bt; int M, N, K; };

struct StaticOrder {
    int nM, nN, nwg, G, c;
    __host__ __device__ void init(int M, int N, int G_, int c_) { nM = M / BM; nN = N / BM; nwg = nM * nN; G = G_; c = c_; }
    __host__ __device__ bool next(int i, Unit& u) const {
        const long L = (long)i * G + c; if (L >= nwg) return false;
        int wgid = (int)L; { const int q = nwg / NXCD, r = nwg % NXCD, xcd = wgid % NXCD, off = wgid / NXCD; wgid = (xcd < r ? xcd * (q + 1) : r * (q + 1) + (xcd - r) * q) + off; }
        const int nig = WGM * nN, gid = wgid / nig, fm = gid * WGM, gsz = (nM - fm) < WGM ? (nM - fm) : WGM;
        u.pm = fm + ((wgid % nig) % gsz); u.pn = (wgid % nig) / gsz; return true;
    }
    __device__ __forceinline__ void a_ready(const Unit&) const {}
    __device__ __forceinline__ void done(const Unit&) const {}
};
__device__ __forceinline__ unsigned cvt_pk_bf16(float lo, float hi) { unsigned r; asm volatile("v_cvt_pk_bf16_f32 %0, %1, %2" : "=v"(r) : "v"(lo), "v"(hi)); return r; }
typedef float f32x2 __attribute__((ext_vector_type(2)));
template <class Epi, class Sched, bool ALIGN_EPI = false, bool SP2 = false>
__device__ __forceinline__ void gemm_phase(PG8_LAS unsigned char* lds, const Gemm g, const Sched& S, const Epi& E) {
    int tid_ = threadIdx.x; asm volatile("" : "+v"(tid_));
    const int tid = tid_, wid = __builtin_amdgcn_readfirstlane(tid >> 6), lane = tid & 63, wr = wid >> 2, wc = wid & 3, fr = lane & 15, fq = lane >> 4;
    const int K = g.K, nt = K / BK;
    unsigned voffA[2], voffB[2];
#pragma unroll
    for (int i = 0; i < 2; ++i) { int R, C; stage_rc(tid * 16 + i * 8192, R, C); const int Rb = Epi::PERM ? ((R & ~31) + perm32(R & 31)) : R;
        voffA[i] = (unsigned)(R * K + C) * 2u; voffB[i] = (unsigned)(Rb * K + C) * 2u; }
    const size_t kstep = (size_t)(BK * 2);
    const size_t hstep = (size_t)HALF * K * 2;
    const size_t tstep = 2 * hstep;
    const unsigned ldsw = (unsigned)wid * 1024u;
    const int aoff = lds_byte(wr * 64 + fr, fq * 8), boff = lds_byte(wc * 32 + fr, fq * 8);
#define PG8_SA(b, h) (((b) * 2 + (h)) * HTB)
#define PG8_SB(b, h) ((4 + (b) * 2 + (h)) * HTB)
#define PG8_STAGE(bufoff, gbase, voff) do { _Pragma("unroll") for (int _i = 0; _i < 2; ++_i) \
        __builtin_amdgcn_global_load_lds((const unsigned*)((const char*)(gbase) + (voff)[_i]), (PG8_LAS unsigned*)(lds + (bufoff) + ldsw + _i * 8192), 16, 0, 0); } while (0)
#define PG8_LDA(dst, b, h) do { _Pragma("unroll") for (int m = 0; m < 4; ++m) _Pragma("unroll") for (int k = 0; k < 2; ++k) dst[m][k] = *(const PG8_LAS bf16x8*)(lds + PG8_SA(b, h) + aoff + m * 2048 + k * 1024); } while (0)
#define PG8_LDB(dst, b, h) do { _Pragma("unroll") for (int n = 0; n < 2; ++n) _Pragma("unroll") for (int k = 0; k < 2; ++k) dst[n][k] = *(const PG8_LAS bf16x8*)(lds + PG8_SB(b, h) + boff + n * 2048 + k * 1024); } while (0)
#define PG8_MMA(ai, bj, At, Bt) do { __builtin_amdgcn_s_setprio(1); _Pragma("unroll") for (int m = 0; m < 4; ++m) _Pragma("unroll") for (int n = 0; n < 2; ++n) _Pragma("unroll") for (int k = 0; k < 2; ++k) \
        acc[ai][bj][m][n] = __builtin_amdgcn_mfma_f32_16x16x32_bf16(Bt[n][k], At[m][k], acc[ai][bj][m][n], 0, 0, 0); __builtin_amdgcn_s_setprio(0); } while (0)
#define PG8_WAIT_V(n) asm volatile("s_waitcnt vmcnt(" #n ")" ::: "memory")
#define PG8_WAIT_L(n) asm volatile("s_waitcnt lgkmcnt(" #n ")" ::: "memory")
#define PG8_BAR __builtin_amdgcn_s_barrier()
#define PG8_SCHED __builtin_amdgcn_sched_barrier(0)
    Unit cur, nxt; int ui = 0;
    if (!S.next(0, cur)) return;
    f32x4 acc[2][2][4][2];
#pragma unroll
    for (int a = 0; a < 2; ++a)
#pragma unroll
        for (int b = 0; b < 2; ++b)
#pragma unroll
            for (int m = 0; m < 4; ++m)
#pragma unroll
                for (int n = 0; n < 2; ++n) acc[a][b][m][n] = (f32x4){0.f, 0.f, 0.f, 0.f};
    bf16x8 At[4][2], B0[2][2], B1[2][2];
    const char* cA = (const char*)g.A + (size_t)cur.pm * tstep; const char* cB = (const char*)g.Bt + (size_t)cur.pn * tstep;
    S.a_ready(cur);
    if constexpr (SP2) {
        PG8_STAGE(PG8_SB(0, 0), cB, voffB); PG8_STAGE(PG8_SB(0, 1), cB + hstep, voffB); PG8_STAGE(PG8_SA(0, 0), cA, voffA); PG8_STAGE(PG8_SA(0, 1), cA + hstep, voffA);
        if (wr == 1) PG8_BAR;
        PG8_WAIT_V(2); PG8_BAR;
        PG8_STAGE(PG8_SB(1, 0), cB + kstep, voffB); PG8_STAGE(PG8_SA(1, 0), cA + kstep, voffA); PG8_STAGE(PG8_SB(1, 1), cB + hstep + kstep, voffB);
        PG8_WAIT_V(6); PG8_BAR;
    } else {
        PG8_STAGE(PG8_SB(0, 0), cB, voffB); PG8_STAGE(PG8_SA(0, 0), cA, voffA); PG8_STAGE(PG8_SB(0, 1), cB + hstep, voffB); PG8_STAGE(PG8_SA(0, 1), cA + hstep, voffA);
        if (wr == 1) PG8_BAR;
        PG8_WAIT_V(4); PG8_BAR;
        PG8_STAGE(PG8_SB(1, 0), cB + kstep, voffB); PG8_STAGE(PG8_SA(1, 0), cA + kstep, voffA); PG8_STAGE(PG8_SB(1, 1), cB + hstep + kstep, voffB);
        PG8_WAIT_V(6); PG8_BAR;
    }
    for (;;) {
        const bool has_next = S.next(ui + 1, nxt);
        const char* nA = has_next ? (const char*)g.A + (size_t)nxt.pm * tstep : cA; const char* nB = has_next ? (const char*)g.Bt + (size_t)nxt.pn * tstep : cB;
        for (int t = 0; t < nt; t += 2) {
            const bool last = (t == nt - 2);
            const char* a1 = cA + (size_t)(t + 1) * kstep;
            const char* a2 = last ? nA : cA + (size_t)(t + 2) * kstep; const char* b2 = last ? nB : cB + (size_t)(t + 2) * kstep;
            const char* a3 = a2 + kstep; const char* b3 = b2 + kstep;
            if (last && has_next) S.a_ready(nxt);
            if constexpr (SP2) {
            PG8_LDB(B0, 0, 0); PG8_LDB(B1, 0, 1); PG8_SCHED; PG8_LDA(At, 0, 0); PG8_STAGE(PG8_SA(1, 1), a1 + hstep, voffA);
            PG8_WAIT_V(8); PG8_WAIT_L(0); PG8_BAR; PG8_MMA(0, 0, At, B0); PG8_MMA(0, 1, At, B1); PG8_BAR; PG8_SCHED;
            PG8_LDA(At, 0, 1); PG8_STAGE(PG8_SB(0, 0), b2, voffB); PG8_STAGE(PG8_SB(0, 1), b2 + hstep, voffB); PG8_STAGE(PG8_SA(0, 0), a2, voffA);
            PG8_WAIT_V(8); PG8_WAIT_L(0); PG8_BAR; PG8_MMA(1, 0, At, B0); PG8_MMA(1, 1, At, B1); PG8_BAR; PG8_SCHED;
            PG8_LDB(B0, 1, 0); PG8_LDB(B1, 1, 1); PG8_SCHED; PG8_LDA(At, 1, 0); PG8_STAGE(PG8_SA(0, 1), a2 + hstep, voffA);
            PG8_WAIT_V(8); PG8_WAIT_L(0); PG8_BAR; PG8_MMA(0, 0, At, B0); PG8_MMA(0, 1, At, B1); PG8_BAR; PG8_SCHED;
            PG8_LDA(At, 1, 1); PG8_STAGE(PG8_SB(1, 0), b3, voffB); PG8_STAGE(PG8_SB(1, 1), b3 + hstep, voffB); PG8_STAGE(PG8_SA(1, 0), a3, voffA);
            PG8_WAIT_V(8); PG8_WAIT_L(0); PG8_BAR; PG8_MMA(1, 0, At, B0); PG8_MMA(1, 1, At, B1); PG8_BAR; PG8_SCHED;
            } else {
            PG8_LDB(B0, 0, 0); PG8_SCHED; PG8_LDA(At, 0, 0); PG8_STAGE(PG8_SA(1, 1), a1 + hstep, voffA);
            PG8_WAIT_L(8); PG8_BAR; PG8_WAIT_L(0); PG8_MMA(0, 0, At, B0); PG8_BAR; PG8_SCHED;
            PG8_LDB(B1, 0, 1); PG8_STAGE(PG8_SB(0, 0), b2, voffB);
            PG8_BAR; PG8_WAIT_L(0); PG8_MMA(0, 1, At, B1); PG8_BAR;
            PG8_LDA(At, 0, 1); PG8_STAGE(PG8_SA(0, 0), a2, voffA);
            PG8_BAR; PG8_WAIT_L(0); PG8_MMA(1, 0, At, B0); PG8_BAR; PG8_SCHED;
            PG8_STAGE(PG8_SB(0, 1), b2 + hstep, voffB);
            PG8_WAIT_V(6); PG8_BAR; PG8_MMA(1, 1, At, B1); PG8_BAR;
            PG8_LDB(B0, 1, 0); PG8_SCHED; PG8_LDA(At, 1, 0); PG8_STAGE(PG8_SA(0, 1), a2 + hstep, voffA);
            PG8_WAIT_L(8); PG8_BAR; PG8_WAIT_L(0); PG8_MMA(0, 0, At, B0); PG8_BAR; PG8_SCHED;
            PG8_LDB(B1, 1, 1); PG8_STAGE(PG8_SB(1, 0), b3, voffB);
            PG8_BAR; PG8_WAIT_L(0); PG8_MMA(0, 1, At, B1); PG8_BAR;
            PG8_LDA(At, 1, 1); PG8_STAGE(PG8_SA(1, 0), a3, voffA);
            PG8_BAR; PG8_WAIT_L(0); PG8_MMA(1, 0, At, B0); PG8_BAR; PG8_SCHED;
            PG8_STAGE(PG8_SB(1, 1), b3 + hstep, voffB);
            PG8_WAIT_V(6); PG8_BAR; PG8_MMA(1, 1, At, B1); PG8_BAR;
            }
        }
        if constexpr (ALIGN_EPI) { if (wr == 0) PG8_BAR; }
        if constexpr (!Epi::AFTER_DRAIN) { E(acc, cur, wr, wc, fr, fq); S.done(cur); }
        if (!has_next) break;
#pragma unroll
        for (int a = 0; a < 2; ++a)
#pragma unroll
            for (int b = 0; b < 2; ++b)
#pragma unroll
                for (int m = 0; m < 4; ++m)
#pragma unroll
                    for (int n = 0; n < 2; ++n) acc[a][b][m][n] = (f32x4){0.f, 0.f, 0.f, 0.f};
        cur = nxt; cA = nA; cB = nB; ++ui;
        if constexpr (ALIGN_EPI) { if (wr == 1) PG8_BAR; }
    }
    PG8_WAIT_V(0);
    if constexpr (!ALIGN_EPI) { if (wr == 0) PG8_BAR; }
    PG8_BAR;
    if constexpr (Epi::AFTER_DRAIN) { E.fused(acc, cur, wr, wc, fr, fq, lds, wid, lane); S.done(cur); }
#undef PG8_SA
#undef PG8_SB
#undef PG8_STAGE
#undef PG8_LDA
#undef PG8_LDB
#undef PG8_MMA
#undef PG8_WAIT_V
#undef PG8_WAIT_L
#undef PG8_BAR
#undef PG8_SCHED
}
}
#define GAS __attribute__((address_space(1)))
#define LAS __attribute__((address_space(3)))
typedef unsigned short bf16;
typedef unsigned v4u __attribute__((ext_vector_type(4)));
typedef float f32x4 __attribute__((ext_vector_type(4)));
typedef short bf16x8 __attribute__((ext_vector_type(8)));
typedef GAS unsigned gu32;
typedef GAS unsigned long long gu64;
#define RLX_AGENT __ATOMIC_RELAXED, __HIP_MEMORY_SCOPE_AGENT
#define LDS_WAIT() asm volatile("s_waitcnt lgkmcnt(0)" ::: "memory")
#define VM_WAIT() asm volatile("s_waitcnt vmcnt(0)" ::: "memory")
__device__ __forceinline__ unsigned long long rt() { return __builtin_amdgcn_s_memrealtime(); }
__device__ __forceinline__ unsigned f2bf(float f) { unsigned u = __builtin_bit_cast(unsigned, f); return (u + 0x7fffu + ((u >> 16) & 1u)) >> 16; }
typedef float pk2_f32x2 __attribute__((ext_vector_type(2)));
typedef __bf16 pk2_bf16x2 __attribute__((ext_vector_type(2)));
__device__ __forceinline__ unsigned pk2(float lo, float hi) { pk2_f32x2 v = {lo, hi}; pk2_bf16x2 b = __builtin_convertvector(v, pk2_bf16x2); return __builtin_bit_cast(unsigned, b); }
#define XB_TMO      128
#define XB_XCNT(j)  (256  + 64 * (j))
#define XB_XSUB(j)  (1280 + 64 * (j))
#define XB_XGEN(j)  (2304 + 64 * (j))
#define XB_TOP      3328
#define XB_TOPGEN   3392
#define XB_LSUB(j)  (3520 + 64 * (j))
#define XCD_BAR_WORDS (3520 + 64 * 128)
#define XB_SPIN_CAP (1u << 18)
#define BAR_EARLY_INV 1
#define TOUCH_TILES 4
#define BAR_EARLY_WB 1
#if BAR_EARLY_INV
#define EARLY_INV() asm volatile("buffer_inv sc1" ::: "memory")
#define LATE_ACQ() asm volatile("" ::: "memory")
#else
#define EARLY_INV() do {} while (0)
#define LATE_ACQ() __builtin_amdgcn_fence(__ATOMIC_ACQUIRE, "agent")
#endif
#define BAR_POLL_SLEEP 1

__device__ __forceinline__ unsigned xb_ld(unsigned* p)              { return __hip_atomic_load(p, __ATOMIC_RELAXED, __HIP_MEMORY_SCOPE_AGENT); }
__device__ __forceinline__ unsigned xb_add(unsigned* p, unsigned v) { return __hip_atomic_fetch_add(p, v, __ATOMIC_RELAXED, __HIP_MEMORY_SCOPE_AGENT); }
__device__ __forceinline__ unsigned xb_xcc_id() { return (unsigned)__builtin_amdgcn_s_getreg((3 << 11) | 20) & 0xFu; }
#define XB_SPIN(cond, bar) do { unsigned _sp = 0; while (cond) { __builtin_amdgcn_s_sleep(1); \
    if ((++_sp & 255u) == 0u) { if (xb_ld(&(bar)[XB_TMO])) break; if (_sp > XB_SPIN_CAP) { atomicAdd(&(bar)[XB_TMO], 1u); break; } } } } while (0)

struct XcdBarrier {
    unsigned* bar; unsigned x;
    volatile LAS unsigned* st;
};

__device__ __forceinline__ XcdBarrier xcd_barrier_post(unsigned* bar, volatile LAS unsigned* st) {
    XcdBarrier b; b.bar = bar; b.x = xb_xcc_id(); b.st = st;
    if (threadIdx.x == 0) st[2] = xb_add(&bar[XB_XCNT(b.x)], 1u);
    return b;
}
__device__ __forceinline__ void xcd_barrier_complete(unsigned* bar, unsigned x, unsigned& nloc, unsigned& nx, unsigned& even) {
    const unsigned G = gridDim.x * gridDim.y * gridDim.z;
    unsigned sum, cnt, mine, ev, sp = 0u;
    for (;;) {
        sum = 0u; cnt = 0u; mine = 0u; ev = (G % 64u == 0u) ? 1u : 0u;
#pragma unroll
        for (unsigned j = 0; j < 16; ++j) { const unsigned c = xb_ld(&bar[XB_XCNT(j)]); sum += c; cnt += (c > 0u) ? 1u : 0u; mine = (j == x) ? c : mine; ev = (c == ((j < 8u) ? G / 8u : 0u)) ? ev : 0u; }
        if (sum == G) break;
        __builtin_amdgcn_s_sleep(1);
        if ((++sp & 255u) == 0u) { if (xb_ld(&bar[XB_TMO])) break; if (sp > XB_SPIN_CAP) { atomicAdd(&bar[XB_TMO], 1u); break; } }
    }
    nloc = mine > 0u ? mine : 1u; nx = cnt > 0u ? cnt : 1u; even = (sum == G) ? ev : 0u;
}

__device__ __forceinline__ void xcd_barrier(const XcdBarrier& b) {
    asm volatile("s_waitcnt vmcnt(0)" ::: "memory");
    __syncthreads();
    if (threadIdx.x == 0) {
        unsigned* bar = b.bar;
        __builtin_amdgcn_s_waitcnt(0);
        unsigned nloc = b.st[0], nx = b.st[1];
        if (nloc == 0u) { unsigned ev; xcd_barrier_complete(bar, b.x, nloc, nx, ev); b.st[0] = nloc; b.st[1] = nx; b.st[3] = ev; }
        const unsigned old = xb_add(&bar[XB_XSUB(b.x)], 1u);
        const unsigned gen = old / nloc;
        if (old + 1u == (gen + 1u) * nloc) {
            __builtin_amdgcn_fence(__ATOMIC_RELEASE, "agent");
            asm volatile("s_waitcnt vmcnt(0)" ::: "memory");
            const unsigned og = xb_add(&bar[XB_TOP], 1u);
            const unsigned tg = og / nx;
            if (og + 1u == (tg + 1u) * nx) xb_add(&bar[XB_TOPGEN], 1u);
            else XB_SPIN(xb_ld(&bar[XB_TOPGEN]) == tg, bar);
            __builtin_amdgcn_fence(__ATOMIC_ACQUIRE, "agent");
            xb_add(&bar[XB_XGEN(b.x)], 1u);
            asm volatile("s_waitcnt vmcnt(0)" ::: "memory");
        } else {
            XB_SPIN(xb_ld(&bar[XB_XGEN(b.x)]) == gen, bar);
            __builtin_amdgcn_fence(__ATOMIC_ACQUIRE, "agent");
            asm volatile("s_waitcnt vmcnt(0)" ::: "memory");
        }
    }
    __syncthreads();
}

__device__ __forceinline__ void flat_barrier(const XcdBarrier& b) {
    asm volatile("s_waitcnt vmcnt(0)" ::: "memory");
    __syncthreads();
    if (threadIdx.x == 0) {
        unsigned* bar = b.bar;
        __builtin_amdgcn_s_waitcnt(0);
        const unsigned r = b.st[0] + 1u; b.st[0] = r;
        __builtin_amdgcn_fence(__ATOMIC_RELEASE, "agent");
        asm volatile("s_waitcnt vmcnt(0)" ::: "memory");
        (void)xb_add(&bar[XB_XSUB(b.x & 7u)], 1u);
        const unsigned target = gridDim.x * r;
        unsigned sp = 0u;
        for (;;) {
            unsigned c[8];
#pragma unroll
            for (unsigned j = 0; j < 8; ++j) c[j] = xb_ld(&bar[XB_XSUB(j)]);
            const unsigned sum = ((c[0] + c[1]) + (c[2] + c[3])) + ((c[4] + c[5]) + (c[6] + c[7]));
            if (sum >= target) break;
            __builtin_amdgcn_s_sleep(1);
            if ((++sp & 255u) == 0u) { if (xb_ld(&bar[XB_TMO])) break; if (sp > XB_SPIN_CAP) { atomicAdd(&bar[XB_TMO], 1u); break; } }
        }
        __builtin_amdgcn_fence(__ATOMIC_ACQUIRE, "agent");
        asm volatile("s_waitcnt vmcnt(0)" ::: "memory");
    }
    __syncthreads();
}

__device__ __forceinline__ void xcd_barrier2(const XcdBarrier& b) {
    asm volatile("s_waitcnt vmcnt(0)" ::: "memory");
    __syncthreads();
    if (threadIdx.x == 0) {
        unsigned* bar = b.bar;
        __builtin_amdgcn_s_waitcnt(0);
        unsigned nloc = b.st[0], nx = b.st[1];
        if (nloc == 0u) { unsigned ev; xcd_barrier_complete(bar, b.x, nloc, nx, ev); b.st[0] = nloc; b.st[1] = nx; b.st[3] = ev; }
        EARLY_INV();
        const unsigned old = xb_add(&bar[XB_XSUB(b.x)], 1u);
        const unsigned gen = old / nloc;
        if (old + 1u == (gen + 1u) * nloc) {
            __builtin_amdgcn_fence(__ATOMIC_RELEASE, "agent");
            asm volatile("s_waitcnt vmcnt(0)" ::: "memory");
            (void)xb_add(&bar[XB_TOP], 1u);
        } else if (BAR_EARLY_WB && (old == gen * nloc || old == gen * nloc + (nloc >> 1))) {
            asm volatile("buffer_wbl2 sc1" ::: "memory");
        }
        const unsigned target = (gen + 1u) * nx;
        { unsigned _sp = 0; while (xb_ld(&bar[XB_TOP]) < target) { __builtin_amdgcn_s_sleep(BAR_POLL_SLEEP);
            if ((++_sp & 255u) == 0u) { if (xb_ld(&bar[XB_TMO])) break; if (_sp > XB_SPIN_CAP) { atomicAdd(&bar[XB_TMO], 1u); break; } } } }
        LATE_ACQ();
        asm volatile("s_waitcnt vmcnt(0)" ::: "memory");
    }
    __syncthreads();
}

__device__ __forceinline__ void xcd_local_barrier(const XcdBarrier& b, const char* touch = nullptr, unsigned tstride = 0) {
    asm volatile("s_waitcnt vmcnt(0)" ::: "memory");
    __syncthreads();
    if (touch != nullptr && threadIdx.x >= 64) {
        unsigned t = threadIdx.x - 64u; asm volatile("" : "+v"(t));
        unsigned tv[3];
#pragma unroll
        for (int i = 0; i < 3; ++i) { unsigned ln = t + 448u * i; ln = (ln < 256u * TOUCH_TILES) ? ln : t; tv[i] = *(const unsigned*)(touch + ((tstride == 0u) ? (size_t)ln * 128u : (size_t)(ln & 255u) * tstride + (ln >> 8) * 128u)); }
        asm volatile("" :: "v"(tv[0]), "v"(tv[1]), "v"(tv[2]));
    }
    if (threadIdx.x == 0) {
        unsigned* bar = b.bar;
        __builtin_amdgcn_s_waitcnt(0);
        const unsigned ngrp = b.st[0] >> 2, j = 4u * b.x + (b.st[2] & 3u);
        EARLY_INV();
        const unsigned old = xb_add(&bar[XB_LSUB(j)], 1u);
        const unsigned target = (old / ngrp + 1u) * ngrp;
        XB_SPIN(xb_ld(&bar[XB_LSUB(j)]) < target, bar);
        LATE_ACQ();
        asm volatile("s_waitcnt vmcnt(0)" ::: "memory");
    }
    __syncthreads();
}

constexpr int D = 1024, SEQ = 8192, NB = 2, MP = NB * SEQ, SB = 128, ST = 8, MS = SB * ST, M = MP + MS;
constexpr int NQKV = 1536, FF = 4096, NKV = 4, HD = 64, KVW = NKV * HD, NG = 64, GC = 16, NS = 64;
constexpr int CH = 256, NCH = SEQ / CH;
constexpr int NPHASE = 22;
constexpr size_t O_KP = 17825792, O_VP = 17956864, O_HRP = 18087936, O_HIP = 18104320, O_KS = 18120704, O_VS = 26509312, O_HRS = 34897920, O_HIS = 35946496, O_END = 36995072;
constexpr size_t MiB = 1u << 20;
constexpr size_t WS_CTL = 0, CTL_ZERO_BYTES = 64 * 1024;
constexpr size_t WS_SSP = 1 * MiB;
constexpr size_t WS_TAB = 5 * MiB + 512 * 1024;
constexpr size_t WS_HS = 6 * MiB;
constexpr size_t WS_WQKV = 8 * MiB, WS_WO = 14 * MiB, WS_WGLU = 18 * MiB, WS_WUP = 26 * MiB, WS_WDN = 58 * MiB;
constexpr size_t WS_XB = 90 * MiB;
constexpr size_t WS_H = 124 * MiB;
constexpr size_t WS_Q = 124 * MiB, WS_K = 158 * MiB, WS_V = 167 * MiB, WS_O = 176 * MiB;
constexpr size_t WS_BT = 260 * MiB, WS_CT = 261 * MiB;
constexpr size_t WS_END = 262 * MiB;
constexpr int CW_BAR = 4096;
static_assert((CW_BAR + XCD_BAR_WORDS) * 4 <= (int)CTL_ZERO_BYTES, "barrier words inside the memset region");
constexpr int RING_BYTES = 131072, XA_BYTES = 4096, LDSCTL_OFF = RING_BYTES + XA_BYTES  , MISC_OFF = LDSCTL_OFF + 320, LDS_BYTES = 147456;

__device__ __forceinline__ float wave_sum(float v) {
#pragma unroll
    for (int o = 1; o < 64; o <<= 1) v += __shfl_xor(v, o);
    return v;
}
__device__ __forceinline__ float wave_max(float v) {
#pragma unroll
    for (int o = 1; o < 64; o <<= 1) v = fmaxf(v, __shfl_xor(v, o));
    return v;
}
__device__ __forceinline__ float bf_lo(unsigned u) { return __uint_as_float(u << 16); }
__device__ __forceinline__ float bf_hi(unsigned u) { return __uint_as_float(u & 0xffff0000u); }

#define PROBE_DUP 0
#define PROBE_SSP2 0
#define PROBE_TM 0
#define PROBE_A 4
#define KREP_FOREIGN_B 0
#define KREP_DN 1
#define PROBE_HALF 0
struct Prof { unsigned long long tacc, tlast; };
#define PMARK(pr, c) do { if (PROBE_TM && (c) > 0) { const unsigned long long n_ = __builtin_amdgcn_s_memrealtime(); if (((PROBE_TM) >> (c)) & 1) (pr).tacc += n_ - (pr).tlast; (pr).tlast = n_; } } while (0)
#define PROBE_S (((PROBE_DUP) >> 6) & 7)
__device__ __forceinline__ float xsum16(float v) { const unsigned u = __builtin_bit_cast(unsigned, v); const auto r = __builtin_amdgcn_permlane16_swap(u, u, false, false); return __builtin_bit_cast(float, (unsigned)r[0]) + __builtin_bit_cast(float, (unsigned)r[1]); }
__device__ __forceinline__ float xsum32(float v) { const unsigned u = __builtin_bit_cast(unsigned, v); const auto r = __builtin_amdgcn_permlane32_swap(u, u, false, false); return __builtin_bit_cast(float, (unsigned)r[0]) + __builtin_bit_cast(float, (unsigned)r[1]); }
__device__ __forceinline__ float xmax32(float v) { const unsigned u = __builtin_bit_cast(unsigned, v); const auto r = __builtin_amdgcn_permlane32_swap(u, u, false, false); return fmaxf(__builtin_bit_cast(float, (unsigned)r[0]), __builtin_bit_cast(float, (unsigned)r[1])); }
namespace pg8 {
constexpr int XMP = 16384;
constexpr bool BTILED = true;
__host__ __device__ __forceinline__ int invperm32(int c) { return 16 * ((c >> 2) & 1) + 4 * (c >> 3) + (c & 3); }
constexpr size_t XBX_OFF = (size_t)32 << 20;
__host__ __device__ __forceinline__ size_t xb_off(int row, int col) {
    return (row < XMP) ? ((size_t)((((row >> 8) * 16 + (col >> 6)) * 2 + ((row >> 7) & 1))) * 16384 + lds_byte(row & 127, col & 63))
                       : XBX_OFF + (size_t)((((row - XMP) >> 4) * 16 + (col >> 6))) * 2048 + lds_byte((row - XMP) & 15, col & 63);
}
struct PanelOrder {
    StaticOrder so; int grp, q, m, nN2;
    __device__ __forceinline__ void init(int M, int N, int G_, int c_, int grp_, int q_, int m_) { so.init(M, N, G_, c_); grp = grp_; q = q_; m = m_; nN2 = 2 * (N / BM); }
    __device__ __forceinline__ bool next(int i, Unit& u) const {
        if (!grp) return so.next(i, u);
        const int idx = m + 8 * i; if (idx >= nN2) return false;
        u.pm = (idx & 1) ? 32 + q : q; u.pn = idx >> 1; return true;
    }
    __device__ __forceinline__ void a_ready(const Unit&) const {}
    __device__ __forceinline__ void done(const Unit&) const {}
};
template <int NL>
__device__ __forceinline__ float row_rinv(const float* ssp, int row, int np, int fq) {
    const float* p = ssp + (size_t)row * 64 + (np >> 2) * fq;
    f32x4 v[NL];
#pragma unroll
    for (int i = 0; i < NL; ++i) v[i] = *(const f32x4*)(p + 4 * i);
    float s = 0.f, s2 = 0.f;
#pragma unroll
    for (int i = 0; i < NL / 2; ++i) { s += (v[i][0] + v[i][1]) + (v[i][2] + v[i][3]); s2 += (v[NL / 2 + i][0] + v[NL / 2 + i][1]) + (v[NL / 2 + i][2] + v[NL / 2 + i][3]); }
    s += (np == 16 * NL) ? s2 : 0.f;
    s = xsum16(s); s = xsum32(s);
    return rsqrtf(s * (1.0f / 1024.0f) + 1e-6f);
}
constexpr int RINV_TAB_OFF = 135680;
__device__ __forceinline__ void unit_rinv_to_lds(PG8_LAS unsigned char* lds, const float* ssp, int pm, int np, int nps) {
    int t = threadIdx.x; asm volatile("" : "+v"(t));
    PG8_LAS float* tab = (PG8_LAS float*)(lds + RINV_TAB_OFF);
    if (t < 288) {
        const bool smp = t >= 256; const int hf = smp ? ((t - 256) >> 4) : 0;
        const int row = smp ? XMP + pm * 16 + (t & 15) : pm * BM + t; const int n = (smp ? nps : np) - 32 * hf;
        const float* p = ssp + (size_t)row * 64 + 32 * hf;
        f32x4 v[8];
#pragma unroll
        for (int i = 0; i < 8; ++i) v[i] = *(const f32x4*)(p + 4 * i);
        float s = 0.f;
#pragma unroll
        for (int i = 0; i < 8; ++i) { const float si = (v[i][0] + v[i][1]) + (v[i][2] + v[i][3]); s += (4 * i < n) ? si : 0.f; }
        if (smp) s += __shfl_xor(s, 16);
        if (t < 272) tab[t] = rsqrtf(s * (1.0f / 1024.0f) + 1e-6f);
    }
    asm volatile("s_waitcnt lgkmcnt(0)" ::: "memory"); __builtin_amdgcn_s_barrier(); asm volatile("" ::: "memory");
}
__device__ __forceinline__ u32x4 pack8(const f32x4 a, const f32x4 b) { u32x4 w; w.x = cvt_pk_bf16(a[0], a[1]); w.y = cvt_pk_bf16(a[2], a[3]); w.z = cvt_pk_bf16(b[0], b[1]); w.w = cvt_pk_bf16(b[2], b[3]); return w; }
typedef unsigned u32x2 __attribute__((ext_vector_type(2)));
__device__ __forceinline__ u32x2 pack4(const f32x4 a) { u32x2 w; w.x = cvt_pk_bf16(a[0], a[1]); w.y = cvt_pk_bf16(a[2], a[3]); return w; }
__device__ __forceinline__ float sumsq4(const f32x4 v) { return (v[0] * v[0] + v[1] * v[1]) + (v[2] * v[2] + v[3] * v[3]); }

struct EpiQKV {
    static constexpr bool PERM = true, AFTER_DRAIN = false, INPLACE = false, RESID = false; static constexpr int EPI_VMEM_MIN = 18;
    __device__ __forceinline__ void load_resid(const Unit&, int, int, int, int, u32x4 (&)[8][2], u32x2 (&)[2]) const {}
    bf16_t *Q, *K, *V; const float* ssp; int np, nps; float *kp, *vp, *ks, *vs;
    __device__ __forceinline__ void prefetch(const Unit& u, PG8_LAS unsigned char* lds) const {
        PG8_LAS int* lastpm = (PG8_LAS int*)(lds + RINV_TAB_OFF + 1088 + 64);
        if (*lastpm != u.pm) { unit_rinv_to_lds(lds, ssp, u.pm, np, nps); if (threadIdx.x == 0) *lastpm = u.pm; } }
    __device__ __forceinline__ void operator()(const f32x4 (&acc)[2][2][4][2], const f32x4 (&accx)[2], const Unit& u, int wr, int wc, int fr, int fq, PG8_LAS unsigned char* lds) const {
        const int rowb = u.pm * BM + wr * 64 + fr, pn = u.pn;
        { PG8_LAS int* lastpm = (PG8_LAS int*)(lds + RINV_TAB_OFF + 1088 + 64);
          if (*lastpm != u.pm) { unit_rinv_to_lds(lds, ssp, u.pm, np, nps); if (threadIdx.x == 0) *lastpm = u.pm; } }
        float rr[2][4];
        { const PG8_LAS float* tab = (const PG8_LAS float*)(lds + RINV_TAB_OFF);
#pragma unroll
          for (int ai = 0; ai < 2; ++ai)
#pragma unroll
              for (int m = 0; m < 4; ++m) rr[ai][m] = tab[ai * HALF + wr * 64 + m * 16 + fr]; }
        const float rx = ((const PG8_LAS float*)(lds + RINV_TAB_OFF))[256 + fr];
#pragma unroll
        for (int ai = 0; ai < 2; ++ai)
#pragma unroll
            for (int m = 0; m < 4; ++m) {
                const int row = rowb + ai * HALF + m * 16;
                const float r = rr[ai][m];
#pragma unroll
                for (int bj = 0; bj < 2; ++bj) {
                    const f32x4 v0 = acc[ai][bj][m][0] * r, v1 = acc[ai][bj][m][1] * r;
                    const int cl = bj * HALF + wc * 32 + 8 * fq;
                    const u32x4 w = pack8(v0, v1);
                    if (pn < 4) { *(u32x4*)((char*)Q + xb_off(row, pn * 256 + cl)) = w; }
                    else {
                        bf16_t* B = (pn == 4) ? K : V;
                        *(u32x4*)(B + (size_t)row * 256 + cl) = w;
                        const int t = row & 8191;
                        if (t >= 8064) { float* o = ((pn == 4) ? kp : vp) + ((size_t)(row >> 13) * 128 + (t - 8064)) * 256 + cl; *(f32x4*)o = v0; *(f32x4*)(o + 4) = v1; }
                    }
                }
            }
        {
            const int xrow = u.pm * 16 + fr, row = XMP + xrow;
            const float r = rx;
#pragma unroll
            for (int bj = 0; bj < 2; ++bj) {
                const f32x4 v = accx[bj] * r;
                const int cl = bj * HALF + wc * 32 + 8 * fq + 4 * wr;
                const u32x2 w = pack4(v);
                if (pn < 4) { *(u32x2*)((char*)Q + xb_off(row, pn * 256 + cl)) = w; }
                else {
                    bf16_t* B = (pn == 4) ? K : V;
                    *(u32x2*)(B + (size_t)row * 256 + cl) = w;
                    float* o = ((pn == 4) ? ks : vs) + ((size_t)(xrow >> 3) * 128 + 120 + (xrow & 7)) * 256 + cl; *(f32x4*)o = v;
                }
            }
        }
    }
};
__device__ __forceinline__ void unpack8(const u32x4 w, f32x4& a, f32x4& b) {
    a[0] = __uint_as_float(w.x << 16); a[1] = __uint_as_float(w.x & 0xffff0000u); a[2] = __uint_as_float(w.y << 16); a[3] = __uint_as_float(w.y & 0xffff0000u);
    b[0] = __uint_as_float(w.z << 16); b[1] = __uint_as_float(w.z & 0xffff0000u); b[2] = __uint_as_float(w.w << 16); b[3] = __uint_as_float(w.w & 0xffff0000u); }
__device__ __forceinline__ f32x4 unpack4(const u32x2 w) { f32x4 a; a[0] = __uint_as_float(w.x << 16); a[1] = __uint_as_float(w.x & 0xffff0000u); a[2] = __uint_as_float(w.y << 16); a[3] = __uint_as_float(w.y & 0xffff0000u); return a; }
#define XB_STORE_NT 0
#if XB_STORE_NT
__device__ __forceinline__ void XB_STORE(const u32x4 v, u32x4* p) { __builtin_nontemporal_store(v, p); }
#else
__device__ __forceinline__ void XB_STORE(const u32x4 v, u32x4* p) { *p = v; }
#endif
struct EpiRes {
    static constexpr bool PERM = true, AFTER_DRAIN = false, INPLACE = false, RESID = true; static constexpr int EPI_VMEM_MIN = 0;
    bf16_t* XB; float* ssp;
    __device__ __forceinline__ void prefetch(const Unit&, PG8_LAS unsigned char*) const {}
    __device__ __forceinline__ void load_resid(const Unit& u, int wr, int wc, int fr, int fq, u32x4 (&o)[8][2], u32x2 (&ox)[2]) const {
        const int rowb = u.pm * BM + wr * 64 + fr, colb = u.pn * 256 + wc * 32 + 8 * fq, xrow = u.pm * 16 + fr;
#pragma unroll
        for (int am = 0; am < 8; ++am)
#pragma unroll
            for (int bj = 0; bj < 2; ++bj) o[am][bj] = *(const u32x4*)((const char*)XB + xb_off(rowb + (am >> 2) * HALF + (am & 3) * 16, colb + bj * HALF));
#pragma unroll
        for (int bj = 0; bj < 2; ++bj) ox[bj] = *(const u32x2*)((const char*)XB + xb_off(XMP + xrow, colb + bj * HALF + 4 * wr));
    }
    __device__ __forceinline__ void operator()(const f32x4 (&acc)[2][2][4][2], const f32x4 (&accx)[2], const Unit& u, int wr, int wc, int fr, int fq, PG8_LAS unsigned char* lds) const {
        const int rowb = u.pm * BM + wr * 64 + fr, pn = u.pn;
        const int colb = pn * 256 + wc * 32 + 8 * fq;
        const int xrow = u.pm * 16 + fr;
#pragma unroll
        for (int am = 0; am < 8; ++am) {
            const int ai = am >> 2, m = am & 3;
            const int row = rowb + ai * HALF + m * 16;
            float ss = 0.f;
#pragma unroll
            for (int bj = 0; bj < 2; ++bj) {
                const f32x4 v0 = acc[ai][bj][m][0], v1 = acc[ai][bj][m][1];
                XB_STORE(pack8(v0, v1), (u32x4*)((char*)XB + xb_off(row, colb + bj * HALF)));
                ss += sumsq4(v0) + sumsq4(v1);
            }
            ss = xsum16(ss); ss = xsum32(ss);
            if (fq == 0) { ssp[(size_t)row * 64 + pn * 4 + wc] = ss; if (PROBE_SSP2) ssp[(size_t)(263 * 262144) + (size_t)row * 64 + pn * 4 + wc] = ss; }
        }
        {
            const int row = XMP + xrow;
            float ss = 0.f;
#pragma unroll
            for (int bj = 0; bj < 2; ++bj) {
                const f32x4 v = accx[bj];
                *(u32x2*)((char*)XB + xb_off(XMP + xrow, colb + bj * HALF + 4 * wr)) = pack4(v);
                ss += sumsq4(v);
            }
            ss = xsum16(ss); ss = xsum32(ss);
            if (fq == 0) ssp[(size_t)row * 64 + (pn * 4 + wc) * 2 + wr] = ss;
        }
    }
};
struct EpiFin {
    static constexpr bool PERM = true, AFTER_DRAIN = false, INPLACE = false, RESID = true; static constexpr int EPI_VMEM_MIN = 0;
    const bf16_t* XB; float* ssp; const float* gf; float* out; XcdBarrier bar; bool loc;
    __device__ __forceinline__ void prefetch(const Unit&, PG8_LAS unsigned char*) const {}
    __device__ __forceinline__ void load_resid(const Unit& u, int wr, int wc, int fr, int fq, u32x4 (&o)[8][2], u32x2 (&ox)[2]) const {
        const int rowb = u.pm * BM + wr * 64 + fr, colb = u.pn * 256 + wc * 32 + 8 * fq, xrow = u.pm * 16 + fr;
#pragma unroll
        for (int am = 0; am < 8; ++am)
#pragma unroll
            for (int bj = 0; bj < 2; ++bj) o[am][bj] = *(const u32x4*)((const char*)XB + xb_off(rowb + (am >> 2) * HALF + (am & 3) * 16, colb + bj * HALF));
#pragma unroll
        for (int bj = 0; bj < 2; ++bj) ox[bj] = *(const u32x2*)((const char*)XB + xb_off(XMP + xrow, colb + bj * HALF + 4 * wr));
    }
    __device__ __forceinline__ void operator()(const f32x4 (&acc)[2][2][4][2], const f32x4 (&accx)[2], const Unit& u, int wr, int wc, int fr, int fq, PG8_LAS unsigned char* lds) const {
        const int rowb = u.pm * BM + wr * 64 + fr, pn = u.pn;
        const int colb = pn * 256 + wc * 32 + 8 * fq;
        const int xrow = u.pm * 16 + fr;
#pragma unroll
        for (int am = 0; am < 8; ++am) {
            const int ai = am >> 2, m = am & 3;
            float ss = (sumsq4(acc[ai][0][m][0]) + sumsq4(acc[ai][0][m][1])) + (sumsq4(acc[ai][1][m][0]) + sumsq4(acc[ai][1][m][1]));
            ss = xsum16(ss); ss = xsum32(ss);
            if (fq == 0) ssp[(size_t)(rowb + ai * HALF + m * 16) * 64 + pn * 4 + wc] = ss;
        }
        { float ss = sumsq4(accx[0]) + sumsq4(accx[1]); ss = xsum16(ss); ss = xsum32(ss);
          if (fq == 0) ssp[(size_t)(XMP + xrow) * 64 + (pn * 4 + wc) * 2 + wr] = ss; }
        if (loc) xcd_local_barrier(bar); else xcd_barrier2(bar);
        unit_rinv_to_lds(lds, ssp, u.pm, 16, 32);
        const PG8_LAS float* tab = (const PG8_LAS float*)(lds + RINV_TAB_OFF);
        f32x4 g0[2], g1[2];
#pragma unroll
        for (int bj = 0; bj < 2; ++bj) { g0[bj] = *(const f32x4*)(gf + colb + bj * HALF); g1[bj] = *(const f32x4*)(gf + colb + bj * HALF + 4); }
#pragma unroll
        for (int am = 0; am < 8; ++am) {
            const int ai = am >> 2, m = am & 3;
            const int row = rowb + ai * HALF + m * 16;
            const float r = tab[ai * HALF + wr * 64 + m * 16 + fr];
#pragma unroll
            for (int bj = 0; bj < 2; ++bj) { float* yo = out + (size_t)row * 1024 + colb + bj * HALF; *(f32x4*)yo = acc[ai][bj][m][0] * r * g0[bj]; *(f32x4*)(yo + 4) = acc[ai][bj][m][1] * r * g1[bj]; }
        }
        {
            const float r = tab[256 + fr];
#pragma unroll
            for (int bj = 0; bj < 2; ++bj) { const f32x4 gx = *(const f32x4*)(gf + colb + bj * HALF + 4 * wr); *(f32x4*)(out + (size_t)(XMP + xrow) * 1024 + colb + bj * HALF + 4 * wr) = accx[bj] * r * gx; }
        }
    }
};
#if PROBE_S
#define PS(x) ((x) * s)
#else
#define PS(x) (x)
#endif
struct EpiGlu {
    static constexpr bool PERM = true, AFTER_DRAIN = false, INPLACE = true, RESID = false; static constexpr int EPI_VMEM_MIN = 18;
    __device__ __forceinline__ void prefetch(const Unit&, PG8_LAS unsigned char*) const {}
    __device__ __forceinline__ void load_resid(const Unit&, int, int, int, int, u32x4 (&)[8][2], u32x2 (&)[2]) const {}
    bf16_t* XB; float* ssp;
#if PROBE_S
    float s;
#endif
    __device__ __forceinline__ void operator()(const f32x4 (&acc)[2][2][4][2], const f32x4 (&accx)[2], const Unit& u, int wr, int wc, int fr, int fq, PG8_LAS unsigned char* lds) const {
        const int rowb = u.pm * BM + wr * 64 + fr, pn = u.pn;
        const int col = pn * 128 + wc * 32 + 8 * fq;
        const int xrow = u.pm * 16 + fr;
        u32x2* xbx = (u32x2*)((char*)XB + xb_off(XMP + xrow, col + 4 * wr));
        const u32x2 ox = *xbx;
#pragma unroll
        for (int am = 0; am < 8; am += 4) {
            u32x4 o[4];
#pragma unroll
            for (int h = 0; h < 4; ++h) o[h] = *(const u32x4*)((const char*)XB + xb_off(rowb + ((am + h) >> 2) * HALF + ((am + h) & 3) * 16, col));
#pragma unroll
            for (int h = 0; h < 4; ++h) {
                const int ai = (am + h) >> 2, m = (am + h) & 3;
                const int row = rowb + ai * HALF + m * 16;
                f32x4 v0, v1; unpack8(o[h], v0, v1);
#pragma unroll
                for (int e = 0; e < 4; ++e) {
                    v0[e] += PS(acc[ai][0][m][0][e] * __builtin_amdgcn_rcpf(1.0f + __expf(-acc[ai][1][m][0][e])));
                    v1[e] += PS(acc[ai][0][m][1][e] * __builtin_amdgcn_rcpf(1.0f + __expf(-acc[ai][1][m][1][e])));
                }
                XB_STORE(pack8(v0, v1), (u32x4*)((char*)XB + xb_off(row, col)));
                float ss = sumsq4(v0) + sumsq4(v1);
                ss = xsum16(ss); ss = xsum32(ss);
                if (fq == 0) ssp[(size_t)row * 64 + pn * 4 + wc] = ss;
            }
            asm volatile("" ::: "memory");
        }
        {
            const int row = XMP + xrow;
            f32x4 v = unpack4(ox);
#pragma unroll
            for (int e = 0; e < 4; ++e) v[e] += PS(accx[0][e] * __builtin_amdgcn_rcpf(1.0f + __expf(-accx[1][e])));
            *xbx = pack4(v);
            float ss = sumsq4(v);
            ss = xsum16(ss); ss = xsum32(ss);
            if (fq == 0) ssp[(size_t)row * 64 + (pn * 4 + wc) * 2 + wr] = ss;
        }
    }
};
#define H_STORE_MODE 0
#if H_STORE_MODE == 1
__device__ __forceinline__ void H_STORE(const u32x4 v, u32x4* p) { asm volatile("global_store_dwordx4 %0, %1, off sc1" :: "v"(p), "v"(v) : "memory"); }
#else
__device__ __forceinline__ void H_STORE(const u32x4 v, u32x4* p) { __builtin_nontemporal_store(v, p); }
#endif
__device__ __forceinline__ float relu0(float x) { float o; asm("v_max_f32_e32 %0, 0, %1" : "=v"(o) : "v"(x)); return o; }
struct EpiUp {
    static constexpr bool PERM = true, AFTER_DRAIN = false, INPLACE = false, RESID = false; static constexpr int EPI_VMEM_MIN = 18;
    __device__ __forceinline__ void load_resid(const Unit&, int, int, int, int, u32x4 (&)[8][2], u32x2 (&)[2]) const {}
    __device__ __forceinline__ void prefetch(const Unit& u, PG8_LAS unsigned char* lds) const {
        PG8_LAS int* lastpm = (PG8_LAS int*)(lds + RINV_TAB_OFF + 1088 + 64);
        if (*lastpm != u.pm) { unit_rinv_to_lds(lds, ssp, u.pm, np, nps); if (threadIdx.x == 0) *lastpm = u.pm; } }
    bf16_t* H; bf16_t* Hx; const float* ssp; int np, nps;
    __device__ __forceinline__ void operator()(const f32x4 (&acc)[2][2][4][2], const f32x4 (&accx)[2], const Unit& u, int wr, int wc, int fr, int fq, PG8_LAS unsigned char* lds) const {
        const int rowb = u.pm * BM + wr * 64 + fr, pn = u.pn;
        { PG8_LAS int* lastpm = (PG8_LAS int*)(lds + RINV_TAB_OFF + 1088 + 64);
          if (*lastpm != u.pm) { unit_rinv_to_lds(lds, ssp, u.pm, np, nps); if (threadIdx.x == 0) *lastpm = u.pm; } }
        float rr[2][4];
        { const PG8_LAS float* tab = (const PG8_LAS float*)(lds + RINV_TAB_OFF);
#pragma unroll
          for (int ai = 0; ai < 2; ++ai)
#pragma unroll
              for (int m = 0; m < 4; ++m) rr[ai][m] = tab[ai * HALF + wr * 64 + m * 16 + fr]; }
        const float rx = ((const PG8_LAS float*)(lds + RINV_TAB_OFF))[256 + fr];
#pragma unroll
        for (int ai = 0; ai < 2; ++ai)
#pragma unroll
            for (int m = 0; m < 4; ++m) {
                const int row = rowb + ai * HALF + m * 16;
                const float r2 = rr[ai][m] * rr[ai][m];
#pragma unroll
                for (int bj = 0; bj < 2; ++bj) {
                    f32x4 v0 = acc[ai][bj][m][0], v1 = acc[ai][bj][m][1];
#pragma unroll
                    for (int e = 0; e < 4; ++e) { v0[e] = relu0(v0[e]); v1[e] = relu0(v1[e]); }
                    v0 = (v0 * v0) * r2; v1 = (v1 * v1) * r2;
                    H_STORE(pack8(v0, v1), (u32x4*)((char*)H + (((size_t)u.pm * 64 + (4 * pn + 2 * bj + (wc >> 1))) * 2 + ai) * 16384 + lds_byte(wr * 64 + m * 16 + fr, 32 * (wc & 1) + 8 * fq)));
                }
            }
        {
            const int xrow = u.pm * 16 + fr, row = XMP + xrow;
            const float r = rx;
#pragma unroll
            for (int bj = 0; bj < 2; ++bj) {
                f32x4 v = accx[bj];
#pragma unroll
                for (int e = 0; e < 4; ++e) v[e] = relu0(v[e]);
                v = (v * v) * (r * r);
                *(u32x2*)((char*)Hx + ((size_t)u.pm * 64 + (4 * pn + 2 * bj + (wc >> 1))) * 2048 + lds_byte(fr, 32 * (wc & 1) + 8 * fq) + 8 * wr) = pack4(v);
            }
        }
    }
};

struct GemmX { const bf16_t* A; const bf16_t* Bt; const bf16_t* Ax; int K; };
template <class Epi, class Sched, int KREP = 1, int EREP = 1, int SKEW_TICKS = 0, bool ATILED = false, int KOVR = 0, bool BNT = false, int TOUCHN = 0>
__device__ __forceinline__ void gemm_phase_x(PG8_LAS unsigned char* lds, const GemmX g, const Sched& S, const Epi& E, Prof& pr, const int pc  ) {
    int tid_ = threadIdx.x; asm volatile("" : "+v"(tid_));
    const int tid = tid_, wid = __builtin_amdgcn_readfirstlane(tid >> 6), lane = tid & 63, wr = wid >> 2, wc = wid & 3, fr = lane & 15, fq = lane >> 4;
    int K_ = KOVR ? KOVR : g.K; if (KOVR) asm volatile("" : "+s"(K_));
    const int K = K_, nt = K / BK;
    unsigned voffA[2], voffB[2], voffX;
#pragma unroll
    for (int i = 0; i < 2; ++i) { int R, C; stage_rc(tid * 16 + i * 8192, R, C); const int Rb = Epi::PERM ? ((R & ~31) + perm32(R & 31)) : R;
        voffA[i] = ATILED ? (unsigned)(tid * 16 + i * 8192) : (unsigned)(R * K + C) * 2u; voffB[i] = BTILED ? (unsigned)(tid * 16 + i * 8192) : (unsigned)(Rb * K + C) * 2u; }
    { int R, C; const int p = wid * 256 + lane * 4; stage_rc(p & ~15, R, C); voffX = ATILED ? (unsigned)p : (unsigned)(R * K + C) * 2u + (unsigned)(p & 15); }
    const size_t kstepB = BTILED ? (size_t)32768 : (size_t)(BK * 2), hstepB = BTILED ? (size_t)16384 : (size_t)HALF * K * 2, tstepB = BTILED ? (size_t)nt * 32768 : 2 * hstepB;
    const size_t kstepA = ATILED ? (size_t)32768 : (size_t)(BK * 2), hstepA = ATILED ? (size_t)16384 : (size_t)HALF * K * 2, tstepA = ATILED ? (size_t)nt * 32768 : (size_t)2 * HALF * K * 2;
    const size_t kstepX = ATILED ? (size_t)2048 : (size_t)(BK * 2), xstep = ATILED ? (size_t)nt * 2048 : (size_t)16 * K * 2;
    const unsigned ldsw = (unsigned)wid * 1024u, ldsx = (unsigned)wid * 256u;
    const int aoff = lds_byte(wr * 64 + fr, fq * 8), boff = lds_byte(wc * 32 + fr, fq * 8), xoff = lds_byte(fr, fq * 8);
#define PG8_SA(b, h) (((b) * 2 + (h)) * HTB)
#define PG8_SB(b, h) ((4 + (b) * 2 + (h)) * HTB)
#define PG8_XA(b) (STAGE_BYTES + (b) * 2048)
#define PG8_STAGE(bufoff, gbase, voff) do { _Pragma("unroll") for (int _i = 0; _i < 2; ++_i) \
        __builtin_amdgcn_global_load_lds((const unsigned*)((const char*)(gbase) + (voff)[_i]), (PG8_LAS unsigned*)(lds + (bufoff) + ldsw + _i * 8192), 16, 0, 0); } while (0)
#define PG8_STAGEB(bufoff, gbase, voff) do { _Pragma("unroll") for (int _i = 0; _i < 2; ++_i) \
        __builtin_amdgcn_global_load_lds((const unsigned*)((const char*)(gbase) + (voff)[_i]), (PG8_LAS unsigned*)(lds + (bufoff) + ldsw + _i * 8192), 16, 0, BNT ? 2 : 0); } while (0)
#define PG8_STAGEX(b, gbase) __builtin_amdgcn_global_load_lds((const unsigned*)((const char*)(gbase) + voffX), (PG8_LAS unsigned*)(lds + PG8_XA(b) + ldsx), 4, 0, 0)
#define PG8_LDA(dst, b, h) do { _Pragma("unroll") for (int m = 0; m < 4; ++m) _Pragma("unroll") for (int k = 0; k < 2; ++k) dst[m][k] = *(const PG8_LAS bf16x8*)(lds + PG8_SA(b, h) + aoff + m * 2048 + k * 1024); } while (0)
#define PG8_LDB(dst, b, h) do { _Pragma("unroll") for (int n = 0; n < 2; ++n) _Pragma("unroll") for (int k = 0; k < 2; ++k) dst[n][k] = *(const PG8_LAS bf16x8*)(lds + PG8_SB(b, h) + boff + n * 2048 + k * 1024); } while (0)
#define PG8_LDX(dst, b) do { _Pragma("unroll") for (int k = 0; k < 2; ++k) dst[k] = *(const PG8_LAS bf16x8*)(lds + PG8_XA(b) + xoff + k * 1024); } while (0)
#define PG8_MMA(ai, bj, At, Bt) do { __builtin_amdgcn_s_setprio(1); _Pragma("unroll") for (int m = 0; m < 4; ++m) _Pragma("unroll") for (int n = 0; n < 2; ++n) _Pragma("unroll") for (int k = 0; k < 2; ++k) \
        acc[ai][bj][m][n] = __builtin_amdgcn_mfma_f32_16x16x32_bf16(Bt[n][k], At[m][k], acc[ai][bj][m][n], 0, 0, 0); __builtin_amdgcn_s_setprio(0); } while (0)
#define PG8_XMMA() do { if (wr == 0) { _Pragma("unroll") for (int k = 0; k < 2; ++k) { accx[0] = __builtin_amdgcn_mfma_f32_16x16x32_bf16(B0[0][k], Ax[k], accx[0], 0, 0, 0); accx[1] = __builtin_amdgcn_mfma_f32_16x16x32_bf16(B1[0][k], Ax[k], accx[1], 0, 0, 0); } } \
        else { _Pragma("unroll") for (int k = 0; k < 2; ++k) { accx[0] = __builtin_amdgcn_mfma_f32_16x16x32_bf16(B0[1][k], Ax[k], accx[0], 0, 0, 0); accx[1] = __builtin_amdgcn_mfma_f32_16x16x32_bf16(B1[1][k], Ax[k], accx[1], 0, 0, 0); } } } while (0)
#define PG8_WAIT_V(n) asm volatile("s_waitcnt vmcnt(" #n ")" ::: "memory")
#define PG8_WAIT_VR(rx) do { if (Epi::EPI_VMEM_MIN >= 18) asm volatile("s_cmp_lg_u32 %0, 0\n\ts_cbranch_scc1 LRX_%=\n\ts_waitcnt vmcnt(9)\nLRX_%=:\n\ts_waitcnt vmcnt(27)" :: "s"(rx) : "memory", "scc"); else asm volatile("s_waitcnt vmcnt(9)" ::: "memory"); } while (0)
#define PG8_WAIT_L(n) asm volatile("s_waitcnt lgkmcnt(" #n ")" ::: "memory")
#define PG8_BAR __builtin_amdgcn_s_barrier()
#define PG8_SCHED __builtin_amdgcn_sched_barrier(0)
    Unit cur, nxt; int ui = 0;
    if (!S.next(0, cur)) return;
    if (SKEW_TICKS > 0) { const unsigned long long t0 = __builtin_amdgcn_s_memrealtime(); const unsigned idx_ = blockIdx.x >> 3;
        const unsigned long long dl = (unsigned long long)SKEW_TICKS * (unsigned)(idx_ & 31u);
        while (__builtin_amdgcn_s_memrealtime() - t0 < dl) __builtin_amdgcn_s_sleep(8); }
    f32x4 acc[2][2][4][2]; f32x4 accx[2];
#define PG8_ACC_ZERO() do { _Pragma("unroll") for (int a = 0; a < 2; ++a) _Pragma("unroll") for (int b = 0; b < 2; ++b) _Pragma("unroll") for (int m = 0; m < 4; ++m) _Pragma("unroll") for (int n = 0; n < 2; ++n) \
        acc[a][b][m][n] = (f32x4){0.f, 0.f, 0.f, 0.f}; accx[0] = (f32x4){0.f, 0.f, 0.f, 0.f}; accx[1] = (f32x4){0.f, 0.f, 0.f, 0.f}; } while (0)
#define PG8_ACC_RESID() do { _Pragma("unroll") for (int am = 0; am < 8; ++am) _Pragma("unroll") for (int b = 0; b < 2; ++b) unpack8(ro[am][b], acc[am >> 2][b][am & 3][0], acc[am >> 2][b][am & 3][1]); \
        accx[0] = unpack4(rox[0]); accx[1] = unpack4(rox[1]); } while (0)
    u32x4 ro[8][2]; u32x2 rox[2];
    if (Epi::RESID) { int fr_ = fr, fq_ = fq; asm volatile("" : "+v"(fr_), "+v"(fq_)); E.load_resid(cur, wr, wc, fr_, fq_, ro, rox); }
    bf16x8 At[4][2], B0[2][2], B1[2][2], Ax[2];
    const char* const xbase = ATILED ? (const char*)g.Ax : (const char*)g.A + (size_t)XMP * K * 2;
    const char* cA = (const char*)g.A + (size_t)cur.pm * tstepA; const char* cB = (const char*)g.Bt + (size_t)cur.pn * tstepB; const char* cX = xbase + (size_t)cur.pm * xstep;
    S.a_ready(cur);
    PG8_STAGEB(PG8_SB(0, 0), cB, voffB); PG8_STAGEB(PG8_SB(0, 1), cB + hstepB, voffB); PG8_STAGE(PG8_SA(0, 0), cA, voffA); PG8_STAGEX(0, cX); PG8_STAGE(PG8_SA(0, 1), cA + hstepA, voffA);
    if (wr == 1) PG8_BAR;
    PG8_WAIT_V(2); PG8_BAR;
    PG8_STAGEB(PG8_SB(1, 0), cB + kstepB, voffB); PG8_STAGE(PG8_SA(1, 0), cA + kstepA, voffA); PG8_STAGEB(PG8_SB(1, 1), cB + hstepB + kstepB, voffB); PG8_STAGEX(1, cX + kstepX);
    PG8_WAIT_V(7); PG8_BAR;
    if (Epi::RESID) PG8_ACC_RESID(); else PG8_ACC_ZERO();
    PMARK(pr, pc);
    for (;;) {
        const bool has_next = S.next(ui + 1, nxt);
        const char* nA = has_next ? (const char*)g.A + (size_t)nxt.pm * tstepA : cA; const char* nB = has_next ? (const char*)g.Bt + (size_t)nxt.pn * tstepB : cB; const char* nX = has_next ? xbase + (size_t)nxt.pm * xstep : cX;
        for (int kr = 0; kr < KREP; ++kr) {
        const bool fin = (kr == KREP - 1);
        if (KREP > 1 && kr > 0) {
#pragma unroll
            for (int a = 0; a < 2; ++a)
#pragma unroll
                for (int b = 0; b < 2; ++b)
#pragma unroll
                    for (int m = 0; m < 4; ++m)
#pragma unroll
                        for (int n = 0; n < 2; ++n) acc[a][b][m][n] = (f32x4){0.f, 0.f, 0.f, 0.f};
            accx[0] = (f32x4){0.f, 0.f, 0.f, 0.f}; accx[1] = (f32x4){0.f, 0.f, 0.f, 0.f};
        }
        for (int t = 0; t < nt; t += 2) {
            const bool last = (t == nt - 2);
            const int relax = __builtin_amdgcn_readfirstlane(((t == 0) && (ui > 0) && (kr == 0)) ? 1 : 0);
            if (PROBE_HALF && pc && t == nt / 2) PMARK(pr, 13);
            const char* a1 = cA + (size_t)(t + 1) * kstepA;
            const char* a2 = last ? (fin ? nA : cA) : cA + (size_t)(t + 2) * kstepA; const char* rB = (KREP_FOREIGN_B && KREP > 1 && !fin) ? cB + KREP_FOREIGN_B : cB;
            const char* b2 = last ? (fin ? nB : cB) : rB + (size_t)(t + 2) * kstepB; const char* x2 = last ? (fin ? nX : cX) : cX + (size_t)(t + 2) * kstepX;
            const char* a3 = a2 + kstepA; const char* b3 = b2 + kstepB; const char* x3 = x2 + kstepX;
            if (last && has_next && fin) S.a_ready(nxt);
            PG8_LDB(B0, 0, 0); PG8_LDB(B1, 0, 1); PG8_SCHED; PG8_LDA(At, 0, 0); PG8_LDX(Ax, 0); PG8_STAGE(PG8_SA(1, 1), a1 + hstepA, voffA);
            PG8_WAIT_VR(relax); PG8_WAIT_L(0); PG8_BAR; PG8_MMA(0, 0, At, B0); PG8_MMA(0, 1, At, B1); PG8_XMMA(); PG8_BAR; PG8_SCHED;
            PG8_LDA(At, 0, 1); PG8_STAGEB(PG8_SB(0, 0), b2, voffB); PG8_STAGEB(PG8_SB(0, 1), b2 + hstepB, voffB); PG8_STAGE(PG8_SA(0, 0), a2, voffA); PG8_STAGEX(0, x2);
            PG8_WAIT_VR(relax); PG8_WAIT_L(0); PG8_BAR; PG8_MMA(1, 0, At, B0); PG8_MMA(1, 1, At, B1); PG8_BAR; PG8_SCHED;
            PG8_LDB(B0, 1, 0); PG8_LDB(B1, 1, 1); PG8_SCHED; PG8_LDA(At, 1, 0); PG8_LDX(Ax, 1); PG8_STAGE(PG8_SA(0, 1), a2 + hstepA, voffA);
            PG8_WAIT_V(9); PG8_WAIT_L(0); PG8_BAR; PG8_MMA(0, 0, At, B0); PG8_MMA(0, 1, At, B1); PG8_XMMA(); PG8_BAR; PG8_SCHED;
            PG8_LDA(At, 1, 1); PG8_STAGEB(PG8_SB(1, 0), b3, voffB); PG8_STAGEB(PG8_SB(1, 1), b3 + hstepB, voffB); PG8_STAGE(PG8_SA(1, 0), a3, voffA); PG8_STAGEX(1, x3);
            PG8_WAIT_V(9); PG8_WAIT_L(0); PG8_BAR; PG8_MMA(1, 0, At, B0); PG8_MMA(1, 1, At, B1); PG8_BAR; PG8_SCHED;
        }
        if (KREP > 1 && !fin) PMARK(pr, pc ? 13 : 0);
        }
        if (wr == 0) PG8_BAR;
        PMARK(pr, pc ? pc + 1 : 0);
        { int fr_ = fr, fq_ = fq; asm volatile("" : "+v"(fr_), "+v"(fq_));
          unsigned tv_[(TOUCHN > 0) ? TOUCHN : 1] = {0u};
          if (TOUCHN > 0 && has_next) {
              int tt_ = tid; asm volatile("" : "+v"(tt_));
              const int row_ = tt_ & 255, tsel_ = tt_ >> 8;
#pragma unroll
              for (int i_ = 0; i_ < TOUCHN; ++i_) {
                  const int kt_ = 2 + i_;
                  const char* p_ = tsel_ ? (BTILED ? nB + (size_t)kt_ * kstepB + (size_t)row_ * 128 : nB + (size_t)kt_ * kstepB + (size_t)row_ * K * 2)
                                         : (ATILED ? nA + (size_t)kt_ * kstepA + (size_t)row_ * 128 : nA + (size_t)kt_ * kstepA + (size_t)row_ * K * 2);
                  tv_[i_] = *(const volatile unsigned*)p_;
              }
          }
          for (int er = 0; er < EREP; ++er) { E(acc, accx, cur, wr, wc, fr_, fq_, lds);
              if (EREP > 1 && Epi::INPLACE) {
#pragma unroll
                  for (int a = 0; a < 2; ++a)
#pragma unroll
                      for (int b = 0; b < 2; ++b)
#pragma unroll
                          for (int m = 0; m < 4; ++m)
#pragma unroll
                              for (int n = 0; n < 2; ++n) acc[a][b][m][n] = (f32x4){0.f, 0.f, 0.f, 0.f};
                  accx[0] = (f32x4){0.f, 0.f, 0.f, 0.f}; accx[1] = (f32x4){0.f, 0.f, 0.f, 0.f}; } }
          if (TOUCHN > 0) {
#pragma unroll
              for (int i_ = 0; i_ < TOUCHN; ++i_) asm volatile("" :: "v"(tv_[i_]));
          } } S.done(cur);
        PMARK(pr, pc ? pc + 2 : 0);
        if (!has_next) break;
        cur = nxt; cA = nA; cB = nB; cX = nX; ++ui;
        if (Epi::RESID) { int fr_ = fr, fq_ = fq; asm volatile("" : "+v"(fr_), "+v"(fq_)); E.load_resid(cur, wr, wc, fr_, fq_, ro, rox); PG8_ACC_RESID(); }
        else PG8_ACC_ZERO();
        if (wr == 1) PG8_BAR;
    }
    PG8_WAIT_V(0);
    PG8_BAR;
#undef PG8_ACC_ZERO
#undef PG8_ACC_RESID
#undef PG8_SA
#undef PG8_SB
#undef PG8_XA
#undef PG8_STAGE
#undef PG8_STAGEB
#undef PG8_STAGEX
#undef PG8_LDA
#undef PG8_LDB
#undef PG8_LDX
#undef PG8_MMA
#undef PG8_XMMA
#undef PG8_WAIT_V
#undef PG8_WAIT_VR
#undef PG8_WAIT_L
#undef PG8_BAR
#undef PG8_SCHED
}
}

__device__ __forceinline__ void p0_transpose_item(const float* W, int K, int N, const float* gain, bf16* WT, int glu, LAS float* scr, int item, int lane) {
    const int nblk = N / 64, kb = item / nblk, nb = item % nblk, k0 = 64 * kb, n0 = 64 * nb;
    const int q = lane & 15, kr = lane >> 4;
    f32x4 v[16];
#pragma unroll
    for (int i = 0; i < 16; ++i) v[i] = *(const f32x4*)(W + (size_t)(k0 + 4 * i + kr) * N + n0 + 4 * q);
    if (gain) {
#pragma unroll
        for (int i = 0; i < 16; ++i) v[i] = v[i] * gain[k0 + 4 * i + kr];
    }
#pragma unroll
    for (int i = 0; i < 16; ++i) { LAS float* d = scr + (4 * i + kr) * 65 + 4 * q; d[0] = v[i][0]; d[1] = v[i][1]; d[2] = v[i][2]; d[3] = v[i][3]; }
    LDS_WAIT(); asm volatile("" ::: "memory");
    int drow0 = n0; if (glu) { const int bj = n0 / 1024, rem = n0 % 1024; drow0 = (rem / 128) * 256 + bj * 128 + (rem % 128); }
    const int c = lane & 7;
#pragma unroll
    for (int j = 0; j < 8; ++j) { const int n = (lane >> 3) + 8 * j; const LAS float* sp = scr + (8 * c) * 65 + n;
        v4u o; o.x = pk2(sp[0 * 65], sp[1 * 65]); o.y = pk2(sp[2 * 65], sp[3 * 65]); o.z = pk2(sp[4 * 65], sp[5 * 65]); o.w = pk2(sp[6 * 65], sp[7 * 65]);
        if (pg8::BTILED) { const int ng = drow0 + n, nl = ng & 127, kk = k0 + 8 * c;
            const size_t off = ((size_t)((ng >> 8) * (K / 64) + (kk >> 6)) * 2 + ((ng >> 7) & 1)) * 16384 + pg8::lds_byte((nl & ~31) + pg8::invperm32(nl & 31), kk & 63);
            *(GAS v4u*)((char*)WT + off) = o; }
        else *(GAS v4u*)(WT + (size_t)(drow0 + n) * K + k0 + 8 * c) = o; }
    LDS_WAIT(); asm volatile("" ::: "memory");
}

__device__ __forceinline__ void sincos_rr(float x, float& s, float& c) {
    const float q = rintf(x * 0.63661977236758f);
    float r = fmaf(-q, 1.57079637050629f, x); r = fmaf(-q, -4.37113882867379e-8f, r);
    const float r2 = r * r;
    const float sp = r + r * r2 * (-1.6666667163e-1f + r2 * (8.3333337680e-3f + r2 * (-1.9841270114e-4f + r2 * 2.7557314297e-6f)));
    const float cp = 1.0f + r2 * (-0.5f + r2 * (4.1666667908e-2f + r2 * (-1.3888889225e-3f + r2 * (2.4801587642e-5f + r2 * -2.7557314297e-7f))));
    const int qi = (int)q & 3;
    s = (qi == 0) ? sp : (qi == 1) ? cp : (qi == 2) ? -sp : -cp;
    c = (qi == 0) ? cp : (qi == 1) ? -sp : (qi == 2) ? -cp : sp;
}

typedef float f32x16 __attribute__((ext_vector_type(16)));
typedef float f32x2_t __attribute__((ext_vector_type(2))); typedef __bf16 bf16x2_t __attribute__((ext_vector_type(2)));
__device__ __forceinline__ unsigned cvtpk_c(float lo, float hi) { f32x2_t v = {lo, hi}; bf16x2_t b = __builtin_convertvector(v, bf16x2_t); return __builtin_bit_cast(unsigned, b); }
typedef unsigned u32x2 __attribute__((ext_vector_type(2)));
__device__ __forceinline__ void ssm_abar_calc(const float* A_re, const float* A_im, const float* log_dt, int g, int n, float& abr, float& abi, float& cfr, float& cfi) {
    const float dt = expf(log_dt[g]);
    const float ar = A_re[g * 64 + n], ai = A_im[g * 64 + n];
    const float mag = expf(dt * ar); float sn, cs; sincos_rr(dt * ai, sn, cs);
    abr = mag * cs; abi = mag * sn;
    const float den = ar * ar + ai * ai, nr = abr - 1.0f;
    cfr = (nr * ar + abi * ai) / den; cfi = (abi * ar - nr * ai) / den;
}
__device__ __forceinline__ float gelu_tanh(float y) {
    constexpr float C1 = -2.0f * 0.7978845608028654f * 1.4426950408889634f, C3 = C1 * 0.044715f;
    return y * __builtin_amdgcn_rcpf(1.0f + __builtin_amdgcn_exp2f(y * fmaf(y * y, C3, C1)));
}
__device__ __forceinline__ void wg_rinv(LAS float* tab, const float* ssp, int rowL, int rowH, bool sample, int tid) {
    __syncthreads();
    const int row = sample ? (tid >> 1) : tid, hf = sample ? (tid & 1) : 0;
    if (!sample || row < 32) {
        const int grow = sample ? ((row < 16) ? rowL + row : rowH + row - 16) : ((row < 256) ? rowL + row : rowH + row - 256);
        const float* p = ssp + (size_t)grow * 64 + 16 * hf;
        f32x4 v[4];
#pragma unroll
        for (int i = 0; i < 4; ++i) v[i] = *(const f32x4*)(p + 4 * i);
        float s_ = (((v[0][0] + v[0][1]) + (v[0][2] + v[0][3])) + ((v[1][0] + v[1][1]) + (v[1][2] + v[1][3]))) + (((v[2][0] + v[2][1]) + (v[2][2] + v[2][3])) + ((v[3][0] + v[3][1]) + (v[3][2] + v[3][3])));
        if (sample) s_ += __shfl_xor(s_, 1);
        if (hf == 0) tab[row] = rsqrtf(s_ * (1.0f / 1024.0f) + 1e-6f);
    }
    __syncthreads();
}
struct SsmT { const bf16* BT; const bf16* CT; const float* tab; const float* Dk; const float* gain; };
template <int MODE>
__device__ __forceinline__ void ssm_mfma_unit(LAS unsigned char* wl, int lane, int g, const SsmT& T, const bf16* XB, LAS float* rv  , const float* ssp, int tid, int rowL, int rowH, int nblk,
                                              float (&st)[4]  , bf16* Gout, const float* h0r, const float* h0i, float* hor, float* hoi  , int b0L, int b0H  ) {
    const int r32 = lane & 31, hi5 = lane >> 5, c16 = lane & 15, kq = lane >> 4;
    const int aseq = (r32 >> 2) & 1, atok = 4 * (r32 >> 3) + (r32 & 3);
    const int arow = (aseq ? rowH : rowL) + atok;
    pg8::bf16x8 bt[4], ct[4];
#pragma unroll
    for (int tn = 0; tn < 4; ++tn) bt[tn] = *(const pg8::bf16x8*)(T.BT + (size_t)(tn * 32 + r32) * 16 + 8 * hi5);
    if (MODE != 0) {
#pragma unroll
        for (int ks = 0; ks < 4; ++ks) ct[ks] = *(const pg8::bf16x8*)(T.CT + (size_t)c16 * 128 + 32 * ks + 8 * kq);
    }
    float ar[2], ai[2];
    { const f32x4 t0 = *(const f32x4*)(T.tab + (size_t)r32 * 4), t1 = *(const f32x4*)(T.tab + (size_t)(32 + r32) * 4); ar[0] = t0[0]; ai[0] = t0[1]; ar[1] = t1[0]; ai[1] = t1[1]; }
    f32x4 Dg = {0.f, 0.f, 0.f, 0.f};
    if (MODE != 0) { const f32x4 dv = *(const f32x4*)(T.Dk + 4 * kq), gv = *(const f32x4*)(T.gain + 4 * kq); Dg = dv * gv; }
    float pwr[2][16], pwi[2][16], a16r[2], a16i[2];
    if (MODE == 0) {
#pragma unroll
        for (int p = 0; p < 2; ++p) {
            float cr = 1.0f, ci = 0.0f;
#pragma unroll
            for (int r = 15; r >= 0; --r) { pwr[p][r] = cr; pwi[p][r] = ci; const float tr = cr * ar[p] - ci * ai[p], ti = cr * ai[p] + ci * ar[p]; cr = tr; ci = ti; }
            a16r[p] = cr; a16i[p] = ci;
        }
    }
    pg8::bf16x8 xa_all[4];
#pragma unroll
    for (int k = 0; k < 4; ++k) if (k < nblk) xa_all[k] = *(const pg8::bf16x8*)((const char*)XB + pg8::xb_off(arow + 16 * k, g * 16 + 8 * hi5));
    float h0v[2][2][2];
    if (MODE == 2) {
#pragma unroll
        for (int w = 0; w < 2; ++w)
#pragma unroll
            for (int p = 0; p < 2; ++p) { const size_t hidx = ((size_t)((hi5 ? b0H : b0L) + w) * 64 + g) * 64 + 32 * p + r32; h0v[w][p][0] = h0r[hidx]; h0v[w][p][1] = h0i[hidx]; }
    }
    wg_rinv(rv, ssp, rowL, rowH, MODE == 2, tid);
    for (int blk = 0; blk < nblk; ++blk) {
        const pg8::bf16x8 xa = xa_all[0];
        if (MODE != 2) {
#pragma unroll
            for (int k = 0; k < 3; ++k) xa_all[k] = xa_all[k + 1];
            if (blk + 4 < nblk) xa_all[3] = *(const pg8::bf16x8*)((const char*)XB + pg8::xb_off(arow + 16 * (blk + 4), g * 16 + 8 * hi5));
        }
        if (MODE != 0) *(LAS pg8::bf16x8*)(wl + 8704 + r32 * 32 + hi5 * 16) = xa;
        const LAS float* rvb = rv + ((MODE == 2) ? 0 : 16 * blk);
        pg8::bf16x8 xs_;
        { const float rin = rvb[((MODE == 2) ? 16 : 256) * aseq + atok]; const v4u xw = __builtin_bit_cast(v4u, xa); v4u ow;
          ow.x = cvtpk_c(bf_lo(xw.x) * rin, bf_hi(xw.x) * rin); ow.y = cvtpk_c(bf_lo(xw.y) * rin, bf_hi(xw.y) * rin);
          ow.z = cvtpk_c(bf_lo(xw.z) * rin, bf_hi(xw.z) * rin); ow.w = cvtpk_c(bf_lo(xw.w) * rin, bf_hi(xw.w) * rin); xs_ = __builtin_bit_cast(pg8::bf16x8, ow); }
        f32x16 IN[4];
#pragma unroll
        for (int tn = 0; tn < 4; ++tn) { const f32x16 z = {0.f, 0.f, 0.f, 0.f, 0.f, 0.f, 0.f, 0.f, 0.f, 0.f, 0.f, 0.f, 0.f, 0.f, 0.f, 0.f}; IN[tn] = __builtin_amdgcn_mfma_f32_32x32x16_bf16(xs_, bt[tn], z, 0, 0, 0); }
        if (MODE == 0) {
#pragma unroll
            for (int p = 0; p < 2; ++p) {
                float er[2] = {0.f, 0.f}, ei[2] = {0.f, 0.f};
#pragma unroll
                for (int r = 0; r < 16; ++r) {
                    const float xr_ = IN[2 * p][r], xi_ = IN[2 * p + 1][r], wr_ = pwr[p][r], wi_ = pwi[p][r];
                    float t = fmaf(wr_, xr_, er[r & 1]); asm volatile("" : "+v"(t)); t = fmaf(-wi_, xi_, t); asm volatile("" : "+v"(t)); er[r & 1] = t;
                    float u = fmaf(wr_, xi_, ei[r & 1]); asm volatile("" : "+v"(u)); u = fmaf(wi_, xr_, u); asm volatile("" : "+v"(u)); ei[r & 1] = u;
                }
                float e_r = er[0] + er[1], e_i = ei[0] + ei[1];
                asm volatile("" : "+v"(e_r), "+v"(e_i));
                const float sr = st[2 * p], si = st[2 * p + 1];
                float nr = fmaf(a16r[p], sr, e_r); asm volatile("" : "+v"(nr)); nr = fmaf(-a16i[p], si, nr); asm volatile("" : "+v"(nr));
                float ni = fmaf(a16r[p], si, e_i); asm volatile("" : "+v"(ni)); ni = fmaf(a16i[p], sr, ni); asm volatile("" : "+v"(ni));
                st[2 * p] = nr; st[2 * p + 1] = ni;
            }
        } else {
            float cr[2] = {st[0], st[2]}, ci[2] = {st[1], st[3]};
#pragma unroll
            for (int r = 0; r < 16; ++r) {
                if (MODE == 2 && (r & 7) == 0) {
#pragma unroll
                    for (int p = 0; p < 2; ++p) { cr[p] = h0v[r >> 3][p][0]; ci[p] = h0v[r >> 3][p][1]; } }
                float tr0 = fmaf(ar[0], cr[0], IN[0][r]); asm volatile("" : "+v"(tr0)); float tr1 = fmaf(ar[1], cr[1], IN[2][r]); asm volatile("" : "+v"(tr1));
                float ti0 = fmaf(ar[0], ci[0], IN[1][r]); asm volatile("" : "+v"(ti0)); float ti1 = fmaf(ar[1], ci[1], IN[3][r]); asm volatile("" : "+v"(ti1));
                tr0 = fmaf(-ai[0], ci[0], tr0); asm volatile("" : "+v"(tr0)); tr1 = fmaf(-ai[1], ci[1], tr1); asm volatile("" : "+v"(tr1));
                ti0 = fmaf(ai[0], cr[0], ti0); asm volatile("" : "+v"(ti0)); ti1 = fmaf(ai[1], cr[1], ti1); asm volatile("" : "+v"(ti1));
                cr[0] = tr0; cr[1] = tr1; ci[0] = ti0; ci[1] = ti1; IN[0][r] = tr0; IN[2][r] = tr1; IN[1][r] = ti0; IN[3][r] = ti1;
                if (MODE == 2 && (r & 7) == 7) {
#pragma unroll
                    for (int p = 0; p < 2; ++p) { const size_t hidx = ((size_t)((hi5 ? b0H : b0L) + (r >> 3)) * 64 + g) * 64 + 32 * p + r32; hor[hidx] = cr[p]; hoi[hidx] = ci[p]; } }
            }
            st[0] = cr[0]; st[1] = ci[0]; st[2] = cr[1]; st[3] = ci[1];
#pragma unroll
            for (int r = 0; r < 16; ++r) { pg8::u32x2 hw2; hw2.x = pg8::cvt_pk_bf16(IN[0][r], IN[1][r]); hw2.y = pg8::cvt_pk_bf16(IN[2][r], IN[3][r]);
                *(LAS pg8::u32x2*)(wl + (16 * hi5 + r) * 272 + 8 * r32) = hw2; }
            LDS_WAIT(); asm volatile("" ::: "memory");
#pragma unroll
            for (int tt = 0; tt < 2; ++tt) {
                f32x4 y = {0.f, 0.f, 0.f, 0.f};
#pragma unroll
                for (int ks = 0; ks < 4; ++ks) { const pg8::bf16x8 hf = *(const LAS pg8::bf16x8*)(wl + (16 * tt + c16) * 272 + (32 * ks + 8 * kq) * 2); y = __builtin_amdgcn_mfma_f32_16x16x32_bf16(ct[ks], hf, y, 0, 0, 0); }
                const int token = (tt ? rowH : rowL) + 16 * blk + c16;
                const float rinv = rvb[((MODE == 2) ? 16 : 256) * tt + c16];
                const int xrow = 8 * (c16 >> 2) + 4 * tt + (c16 & 3);
                const f32x4 xv = pg8::unpack4(*(const LAS u32x2*)(wl + 8704 + xrow * 32 + kq * 8));
                f32x4 o;
#pragma unroll
                for (int e = 0; e < 4; ++e) o[e] = gelu_tanh(y[e] + Dg[e] * (xv[e] * rinv));
                *(u32x2*)(Gout + (size_t)token * 1024 + g * 16 + 4 * kq) = pg8::pack4(o);
            }
        }
        LDS_WAIT(); asm volatile("" ::: "memory");
    }
}

__device__ __forceinline__ void attn_task(const LAS unsigned char* Kl, const LAS unsigned char* Vl, LAS unsigned char* stg  , const pg8::bf16x8 (&qf)[4]  , bf16* Ob, const float* sinks, int head, int tloc, int kb0, int jkmin, int lane, bool samp, int orow0, int ohead0) {
    const int r32 = lane & 31, hi5 = lane >> 5;
    const float slope2 = exp2f(-0.5f * (float)(head + 1)) * 1.4426950408889634f, sink2 = sinks[head] * 1.4426950408889634f;
    f32x16 S[5];
    __builtin_amdgcn_s_setprio(1);
#pragma unroll
    for (int i = 0; i < 5; ++i) {
        f32x16 acc = {0.f, 0.f, 0.f, 0.f, 0.f, 0.f, 0.f, 0.f, 0.f, 0.f, 0.f, 0.f, 0.f, 0.f, 0.f, 0.f};
#pragma unroll
        for (int ks = 0; ks < 4; ++ks) { const pg8::bf16x8 kf = *(const LAS pg8::bf16x8*)(Kl + (32 * (kb0 + i) + r32) * 144 + 32 * ks + 16 * hi5); acc = __builtin_amdgcn_mfma_f32_32x32x16_bf16(kf, qf[ks], acc, 0, 0, 0); }
        S[i] = acc;
    }
    __builtin_amdgcn_s_setprio(0);
    float mx = sink2;
    const int dlim = (tloc + 128 - jkmin < 128) ? (tloc + 128 - jkmin) : 128;
    f32x16 so16;
#pragma unroll
    for (int r = 0; r < 16; ++r) so16[r] = slope2 * (float)((r & 3) + 8 * (r >> 2));
    const f32x16 c1v = {0.18033688011112042f, 0.18033688011112042f, 0.18033688011112042f, 0.18033688011112042f, 0.18033688011112042f, 0.18033688011112042f, 0.18033688011112042f, 0.18033688011112042f,
                        0.18033688011112042f, 0.18033688011112042f, 0.18033688011112042f, 0.18033688011112042f, 0.18033688011112042f, 0.18033688011112042f, 0.18033688011112042f, 0.18033688011112042f};
#pragma unroll
    for (int i = 0; i < 5; ++i) {
        const int base = tloc + 128 - 32 * (kb0 + i) - 4 * hi5;
        const float nb = -slope2 * (float)base;
        const bool edge = (i == 0) || (i == 4);
        const bool binv = !edge && (32 * (kb0 + i) < jkmin);
        const float nbe = binv ? -1e30f : nb, c1e = binv ? 0.0f : 0.18033688011112042f;
        f32x16 sv = __builtin_elementwise_fma(S[i], c1v * (c1e * (1.0f / 0.18033688011112042f)), so16 + nbe);
#pragma unroll
        for (int r = 0; r < 16; ++r) {
            if (edge) { const unsigned d = (unsigned)(base - ((r & 3) + 8 * (r >> 2))); sv[r] = (d <= (unsigned)dlim) ? sv[r] : -1e30f; }
            mx = fmaxf(mx, sv[r]);
        }
        S[i] = sv;
    }
    mx = xmax32(mx);
    f32x16 ls16 = {0.f, 0.f, 0.f, 0.f, 0.f, 0.f, 0.f, 0.f, 0.f, 0.f, 0.f, 0.f, 0.f, 0.f, 0.f, 0.f};
    const float nmx = -mx; const f32x16 nmx16 = {nmx, nmx, nmx, nmx, nmx, nmx, nmx, nmx, nmx, nmx, nmx, nmx, nmx, nmx, nmx, nmx};
#pragma unroll
    for (int i = 0; i < 5; ++i) {
        f32x16 t = S[i] + nmx16;
#pragma unroll
        for (int r = 0; r < 16; ++r) t[r] = __builtin_amdgcn_exp2f(t[r]);
        S[i] = t; ls16 += t;
    }
    float lsum = ((ls16[0] + ls16[1]) + (ls16[2] + ls16[3])) + ((ls16[4] + ls16[5]) + (ls16[6] + ls16[7])) + (((ls16[8] + ls16[9]) + (ls16[10] + ls16[11])) + ((ls16[12] + ls16[13]) + (ls16[14] + ls16[15])));
    lsum = xsum32(lsum); lsum += __builtin_amdgcn_exp2f(sink2 - mx);
    const float inv = __builtin_amdgcn_rcpf(lsum);
    f32x16 O0 = {0.f, 0.f, 0.f, 0.f, 0.f, 0.f, 0.f, 0.f, 0.f, 0.f, 0.f, 0.f, 0.f, 0.f, 0.f, 0.f}, O1 = O0;
    __builtin_amdgcn_s_setprio(1);
    const LAS unsigned char* vbase = Vl + (4 * hi5 + ((lane & 15) >> 2)) * 144 + (16 * ((lane >> 4) & 1) + 4 * (lane & 3)) * 2;
#pragma unroll
    for (int i = 0; i < 5; ++i) {
        u32x2 tv[8];
        { const LAS unsigned char* vp = vbase + 32 * (kb0 + i) * 144;
          asm volatile("ds_read_b64_tr_b16 %0, %8\n\tds_read_b64_tr_b16 %1, %8 offset:1152\n\tds_read_b64_tr_b16 %2, %8 offset:64\n\tds_read_b64_tr_b16 %3, %8 offset:1216\n\t"
                       "ds_read_b64_tr_b16 %4, %8 offset:2304\n\tds_read_b64_tr_b16 %5, %8 offset:3456\n\tds_read_b64_tr_b16 %6, %8 offset:2368\n\tds_read_b64_tr_b16 %7, %8 offset:3520\n\ts_waitcnt lgkmcnt(0)"
                       : "=&v"(tv[0]), "=&v"(tv[1]), "=&v"(tv[2]), "=&v"(tv[3]), "=&v"(tv[4]), "=&v"(tv[5]), "=&v"(tv[6]), "=&v"(tv[7]) : "v"(vp) : "memory"); }
#pragma unroll
        for (int s2 = 0; s2 < 2; ++s2) {
            v4u pw; pw.x = cvtpk_c(S[i][8 * s2 + 0], S[i][8 * s2 + 1]); pw.y = cvtpk_c(S[i][8 * s2 + 2], S[i][8 * s2 + 3]);
            pw.z = cvtpk_c(S[i][8 * s2 + 4], S[i][8 * s2 + 5]); pw.w = cvtpk_c(S[i][8 * s2 + 6], S[i][8 * s2 + 7]);
            const pg8::bf16x8 pf = __builtin_bit_cast(pg8::bf16x8, pw);
            { v4u vw; vw.x = tv[4 * s2 + 0].x; vw.y = tv[4 * s2 + 0].y; vw.z = tv[4 * s2 + 1].x; vw.w = tv[4 * s2 + 1].y; O0 = __builtin_amdgcn_mfma_f32_32x32x16_bf16(__builtin_bit_cast(pg8::bf16x8, vw), pf, O0, 0, 0, 0); }
            { v4u vw; vw.x = tv[4 * s2 + 2].x; vw.y = tv[4 * s2 + 2].y; vw.z = tv[4 * s2 + 3].x; vw.w = tv[4 * s2 + 3].y; O1 = __builtin_amdgcn_mfma_f32_32x32x16_bf16(__builtin_bit_cast(pg8::bf16x8, vw), pf, O1, 0, 0, 0); }
        }
    }
    __builtin_amdgcn_s_setprio(0);
#pragma unroll
    for (int qd = 0; qd < 4; ++qd) {
        u32x2 w0; w0.x = pg8::cvt_pk_bf16(O0[4 * qd] * inv, O0[4 * qd + 1] * inv); w0.y = pg8::cvt_pk_bf16(O0[4 * qd + 2] * inv, O0[4 * qd + 3] * inv);
        u32x2 w1; w1.x = pg8::cvt_pk_bf16(O1[4 * qd] * inv, O1[4 * qd + 1] * inv); w1.y = pg8::cvt_pk_bf16(O1[4 * qd + 2] * inv, O1[4 * qd + 3] * inv);
        *(LAS u32x2*)(stg + r32 * 144 + (8 * qd + 4 * hi5) * 2) = w0; *(LAS u32x2*)(stg + r32 * 144 + (32 + 8 * qd + 4 * hi5) * 2) = w1;
    }
    LDS_WAIT(); asm volatile("" ::: "memory");
#pragma unroll
    for (int i = 0; i < 4; ++i) {
        const int qq = (lane >> 3) + 8 * i, c = lane & 7;
        const v4u w = *(const LAS v4u*)(stg + qq * 144 + c * 16);
        const int orow = orow0 + (samp ? (qq & 7) : qq), ohead = ohead0 + (samp ? (qq >> 3) : 0);
        *(v4u*)(Ob + (size_t)orow * 1024 + ohead * 64 + 8 * c) = w;
    }
    LDS_WAIT(); asm volatile("" ::: "memory");
}

template <class T> __device__ __forceinline__ T karg(const __attribute__((address_space(4))) char* ka, int off) { typedef const __attribute__((address_space(4))) T CT; return *(CT*)(ka + off); }
struct Args { const float* in[23]; float* out; unsigned char* ws; int ph_lo, ph_hi; };
static_assert(sizeof(Args) == 208 && __builtin_offsetof(Args, out) == 184 && __builtin_offsetof(Args, ws) == 192, "kernarg layout used by KARG");

#define KARG(T, off) karg<T>(ka, (off))
#define INP(k) karg<const float*>(ka, 8 * (k))
constexpr int CI_QKV = 16 * 24, CI_O = 16 * 16, CI_GLU = 16 * 32, CI_UP = 16 * 64, CI_DN = 64 * 16, CI_SLOT = CI_O + 2 * CI_UP + 2 * CI_DN + CI_GLU;
constexpr int CI_SLOT_A = CI_O + CI_UP + CI_DN;
__device__ __forceinline__ void convert_gi(const __attribute__((address_space(4))) char* ka, unsigned char* ws, LAS float* scr, int gi, int lane) {
    int r = gi;
    if (r < CI_QKV) { p0_transpose_item(INP(9), D, NQKV, INP(6), (bf16*)(ws + WS_WQKV), 0, scr, r, lane); return; } r -= CI_QKV;
    const int sl = r / CI_SLOT; r -= sl * CI_SLOT;
    if (sl >= 2) { p0_transpose_item(INP(9) + (size_t)D * NQKV, D, NQKV, INP(6) + (size_t)2 * D, (bf16*)(ws + WS_WQKV) + (size_t)NQKV * D, 0, scr, r, lane); return; }
    const int la = 2 * sl, ls = 2 * sl + 1;
    if (r < CI_O) { p0_transpose_item(INP(10) + (size_t)sl * D * D, D, D, nullptr, (bf16*)(ws + WS_WO) + (size_t)sl * D * D, 0, scr, r, lane); return; } r -= CI_O;
    if (r < CI_UP) { p0_transpose_item(INP(21) + (size_t)la * D * FF, D, FF, INP(7) + (size_t)la * D, (bf16*)(ws + WS_WUP) + (size_t)la * FF * D, 0, scr, r, lane); return; } r -= CI_UP;
    if (r < CI_DN) { p0_transpose_item(INP(22) + (size_t)la * FF * D, FF, D, nullptr, (bf16*)(ws + WS_WDN) + (size_t)la * D * FF, 0, scr, r, lane); return; } r -= CI_DN;
    if (r < CI_GLU) { p0_transpose_item(INP(20) + (size_t)sl * D * 2 * D, D, 2 * D, nullptr, (bf16*)(ws + WS_WGLU) + (size_t)sl * 2 * D * D, 1, scr, r, lane); return; } r -= CI_GLU;
    if (r < CI_UP) { p0_transpose_item(INP(21) + (size_t)ls * D * FF, D, FF, INP(7) + (size_t)ls * D, (bf16*)(ws + WS_WUP) + (size_t)ls * FF * D, 0, scr, r, lane); return; } r -= CI_UP;
    p0_transpose_item(INP(22) + (size_t)ls * FF * D, FF, D, nullptr, (bf16*)(ws + WS_WDN) + (size_t)ls * D * FF, 0, scr, r, lane);
}
#ifndef SKEW_UP
#define SKEW_UP 250
#define SKEW_GLU 250
#endif
#ifndef PROBE_DUP
#endif
#define NREP(bit) (((PROBE_DUP) >> (bit)) & 1 ? 2 : 1)
#ifndef EN_P0
#define EN_P0 1
#endif
#ifndef EN_QKV
#define EN_QKV 1
#endif
#ifndef EN_ATT
#define EN_ATT 1
#endif
#ifndef EN_OPJ
#define EN_OPJ 1
#endif
#ifndef EN_S1
#define EN_S1 1
#endif
#ifndef EN_S3
#define EN_S3 1
#endif
#ifndef EN_GLU
#define EN_GLU 1
#endif
#ifndef EN_UP
#define EN_UP 1
#endif
#ifndef EN_DN
#define EN_DN 1
#endif
#ifndef EN_FIN
#define EN_FIN 1
#endif
__global__ void __launch_bounds__(512, 2) fwd_kernel(Args args) {
    extern __shared__ __attribute__((aligned(16))) unsigned char lds[];
    LAS unsigned char* const L = (LAS unsigned char*)lds;
#define FRESH_IDS int tid = threadIdx.x; asm volatile("" : "+v"(tid)); const int lane = tid & 63, wave = __builtin_amdgcn_readfirstlane(tid >> 6); const int gw = vcu * 8 + wave; (void)lane; (void)gw
    const int G = gridDim.x, bx = blockIdx.x;
    const int vcu = (G % 8 == 0) ? (bx % 8) * (G / 8) + bx / 8 : bx;
    const int NGW = G * 8;
    for (int u = threadIdx.x; u < (LDS_BYTES - LDSCTL_OFF) / 4; u += 512) ((LAS unsigned*)(L + LDSCTL_OFF))[u] = 0u;
    __syncthreads();
    const int lo = args.ph_lo, hi = args.ph_hi;
    Prof pr; pr.tacc = 0ull; pr.tlast = PROBE_TM ? __builtin_amdgcn_s_memrealtime() : 0ull;
    const bool multi = (hi - lo) > 1;
    XcdBarrier bar; bar.bar = (unsigned*)(args.ws + WS_CTL) + CW_BAR; bar.x = 0; bar.st = nullptr;
#define FLAT_BAR 2
#define USE_LOCAL_SEAMS 1
#define FUSE_FINAL 1
#define SLOT_ONE_PCT 72
#define TOUCH_B 1
#define TOUCH_W 0
#define UNIT_TOUCH 0
#define UP_BNT false
#define ATT_ROT 0
#define ATT_KV_PREFETCH 0
#define SAMP_BATCH 5
#define PROBE_UNI 0
#if FLAT_BAR == 1
    bar.x = xb_xcc_id(); bar.st = (volatile LAS unsigned*)(L + MISC_OFF) + 8;
#define GRID_BARRIER flat_barrier
#else
    if (multi) bar = xcd_barrier_post((unsigned*)(args.ws + WS_CTL) + CW_BAR, (volatile LAS unsigned*)(L + MISC_OFF) + 8);
#if FLAT_BAR == 2
#define GRID_BARRIER xcd_barrier2
#else
#define GRID_BARRIER xcd_barrier
#endif
#endif
    (void)multi;
#define IN(k) (lo <= (k) && (k) < hi)
#define MARK(c) PMARK(pr, c)
#define SEAM(k, c) do { MARK(c); if (IN(k) && IN((k) + 1)) GRID_BARRIER(bar); MARK(1); } while (0)
#define SEAM_LB(k, c, wptr, wstride, wbytes) do { MARK(c); if (IN(k) && IN((k) + 1)) { if (uni) { xcd_local_barrier(bar, TOUCH_B ? (const char*)(wptr) + (size_t)(gm >> 1) * ((wstride) / 128) * 32768 : nullptr, 0u); MARK(2); } else { GRID_BARRIER(bar); MARK(1); } } } while (0)
#define SEAM_L(k, c) do { MARK(c); if (IN(k) && IN((k) + 1)) { if (uni) { xcd_local_barrier(bar); MARK(2); } else { GRID_BARRIER(bar); MARK(1); } } } while (0)

#define FRESH_PTRS const __attribute__((address_space(4))) char* ka = (const __attribute__((address_space(4))) char*)__builtin_amdgcn_kernarg_segment_ptr(); asm volatile("" : "+s"(ka)); \
    unsigned char* const ws = KARG(unsigned char*, 192); float* const out = KARG(float*, 184); \
    float* const ssp = (float*)(ws + WS_SSP); float* const HS = (float*)(ws + WS_HS); bf16* const XB = (bf16*)(ws + WS_XB); bf16* const Hb = (bf16*)(ws + WS_H); \
    bf16* const Qb = (bf16*)(ws + WS_Q); bf16* const Kb = (bf16*)(ws + WS_K); bf16* const Vb = (bf16*)(ws + WS_V); bf16* const Ob = (bf16*)(ws + WS_O); \
    const float* const x_p = INP(0); const float* const x_s = INP(1); (void)ssp; (void)HS; (void)XB; (void)Hb; (void)Qb; (void)Kb; (void)Vb; (void)Ob; (void)x_p; (void)x_s
    if (EN_P0 && IN(0)) for (int rp = 0; rp < NREP(0); ++rp) {
        FRESH_IDS; FRESH_PTRS;
        LAS float* scr = (LAS float*)(L + wave * 16640);
        for (int it = gw; it < 2 * CI_QKV; it += NGW) convert_gi(ka, ws, scr, (it < CI_QKV) ? it : it - CI_QKV + CI_QKV + 2 * CI_SLOT, lane);
        const int tb = G - 1 - vcu, tc = (tb + G - (16 % G)) % G;
        for (int i = tb * 512 + tid; i < 2 * NG * NS; i += G * 512) {
            const int jj = i >> 12, gn = i & 4095, g = gn >> 6, n = gn & 63; float abr, abi, cfr, cfi;
            ssm_abar_calc(INP(12) + (size_t)jj * NG * NS, INP(13) + (size_t)jj * NG * NS, INP(14) + (size_t)jj * NG, g, n, abr, abi, cfr, cfi);
            f32x4 v; v[0] = abr; v[1] = abi; v[2] = cfr; v[3] = cfi; *(f32x4*)((float*)(ws + WS_TAB) + (size_t)i * 4) = v;
            const float* bre = INP(15) + (size_t)i * 16; const float* bim = INP(16) + (size_t)i * 16; const float* gn_ = INP(6) + (size_t)(2 * jj + 1) * D + g * 16;
            bf16* btr = (bf16*)(ws + WS_BT) + ((size_t)(jj * NG + g) * 128 + (2 * (n >> 5)) * 32 + (n & 31)) * 16; bf16* bti = btr + 32 * 16;
#pragma unroll
            for (int c8 = 0; c8 < 2; ++c8) {
                float wr_[8], wi_[8];
#pragma unroll
                for (int c4 = 0; c4 < 2; ++c4) { const f32x4 br = *(const f32x4*)(bre + 8 * c8 + 4 * c4), bi = *(const f32x4*)(bim + 8 * c8 + 4 * c4), gv = *(const f32x4*)(gn_ + 8 * c8 + 4 * c4);
#pragma unroll
                    for (int e = 0; e < 4; ++e) { wr_[4 * c4 + e] = (cfr * br[e] - cfi * bi[e]) * gv[e]; wi_[4 * c4 + e] = (cfr * bi[e] + cfi * br[e]) * gv[e]; } }
                v4u o; o.x = pk2(wr_[0], wr_[1]); o.y = pk2(wr_[2], wr_[3]); o.z = pk2(wr_[4], wr_[5]); o.w = pk2(wr_[6], wr_[7]); *(v4u*)(btr + 8 * c8) = o;
                o.x = pk2(wi_[0], wi_[1]); o.y = pk2(wi_[2], wi_[3]); o.z = pk2(wi_[4], wi_[5]); o.w = pk2(wi_[6], wi_[7]); *(v4u*)(bti + 8 * c8) = o;
            }
        }
        for (int i = tc * 512 + tid; i < 2 * NG * GC * 16; i += G * 512) {
            const int n4 = i & 15; const size_t rowi = (size_t)(i >> 4);
            const f32x4 cr = *(const f32x4*)(INP(17) + rowi * 64 + 4 * n4), ci = *(const f32x4*)(INP(18) + rowi * 64 + 4 * n4);
            unsigned* crow = (unsigned*)((bf16*)(ws + WS_CT) + rowi * 128);
#pragma unroll
            for (int e = 0; e < 4; ++e) { const int n = 4 * n4 + e; crow[2 * (n & 31) + (n >> 5)] = pk2(cr[e], -ci[e]); }
        }
        __syncthreads();
    }
    SEAM(0, 3);
    int cbx = bx, gq = 0, gm = 0; bool uni = false;
    const bool fusefin = FUSE_FINAL && multi && (G == (MP / 256) * (D / 256));
#if USE_LOCAL_SEAMS
    if (IN(0) && IN(1) && G == 256) { const unsigned ev = bar.st[3], rk = bar.st[2]; uni = __builtin_amdgcn_readfirstlane((int)ev) != 0;
        if (uni) { const int rk_ = __builtin_amdgcn_readfirstlane((int)rk); cbx = (int)bar.x + 8 * rk_; gq = 4 * (int)bar.x + (rk_ & 3); gm = rk_ >> 2; } }
    if (PROBE_UNI && uni) { const unsigned long long t0 = __builtin_amdgcn_s_memrealtime(); while (__builtin_amdgcn_s_memrealtime() - t0 < 20000ull) __builtin_amdgcn_s_sleep(8); }
#endif

    if (EN_P0 && IN(0)) for (int rp = 0; rp < NREP(0); ++rp) {
        FRESH_IDS; FRESH_PTRS;
        const int nunit = uni ? 34 * 8 : (M / 16) * 8, ustart = uni ? gm * 8 + wave : gw, ustep = uni ? 64 : NGW;
        const int r16 = lane >> 2, c4 = lane & 3;
#pragma unroll 1
        for (int u = ustart; u < nunit; u += ustep) {
            const int lg = u >> 3, cb = u & 7;
            const int row0 = uni ? ((lg < 16) ? 256 * gq + 16 * lg : (lg < 32) ? SEQ + 256 * gq + 16 * (lg - 16) : (lg == 32) ? MP + 16 * gq : MP + 16 * (32 + gq)) : 16 * lg;
            const int m = row0 + r16;
            const float* xrow = ((m < MP) ? x_p + (size_t)m * D : x_s + (size_t)(m - MP) * D) + 128 * cb + 8 * c4;
            f32x4 v[4][2];
#pragma unroll
            for (int sc = 0; sc < 4; ++sc) { v[sc][0] = *(const GAS f32x4*)(xrow + 32 * sc); v[sc][1] = *(const GAS f32x4*)(xrow + 32 * sc + 4); }
            float sq = 0.f;
#pragma unroll
            for (int sc = 0; sc < 4; ++sc) {
                sq += pg8::sumsq4(v[sc][0]) + pg8::sumsq4(v[sc][1]);
                v4u o; o.x = pk2(v[sc][0][0], v[sc][0][1]); o.y = pk2(v[sc][0][2], v[sc][0][3]); o.z = pk2(v[sc][1][0], v[sc][1][1]); o.w = pk2(v[sc][1][2], v[sc][1][3]);
                *(v4u*)((char*)XB + pg8::xb_off(m, 128 * cb + 32 * sc + 8 * c4)) = o;
            }
            sq += __shfl_xor(sq, 1); sq += __shfl_xor(sq, 2);
            ssp[(size_t)m * 64 + cb + 8 * c4] = (c4 == 0) ? sq : 0.f;
        }
        __syncthreads();
    }
    SEAM_L(0, 4);

    for (int l = 0; l < 4; ++l) {
        const int pb = 1 + 5 * l, j = l >> 1;
        if ((l & 1) == 0) {
            if (EN_QKV && IN(pb)) for (int rp = 0; rp < NREP(3); ++rp) {
                FRESH_PTRS;
                pg8::GemmX g{XB, (const bf16*)(ws + WS_WQKV) + (size_t)j * NQKV * D, (const bf16*)((const char*)XB + pg8::XBX_OFF), D}; pg8::PanelOrder S; { int cb_ = cbx, q_ = gq, m_ = gm; asm volatile("" : "+s"(cb_), "+s"(q_), "+s"(m_)); S.init(MP, NQKV, G, cb_, uni ? 1 : 0, q_, m_); }
                pg8::EpiQKV E{Qb, Kb, Vb, ssp, 16, 32, out + O_KP + (size_t)j * 2 * 128 * 256, out + O_VP + (size_t)j * 2 * 128 * 256, out + O_KS + (size_t)j * SB * 128 * 256, out + O_VS + (size_t)j * SB * 128 * 256};
                if (threadIdx.x == 0) *(LAS int*)(L + pg8::RINV_TAB_OFF + 1152) = -1;
                __syncthreads();
                pg8::gemm_phase_x<pg8::EpiQKV, pg8::PanelOrder, 1, 1, 0, true>(L, g, S, E, pr, 22);
                if (rp == 0) {
                    FRESH_IDS;
                    LAS float* scr = (LAS float*)(L + wave * 16640);
                    constexpr int NCHUNK = 256 * 24;
                    const bool one = uni && gm >= 4;
                    const int nshare = uni ? 128 : G, myw = (uni ? gq * 4 + (gm & 3) : bx) * 8 + wave;
                    const int csplit = uni ? (CI_SLOT_A * SLOT_ONE_PCT) / 100 : CI_SLOT_A, ksplit = uni ? (NCHUNK * SLOT_ONE_PCT) / 100 : NCHUNK;
                    const int clo = (uni && !one) ? csplit : 0, chi = (uni && !one) ? CI_SLOT_A : csplit, klo = (uni && !one) ? ksplit : 0, khi = (uni && !one) ? NCHUNK : ksplit;
#pragma unroll 1
                    for (int it = clo + myw; it < chi; it += nshare * 8) convert_gi(ka, ws, scr, CI_QKV + j * CI_SLOT + it, lane);
#pragma unroll 1
                    for (int c = klo + myw; c < khi; c += nshare * 8) {
                        const int jb = c / 24, part = c - jb * 24;
                        const f32x4* src = (const f32x4*)(INP(2 + j) + (size_t)jb * 128 * 256 + 8 * 256) + part * 320 + lane;
                        f32x4* dst = (f32x4*)(out + (j ? O_VS : O_KS) + (size_t)jb * 128 * 256) + part * 320 + lane;
                        f32x4 v[5];
#pragma unroll
                        for (int k = 0; k < 5; ++k) v[k] = src[k * 64];
#pragma unroll
                        for (int k = 0; k < 5; ++k) dst[k * 64] = v[k];
                    }
                    __syncthreads();
                }
            }
            SEAM(pb, 5);
            if (EN_ATT && IN(pb + 1)) for (int rp = 0; rp < NREP(1); ++rp) {
                FRESH_IDS; FRESH_PTRS;
                const float* ck = INP(2) + (size_t)j * SB * 128 * 256; const float* cv = INP(3) + (size_t)j * SB * 128 * 256;
                const float* sinks = INP(11) + j * 16;
                const int r32 = lane & 31;
                const int nrounds = (512 + 256 + G - 1) / G;
                const int hw = wave >> 2, t256 = tid & 255;
                int gq_ = gq, gm_ = gm, vcu_ = vcu; asm volatile("" : "+s"(gq_), "+s"(gm_), "+s"(vcu_));
                auto decode = [&](int ur_, bool& valid_, bool& samp_, int& kvh_, int& qblk_, int& b_) {
                    const int u_ = vcu_ + ur_ * G; valid_ = (ur_ < nrounds) && (uni || u_ < 512 + 256); samp_ = uni ? (ur_ == 2) : (u_ >= 512); qblk_ = 0; kvh_ = 0; b_ = 0;
                    if (uni) { if (!samp_) { const int t = gm_ + 8 * ur_; b_ = t & 1; qblk_ = 2 * gq_ + ((t >> 1) & 1); kvh_ = t >> 2; } else { const int usl = 2 * gm_ + hw, bs = usl >> 2; kvh_ = usl & 3; b_ = 2 * gq_ + (bs & 1) + 64 * (bs >> 1); } }
                    else if (!samp_) { kvh_ = u_ & 3; qblk_ = (u_ >> 2) & 63; b_ = u_ >> 8; } else { const int us = 2 * (u_ - 512) + hw; kvh_ = us & 3; b_ = us >> 2; }
                };
                v4u kv[4], vv[4];
                auto issue_kv = [&](int qblk_, int b_, int kvh_) {
#pragma unroll
                    for (int c = 0; c < 4; ++c) { const int id = tid + 512 * c, key = id >> 3, ch = id & 7, s_ = qblk_ * 128 - 128 + key;
                        kv[c] = (v4u){0u, 0u, 0u, 0u}; vv[c] = (v4u){0u, 0u, 0u, 0u};
                        if (s_ >= 0) { const size_t off = (size_t)((b_ << 13) + s_) * 256 + kvh_ * 64 + ch * 8; kv[c] = *(const v4u*)(Kb + off); vv[c] = *(const v4u*)(Vb + off); } }
                };
                if (ATT_KV_PREFETCH) { bool v0_, s0_; int k0_, q0_, b0_; decode(0, v0_, s0_, k0_, q0_, b0_); if (v0_ && !s0_) issue_kv(q0_, b0_, k0_); }
                for (int ur = 0; ur < nrounds; ++ur) {
                    bool valid, samp; int kvh, qblk, b;
                    decode(ur, valid, samp, kvh, qblk, b);
                    if (!valid) break;
                    LAS unsigned char* Ks = samp ? L + hw * 56320 : L; LAS unsigned char* Vs = samp ? Ks + 23040 : L + 36864;
                    if (!samp) {
                        if (!ATT_KV_PREFETCH) issue_kv(qblk, b, kvh);
#pragma unroll
                        for (int c = 0; c < 4; ++c) { const int id = tid + 512 * c, key = id >> 3, ch = id & 7;
                            *(LAS v4u*)(Ks + key * 144 + ch * 16) = kv[c];
                            *(LAS v4u*)(Vs + key * 144 + ch * 16) = vv[c]; }
                    } else {
#pragma unroll 1
                    for (int c0 = 0; c0 < 5; c0 += SAMP_BATCH) {
                        v4u kv[SAMP_BATCH], vv[SAMP_BATCH];
#pragma unroll
                        for (int c = 0; c < SAMP_BATCH; ++c) { const int id = t256 + 256 * (c0 + c), key = id >> 3, ch = id & 7;
                            kv[c] = (v4u){0u, 0u, 0u, 0u}; vv[c] = (v4u){0u, 0u, 0u, 0u};
                            if (c0 + c < 5) {
                            if (key < 128) { const size_t off = ((size_t)b * 128 + key) * 256 + kvh * 64 + ch * 8;
                                const f32x4 k0 = *(const f32x4*)(ck + off), k1 = *(const f32x4*)(ck + off + 4), v0 = *(const f32x4*)(cv + off), v1 = *(const f32x4*)(cv + off + 4);
                                kv[c].x = pk2(k0[0], k0[1]); kv[c].y = pk2(k0[2], k0[3]); kv[c].z = pk2(k1[0], k1[1]); kv[c].w = pk2(k1[2], k1[3]);
                                vv[c].x = pk2(v0[0], v0[1]); vv[c].y = pk2(v0[2], v0[3]); vv[c].z = pk2(v1[0], v1[1]); vv[c].w = pk2(v1[2], v1[3]); }
                            else if (key < 136) { const size_t off = (size_t)(MP + b * 8 + (key - 128)) * 256 + kvh * 64 + ch * 8; kv[c] = *(const v4u*)(Kb + off); vv[c] = *(const v4u*)(Vb + off); } } }
#pragma unroll
                        for (int c = 0; c < SAMP_BATCH; ++c) if (c0 + c < 5) { const int id = t256 + 256 * (c0 + c), key = id >> 3, ch = id & 7;
                            *(LAS v4u*)(Ks + key * 144 + ch * 16) = kv[c];
                            *(LAS v4u*)(Vs + key * 144 + ch * 16) = vv[c]; }
                    }
                    }
                    const int hi5q = lane >> 5;
                    const int head0 = samp ? kvh * 4 + (r32 >> 3) : kvh * 4 + (wave >> 1), tloc0 = samp ? (r32 & 7) : 32 * (2 * (wave & 1)) + r32;
                    const int qrow0 = samp ? MP + b * 8 + tloc0 : (b << 13) + qblk * 128 + tloc0;
                    pg8::bf16x8 qf[4];
#pragma unroll
                    for (int ks = 0; ks < 4; ++ks) qf[ks] = *(const pg8::bf16x8*)((const char*)Qb + pg8::xb_off(qrow0, head0 * 64 + 16 * ks + 8 * hi5q));
                    __syncthreads();
                    if (ATT_KV_PREFETCH) { bool vn_, sn_; int kn_, qn_, bn_; decode(ur + 1, vn_, sn_, kn_, qn_, bn_); if (vn_ && !sn_) issue_kv(qn_, bn_, kn_); }
                    const int ntask = samp ? (((wave & 3) == 0) ? 1 : 0) : 2;
                    for (int ti = 0; ti < ntask; ++ti) {
                        int head, tloc, kb0, jkmin;
                        if (!samp) { const int sb = 2 * (wave & 1) + ti; head = head0; tloc = 32 * sb + r32; kb0 = sb; jkmin = (qblk == 0) ? 128 : 0; }
                        else { head = head0; tloc = tloc0; kb0 = 0; jkmin = 0; }
                        if (ti > 0) {
#pragma unroll
                            for (int ks = 0; ks < 4; ++ks) qf[ks] = *(const pg8::bf16x8*)((const char*)Qb + pg8::xb_off(qrow0 + 32 * ti, head0 * 64 + 16 * ks + 8 * hi5q));
                        }
                        LAS unsigned char* stg = samp ? (L + 112640 + hw * 4608) : (L + 73728 + wave * 4608);
                        attn_task(Ks, Vs, stg, qf, Ob, sinks, head, tloc, kb0, jkmin, lane, samp, samp ? (MP + b * 8) : ((b << 13) + qblk * 128 + 32 * (2 * (wave & 1) + ti)), samp ? kvh * 4 : head);
                    }
                    __syncthreads();
                    MARK(samp ? 14 : 13);
                }
            }
            SEAM_LB(pb + 1, 6, args.ws + WS_WO + (size_t)j * D * D * 2, D * 2, D * D * 2);
            if (EN_OPJ && IN(pb + 2)) {
                FRESH_PTRS;
                pg8::GemmX g{Ob, (const bf16*)(ws + WS_WO) + (size_t)j * D * D, nullptr, D}; pg8::PanelOrder S; { int cb_ = cbx, q_ = gq, m_ = gm; asm volatile("" : "+s"(cb_), "+s"(q_), "+s"(m_)); S.init(MP, D, G, cb_, uni ? 1 : 0, q_, m_); }
                pg8::EpiRes E{XB, ssp};
                pg8::gemm_phase_x<pg8::EpiRes, pg8::PanelOrder>(L, g, S, E, pr, 25);
            }
            SEAM_LB(pb + 2, 7, args.ws + WS_WUP + (size_t)l * FF * D * 2, D * 2, FF * D * 2);
        } else {
#define SSMT(gg) const SsmT T_{(const bf16*)(ws + WS_BT) + ((size_t)j * NG + (gg)) * 128 * 16, (const bf16*)(ws + WS_CT) + ((size_t)j * NG + (gg)) * 16 * 128, (const float*)(ws + WS_TAB) + ((size_t)j * NG + (gg)) * NS * 4, \
                          INP(19) + (size_t)j * D + (gg) * 16, INP(6) + (size_t)l * D + (gg) * 16}
            if (EN_S1 && IN(pb)) for (int rp = 0; rp < NREP(2); ++rp) {
                FRESH_IDS; FRESH_PTRS; LAS unsigned char* wl = L + wave * 9728; LAS float* rvs = (LAS float*)(L + 8 * 9728);
                for (int u = uni ? gq * 64 + gm * 8 + wave : gw; u < (NCH - 1) * NG; u += uni ? (NCH * NG) : NGW) {
                    int lane = tid & 63; asm volatile("" : "+v"(lane));
                    const int g = u & 63, ch = u >> 6, hb = lane >> 5;
                    SSMT(g);
                    float st[4] = {0.f, 0.f, 0.f, 0.f};
                    ssm_mfma_unit<0>(wl, lane, g, T_, XB, rvs, ssp, tid, ch * CH, SEQ + ch * CH, CH / 16, st, nullptr, nullptr, nullptr, nullptr, nullptr, 0, 0);
                    { float* hs = HS + ((size_t)((hb * NCH + ch) * NG + g) * NS) * 2; const int r32 = lane & 31; *(float2*)(hs + 2 * r32) = make_float2(st[0], st[1]); *(float2*)(hs + 2 * (32 + r32)) = make_float2(st[2], st[3]); }
                }
                __syncthreads();
                if (rp == 0) {
                    LAS float* scr = (LAS float*)(L + wave * 16640);
#pragma unroll 1
                    for (int it = gw; it < CI_SLOT - CI_SLOT_A; it += NGW) convert_gi(ka, ws, scr, CI_QKV + j * CI_SLOT + CI_SLOT_A + it, lane);
                    __syncthreads();
                }
            }
            SEAM(pb, 8);
            if (EN_S3 && IN(pb + 1)) for (int rp = 0; rp < NREP(2); ++rp) {
                FRESH_IDS; FRESH_PTRS; LAS unsigned char* wl = L + wave * 9728; LAS float* rvs = (LAS float*)(L + 8 * 9728);
                for (int u = uni ? gq * 64 + gm * 8 + wave : gw; u < NCH * NG + (SB / 4) * NG; u += uni ? (NCH * NG) : NGW) {
                    int lane = tid & 63; asm volatile("" : "+v"(lane));
                    if (u < NCH * NG) {
                        const int g = u & 63, ch = u >> 6, r32 = lane & 31, hb = lane >> 5;
                        SSMT(g);
                        float st[4] = {0.f, 0.f, 0.f, 0.f};
                        f32x4 tv[2]; float2 e[16][2];
#pragma unroll
                        for (int p = 0; p < 2; ++p) tv[p] = *(const f32x4*)(T_.tab + (size_t)(32 * p + r32) * 4);
#pragma unroll
                        for (int k = 0; k < 16; ++k)
#pragma unroll
                            for (int p = 0; p < 2; ++p) e[k][p] = (k < ch) ? *(const float2*)(HS + ((size_t)((hb * NCH + k) * NG + g) * NS + 32 * p + r32) * 2) : make_float2(0.f, 0.f);
                        float aLr[2], aLi[2];
#pragma unroll
                        for (int p = 0; p < 2; ++p) {
                            float xr_ = tv[p][0], xi_ = tv[p][1];
#pragma unroll
                            for (int sq = 0; sq < 8; ++sq) { const float tr = xr_ * xr_ - xi_ * xi_, ti = 2.0f * xr_ * xi_; xr_ = tr; xi_ = ti; }
                            aLr[p] = xr_; aLi[p] = xi_;
                        }
                        for (int i0 = 0; i0 < ch; i0 += 16) {
                            if (i0 > 0) {
#pragma unroll
                                for (int k = 0; k < 16; ++k)
#pragma unroll
                                    for (int p = 0; p < 2; ++p) e[k][p] = (i0 + k < ch) ? *(const float2*)(HS + ((size_t)((hb * NCH + i0 + k) * NG + g) * NS + 32 * p + r32) * 2) : make_float2(0.f, 0.f);
                            }
#pragma unroll
                            for (int k = 0; k < 16; ++k) if (i0 + k < ch) {
#pragma unroll
                                for (int p = 0; p < 2; ++p) { const float tr = aLr[p] * st[2 * p] - aLi[p] * st[2 * p + 1] + e[k][p].x, ti = aLr[p] * st[2 * p + 1] + aLi[p] * st[2 * p] + e[k][p].y; st[2 * p] = tr; st[2 * p + 1] = ti; }
                            }
                        }
                        ssm_mfma_unit<1>(wl, lane, g, T_, XB, rvs, ssp, tid, ch * CH, SEQ + ch * CH, CH / 16, st, Ob, nullptr, nullptr, nullptr, nullptr, 0, 0);
                        if (ch == NCH - 1) { float* hr_o = out + O_HRP + ((size_t)(j * NB + hb) * NG + g) * NS; float* hi_o = out + O_HIP + ((size_t)(j * NB + hb) * NG + g) * NS;
                            hr_o[r32] = st[0]; hi_o[r32] = st[1]; hr_o[32 + r32] = st[2]; hi_o[32 + r32] = st[3]; }
                    } else {
                        const int us = u - NCH * NG, g = us & 63, bb = us >> 6;
                        const int rowL_ = uni ? MP + 16 * bb : MP + bb * 32, rowH_ = uni ? MP + 16 * (32 + bb) : MP + bb * 32 + 16, b0L_ = uni ? 2 * bb : 4 * bb, b0H_ = uni ? 64 + 2 * bb : 4 * bb + 2;
                        SSMT(g);
                        float st[4] = {0.f, 0.f, 0.f, 0.f};
                        ssm_mfma_unit<2>(wl, lane, g, T_, XB, rvs, ssp, tid, rowL_, rowH_, 1, st, Ob, INP(4) + (size_t)j * SB * NG * NS, INP(5) + (size_t)j * SB * NG * NS, out + O_HRS + (size_t)j * SB * NG * NS, out + O_HIS + (size_t)j * SB * NG * NS, b0L_, b0H_);
                    }
                }
                __syncthreads();
            }
            SEAM_LB(pb + 1, 9, args.ws + WS_WGLU + (size_t)j * 2 * D * D * 2, D * 2, 2 * D * D * 2);
            if (EN_GLU && IN(pb + 2)) {
                FRESH_PTRS;
                pg8::GemmX g{Ob, (const bf16*)(ws + WS_WGLU) + (size_t)j * 2 * D * D, nullptr, D}; pg8::PanelOrder S; { int cb_ = cbx, q_ = gq, m_ = gm; asm volatile("" : "+s"(cb_), "+s"(q_), "+s"(m_)); S.init(MP, 2 * D, G, cb_, uni ? 1 : 0, q_, m_); }
#if PROBE_S
                pg8::EpiGlu E{XB, ssp, 1.0f};
                pg8::gemm_phase_x<pg8::EpiGlu, pg8::PanelOrder>(L, g, S, E, pr, 28);
                if (PROBE_S & 4) { GRID_BARRIER(bar); pg8::EpiGlu E0{XB, ssp, 0.0f}; pg8::gemm_phase_x<pg8::EpiGlu, pg8::PanelOrder>(L, g, S, E0, pr, 0); }
#else
                pg8::EpiGlu E{XB, ssp};
                pg8::gemm_phase_x<pg8::EpiGlu, pg8::PanelOrder>(L, g, S, E, pr, 28);
#endif
            }
            SEAM_LB(pb + 2, 10, args.ws + WS_WUP + (size_t)l * FF * D * 2, D * 2, FF * D * 2);
        }
        if (EN_UP && IN(pb + 3)) for (int rp = 0; rp < NREP(4); ++rp) {
            FRESH_PTRS;
            pg8::GemmX g{XB, (const bf16*)(ws + WS_WUP) + (size_t)l * FF * D, (const bf16*)((const char*)XB + pg8::XBX_OFF), D}; pg8::PanelOrder S; { int cb_ = cbx, q_ = gq, m_ = gm; asm volatile("" : "+s"(cb_), "+s"(q_), "+s"(m_)); S.init(MP, FF, G, cb_, uni ? 1 : 0, q_, m_); }
            pg8::EpiUp E{Hb, (bf16*)(ws + WS_H + 128 * MiB), ssp, (l & 1) ? 32 : 16, (l & 1) ? 64 : 32};
            if (threadIdx.x == 0) *(LAS int*)(L + pg8::RINV_TAB_OFF + 1152) = -1;
            __syncthreads();
            pg8::gemm_phase_x<pg8::EpiUp, pg8::PanelOrder, NREP(5), NREP(6), 0, true, 0, UP_BNT, UNIT_TOUCH>(L, g, S, E, pr, 16);
        }
        SEAM_LB(pb + 3, 11, args.ws + WS_WDN + (size_t)l * D * FF * 2, FF * 2, D * FF * 2);
        if (EN_DN && IN(pb + 4)) {
            FRESH_PTRS;
            pg8::GemmX g{Hb, (const bf16*)(ws + WS_WDN) + (size_t)l * D * FF, (const bf16*)(ws + WS_H + 128 * MiB), FF}; pg8::PanelOrder S; { int cb_ = cbx, q_ = gq, m_ = gm; asm volatile("" : "+s"(cb_), "+s"(q_), "+s"(m_)); S.init(MP, D, G, cb_, uni ? 1 : 0, q_, m_); }
            if (l == 3 && fusefin) { pg8::EpiFin E{XB, ssp, INP(8), out, bar, uni}; pg8::gemm_phase_x<pg8::EpiFin, pg8::PanelOrder, 1, 1, 0, true>(L, g, S, E, pr, 19); }
            else {
            pg8::EpiRes E{XB, ssp};
            pg8::gemm_phase_x<pg8::EpiRes, pg8::PanelOrder, KREP_DN, 1, 0, true>(L, g, S, E, pr, 19); }
        }
        if (l == 1) SEAM_LB(pb + 4, 12, args.ws + WS_WQKV + (size_t)NQKV * D * 2, D * 2, NQKV * D * 2); else if (l < 3) SEAM_L(pb + 4, 12); else if (!fusefin) SEAM(pb + 4, 12); else MARK(12);
    }
    if (EN_FIN && IN(21) && !fusefin) for (int rp = 0; rp < NREP(9); ++rp) {
        FRESH_IDS; FRESH_PTRS;
        const float* gf = INP(8);
        f32x4 gv[4];
#pragma unroll
        for (int jx = 0; jx < 4; ++jx) gv[jx] = *(const f32x4*)(gf + 256 * jx + 4 * lane);
        for (int m0 = gw; m0 < M; m0 += 4 * NGW) {
            float pv[4]; pg8::u32x2 xw[4][4];
#pragma unroll
            for (int r = 0; r < 4; ++r) { const int m = m0 + r * NGW; pv[r] = 0.f;
                if (m < M) { if (lane < ((m < MP) ? 16 : 32)) pv[r] = ssp[(size_t)m * 64 + lane];
#pragma unroll
                    for (int jx = 0; jx < 4; ++jx) xw[r][jx] = *(const pg8::u32x2*)((const char*)XB + pg8::xb_off(m, 4 * lane + 256 * jx)); } }
#pragma unroll
            for (int r = 0; r < 4; ++r) { const int m = m0 + r * NGW;
                if (m < M) { const float rinv = rsqrtf(wave_sum(pv[r]) * (1.0f / 1024.0f) + 1e-6f); float* yo = out + (size_t)m * D + 4 * lane;
#pragma unroll
                    for (int jx = 0; jx < 4; ++jx) *(f32x4*)(yo + 256 * jx) = pg8::unpack4(xw[r][jx]) * rinv * gv[jx]; } }
        }
    }
    if (PROBE_TM) { const unsigned long long t0_ = __builtin_amdgcn_s_memrealtime(), dl_ = (unsigned long long)(PROBE_A) * pr.tacc; while (__builtin_amdgcn_s_memrealtime() - t0_ < dl_) __builtin_amdgcn_s_sleep(8); }
#undef IN
#undef SEAM
}

#ifndef MK_SPLIT
#define MK_SPLIT 0
#endif
extern "C" void kernel_launch(void* const* d_in, const int* in_sizes, int n_in, void* d_out, int out_size, void* d_ws, size_t ws_size, hipStream_t stream) {
    static int grid = 0;
    if (grid == 0) {
        if (n_in != 23 || in_sizes[0] != MP * D || (size_t)out_size != O_END || ws_size < WS_END) { fprintf(stderr, "kernel_launch: unexpected shapes (n_in %d, in0 %d, out %d, ws %zu); nothing launched\n", n_in, n_in > 0 ? in_sizes[0] : -1, out_size, ws_size); grid = -1; return; }
        int dev = 0, cus = 0, per_cu = 0;
        if (hipGetDevice(&dev) != hipSuccess || hipDeviceGetAttribute(&cus, hipDeviceAttributeMultiprocessorCount, dev) != hipSuccess) { fprintf(stderr, "kernel_launch: device query failed\n"); grid = -1; return; }
        if (hipFuncSetAttribute((const void*)fwd_kernel, hipFuncAttributeMaxDynamicSharedMemorySize, LDS_BYTES) != hipSuccess) { fprintf(stderr, "kernel_launch: hipFuncSetAttribute failed\n"); grid = -1; return; }
        if (hipOccupancyMaxActiveBlocksPerMultiprocessor(&per_cu, (const void*)fwd_kernel, 512, LDS_BYTES) != hipSuccess || per_cu < 1) fprintf(stderr, "kernel_launch: note: occupancy query reports %d blocks per CU\n", per_cu);
        (void)hipGetLastError();
        grid = cus;
    }
    if (grid < 0) return;
    (void)hipMemsetAsync((char*)d_ws + WS_CTL, 0, CTL_ZERO_BYTES, stream);
    Args a{};
    for (int i = 0; i < 23; ++i) a.in[i] = (const float*)d_in[i];
    a.out = (float*)d_out; a.ws = (unsigned char*)d_ws;
#if MK_SPLIT
    for (int p = 0; p < NPHASE; ++p) { a.ph_lo = p; a.ph_hi = p + 1; hipLaunchKernelGGL(fwd_kernel, dim3(grid), dim3(512), LDS_BYTES, stream, a); }
#else
    a.ph_lo = 0; a.ph_hi = NPHASE; hipLaunchKernelGGL(fwd_kernel, dim3(grid), dim3(512), LDS_BYTES, stream, a);
#endif
}
```
